# Optimizing an MI355X kernel written in HIP

```python
import jax, jax.numpy as jnp
from jax import lax
import numpy as np

D_MODEL = 1024
BATCH = 16
SEQ = 4096
DEPTH = 4

GRID_W = 64
CTX_LEN = 256
HEAD_DIM = 64
N_Q_HEADS = (D_MODEL // 2) // HEAD_DIM
N_KV_HEADS = max(N_Q_HEADS // 4, 1)
GQA_GROUP = N_Q_HEADS // N_KV_HEADS
ATTN_W = N_Q_HEADS * HEAD_DIM
KV_W = N_KV_HEADS * HEAD_DIM
CONF_W = D_MODEL // 4
CONF_CONV = 31
SCONV_W = D_MODEL - ATTN_W - CONF_W
SHORT_CONV = 3
MIX_W = ATTN_W + CONF_W + SCONV_W
IN_W = ATTN_W + 2 * KV_W + 2 * CONF_W + 3 * SCONV_W
Q_BLOCK = 128
ROPE_THETA = 10000.0
ROPE_AXIS_DIM = HEAD_DIM // 2
N_EXPERTS = 32
TOP_K = 4
D_EXPERT = D_MODEL
SWIGLU_ALPHA = 1.702
SWIGLU_LIMIT = 7.0
EXPERT_BLOCK = 256
N_ADA = 6
EPS = 1e-6

kernel_name = 'hybrid_parallel_heads_dit_moe'


def rms_norm(x, g):
    xf = x.astype(jnp.float32)
    y = xf * lax.rsqrt(jnp.mean(xf * xf, axis=-1, keepdims=True) + EPS)
    return (y * g.astype(jnp.float32)).astype(x.dtype)


def layer_norm(x, g, b):
    xf = x.astype(jnp.float32)
    mu = jnp.mean(xf, axis=-1, keepdims=True)
    var = jnp.mean(jnp.square(xf - mu), axis=-1, keepdims=True)
    y = (xf - mu) * lax.rsqrt(var + EPS)
    return (y * g.astype(jnp.float32) + b.astype(jnp.float32)).astype(x.dtype)


def modulate(x, g, shift, scale):
    return rms_norm(x, g) * (1 + scale) + shift


def depthwise_conv(x, w):
    pad = (w.shape[0] - 1) // 2
    return lax.conv_general_dilated(x, w[:, None, :].astype(x.dtype), (1,), [(pad, pad)],
                                    dimension_numbers=('NWC', 'WIO', 'NWC'),
                                    feature_group_count=x.shape[-1])


def axial_rope_tables(rows):
    row = jnp.repeat(jnp.arange(rows, dtype=jnp.float32), GRID_W)
    col = jnp.tile(jnp.arange(GRID_W, dtype=jnp.float32), rows)
    inv = ROPE_THETA ** (-jnp.arange(0, ROPE_AXIS_DIM, 2, dtype=jnp.float32) / ROPE_AXIS_DIM)
    ang = jnp.concatenate([row[:, None] * inv, col[:, None] * inv], axis=-1)
    return jnp.cos(ang), jnp.sin(ang)


def apply_axial_rope(x, cos, sin):
    xf = x.astype(jnp.float32)
    half = ROPE_AXIS_DIM // 2
    parts = []
    for a in range(2):
        xa = xf[..., a * ROPE_AXIS_DIM:(a + 1) * ROPE_AXIS_DIM]
        x1, x2 = xa[..., :half], xa[..., half:]
        ca = cos[:, None, a * half:(a + 1) * half]
        sa = sin[:, None, a * half:(a + 1) * half]
        parts += [x1 * ca - x2 * sa, x2 * ca + x1 * sa]
    return jnp.concatenate(parts, axis=-1).astype(x.dtype)


def heads(t, n):
    return t.reshape(t.shape[:-1] + (n, HEAD_DIM))


def split_in(p):
    return jnp.split(p, [ATTN_W, ATTN_W + KV_W, ATTN_W + 2 * KV_W, ATTN_W + 2 * KV_W + 2 * CONF_W], axis=-1)


def gqa_softmax(q, k, v):
    s = jnp.einsum('bqhgd,bkhd->bhgqk', q, k, preferred_element_type=jnp.float32) * (HEAD_DIM ** -0.5)
    p = jax.nn.softmax(s, axis=-1).astype(v.dtype)
    return jnp.einsum('bhgqk,bkhd->bqhgd', p, v)


def latent_attention(q, k, v, k_ctx, v_ctx):
    b, s = q.shape[:2]
    keys = jnp.concatenate([k, k_ctx], axis=1)
    vals = jnp.concatenate([v, v_ctx], axis=1)
    nb = s // Q_BLOCK
    qb = q.reshape(b, nb, Q_BLOCK, N_KV_HEADS, GQA_GROUP, HEAD_DIM).swapaxes(0, 1)
    out = lax.map(lambda qblk: gqa_softmax(qblk, keys, vals), qb)
    return out.swapaxes(0, 1).reshape(b, s, ATTN_W)


def conv_mixers(conf_in, sc_in, w_dw31, b_dw31, g_ln, b_ln, w_dw3):
    a, gate = jnp.split(conf_in, 2, axis=-1)
    u = depthwise_conv(a * jax.nn.sigmoid(gate), w_dw31) + b_dw31
    u = jax.nn.silu(layer_norm(u, g_ln, b_ln))
    bg, cg, hv = jnp.split(sc_in, 3, axis=-1)
    s = bg * depthwise_conv(cg * hv, w_dw3)
    return u, s


def merge_groups(attn, conf, sc, g_grp, w_out):
    y = jnp.concatenate([rms_norm(attn, g_grp[:ATTN_W]),
                         rms_norm(conf, g_grp[ATTN_W:ATTN_W + CONF_W]),
                         rms_norm(sc, g_grp[ATTN_W + CONF_W:])], axis=-1)
    return y @ w_out


def moe_ffn(h, w_r, b_r, w1, b1, w2, b2):
    n_tok = h.shape[0]
    n_pairs = n_tok * TOP_K
    logits = jnp.matmul(h, w_r, preferred_element_type=jnp.float32) + b_r.astype(jnp.float32)
    top_v, top_i = lax.top_k(logits, TOP_K)
    probs = jax.nn.softmax(top_v, axis=-1)
    e_flat = top_i.reshape(-1)
    tok_flat = jnp.arange(n_pairs, dtype=jnp.int32) // TOP_K
    w_flat = probs.reshape(-1)
    order = jnp.argsort(e_flat)
    e_sorted = e_flat[order]
    counts = jnp.bincount(e_flat, length=N_EXPERTS)
    starts = jnp.cumsum(counts) - counts
    padded = (counts + EXPERT_BLOCK - 1) // EXPERT_BLOCK * EXPERT_BLOCK
    pad_ends = jnp.cumsum(padded)
    dest = (pad_ends - padded)[e_sorted] + jnp.arange(n_pairs, dtype=jnp.int32) - starts[e_sorted]
    n_blocks = -(-n_pairs // EXPERT_BLOCK) + N_EXPERTS
    cap = n_blocks * EXPERT_BLOCK
    tok_buf = jnp.zeros((cap,), jnp.int32).at[dest].set(tok_flat[order])
    wt_buf = jnp.zeros((cap,), jnp.float32).at[dest].set(w_flat[order])
    blk_expert = jnp.minimum(jnp.searchsorted(pad_ends, jnp.arange(n_blocks) * EXPERT_BLOCK, side='right'),
                             N_EXPERTS - 1)

    def expert_block(args):
        tok, wt, e = args
        u = h[tok] @ w1[e] + b1[e]
        gate = jnp.minimum(u[:, 0::2], SWIGLU_LIMIT)
        up = jnp.clip(u[:, 1::2], -SWIGLU_LIMIT, SWIGLU_LIMIT)
        glu = gate * jax.nn.sigmoid(SWIGLU_ALPHA * gate)
        y = ((up + 1) * glu) @ w2[e] + b2[e]
        return y.astype(jnp.float32) * wt[:, None]

    ys = lax.map(expert_block, (tok_buf.reshape(n_blocks, EXPERT_BLOCK),
                                wt_buf.reshape(n_blocks, EXPERT_BLOCK), blk_expert))
    out = jnp.zeros((n_tok, h.shape[1]), jnp.float32).at[tok_buf].add(ys.reshape(cap, h.shape[1]))
    return out.astype(h.dtype)


def setup_inputs(seed: int = 0) -> dict:
    key = jax.random.key(seed)
    ks = jax.random.split(key, 24)
    f32 = jnp.float32
    nrm = jax.random.normal

    def w(k, shape, fan_in, scale=1.0):
        return nrm(k, shape, f32) * (scale * fan_in ** -0.5)

    def gain(k, shape):
        return 1.0 + 0.02 * nrm(k, shape, f32)

    def bias(k, shape, s=0.02):
        return s * nrm(k, shape, f32)

    return {
        'x': nrm(ks[0], (BATCH, SEQ, D_MODEL), f32),
        'c': nrm(ks[1], (BATCH, D_MODEL), f32),
        'ctx': nrm(ks[2], (BATCH, CTX_LEN, D_MODEL), f32),
        'c_ctx': nrm(ks[3], (D_MODEL,), f32),
        'w_ada': w(ks[4], (DEPTH, D_MODEL, N_ADA * D_MODEL), D_MODEL, 0.5),
        'b_ada': bias(ks[5], (DEPTH, N_ADA * D_MODEL)),
        'g_norm_mix': gain(ks[6], (DEPTH, D_MODEL)),
        'g_norm_ffn': gain(ks[7], (DEPTH, D_MODEL)),
        'w_in': w(ks[8], (DEPTH, D_MODEL, IN_W), D_MODEL),
        'g_q': gain(ks[9], (DEPTH, HEAD_DIM)),
        'g_k': gain(ks[10], (DEPTH, HEAD_DIM)),
        'w_conf_dw': w(ks[11], (DEPTH, CONF_CONV, CONF_W), CONF_CONV),
        'b_conf_dw': bias(ks[12], (DEPTH, CONF_W)),
        'g_conf_ln': gain(ks[13], (DEPTH, CONF_W)),
        'b_conf_ln': bias(ks[14], (DEPTH, CONF_W)),
        'w_sc_dw': w(ks[15], (DEPTH, SHORT_CONV, SCONV_W), SHORT_CONV),
        'g_grp': gain(ks[16], (DEPTH, MIX_W)),
        'w_out': w(ks[17], (DEPTH, MIX_W, D_MODEL), MIX_W),
        'w_router': w(ks[18], (DEPTH, D_MODEL, N_EXPERTS), D_MODEL),
        'b_router': bias(ks[19], (DEPTH, N_EXPERTS), 0.01),
        'w_e_in': w(ks[20], (DEPTH, N_EXPERTS, D_MODEL, 2 * D_EXPERT), D_MODEL),
        'b_e_in': bias(ks[21], (DEPTH, N_EXPERTS, 2 * D_EXPERT)),
        'w_e_out': w(ks[22], (DEPTH, N_EXPERTS, D_EXPERT, D_MODEL), D_EXPERT),
        'b_e_out': bias(ks[23], (DEPTH, N_EXPERTS, D_MODEL)),
    }


def reference(x, c, ctx, c_ctx, w_ada, b_ada, g_norm_mix, g_norm_ffn, w_in, g_q, g_k,
              w_conf_dw, b_conf_dw, g_conf_ln, b_conf_ln, w_sc_dw, g_grp, w_out,
              w_router, b_router, w_e_in, b_e_in, w_e_out, b_e_out):
    b, s, d = x.shape
    n_ctx = ctx.shape[1]
    rows = s // GRID_W
    cos, sin = axial_rope_tables(rows)
    silu_c = jax.nn.silu(c)
    silu_cc = jax.nn.silu(c_ctx)
    xc = ctx
    for l in range(DEPTH):
        last = l == DEPTH - 1
        mod = silu_c @ w_ada[l] + b_ada[l]
        mod_c = silu_cc @ w_ada[l] + b_ada[l]
        sh1, sc1, gt1, sh2, sc2, gt2 = jnp.split(mod[:, None, :], N_ADA, axis=-1)
        csh1, csc1, cgt1, csh2, csc2, cgt2 = jnp.split(mod_c, N_ADA, axis=-1)

        h = modulate(x, g_norm_mix[l], sh1, sc1)
        hc = modulate(xc, g_norm_mix[l], csh1, csc1)
        q, k, v, conf_in, sc_in = split_in(h @ w_in[l])
        q = apply_axial_rope(rms_norm(heads(q, N_Q_HEADS), g_q[l]), cos, sin)
        k = apply_axial_rope(rms_norm(heads(k, N_KV_HEADS), g_k[l]), cos, sin)
        v = heads(v, N_KV_HEADS)
        if last:
            k_c, v_c = jnp.split(hc @ w_in[l][:, ATTN_W:ATTN_W + 2 * KV_W], 2, axis=-1)
        else:
            q_c, k_c, v_c, conf_c, sc_c = split_in(hc @ w_in[l])
        k_c = rms_norm(heads(k_c, N_KV_HEADS), g_k[l])
        v_c = heads(v_c, N_KV_HEADS)

        attn = latent_attention(q, k, v, k_c, v_c)
        conf, sc = conv_mixers(conf_in, sc_in, w_conf_dw[l], b_conf_dw[l], g_conf_ln[l], b_conf_ln[l], w_sc_dw[l])
        x = x + gt1 * merge_groups(attn, conf, sc, g_grp[l], w_out[l])

        if not last:
            q_c = rms_norm(heads(q_c, N_Q_HEADS), g_q[l])
            attn_c = gqa_softmax(q_c.reshape(b, n_ctx, N_KV_HEADS, GQA_GROUP, HEAD_DIM), k_c, v_c)
            attn_c = attn_c.reshape(b, n_ctx, ATTN_W)
            conf_cx, sc_cx = conv_mixers(conf_c, sc_c, w_conf_dw[l], b_conf_dw[l], g_conf_ln[l], b_conf_ln[l], w_sc_dw[l])
            xc = xc + cgt1 * merge_groups(attn_c, conf_cx, sc_cx, g_grp[l], w_out[l])

        h2 = modulate(x, g_norm_ffn[l], sh2, sc2).reshape(b * s, d)
        if last:
            f = moe_ffn(h2, w_router[l], b_router[l], w_e_in[l], b_e_in[l], w_e_out[l], b_e_out[l])
            x = x + gt2 * f.reshape(b, s, d)
        else:
            h2c = modulate(xc, g_norm_ffn[l], csh2, csc2).reshape(b * n_ctx, d)
            f = moe_ffn(jnp.concatenate([h2, h2c], axis=0), w_router[l], b_router[l],
                        w_e_in[l], b_e_in[l], w_e_out[l], b_e_out[l])
            x = x + gt2 * f[:b * s].reshape(b, s, d)
            xc = xc + cgt2 * f[b * s:].reshape(b, n_ctx, d)
    return x
```

```cpp
#include <hip/hip_runtime.h>
#include <hip/hip_bf16.h>
#include <cstdio>
#include <cstdint>
#include <cmath>
namespace pg8 {
#define PG8_LAS __attribute__((address_space(3)))
typedef unsigned short bf16_t;
typedef short bf16x8 __attribute__((ext_vector_type(8)));
typedef float f32x4 __attribute__((ext_vector_type(4)));
typedef unsigned u32x4 __attribute__((ext_vector_type(4)));
constexpr int BM = 256, BK = 64, HALF = 128, HTB = HALF * BK * 2  , STAGE_BYTES = 8 * HTB, NXCD = 8, WGM = 8;

__host__ __device__ __forceinline__ int lds_byte(int r, int c) { const int st = (r >> 4) * 2 + (c >> 5), rr = r & 15, cc = c & 31, ob = rr * 64 + cc * 2; return st * 1024 + (ob ^ (((ob >> 9) & 1) << 5)); }
__host__ __device__ __forceinline__ void stage_rc(int b, int& R, int& C) { const int st = b / 1024, sb = b % 1024, swz = sb ^ (((sb >> 9) & 1) << 5); R = (st >> 1) * 16 + swz / 64; C = (st & 1) * 32 + (swz % 64) / 2; }
__host__ __device__ __forceinline__ int perm32(int rho) { const int n = rho >> 4, i = rho & 15; return 8 * (i >> 2) + 4 * n + (i & 3); }

struct Unit { int pm, pn; };
struct Gemm { const bf16_t* A; const bf16_t* Bt; int M, N, K; };

struct StaticOrder {
    int nM, nN, nwg, G, c;
    __host__ __device__ void init(int M, int N, int G_, int c_) { nM = M / BM; nN = N / BM; nwg = nM * nN; G = G_; c = c_; }
    __host__ __device__ bool next(int i, Unit& u) const {
        const long L = (long)i * G + c; if (L >= nwg) return false;
        int wgid = (int)L; { const int q = nwg / NXCD, r = nwg % NXCD, xcd = wgid % NXCD, off = wgid / NXCD; wgid = (xcd < r ? xcd * (q + 1) : r * (q + 1) + (xcd - r) * q) + off; }
        const int nig = WGM * nN, gid = wgid / nig, fm = gid * WGM, gsz = (nM - fm) < WGM ? (nM - fm) : WGM;
        u.pm = fm + ((wgid % nig) % gsz); u.pn = (wgid % nig) / gsz; return true;
    }
    __device__ __forceinline__ void a_ready(const Unit&) const {}
    __device__ __forceinline__ void done(const Unit&) const {}
};

__device__ __forceinline__ unsigned cvt_pk_bf16(float lo, float hi) { unsigned r; asm volatile("v_cvt_pk_bf16_f32 %0, %1, %2" : "=v"(r) : "v"(lo), "v"(hi)); return r; }
typedef float f32x2 __attribute__((ext_vector_type(2)));

struct MoeOrder {
    int nN, ntl, nwg, G, c; const PG8_LAS unsigned char* t2e;
    __device__ __forceinline__ void init(int ntl_, int nN_, int G_, int c_, const PG8_LAS unsigned char* t2e_) { ntl = ntl_; nN = nN_; nwg = ntl_ * nN_; G = G_; c = c_; t2e = t2e_; }
    __device__ __forceinline__ bool next(int i, Unit& u) const {
        const long L = (long)i * G + c; if (L >= nwg) return false;
        int wgid = (int)L; { const int q = nwg / NXCD, r = nwg % NXCD, xcd = wgid % NXCD, off = wgid / NXCD; wgid = (xcd < r ? xcd * (q + 1) : r * (q + 1) + (xcd - r) * q) + off; }
        const int nig = WGM * nN, gid = wgid / nig, fm = gid * WGM, gsz = (ntl - fm) < WGM ? (ntl - fm) : WGM;
        const int rt = fm + ((wgid % nig) % gsz), pn = (wgid % nig) / gsz;
        u.pm = rt; u.pn = (int)t2e[rt] * nN + pn; return true;
    }
    __device__ __forceinline__ void a_ready(const Unit&) const {}
    __device__ __forceinline__ void done(const Unit&) const {}
};

struct EpiStore {
    static constexpr bool PERM = true, AFTER_DRAIN = false;
    bf16_t* O; int ldc;
    __device__ __forceinline__ void operator()(const f32x4 (&acc)[2][2][4][2], const Unit& u, int wr, int wc, int fr, int fq) const {
        const int row0 = u.pm * BM + wr * 64 + fr, col0 = u.pn * BM + wc * 32 + 8 * fq;
#pragma unroll
        for (int ai = 0; ai < 2; ++ai)
#pragma unroll
            for (int m = 0; m < 4; ++m) { bf16_t* rowp = O + (size_t)(row0 + ai * HALF + m * 16) * ldc + col0;
#pragma unroll
                for (int bj = 0; bj < 2; ++bj) { const f32x4 v0 = acc[ai][bj][m][0], v1 = acc[ai][bj][m][1];
                    u32x4 w; w.x = cvt_pk_bf16(v0[0], v0[1]); w.y = cvt_pk_bf16(v0[2], v0[3]); w.z = cvt_pk_bf16(v1[0], v1[1]); w.w = cvt_pk_bf16(v1[2], v1[3]);
                    *(u32x4*)(rowp + bj * HALF) = w; } }
    }
};
struct EpiResid {
    static constexpr bool PERM = false, AFTER_DRAIN = false;
    float* X; const float* gate;
    __device__ __forceinline__ void operator()(const f32x4 (&acc)[2][2][4][2], const Unit& u, int wr, int wc, int fr, int fq) const {
        const int seg = u.pm / 17, rem = u.pm - seg * 17; const int j = (rem == 16) ? 16 : seg;
        const int row0 = u.pm * BM + wr * 64 + fr, col0 = u.pn * BM + wc * 32 + 4 * fq;
        const float* g = gate + (size_t)j * 6144 + col0;
        f32x4 gv[2][2];
#pragma unroll
        for (int bj = 0; bj < 2; ++bj)
#pragma unroll
            for (int n = 0; n < 2; ++n) gv[bj][n] = *(const f32x4*)(g + bj * HALF + n * 16);
#pragma unroll
        for (int ai = 0; ai < 2; ++ai)
#pragma unroll
            for (int m = 0; m < 4; ++m) { float* rowp = X + (size_t)(row0 + ai * HALF + m * 16) * 1024 + col0;
#pragma unroll
                for (int bj = 0; bj < 2; ++bj)
#pragma unroll
                    for (int n = 0; n < 2; ++n) { f32x4* p = (f32x4*)(rowp + bj * HALF + n * 16); *p = *p + gv[bj][n] * acc[ai][bj][m][n]; } }
    }
};
struct EpiLogits {
    static constexpr bool PERM = false, AFTER_DRAIN = false;
    float* LOG;
    __device__ __forceinline__ void operator()(const f32x4 (&acc)[2][2][4][2], const Unit& u, int wr, int wc, int fr, int fq) const {
        if (wc != 0) return;
        const int row0 = u.pm * BM + wr * 64 + fr;
#pragma unroll
        for (int ai = 0; ai < 2; ++ai)
#pragma unroll
            for (int m = 0; m < 4; ++m) { float* rowp = LOG + (size_t)(row0 + ai * HALF + m * 16) * 32 + 4 * fq;
#pragma unroll
                for (int n = 0; n < 2; ++n) *(f32x4*)(rowp + n * 16) = acc[ai][0][m][n]; }
    }
};
struct EpiSwiglu {
    static constexpr bool PERM = true, AFTER_DRAIN = false;
    bf16_t* ACT; const float* b1p;
    __device__ __forceinline__ void operator()(const f32x4 (&acc)[2][2][4][2], const Unit& u, int wr, int wc, int fr, int fq) const {
        const int e = u.pn >> 3, pn = u.pn & 7;
        const int row0 = u.pm * BM + wr * 64 + fr, lc = wc * 32 + 8 * fq;
        const float* bp = b1p + (size_t)e * 2048 + pn * 256 + lc;
        f32x4 bg[2], bu[2];
#pragma unroll
        for (int n = 0; n < 2; ++n) { bg[n] = *(const f32x4*)(bp + 4 * n); bu[n] = *(const f32x4*)(bp + HALF + 4 * n); }
#pragma unroll
        for (int ai = 0; ai < 2; ++ai)
#pragma unroll
            for (int m = 0; m < 4; ++m) { bf16_t* rowp = ACT + (size_t)(row0 + ai * HALF + m * 16) * 1024 + pn * 128 + lc;
                f32x4 a[2];
#pragma unroll
                for (int n = 0; n < 2; ++n) { const f32x4 gt = acc[ai][0][m][n] + bg[n], up = acc[ai][1][m][n] + bu[n];
#pragma unroll
                    for (int i = 0; i < 4; ++i) { const float gc = fminf(gt[i], 7.0f), uc = fminf(fmaxf(up[i], -7.0f), 7.0f);
                        const float sg = __builtin_amdgcn_rcpf(1.0f + __builtin_amdgcn_exp2f(gc * (-1.702f * 1.4426950408889634f)));
                        a[n][i] = (uc + 1.0f) * (gc * sg); } }
                u32x4 w; w.x = cvt_pk_bf16(a[0][0], a[0][1]); w.y = cvt_pk_bf16(a[0][2], a[0][3]); w.z = cvt_pk_bf16(a[1][0], a[1][1]); w.w = cvt_pk_bf16(a[1][2], a[1][3]);
                *(u32x4*)rowp = w; }
    }
};
struct EpiDown {
    static constexpr bool PERM = true, AFTER_DRAIN = false;
    bf16_t* YP; const float* b2;
    __device__ __forceinline__ void operator()(const f32x4 (&acc)[2][2][4][2], const Unit& u, int wr, int wc, int fr, int fq) const {
        const int e = u.pn >> 2, pn = u.pn & 3;
        const int row0 = u.pm * BM + wr * 64 + fr, col0 = pn * BM + wc * 32 + 8 * fq;
        const float* bp = b2 + (size_t)e * 1024 + col0;
        f32x4 bv[2][2];
#pragma unroll
        for (int bj = 0; bj < 2; ++bj)
#pragma unroll
            for (int n = 0; n < 2; ++n) bv[bj][n] = *(const f32x4*)(bp + bj * HALF + 4 * n);
#pragma unroll
        for (int ai = 0; ai < 2; ++ai)
#pragma unroll
            for (int m = 0; m < 4; ++m) { bf16_t* rowp = YP + (size_t)(row0 + ai * HALF + m * 16) * 1024 + col0;
#pragma unroll
                for (int bj = 0; bj < 2; ++bj) { const f32x4 v0 = acc[ai][bj][m][0] + bv[bj][0], v1 = acc[ai][bj][m][1] + bv[bj][1];
                    u32x4 w; w.x = cvt_pk_bf16(v0[0], v0[1]); w.y = cvt_pk_bf16(v0[2], v0[3]); w.z = cvt_pk_bf16(v1[0], v1[1]); w.w = cvt_pk_bf16(v1[2], v1[3]);
                    *(u32x4*)(rowp + bj * HALF) = w; } }
    }
};

template <class Epi, class Sched, bool ALIGN_EPI = false, bool SP2 = false>
__device__ __forceinline__ void gemm_phase(PG8_LAS unsigned char* lds, const Gemm g, const Sched& S, const Epi& E) {
    int tid_ = threadIdx.x; asm volatile("" : "+v"(tid_));
    const int tid = tid_, wid = __builtin_amdgcn_readfirstlane(tid >> 6), lane = tid & 63, wr = wid >> 2, wc = wid & 3, fr = lane & 15, fq = lane >> 4;
    const int K = g.K, nt = K / BK;
    unsigned voffA[2], voffB[2];
#pragma unroll
    for (int i = 0; i < 2; ++i) { int R, C; stage_rc(tid * 16 + i * 8192, R, C); const int Rb = Epi::PERM ? ((R & ~31) + perm32(R & 31)) : R;
        voffA[i] = (unsigned)(R * K + C) * 2u; voffB[i] = (unsigned)(Rb * K + C) * 2u; }
    const size_t kstep = (size_t)(BK * 2);
    const size_t hstep = (size_t)HALF * K * 2;
    const size_t tstep = 2 * hstep;
    const unsigned ldsw = (unsigned)wid * 1024u;
    const int aoff = lds_byte(wr * 64 + fr, fq * 8), boff = lds_byte(wc * 32 + fr, fq * 8);
#define PG8_SA(b, h) (((b) * 2 + (h)) * HTB)
#define PG8_SB(b, h) ((4 + (b) * 2 + (h)) * HTB)
#define PG8_STAGE(bufoff, gbase, voff) do { _Pragma("unroll") for (int _i = 0; _i < 2; ++_i) \
        __builtin_amdgcn_global_load_lds((const unsigned*)((const char*)(gbase) + (voff)[_i]), (PG8_LAS unsigned*)(lds + (bufoff) + ldsw + _i * 8192), 16, 0, 0); } while (0)
#define PG8_LDA(dst, b, h) do { _Pragma("unroll") for (int m = 0; m < 4; ++m) _Pragma("unroll") for (int k = 0; k < 2; ++k) dst[m][k] = *(const PG8_LAS bf16x8*)(lds + PG8_SA(b, h) + aoff + m * 2048 + k * 1024); } while (0)
#define PG8_LDB(dst, b, h) do { _Pragma("unroll") for (int n = 0; n < 2; ++n) _Pragma("unroll") for (int k = 0; k < 2; ++k) dst[n][k] = *(const PG8_LAS bf16x8*)(lds + PG8_SB(b, h) + boff + n * 2048 + k * 1024); } while (0)
#define PG8_MMA(ai, bj, At, Bt) do { __builtin_amdgcn_s_setprio(1); _Pragma("unroll") for (int m = 0; m < 4; ++m) _Pragma("unroll") for (int n = 0; n < 2; ++n) _Pragma("unroll") for (int k = 0; k < 2; ++k) \
        acc[ai][bj][m][n] = __builtin_amdgcn_mfma_f32_16x16x32_bf16(Bt[n][k], At[m][k], acc[ai][bj][m][n], 0, 0, 0); __builtin_amdgcn_s_setprio(0); } while (0)
#define PG8_WAIT_V(n) asm volatile("s_waitcnt vmcnt(" #n ")" ::: "memory")
#define PG8_WAIT_L(n) asm volatile("s_waitcnt lgkmcnt(" #n ")" ::: "memory")
#define PG8_BAR __builtin_amdgcn_s_barrier()
#define PG8_SCHED __builtin_amdgcn_sched_barrier(0)
    Unit cur, nxt; int ui = 0;
    if (!S.next(0, cur)) return;
    f32x4 acc[2][2][4][2];
#pragma unroll
    for (int a = 0; a < 2; ++a)
#pragma unroll
        for (int b = 0; b < 2; ++b)
#pragma unroll
            for (int m = 0; m < 4; ++m)
#pragma unroll
                for (int n = 0; n < 2; ++n) acc[a][b][m][n] = (f32x4){0.f, 0.f, 0.f, 0.f};
    bf16x8 At[4][2], B0[2][2], B1[2][2];
    const char* cA = (const char*)g.A + (size_t)cur.pm * tstep; const char* cB = (const char*)g.Bt + (size_t)cur.pn * tstep;
    S.a_ready(cur);
    if constexpr (SP2) {
        PG8_STAGE(PG8_SB(0, 0), cB, voffB); PG8_STAGE(PG8_SB(0, 1), cB + hstep, voffB); PG8_STAGE(PG8_SA(0, 0), cA, voffA); PG8_STAGE(PG8_SA(0, 1), cA + hstep, voffA);
        if (wr == 1) PG8_BAR;
        PG8_WAIT_V(2); PG8_BAR;
        PG8_STAGE(PG8_SB(1, 0), cB + kstep, voffB); PG8_STAGE(PG8_SA(1, 0), cA + kstep, voffA); PG8_STAGE(PG8_SB(1, 1), cB + hstep + kstep, voffB);
        PG8_WAIT_V(6); PG8_BAR;
    } else {
        PG8_STAGE(PG8_SB(0, 0), cB, voffB); PG8_STAGE(PG8_SA(0, 0), cA, voffA); PG8_STAGE(PG8_SB(0, 1), cB + hstep, voffB); PG8_STAGE(PG8_SA(0, 1), cA + hstep, voffA);
        if (wr == 1) PG8_BAR;
        PG8_WAIT_V(4); PG8_BAR;
        PG8_STAGE(PG8_SB(1, 0), cB + kstep, voffB); PG8_STAGE(PG8_SA(1, 0), cA + kstep, voffA); PG8_STAGE(PG8_SB(1, 1), cB + hstep + kstep, voffB);
        PG8_WAIT_V(6); PG8_BAR;
    }
    for (;;) {
        const bool has_next = S.next(ui + 1, nxt);
        const char* nA = has_next ? (const char*)g.A + (size_t)nxt.pm * tstep : cA; const char* nB = has_next ? (const char*)g.Bt + (size_t)nxt.pn * tstep : cB;
        for (int t = 0; t < nt; t += 2) {
            const bool last = (t == nt - 2);
            const char* a1 = cA + (size_t)(t + 1) * kstep;
            const char* a2 = last ? nA : cA + (size_t)(t + 2) * kstep; const char* b2 = last ? nB : cB + (size_t)(t + 2) * kstep;
            const char* a3 = a2 + kstep; const char* b3 = b2 + kstep;
            if (last && has_next) S.a_ready(nxt);
            if constexpr (SP2) {
            PG8_LDB(B0, 0, 0); PG8_LDB(B1, 0, 1); PG8_SCHED; PG8_LDA(At, 0, 0); PG8_STAGE(PG8_SA(1, 1), a1 + hstep, voffA);
            PG8_WAIT_V(8); PG8_WAIT_L(0); PG8_BAR; PG8_MMA(0, 0, At, B0); PG8_MMA(0, 1, At, B1); PG8_BAR; PG8_SCHED;
            PG8_LDA(At, 0, 1); PG8_STAGE(PG8_SB(0, 0), b2, voffB); PG8_STAGE(PG8_SB(0, 1), b2 + hstep, voffB); PG8_STAGE(PG8_SA(0, 0), a2, voffA);
            PG8_WAIT_V(8); PG8_WAIT_L(0); PG8_BAR; PG8_MMA(1, 0, At, B0); PG8_MMA(1, 1, At, B1); PG8_BAR; PG8_SCHED;
            PG8_LDB(B0, 1, 0); PG8_LDB(B1, 1, 1); PG8_SCHED; PG8_LDA(At, 1, 0); PG8_STAGE(PG8_SA(0, 1), a2 + hstep, voffA);
            PG8_WAIT_V(8); PG8_WAIT_L(0); PG8_BAR; PG8_MMA(0, 0, At, B0); PG8_MMA(0, 1, At, B1); PG8_BAR; PG8_SCHED;
            PG8_LDA(At, 1, 1); PG8_STAGE(PG8_SB(1, 0), b3, voffB); PG8_STAGE(PG8_SB(1, 1), b3 + hstep, voffB); PG8_STAGE(PG8_SA(1, 0), a3, voffA);
            PG8_WAIT_V(8); PG8_WAIT_L(0); PG8_BAR; PG8_MMA(1, 0, At, B0); PG8_MMA(1, 1, At, B1); PG8_BAR; PG8_SCHED;
            } else {
            PG8_LDB(B0, 0, 0); PG8_SCHED; PG8_LDA(At, 0, 0); PG8_STAGE(PG8_SA(1, 1), a1 + hstep, voffA);
            PG8_WAIT_L(8); PG8_BAR; PG8_WAIT_L(0); PG8_MMA(0, 0, At, B0); PG8_BAR; PG8_SCHED;
            PG8_LDB(B1, 0, 1); PG8_STAGE(PG8_SB(0, 0), b2, voffB);
            PG8_BAR; PG8_WAIT_L(0); PG8_MMA(0, 1, At, B1); PG8_BAR;
            PG8_LDA(At, 0, 1); PG8_STAGE(PG8_SA(0, 0), a2, voffA);
            PG8_BAR; PG8_WAIT_L(0); PG8_MMA(1, 0, At, B0); PG8_BAR; PG8_SCHED;
            PG8_STAGE(PG8_SB(0, 1), b2 + hstep, voffB);
            PG8_WAIT_V(6); PG8_BAR; PG8_MMA(1, 1, At, B1); PG8_BAR;
            PG8_LDB(B0, 1, 0); PG8_SCHED; PG8_LDA(At, 1, 0); PG8_STAGE(PG8_SA(0, 1), a2 + hstep, voffA);
            PG8_WAIT_L(8); PG8_BAR; PG8_WAIT_L(0); PG8_MMA(0, 0, At, B0); PG8_BAR; PG8_SCHED;
            PG8_LDB(B1, 1, 1); PG8_STAGE(PG8_SB(1, 0), b3, voffB);
            PG8_BAR; PG8_WAIT_L(0); PG8_MMA(0, 1, At, B1); PG8_BAR;
            PG8_LDA(At, 1, 1); PG8_STAGE(PG8_SA(1, 0), a3, voffA);
            PG8_BAR; PG8_WAIT_L(0); PG8_MMA(1, 0, At, B0); PG8_BAR; PG8_SCHED;
            PG8_STAGE(PG8_SB(1, 1), b3 + hstep, voffB);
            PG8_WAIT_V(6); PG8_BAR; PG8_MMA(1, 1, At, B1); PG8_BAR;
            }
        }
        if constexpr (ALIGN_EPI) { if (wr == 0) PG8_BAR; }
        if constexpr (!Epi::AFTER_DRAIN) { E(acc, cur, wr, wc, fr, fq); S.done(cur); }
        if (!has_next) break;
#pragma unroll
        for (int a = 0; a < 2; ++a)
#pragma unroll
            for (int b = 0; b < 2; ++b)
#pragma unroll
                for (int m = 0; m < 4; ++m)
#pragma unroll
                    for (int n = 0; n < 2; ++n) acc[a][b][m][n] = (f32x4){0.f, 0.f, 0.f, 0.f};
        cur = nxt; cA = nA; cB = nB; ++ui;
        if constexpr (ALIGN_EPI) { if (wr == 1) PG8_BAR; }
    }
    PG8_WAIT_V(0);
    if constexpr (!ALIGN_EPI) { if (wr == 0) PG8_BAR; }
    PG8_BAR;
    if constexpr (Epi::AFTER_DRAIN) { E.fused(acc, cur, wr, wc, fr, fq, lds, wid, lane); S.done(cur); }
#undef PG8_SA
#undef PG8_SB
#undef PG8_STAGE
#undef PG8_LDA
#undef PG8_LDB
#undef PG8_MMA
#undef PG8_WAIT_V
#undef PG8_WAIT_L
#undef PG8_BAR
#undef PG8_SCHED
}
}
#ifndef ATTN_STORE16
#define ATTN_STORE16(p,v) (*(u32x4*)(p)=(v))
#endif
namespace attn_body {
using bf16=__hip_bfloat16;
using bf16x8=__attribute__((ext_vector_type(8)))short;
using s16x4=__attribute__((ext_vector_type(4)))short;
using f32x16=__attribute__((ext_vector_type(16)))float;
using u32x4=__attribute__((ext_vector_type(4)))unsigned;
constexpr int D=64,PQ=2048,PO=1024,KOFF=512,VOFF=640;
constexpr int NW=8,QBLK=32,QB=QBLK*NW,KVBLK=64;
__device__ __forceinline__ int crow(int r,int hi){return (r&3)+8*(r>>2)+4*hi;}
#define SBAR() __builtin_amdgcn_sched_barrier(0)
constexpr int NSLOT=3, SLOTB=8192;
constexpr int LDS_K=0, LDS_V=NSLOT*SLOTB, LDS_WS=2*NSLOT*SLOTB, LDS_OST=LDS_WS+NW*64*4, LDS_BYTES=LDS_OST+NW*4096;
constexpr float C2=0.125f*1.4426950408889634f;
__device__ __forceinline__ void glds16(const void*gsrc,unsigned lds_dst){unsigned keep;
  asm volatile("s_mov_b32 %0, m0\n\ts_mov_b32 m0, %2\n\ts_nop 0\n\tglobal_load_lds_dwordx4 %1, off\n\ts_mov_b32 m0, %0":"=&s"(keep):"v"(gsrc),"s"(lds_dst):"memory");}
__device__ __forceinline__ float max3f(float a,float b,float c){float r;asm("v_max3_f32 %0, %1, %2, %3":"=v"(r):"v"(a),"v"(b),"v"(c));return r;}
__device__ __forceinline__ float max2f(float a,float b){float r;asm("v_max_f32_e32 %0, %1, %2":"=v"(r):"v"(a),"v"(b));return r;}
__device__ __forceinline__ float fadd_s(float a,float b){float r;asm("v_add_f32_e32 %0, %1, %2":"=v"(r):"v"(a),"v"(b));return r;}
__device__ __forceinline__ float fsub_s(float a,float b){float r;asm("v_sub_f32_e32 %0, %1, %2":"=v"(r):"v"(a),"v"(b));return r;}
typedef float f32x2_t __attribute__((ext_vector_type(2))); typedef __bf16 bf16x2_t __attribute__((ext_vector_type(2)));
__device__ __forceinline__ unsigned cvtpk_s(float lo,float hi){f32x2_t v={lo,hi};bf16x2_t b=__builtin_convertvector(v,bf16x2_t);return __builtin_bit_cast(unsigned,b);}
#define WAIT_BAR(N) asm volatile("s_waitcnt vmcnt(" #N ") lgkmcnt(0)\n\ts_barrier":::"memory")

__device__ __forceinline__ void qkt(f32x16&p0,f32x16&p1,const char*Kslot,const bf16x8*qr,const f32x16&negm,int r32,int hi){
  const char*kb=Kslot+hi*1024+r32*16;
  #pragma unroll
  for(int d0=0;d0<4;++d0){
    const bf16x8 b0=*reinterpret_cast<const bf16x8*>(kb+d0*2048);
    const bf16x8 b1=*reinterpret_cast<const bf16x8*>(kb+d0*2048+512);
    if(d0==0){p0=__builtin_amdgcn_mfma_f32_32x32x16_bf16(b0,qr[0],negm,0,0,0);p1=__builtin_amdgcn_mfma_f32_32x32x16_bf16(b1,qr[0],negm,0,0,0);}
    else{p0=__builtin_amdgcn_mfma_f32_32x32x16_bf16(b0,qr[d0],p0,0,0,0);p1=__builtin_amdgcn_mfma_f32_32x32x16_bf16(b1,qr[d0],p1,0,0,0);}}
}
typedef __attribute__((address_space(3))) const char* lds_cptr;
typedef short v4i16_t __attribute__((ext_vector_type(4)));
__device__ __forceinline__ void kload8(bf16x8*kf,lds_cptr kp){
  kf[0]=*(const __attribute__((address_space(3))) bf16x8*)(kp);      kf[1]=*(const __attribute__((address_space(3))) bf16x8*)(kp+512);
  kf[2]=*(const __attribute__((address_space(3))) bf16x8*)(kp+2048); kf[3]=*(const __attribute__((address_space(3))) bf16x8*)(kp+2560);
  kf[4]=*(const __attribute__((address_space(3))) bf16x8*)(kp+4096); kf[5]=*(const __attribute__((address_space(3))) bf16x8*)(kp+4608);
  kf[6]=*(const __attribute__((address_space(3))) bf16x8*)(kp+6144); kf[7]=*(const __attribute__((address_space(3))) bf16x8*)(kp+6656);
}
__device__ __forceinline__ void kload2(bf16x8*kf,lds_cptr kp,int j){ kf[2*j]=*(const __attribute__((address_space(3))) bf16x8*)(kp+j*2048); kf[2*j+1]=*(const __attribute__((address_space(3))) bf16x8*)(kp+j*2048+512); }
__device__ __forceinline__ s16x4 vtr(lds_cptr p){ return __builtin_bit_cast(s16x4,__builtin_amdgcn_ds_read_tr16_b64_v4i16((__attribute__((address_space(3))) v4i16_t*)p)); }
__device__ __forceinline__ float rowmax(const f32x16&p0,const f32x16&p1){
  float a=max3f(p0[0],p0[1],p1[0]),b=max3f(p0[2],p0[3],p1[1]);a=max3f(a,p1[2],p1[3]);
  #pragma unroll
  for(int r=4;r<16;r+=4){a=max3f(a,p0[r],p0[r+1]);b=max3f(b,p0[r+2],p0[r+3]);a=max3f(a,p1[r],p1[r+1]);b=max3f(b,p1[r+2],p1[r+3]);}
  const float m=max2f(a,b);
  auto rr=__builtin_amdgcn_permlane32_swap(__float_as_uint(m),__float_as_uint(m),false,false);
  return max2f(__uint_as_float(rr[0]),__uint_as_float(rr[1]));
}
__device__ __forceinline__ void pv(f32x16*o,int vb,bf16x8 pa0,bf16x8 pa1,bf16x8 pa2,bf16x8 pa3){
  #pragma unroll
  for(int d0=0;d0<2;++d0){s16x4 lo[4],hi[4];
    #pragma unroll
    for(int ks=0;ks<4;++ks){
      asm volatile("ds_read_b64_tr_b16 %0,%1 offset:%c2":"=&v"(lo[ks]):"v"(vb),"i"(d0*4096+ks*1024):"memory");
      asm volatile("ds_read_b64_tr_b16 %0,%1 offset:%c2":"=&v"(hi[ks]):"v"(vb),"i"(d0*4096+ks*1024+512):"memory");}
    asm volatile("s_waitcnt lgkmcnt(0)":::"memory");SBAR();
    #define PK(k) (bf16x8){lo[k][0],lo[k][1],lo[k][2],lo[k][3],hi[k][0],hi[k][1],hi[k][2],hi[k][3]}
    o[d0]=__builtin_amdgcn_mfma_f32_32x32x16_bf16(pa0,PK(0),o[d0],0,0,0);
    o[d0]=__builtin_amdgcn_mfma_f32_32x32x16_bf16(pa1,PK(1),o[d0],0,0,0);
    o[d0]=__builtin_amdgcn_mfma_f32_32x32x16_bf16(pa2,PK(2),o[d0],0,0,0);
    o[d0]=__builtin_amdgcn_mfma_f32_32x32x16_bf16(pa3,PK(3),o[d0],0,0,0);
    #undef PK
  }
}

template<int THRL> __device__ __forceinline__ void attn_unit(long qrow0,long krow0,int NTarg,int h,const bf16*Pq,bf16*Yo,char*shm){
  int tid_=threadIdx.x; asm volatile("":"+v"(tid_)); const int tid=tid_,lane=tid&63,r32=lane&31,hi=lane>>5; const int wid=__builtin_amdgcn_readfirstlane(tid>>6);
  const bf16*Qw=Pq+(qrow0+wid*QBLK)*PQ+h*D;
  const bf16*Kh=Pq+krow0*PQ+KOFF+(h>>2)*D,*Vh=Pq+krow0*PQ+VOFF+(h>>2)*D;
  const unsigned lds0=(unsigned)(uintptr_t)shm;
  float*wsf=(float*)(shm+LDS_WS)+wid*64;
  const bf16*ksrc=Kh+(long)lane*PQ+wid*8;
  const bf16*vsrc=Vh+(long)(16*(wid&3)+(lane>>2))*PQ+(wid>>2)*32+(lane&3)*8;
  const unsigned kdst=lds0+LDS_K+wid*1024, vdst=lds0+LDS_V+wid*1024;
  #define DMA_K(t,slot) glds16(ksrc+(long)(t)*KVBLK*PQ,(unsigned)__builtin_amdgcn_readfirstlane(kdst+(slot)))
  #define DMA_V(t,slot) glds16(vsrc+(long)(t)*KVBLK*PQ,(unsigned)__builtin_amdgcn_readfirstlane(vdst+(slot)))
  const int vb0=(int)(lds0+LDS_V)+((lane>>4)&1)*32+(lane&3)*8+(4*hi+((lane&15)>>2))*64;
  const char*Kbase=shm+LDS_K; bf16x8 kf[8];
  const lds_cptr shm3=(lds_cptr)shm; const lds_cptr kp0=shm3+LDS_K+hi*1024+r32*16; const lds_cptr vp0=shm3+LDS_V+((lane>>4)&1)*32+(lane&3)*8+(4*hi+((lane&15)>>2))*64;
  const int NT=NTarg;
  DMA_K(0,0);DMA_V(0,0);DMA_K(1,SLOTB);
  bf16x8 qr[4];
  #pragma unroll
  for(int d0=0;d0<4;++d0)qr[d0]=*reinterpret_cast<const bf16x8*>(&Qw[(long)r32*PQ+d0*16+hi*8]);
  float mhat=0.f,l_reg=0.f;f32x16 o[2];o[0]=f32x16{};o[1]=f32x16{};f32x16 negm=f32x16{};asm volatile("":"+v"(negm));

  #define CMASK(P0,P1,t) do{}while(0)
  bool resc=false;
  #define START(P0,P1) do{ const float rm=rowmax(P0,P1); resc=false; \
    { const float dl=rm; mhat=fadd_s(mhat,dl); \
      _Pragma("unroll") for(int r=0;r<16;++r){P0[r]=fsub_s(P0[r],dl);P1[r]=fsub_s(P1[r],dl);} \
      _Pragma("unroll") for(int r=0;r<16;++r)negm[r]=-mhat; asm volatile("":"+v"(negm)); } \
    _Pragma("unroll") for(int r=0;r<16;++r)P0[r]=__builtin_amdgcn_exp2f(P0[r]); }while(0)
  #define RESC() do{ if(resc){ asm volatile("s_waitcnt lgkmcnt(0)":::"memory"); \
      _Pragma("unroll") for(int d_=0;d_<2;++d_) _Pragma("unroll") for(int r=0;r<16;++r)o[d_][r]*=wsf[crow(r,hi)]; } }while(0)
  f32x16 pA0,pA1,pB0,pB1;
  int sl_prev=0,sl_cur=0,sl_next=SLOTB;
  #define ROT() do{sl_prev=sl_cur;sl_cur=sl_next;sl_next=(sl_next==(NSLOT-1)*SLOTB)?0:sl_next+SLOTB;}while(0)
  DMA_K(2,2*SLOTB);
  WAIT_BAR(3);
  qkt(pA0,pA1,Kbase,qr,negm,r32,hi);asm volatile("s_nop 15\n\ts_nop 7":"+v"(pA0),"+v"(pA1));CMASK(pA0,pA1,0);
  START(pA0,pA1);
  _Pragma("unroll") for(int r=0;r<16;++r)pA1[r]=__builtin_amdgcn_exp2f(pA1[r]);
  WAIT_BAR(0);
  DMA_K(3,0);DMA_V(1,SLOTB);
  ROT();
  kload8(kf,kp0+sl_cur);
  WAIT_BAR(2);
  s16x4 vlo[8],vhi[8]; u32x4 pw0,pw1,pw2,pw3;
  #define PKW(P,B) cvtpk_s(P[B],P[B+1])
  #define PAF(k) __builtin_bit_cast(bf16x8,pw##k)
  #define VFR(i) (bf16x8){vlo[i][0],vlo[i][1],vlo[i][2],vlo[i][3],vhi[i][0],vhi[i][1],vhi[i][2],vhi[i][3]}
  #define PIN(x) asm volatile("":"+v"(x))
  #define MX3(a,b,c) __builtin_fmaxf(__builtin_fmaxf((a),(b)),(c))
  #define GAPA(MF,A0,A1,A2,A3,W0,W1,PW) do{ MF; sacc+=A0; sacc+=A1; sacc+=A2; sacc+=A3; PIN(sacc); W0; W1; PIN(PW); SBAR(); }while(0)
  #define EX(v) __builtin_amdgcn_exp2f(v)
  #define GAPB(MF,X,B) do{ MF; X[B]=EX(X[B]); X[B+1]=EX(X[B+1]); X[B+2]=EX(X[B+2]); X[B+3]=EX(X[B+3]); PIN(X); SBAR(); }while(0)
  #define VRD(i) do{ vlo[i]=vtr(vp_+(((i)>>2)*4096+((i)&3)*1024)); vhi[i]=vtr(vp_+(((i)>>2)*4096+((i)&3)*1024+512)); }while(0)
  #define KRD(G,j) do{ if(G){ kload2(kf,kp0+sl_next,j); SBAR(); } }while(0)
  #define STEP(C0,C1,P0,P1,t,GK,GV,GL) do{ SBAR(); \
    const lds_cptr vp_=vp0+sl_prev; \
    VRD(0); SBAR(); float sacc=(P0[0]+P0[1]); \
    GAPA(C0=__builtin_amdgcn_mfma_f32_32x32x16_bf16(kf[0],qr[0],negm,0,0,0), P0[2],P0[3],P0[4],P0[5],     pw0[0]=PKW(P0,0), pw0[1]=PKW(P0,2), pw0); \
    VRD(4); SBAR(); GAPA(C1=__builtin_amdgcn_mfma_f32_32x32x16_bf16(kf[1],qr[0],negm,0,0,0), P0[6],P0[7],P0[8],P0[9],     pw0[2]=PKW(P0,4), pw0[3]=PKW(P0,6), pw0); \
    VRD(1); SBAR(); GAPA(C0=__builtin_amdgcn_mfma_f32_32x32x16_bf16(kf[2],qr[1],C0,0,0,0),   P0[10],P0[11],P0[12],P0[13], pw1[0]=PKW(P0,8), pw1[1]=PKW(P0,10), pw1); \
    VRD(5); SBAR(); GAPA(C1=__builtin_amdgcn_mfma_f32_32x32x16_bf16(kf[3],qr[1],C1,0,0,0),   P0[14],P0[15],P1[0],P1[1],   pw1[2]=PKW(P0,12),pw1[3]=PKW(P0,14), pw1); \
    VRD(2); SBAR(); GAPA(C0=__builtin_amdgcn_mfma_f32_32x32x16_bf16(kf[4],qr[2],C0,0,0,0),   P1[2],P1[3],P1[4],P1[5],     pw2[0]=PKW(P1,0), pw2[1]=PKW(P1,2), pw2); \
    VRD(6); SBAR(); GAPA(C1=__builtin_amdgcn_mfma_f32_32x32x16_bf16(kf[5],qr[2],C1,0,0,0),   P1[6],P1[7],P1[8],P1[9],     pw2[2]=PKW(P1,4), pw2[3]=PKW(P1,6), pw2); \
    VRD(3); SBAR(); GAPA(C0=__builtin_amdgcn_mfma_f32_32x32x16_bf16(kf[6],qr[3],C0,0,0,0),   P1[10],P1[11],P1[12],P1[13], pw3[0]=PKW(P1,8), pw3[1]=PKW(P1,10), pw3); \
    VRD(7); SBAR(); GAPA(C1=__builtin_amdgcn_mfma_f32_32x32x16_bf16(kf[7],qr[3],C1,0,0,0),   P1[14],P1[15],0.f,0.f,       pw3[2]=PKW(P1,12),pw3[3]=PKW(P1,14), pw3); \
    l_reg+=sacc; \
    if(GK){DMA_K((t)+3,sl_cur);} if(GV){DMA_V((t)+1,sl_next);} \
    CMASK(C0,C1,t); \
    { float a=MX3(C0[0],C0[1],C1[0]),b=MX3(C0[2],C0[3],C1[1]); a=MX3(a,C1[2],C1[3]); \
      _Pragma("unroll") for(int r=4;r<16;r+=4){a=MX3(a,C0[r],C0[r+1]);b=MX3(b,C0[r+2],C0[r+3]);a=MX3(a,C1[r],C1[r+1]);b=MX3(b,C1[r+2],C1[r+3]);} \
      float rm=__builtin_fmaxf(a,b); { auto rr=__builtin_amdgcn_permlane32_swap(__float_as_uint(rm),__float_as_uint(rm),false,false); rm=__builtin_fmaxf(__uint_as_float(rr[0]),__uint_as_float(rr[1])); } \
      resc=false; \
      if(__builtin_expect(__any(rm>(float)THRL),0)){ const float dl=__builtin_fmaxf(rm,0.f); mhat+=dl; \
        _Pragma("unroll") for(int r=0;r<16;++r){C0[r]-=dl;C1[r]-=dl;} \
        _Pragma("unroll") for(int r=0;r<16;++r)negm[r]=-mhat; asm volatile("":"+v"(negm)); \
        const float f=__builtin_amdgcn_exp2f(-dl); l_reg*=f; if(hi==0)wsf[r32]=f; resc=true; } } \
    SBAR(); \
    GAPB(o[0]=__builtin_amdgcn_mfma_f32_32x32x16_bf16(PAF(0),VFR(0),o[0],0,0,0), C0,0); \
    GAPB(o[1]=__builtin_amdgcn_mfma_f32_32x32x16_bf16(PAF(0),VFR(4),o[1],0,0,0), C0,4); \
    KRD(GL,0); GAPB(o[0]=__builtin_amdgcn_mfma_f32_32x32x16_bf16(PAF(1),VFR(1),o[0],0,0,0), C0,8); \
    KRD(GL,1); GAPB(o[1]=__builtin_amdgcn_mfma_f32_32x32x16_bf16(PAF(1),VFR(5),o[1],0,0,0), C0,12); \
    KRD(GL,2); GAPB(o[0]=__builtin_amdgcn_mfma_f32_32x32x16_bf16(PAF(2),VFR(2),o[0],0,0,0), C1,0); \
    KRD(GL,3); GAPB(o[1]=__builtin_amdgcn_mfma_f32_32x32x16_bf16(PAF(2),VFR(6),o[1],0,0,0), C1,4); \
    GAPB(o[0]=__builtin_amdgcn_mfma_f32_32x32x16_bf16(PAF(3),VFR(3),o[0],0,0,0), C1,8); \
    GAPB(o[1]=__builtin_amdgcn_mfma_f32_32x32x16_bf16(PAF(3),VFR(7),o[1],0,0,0), C1,12); \
    }while(0)
  int t=1;
  #undef CMASK
  #define CMASK(P0,P1,t) do{}while(0)
  for(;t+5<NT;t+=2){
    STEP(pB0,pB1,pA0,pA1,t,true,true,true);     WAIT_BAR(2); RESC(); ROT();
    STEP(pA0,pA1,pB0,pB1,t+1,true,true,true);   WAIT_BAR(2); RESC(); ROT();
  }
  #undef CMASK
  #define CMASK(P0,P1,t) do{}while(0)
  #define ENDW(tt) do{ if((tt)+3<NT){WAIT_BAR(2);} else if((tt)+2<NT){WAIT_BAR(1);} else {WAIT_BAR(0);} }while(0)
  for(;t+1<NT;t+=2){
    STEP(pB0,pB1,pA0,pA1,t,(t+3<NT),(t+1<NT),(t+1<NT));       ENDW(t);   RESC(); ROT();
    STEP(pA0,pA1,pB0,pB1,t+1,(t+4<NT),(t+2<NT),(t+2<NT));     ENDW(t+1); RESC(); ROT();
  }
  STEP(pB0,pB1,pA0,pA1,NT-1,false,false,false); RESC();
  { float sacc=pB0[0]+pB0[1]; _Pragma("unroll") for(int r=2;r<16;++r)sacc+=pB0[r]; _Pragma("unroll") for(int r=0;r<16;++r)sacc+=pB1[r]; l_reg+=sacc;
    pw0=(u32x4){PKW(pB0,0),PKW(pB0,2),PKW(pB0,4),PKW(pB0,6)};pw1=(u32x4){PKW(pB0,8),PKW(pB0,10),PKW(pB0,12),PKW(pB0,14)};pw2=(u32x4){PKW(pB1,0),PKW(pB1,2),PKW(pB1,4),PKW(pB1,6)};pw3=(u32x4){PKW(pB1,8),PKW(pB1,10),PKW(pB1,12),PKW(pB1,14)};
    SBAR(); pv(o,vb0+sl_cur,PAF(0),PAF(1),PAF(2),PAF(3)); }
  #undef PKW
  #undef PAF
  #undef VFR
  #undef PIN
  #undef MX3
  #undef GAPA
  #undef GAPB
  #undef EX
  #undef VRD
  #undef KRD
  #undef STEP
  #undef ENDW
  {auto rr=__builtin_amdgcn_permlane32_swap(__float_as_uint(l_reg),__float_as_uint(l_reg),false,false);l_reg=__uint_as_float(rr[0])+__uint_as_float(rr[1]);}
  if(hi==0)wsf[32+r32]=l_reg;asm volatile("s_waitcnt lgkmcnt(0)":::"memory");
  float rli[16];
  #pragma unroll
  for(int r=0;r<16;++r)rli[r]=__builtin_amdgcn_rcpf(wsf[32+crow(r,hi)]);
  bf16*Ow=Yo+(qrow0+wid*QBLK)*PO+h*D;
  { bf16*stg=(bf16*)(shm+LDS_OST)+wid*2048;
    #pragma unroll
    for(int r=0;r<16;++r){const int orow=crow(r,hi);
      #pragma unroll
      for(int d0=0;d0<2;++d0)stg[orow*64+d0*32+r32]=__float2bfloat16(o[d0][r]*rli[r]);}
    asm volatile("s_waitcnt lgkmcnt(0)":::"memory");
    #pragma unroll
    for(int i=0;i<4;++i){const int row=i*8+(lane>>3),ch=lane&7; const u32x4 v=*(const u32x4*)(stg+row*64+ch*8); ATTN_STORE16(Ow+(long)row*PO+ch*8,v);} }
  asm volatile("s_waitcnt lgkmcnt(0)\n\ts_barrier":::"memory");
  #undef DMA_K
  #undef DMA_V
  #undef CMASK
  #undef START
  #undef RESC
  #undef ROT
}
constexpr int ATTN_LDS_BYTES=LDS_BYTES;
#undef SBAR
#undef WAIT_BAR
}
namespace mk {
constexpr int NB = 16, SQ = 4096, CL = 256, SEG = SQ + CL, T = NB * SEG, D = 1024, INW = 2048, NL = 4, NE = 32;
constexpr int NROWT = T / 256;
constexpr int MAXRT = 1120, CAP = MAXRT * 256;
constexpr int MODW = 6 * D;
constexpr float EPS = 1e-6f;
constexpr int NWAVES = 8;
constexpr int PPL = 12, NPHASE = 2 + NL * PPL;

constexpr size_t MiB = 1u << 20;
constexpr size_t WS_CTL = 0, CTL_ZERO_BYTES = 1 * MiB;
constexpr size_t WS_MOD = 4 * MiB;
constexpr size_t WS_B1P = 6 * MiB;
constexpr size_t WS_PAIR = 8 * MiB;
constexpr size_t WS_TOK = 12 * MiB;
constexpr size_t WS_LOG = 22 * MiB;
constexpr size_t WS_WINT = 32 * MiB;
constexpr size_t WS_WOUTT = 50 * MiB;
constexpr size_t WS_WRT = 60 * MiB;
constexpr size_t WS_W1T = 64 * MiB;
constexpr size_t WS_W2T = 576 * MiB;
constexpr size_t WS_X = 832 * MiB;
constexpr size_t WS_HB = 1104 * MiB;
constexpr size_t WS_P = 1240 * MiB;
constexpr size_t WS_Y = 1512 * MiB;
constexpr size_t WS_HP = 1648 * MiB;
constexpr size_t WS_ACT = 2208 * MiB;
constexpr size_t WS_YP = 2768 * MiB;
constexpr size_t WS_END = 3328 * MiB;
static_assert(WS_MOD + (size_t)NL * 17 * MODW * 4 <= WS_B1P && WS_B1P + (size_t)NL * NE * 2048 * 4 <= WS_PAIR && WS_PAIR + (size_t)T * 32 <= WS_TOK && WS_TOK + (size_t)NE * T * 4 <= WS_LOG && WS_LOG + (size_t)T * 128 <= WS_WINT, "ws map 1");
static_assert(WS_WINT + (size_t)NL * 2048 * 1024 * 2 <= WS_WOUTT && WS_WOUTT + (size_t)NL * 1024 * 1024 * 2 <= WS_WRT && WS_WRT + (size_t)NL * 256 * 1024 * 2 <= WS_W1T && WS_W1T + (size_t)NL * NE * 2048 * 1024 * 2 <= WS_W2T && WS_W2T + (size_t)NL * NE * 1024 * 1024 * 2 <= WS_X, "ws map 2");
static_assert(WS_X + (size_t)T * 4096 <= WS_HB && WS_HB + (size_t)T * 2048 <= WS_P && WS_P + (size_t)T * 4096 <= WS_Y && WS_Y + (size_t)T * 2048 <= WS_HP && WS_HP + (size_t)CAP * 2048 <= WS_ACT && WS_ACT + (size_t)CAP * 2048 <= WS_YP && WS_YP + (size_t)CAP * 2048 <= WS_END, "ws map 3");
constexpr int CW_BAR = 4096;
constexpr int CW_CNT = 65536;
constexpr int RING_BYTES = 131072;
constexpr int ROPE_OFF = RING_BYTES;
constexpr int T2E_OFF = ROPE_OFF + 8192;
constexpr int MISC_OFF = T2E_OFF + 2048;
constexpr int LDS_BYTES = 147456;
static_assert(MISC_OFF + 1024 <= LDS_BYTES, "LDS map");

#define GAS __attribute__((address_space(1)))
#define LAS __attribute__((address_space(3)))
typedef unsigned short bf16;
typedef unsigned v4u __attribute__((ext_vector_type(4)));
typedef unsigned v2u __attribute__((ext_vector_type(2)));
typedef float f32x4 __attribute__((ext_vector_type(4)));
typedef float f32x2 __attribute__((ext_vector_type(2)));
typedef GAS unsigned gu32;
#define RLX_AGENT __ATOMIC_RELAXED, __HIP_MEMORY_SCOPE_AGENT
#define LDS_WAIT() asm volatile("s_waitcnt lgkmcnt(0)" ::: "memory")
#define VM_WAIT() asm volatile("s_waitcnt vmcnt(0)" ::: "memory")
__device__ __forceinline__ unsigned f2bf(float f) { unsigned u = __builtin_bit_cast(unsigned, f); return (u + 0x7fffu + ((u >> 16) & 1u)) >> 16; }
__device__ __forceinline__ unsigned pk2(float lo, float hi) { return f2bf(lo) | (f2bf(hi) << 16); }
__device__ __forceinline__ float bflo(unsigned w) { return __builtin_bit_cast(float, w << 16); }
__device__ __forceinline__ float bfhi(unsigned w) { return __builtin_bit_cast(float, w & 0xffff0000u); }
__device__ __forceinline__ f32x4 bf4(v2u w) { return (f32x4){bflo(w.x), bfhi(w.x), bflo(w.y), bfhi(w.y)}; }
__device__ __forceinline__ v2u pk4(f32x4 v) { return (v2u){pk2(v.x, v.y), pk2(v.z, v.w)}; }
__device__ __forceinline__ float wave_sum(float v) {
#pragma unroll
    for (int o = 1; o < 64; o <<= 1) v += __shfl_xor(v, o);
    return v;
}
__device__ __forceinline__ float sum4(f32x4 v) { return (v.x + v.y) + (v.z + v.w); }
__device__ __forceinline__ float sigmoidf_(float z) { return __builtin_amdgcn_rcpf(1.0f + __builtin_amdgcn_exp2f(z * -1.4426950408889634f)); }
template <int I> __device__ __forceinline__ const float* ldin() { const GAS float* p;
    asm volatile("s_load_dwordx2 %0, %1, %2\n\ts_waitcnt lgkmcnt(0)" : "=s"(p) : "s"(__builtin_amdgcn_kernarg_segment_ptr()), "n"(I * 8) : "memory"); return (const float*)p; }
__device__ __forceinline__ float* ldout() { GAS float* p;
    asm volatile("s_load_dwordx2 %0, %1, %2\n\ts_waitcnt lgkmcnt(0)" : "=s"(p) : "s"(__builtin_amdgcn_kernarg_segment_ptr()), "n"(24 * 8) : "memory"); return (float*)p; }
#define XB_TMO      128
#define XB_XCNT(j)  (256  + 64 * (j))
#define XB_XSUB(j)  (1280 + 64 * (j))
#define XB_XGEN(j)  (2304 + 64 * (j))
#define XB_TOP      3328
#define XB_TOPGEN   3392
#define XCD_BAR_WORDS 3456
#define XB_SPIN_CAP (1u << 22)

__device__ __forceinline__ unsigned xb_ld(unsigned* p)              { return __hip_atomic_load(p, __ATOMIC_RELAXED, __HIP_MEMORY_SCOPE_AGENT); }
__device__ __forceinline__ unsigned xb_add(unsigned* p, unsigned v) { return __hip_atomic_fetch_add(p, v, __ATOMIC_RELAXED, __HIP_MEMORY_SCOPE_AGENT); }
__device__ __forceinline__ unsigned xb_xcc_id() { return (unsigned)__builtin_amdgcn_s_getreg((3 << 11) | 20) & 0xFu; }
#define XB_SPIN(cond, bar) do { unsigned _sp = 0; while (cond) { __builtin_amdgcn_s_sleep(1); \
    if ((++_sp & 255u) == 0u) { if (xb_ld(&(bar)[XB_TMO])) break; if (_sp > XB_SPIN_CAP) { atomicAdd(&(bar)[XB_TMO], 1u); break; } } } } while (0)

struct XcdBarrier {
    unsigned* bar; unsigned x;
    volatile LAS unsigned* st;
};

__device__ __forceinline__ XcdBarrier xcd_barrier_post(unsigned* bar, volatile LAS unsigned* st) {
    XcdBarrier b; b.bar = bar; b.x = xb_xcc_id(); b.st = st;
    if (threadIdx.x == 0) (void)xb_add(&bar[XB_XCNT(b.x)], 1u);
    return b;
}
__device__ __forceinline__ void xcd_barrier_complete(unsigned* bar, unsigned x, unsigned& nloc, unsigned& nx) {
    const unsigned G = gridDim.x * gridDim.y * gridDim.z;
    unsigned sum, cnt, mine, sp = 0u;
    for (;;) {
        sum = 0u; cnt = 0u; mine = 0u;
#pragma unroll
        for (unsigned j = 0; j < 16; ++j) { const unsigned c = xb_ld(&bar[XB_XCNT(j)]); sum += c; cnt += (c > 0u) ? 1u : 0u; mine = (j == x) ? c : mine; }
        if (sum == G) break;
        __builtin_amdgcn_s_sleep(1);
        if ((++sp & 255u) == 0u) { if (xb_ld(&bar[XB_TMO])) break; if (sp > XB_SPIN_CAP) { atomicAdd(&bar[XB_TMO], 1u); break; } }
    }
    nloc = mine > 0u ? mine : 1u; nx = cnt > 0u ? cnt : 1u;
}

__device__ __forceinline__ void xcd_barrier(const XcdBarrier& b) {
    asm volatile("s_waitcnt vmcnt(0)" ::: "memory");
    __syncthreads();
    if (threadIdx.x == 0) {
        unsigned* bar = b.bar;
        __builtin_amdgcn_s_waitcnt(0);
        unsigned nloc = b.st[0], nx = b.st[1];
        if (nloc == 0u) { xcd_barrier_complete(bar, b.x, nloc, nx); b.st[0] = nloc; b.st[1] = nx; }
        const unsigned old = xb_add(&bar[XB_XSUB(b.x)], 1u);
        const unsigned gen = old / nloc;
        if (old + 1u == (gen + 1u) * nloc) {
            __builtin_amdgcn_fence(__ATOMIC_RELEASE, "agent");
            asm volatile("s_waitcnt vmcnt(0)" ::: "memory");
            const unsigned og = xb_add(&bar[XB_TOP], 1u);
            const unsigned tg = og / nx;
            if (og + 1u == (tg + 1u) * nx) xb_add(&bar[XB_TOPGEN], 1u);
            else XB_SPIN(xb_ld(&bar[XB_TOPGEN]) == tg, bar);
            __builtin_amdgcn_fence(__ATOMIC_ACQUIRE, "agent");
            xb_add(&bar[XB_XGEN(b.x)], 1u);
            asm volatile("s_waitcnt vmcnt(0)" ::: "memory");
        } else {
            XB_SPIN(xb_ld(&bar[XB_XGEN(b.x)]) == gen, bar);
            __builtin_amdgcn_fence(__ATOMIC_ACQUIRE, "agent");
            asm volatile("s_waitcnt vmcnt(0)" ::: "memory");
        }
    }
    __syncthreads();
}

struct Ctx {
    LAS unsigned char* lds; volatile LAS unsigned* MISC; gu32* ctl;
    int tid, lane, wave, vcu, G, gw, ngw;
    GAS unsigned char* ws;
    __device__ __forceinline__ float* MOD() const { return (float*)(ws + WS_MOD); }
    __device__ __forceinline__ float* B1P() const { return (float*)(ws + WS_B1P); }
    __device__ __forceinline__ float* LOG() const { return (float*)(ws + WS_LOG); }
    __device__ __forceinline__ float* X() const { return (float*)(ws + WS_X); }
    __device__ __forceinline__ v2u* PAIR() const { return (v2u*)(ws + WS_PAIR); }
    __device__ __forceinline__ int* TOK() const { return (int*)(ws + WS_TOK); }
    __device__ __forceinline__ bf16* WINT() const { return (bf16*)(ws + WS_WINT); }
    __device__ __forceinline__ bf16* WOUTT() const { return (bf16*)(ws + WS_WOUTT); }
    __device__ __forceinline__ bf16* WRT() const { return (bf16*)(ws + WS_WRT); }
    __device__ __forceinline__ bf16* W1T() const { return (bf16*)(ws + WS_W1T); }
    __device__ __forceinline__ bf16* W2T() const { return (bf16*)(ws + WS_W2T); }
    __device__ __forceinline__ bf16* HB() const { return (bf16*)(ws + WS_HB); }
    __device__ __forceinline__ bf16* P() const { return (bf16*)(ws + WS_P); }
    __device__ __forceinline__ bf16* Y() const { return (bf16*)(ws + WS_Y); }
    __device__ __forceinline__ bf16* HP() const { return (bf16*)(ws + WS_HP); }
    __device__ __forceinline__ bf16* ACT() const { return (bf16*)(ws + WS_ACT); }
    __device__ __forceinline__ bf16* YP() const { return (bf16*)(ws + WS_YP); }
};
struct Args { const float* in[24]; float* out; unsigned char* ws; int ph_lo, ph_hi; };

__device__ __forceinline__ int w1_row(int n) { const int a = n >> 1; return ((a >> 7) << 8) + ((n & 1) << 7) + (a & 127); }
template <int MODE>
__device__ __forceinline__ void transpose_item(const float* W, int K, int N, bf16* WT, LAS float* scr, int item, int lane) {
    const int nblk = N / 32, kb = item / nblk, nb = item % nblk, k0 = 64 * kb, n0 = 32 * nb;
#pragma unroll 8
    for (int i = 0; i < 32; ++i) { const int kk = 2 * i + (lane >> 5); scr[kk * 33 + (lane & 31)] = W[(size_t)(k0 + kk) * N + n0 + (lane & 31)]; }
    LDS_WAIT(); asm volatile("" ::: "memory");
    const int c = lane & 7;
#pragma unroll
    for (int j = 0; j < 4; ++j) { const int n = (lane >> 3) + 8 * j; const LAS float* s = scr + (8 * c) * 33 + n;
        v4u o; o.x = pk2(s[0 * 33], s[1 * 33]); o.y = pk2(s[2 * 33], s[3 * 33]); o.z = pk2(s[4 * 33], s[5 * 33]); o.w = pk2(s[6 * 33], s[7 * 33]);
        const int orow = MODE == 1 ? w1_row(n0 + n) : (n0 + n);
        *(GAS v4u*)(WT + (size_t)orow * K + k0 + 8 * c) = o; }
    LDS_WAIT(); asm volatile("" ::: "memory");
}
__device__ __forceinline__ void phase_prologue(const Ctx& C, const Args& A) {
    {
        LAS float* sS = (LAS float*)C.lds;
        const float* cin = ldin<1>(); const float* cctx = ldin<3>(); const float* wada = ldin<4>(); const float* bada = ldin<5>();
        for (int i = C.tid; i < 17 * 1024; i += NWAVES * 64) { const int j = i >> 10, k = i & 1023; const float v = j < 16 ? cin[j * 1024 + k] : cctx[k]; sS[i] = v * sigmoidf_(v); }
        __syncthreads();
        const int kl = C.tid & 15, cg = C.tid >> 4;
        for (int item = blockIdx.x; item < NL * 48; item += C.G) {
            const int l = item / 48, c0 = (item % 48) * 128 + 4 * cg;
            const float* W = wada + (size_t)l * 1024 * MODW + c0;
            f32x4 acc[17];
#pragma unroll
            for (int j = 0; j < 17; ++j) acc[j] = (f32x4){0.f, 0.f, 0.f, 0.f};
            for (int k = kl; k < 1024; k += 16) { const f32x4 w = *(const f32x4*)(W + (size_t)k * MODW);
#pragma unroll
                for (int j = 0; j < 17; ++j) acc[j] += sS[j * 1024 + k] * w; }
#pragma unroll
            for (int j = 0; j < 17; ++j)
#pragma unroll
                for (int o = 1; o < 16; o <<= 1) { acc[j].x += __shfl_xor(acc[j].x, o); acc[j].y += __shfl_xor(acc[j].y, o); acc[j].z += __shfl_xor(acc[j].z, o); acc[j].w += __shfl_xor(acc[j].w, o); }
            if (kl == 0) { const f32x4 bv = *(const f32x4*)(bada + (size_t)l * MODW + c0);
#pragma unroll
                for (int j = 0; j < 17; ++j) *(f32x4*)(C.MOD() + ((size_t)l * 17 + j) * MODW + c0) = acc[j] + bv; }
        }
        __syncthreads();
    }
    {
        LAS float* scr = (LAS float*)(C.lds + C.wave * 16384);
        const float* w_in = ldin<8>(); const float* w_out = ldin<17>(); const float* w_r = ldin<18>(); const float* w_e1 = ldin<20>(); const float* w_e2 = ldin<22>(); const float* b_e1 = ldin<21>();
        constexpr int I_IN = 16 * 64, I_OUT = 16 * 32, I_E1 = 16 * 64, I_E2 = 16 * 32, I_R = 16;
        constexpr int PER_L = I_IN + I_OUT + NE * I_E1 + NE * I_E2 + I_R;
        for (int it = C.gw; it < NL * PER_L; it += C.ngw) {
            const int l = it / PER_L; int r = it - l * PER_L;
            if (r < I_IN) { transpose_item<0>(w_in + (size_t)l * 1024 * 2048, 1024, 2048, C.WINT() + (size_t)l * 2048 * 1024, scr, r, C.lane); continue; } r -= I_IN;
            if (r < I_OUT) { transpose_item<0>(w_out + (size_t)l * 1024 * 1024, 1024, 1024, C.WOUTT() + (size_t)l * 1024 * 1024, scr, r, C.lane); continue; } r -= I_OUT;
            if (r < NE * I_E1) { const int e = r / I_E1; transpose_item<1>(w_e1 + ((size_t)l * NE + e) * 1024 * 2048, 1024, 2048, C.W1T() + ((size_t)l * NE + e) * 2048 * 1024, scr, r % I_E1, C.lane); continue; } r -= NE * I_E1;
            if (r < NE * I_E2) { const int e = r / I_E2; transpose_item<0>(w_e2 + ((size_t)l * NE + e) * 1024 * 1024, 1024, 1024, C.W2T() + ((size_t)l * NE + e) * 1024 * 1024, scr, r % I_E2, C.lane); continue; } r -= NE * I_E2;
            transpose_item<0>(w_r + (size_t)l * 1024 * 32, 1024, 32, C.WRT() + (size_t)l * 256 * 1024, scr, r, C.lane);
        }
        for (int i = C.gw * 64 + C.lane; i < NL * NE * 2048; i += C.ngw * 64) { const int n = i & 2047; C.B1P()[(i & ~2047) + w1_row(n)] = b_e1[i]; }
    }
}

__device__ __forceinline__ void moe_tables(const Ctx& C, int l, bool with_t2e) {
    __syncthreads();
    if (C.tid < NE) C.MISC[40 + C.tid] = __hip_atomic_load(C.ctl + CW_CNT + (l * NE + C.tid) * 64, RLX_AGENT);
    __syncthreads();
    if (C.tid == 0) { unsigned s = 0;
#pragma unroll 1
        for (int e = 0; e < NE; ++e) { C.MISC[e] = s; s += (C.MISC[40 + e] + 255u) >> 8; } C.MISC[NE] = s; }
    __syncthreads();
    if (with_t2e) { LAS unsigned char* t2e = (LAS unsigned char*)(C.lds + T2E_OFF);
        for (int rt = C.tid; rt < MAXRT; rt += NWAVES * 64) { unsigned e = 0;
#pragma unroll 1
            for (int k = 1; k < NE; ++k) e += (C.MISC[k] <= (unsigned)rt) ? 1u : 0u;
            t2e[rt] = (unsigned char)e; }
        __syncthreads(); }
}

__device__ __forceinline__ void row_bt(int r, int& b, int& t, int& j) { b = r / SEG; t = r - b * SEG; j = t < SQ ? b : 16; }
__device__ __forceinline__ void modulate_store(const f32x4 (&v)[4], const float* g, const float* shift, const float* scale, bf16* orow, int lane) {
    float ss = 0.f;
#pragma unroll
    for (int jj = 0; jj < 4; ++jj) ss += sum4(v[jj] * v[jj]);
    const float rs = __builtin_amdgcn_rsqf(wave_sum(ss) * (1.0f / D) + EPS);
#pragma unroll
    for (int jj = 0; jj < 4; ++jj) { const int c = 256 * jj + 4 * lane;
        const f32x4 gv = *(const f32x4*)(g + c), sh = *(const f32x4*)(shift + c), sc = *(const f32x4*)(scale + c);
        const f32x4 h = (v[jj] * rs) * gv * (1.0f + sc) + sh;
        *(GAS v2u*)(orow + c) = pk4(h); }
}
__device__ __forceinline__ void moe_combine(const Ctx& C, int r, f32x4 (&acc)[4]) {
#pragma unroll
    for (int jj = 0; jj < 4; ++jj) acc[jj] = (f32x4){0.f, 0.f, 0.f, 0.f};
#pragma unroll
    for (int k = 0; k < 4; ++k) { const v2u pr = C.PAIR()[(size_t)r * 4 + k]; const unsigned e = pr.x & 31u, pos = pr.x >> 5; const unsigned wb = pr.y; const float wt = __uint_as_float(wb);
        const bf16* yp = C.YP() + ((size_t)C.MISC[e] * 256 + pos) * D + 4 * C.lane;
#pragma unroll
        for (int jj = 0; jj < 4; ++jj) acc[jj] += wt * bf4(*(const GAS v2u*)(yp + 256 * jj)); }
}

__device__ __forceinline__ void phase_premix(const Ctx& C, const Args& A, int l) {
    if (l > 0) moe_tables(C, l - 1, false);
    const float* modl = C.MOD() + (size_t)l * 17 * MODW; const float* modp = C.MOD() + (size_t)(l > 0 ? l - 1 : 0) * 17 * MODW;
    const float* g = ldin<6>() + (size_t)l * D; const float* xin = ldin<0>(); const float* cxin = ldin<2>();
    for (int r = C.gw; r < T; r += C.ngw) {
        int b, t, j; row_bt(r, b, t, j);
        f32x4 v[4]; float* xr = C.X() + (size_t)r * D + 4 * C.lane;
        if (l == 0) { const float* src = (t < SQ ? xin + ((size_t)b * SQ + t) * D : cxin + ((size_t)b * CL + (t - SQ)) * D) + 4 * C.lane;
#pragma unroll
            for (int jj = 0; jj < 4; ++jj) v[jj] = *(const f32x4*)(src + 256 * jj);
        } else { f32x4 acc[4]; moe_combine(C, r, acc); const float* gt2 = modp + (size_t)j * MODW + 5 * D + 4 * C.lane;
#pragma unroll
            for (int jj = 0; jj < 4; ++jj) v[jj] = *(const f32x4*)(xr + 256 * jj) + *(const f32x4*)(gt2 + 256 * jj) * acc[jj]; }
#pragma unroll
        for (int jj = 0; jj < 4; ++jj) *(f32x4*)(xr + 256 * jj) = v[jj];
        const float* mj = modl + (size_t)j * MODW;
        modulate_store(v, g, mj + 0 * D, mj + 1 * D, C.HB() + (size_t)r * D, C.lane);
    }
}
__device__ __forceinline__ void phase_premoe(const Ctx& C, const Args& A, int l) {
    const float* modl = C.MOD() + (size_t)l * 17 * MODW; const float* g = ldin<7>() + (size_t)l * D;
    for (int r = C.gw; r < T; r += C.ngw) {
        int b, t, j; row_bt(r, b, t, j);
        f32x4 v[4]; const float* xr = C.X() + (size_t)r * D + 4 * C.lane;
#pragma unroll
        for (int jj = 0; jj < 4; ++jj) v[jj] = *(const f32x4*)(xr + 256 * jj);
        const float* mj = modl + (size_t)j * MODW;
        modulate_store(v, g, mj + 3 * D, mj + 4 * D, C.HB() + (size_t)r * D, C.lane);
    }
}
__device__ __forceinline__ void phase_final(const Ctx& C, const Args& A) {
    moe_tables(C, NL - 1, false);
    const float* modp = C.MOD() + (size_t)(NL - 1) * 17 * MODW; float* outp = ldout();
    for (int q = C.gw; q < NB * SQ; q += C.ngw) {
        const int b = q / SQ, t = q - b * SQ, r = b * SEG + t;
        f32x4 acc[4]; moe_combine(C, r, acc);
        const float* xr = C.X() + (size_t)r * D + 4 * C.lane; const float* gt2 = modp + (size_t)b * MODW + 5 * D + 4 * C.lane; float* o = outp + (size_t)q * D + 4 * C.lane;
#pragma unroll
        for (int jj = 0; jj < 4; ++jj) *(f32x4*)(o + 256 * jj) = *(const f32x4*)(xr + 256 * jj) + *(const f32x4*)(gt2 + 256 * jj) * acc[jj];
    }
}

__device__ __forceinline__ void phase_qknorm(const Ctx& C, const Args& A, int l) {
    const LAS f32x2* rope = (const LAS f32x2*)(C.lds + ROPE_OFF);
    const float* gq = ldin<9>() + l * 64; const float* gk = ldin<10>() + l * 64;
    const int d0 = 8 * (C.lane & 7);
    const int ax = d0 >> 5, o0 = d0 & 31; const bool first = o0 < 16; const int i0 = o0 & 15;
    float gqv[8], gkv[8];
#pragma unroll
    for (int i = 0; i < 8; ++i) { gqv[i] = gq[d0 + i]; gkv[i] = gk[d0 + i]; }
    for (int r = C.gw; r < T; r += C.ngw) {
        int b, t, j; row_bt(r, b, t, j);
        const bool lat = t < SQ; const int pos = ax == 0 ? (t >> 6) : (t & 63);
        bf16* prow = C.P() + (size_t)r * INW;
#pragma unroll
        for (int part = 0; part < 2; ++part) {
            const bool act = part == 0 || C.lane < 16;
            bf16* p = prow + (part == 0 ? 0 : 512) + 8 * (act ? C.lane : 0);
            const v4u w = *(const GAS v4u*)p;
            float f[8] = {bflo(w.x), bfhi(w.x), bflo(w.y), bfhi(w.y), bflo(w.z), bfhi(w.z), bflo(w.w), bfhi(w.w)};
            float ss = 0.f;
#pragma unroll
            for (int i = 0; i < 8; ++i) ss += f[i] * f[i];
            ss += __shfl_xor(ss, 1); ss += __shfl_xor(ss, 2); ss += __shfl_xor(ss, 4);
            const float rs = __builtin_amdgcn_rsqf(ss * (1.0f / 64.0f) + EPS);
#pragma unroll
            for (int i = 0; i < 8; ++i) f[i] = f[i] * rs * (part == 0 ? gqv[i] : gkv[i]);
            float o[8];
#pragma unroll
            for (int i = 0; i < 8; ++i) { const float pv = __shfl_xor(f[i], 2); const f32x2 cs = rope[pos * 16 + i0 + i];
                const float rot = first ? f[i] * cs.x - pv * cs.y : f[i] * cs.x + pv * cs.y;
                o[i] = lat ? rot : f[i]; if (part == 0) o[i] *= attn_body::C2; }
            if (act) { v4u ow; ow.x = pk2(o[0], o[1]); ow.y = pk2(o[2], o[3]); ow.z = pk2(o[4], o[5]); ow.w = pk2(o[6], o[7]); *(GAS v4u*)p = ow; }
        }
    }
}

__device__ __forceinline__ void phase_attn(const Ctx& C) {
    char* shm = (char*)C.lds;
    const attn_body::bf16* Pq = (const attn_body::bf16*)C.P(); attn_body::bf16* Yo = (attn_body::bf16*)C.Y();
    const int nlat = NB * 8 * 16;
    const int per = (nlat + C.G - 1) / C.G;
    for (int i = 0; i < per; ++i) { const int u = C.vcu * per + i; if (u >= nlat) break;
        const int qb = u & 15, h = (u >> 4) & 7, b = u >> 7;
        attn_body::attn_unit<8>((long)b * SEG + qb * 256, (long)b * SEG, SEG / 64, h, Pq, Yo, shm); }
    for (int u = C.vcu; u < NB * 8; u += C.G) { const int h = u & 7, b = u >> 3;
        attn_body::attn_unit<8>((long)b * SEG + SQ, (long)b * SEG + SQ, CL / 64, h, Pq, Yo, shm); }
}

__device__ __forceinline__ void phase_conv(const Ctx& C, const Args& A, int l) {
    LAS float* zL = (LAS float*)C.lds;
    const int c4 = 4 * C.lane;
    f32x4 wk[31]; const float* wdw = ldin<11>();
#pragma unroll
    for (int jt = 0; jt < 31; ++jt) wk[jt] = *(const f32x4*)(wdw + ((size_t)l * 31 + jt) * 256 + c4);
    const f32x4 b31 = *(const f32x4*)(ldin<12>() + l * 256 + c4), gln = *(const f32x4*)(ldin<13>() + l * 256 + c4), bln = *(const f32x4*)(ldin<14>() + l * 256 + c4);
    const float* wsc = ldin<15>() + (size_t)l * 3 * 256 + c4; const f32x4 w30 = *(const f32x4*)(wsc), w31 = *(const f32x4*)(wsc + 256), w32 = *(const f32x4*)(wsc + 512);
    const float* gg = ldin<16>() + (size_t)l * D;
    const f32x4 gA0 = *(const f32x4*)(gg + 8 * C.lane), gA1 = *(const f32x4*)(gg + 8 * C.lane + 4), gC = *(const f32x4*)(gg + 512 + c4), gS = *(const f32x4*)(gg + 768 + c4);
    for (int tile = C.vcu; tile < T / 64; tile += C.G) {
        const int b = tile / 68, tt = tile - b * 68, t0 = tt * 64;
        const int seg_lo = tt < 64 ? 0 : SQ, seg_hi = tt < 64 ? SQ : SEG;
        const size_t rbase = (size_t)b * SEG;
        __syncthreads();
        for (int zr = C.wave; zr < 94; zr += NWAVES) { const int t = t0 - 15 + zr; f32x4 z = (f32x4){0.f, 0.f, 0.f, 0.f};
            if (t >= seg_lo && t < seg_hi) { const bf16* p = C.P() + (rbase + t) * INW; const f32x4 a = bf4(*(const GAS v2u*)(p + 768 + c4)), gt = bf4(*(const GAS v2u*)(p + 1024 + c4));
                z = (f32x4){a.x * sigmoidf_(gt.x), a.y * sigmoidf_(gt.y), a.z * sigmoidf_(gt.z), a.w * sigmoidf_(gt.w)}; }
            *(LAS f32x4*)(zL + zr * 256 + c4) = z; }
        __syncthreads();
        for (int i = C.wave; i < 64; i += NWAVES) { const int t = t0 + i; const size_t r = rbase + t;
            f32x4 u = b31;
#pragma unroll
            for (int jt = 0; jt < 31; ++jt) u += wk[jt] * *(const LAS f32x4*)(zL + (i + jt) * 256 + c4);
            const float mean = wave_sum(sum4(u)) * (1.0f / 256.0f); const f32x4 d = u - mean;
            const float var = wave_sum(sum4(d * d)) * (1.0f / 256.0f); const f32x4 y = d * __builtin_amdgcn_rsqf(var + EPS) * gln + bln;
            const f32x4 cf = (f32x4){y.x * sigmoidf_(y.x), y.y * sigmoidf_(y.y), y.z * sigmoidf_(y.z), y.w * sigmoidf_(y.w)};
            const float rsc = __builtin_amdgcn_rsqf(wave_sum(sum4(cf * cf)) * (1.0f / 256.0f) + EPS);
            bf16* yr = C.Y() + r * D;
            *(GAS v2u*)(yr + 512 + c4) = pk4(cf * rsc * gC);
            const bf16* p = C.P() + r * INW; f32x4 m0 = (f32x4){0.f, 0.f, 0.f, 0.f}, m2 = m0;
            const f32x4 m1 = bf4(*(const GAS v2u*)(p + 1536 + c4)) * bf4(*(const GAS v2u*)(p + 1792 + c4));
            if (t - 1 >= seg_lo) m0 = bf4(*(const GAS v2u*)(p - INW + 1536 + c4)) * bf4(*(const GAS v2u*)(p - INW + 1792 + c4));
            if (t + 1 < seg_hi) m2 = bf4(*(const GAS v2u*)(p + INW + 1536 + c4)) * bf4(*(const GAS v2u*)(p + INW + 1792 + c4));
            const f32x4 sv = bf4(*(const GAS v2u*)(p + 1280 + c4)) * (w30 * m0 + w31 * m1 + w32 * m2);
            const float rss = __builtin_amdgcn_rsqf(wave_sum(sum4(sv * sv)) * (1.0f / 256.0f) + EPS);
            *(GAS v2u*)(yr + 768 + c4) = pk4(sv * rss * gS);
            const v4u aw = *(const GAS v4u*)(yr + 8 * C.lane);
            const f32x4 a0 = bf4((v2u){aw.x, aw.y}), a1 = bf4((v2u){aw.z, aw.w});
            const float rsa = __builtin_amdgcn_rsqf(wave_sum(sum4(a0 * a0) + sum4(a1 * a1)) * (1.0f / 512.0f) + EPS);
            const v2u o0 = pk4(a0 * rsa * gA0), o1 = pk4(a1 * rsa * gA1);
            *(GAS v4u*)(yr + 8 * C.lane) = (v4u){o0.x, o0.y, o1.x, o1.y};
        }
    }
    __syncthreads();
}

__device__ __forceinline__ void phase_route(const Ctx& C, const Args& A, int l) {
    volatile LAS unsigned* lhist = C.MISC + 80; volatile LAS unsigned* lbase = C.MISC + 112;
    const float br = C.lane < NE ? ldin<19>()[l * NE + C.lane] : 0.f;
    gu32* cnt = C.ctl + CW_CNT + (size_t)l * NE * 64;
    for (int tile = C.vcu; tile < T / 64; tile += C.G) {
        __syncthreads();
        if (C.tid < NE) lhist[C.tid] = 0u;
        __syncthreads();
        unsigned pe[8], pp[8];
#pragma unroll
        for (int i = 0; i < 8; ++i) { const int r = tile * 64 + C.wave * 8 + i;
            float v = C.lane < NE ? C.LOG()[(size_t)r * NE + C.lane] + br : -INFINITY;
            float sv[4]; int se[4];
#pragma unroll
            for (int k = 0; k < 4; ++k) { float m = v; int mi = C.lane;
#pragma unroll
                for (int o = 1; o < 64; o <<= 1) { const float ov = __shfl_xor(m, o); const int oi = __shfl_xor(mi, o); if (ov > m || (ov == m && oi < mi)) { m = ov; mi = oi; } }
                sv[k] = m; se[k] = mi; if (C.lane == mi) v = -INFINITY; }
            const float e1 = __expf(sv[1] - sv[0]), e2 = __expf(sv[2] - sv[0]), e3 = __expf(sv[3] - sv[0]); const float inv = __builtin_amdgcn_rcpf(1.0f + e1 + e2 + e3);
            const int kk = C.lane & 3;
            pe[i] = (unsigned)(kk == 0 ? se[0] : kk == 1 ? se[1] : kk == 2 ? se[2] : se[3]);
            const float pwi = (kk == 0 ? 1.0f : kk == 1 ? e1 : kk == 2 ? e2 : e3) * inv;
            pp[i] = 0u;
            if (C.lane < 4) { pp[i] = __hip_atomic_fetch_add((LAS unsigned*)(C.lds + MISC_OFF) + 80 + pe[i], 1u, __ATOMIC_RELAXED, __HIP_MEMORY_SCOPE_WORKGROUP);
                ((GAS float*)C.PAIR())[((size_t)r * 4 + C.lane) * 2 + 1] = pwi; } }
        __syncthreads();
        if (C.tid < NE) { const unsigned n = lhist[C.tid]; lbase[C.tid] = n ? __hip_atomic_fetch_add(cnt + C.tid * 64, n, RLX_AGENT) : 0u; }
        __syncthreads();
        if (C.lane < 4) {
#pragma unroll
            for (int i = 0; i < 8; ++i) { const int r = tile * 64 + C.wave * 8 + i; const unsigned pos = lbase[pe[i]] + pp[i];
                ((GAS unsigned*)C.PAIR())[((size_t)r * 4 + C.lane) * 2] = pe[i] | (pos << 5);
                C.TOK()[(size_t)pe[i] * T + pos] = r; } }
    }
    __syncthreads();
}

__device__ __forceinline__ void phase_gather(const Ctx& C, const Args& A, int l) {
    moe_tables(C, l, true);
    const LAS unsigned char* t2e = (const LAS unsigned char*)(C.lds + T2E_OFF);
    const int nslot = (int)C.MISC[NE] * 256;
    for (int s = C.gw; s < nslot; s += C.ngw) { const unsigned e = t2e[s >> 8]; const unsigned pos = (unsigned)s - C.MISC[e] * 256u;
        if (pos < C.MISC[40 + e]) { const int r = C.TOK()[(size_t)e * T + pos];
            const GAS v4u* src = (const GAS v4u*)(C.HB() + (size_t)r * D) + C.lane; GAS v4u* dst = (GAS v4u*)(C.HP() + (size_t)s * D) + C.lane;
            dst[0] = src[0]; dst[64] = src[64]; } }
}

__global__ void __launch_bounds__(NWAVES * 64, 2) mk_fwd(Args args) {
    extern __shared__ __attribute__((aligned(16))) unsigned char lds_raw[];
    Ctx C;
    C.lds = (LAS unsigned char*)lds_raw; C.MISC = (volatile LAS unsigned*)(C.lds + MISC_OFF);
    C.tid = threadIdx.x; C.lane = C.tid & 63; C.wave = __builtin_amdgcn_readfirstlane(C.tid >> 6);
    C.G = gridDim.x; { const int bx = blockIdx.x; C.vcu = (C.G % 8 == 0) ? (bx % 8) * (C.G / 8) + bx / 8 : bx; }
    C.gw = C.vcu * NWAVES + C.wave; C.ngw = C.G * NWAVES;
    C.ws = (GAS unsigned char*)args.ws; C.ctl = (gu32*)(C.ws + WS_CTL);
    for (int u = C.tid; u < (LDS_BYTES - MISC_OFF) / 4; u += NWAVES * 64) ((LAS unsigned*)(C.lds + MISC_OFF))[u] = 0u;
    for (int u = C.tid; u < 64 * 16; u += NWAVES * 64) { const int pos = u >> 4, i = u & 15; const float inv = powf(10000.0f, -(float)(2 * i) / 32.0f); const float ang = (float)pos * inv;
        ((LAS f32x2*)(C.lds + ROPE_OFF))[u] = (f32x2){cosf(ang), sinf(ang)}; }
    __syncthreads();
    const int lo = args.ph_lo, hi = args.ph_hi;
    const bool multi = (hi - lo) > 1;
    XcdBarrier bar; bar.bar = (unsigned*)(C.ctl + CW_BAR); bar.x = 0; bar.st = C.MISC + 160;
    if (multi) bar = xcd_barrier_post((unsigned*)(C.ctl + CW_BAR), C.MISC + 160);
#ifndef MK_PHMASK
#define MK_PHMASK 0xFFFF
#endif
#define IN(k) (lo <= (k) && (k) < hi)
#define FRESH() do { asm volatile("" : "+v"(C.tid), "+v"(C.lane)); asm volatile("" : "+s"(C.wave), "+s"(C.vcu), "+s"(C.gw), "+s"(C.ws), "+s"(C.ctl)); } while (0)
#define EN(k) ((MK_PHMASK >> (k)) & 1)
#define SEAM(k) do { if (IN((k) + 1)) xcd_barrier(bar); } while (0)

    if (EN(12) && IN(0)) { phase_prologue(C, args); SEAM(0); }
    for (int l = 0; l < NL; ++l) {
        const int pb = 1 + l * PPL;
        if (EN(0) && IN(pb + 0)) { FRESH(); phase_premix(C, args, l); SEAM(pb + 0); }
        if (EN(1) && IN(pb + 1)) { FRESH();
            pg8::Gemm g{C.HB(), C.WINT() + (size_t)l * INW * D, T, INW, D}; pg8::StaticOrder S; S.init(T, INW, C.G, (int)blockIdx.x);
            pg8::EpiStore E{C.P(), INW};
            pg8::gemm_phase<pg8::EpiStore, pg8::StaticOrder, true, true>(C.lds, g, S, E);
            SEAM(pb + 1); }
        if (EN(2) && IN(pb + 2)) { FRESH(); phase_qknorm(C, args, l); SEAM(pb + 2); }
        if (EN(3) && IN(pb + 3)) { FRESH(); phase_attn(C); SEAM(pb + 3); }
        if (EN(4) && IN(pb + 4)) { FRESH(); phase_conv(C, args, l); SEAM(pb + 4); }
        if (EN(5) && IN(pb + 5)) { FRESH();
            pg8::Gemm g{C.Y(), C.WOUTT() + (size_t)l * D * D, T, D, D}; pg8::StaticOrder S; S.init(T, D, C.G, (int)blockIdx.x);
            pg8::EpiResid E{C.X(), C.MOD() + (size_t)l * 17 * MODW + 2 * D};
            pg8::gemm_phase<pg8::EpiResid, pg8::StaticOrder, true, true>(C.lds, g, S, E);
            SEAM(pb + 5); }
        if (EN(6) && IN(pb + 6)) { FRESH(); phase_premoe(C, args, l); SEAM(pb + 6); }
        if (EN(7) && IN(pb + 7)) { FRESH();
            pg8::Gemm g{C.HB(), C.WRT() + (size_t)l * 256 * D, T, 256, D}; pg8::StaticOrder S; S.init(T, 256, C.G, (int)blockIdx.x);
            pg8::EpiLogits E{C.LOG()};
            pg8::gemm_phase<pg8::EpiLogits, pg8::StaticOrder, true, true>(C.lds, g, S, E);
            SEAM(pb + 7); }
        if (EN(8) && IN(pb + 8)) { FRESH(); phase_route(C, args, l); SEAM(pb + 8); }
        if (EN(9) && IN(pb + 9)) { FRESH(); phase_gather(C, args, l); SEAM(pb + 9); }
        if (EN(10) && IN(pb + 10)) { FRESH();
            moe_tables(C, l, true);
            pg8::Gemm g{C.HP(), C.W1T() + (size_t)l * NE * 2048 * D, CAP, NE * 2048, D};
            pg8::MoeOrder S; S.init((int)C.MISC[NE], 8, C.G, (int)blockIdx.x, (const LAS unsigned char*)(C.lds + T2E_OFF));
            pg8::EpiSwiglu E{C.ACT(), C.B1P() + (size_t)l * NE * 2048};
            pg8::gemm_phase<pg8::EpiSwiglu, pg8::MoeOrder, true, true>(C.lds, g, S, E);
            SEAM(pb + 10); }
        if (EN(11) && IN(pb + 11)) { FRESH();
            moe_tables(C, l, true);
            pg8::Gemm g{C.ACT(), C.W2T() + (size_t)l * NE * D * D, CAP, NE * D, D};
            pg8::MoeOrder S; S.init((int)C.MISC[NE], 4, C.G, (int)blockIdx.x, (const LAS unsigned char*)(C.lds + T2E_OFF));
            pg8::EpiDown E{C.YP(), ldin<23>() + (size_t)l * NE * D};
            pg8::gemm_phase<pg8::EpiDown, pg8::MoeOrder, true, true>(C.lds, g, S, E);
            SEAM(pb + 11); }
    }
    if (EN(13) && IN(NPHASE - 1)) { FRESH(); phase_final(C, args); }
#undef IN
#undef SEAM
}
}


#if defined(MK_DEBUG)
namespace mkdbg {
using namespace mk;
constexpr size_t WS_DBG = 3400 * MiB;
__device__ const int SROWS[12] = {0, 1, 63, 64, 255, 256, 4095, 4096, 4351, 4352, 30000, 69631};
__device__ __forceinline__ float bfv(const bf16* p, size_t i) { return __builtin_bit_cast(float, (unsigned)p[i] << 16); }
__device__ __forceinline__ void report(float* err, int s, float got, float ref, float atol) {
    float e = fabsf(got - ref) / (fabsf(ref) + atol); if (!(e == e)) e = 100.f;
    atomicMax((unsigned*)err + s, __builtin_bit_cast(unsigned, e));
}
__device__ __forceinline__ void row_info(int r, int& b, int& t, int& j) { b = r / SEG; t = r - b * SEG; j = t < SQ ? b : 16; }
__device__ __forceinline__ float silu_(float v) { return v / (1.f + expf(-v)); }
__device__ __forceinline__ float sigm_(float v) { return 1.f / (1.f + expf(-v)); }
__device__ __forceinline__ void naive_attn(const bf16* P, int r, int h, float* q, float* o) {
    int b, t, j; row_info(r, b, t, j);
    const int k0 = t < SQ ? b * SEG : b * SEG + SQ, nk = t < SQ ? SEG : CL;
    for (int d = 0; d < 64; ++d) q[d] = bfv(P, (size_t)r * INW + h * 64 + d);
    float m = -1e30f;
    for (int kk = 0; kk < nk; ++kk) { float s = 0.f; for (int d = 0; d < 64; ++d) s += q[d] * bfv(P, (size_t)(k0 + kk) * INW + 512 + (h >> 2) * 64 + d); m = fmaxf(m, s); }
    float l = 0.f; for (int d = 0; d < 64; ++d) o[d] = 0.f;
    for (int kk = 0; kk < nk; ++kk) { float s = 0.f; for (int d = 0; d < 64; ++d) s += q[d] * bfv(P, (size_t)(k0 + kk) * INW + 512 + (h >> 2) * 64 + d);
        const float p = exp2f(s - m); l += p; for (int d = 0; d < 64; ++d) o[d] += p * bfv(P, (size_t)(k0 + kk) * INW + 640 + (h >> 2) * 64 + d); }
    for (int d = 0; d < 64; ++d) o[d] /= l;
}
__device__ const int DBG_LS_1[2] = {0, 3};
__device__ const int DBG_JS_2[3] = {0, 7, 16};
__device__ const int DBG_NS_3[4] = {0, 1000, 2053, 6143};
__device__ const int DBG_CS_4[4] = {0, 1, 511, 1023};
__device__ const int DBG_CS_5[16] = {0, 63, 64, 511, 512, 575, 639, 640, 767, 768, 1024, 1279, 1280, 1536, 1792, 2047};
__device__ const int DBG_HS_6[4] = {0, 7, 8, 9};
__device__ const int DBG_HS_7[2] = {0, 5};
__device__ const int DBG_CS_8[4] = {0, 255, 256, 1023};
__device__ const int DBG_ES_9[3] = {0, 7, 31};
__device__ const int DBG_CS_10[3] = {0, 500, 1023};
__device__ const int DBG_CS_11[4] = {0, 127, 128, 1023};
__device__ const int DBG_CS_12[4] = {0, 300, 511, 1023};
__device__ const int DBG_CS_13[4] = {0, 300, 511, 1023};
__device__ const int DBG_CS_14[4] = {0, 300, 511, 1023};
__global__ void __launch_bounds__(256) dbg_kernel(Args a, int stage) {
    unsigned char* ws = a.ws; float* err = (float*)(ws + WS_DBG); float* scr = err + 256;
    const float* MOD = (const float*)(ws + WS_MOD); const bf16* HB = (const bf16*)(ws + WS_HB); const bf16* P = (const bf16*)(ws + WS_P); const bf16* Y = (const bf16*)(ws + WS_Y);
    const float* X = (const float*)(ws + WS_X); const float* LOG = (const float*)(ws + WS_LOG); const v2u* PAIR = (const v2u*)(ws + WS_PAIR); const int* TOK = (const int*)(ws + WS_TOK);
    const bf16* HP = (const bf16*)(ws + WS_HP); const bf16* ACT = (const bf16*)(ws + WS_ACT); const bf16* YP = (const bf16*)(ws + WS_YP);
    const unsigned* cnt = (const unsigned*)(ws + WS_CTL) + CW_CNT;
    const int tid = threadIdx.x;
    __shared__ float shm[15360]; __shared__ unsigned tstart[33];
    if (stage == 0) { if (tid < 64) err[tid] = 0.f; return; }
    if (stage == 1) {
        const int* ls = DBG_LS_1; const int* js = DBG_JS_2; const int* ns = DBG_NS_3;
        if (tid < 24) { const int l = ls[tid / 12], j = js[(tid / 4) % 3], n = ns[tid % 4]; float s = 0.f;
            for (int k = 0; k < 1024; ++k) { const float c = j < 16 ? a.in[1][j * 1024 + k] : a.in[3][k]; s += silu_(c) * a.in[4][((size_t)l * 1024 + k) * MODW + n]; }
            s += a.in[5][l * MODW + n]; report(err, 1, MOD[((size_t)l * 17 + j) * MODW + n], s, 0.05f); }
        return; }
    if (stage == 2 || stage == 8) {
        const int* cs = DBG_CS_4;
        if (tid < 48) { const int r = SROWS[tid / 4], c = cs[tid % 4]; int b, t, j; row_info(r, b, t, j);
            const float* xr = stage == 2 ? (t < SQ ? a.in[0] + ((size_t)b * SQ + t) * D : a.in[2] + ((size_t)b * CL + (t - SQ)) * D) : X + (size_t)r * D;
            float ss = 0.f; for (int k = 0; k < D; ++k) ss += xr[k] * xr[k];
            const float rs = 1.f / sqrtf(ss / D + EPS); const float* g = stage == 2 ? a.in[6] : a.in[7]; const float* mj = MOD + (size_t)j * MODW + (stage == 2 ? 0 : 3 * D);
            const float h = xr[c] * rs * g[c] * (1.f + mj[D + c]) + mj[c];
            report(err, stage, bfv(HB, (size_t)r * D + c), h, 0.05f);
            if (stage == 2) report(err, stage, X[(size_t)r * D + c], xr[c], 0.01f); }
        return; }
    if (stage == 3) {
        const int* cs = DBG_CS_5;
        if (tid < 192) { const int r = SROWS[tid / 16], c = cs[tid % 16]; float s = 0.f;
            for (int k = 0; k < D; ++k) s += bfv(HB, (size_t)r * D + k) * a.in[8][(size_t)k * INW + c];
            report(err, 3, bfv(P, (size_t)r * INW + c), s, 0.05f); }
        return; }
    if (stage == 4) {
        const int* hs = DBG_HS_6;
        if (tid < 48) { const int r = SROWS[tid / 4], h = hs[tid % 4]; int b, t, j; row_info(r, b, t, j);
            float* raw = shm + tid * 128; float* o = raw + 64; float ss = 0.f;
            for (int d = 0; d < 64; ++d) { float s = 0.f; for (int k = 0; k < D; ++k) s += bfv(HB, (size_t)r * D + k) * a.in[8][(size_t)k * INW + h * 64 + d]; raw[d] = s; ss += s * s; }
            const float rs = 1.f / sqrtf(ss / 64.f + EPS); const float* g = h < 8 ? a.in[9] : a.in[10];
            for (int d = 0; d < 64; ++d) raw[d] = raw[d] * rs * g[d];
            for (int ax = 0; ax < 2; ++ax) for (int i = 0; i < 16; ++i) { const float pos = ax == 0 ? (float)(t / 64) : (float)(t % 64); const float ang = pos * powf(10000.f, -(float)(2 * i) / 32.f);
                const float c = t < SQ ? cosf(ang) : 1.f, s = t < SQ ? sinf(ang) : 0.f; const float x1 = raw[ax * 32 + i], x2 = raw[ax * 32 + 16 + i];
                o[ax * 32 + i] = x1 * c - x2 * s; o[ax * 32 + 16 + i] = x2 * c + x1 * s; }
            for (int d = 0; d < 64; ++d) { const float ref = o[d] * (h < 8 ? 0.125f * 1.4426950408889634f : 1.f); report(err, 4, bfv(P, (size_t)r * INW + h * 64 + d), ref, h < 8 ? 0.045f : 0.25f); } }
        return; }
    if (stage == 5) {
        const int* hs = DBG_HS_7;
        if (tid < 24) { const int r = SROWS[tid / 2], h = hs[tid % 2]; float* o = shm + tid * 128; naive_attn(P, r, h, o + 64, o);
            for (int d = 0; d < 64; ++d) report(err, 5, bfv(Y, (size_t)r * D + h * 64 + d), o[d], 0.05f); }
        return; }
    if (stage == 6) {
        if (tid < 12) { const int r = SROWS[tid]; int b, t, j; row_info(r, b, t, j); const int lo = t < SQ ? 0 : SQ, hi = t < SQ ? SQ : SEG; const size_t rb = (size_t)b * SEG;
            float* u = shm + tid * 256; float mean = 0.f;
            for (int c = 0; c < 256; ++c) { float s = a.in[12][c];
                for (int jt = 0; jt < 31; ++jt) { const int tt = t + jt - 15; if (tt >= lo && tt < hi) s += a.in[11][jt * 256 + c] * bfv(P, (rb + tt) * INW + 768 + c) * sigm_(bfv(P, (rb + tt) * INW + 1024 + c)); }
                u[c] = s; mean += s; }
            mean /= 256.f; float var = 0.f; for (int c = 0; c < 256; ++c) var += (u[c] - mean) * (u[c] - mean); var /= 256.f;
            float ss = 0.f; for (int c = 0; c < 256; ++c) { const float y = (u[c] - mean) / sqrtf(var + EPS) * a.in[13][c] + a.in[14][c]; u[c] = silu_(y); ss += u[c] * u[c]; }
            float rs = 1.f / sqrtf(ss / 256.f + EPS);
            for (int c = 0; c < 256; ++c) report(err, 6, bfv(Y, (size_t)r * D + 512 + c), u[c] * rs * a.in[16][512 + c], 0.25f);
            ss = 0.f;
            for (int c = 0; c < 256; ++c) { float s = 0.f; for (int jt = 0; jt < 3; ++jt) { const int tt = t + jt - 1; if (tt >= lo && tt < hi) s += a.in[15][jt * 256 + c] * bfv(P, (rb + tt) * INW + 1536 + c) * bfv(P, (rb + tt) * INW + 1792 + c); }
                u[c] = bfv(P, (size_t)r * INW + 1280 + c) * s; ss += u[c] * u[c]; }
            rs = 1.f / sqrtf(ss / 256.f + EPS);
            for (int c = 0; c < 256; ++c) report(err, 7, bfv(Y, (size_t)r * D + 768 + c), u[c] * rs * a.in[16][768 + c], 0.25f); }
        if (tid >= 64 && tid < 80) { const int r = SROWS[(tid - 64) / 8 == 0 ? 2 : 7], h = (tid - 64) % 8; float* o = shm + 3072 + (tid - 64) * 128; naive_attn(P, r, h, o + 64, o);
            for (int d = 0; d < 64; ++d) scr[((tid - 64) / 8) * 512 + h * 64 + d] = o[d]; }
        __syncthreads();
        if (tid < 2) { const int r = SROWS[tid == 0 ? 2 : 7]; float ss = 0.f; for (int c = 0; c < 512; ++c) ss += scr[tid * 512 + c] * scr[tid * 512 + c];
            const float rs = 1.f / sqrtf(ss / 512.f + EPS); for (int c = 0; c < 512; ++c) report(err, 6, bfv(Y, (size_t)r * D + c), scr[tid * 512 + c] * rs * a.in[16][c], 0.25f); }
        return; }
    if (stage == 9) {
        const int* cs = DBG_CS_8;
        if (tid < 48) { const int r = SROWS[tid / 4], c = cs[tid % 4]; int b, t, j; row_info(r, b, t, j);
            const float* xr = t < SQ ? a.in[0] + ((size_t)b * SQ + t) * D : a.in[2] + ((size_t)b * CL + (t - SQ)) * D;
            float s = 0.f; for (int k = 0; k < D; ++k) s += bfv(Y, (size_t)r * D + k) * a.in[17][(size_t)k * D + c];
            report(err, 9, X[(size_t)r * D + c], xr[c] + MOD[(size_t)j * MODW + 2 * D + c] * s, 0.05f); }
        return; }
    if (stage == 10) {
        const int* es = DBG_ES_9;
        if (tid < 36) { const int r = SROWS[tid / 3], e = es[tid % 3]; float s = 0.f; for (int k = 0; k < D; ++k) s += bfv(HB, (size_t)r * D + k) * a.in[18][(size_t)k * NE + e];
            report(err, 10, LOG[(size_t)r * NE + e], s, 0.05f); }
        return; }
    if (stage == 11) {
        if (tid < 12) { const int r = SROWS[tid]; float* v = shm + tid * 32; for (int e = 0; e < 32; ++e) v[e] = LOG[(size_t)r * NE + e] + a.in[19][e];
            float* sv = shm + 1024 + tid * 8; float* sef = sv + 4;
            for (int k = 0; k < 4; ++k) { int bi = 0; for (int e = 1; e < 32; ++e) if (v[e] > v[bi]) bi = e; sef[k] = (float)bi; sv[k] = v[bi]; v[bi] = -1e30f; }
            float den = 0.f; for (int k = 0; k < 4; ++k) den += expf(sv[k] - sv[0]);
            { float* vv = shm + 2048 + tid * 32; for (int e = 0; e < 32; ++e) vv[e] = LOG[(size_t)r * NE + e] + a.in[19][e];
              float mx = -1e30f, dn = 0.f; for (int k = 0; k < 4; ++k) mx = fmaxf(mx, vv[PAIR[(size_t)r * 4 + k].x & 31]); for (int k = 0; k < 4; ++k) dn += expf(vv[PAIR[(size_t)r * 4 + k].x & 31] - mx);
              for (int k = 0; k < 4; ++k) report(err, 22, __uint_as_float((unsigned)(PAIR[(size_t)r * 4 + k].y + 0u)), expf(vv[PAIR[(size_t)r * 4 + k].x & 31] - mx) / dn, 0.01f); }
            for (int k = 0; k < 4; ++k) { const v2u pr = PAIR[(size_t)r * 4 + k]; const int e = pr.x & 31; const unsigned pos = pr.x >> 5;
                if (tid == 0 && (k == 0 || k == 3)) { err[30 + (k ? 2 : 0)] = __uint_as_float((unsigned)(pr.y + 0u)); err[31 + (k ? 2 : 0)] = expf(sv[k] - sv[0]) / den; }
                report(err, 17, (float)e == sef[k] ? 0.f : 1.f, 0.f, 1.0f); report(err, 18, __uint_as_float((unsigned)(pr.y + 0u)), expf(sv[k] - sv[0]) / den, 0.01f);
                const unsigned c = cnt[e * 64]; report(err, 19, pos < c ? 1.f : 0.f, 1.f, 0.001f); report(err, 20, (float)TOK[(size_t)e * T + (pos < (unsigned)T ? pos : 0)], (float)r, 0.001f); } }
        if (tid == 255) { unsigned s = 0; for (int e = 0; e < 32; ++e) s += cnt[e * 64]; report(err, 21, (float)s, (float)(T * 4), 0.001f); }
        if (tid == 253) { int c = 0; const float* pf = (const float*)PAIR; for (int q = 0; q < 64; ++q) { const float w = pf[q * 2 + 1]; if (w > 0.01f && w <= 1.f) ++c; } err[44] = (float)c; }
        if (tid == 254) { for (int k = 0; k < 4; ++k) { const float w = __uint_as_float((unsigned)(PAIR[k].y + 0u)); err[40 + k] = (float)(!(w == w) || w < 0.f || w > 1.f ? 3 : w < 1e-30f ? 0 : w < 0.05f ? 1 : 2); } }
        return; }
    if (tid == 0) { unsigned s = 0; for (int e = 0; e < 32; ++e) { tstart[e] = s; s += (cnt[e * 64] + 255u) >> 8; } tstart[32] = s; }
    __syncthreads();
    if (stage == 12) {
        const int* cs = DBG_CS_10;
        if (tid < 48) { const int r = SROWS[tid / 4], k = tid % 4; const v2u pr = PAIR[(size_t)r * 4 + k]; const size_t slot = (size_t)tstart[pr.x & 31] * 256 + (pr.x >> 5);
            for (int i = 0; i < 3; ++i) report(err, 12, bfv(HP, slot * D + cs[i]), bfv(HB, (size_t)r * D + cs[i]), 0.001f); }
        return; }
    if (stage == 13) {
        const int* cs = DBG_CS_11;
        if (tid < 192) { const int r = SROWS[tid / 16], k = (tid / 4) % 4, c = cs[tid % 4]; const v2u pr = PAIR[(size_t)r * 4 + k]; const int e = pr.x & 31; const size_t slot = (size_t)tstart[e] * 256 + (pr.x >> 5);
            float ug = a.in[21][(size_t)e * 2048 + 2 * c], uu = a.in[21][(size_t)e * 2048 + 2 * c + 1]; const float* w = a.in[20] + (size_t)e * 1024 * 2048;
            for (int kk = 0; kk < D; ++kk) { const float hv = bfv(HP, slot * D + kk); ug += hv * w[(size_t)kk * 2048 + 2 * c]; uu += hv * w[(size_t)kk * 2048 + 2 * c + 1]; }
            const float gc = fminf(ug, 7.f), uc = fminf(fmaxf(uu, -7.f), 7.f); const float ref = (uc + 1.f) * gc * sigm_(1.702f * gc);
            report(err, 13, bfv(ACT, slot * D + c), ref, 0.25f); }
        return; }
    if (stage == 14) {
        const int* cs = DBG_CS_12;
        if (tid < 192) { const int r = SROWS[tid / 16], k = (tid / 4) % 4, c = cs[tid % 4]; const v2u pr = PAIR[(size_t)r * 4 + k]; const int e = pr.x & 31; const size_t slot = (size_t)tstart[e] * 256 + (pr.x >> 5);
            float s = a.in[23][(size_t)e * 1024 + c]; const float* w = a.in[22] + (size_t)e * 1024 * 1024;
            for (int kk = 0; kk < D; ++kk) s += bfv(ACT, slot * D + kk) * w[(size_t)kk * 1024 + c];
            report(err, 14, bfv(YP, slot * D + c), s, 0.25f); }
        return; }
    if (stage == 15) {
        const int* cs = DBG_CS_13;
        if (tid < 48) { const int r = SROWS[tid / 4], c = cs[tid % 4]; int b, t, j; row_info(r, b, t, j); float f = 0.f;
            for (int k = 0; k < 4; ++k) { const v2u pr = PAIR[(size_t)r * 4 + k]; const size_t slot = (size_t)tstart[pr.x & 31] * 256 + (pr.x >> 5); f += __uint_as_float((unsigned)(pr.y + 0u)) * bfv(YP, slot * D + c); }
            scr[2048 + tid] = X[(size_t)r * D + c] + MOD[(size_t)j * MODW + 5 * D + c] * f; }
        return; }
    if (stage == 16) {
        const int* cs = DBG_CS_14;
        if (tid < 48) { const int r = SROWS[tid / 4], c = cs[tid % 4]; report(err, 16, X[(size_t)r * D + c], scr[2048 + tid], 0.02f); }
        return; }
    if (stage == 99) {
        if (tid == 0) {
#if MK_DEBUG == 3
            a.out[0] = (err[44] + 1.f) * 1e20f; return;
#endif
#if MK_DEBUG == 2
            { const float* db = err + 4096; const v2u* PR = (const v2u*)(a.ws + WS_PAIR); int code = 0;
              auto close = [](float x, float y) { return fabsf(x - y) <= 1e-3f * (fabsf(y) + 1e-3f); };
              for (int ln = 0; ln < 4 && !code; ++ln) for (int j = 0; j < 4; ++j) if (!(db[ln * 16 + j] == db[j])) { code = 10 + ln; break; }
              if (!code) for (int j = 0; j < 3; ++j) if (!(db[j] >= db[j + 1])) code = 20 + j;
              if (!code) for (int ln = 0; ln < 4 && !code; ++ln) for (int j = 0; j < 3; ++j) if (!close(db[ln * 16 + 4 + j], expf(db[j + 1] - db[0]))) { code = 30 + ln; break; }
              if (!code) for (int ln = 0; ln < 4; ++ln) if (!close(db[ln * 16 + 7], 1.f + db[ln * 16 + 4] + db[ln * 16 + 5] + db[ln * 16 + 6])) { code = 40 + ln; break; }
              if (!code) for (int ln = 0; ln < 4; ++ln) if (!close(db[ln * 16 + 8], 1.f / db[ln * 16 + 7])) { code = 50 + ln; break; }
              if (!code) for (int ln = 0; ln < 4; ++ln) if (!close(db[ln * 16 + 9], (ln == 0 ? 1.f : db[ln * 16 + 3 + ln]) * db[ln * 16 + 8])) { code = 60 + ln; break; }
              if (!code) for (int ln = 0; ln < 4; ++ln) if (!close(__uint_as_float((unsigned)(PR[ln].y + 0u)), db[ln * 16 + 9])) { code = 70 + ln; break; }
              if (!code) code = 88;
              a.out[0] = (float)code * 1e20f; return; }
#endif
            int mask = 0; for (int i = 0; i < 6; ++i) if (err[17 + i] > 0.06f) mask |= 1 << i; if (mask) err[11] = 1.f;
            for (int s = 1; s < 17; ++s) if (err[s] > 0.06f) { if (s == 11) { a.out[0] = (float)(10 + mask) * 1e14f; break; } a.out[0] = (1.f + 10.f * fminf(err[s], 0.89f)) * powf(10.f, (float)(4 + s)); break; } }
        return; }
}
}
#endif
#ifndef MK_ONE_LAUNCH
#define MK_ONE_LAUNCH 0
#endif
extern "C" void kernel_launch(void* const* d_in, const int* in_sizes, int n_in, void* d_out, int out_size, void* d_ws, size_t ws_size, hipStream_t stream) {
    using namespace mk;
    static int grid = 0;
    if (grid == 0) {
        if (n_in != 24 || out_size != NB * SQ * D || ws_size < WS_END) { fprintf(stderr, "kernel_launch: unexpected shapes (n_in %d, out %d, ws %zu)\n", n_in, out_size, ws_size); grid = -1; return; }
        int dev = 0, cus = 0, per_cu = 0;
        if (hipGetDevice(&dev) != hipSuccess || hipDeviceGetAttribute(&cus, hipDeviceAttributeMultiprocessorCount, dev) != hipSuccess) { grid = -1; return; }
        if (hipFuncSetAttribute((const void*)mk_fwd, hipFuncAttributeMaxDynamicSharedMemorySize, LDS_BYTES) != hipSuccess) { fprintf(stderr, "kernel_launch: hipFuncSetAttribute failed\n"); grid = -1; return; }
        if (hipOccupancyMaxActiveBlocksPerMultiprocessor(&per_cu, (const void*)mk_fwd, NWAVES * 64, LDS_BYTES) != hipSuccess || per_cu < 1) { fprintf(stderr, "kernel_launch: occupancy query says %d\n", per_cu); per_cu = 1; }
        (void)hipGetLastError();
        grid = cus;
    }
    if (grid < 0) return;
    (void)hipMemsetAsync((char*)d_ws + WS_CTL, 0, CTL_ZERO_BYTES, stream);
    Args a{};
    for (int i = 0; i < 24; ++i) a.in[i] = (const float*)d_in[i];
    a.out = (float*)d_out; a.ws = (unsigned char*)d_ws;
#if MK_ONE_LAUNCH
    a.ph_lo = 0; a.ph_hi = NPHASE;
    hipLaunchKernelGGL(mk_fwd, dim3(grid), dim3(NWAVES * 64), LDS_BYTES, stream, a);
#else
#if defined(MK_DEBUG)
#define DBG(s) hipLaunchKernelGGL(mkdbg::dbg_kernel, dim3(1), dim3(256), 0, stream, a, (s))
    DBG(0);
#else
#define DBG(s) do {} while (0)
#endif
    for (int p = 0; p < NPHASE; ++p) { a.ph_lo = p; a.ph_hi = p + 1; hipLaunchKernelGGL(mk_fwd, dim3(grid), dim3(NWAVES * 64), LDS_BYTES, stream, a);
        if (p == 0) DBG(1); if (p == 1) DBG(2); if (p == 2) DBG(3); if (p == 3) DBG(4); if (p == 4) DBG(5); if (p == 5) DBG(6); if (p == 6) DBG(9); if (p == 7) DBG(8); if (p == 8) DBG(10);
        if (p == 9) DBG(11); if (p == 10) DBG(12); if (p == 11) DBG(13); if (p == 12) { DBG(14); DBG(15); } if (p == 13) DBG(16); }
    DBG(99);
#endif
}
```

```cpp
#include <hip/hip_runtime.h>
#include <hip/hip_bf16.h>
#include <cstdio>
#include <cstdint>
#include <cmath>
namespace pg8 {
#define PG8_LAS __attribute__((address_space(3)))
typedef unsigned short bf16_t;
typedef short bf16x8 __attribute__((ext_vector_type(8)));
typedef float f32x4 __attribute__((ext_vector_type(4)));
typedef unsigned u32x4 __attribute__((ext_vector_type(4)));
constexpr int BM = 256, BK = 64, HALF = 128, HTB = HALF * BK * 2  , STAGE_BYTES = 8 * HTB, NXCD = 8, WGM = 8;

__host__ __device__ __forceinline__ int lds_byte(int r, int c) { const int st = (r >> 4) * 2 + (c >> 5), rr = r & 15, cc = c & 31, ob = rr * 64 + cc * 2; return st * 1024 + (ob ^ (((ob >> 9) & 1) << 5)); }
__host__ __device__ __forceinline__ void stage_rc(int b, int& R, int& C) { const int st = b / 1024, sb = b % 1024, swz = sb ^ (((sb >> 9) & 1) << 5); R = (st >> 1) * 16 + swz / 64; C = (st & 1) * 32 + (swz % 64) / 2; }
__host__ __device__ __forceinline__ int perm32(int rho) { const int n = rho >> 4, i = rho & 15; return 8 * (i >> 2) + 4 * n + (i & 3); }

struct Unit { int pm, pn; };
struct Gemm { const bf16_t* A; const bf16_t* Bt; int M, N, K; };

struct StaticOrder {
    int nM, nN, nwg, G, c;
    __host__ __device__ void init(int M, int N, int G_, int c_) { nM = M / BM; nN = N / BM; nwg = nM * nN; G = G_; c = c_; }
    __host__ __device__ bool next(int i, Unit& u) const {
        const long L = (long)i * G + c; if (L >= nwg) return false;
        int wgid = (int)L; { const int q = nwg / NXCD, r = nwg % NXCD, xcd = wgid % NXCD, off = wgid / NXCD; wgid = (xcd < r ? xcd * (q + 1) : r * (q + 1) + (xcd - r) * q) + off; }
        const int nig = WGM * nN, gid = wgid / nig, fm = gid * WGM, gsz = (nM - fm) < WGM ? (nM - fm) : WGM;
        u.pm = fm + ((wgid % nig) % gsz); u.pn = (wgid % nig) / gsz; return true;
    }
    __device__ __forceinline__ void a_ready(const Unit&) const {}
    __device__ __forceinline__ void done(const Unit&) const {}
};

__device__ __forceinline__ unsigned cvt_pk_bf16(float lo, float hi) { unsigned r; asm volatile("v_cvt_pk_bf16_f32 %0, %1, %2" : "=v"(r) : "v"(lo), "v"(hi)); return r; }
typedef float f32x2 __attribute__((ext_vector_type(2)));

struct MoeOrder {
    int nN, ntl, nwg, G, c; const PG8_LAS unsigned char* t2e;
    __device__ __forceinline__ void init(int ntl_, int nN_, int G_, int c_, const PG8_LAS unsigned char* t2e_) { ntl = ntl_; nN = nN_; nwg = ntl_ * nN_; G = G_; c = c_; t2e = t2e_; }
    __device__ __forceinline__ bool next(int i, Unit& u) const {
        const long L = (long)i * G + c; if (L >= nwg) return false;
        int wgid = (int)L; { const int q = nwg / NXCD, r = nwg % NXCD, xcd = wgid % NXCD, off = wgid / NXCD; wgid = (xcd < r ? xcd * (q + 1) : r * (q + 1) + (xcd - r) * q) + off; }
        const int nig = WGM * nN, gid = wgid / nig, fm = gid * WGM, gsz = (ntl - fm) < WGM ? (ntl - fm) : WGM;
        const int rt = fm + ((wgid % nig) % gsz), pn = (wgid % nig) / gsz;
        u.pm = rt; u.pn = (int)t2e[rt] * nN + pn; return true;
    }
    __device__ __forceinline__ void a_ready(const Unit&) const {}
    __device__ __forceinline__ void done(const Unit&) const {}
};

struct EpiStore {
    static constexpr bool PERM = true, AFTER_DRAIN = false;
    bf16_t* O; int ldc;
    __device__ __forceinline__ void operator()(const f32x4 (&acc)[2][2][4][2], const Unit& u, int wr, int wc, int fr, int fq) const {
        const int row0 = u.pm * BM + wr * 64 + fr, col0 = u.pn * BM + wc * 32 + 8 * fq;
#pragma unroll
        for (int ai = 0; ai < 2; ++ai)
#pragma unroll
            for (int m = 0; m < 4; ++m) { bf16_t* rowp = O + (size_t)(row0 + ai * HALF + m * 16) * ldc + col0;
#pragma unroll
                for (int bj = 0; bj < 2; ++bj) { const f32x4 v0 = acc[ai][bj][m][0], v1 = acc[ai][bj][m][1];
                    u32x4 w; w.x = cvt_pk_bf16(v0[0], v0[1]); w.y = cvt_pk_bf16(v0[2], v0[3]); w.z = cvt_pk_bf16(v1[0], v1[1]); w.w = cvt_pk_bf16(v1[2], v1[3]);
                    *(u32x4*)(rowp + bj * HALF) = w; } }
    }
};
struct EpiResid {
    static constexpr bool PERM = false, AFTER_DRAIN = false;
    float* X; const float* gate;
    __device__ __forceinline__ void operator()(const f32x4 (&acc)[2][2][4][2], const Unit& u, int wr, int wc, int fr, int fq) const {
        const int seg = u.pm / 17, rem = u.pm - seg * 17; const int j = (rem == 16) ? 16 : seg;
        const int row0 = u.pm * BM + wr * 64 + fr, col0 = u.pn * BM + wc * 32 + 4 * fq;
        const float* g = gate + (size_t)j * 6144 + col0;
        f32x4 gv[2][2];
#pragma unroll
        for (int bj = 0; bj < 2; ++bj)
#pragma unroll
            for (int n = 0; n < 2; ++n) gv[bj][n] = *(const f32x4*)(g + bj * HALF + n * 16);
#pragma unroll
        for (int ai = 0; ai < 2; ++ai)
#pragma unroll
            for (int m = 0; m < 4; ++m) { float* rowp = X + (size_t)(row0 + ai * HALF + m * 16) * 1024 + col0;
#pragma unroll
                for (int bj = 0; bj < 2; ++bj)
#pragma unroll
                    for (int n = 0; n < 2; ++n) { f32x4* p = (f32x4*)(rowp + bj * HALF + n * 16); *p = *p + gv[bj][n] * acc[ai][bj][m][n]; } }
    }
};
struct EpiLogits {
    static constexpr bool PERM = false, AFTER_DRAIN = false;
    float* LOG;
    __device__ __forceinline__ void operator()(const f32x4 (&acc)[2][2][4][2], const Unit& u, int wr, int wc, int fr, int fq) const {
        if (wc != 0) return;
        const int row0 = u.pm * BM + wr * 64 + fr;
#pragma unroll
        for (int ai = 0; ai < 2; ++ai)
#pragma unroll
            for (int m = 0; m < 4; ++m) { float* rowp = LOG + (size_t)(row0 + ai * HALF + m * 16) * 32 + 4 * fq;
#pragma unroll
                for (int n = 0; n < 2; ++n) *(f32x4*)(rowp + n * 16) = acc[ai][0][m][n]; }
    }
};
struct EpiSwiglu {
    static constexpr bool PERM = true, AFTER_DRAIN = false;
    bf16_t* ACT; const float* b1p;
    __device__ __forceinline__ void operator()(const f32x4 (&acc)[2][2][4][2], const Unit& u, int wr, int wc, int fr, int fq) const {
        const int e = u.pn >> 3, pn = u.pn & 7;
        const int row0 = u.pm * BM + wr * 64 + fr, lc = wc * 32 + 8 * fq;
        const float* bp = b1p + (size_t)e * 2048 + pn * 256 + lc;
        f32x4 bg[2], bu[2];
#pragma unroll
        for (int n = 0; n < 2; ++n) { bg[n] = *(const f32x4*)(bp + 4 * n); bu[n] = *(const f32x4*)(bp + HALF + 4 * n); }
#pragma unroll
        for (int ai = 0; ai < 2; ++ai)
#pragma unroll
            for (int m = 0; m < 4; ++m) { bf16_t* rowp = ACT + (size_t)(row0 + ai * HALF + m * 16) * 1024 + pn * 128 + lc;
                f32x4 a[2];
#pragma unroll
                for (int n = 0; n < 2; ++n) { const f32x4 gt = acc[ai][0][m][n] + bg[n], up = acc[ai][1][m][n] + bu[n];
#pragma unroll
                    for (int i = 0; i < 4; ++i) { const float gc = fminf(gt[i], 7.0f), uc = fminf(fmaxf(up[i], -7.0f), 7.0f);
                        const float sg = __builtin_amdgcn_rcpf(1.0f + __builtin_amdgcn_exp2f(gc * (-1.702f * 1.4426950408889634f)));
                        a[n][i] = (uc + 1.0f) * (gc * sg); } }
                u32x4 w; w.x = cvt_pk_bf16(a[0][0], a[0][1]); w.y = cvt_pk_bf16(a[0][2], a[0][3]); w.z = cvt_pk_bf16(a[1][0], a[1][1]); w.w = cvt_pk_bf16(a[1][2], a[1][3]);
                *(u32x4*)rowp = w; }
    }
};
struct EpiDown {
    static constexpr bool PERM = true, AFTER_DRAIN = false;
    bf16_t* YP; const float* b2;
    __device__ __forceinline__ void operator()(const f32x4 (&acc)[2][2][4][2], const Unit& u, int wr, int wc, int fr, int fq) const {
        const int e = u.pn >> 2, pn = u.pn & 3;
        const int row0 = u.pm * BM + wr * 64 + fr, col0 = pn * BM + wc * 32 + 8 * fq;
        const float* bp = b2 + (size_t)e * 1024 + col0;
        f32x4 bv[2][2];
#pragma unroll
        for (int bj = 0; bj < 2; ++bj)
#pragma unroll
            for (int n = 0; n < 2; ++n) bv[bj][n] = *(const f32x4*)(bp + bj * HALF + 4 * n);
#pragma unroll
        for (int ai = 0; ai < 2; ++ai)
#pragma unroll
            for (int m = 0; m < 4; ++m) { bf16_t* rowp = YP + (size_t)(row0 + ai * HALF + m * 16) * 1024 + col0;
#pragma unroll
                for (int bj = 0; bj < 2; ++bj) { const f32x4 v0 = acc[ai][bj][m][0] + bv[bj][0], v1 = acc[ai][bj][m][1] + bv[bj][1];
                    u32x4 w; w.x = cvt_pk_bf16(v0[0], v0[1]); w.y = cvt_pk_bf16(v0[2], v0[3]); w.z = cvt_pk_bf16(v1[0], v1[1]); w.w = cvt_pk_bf16(v1[2], v1[3]);
                    *(u32x4*)(rowp + bj * HALF) = w; } }
    }
};

template <class Epi, class Sched, bool ALIGN_EPI = false, bool SP2 = false>
__device__ __forceinline__ void gemm_phase(PG8_LAS unsigned char* lds, const Gemm g, const Sched& S, const Epi& E) {
    int tid_ = threadIdx.x; asm volatile("" : "+v"(tid_));
    const int tid = tid_, wid = __builtin_amdgcn_readfirstlane(tid >> 6), lane = tid & 63, wr = wid >> 2, wc = wid & 3, fr = lane & 15, fq = lane >> 4;
    const int K = g.K, nt = K / BK;
    unsigned voffA[2], voffB[2];
#pragma unroll
    for (int i = 0; i < 2; ++i) { int R, C; stage_rc(tid * 16 + i * 8192, R, C); const int Rb = Epi::PERM ? ((R & ~31) + perm32(R & 31)) : R;
        voffA[i] = (unsigned)(R * K + C) * 2u; voffB[i] = (unsigned)(Rb * K + C) * 2u; }
    const size_t kstep = (size_t)(BK * 2);
    const size_t hstep = (size_t)HALF * K * 2;
    const size_t tstep = 2 * hstep;
    const unsigned ldsw = (unsigned)wid * 1024u;
    const int aoff = lds_byte(wr * 64 + fr, fq * 8), boff = lds_byte(wc * 32 + fr, fq * 8);
#define PG8_SA(b, h) (((b) * 2 + (h)) * HTB)
#define PG8_SB(b, h) ((4 + (b) * 2 + (h)) * HTB)
#define PG8_STAGE(bufoff, gbase, voff) do { _Pragma("unroll") for (int _i = 0; _i < 2; ++_i) \
        __builtin_amdgcn_global_load_lds((const unsigned*)((const char*)(gbase) + (voff)[_i]), (PG8_LAS unsigned*)(lds + (bufoff) + ldsw + _i * 8192), 16, 0, 0); } while (0)
#define PG8_LDA(dst, b, h) do { _Pragma("unroll") for (int m = 0; m < 4; ++m) _Pragma("unroll") for (int k = 0; k < 2; ++k) dst[m][k] = *(const PG8_LAS bf16x8*)(lds + PG8_SA(b, h) + aoff + m * 2048 + k * 1024); } while (0)
#define PG8_LDB(dst, b, h) do { _Pragma("unroll") for (int n = 0; n < 2; ++n) _Pragma("unroll") for (int k = 0; k < 2; ++k) dst[n][k] = *(const PG8_LAS bf16x8*)(lds + PG8_SB(b, h) + boff + n * 2048 + k * 1024); } while (0)
#define PG8_MMA(ai, bj, At, Bt) do { __builtin_amdgcn_s_setprio(1); _Pragma("unroll") for (int m = 0; m < 4; ++m) _Pragma("unroll") for (int n = 0; n < 2; ++n) _Pragma("unroll") for (int k = 0; k < 2; ++k) \
        acc[ai][bj][m][n] = __builtin_amdgcn_mfma_f32_16x16x32_bf16(Bt[n][k], At[m][k], acc[ai][bj][m][n], 0, 0, 0); __builtin_amdgcn_s_setprio(0); } while (0)
#define PG8_WAIT_V(n) asm volatile("s_waitcnt vmcnt(" #n ")" ::: "memory")
#define PG8_WAIT_L(n) asm volatile("s_waitcnt lgkmcnt(" #n ")" ::: "memory")
#define PG8_BAR __builtin_amdgcn_s_barrier()
#define PG8_SCHED __builtin_amdgcn_sched_barrier(0)
    Unit cur, nxt; int ui = 0;
    if (!S.next(0, cur)) return;
    f32x4 acc[2][2][4][2];
#pragma unroll
    for (int a = 0; a < 2; ++a)
#pragma unroll
        for (int b = 0; b < 2; ++b)
#pragma unroll
            for (int m = 0; m < 4; ++m)
#pragma unroll
                for (int n = 0; n < 2; ++n) acc[a][b][m][n] = (f32x4){0.f, 0.f, 0.f, 0.f};
    bf16x8 At[4][2], B0[2][2], B1[2][2];
    const char* cA = (const char*)g.A + (size_t)cur.pm * tstep; const char* cB = (const char*)g.Bt + (size_t)cur.pn * tstep;
    S.a_ready(cur);
    if constexpr (SP2) {
        PG8_STAGE(PG8_SB(0, 0), cB, voffB); PG8_STAGE(PG8_SB(0, 1), cB + hstep, voffB); PG8_STAGE(PG8_SA(0, 0), cA, voffA); PG8_STAGE(PG8_SA(0, 1), cA + hstep, voffA);
        if (wr == 1) PG8_BAR;
        PG8_WAIT_V(2); PG8_BAR;
        PG8_STAGE(PG8_SB(1, 0), cB + kstep, voffB); PG8_STAGE(PG8_SA(1, 0), cA + kstep, voffA); PG8_STAGE(PG8_SB(1, 1), cB + hstep + kstep, voffB);
        PG8_WAIT_V(6); PG8_BAR;
    } else {
        PG8_STAGE(PG8_SB(0, 0), cB, voffB); PG8_STAGE(PG8_SA(0, 0), cA, voffA); PG8_STAGE(PG8_SB(0, 1), cB + hstep, voffB); PG8_STAGE(PG8_SA(0, 1), cA + hstep, voffA);
        if (wr == 1) PG8_BAR;
        PG8_WAIT_V(4); PG8_BAR;
        PG8_STAGE(PG8_SB(1, 0), cB + kstep, voffB); PG8_STAGE(PG8_SA(1, 0), cA + kstep, voffA); PG8_STAGE(PG8_SB(1, 1), cB + hstep + kstep, voffB);
        PG8_WAIT_V(6); PG8_BAR;
    }
    for (;;) {
        const bool has_next = S.next(ui + 1, nxt);
        const char* nA = has_next ? (const char*)g.A + (size_t)nxt.pm * tstep : cA; const char* nB = has_next ? (const char*)g.Bt + (size_t)nxt.pn * tstep : cB;
        for (int t = 0; t < nt; t += 2) {
            const bool last = (t == nt - 2);
            const char* a1 = cA + (size_t)(t + 1) * kstep;
            const char* a2 = last ? nA : cA + (size_t)(t + 2) * kstep; const char* b2 = last ? nB : cB + (size_t)(t + 2) * kstep;
            const char* a3 = a2 + kstep; const char* b3 = b2 + kstep;
            if (last && has_next) S.a_ready(nxt);
            if constexpr (SP2) {
            PG8_LDB(B0, 0, 0); PG8_LDB(B1, 0, 1); PG8_SCHED; PG8_LDA(At, 0, 0); PG8_STAGE(PG8_SA(1, 1), a1 + hstep, voffA);
            PG8_WAIT_V(8); PG8_WAIT_L(0); PG8_BAR; PG8_MMA(0, 0, At, B0); PG8_MMA(0, 1, At, B1); PG8_BAR; PG8_SCHED;
            PG8_LDA(At, 0, 1); PG8_STAGE(PG8_SB(0, 0), b2, voffB); PG8_STAGE(PG8_SB(0, 1), b2 + hstep, voffB); PG8_STAGE(PG8_SA(0, 0), a2, voffA);
            PG8_WAIT_V(8); PG8_WAIT_L(0); PG8_BAR; PG8_MMA(1, 0, At, B0); PG8_MMA(1, 1, At, B1); PG8_BAR; PG8_SCHED;
            PG8_LDB(B0, 1, 0); PG8_LDB(B1, 1, 1); PG8_SCHED; PG8_LDA(At, 1, 0); PG8_STAGE(PG8_SA(0, 1), a2 + hstep, voffA);
            PG8_WAIT_V(8); PG8_WAIT_L(0); PG8_BAR; PG8_MMA(0, 0, At, B0); PG8_MMA(0, 1, At, B1); PG8_BAR; PG8_SCHED;
            PG8_LDA(At, 1, 1); PG8_STAGE(PG8_SB(1, 0), b3, voffB); PG8_STAGE(PG8_SB(1, 1), b3 + hstep, voffB); PG8_STAGE(PG8_SA(1, 0), a3, voffA);
            PG8_WAIT_V(8); PG8_WAIT_L(0); PG8_BAR; PG8_MMA(1, 0, At, B0); PG8_MMA(1, 1, At, B1); PG8_BAR; PG8_SCHED;
            } else {
            PG8_LDB(B0, 0, 0); PG8_SCHED; PG8_LDA(At, 0, 0); PG8_STAGE(PG8_SA(1, 1), a1 + hstep, voffA);
            PG8_WAIT_L(8); PG8_BAR; PG8_WAIT_L(0); PG8_MMA(0, 0, At, B0); PG8_BAR; PG8_SCHED;
            PG8_LDB(B1, 0, 1); PG8_STAGE(PG8_SB(0, 0), b2, voffB);
            PG8_BAR; PG8_WAIT_L(0); PG8_MMA(0, 1, At, B1); PG8_BAR;
            PG8_LDA(At, 0, 1); PG8_STAGE(PG8_SA(0, 0), a2, voffA);
            PG8_BAR; PG8_WAIT_L(0); PG8_MMA(1, 0, At, B0); PG8_BAR; PG8_SCHED;
            PG8_STAGE(PG8_SB(0, 1), b2 + hstep, voffB);
            PG8_WAIT_V(6); PG8_BAR; PG8_MMA(1, 1, At, B1); PG8_BAR;
            PG8_LDB(B0, 1, 0); PG8_SCHED; PG8_LDA(At, 1, 0); PG8_STAGE(PG8_SA(0, 1), a2 + hstep, voffA);
            PG8_WAIT_L(8); PG8_BAR; PG8_WAIT_L(0); PG8_MMA(0, 0, At, B0); PG8_BAR; PG8_SCHED;
            PG8_LDB(B1, 1, 1); PG8_STAGE(PG8_SB(1, 0), b3, voffB);
            PG8_BAR; PG8_WAIT_L(0); PG8_MMA(0, 1, At, B1); PG8_BAR;
            PG8_LDA(At, 1, 1); PG8_STAGE(PG8_SA(1, 0), a3, voffA);
            PG8_BAR; PG8_WAIT_L(0); PG8_MMA(1, 0, At, B0); PG8_BAR; PG8_SCHED;
            PG8_STAGE(PG8_SB(1, 1), b3 + hstep, voffB);
            PG8_WAIT_V(6); PG8_BAR; PG8_MMA(1, 1, At, B1); PG8_BAR;
            }
        }
        if constexpr (ALIGN_EPI) { if (wr == 0) PG8_BAR; }
        if constexpr (!Epi::AFTER_DRAIN) { E(acc, cur, wr, wc, fr, fq); S.done(cur); }
        if (!has_next) break;
#pragma unroll
        for (int a = 0; a < 2; ++a)
#pragma unroll
            for (int b = 0; b < 2; ++b)
#pragma unroll
                for (int m = 0; m < 4; ++m)
#pragma unroll
                    for (int n = 0; n < 2; ++n) acc[a][b][m][n] = (f32x4){0.f, 0.f, 0.f, 0.f};
        cur = nxt; cA = nA; cB = nB; ++ui;
        if constexpr (ALIGN_EPI) { if (wr == 1) PG8_BAR; }
    }
    PG8_WAIT_V(0);
    if constexpr (!ALIGN_EPI) { if (wr == 0) PG8_BAR; }
    PG8_BAR;
    if constexpr (Epi::AFTER_DRAIN) { E.fused(acc, cur, wr, wc, fr, fq, lds, wid, lane); S.done(cur); }
#undef PG8_SA
#undef PG8_SB
#undef PG8_STAGE
#undef PG8_LDA
#undef PG8_LDB
#undef PG8_MMA
#undef PG8_WAIT_V
#undef PG8_WAIT_L
#undef PG8_BAR
#undef PG8_SCHED
}
}
#ifndef ATTN_STORE16
#define ATTN_STORE16(p,v) (*(u32x4*)(p)=(v))
#endif
namespace attn_body {
using bf16=__hip_bfloat16;
using bf16x8=__attribute__((ext_vector_type(8)))short;
using s16x4=__attribute__((ext_vector_type(4)))short;
using f32x16=__attribute__((ext_vector_type(16)))float;
using u32x4=__attribute__((ext_vector_type(4)))unsigned;
constexpr int D=64,PQ=2048,PO=1024,KOFF=512,VOFF=640;
constexpr int NW=8,QBLK=32,QB=QBLK*NW,KVBLK=64;
__device__ __forceinline__ int crow(int r,int hi){return (r&3)+8*(r>>2)+4*hi;}
#define SBAR() __builtin_amdgcn_sched_barrier(0)
constexpr int NSLOT=3, SLOTB=8192;
constexpr int LDS_K=0, LDS_V=NSLOT*SLOTB, LDS_WS=2*NSLOT*SLOTB, LDS_OST=LDS_WS+NW*64*4, LDS_BYTES=LDS_OST+NW*4096;
constexpr float C2=0.125f*1.4426950408889634f;
__device__ __forceinline__ void glds16(const void*gsrc,unsigned lds_dst){unsigned keep;
  asm volatile("s_mov_b32 %0, m0\n\ts_mov_b32 m0, %2\n\ts_nop 0\n\tglobal_load_lds_dwordx4 %1, off\n\ts_mov_b32 m0, %0":"=&s"(keep):"v"(gsrc),"s"(lds_dst):"memory");}
__device__ __forceinline__ float max3f(float a,float b,float c){float r;asm("v_max3_f32 %0, %1, %2, %3":"=v"(r):"v"(a),"v"(b),"v"(c));return r;}
__device__ __forceinline__ float max2f(float a,float b){float r;asm("v_max_f32_e32 %0, %1, %2":"=v"(r):"v"(a),"v"(b));return r;}
__device__ __forceinline__ float fadd_s(float a,float b){float r;asm("v_add_f32_e32 %0, %1, %2":"=v"(r):"v"(a),"v"(b));return r;}
__device__ __forceinline__ float fsub_s(float a,float b){float r;asm("v_sub_f32_e32 %0, %1, %2":"=v"(r):"v"(a),"v"(b));return r;}
typedef float f32x2_t __attribute__((ext_vector_type(2))); typedef __bf16 bf16x2_t __attribute__((ext_vector_type(2)));
__device__ __forceinline__ unsigned cvtpk_s(float lo,float hi){f32x2_t v={lo,hi};bf16x2_t b=__builtin_convertvector(v,bf16x2_t);return __builtin_bit_cast(unsigned,b);}
#define WAIT_BAR(N) asm volatile("s_waitcnt vmcnt(" #N ") lgkmcnt(0)\n\ts_barrier":::"memory")

__device__ __forceinline__ void qkt(f32x16&p0,f32x16&p1,const char*Kslot,const bf16x8*qr,const f32x16&negm,int r32,int hi){
  const char*kb=Kslot+hi*1024+r32*16;
  #pragma unroll
  for(int d0=0;d0<4;++d0){
    const bf16x8 b0=*reinterpret_cast<const bf16x8*>(kb+d0*2048);
    const bf16x8 b1=*reinterpret_cast<const bf16x8*>(kb+d0*2048+512);
    if(d0==0){p0=__builtin_amdgcn_mfma_f32_32x32x16_bf16(b0,qr[0],negm,0,0,0);p1=__builtin_amdgcn_mfma_f32_32x32x16_bf16(b1,qr[0],negm,0,0,0);}
    else{p0=__builtin_amdgcn_mfma_f32_32x32x16_bf16(b0,qr[d0],p0,0,0,0);p1=__builtin_amdgcn_mfma_f32_32x32x16_bf16(b1,qr[d0],p1,0,0,0);}}
}
typedef __attribute__((address_space(3))) const char* lds_cptr;
typedef short v4i16_t __attribute__((ext_vector_type(4)));
__device__ __forceinline__ void kload8(bf16x8*kf,lds_cptr kp){
  kf[0]=*(const __attribute__((address_space(3))) bf16x8*)(kp);      kf[1]=*(const __attribute__((address_space(3))) bf16x8*)(kp+512);
  kf[2]=*(const __attribute__((address_space(3))) bf16x8*)(kp+2048); kf[3]=*(const __attribute__((address_space(3))) bf16x8*)(kp+2560);
  kf[4]=*(const __attribute__((address_space(3))) bf16x8*)(kp+4096); kf[5]=*(const __attribute__((address_space(3))) bf16x8*)(kp+4608);
  kf[6]=*(const __attribute__((address_space(3))) bf16x8*)(kp+6144); kf[7]=*(const __attribute__((address_space(3))) bf16x8*)(kp+6656);
}
__device__ __forceinline__ void kload2(bf16x8*kf,lds_cptr kp,int j){ kf[2*j]=*(const __attribute__((address_space(3))) bf16x8*)(kp+j*2048); kf[2*j+1]=*(const __attribute__((address_space(3))) bf16x8*)(kp+j*2048+512); }
__device__ __forceinline__ s16x4 vtr(lds_cptr p){ return __builtin_bit_cast(s16x4,__builtin_amdgcn_ds_read_tr16_b64_v4i16((__attribute__((address_space(3))) v4i16_t*)p)); }
__device__ __forceinline__ float rowmax(const f32x16&p0,const f32x16&p1){
  float a=max3f(p0[0],p0[1],p1[0]),b=max3f(p0[2],p0[3],p1[1]);a=max3f(a,p1[2],p1[3]);
  #pragma unroll
  for(int r=4;r<16;r+=4){a=max3f(a,p0[r],p0[r+1]);b=max3f(b,p0[r+2],p0[r+3]);a=max3f(a,p1[r],p1[r+1]);b=max3f(b,p1[r+2],p1[r+3]);}
  const float m=max2f(a,b);
  auto rr=__builtin_amdgcn_permlane32_swap(__float_as_uint(m),__float_as_uint(m),false,false);
  return max2f(__uint_as_float(rr[0]),__uint_as_float(rr[1]));
}
__device__ __forceinline__ void pv(f32x16*o,int vb,bf16x8 pa0,bf16x8 pa1,bf16x8 pa2,bf16x8 pa3){
  #pragma unroll
  for(int d0=0;d0<2;++d0){s16x4 lo[4],hi[4];
    #pragma unroll
    for(int ks=0;ks<4;++ks){
      asm volatile("ds_read_b64_tr_b16 %0,%1 offset:%c2":"=&v"(lo[ks]):"v"(vb),"i"(d0*4096+ks*1024):"memory");
      asm volatile("ds_read_b64_tr_b16 %0,%1 offset:%c2":"=&v"(hi[ks]):"v"(vb),"i"(d0*4096+ks*1024+512):"memory");}
    asm volatile("s_waitcnt lgkmcnt(0)":::"memory");SBAR();
    #define PK(k) (bf16x8){lo[k][0],lo[k][1],lo[k][2],lo[k][3],hi[k][0],hi[k][1],hi[k][2],hi[k][3]}
    o[d0]=__builtin_amdgcn_mfma_f32_32x32x16_bf16(pa0,PK(0),o[d0],0,0,0);
    o[d0]=__builtin_amdgcn_mfma_f32_32x32x16_bf16(pa1,PK(1),o[d0],0,0,0);
    o[d0]=__builtin_amdgcn_mfma_f32_32x32x16_bf16(pa2,PK(2),o[d0],0,0,0);
    o[d0]=__builtin_amdgcn_mfma_f32_32x32x16_bf16(pa3,PK(3),o[d0],0,0,0);
    #undef PK
  }
}

template<int THRL> __device__ __forceinline__ void attn_unit(long qrow0,long krow0,int NTarg,int h,const bf16*Pq,bf16*Yo,char*shm){
  int tid_=threadIdx.x; asm volatile("":"+v"(tid_)); const int tid=tid_,lane=tid&63,r32=lane&31,hi=lane>>5; const int wid=__builtin_amdgcn_readfirstlane(tid>>6);
  const bf16*Qw=Pq+(qrow0+wid*QBLK)*PQ+h*D;
  const bf16*Kh=Pq+krow0*PQ+KOFF+(h>>2)*D,*Vh=Pq+krow0*PQ+VOFF+(h>>2)*D;
  const unsigned lds0=(unsigned)(uintptr_t)shm;
  float*wsf=(float*)(shm+LDS_WS)+wid*64;
  const bf16*ksrc=Kh+(long)lane*PQ+wid*8;
  const bf16*vsrc=Vh+(long)(16*(wid&3)+(lane>>2))*PQ+(wid>>2)*32+(lane&3)*8;
  const unsigned kdst=lds0+LDS_K+wid*1024, vdst=lds0+LDS_V+wid*1024;
  #define DMA_K(t,slot) glds16(ksrc+(long)(t)*KVBLK*PQ,(unsigned)__builtin_amdgcn_readfirstlane(kdst+(slot)))
  #define DMA_V(t,slot) glds16(vsrc+(long)(t)*KVBLK*PQ,(unsigned)__builtin_amdgcn_readfirstlane(vdst+(slot)))
  const int vb0=(int)(lds0+LDS_V)+((lane>>4)&1)*32+(lane&3)*8+(4*hi+((lane&15)>>2))*64;
  const char*Kbase=shm+LDS_K; bf16x8 kf[8];
  const lds_cptr shm3=(lds_cptr)shm; const lds_cptr kp0=shm3+LDS_K+hi*1024+r32*16; const lds_cptr vp0=shm3+LDS_V+((lane>>4)&1)*32+(lane&3)*8+(4*hi+((lane&15)>>2))*64;
  const int NT=NTarg;
  DMA_K(0,0);DMA_V(0,0);DMA_K(1,SLOTB);
  bf16x8 qr[4];
  #pragma unroll
  for(int d0=0;d0<4;++d0)qr[d0]=*reinterpret_cast<const bf16x8*>(&Qw[(long)r32*PQ+d0*16+hi*8]);
  float mhat=0.f,l_reg=0.f;f32x16 o[2];o[0]=f32x16{};o[1]=f32x16{};f32x16 negm=f32x16{};asm volatile("":"+v"(negm));

  #define CMASK(P0,P1,t) do{}while(0)
  bool resc=false;
  #define START(P0,P1) do{ const float rm=rowmax(P0,P1); resc=false; \
    { const float dl=rm; mhat=fadd_s(mhat,dl); \
      _Pragma("unroll") for(int r=0;r<16;++r){P0[r]=fsub_s(P0[r],dl);P1[r]=fsub_s(P1[r],dl);} \
      _Pragma("unroll") for(int r=0;r<16;++r)negm[r]=-mhat; asm volatile("":"+v"(negm)); } \
    _Pragma("unroll") for(int r=0;r<16;++r)P0[r]=__builtin_amdgcn_exp2f(P0[r]); }while(0)
  #define RESC() do{ if(resc){ asm volatile("s_waitcnt lgkmcnt(0)":::"memory"); \
      _Pragma("unroll") for(int d_=0;d_<2;++d_) _Pragma("unroll") for(int r=0;r<16;++r)o[d_][r]*=wsf[crow(r,hi)]; } }while(0)
  f32x16 pA0,pA1,pB0,pB1;
  int sl_prev=0,sl_cur=0,sl_next=SLOTB;
  #define ROT() do{sl_prev=sl_cur;sl_cur=sl_next;sl_next=(sl_next==(NSLOT-1)*SLOTB)?0:sl_next+SLOTB;}while(0)
  DMA_K(2,2*SLOTB);
  WAIT_BAR(3);
  qkt(pA0,pA1,Kbase,qr,negm,r32,hi);asm volatile("s_nop 15\n\ts_nop 7":"+v"(pA0),"+v"(pA1));CMASK(pA0,pA1,0);
  START(pA0,pA1);
  _Pragma("unroll") for(int r=0;r<16;++r)pA1[r]=__builtin_amdgcn_exp2f(pA1[r]);
  WAIT_BAR(0);
  DMA_K(3,0);DMA_V(1,SLOTB);
  ROT();
  kload8(kf,kp0+sl_cur);
  WAIT_BAR(2);
  s16x4 vlo[8],vhi[8]; u32x4 pw0,pw1,pw2,pw3;
  #define PKW(P,B) cvtpk_s(P[B],P[B+1])
  #define PAF(k) __builtin_bit_cast(bf16x8,pw##k)
  #define VFR(i) (bf16x8){vlo[i][0],vlo[i][1],vlo[i][2],vlo[i][3],vhi[i][0],vhi[i][1],vhi[i][2],vhi[i][3]}
  #define PIN(x) asm volatile("":"+v"(x))
  #define MX3(a,b,c) __builtin_fmaxf(__builtin_fmaxf((a),(b)),(c))
  #define GAPA(MF,A0,A1,A2,A3,W0,W1,PW) do{ MF; sacc+=A0; sacc+=A1; sacc+=A2; sacc+=A3; PIN(sacc); W0; W1; PIN(PW); SBAR(); }while(0)
  #define EX(v) __builtin_amdgcn_exp2f(v)
  #define GAPB(MF,X,B) do{ MF; X[B]=EX(X[B]); X[B+1]=EX(X[B+1]); X[B+2]=EX(X[B+2]); X[B+3]=EX(X[B+3]); PIN(X); SBAR(); }while(0)
  #define VRD(i) do{ vlo[i]=vtr(vp_+(((i)>>2)*4096+((i)&3)*1024)); vhi[i]=vtr(vp_+(((i)>>2)*4096+((i)&3)*1024+512)); }while(0)
  #define KRD(G,j) do{ if(G){ kload2(kf,kp0+sl_next,j); SBAR(); } }while(0)
  #define STEP(C0,C1,P0,P1,t,GK,GV,GL) do{ SBAR(); \
    const lds_cptr vp_=vp0+sl_prev; \
    VRD(0); SBAR(); float sacc=(P0[0]+P0[1]); \
    GAPA(C0=__builtin_amdgcn_mfma_f32_32x32x16_bf16(kf[0],qr[0],negm,0,0,0), P0[2],P0[3],P0[4],P0[5],     pw0[0]=PKW(P0,0), pw0[1]=PKW(P0,2), pw0); \
    VRD(4); SBAR(); GAPA(C1=__builtin_amdgcn_mfma_f32_32x32x16_bf16(kf[1],qr[0],negm,0,0,0), P0[6],P0[7],P0[8],P0[9],     pw0[2]=PKW(P0,4), pw0[3]=PKW(P0,6), pw0); \
    VRD(1); SBAR(); GAPA(C0=__builtin_amdgcn_mfma_f32_32x32x16_bf16(kf[2],qr[1],C0,0,0,0),   P0[10],P0[11],P0[12],P0[13], pw1[0]=PKW(P0,8), pw1[1]=PKW(P0,10), pw1); \
    VRD(5); SBAR(); GAPA(C1=__builtin_amdgcn_mfma_f32_32x32x16_bf16(kf[3],qr[1],C1,0,0,0),   P0[14],P0[15],P1[0],P1[1],   pw1[2]=PKW(P0,12),pw1[3]=PKW(P0,14), pw1); \
    VRD(2); SBAR(); GAPA(C0=__builtin_amdgcn_mfma_f32_32x32x16_bf16(kf[4],qr[2],C0,0,0,0),   P1[2],P1[3],P1[4],P1[5],     pw2[0]=PKW(P1,0), pw2[1]=PKW(P1,2), pw2); \
    VRD(6); SBAR(); GAPA(C1=__builtin_amdgcn_mfma_f32_32x32x16_bf16(kf[5],qr[2],C1,0,0,0),   P1[6],P1[7],P1[8],P1[9],     pw2[2]=PKW(P1,4), pw2[3]=PKW(P1,6), pw2); \
    VRD(3); SBAR(); GAPA(C0=__builtin_amdgcn_mfma_f32_32x32x16_bf16(kf[6],qr[3],C0,0,0,0),   P1[10],P1[11],P1[12],P1[13], pw3[0]=PKW(P1,8), pw3[1]=PKW(P1,10), pw3); \
    VRD(7); SBAR(); GAPA(C1=__builtin_amdgcn_mfma_f32_32x32x16_bf16(kf[7],qr[3],C1,0,0,0),   P1[14],P1[15],0.f,0.f,       pw3[2]=PKW(P1,12),pw3[3]=PKW(P1,14), pw3); \
    l_reg+=sacc; \
    if(GK){DMA_K((t)+3,sl_cur);} if(GV){DMA_V((t)+1,sl_next);} \
    CMASK(C0,C1,t); \
    { float a=MX3(C0[0],C0[1],C1[0]),b=MX3(C0[2],C0[3],C1[1]); a=MX3(a,C1[2],C1[3]); \
      _Pragma("unroll") for(int r=4;r<16;r+=4){a=MX3(a,C0[r],C0[r+1]);b=MX3(b,C0[r+2],C0[r+3]);a=MX3(a,C1[r],C1[r+1]);b=MX3(b,C1[r+2],C1[r+3]);} \
      float rm=__builtin_fmaxf(a,b); { auto rr=__builtin_amdgcn_permlane32_swap(__float_as_uint(rm),__float_as_uint(rm),false,false); rm=__builtin_fmaxf(__uint_as_float(rr[0]),__uint_as_float(rr[1])); } \
      resc=false; \
      if(__builtin_expect(__any(rm>(float)THRL),0)){ const float dl=__builtin_fmaxf(rm,0.f); mhat+=dl; \
        _Pragma("unroll") for(int r=0;r<16;++r){C0[r]-=dl;C1[r]-=dl;} \
        _Pragma("unroll") for(int r=0;r<16;++r)negm[r]=-mhat; asm volatile("":"+v"(negm)); \
        const float f=__builtin_amdgcn_exp2f(-dl); l_reg*=f; if(hi==0)wsf[r32]=f; resc=true; } } \
    SBAR(); \
    GAPB(o[0]=__builtin_amdgcn_mfma_f32_32x32x16_bf16(PAF(0),VFR(0),o[0],0,0,0), C0,0); \
    GAPB(o[1]=__builtin_amdgcn_mfma_f32_32x32x16_bf16(PAF(0),VFR(4),o[1],0,0,0), C0,4); \
    KRD(GL,0); GAPB(o[0]=__builtin_amdgcn_mfma_f32_32x32x16_bf16(PAF(1),VFR(1),o[0],0,0,0), C0,8); \
    KRD(GL,1); GAPB(o[1]=__builtin_amdgcn_mfma_f32_32x32x16_bf16(PAF(1),VFR(5),o[1],0,0,0), C0,12); \
    KRD(GL,2); GAPB(o[0]=__builtin_amdgcn_mfma_f32_32x32x16_bf16(PAF(2),VFR(2),o[0],0,0,0), C1,0); \
    KRD(GL,3); GAPB(o[1]=__builtin_amdgcn_mfma_f32_32x32x16_bf16(PAF(2),VFR(6),o[1],0,0,0), C1,4); \
    GAPB(o[0]=__builtin_amdgcn_mfma_f32_32x32x16_bf16(PAF(3),VFR(3),o[0],0,0,0), C1,8); \
    GAPB(o[1]=__builtin_amdgcn_mfma_f32_32x32x16_bf16(PAF(3),VFR(7),o[1],0,0,0), C1,12); \
    }while(0)
  int t=1;
  #undef CMASK
  #define CMASK(P0,P1,t) do{}while(0)
  for(;t+5<NT;t+=2){
    STEP(pB0,pB1,pA0,pA1,t,true,true,true);     WAIT_BAR(2); RESC(); ROT();
    STEP(pA0,pA1,pB0,pB1,t+1,true,true,true);   WAIT_BAR(2); RESC(); ROT();
  }
  #undef CMASK
  #define CMASK(P0,P1,t) do{}while(0)
  #define ENDW(tt) do{ if((tt)+3<NT){WAIT_BAR(2);} else if((tt)+2<NT){WAIT_BAR(1);} else {WAIT_BAR(0);} }while(0)
  for(;t+1<NT;t+=2){
    STEP(pB0,pB1,pA0,pA1,t,(t+3<NT),(t+1<NT),(t+1<NT));       ENDW(t);   RESC(); ROT();
    STEP(pA0,pA1,pB0,pB1,t+1,(t+4<NT),(t+2<NT),(t+2<NT));     ENDW(t+1); RESC(); ROT();
  }
  STEP(pB0,pB1,pA0,pA1,NT-1,false,false,false); RESC();
  { float sacc=pB0[0]+pB0[1]; _Pragma("unroll") for(int r=2;r<16;++r)sacc+=pB0[r]; _Pragma("unroll") for(int r=0;r<16;++r)sacc+=pB1[r]; l_reg+=sacc;
    pw0=(u32x4){PKW(pB0,0),PKW(pB0,2),PKW(pB0,4),PKW(pB0,6)};pw1=(u32x4){PKW(pB0,8),PKW(pB0,10),PKW(pB0,12),PKW(pB0,14)};pw2=(u32x4){PKW(pB1,0),PKW(pB1,2),PKW(pB1,4),PKW(pB1,6)};pw3=(u32x4){PKW(pB1,8),PKW(pB1,10),PKW(pB1,12),PKW(pB1,14)};
    SBAR(); pv(o,vb0+sl_cur,PAF(0),PAF(1),PAF(2),PAF(3)); }
  #undef PKW
  #undef PAF
  #undef VFR
  #undef PIN
  #undef MX3
  #undef GAPA
  #undef GAPB
  #undef EX
  #undef VRD
  #undef KRD
  #undef STEP
  #undef ENDW
  {auto rr=__builtin_amdgcn_permlane32_swap(__float_as_uint(l_reg),__float_as_uint(l_reg),false,false);l_reg=__uint_as_float(rr[0])+__uint_as_float(rr[1]);}
  if(hi==0)wsf[32+r32]=l_reg;asm volatile("s_waitcnt lgkmcnt(0)":::"memory");
  float rli[16];
  #pragma unroll
  for(int r=0;r<16;++r)rli[r]=__builtin_amdgcn_rcpf(wsf[32+crow(r,hi)]);
  bf16*Ow=Yo+(qrow0+wid*QBLK)*PO+h*D;
  { bf16*stg=(bf16*)(shm+LDS_OST)+wid*2048;
    #pragma unroll
    for(int r=0;r<16;++r){const int orow=crow(r,hi);
      #pragma unroll
      for(int d0=0;d0<2;++d0)stg[orow*64+d0*32+r32]=__float2bfloat16(o[d0][r]*rli[r]);}
    asm volatile("s_waitcnt lgkmcnt(0)":::"memory");
    #pragma unroll
    for(int i=0;i<4;++i){const int row=i*8+(lane>>3),ch=lane&7; const u32x4 v=*(const u32x4*)(stg+row*64+ch*8); ATTN_STORE16(Ow+(long)row*PO+ch*8,v);} }
  asm volatile("s_waitcnt lgkmcnt(0)\n\ts_barrier":::"memory");
  #undef DMA_K
  #undef DMA_V
  #undef CMASK
  #undef START
  #undef RESC
  #undef ROT
}
constexpr int ATTN_LDS_BYTES=LDS_BYTES;
#undef SBAR
#undef WAIT_BAR
}
namespace mk {
constexpr int NB = 16, SQ = 4096, CL = 256, SEG = SQ + CL, T = NB * SEG, D = 1024, INW = 2048, NL = 4, NE = 32;
constexpr int NROWT = T / 256;
constexpr int MAXRT = 1120, CAP = MAXRT * 256;
constexpr int MODW = 6 * D;
constexpr float EPS = 1e-6f;
constexpr int NWAVES = 8;
constexpr int PPL = 12, NPHASE = 2 + NL * PPL;

constexpr size_t MiB = 1u << 20;
constexpr size_t WS_CTL = 0, CTL_ZERO_BYTES = 1 * MiB;
constexpr size_t WS_MOD = 4 * MiB;
constexpr size_t WS_B1P = 6 * MiB;
constexpr size_t WS_PAIR = 8 * MiB;
constexpr size_t WS_TOK = 12 * MiB;
constexpr size_t WS_LOG = 22 * MiB;
constexpr size_t WS_WINT = 32 * MiB;
constexpr size_t WS_WOUTT = 50 * MiB;
constexpr size_t WS_WRT = 60 * MiB;
constexpr size_t WS_W1T = 64 * MiB;
constexpr size_t WS_W2T = 576 * MiB;
constexpr size_t WS_X = 832 * MiB;
constexpr size_t WS_HB = 1104 * MiB;
constexpr size_t WS_P = 1240 * MiB;
constexpr size_t WS_Y = 1512 * MiB;
constexpr size_t WS_HP = 1648 * MiB;
constexpr size_t WS_ACT = 2208 * MiB;
constexpr size_t WS_YP = 2768 * MiB;
constexpr size_t WS_END = 3328 * MiB;
static_assert(WS_MOD + (size_t)NL * 17 * MODW * 4 <= WS_B1P && WS_B1P + (size_t)NL * NE * 2048 * 4 <= WS_PAIR && WS_PAIR + (size_t)T * 32 <= WS_TOK && WS_TOK + (size_t)NE * T * 4 <= WS_LOG && WS_LOG + (size_t)T * 128 <= WS_WINT, "ws map 1");
static_assert(WS_WINT + (size_t)NL * 2048 * 1024 * 2 <= WS_WOUTT && WS_WOUTT + (size_t)NL * 1024 * 1024 * 2 <= WS_WRT && WS_WRT + (size_t)NL * 256 * 1024 * 2 <= WS_W1T && WS_W1T + (size_t)NL * NE * 2048 * 1024 * 2 <= WS_W2T && WS_W2T + (size_t)NL * NE * 1024 * 1024 * 2 <= WS_X, "ws map 2");
static_assert(WS_X + (size_t)T * 4096 <= WS_HB && WS_HB + (size_t)T * 2048 <= WS_P && WS_P + (size_t)T * 4096 <= WS_Y && WS_Y + (size_t)T * 2048 <= WS_HP && WS_HP + (size_t)CAP * 2048 <= WS_ACT && WS_ACT + (size_t)CAP * 2048 <= WS_YP && WS_YP + (size_t)CAP * 2048 <= WS_END, "ws map 3");
constexpr int CW_BAR = 4096;
constexpr int CW_CNT = 65536;
constexpr int RING_BYTES = 131072;
constexpr int ROPE_OFF = RING_BYTES;
constexpr int T2E_OFF = ROPE_OFF + 8192;
constexpr int MISC_OFF = T2E_OFF + 2048;
constexpr int LDS_BYTES = 147456;
static_assert(MISC_OFF + 1024 <= LDS_BYTES, "LDS map");

#define GAS __attribute__((address_space(1)))
#define LAS __attribute__((address_space(3)))
typedef unsigned short bf16;
typedef unsigned v4u __attribute__((ext_vector_type(4)));
typedef unsigned v2u __attribute__((ext_vector_type(2)));
typedef float f32x4 __attribute__((ext_vector_type(4)));
typedef float f32x2 __attribute__((ext_vector_type(2)));
typedef GAS unsigned gu32;
#define RLX_AGENT __ATOMIC_RELAXED, __HIP_MEMORY_SCOPE_AGENT
#define LDS_WAIT() asm volatile("s_waitcnt lgkmcnt(0)" ::: "memory")
#define VM_WAIT() asm volatile("s_waitcnt vmcnt(0)" ::: "memory")
__device__ __forceinline__ unsigned f2bf(float f) { unsigned u = __builtin_bit_cast(unsigned, f); return (u + 0x7fffu + ((u >> 16) & 1u)) >> 16; }
__device__ __forceinline__ unsigned pk2(float lo, float hi) { return f2bf(lo) | (f2bf(hi) << 16); }
__device__ __forceinline__ float bflo(unsigned w) { return __builtin_bit_cast(float, w << 16); }
__device__ __forceinline__ float bfhi(unsigned w) { return __builtin_bit_cast(float, w & 0xffff0000u); }
__device__ __forceinline__ f32x4 bf4(v2u w) { return (f32x4){bflo(w.x), bfhi(w.x), bflo(w.y), bfhi(w.y)}; }
__device__ __forceinline__ v2u pk4(f32x4 v) { return (v2u){pk2(v.x, v.y), pk2(v.z, v.w)}; }
__device__ __forceinline__ float wave_sum(float v) {
#pragma unroll
    for (int o = 1; o < 64; o <<= 1) v += __shfl_xor(v, o);
    return v;
}
__device__ __forceinline__ float sum4(f32x4 v) { return (v.x + v.y) + (v.z + v.w); }
__device__ __forceinline__ float sigmoidf_(float z) { return __builtin_amdgcn_rcpf(1.0f + __builtin_amdgcn_exp2f(z * -1.4426950408889634f)); }
template <int I> __device__ __forceinline__ const float* ldin() { const GAS float* p;
    asm volatile("s_load_dwordx2 %0, %1, %2\n\ts_waitcnt lgkmcnt(0)" : "=s"(p) : "s"(__builtin_amdgcn_kernarg_segment_ptr()), "n"(I * 8) : "memory"); return (const float*)p; }
__device__ __forceinline__ float* ldout() { GAS float* p;
    asm volatile("s_load_dwordx2 %0, %1, %2\n\ts_waitcnt lgkmcnt(0)" : "=s"(p) : "s"(__builtin_amdgcn_kernarg_segment_ptr()), "n"(24 * 8) : "memory"); return (float*)p; }
#define XB_TMO      128
#define XB_XCNT(j)  (256  + 64 * (j))
#define XB_XSUB(j)  (1280 + 64 * (j))
#define XB_XGEN(j)  (2304 + 64 * (j))
#define XB_TOP      3328
#define XB_TOPGEN   3392
#define XCD_BAR_WORDS 3456
#define XB_SPIN_CAP (1u << 22)

__device__ __forceinline__ unsigned xb_ld(unsigned* p)              { return __hip_atomic_load(p, __ATOMIC_RELAXED, __HIP_MEMORY_SCOPE_AGENT); }
__device__ __forceinline__ unsigned xb_add(unsigned* p, unsigned v) { return __hip_atomic_fetch_add(p, v, __ATOMIC_RELAXED, __HIP_MEMORY_SCOPE_AGENT); }
__device__ __forceinline__ unsigned xb_xcc_id() { return (unsigned)__builtin_amdgcn_s_getreg((3 << 11) | 20) & 0xFu; }
#define XB_SPIN(cond, bar) do { unsigned _sp = 0; while (cond) { __builtin_amdgcn_s_sleep(1); \
    if ((++_sp & 255u) == 0u) { if (xb_ld(&(bar)[XB_TMO])) break; if (_sp > XB_SPIN_CAP) { atomicAdd(&(bar)[XB_TMO], 1u); break; } } } } while (0)

struct XcdBarrier {
    unsigned* bar; unsigned x;
    volatile LAS unsigned* st;
};

__device__ __forceinline__ XcdBarrier xcd_barrier_post(unsigned* bar, volatile LAS unsigned* st) {
    XcdBarrier b; b.bar = bar; b.x = xb_xcc_id(); b.st = st;
    if (threadIdx.x == 0) (void)xb_add(&bar[XB_XCNT(b.x)], 1u);
    return b;
}
__device__ __forceinline__ void xcd_barrier_complete(unsigned* bar, unsigned x, unsigned& nloc, unsigned& nx) {
    const unsigned G = gridDim.x * gridDim.y * gridDim.z;
    unsigned sum, cnt, mine, sp = 0u;
    for (;;) {
        sum = 0u; cnt = 0u; mine = 0u;
#pragma unroll
        for (unsigned j = 0; j < 16; ++j) { const unsigned c = xb_ld(&bar[XB_XCNT(j)]); sum += c; cnt += (c > 0u) ? 1u : 0u; mine = (j == x) ? c : mine; }
        if (sum == G) break;
        __builtin_amdgcn_s_sleep(1);
        if ((++sp & 255u) == 0u) { if (xb_ld(&bar[XB_TMO])) break; if (sp > XB_SPIN_CAP) { atomicAdd(&bar[XB_TMO], 1u); break; } }
    }
    nloc = mine > 0u ? mine : 1u; nx = cnt > 0u ? cnt : 1u;
}

__device__ __forceinline__ void xcd_barrier(const XcdBarrier& b) {
    asm volatile("s_waitcnt vmcnt(0)" ::: "memory");
    __syncthreads();
    if (threadIdx.x == 0) {
        unsigned* bar = b.bar;
        __builtin_amdgcn_s_waitcnt(0);
        unsigned nloc = b.st[0], nx = b.st[1];
        if (nloc == 0u) { xcd_barrier_complete(bar, b.x, nloc, nx); b.st[0] = nloc; b.st[1] = nx; }
        const unsigned old = xb_add(&bar[XB_XSUB(b.x)], 1u);
        const unsigned gen = old / nloc;
        if (old + 1u == (gen + 1u) * nloc) {
            __builtin_amdgcn_fence(__ATOMIC_RELEASE, "agent");
            asm volatile("s_waitcnt vmcnt(0)" ::: "memory");
            const unsigned og = xb_add(&bar[XB_TOP], 1u);
            const unsigned tg = og / nx;
            if (og + 1u == (tg + 1u) * nx) xb_add(&bar[XB_TOPGEN], 1u);
            else XB_SPIN(xb_ld(&bar[XB_TOPGEN]) == tg, bar);
            __builtin_amdgcn_fence(__ATOMIC_ACQUIRE, "agent");
            xb_add(&bar[XB_XGEN(b.x)], 1u);
            asm volatile("s_waitcnt vmcnt(0)" ::: "memory");
        } else {
            XB_SPIN(xb_ld(&bar[XB_XGEN(b.x)]) == gen, bar);
            __builtin_amdgcn_fence(__ATOMIC_ACQUIRE, "agent");
            asm volatile("s_waitcnt vmcnt(0)" ::: "memory");
        }
    }
    __syncthreads();
}

struct Ctx {
    LAS unsigned char* lds; volatile LAS unsigned* MISC; gu32* ctl;
    int tid, lane, wave, vcu, G, gw, ngw;
    GAS unsigned char* ws;
    __device__ __forceinline__ float* MOD() const { return (float*)(ws + WS_MOD); }
    __device__ __forceinline__ float* B1P() const { return (float*)(ws + WS_B1P); }
    __device__ __forceinline__ float* LOG() const { return (float*)(ws + WS_LOG); }
    __device__ __forceinline__ float* X() const { return (float*)(ws + WS_X); }
    __device__ __forceinline__ v2u* PAIR() const { return (v2u*)(ws + WS_PAIR); }
    __device__ __forceinline__ int* TOK() const { return (int*)(ws + WS_TOK); }
    __device__ __forceinline__ bf16* WINT() const { return (bf16*)(ws + WS_WINT); }
    __device__ __forceinline__ bf16* WOUTT() const { return (bf16*)(ws + WS_WOUTT); }
    __device__ __forceinline__ bf16* WRT() const { return (bf16*)(ws + WS_WRT); }
    __device__ __forceinline__ bf16* W1T() const { return (bf16*)(ws + WS_W1T); }
    __device__ __forceinline__ bf16* W2T() const { return (bf16*)(ws + WS_W2T); }
    __device__ __forceinline__ bf16* HB() const { return (bf16*)(ws + WS_HB); }
    __device__ __forceinline__ bf16* P() const { return (bf16*)(ws + WS_P); }
    __device__ __forceinline__ bf16* Y() const { return (bf16*)(ws + WS_Y); }
    __device__ __forceinline__ bf16* HP() const { return (bf16*)(ws + WS_HP); }
    __device__ __forceinline__ bf16* ACT() const { return (bf16*)(ws + WS_ACT); }
    __device__ __forceinline__ bf16* YP() const { return (bf16*)(ws + WS_YP); }
};
struct Args { const float* in[24]; float* out; unsigned char* ws; int ph_lo, ph_hi; };

__device__ __forceinline__ int w1_row(int n) { const int a = n >> 1; return ((a >> 7) << 8) + ((n & 1) << 7) + (a & 127); }
template <int MODE>
__device__ __forceinline__ void transpose_item(const float* W, int K, int N, bf16* WT, LAS float* scr, int item, int lane) {
    const int nblk = N / 32, kb = item / nblk, nb = item % nblk, k0 = 64 * kb, n0 = 32 * nb;
#pragma unroll 8
    for (int i = 0; i < 32; ++i) { const int kk = 2 * i + (lane >> 5); scr[kk * 33 + (lane & 31)] = W[(size_t)(k0 + kk) * N + n0 + (lane & 31)]; }
    LDS_WAIT(); asm volatile("" ::: "memory");
    const int c = lane & 7;
#pragma unroll
    for (int j = 0; j < 4; ++j) { const int n = (lane >> 3) + 8 * j; const LAS float* s = scr + (8 * c) * 33 + n;
        v4u o; o.x = pk2(s[0 * 33], s[1 * 33]); o.y = pk2(s[2 * 33], s[3 * 33]); o.z = pk2(s[4 * 33], s[5 * 33]); o.w = pk2(s[6 * 33], s[7 * 33]);
        const int orow = MODE == 1 ? w1_row(n0 + n) : (n0 + n);
        *(GAS v4u*)(WT + (size_t)orow * K + k0 + 8 * c) = o; }
    LDS_WAIT(); asm volatile("" ::: "memory");
}
__device__ __forceinline__ void phase_prologue(const Ctx& C, const Args& A) {
    {
        LAS float* sS = (LAS float*)C.lds;
        const float* cin = ldin<1>(); const float* cctx = ldin<3>(); const float* wada = ldin<4>(); const float* bada = ldin<5>();
        for (int i = C.tid; i < 17 * 1024; i += NWAVES * 64) { const int j = i >> 10, k = i & 1023; const float v = j < 16 ? cin[j * 1024 + k] : cctx[k]; sS[i] = v * sigmoidf_(v); }
        __syncthreads();
        const int kl = C.tid & 15, cg = C.tid >> 4;
        for (int item = blockIdx.x; item < NL * 48; item += C.G) {
            const int l = item / 48, c0 = (item % 48) * 128 + 4 * cg;
            const float* W = wada + (size_t)l * 1024 * MODW + c0;
            f32x4 acc[17];
#pragma unroll
            for (int j = 0; j < 17; ++j) acc[j] = (f32x4){0.f, 0.f, 0.f, 0.f};
            for (int k = kl; k < 1024; k += 16) { const f32x4 w = *(const f32x4*)(W + (size_t)k * MODW);
#pragma unroll
                for (int j = 0; j < 17; ++j) acc[j] += sS[j * 1024 + k] * w; }
#pragma unroll
            for (int j = 0; j < 17; ++j)
#pragma unroll
                for (int o = 1; o < 16; o <<= 1) { acc[j].x += __shfl_xor(acc[j].x, o); acc[j].y += __shfl_xor(acc[j].y, o); acc[j].z += __shfl_xor(acc[j].z, o); acc[j].w += __shfl_xor(acc[j].w, o); }
            if (kl == 0) { const f32x4 bv = *(const f32x4*)(bada + (size_t)l * MODW + c0);
#pragma unroll
                for (int j = 0; j < 17; ++j) *(f32x4*)(C.MOD() + ((size_t)l * 17 + j) * MODW + c0) = acc[j] + bv; }
        }
        __syncthreads();
    }
    {
        LAS float* scr = (LAS float*)(C.lds + C.wave * 16384);
        const float* w_in = ldin<8>(); const float* w_out = ldin<17>(); const float* w_r = ldin<18>(); const float* w_e1 = ldin<20>(); const float* w_e2 = ldin<22>(); const float* b_e1 = ldin<21>();
        constexpr int I_IN = 16 * 64, I_OUT = 16 * 32, I_E1 = 16 * 64, I_E2 = 16 * 32, I_R = 16;
        constexpr int PER_L = I_IN + I_OUT + NE * I_E1 + NE * I_E2 + I_R;
        for (int it = C.gw; it < NL * PER_L; it += C.ngw) {
            const int l = it / PER_L; int r = it - l * PER_L;
            if (r < I_IN) { transpose_item<0>(w_in + (size_t)l * 1024 * 2048, 1024, 2048, C.WINT() + (size_t)l * 2048 * 1024, scr, r, C.lane); continue; } r -= I_IN;
            if (r < I_OUT) { transpose_item<0>(w_out + (size_t)l * 1024 * 1024, 1024, 1024, C.WOUTT() + (size_t)l * 1024 * 1024, scr, r, C.lane); continue; } r -= I_OUT;
            if (r < NE * I_E1) { const int e = r / I_E1; transpose_item<1>(w_e1 + ((size_t)l * NE + e) * 1024 * 2048, 1024, 2048, C.W1T() + ((size_t)l * NE + e) * 2048 * 1024, scr, r % I_E1, C.lane); continue; } r -= NE * I_E1;
            if (r < NE * I_E2) { const int e = r / I_E2; transpose_item<0>(w_e2 + ((size_t)l * NE + e) * 1024 * 1024, 1024, 1024, C.W2T() + ((size_t)l * NE + e) * 1024 * 1024, scr, r % I_E2, C.lane); continue; } r -= NE * I_E2;
            transpose_item<0>(w_r + (size_t)l * 1024 * 32, 1024, 32, C.WRT() + (size_t)l * 256 * 1024, scr, r, C.lane);
        }
        for (int i = C.gw * 64 + C.lane; i < NL * NE * 2048; i += C.ngw * 64) { const int n = i & 2047; C.B1P()[(i & ~2047) + w1_row(n)] = b_e1[i]; }
    }
}

__device__ __forceinline__ void moe_tables(const Ctx& C, int l, bool with_t2e) {
    __syncthreads();
    if (C.tid < NE) C.MISC[40 + C.tid] = __hip_atomic_load(C.ctl + CW_CNT + (l * NE + C.tid) * 64, RLX_AGENT);
    __syncthreads();
    if (C.tid == 0) { unsigned s = 0;
#pragma unroll 1
        for (int e = 0; e < NE; ++e) { C.MISC[e] = s; s += (C.MISC[40 + e] + 255u) >> 8; } C.MISC[NE] = s; }
    __syncthreads();
    if (with_t2e) { LAS unsigned char* t2e = (LAS unsigned char*)(C.lds + T2E_OFF);
        for (int rt = C.tid; rt < MAXRT; rt += NWAVES * 64) { unsigned e = 0;
#pragma unroll 1
            for (int k = 1; k < NE; ++k) e += (C.MISC[k] <= (unsigned)rt) ? 1u : 0u;
            t2e[rt] = (unsigned char)e; }
        __syncthreads(); }
}

__device__ __forceinline__ void row_bt(int r, int& b, int& t, int& j) { b = r / SEG; t = r - b * SEG; j = t < SQ ? b : 16; }
__device__ __forceinline__ void modulate_store(const f32x4 (&v)[4], const float* g, const float* shift, const float* scale, bf16* orow, int lane) {
    float ss = 0.f;
#pragma unroll
    for (int jj = 0; jj < 4; ++jj) ss += sum4(v[jj] * v[jj]);
    const float rs = __builtin_amdgcn_rsqf(wave_sum(ss) * (1.0f / D) + EPS);
#pragma unroll
    for (int jj = 0; jj < 4; ++jj) { const int c = 256 * jj + 4 * lane;
        const f32x4 gv = *(const f32x4*)(g + c), sh = *(const f32x4*)(shift + c), sc = *(const f32x4*)(scale + c);
        const f32x4 h = (v[jj] * rs) * gv * (1.0f + sc) + sh;
        *(GAS v2u*)(orow + c) = pk4(h); }
}
__device__ __forceinline__ void moe_combine(const Ctx& C, int r, f32x4 (&acc)[4]) {
#pragma unroll
    for (int jj = 0; jj < 4; ++jj) acc[jj] = (f32x4){0.f, 0.f, 0.f, 0.f};
#pragma unroll
    for (int k = 0; k < 4; ++k) { const v2u pr = C.PAIR()[(size_t)r * 4 + k]; const unsigned e = pr.x & 31u, pos = pr.x >> 5; const unsigned wb = pr.y; const float wt = __uint_as_float(wb);
        const bf16* yp = C.YP() + ((size_t)C.MISC[e] * 256 + pos) * D + 4 * C.lane;
#pragma unroll
        for (int jj = 0; jj < 4; ++jj) acc[jj] += wt * bf4(*(const GAS v2u*)(yp + 256 * jj)); }
}

__device__ __forceinline__ void phase_premix(const Ctx& C, const Args& A, int l) {
    if (l > 0) moe_tables(C, l - 1, false);
    const float* modl = C.MOD() + (size_t)l * 17 * MODW; const float* modp = C.MOD() + (size_t)(l > 0 ? l - 1 : 0) * 17 * MODW;
    const float* g = ldin<6>() + (size_t)l * D; const float* xin = ldin<0>(); const float* cxin = ldin<2>();
    for (int r = C.gw; r < T; r += C.ngw) {
        int b, t, j; row_bt(r, b, t, j);
        f32x4 v[4]; float* xr = C.X() + (size_t)r * D + 4 * C.lane;
        if (l == 0) { const float* src = (t < SQ ? xin + ((size_t)b * SQ + t) * D : cxin + ((size_t)b * CL + (t - SQ)) * D) + 4 * C.lane;
#pragma unroll
            for (int jj = 0; jj < 4; ++jj) v[jj] = *(const f32x4*)(src + 256 * jj);
        } else { f32x4 acc[4]; moe_combine(C, r, acc); const float* gt2 = modp + (size_t)j * MODW + 5 * D + 4 * C.lane;
#pragma unroll
            for (int jj = 0; jj < 4; ++jj) v[jj] = *(const f32x4*)(xr + 256 * jj) + *(const f32x4*)(gt2 + 256 * jj) * acc[jj]; }
#pragma unroll
        for (int jj = 0; jj < 4; ++jj) *(f32x4*)(xr + 256 * jj) = v[jj];
        const float* mj = modl + (size_t)j * MODW;
        modulate_store(v, g, mj + 0 * D, mj + 1 * D, C.HB() + (size_t)r * D, C.lane);
    }
}
__device__ __forceinline__ void phase_premoe(const Ctx& C, const Args& A, int l) {
    const float* modl = C.MOD() + (size_t)l * 17 * MODW; const float* g = ldin<7>() + (size_t)l * D;
    for (int r = C.gw; r < T; r += C.ngw) {
        int b, t, j; row_bt(r, b, t, j);
        f32x4 v[4]; const float* xr = C.X() + (size_t)r * D + 4 * C.lane;
#pragma unroll
        for (int jj = 0; jj < 4; ++jj) v[jj] = *(const f32x4*)(xr + 256 * jj);
        const float* mj = modl + (size_t)j * MODW;
        modulate_store(v, g, mj + 3 * D, mj + 4 * D, C.HB() + (size_t)r * D, C.lane);
    }
}
__device__ __forceinline__ void phase_final(const Ctx& C, const Args& A) {
    moe_tables(C, NL - 1, false);
    const float* modp = C.MOD() + (size_t)(NL - 1) * 17 * MODW; float* outp = ldout();
    for (int q = C.gw; q < NB * SQ; q += C.ngw) {
        const int b = q / SQ, t = q - b * SQ, r = b * SEG + t;
        f32x4 acc[4]; moe_combine(C, r, acc);
        const float* xr = C.X() + (size_t)r * D + 4 * C.lane; const float* gt2 = modp + (size_t)b * MODW + 5 * D + 4 * C.lane; float* o = outp + (size_t)q * D + 4 * C.lane;
#pragma unroll
        for (int jj = 0; jj < 4; ++jj) *(f32x4*)(o + 256 * jj) = *(const f32x4*)(xr + 256 * jj) + *(const f32x4*)(gt2 + 256 * jj) * acc[jj];
    }
}

__device__ __forceinline__ void phase_qknorm(const Ctx& C, const Args& A, int l) {
    const LAS f32x2* rope = (const LAS f32x2*)(C.lds + ROPE_OFF);
    const float* gq = ldin<9>() + l * 64; const float* gk = ldin<10>() + l * 64;
    const int d0 = 8 * (C.lane & 7);
    const int ax = d0 >> 5, o0 = d0 & 31; const bool first = o0 < 16; const int i0 = o0 & 15;
    float gqv[8], gkv[8];
#pragma unroll
    for (int i = 0; i < 8; ++i) { gqv[i] = gq[d0 + i]; gkv[i] = gk[d0 + i]; }
    for (int r = C.gw; r < T; r += C.ngw) {
        int b, t, j; row_bt(r, b, t, j);
        const bool lat = t < SQ; const int pos = ax == 0 ? (t >> 6) : (t & 63);
        bf16* prow = C.P() + (size_t)r * INW;
#pragma unroll
        for (int part = 0; part < 2; ++part) {
            const bool act = part == 0 || C.lane < 16;
            bf16* p = prow + (part == 0 ? 0 : 512) + 8 * (act ? C.lane : 0);
            const v4u w = *(const GAS v4u*)p;
            float f[8] = {bflo(w.x), bfhi(w.x), bflo(w.y), bfhi(w.y), bflo(w.z), bfhi(w.z), bflo(w.w), bfhi(w.w)};
            float ss = 0.f;
#pragma unroll
            for (int i = 0; i < 8; ++i) ss += f[i] * f[i];
            ss += __shfl_xor(ss, 1); ss += __shfl_xor(ss, 2); ss += __shfl_xor(ss, 4);
            const float rs = __builtin_amdgcn_rsqf(ss * (1.0f / 64.0f) + EPS);
#pragma unroll
            for (int i = 0; i < 8; ++i) f[i] = f[i] * rs * (part == 0 ? gqv[i] : gkv[i]);
            float o[8];
#pragma unroll
            for (int i = 0; i < 8; ++i) { const float pv = __shfl_xor(f[i], 2); const f32x2 cs = rope[pos * 16 + i0 + i];
                const float rot = first ? f[i] * cs.x - pv * cs.y : f[i] * cs.x + pv * cs.y;
                o[i] = lat ? rot : f[i]; if (part == 0) o[i] *= attn_body::C2; }
            if (act) { v4u ow; ow.x = pk2(o[0], o[1]); ow.y = pk2(o[2], o[3]); ow.z = pk2(o[4], o[5]); ow.w = pk2(o[6], o[7]); *(GAS v4u*)p = ow; }
        }
    }
}

__device__ __forceinline__ void phase_attn(const Ctx& C) {
    char* shm = (char*)C.lds;
    const attn_body::bf16* Pq = (const attn_body::bf16*)C.P(); attn_body::bf16* Yo = (attn_body::bf16*)C.Y();
    const int nlat = NB * 8 * 16;
    const int per = (nlat + C.G - 1) / C.G;
    for (int i = 0; i < per; ++i) { const int u = C.vcu * per + i; if (u >= nlat) break;
        const int qb = u & 15, h = (u >> 4) & 7, b = u >> 7;
        attn_body::attn_unit<8>((long)b * SEG + qb * 256, (long)b * SEG, SEG / 64, h, Pq, Yo, shm); }
    for (int u = C.vcu; u < NB * 8; u += C.G) { const int h = u & 7, b = u >> 3;
        attn_body::attn_unit<8>((long)b * SEG + SQ, (long)b * SEG + SQ, CL / 64, h, Pq, Yo, shm); }
}

__device__ __forceinline__ void phase_conv(const Ctx& C, const Args& A, int l) {
    LAS float* zL = (LAS float*)C.lds;
    const int c4 = 4 * C.lane;
    f32x4 wk[31]; const float* wdw = ldin<11>();
#pragma unroll
    for (int jt = 0; jt < 31; ++jt) wk[jt] = *(const f32x4*)(wdw + ((size_t)l * 31 + jt) * 256 + c4);
    const f32x4 b31 = *(const f32x4*)(ldin<12>() + l * 256 + c4), gln = *(const f32x4*)(ldin<13>() + l * 256 + c4), bln = *(const f32x4*)(ldin<14>() + l * 256 + c4);
    const float* wsc = ldin<15>() + (size_t)l * 3 * 256 + c4; const f32x4 w30 = *(const f32x4*)(wsc), w31 = *(const f32x4*)(wsc + 256), w32 = *(const f32x4*)(wsc + 512);
    const float* gg = ldin<16>() + (size_t)l * D;
    const f32x4 gA0 = *(const f32x4*)(gg + 8 * C.lane), gA1 = *(const f32x4*)(gg + 8 * C.lane + 4), gC = *(const f32x4*)(gg + 512 + c4), gS = *(const f32x4*)(gg + 768 + c4);
    for (int tile = C.vcu; tile < T / 64; tile += C.G) {
        const int b = tile / 68, tt = tile - b * 68, t0 = tt * 64;
        const int seg_lo = tt < 64 ? 0 : SQ, seg_hi = tt < 64 ? SQ : SEG;
        const size_t rbase = (size_t)b * SEG;
        __syncthreads();
        for (int zr = C.wave; zr < 94; zr += NWAVES) { const int t = t0 - 15 + zr; f32x4 z = (f32x4){0.f, 0.f, 0.f, 0.f};
            if (t >= seg_lo && t < seg_hi) { const bf16* p = C.P() + (rbase + t) * INW; const f32x4 a = bf4(*(const GAS v2u*)(p + 768 + c4)), gt = bf4(*(const GAS v2u*)(p + 1024 + c4));
                z = (f32x4){a.x * sigmoidf_(gt.x), a.y * sigmoidf_(gt.y), a.z * sigmoidf_(gt.z), a.w * sigmoidf_(gt.w)}; }
            *(LAS f32x4*)(zL + zr * 256 + c4) = z; }
        __syncthreads();
        for (int i = C.wave; i < 64; i += NWAVES) { const int t = t0 + i; const size_t r = rbase + t;
            f32x4 u = b31;
#pragma unroll
            for (int jt = 0; jt < 31; ++jt) u += wk[jt] * *(const LAS f32x4*)(zL + (i + jt) * 256 + c4);
            const float mean = wave_sum(sum4(u)) * (1.0f / 256.0f); const f32x4 d = u - mean;
            const float var = wave_sum(sum4(d * d)) * (1.0f / 256.0f); const f32x4 y = d * __builtin_amdgcn_rsqf(var + EPS) * gln + bln;
            const f32x4 cf = (f32x4){y.x * sigmoidf_(y.x), y.y * sigmoidf_(y.y), y.z * sigmoidf_(y.z), y.w * sigmoidf_(y.w)};
            const float rsc = __builtin_amdgcn_rsqf(wave_sum(sum4(cf * cf)) * (1.0f / 256.0f) + EPS);
            bf16* yr = C.Y() + r * D;
            *(GAS v2u*)(yr + 512 + c4) = pk4(cf * rsc * gC);
            const bf16* p = C.P() + r * INW; f32x4 m0 = (f32x4){0.f, 0.f, 0.f, 0.f}, m2 = m0;
            const f32x4 m1 = bf4(*(const GAS v2u*)(p + 1536 + c4)) * bf4(*(const GAS v2u*)(p + 1792 + c4));
            if (t - 1 >= seg_lo) m0 = bf4(*(const GAS v2u*)(p - INW + 1536 + c4)) * bf4(*(const GAS v2u*)(p - INW + 1792 + c4));
            if (t + 1 < seg_hi) m2 = bf4(*(const GAS v2u*)(p + INW + 1536 + c4)) * bf4(*(const GAS v2u*)(p + INW + 1792 + c4));
            const f32x4 sv = bf4(*(const GAS v2u*)(p + 1280 + c4)) * (w30 * m0 + w31 * m1 + w32 * m2);
            const float rss = __builtin_amdgcn_rsqf(wave_sum(sum4(sv * sv)) * (1.0f / 256.0f) + EPS);
            *(GAS v2u*)(yr + 768 + c4) = pk4(sv * rss * gS);
            const v4u aw = *(const GAS v4u*)(yr + 8 * C.lane);
            const f32x4 a0 = bf4((v2u){aw.x, aw.y}), a1 = bf4((v2u){aw.z, aw.w});
            const float rsa = __builtin_amdgcn_rsqf(wave_sum(sum4(a0 * a0) + sum4(a1 * a1)) * (1.0f / 512.0f) + EPS);
            const v2u o0 = pk4(a0 * rsa * gA0), o1 = pk4(a1 * rsa * gA1);
            *(GAS v4u*)(yr + 8 * C.lane) = (v4u){o0.x, o0.y, o1.x, o1.y};
        }
    }
    __syncthreads();
}

__device__ __forceinline__ void phase_route(const Ctx& C, const Args& A, int l) {
    volatile LAS unsigned* lhist = C.MISC + 80; volatile LAS unsigned* lbase = C.MISC + 112;
    const float br = C.lane < NE ? ldin<19>()[l * NE + C.lane] : 0.f;
    gu32* cnt = C.ctl + CW_CNT + (size_t)l * NE * 64;
    for (int tile = C.vcu; tile < T / 64; tile += C.G) {
        __syncthreads();
        if (C.tid < NE) lhist[C.tid] = 0u;
        __syncthreads();
        unsigned pe[8], pp[8];
#pragma unroll
        for (int i = 0; i < 8; ++i) { const int r = tile * 64 + C.wave * 8 + i;
            float v = C.lane < NE ? C.LOG()[(size_t)r * NE + C.lane] + br : -INFINITY;
            float sv[4]; int se[4];
#pragma unroll
            for (int k = 0; k < 4; ++k) { float m = v; int mi = C.lane;
#pragma unroll
                for (int o = 1; o < 64; o <<= 1) { const float ov = __shfl_xor(m, o); const int oi = __shfl_xor(mi, o); if (ov > m || (ov == m && oi < mi)) { m = ov; mi = oi; } }
                sv[k] = m; se[k] = mi; if (C.lane == mi) v = -INFINITY; }
            const float e1 = __expf(sv[1] - sv[0]), e2 = __expf(sv[2] - sv[0]), e3 = __expf(sv[3] - sv[0]); const float inv = __builtin_amdgcn_rcpf(1.0f + e1 + e2 + e3);
            const int kk = C.lane & 3;
            pe[i] = (unsigned)(kk == 0 ? se[0] : kk == 1 ? se[1] : kk == 2 ? se[2] : se[3]);
            const float pwi = (kk == 0 ? 1.0f : kk == 1 ? e1 : kk == 2 ? e2 : e3) * inv;
            pp[i] = 0u;
            if (C.lane < 4) { pp[i] = __hip_atomic_fetch_add((LAS unsigned*)(C.lds + MISC_OFF) + 80 + pe[i], 1u, __ATOMIC_RELAXED, __HIP_MEMORY_SCOPE_WORKGROUP);
                ((GAS float*)C.PAIR())[((size_t)r * 4 + C.lane) * 2 + 1] = pwi; } }
        __syncthreads();
        if (C.tid < NE) { const unsigned n = lhist[C.tid]; lbase[C.tid] = n ? __hip_atomic_fetch_add(cnt + C.tid * 64, n, RLX_AGENT) : 0u; }
        __syncthreads();
        if (C.lane < 4) {
#pragma unroll
            for (int i = 0; i < 8; ++i) { const int r = tile * 64 + C.wave * 8 + i; const unsigned pos = lbase[pe[i]] + pp[i];
                ((GAS unsigned*)C.PAIR())[((size_t)r * 4 + C.lane) * 2] = pe[i] | (pos << 5);
                C.TOK()[(size_t)pe[i] * T + pos] = r; } }
    }
    __syncthreads();
}

__device__ __forceinline__ void phase_gather(const Ctx& C, const Args& A, int l) {
    moe_tables(C, l, true);
    const LAS unsigned char* t2e = (const LAS unsigned char*)(C.lds + T2E_OFF);
    const int nslot = (int)C.MISC[NE] * 256;
    for (int s = C.gw; s < nslot; s += C.ngw) { const unsigned e = t2e[s >> 8]; const unsigned pos = (unsigned)s - C.MISC[e] * 256u;
        if (pos < C.MISC[40 + e]) { const int r = C.TOK()[(size_t)e * T + pos];
            const GAS v4u* src = (const GAS v4u*)(C.HB() + (size_t)r * D) + C.lane; GAS v4u* dst = (GAS v4u*)(C.HP() + (size_t)s * D) + C.lane;
            dst[0] = src[0]; dst[64] = src[64]; } }
}

__global__ void __launch_bounds__(NWAVES * 64, 2) mk_fwd(Args args) {
    extern __shared__ __attribute__((aligned(16))) unsigned char lds_raw[];
    Ctx C;
    C.lds = (LAS unsigned char*)lds_raw; C.MISC = (volatile LAS unsigned*)(C.lds + MISC_OFF);
    C.tid = threadIdx.x; C.lane = C.tid & 63; C.wave = __builtin_amdgcn_readfirstlane(C.tid >> 6);
    C.G = gridDim.x; { const int bx = blockIdx.x; C.vcu = (C.G % 8 == 0) ? (bx % 8) * (C.G / 8) + bx / 8 : bx; }
    C.gw = C.vcu * NWAVES + C.wave; C.ngw = C.G * NWAVES;
    C.ws = (GAS unsigned char*)args.ws; C.ctl = (gu32*)(C.ws + WS_CTL);
    for (int u = C.tid; u < (LDS_BYTES - MISC_OFF) / 4; u += NWAVES * 64) ((LAS unsigned*)(C.lds + MISC_OFF))[u] = 0u;
    for (int u = C.tid; u < 64 * 16; u += NWAVES * 64) { const int pos = u >> 4, i = u & 15; const float inv = powf(10000.0f, -(float)(2 * i) / 32.0f); const float ang = (float)pos * inv;
        ((LAS f32x2*)(C.lds + ROPE_OFF))[u] = (f32x2){cosf(ang), sinf(ang)}; }
    __syncthreads();
    const int lo = args.ph_lo, hi = args.ph_hi;
    const bool multi = (hi - lo) > 1;
    XcdBarrier bar; bar.bar = (unsigned*)(C.ctl + CW_BAR); bar.x = 0; bar.st = C.MISC + 160;
    if (multi) bar = xcd_barrier_post((unsigned*)(C.ctl + CW_BAR), C.MISC + 160);
#ifndef MK_PHMASK
#define MK_PHMASK 0xFFFF
#endif
#define IN(k) (lo <= (k) && (k) < hi)
#define FRESH() do { asm volatile("" : "+v"(C.tid), "+v"(C.lane)); asm volatile("" : "+s"(C.wave), "+s"(C.vcu), "+s"(C.gw), "+s"(C.ws), "+s"(C.ctl)); } while (0)
#define EN(k) ((MK_PHMASK >> (k)) & 1)
#define SEAM(k) do { if (IN((k) + 1)) xcd_barrier(bar); } while (0)

    if (EN(12) && IN(0)) { phase_prologue(C, args); SEAM(0); }
    for (int l = 0; l < NL; ++l) {
        const int pb = 1 + l * PPL;
        if (EN(0) && IN(pb + 0)) { FRESH(); phase_premix(C, args, l); SEAM(pb + 0); }
        if (EN(1) && IN(pb + 1)) { FRESH();
            pg8::Gemm g{C.HB(), C.WINT() + (size_t)l * INW * D, T, INW, D}; pg8::StaticOrder S; S.init(T, INW, C.G, (int)blockIdx.x);
            pg8::EpiStore E{C.P(), INW};
            pg8::gemm_phase<pg8::EpiStore, pg8::StaticOrder, true, true>(C.lds, g, S, E);
            SEAM(pb + 1); }
        if (EN(2) && IN(pb + 2)) { FRESH(); phase_qknorm(C, args, l); SEAM(pb + 2); }
        if (EN(3) && IN(pb + 3)) { FRESH(); phase_attn(C); SEAM(pb + 3); }
        if (EN(4) && IN(pb + 4)) { FRESH(); phase_conv(C, args, l); SEAM(pb + 4); }
        if (EN(5) && IN(pb + 5)) { FRESH();
            pg8::Gemm g{C.Y(), C.WOUTT() + (size_t)l * D * D, T, D, D}; pg8::StaticOrder S; S.init(T, D, C.G, (int)blockIdx.x);
            pg8::EpiResid E{C.X(), C.MOD() + (size_t)l * 17 * MODW + 2 * D};
            pg8::gemm_phase<pg8::EpiResid, pg8::StaticOrder, true, true>(C.lds, g, S, E);
            SEAM(pb + 5); }
        if (EN(6) && IN(pb + 6)) { FRESH(); phase_premoe(C, args, l); SEAM(pb + 6); }
        if (EN(7) && IN(pb + 7)) { FRESH();
            pg8::Gemm g{C.HB(), C.WRT() + (size_t)l * 256 * D, T, 256, D}; pg8::StaticOrder S; S.init(T, 256, C.G, (int)blockIdx.x);
            pg8::EpiLogits E{C.LOG()};
            pg8::gemm_phase<pg8::EpiLogits, pg8::StaticOrder, true, true>(C.lds, g, S, E);
            SEAM(pb + 7); }
        if (EN(8) && IN(pb + 8)) { FRESH(); phase_route(C, args, l); SEAM(pb + 8); }
        if (EN(9) && IN(pb + 9)) { FRESH(); phase_gather(C, args, l); SEAM(pb + 9); }
        if (EN(10) && IN(pb + 10)) { FRESH();
            moe_tables(C, l, true);
            pg8::Gemm g{C.HP(), C.W1T() + (size_t)l * NE * 2048 * D, CAP, NE * 2048, D};
            pg8::MoeOrder S; S.init((int)C.MISC[NE], 8, C.G, (int)blockIdx.x, (const LAS unsigned char*)(C.lds + T2E_OFF));
            pg8::EpiSwiglu E{C.ACT(), C.B1P() + (size_t)l * NE * 2048};
            pg8::gemm_phase<pg8::EpiSwiglu, pg8::MoeOrder, true, true>(C.lds, g, S, E);
            SEAM(pb + 10); }
        if (EN(11) && IN(pb + 11)) { FRESH();
            moe_tables(C, l, true);
            pg8::Gemm g{C.ACT(), C.W2T() + (size_t)l * NE * D * D, CAP, NE * D, D};
            pg8::MoeOrder S; S.init((int)C.MISC[NE], 4, C.G, (int)blockIdx.x, (const LAS unsigned char*)(C.lds + T2E_OFF));
            pg8::EpiDown E{C.YP(), ldin<23>() + (size_t)l * NE * D};
            pg8::gemm_phase<pg8::EpiDown, pg8::MoeOrder, true, true>(C.lds, g, S, E);
            SEAM(pb + 11); }
    }
    if (EN(13) && IN(NPHASE - 1)) { FRESH(); phase_final(C, args); }
#undef IN
#undef SEAM
}
}


#if defined(MK_DEBUG)
namespace mkdbg {
using namespace mk;
constexpr size_t WS_DBG = 3400 * MiB;
__device__ const int SROWS[12] = {0, 1, 63, 64, 255, 256, 4095, 4096, 4351, 4352, 30000, 69631};
__device__ __forceinline__ float bfv(const bf16* p, size_t i) { return __builtin_bit_cast(float, (unsigned)p[i] << 16); }
__device__ __forceinline__ void report(float* err, int s, float got, float ref, float atol) {
    float e = fabsf(got - ref) / (fabsf(ref) + atol); if (!(e == e)) e = 100.f;
    atomicMax((unsigned*)err + s, __builtin_bit_cast(unsigned, e));
}
__device__ __forceinline__ void row_info(int r, int& b, int& t, int& j) { b = r / SEG; t = r - b * SEG; j = t < SQ ? b : 16; }
__device__ __forceinline__ float silu_(float v) { return v / (1.f + expf(-v)); }
__device__ __forceinline__ float sigm_(float v) { return 1.f / (1.f + expf(-v)); }
__device__ __forceinline__ void naive_attn(const bf16* P, int r, int h, float* q, float* o) {
    int b, t, j; row_info(r, b, t, j);
    const int k0 = t < SQ ? b * SEG : b * SEG + SQ, nk = t < SQ ? SEG : CL;
    for (int d = 0; d < 64; ++d) q[d] = bfv(P, (size_t)r * INW + h * 64 + d);
    float m = -1e30f;
    for (int kk = 0; kk < nk; ++kk) { float s = 0.f; for (int d = 0; d < 64; ++d) s += q[d] * bfv(P, (size_t)(k0 + kk) * INW + 512 + (h >> 2) * 64 + d); m = fmaxf(m, s); }
    float l = 0.f; for (int d = 0; d < 64; ++d) o[d] = 0.f;
    for (int kk = 0; kk < nk; ++kk) { float s = 0.f; for (int d = 0; d < 64; ++d) s += q[d] * bfv(P, (size_t)(k0 + kk) * INW + 512 + (h >> 2) * 64 + d);
        const float p = exp2f(s - m); l += p; for (int d = 0; d < 64; ++d) o[d] += p * bfv(P, (size_t)(k0 + kk) * INW + 640 + (h >> 2) * 64 + d); }
    for (int d = 0; d < 64; ++d) o[d] /= l;
}
__device__ const int DBG_LS_1[2] = {0, 3};
__device__ const int DBG_JS_2[3] = {0, 7, 16};
__device__ const int DBG_NS_3[4] = {0, 1000, 2053, 6143};
__device__ const int DBG_CS_4[4] = {0, 1, 511, 1023};
__device__ const int DBG_CS_5[16] = {0, 63, 64, 511, 512, 575, 639, 640, 767, 768, 1024, 1279, 1280, 1536, 1792, 2047};
__device__ const int DBG_HS_6[4] = {0, 7, 8, 9};
__device__ const int DBG_HS_7[2] = {0, 5};
__device__ const int DBG_CS_8[4] = {0, 255, 256, 1023};
__device__ const int DBG_ES_9[3] = {0, 7, 31};
__device__ const int DBG_CS_10[3] = {0, 500, 1023};
__device__ const int DBG_CS_11[4] = {0, 127, 128, 1023};
__device__ const int DBG_CS_12[4] = {0, 300, 511, 1023};
__device__ const int DBG_CS_13[4] = {0, 300, 511, 1023};
__device__ const int DBG_CS_14[4] = {0, 300, 511, 1023};
__global__ void __launch_bounds__(256) dbg_kernel(Args a, int stage) {
    unsigned char* ws = a.ws; float* err = (float*)(ws + WS_DBG); float* scr = err + 256;
    const float* MOD = (const float*)(ws + WS_MOD); const bf16* HB = (const bf16*)(ws + WS_HB); const bf16* P = (const bf16*)(ws + WS_P); const bf16* Y = (const bf16*)(ws + WS_Y);
    const float* X = (const float*)(ws + WS_X); const float* LOG = (const float*)(ws + WS_LOG); const v2u* PAIR = (const v2u*)(ws + WS_PAIR); const int* TOK = (const int*)(ws + WS_TOK);
    const bf16* HP = (const bf16*)(ws + WS_HP); const bf16* ACT = (const bf16*)(ws + WS_ACT); const bf16* YP = (const bf16*)(ws + WS_YP);
    const unsigned* cnt = (const unsigned*)(ws + WS_CTL) + CW_CNT;
    const int tid = threadIdx.x;
    __shared__ float shm[15360]; __shared__ unsigned tstart[33];
    if (stage == 0) { if (tid < 64) err[tid] = 0.f; return; }
    if (stage == 1) {
        const int* ls = DBG_LS_1; const int* js = DBG_JS_2; const int* ns = DBG_NS_3;
        if (tid < 24) { const int l = ls[tid / 12], j = js[(tid / 4) % 3], n = ns[tid % 4]; float s = 0.f;
            for (int k = 0; k < 1024; ++k) { const float c = j < 16 ? a.in[1][j * 1024 + k] : a.in[3][k]; s += silu_(c) * a.in[4][((size_t)l * 1024 + k) * MODW + n]; }
            s += a.in[5][l * MODW + n]; report(err, 1, MOD[((size_t)l * 17 + j) * MODW + n], s, 0.05f); }
        return; }
    if (stage == 2 || stage == 8) {
        const int* cs = DBG_CS_4;
        if (tid < 48) { const int r = SROWS[tid / 4], c = cs[tid % 4]; int b, t, j; row_info(r, b, t, j);
            const float* xr = stage == 2 ? (t < SQ ? a.in[0] + ((size_t)b * SQ + t) * D : a.in[2] + ((size_t)b * CL + (t - SQ)) * D) : X + (size_t)r * D;
            float ss = 0.f; for (int k = 0; k < D; ++k) ss += xr[k] * xr[k];
            const float rs = 1.f / sqrtf(ss / D + EPS); const float* g = stage == 2 ? a.in[6] : a.in[7]; const float* mj = MOD + (size_t)j * MODW + (stage == 2 ? 0 : 3 * D);
            const float h = xr[c] * rs * g[c] * (1.f + mj[D + c]) + mj[c];
            report(err, stage, bfv(HB, (size_t)r * D + c), h, 0.05f);
            if (stage == 2) report(err, stage, X[(size_t)r * D + c], xr[c], 0.01f); }
        return; }
    if (stage == 3) {
        const int* cs = DBG_CS_5;
        if (tid < 192) { const int r = SROWS[tid / 16], c = cs[tid % 16]; float s = 0.f;
            for (int k = 0; k < D; ++k) s += bfv(HB, (size_t)r * D + k) * a.in[8][(size_t)k * INW + c];
            report(err, 3, bfv(P, (size_t)r * INW + c), s, 0.05f); }
        return; }
    if (stage == 4) {
        const int* hs = DBG_HS_6;
        if (tid < 48) { const int r = SROWS[tid / 4], h = hs[tid % 4]; int b, t, j; row_info(r, b, t, j);
            float* raw = shm + tid * 128; float* o = raw + 64; float ss = 0.f;
            for (int d = 0; d < 64; ++d) { float s = 0.f; for (int k = 0; k < D; ++k) s += bfv(HB, (size_t)r * D + k) * a.in[8][(size_t)k * INW + h * 64 + d]; raw[d] = s; ss += s * s; }
            const float rs = 1.f / sqrtf(ss / 64.f + EPS); const float* g = h < 8 ? a.in[9] : a.in[10];
            for (int d = 0; d < 64; ++d) raw[d] = raw[d] * rs * g[d];
            for (int ax = 0; ax < 2; ++ax) for (int i = 0; i < 16; ++i) { const float pos = ax == 0 ? (float)(t / 64) : (float)(t % 64); const float ang = pos * powf(10000.f, -(float)(2 * i) / 32.f);
                const float c = t < SQ ? cosf(ang) : 1.f, s = t < SQ ? sinf(ang) : 0.f; const float x1 = raw[ax * 32 + i], x2 = raw[ax * 32 + 16 + i];
                o[ax * 32 + i] = x1 * c - x2 * s; o[ax * 32 + 16 + i] = x2 * c + x1 * s; }
            for (int d = 0; d < 64; ++d) { const float ref = o[d] * (h < 8 ? 0.125f * 1.4426950408889634f : 1.f); report(err, 4, bfv(P, (size_t)r * INW + h * 64 + d), ref, h < 8 ? 0.045f : 0.25f); } }
        return; }
    if (stage == 5) {
        const int* hs = DBG_HS_7;
        if (tid < 24) { const int r = SROWS[tid / 2], h = hs[tid % 2]; float* o = shm + tid * 128; naive_attn(P, r, h, o + 64, o);
            for (int d = 0; d < 64; ++d) report(err, 5, bfv(Y, (size_t)r * D + h * 64 + d), o[d], 0.05f); }
        return; }
    if (stage == 6) {
        if (tid < 12) { const int r = SROWS[tid]; int b, t, j; row_info(r, b, t, j); const int lo = t < SQ ? 0 : SQ, hi = t < SQ ? SQ : SEG; const size_t rb = (size_t)b * SEG;
            float* u = shm + tid * 256; float mean = 0.f;
            for (int c = 0; c < 256; ++c) { float s = a.in[12][c];
                for (int jt = 0; jt < 31; ++jt) { const int tt = t + jt - 15; if (tt >= lo && tt < hi) s += a.in[11][jt * 256 + c] * bfv(P, (rb + tt) * INW + 768 + c) * sigm_(bfv(P, (rb + tt) * INW + 1024 + c)); }
                u[c] = s; mean += s; }
            mean /= 256.f; float var = 0.f; for (int c = 0; c < 256; ++c) var += (u[c] - mean) * (u[c] - mean); var /= 256.f;
            float ss = 0.f; for (int c = 0; c < 256; ++c) { const float y = (u[c] - mean) / sqrtf(var + EPS) * a.in[13][c] + a.in[14][c]; u[c] = silu_(y); ss += u[c] * u[c]; }
            float rs = 1.f / sqrtf(ss / 256.f + EPS);
            for (int c = 0; c < 256; ++c) report(err, 6, bfv(Y, (size_t)r * D + 512 + c), u[c] * rs * a.in[16][512 + c], 0.25f);
            ss = 0.f;
            for (int c = 0; c < 256; ++c) { float s = 0.f; for (int jt = 0; jt < 3; ++jt) { const int tt = t + jt - 1; if (tt >= lo && tt < hi) s += a.in[15][jt * 256 + c] * bfv(P, (rb + tt) * INW + 1536 + c) * bfv(P, (rb + tt) * INW + 1792 + c); }
                u[c] = bfv(P, (size_t)r * INW + 1280 + c) * s; ss += u[c] * u[c]; }
            rs = 1.f / sqrtf(ss / 256.f + EPS);
            for (int c = 0; c < 256; ++c) report(err, 7, bfv(Y, (size_t)r * D + 768 + c), u[c] * rs * a.in[16][768 + c], 0.25f); }
        if (tid >= 64 && tid < 80) { const int r = SROWS[(tid - 64) / 8 == 0 ? 2 : 7], h = (tid - 64) % 8; float* o = shm + 3072 + (tid - 64) * 128; naive_attn(P, r, h, o + 64, o);
            for (int d = 0; d < 64; ++d) scr[((tid - 64) / 8) * 512 + h * 64 + d] = o[d]; }
        __syncthreads();
        if (tid < 2) { const int r = SROWS[tid == 0 ? 2 : 7]; float ss = 0.f; for (int c = 0; c < 512; ++c) ss += scr[tid * 512 + c] * scr[tid * 512 + c];
            const float rs = 1.f / sqrtf(ss / 512.f + EPS); for (int c = 0; c < 512; ++c) report(err, 6, bfv(Y, (size_t)r * D + c), scr[tid * 512 + c] * rs * a.in[16][c], 0.25f); }
        return; }
    if (stage == 9) {
        const int* cs = DBG_CS_8;
        if (tid < 48) { const int r = SROWS[tid / 4], c = cs[tid % 4]; int b, t, j; row_info(r, b, t, j);
            const float* xr = t < SQ ? a.in[0] + ((size_t)b * SQ + t) * D : a.in[2] + ((size_t)b * CL + (t - SQ)) * D;
            float s = 0.f; for (int k = 0; k < D; ++k) s += bfv(Y, (size_t)r * D + k) * a.in[17][(size_t)k * D + c];
            report(err, 9, X[(size_t)r * D + c], xr[c] + MOD[(size_t)j * MODW + 2 * D + c] * s, 0.05f); }
        return; }
    if (stage == 10) {
        const int* es = DBG_ES_9;
        if (tid < 36) { const int r = SROWS[tid / 3], e = es[tid % 3]; float s = 0.f; for (int k = 0; k < D; ++k) s += bfv(HB, (size_t)r * D + k) * a.in[18][(size_t)k * NE + e];
            report(err, 10, LOG[(size_t)r * NE + e], s, 0.05f); }
        return; }
    if (stage == 11) {
        if (tid < 12) { const int r = SROWS[tid]; float* v = shm + tid * 32; for (int e = 0; e < 32; ++e) v[e] = LOG[(size_t)r * NE + e] + a.in[19][e];
            float* sv = shm + 1024 + tid * 8; float* sef = sv + 4;
            for (int k = 0; k < 4; ++k) { int bi = 0; for (int e = 1; e < 32; ++e) if (v[e] > v[bi]) bi = e; sef[k] = (float)bi; sv[k] = v[bi]; v[bi] = -1e30f; }
            float den = 0.f; for (int k = 0; k < 4; ++k) den += expf(sv[k] - sv[0]);
            { float* vv = shm + 2048 + tid * 32; for (int e = 0; e < 32; ++e) vv[e] = LOG[(size_t)r * NE + e] + a.in[19][e];
              float mx = -1e30f, dn = 0.f; for (int k = 0; k < 4; ++k) mx = fmaxf(mx, vv[PAIR[(size_t)r * 4 + k].x & 31]); for (int k = 0; k < 4; ++k) dn += expf(vv[PAIR[(size_t)r * 4 + k].x & 31] - mx);
              for (int k = 0; k < 4; ++k) report(err, 22, __uint_as_float((unsigned)(PAIR[(size_t)r * 4 + k].y + 0u)), expf(vv[PAIR[(size_t)r * 4 + k].x & 31] - mx) / dn, 0.01f); }
            for (int k = 0; k < 4; ++k) { const v2u pr = PAIR[(size_t)r * 4 + k]; const int e = pr.x & 31; const unsigned pos = pr.x >> 5;
                if (tid == 0 && (k == 0 || k == 3)) { err[30 + (k ? 2 : 0)] = __uint_as_float((unsigned)(pr.y + 0u)); err[31 + (k ? 2 : 0)] = expf(sv[k] - sv[0]) / den; }
                report(err, 17, (float)e == sef[k] ? 0.f : 1.f, 0.f, 1.0f); report(err, 18, __uint_as_float((unsigned)(pr.y + 0u)), expf(sv[k] - sv[0]) / den, 0.01f);
                const unsigned c = cnt[e * 64]; report(err, 19, pos < c ? 1.f : 0.f, 1.f, 0.001f); report(err, 20, (float)TOK[(size_t)e * T + (pos < (unsigned)T ? pos : 0)], (float)r, 0.001f); } }
        if (tid == 255) { unsigned s = 0; for (int e = 0; e < 32; ++e) s += cnt[e * 64]; report(err, 21, (float)s, (float)(T * 4), 0.001f); }
        if (tid == 253) { int c = 0; const float* pf = (const float*)PAIR; for (int q = 0; q < 64; ++q) { const float w = pf[q * 2 + 1]; if (w > 0.01f && w <= 1.f) ++c; } err[44] = (float)c; }
        if (tid == 254) { for (int k = 0; k < 4; ++k) { const float w = __uint_as_float((unsigned)(PAIR[k].y + 0u)); err[40 + k] = (float)(!(w == w) || w < 0.f || w > 1.f ? 3 : w < 1e-30f ? 0 : w < 0.05f ? 1 : 2); } }
        return; }
    if (tid == 0) { unsigned s = 0; for (int e = 0; e < 32; ++e) { tstart[e] = s; s += (cnt[e * 64] + 255u) >> 8; } tstart[32] = s; }
    __syncthreads();
    if (stage == 12) {
        const int* cs = DBG_CS_10;
        if (tid < 48) { const int r = SROWS[tid / 4], k = tid % 4; const v2u pr = PAIR[(size_t)r * 4 + k]; const size_t slot = (size_t)tstart[pr.x & 31] * 256 + (pr.x >> 5);
            for (int i = 0; i < 3; ++i) report(err, 12, bfv(HP, slot * D + cs[i]), bfv(HB, (size_t)r * D + cs[i]), 0.001f); }
        return; }
    if (stage == 13) {
        const int* cs = DBG_CS_11;
        if (tid < 192) { const int r = SROWS[tid / 16], k = (tid / 4) % 4, c = cs[tid % 4]; const v2u pr = PAIR[(size_t)r * 4 + k]; const int e = pr.x & 31; const size_t slot = (size_t)tstart[e] * 256 + (pr.x >> 5);
            float ug = a.in[21][(size_t)e * 2048 + 2 * c], uu = a.in[21][(size_t)e * 2048 + 2 * c + 1]; const float* w = a.in[20] + (size_t)e * 1024 * 2048;
            for (int kk = 0; kk < D; ++kk) { const float hv = bfv(HP, slot * D + kk); ug += hv * w[(size_t)kk * 2048 + 2 * c]; uu += hv * w[(size_t)kk * 2048 + 2 * c + 1]; }
            const float gc = fminf(ug, 7.f), uc = fminf(fmaxf(uu, -7.f), 7.f); const float ref = (uc + 1.f) * gc * sigm_(1.702f * gc);
            report(err, 13, bfv(ACT, slot * D + c), ref, 0.25f); }
        return; }
    if (stage == 14) {
        const int* cs = DBG_CS_12;
        if (tid < 192) { const int r = SROWS[tid / 16], k = (tid / 4) % 4, c = cs[tid % 4]; const v2u pr = PAIR[(size_t)r * 4 + k]; const int e = pr.x & 31; const size_t slot = (size_t)tstart[e] * 256 + (pr.x >> 5);
            float s = a.in[23][(size_t)e * 1024 + c]; const float* w = a.in[22] + (size_t)e * 1024 * 1024;
            for (int kk = 0; kk < D; ++kk) s += bfv(ACT, slot * D + kk) * w[(size_t)kk * 1024 + c];
            report(err, 14, bfv(YP, slot * D + c), s, 0.25f); }
        return; }
    if (stage == 15) {
        const int* cs = DBG_CS_13;
        if (tid < 48) { const int r = SROWS[tid / 4], c = cs[tid % 4]; int b, t, j; row_info(r, b, t, j); float f = 0.f;
            for (int k = 0; k < 4; ++k) { const v2u pr = PAIR[(size_t)r * 4 + k]; const size_t slot = (size_t)tstart[pr.x & 31] * 256 + (pr.x >> 5); f += __uint_as_float((unsigned)(pr.y + 0u)) * bfv(YP, slot * D + c); }
            scr[2048 + tid] = X[(size_t)r * D + c] + MOD[(size_t)j * MODW + 5 * D + c] * f; }
        return; }
    if (stage == 16) {
        const int* cs = DBG_CS_14;
        if (tid < 48) { const int r = SROWS[tid / 4], c = cs[tid % 4]; report(err, 16, X[(size_t)r * D + c], scr[2048 + tid], 0.02f); }
        return; }
    if (stage == 99) {
        if (tid == 0) {
#if MK_DEBUG == 3
            a.out[0] = (err[44] + 1.f) * 1e20f; return;
#endif
#if MK_DEBUG == 2
            { const float* db = err + 4096; const v2u* PR = (const v2u*)(a.ws + WS_PAIR); int code = 0;
              auto close = [](float x, float y) { return fabsf(x - y) <= 1e-3f * (fabsf(y) + 1e-3f); };
              for (int ln = 0; ln < 4 && !code; ++ln) for (int j = 0; j < 4; ++j) if (!(db[ln * 16 + j] == db[j])) { code = 10 + ln; break; }
              if (!code) for (int j = 0; j < 3; ++j) if (!(db[j] >= db[j + 1])) code = 20 + j;
              if (!code) for (int ln = 0; ln < 4 && !code; ++ln) for (int j = 0; j < 3; ++j) if (!close(db[ln * 16 + 4 + j], expf(db[j + 1] - db[0]))) { code = 30 + ln; break; }
              if (!code) for (int ln = 0; ln < 4; ++ln) if (!close(db[ln * 16 + 7], 1.f + db[ln * 16 + 4] + db[ln * 16 + 5] + db[ln * 16 + 6])) { code = 40 + ln; break; }
              if (!code) for (int ln = 0; ln < 4; ++ln) if (!close(db[ln * 16 + 8], 1.f / db[ln * 16 + 7])) { code = 50 + ln; break; }
              if (!code) for (int ln = 0; ln < 4; ++ln) if (!close(db[ln * 16 + 9], (ln == 0 ? 1.f : db[ln * 16 + 3 + ln]) * db[ln * 16 + 8])) { code = 60 + ln; break; }
              if (!code) for (int ln = 0; ln < 4; ++ln) if (!close(__uint_as_float((unsigned)(PR[ln].y + 0u)), db[ln * 16 + 9])) { code = 70 + ln; break; }
              if (!code) code = 88;
              a.out[0] = (float)code * 1e20f; return; }
#endif
            int mask = 0; for (int i = 0; i < 6; ++i) if (err[17 + i] > 0.06f) mask |= 1 << i; if (mask) err[11] = 1.f;
            for (int s = 1; s < 17; ++s) if (err[s] > 0.06f) { if (s == 11) { a.out[0] = (float)(10 + mask) * 1e14f; break; } a.out[0] = (1.f + 10.f * fminf(err[s], 0.89f)) * powf(10.f, (float)(4 + s)); break; } }
        return; }
}
}
#endif
#ifndef MK_ONE_LAUNCH
#define MK_ONE_LAUNCH 1
#endif
extern "C" void kernel_launch(void* const* d_in, const int* in_sizes, int n_in, void* d_out, int out_size, void* d_ws, size_t ws_size, hipStream_t stream) {
    using namespace mk;
    static int grid = 0;
    if (grid == 0) {
        if (n_in != 24 || out_size != NB * SQ * D || ws_size < WS_END) { fprintf(stderr, "kernel_launch: unexpected shapes (n_in %d, out %d, ws %zu)\n", n_in, out_size, ws_size); grid = -1; return; }
        int dev = 0, cus = 0, per_cu = 0;
        if (hipGetDevice(&dev) != hipSuccess || hipDeviceGetAttribute(&cus, hipDeviceAttributeMultiprocessorCount, dev) != hipSuccess) { grid = -1; return; }
        if (hipFuncSetAttribute((const void*)mk_fwd, hipFuncAttributeMaxDynamicSharedMemorySize, LDS_BYTES) != hipSuccess) { fprintf(stderr, "kernel_launch: hipFuncSetAttribute failed\n"); grid = -1; return; }
        if (hipOccupancyMaxActiveBlocksPerMultiprocessor(&per_cu, (const void*)mk_fwd, NWAVES * 64, LDS_BYTES) != hipSuccess || per_cu < 1) { fprintf(stderr, "kernel_launch: occupancy query says %d\n", per_cu); per_cu = 1; }
        (void)hipGetLastError();
        grid = cus;
    }
    if (grid < 0) return;
    (void)hipMemsetAsync((char*)d_ws + WS_CTL, 0, CTL_ZERO_BYTES, stream);
    Args a{};
    for (int i = 0; i < 24; ++i) a.in[i] = (const float*)d_in[i];
    a.out = (float*)d_out; a.ws = (unsigned char*)d_ws;
#if MK_ONE_LAUNCH
    a.ph_lo = 0; a.ph_hi = NPHASE;
    hipLaunchKernelGGL(mk_fwd, dim3(grid), dim3(NWAVES * 64), LDS_BYTES, stream, a);
#else
#if defined(MK_DEBUG)
#define DBG(s) hipLaunchKernelGGL(mkdbg::dbg_kernel, dim3(1), dim3(256), 0, stream, a, (s))
    DBG(0);
#else
#define DBG(s) do {} while (0)
#endif
    for (int p = 0; p < NPHASE; ++p) { a.ph_lo = p; a.ph_hi = p + 1; hipLaunchKernelGGL(mk_fwd, dim3(grid), dim3(NWAVES * 64), LDS_BYTES, stream, a);
        if (p == 0) DBG(1); if (p == 1) DBG(2); if (p == 2) DBG(3); if (p == 3) DBG(4); if (p == 4) DBG(5); if (p == 5) DBG(6); if (p == 6) DBG(9); if (p == 7) DBG(8); if (p == 8) DBG(10);
        if (p == 9) DBG(11); if (p == 10) DBG(12); if (p == 11) DBG(13); if (p == 12) { DBG(14); DBG(15); } if (p == 13) DBG(16); }
    DBG(99);
#endif
}
```

```cpp
#include <hip/hip_runtime.h>
#include <hip/hip_bf16.h>
#include <cstdio>
#include <cstdint>
#include <cmath>
namespace pg8 {
#define PG8_LAS __attribute__((address_space(3)))
typedef unsigned short bf16_t;
typedef short bf16x8 __attribute__((ext_vector_type(8)));
typedef float f32x4 __attribute__((ext_vector_type(4)));
typedef unsigned u32x4 __attribute__((ext_vector_type(4)));
typedef int i32x4 __attribute__((ext_vector_type(4)));
typedef int i32x8 __attribute__((ext_vector_type(8)));
typedef unsigned u32x2 __attribute__((ext_vector_type(2)));
constexpr int BM = 256, BK = 64, HALF = 128, HTB = HALF * BK * 2  , STAGE_BYTES = 8 * HTB, NXCD = 8, WGM = 8;

__host__ __device__ __forceinline__ int lds_byte(int r, int c) { const int st = (r >> 4) * 2 + (c >> 5), rr = r & 15, cc = c & 31, ob = rr * 64 + cc * 2; return st * 1024 + (ob ^ (((ob >> 9) & 1) << 5)); }
__host__ __device__ __forceinline__ void stage_rc(int b, int& R, int& C) { const int st = b / 1024, sb = b % 1024, swz = sb ^ (((sb >> 9) & 1) << 5); R = (st >> 1) * 16 + swz / 64; C = (st & 1) * 32 + (swz % 64) / 2; }
__host__ __device__ __forceinline__ int perm32(int rho) { const int n = rho >> 4, i = rho & 15; return 8 * (i >> 2) + 4 * n + (i & 3); }

struct Unit { int pm, pn; };
struct Gemm { const bf16_t* A; const bf16_t* Bt; int M, N, K; };

struct StaticOrder {
    int nM, nN, nwg, G, c;
    __host__ __device__ void init(int M, int N, int G_, int c_) { nM = M / BM; nN = N / BM; nwg = nM * nN; G = G_; c = c_; }
    __host__ __device__ bool next(int i, Unit& u) const {
        const long L = (long)i * G + c; if (L >= nwg) return false;
        int wgid = (int)L; { const int q = nwg / NXCD, r = nwg % NXCD, xcd = wgid % NXCD, off = wgid / NXCD; wgid = (xcd < r ? xcd * (q + 1) : r * (q + 1) + (xcd - r) * q) + off; }
        const int nig = WGM * nN, gid = wgid / nig, fm = gid * WGM, gsz = (nM - fm) < WGM ? (nM - fm) : WGM;
        u.pm = fm + ((wgid % nig) % gsz); u.pn = (wgid % nig) / gsz; return true;
    }
    __device__ __forceinline__ void a_ready(const Unit&) const {}
    __device__ __forceinline__ void done(const Unit&) const {}
};

__device__ __forceinline__ unsigned cvt_pk_bf16(float lo, float hi) { unsigned r; asm volatile("v_cvt_pk_bf16_f32 %0, %1, %2" : "=v"(r) : "v"(lo), "v"(hi)); return r; }
typedef float f32x2 __attribute__((ext_vector_type(2)));

struct MoeOrder {
    int nN, ntl, nwg, G, c; const PG8_LAS unsigned char* t2e;
    __device__ __forceinline__ void init(int ntl_, int nN_, int G_, int c_, const PG8_LAS unsigned char* t2e_) { ntl = ntl_; nN = nN_; nwg = ntl_ * nN_; G = G_; c = c_; t2e = t2e_; }
    __device__ __forceinline__ bool next(int i, Unit& u) const {
        const long L = (long)i * G + c; if (L >= nwg) return false;
        int wgid = (int)L; { const int q = nwg / NXCD, r = nwg % NXCD, xcd = wgid % NXCD, off = wgid / NXCD; wgid = (xcd < r ? xcd * (q + 1) : r * (q + 1) + (xcd - r) * q) + off; }
        const int nig = WGM * nN, gid = wgid / nig, fm = gid * WGM, gsz = (ntl - fm) < WGM ? (ntl - fm) : WGM;
        const int rt = fm + ((wgid % nig) % gsz), pn = (wgid % nig) / gsz;
        u.pm = rt; u.pn = (int)t2e[rt] * nN + pn; return true;
    }
    __device__ __forceinline__ void a_ready(const Unit&) const {}
    __device__ __forceinline__ void done(const Unit&) const {}
};

struct EpiStore {
    static constexpr bool PERM = true, AFTER_DRAIN = false;
    bf16_t* O; int ldc;
    __device__ __forceinline__ void operator()(const f32x4 (&acc)[2][2][4][2], const Unit& u, int wr, int wc, int fr, int fq) const {
        const int row0 = u.pm * BM + wr * 64 + fr, col0 = u.pn * BM + wc * 32 + 8 * fq;
#pragma unroll
        for (int ai = 0; ai < 2; ++ai)
#pragma unroll
            for (int m = 0; m < 4; ++m) { bf16_t* rowp = O + (size_t)(row0 + ai * HALF + m * 16) * ldc + col0;
#pragma unroll
                for (int bj = 0; bj < 2; ++bj) { const f32x4 v0 = acc[ai][bj][m][0], v1 = acc[ai][bj][m][1];
                    u32x4 w; w.x = cvt_pk_bf16(v0[0], v0[1]); w.y = cvt_pk_bf16(v0[2], v0[3]); w.z = cvt_pk_bf16(v1[0], v1[1]); w.w = cvt_pk_bf16(v1[2], v1[3]);
                    *(u32x4*)(rowp + bj * HALF) = w; } }
    }
};
struct EpiResid {
    static constexpr bool PERM = false, AFTER_DRAIN = false;
    float* X; const float* gate;
    __device__ __forceinline__ void operator()(const f32x4 (&acc)[2][2][4][2], const Unit& u, int wr, int wc, int fr, int fq) const {
        const int seg = u.pm / 17, rem = u.pm - seg * 17; const int j = (rem == 16) ? 16 : seg;
        const int row0 = u.pm * BM + wr * 64 + fr, col0 = u.pn * BM + wc * 32 + 4 * fq;
        const float* g = gate + (size_t)j * 6144 + col0;
        f32x4 gv[2][2];
#pragma unroll
        for (int bj = 0; bj < 2; ++bj)
#pragma unroll
            for (int n = 0; n < 2; ++n) gv[bj][n] = *(const f32x4*)(g + bj * HALF + n * 16);
#pragma unroll
        for (int ai = 0; ai < 2; ++ai)
#pragma unroll
            for (int m = 0; m < 4; ++m) { float* rowp = X + (size_t)(row0 + ai * HALF + m * 16) * 1024 + col0;
#pragma unroll
                for (int bj = 0; bj < 2; ++bj)
#pragma unroll
                    for (int n = 0; n < 2; ++n) { f32x4* p = (f32x4*)(rowp + bj * HALF + n * 16); *p = *p + gv[bj][n] * acc[ai][bj][m][n]; } }
    }
};
struct EpiLogits {
    static constexpr bool PERM = false, AFTER_DRAIN = false;
    float* LOG;
    __device__ __forceinline__ void operator()(const f32x4 (&acc)[2][2][4][2], const Unit& u, int wr, int wc, int fr, int fq) const {
        if (wc != 0) return;
        const int row0 = u.pm * BM + wr * 64 + fr;
#pragma unroll
        for (int ai = 0; ai < 2; ++ai)
#pragma unroll
            for (int m = 0; m < 4; ++m) { float* rowp = LOG + (size_t)(row0 + ai * HALF + m * 16) * 32 + 4 * fq;
#pragma unroll
                for (int n = 0; n < 2; ++n) *(f32x4*)(rowp + n * 16) = acc[ai][0][m][n]; }
    }
};
struct EpiSwiglu {
    static constexpr bool PERM = true, AFTER_DRAIN = false;
    bf16_t* ACT; const float* b1p;
    __device__ __forceinline__ void operator()(const f32x4 (&acc)[2][2][4][2], const Unit& u, int wr, int wc, int fr, int fq) const {
        const int e = u.pn >> 3, pn = u.pn & 7;
        const int row0 = u.pm * BM + wr * 64 + fr, lc = wc * 32 + 8 * fq;
        const float* bp = b1p + (size_t)e * 2048 + pn * 256 + lc;
        f32x4 bg[2], bu[2];
#pragma unroll
        for (int n = 0; n < 2; ++n) { bg[n] = *(const f32x4*)(bp + 4 * n); bu[n] = *(const f32x4*)(bp + HALF + 4 * n); }
#pragma unroll
        for (int ai = 0; ai < 2; ++ai)
#pragma unroll
            for (int m = 0; m < 4; ++m) { bf16_t* rowp = ACT + (size_t)(row0 + ai * HALF + m * 16) * 1024 + pn * 128 + lc;
                f32x4 a[2];
#pragma unroll
                for (int n = 0; n < 2; ++n) { const f32x4 gt = acc[ai][0][m][n] + bg[n], up = acc[ai][1][m][n] + bu[n];
#pragma unroll
                    for (int i = 0; i < 4; ++i) { const float gc = fminf(gt[i], 7.0f), uc = fminf(fmaxf(up[i], -7.0f), 7.0f);
                        const float sg = __builtin_amdgcn_rcpf(1.0f + __builtin_amdgcn_exp2f(gc * (-1.702f * 1.4426950408889634f)));
                        a[n][i] = (uc + 1.0f) * (gc * sg); } }
                u32x4 w; w.x = cvt_pk_bf16(a[0][0], a[0][1]); w.y = cvt_pk_bf16(a[0][2], a[0][3]); w.z = cvt_pk_bf16(a[1][0], a[1][1]); w.w = cvt_pk_bf16(a[1][2], a[1][3]);
                *(u32x4*)rowp = w; }
    }
};
struct EpiSwiglu8 {
    static constexpr bool PERM = true, AFTER_DRAIN = false;
    unsigned char* ACT; const float* b1p;
    __device__ __forceinline__ void operator()(const f32x4 (&acc)[2][2][4][2], const Unit& u, int wr, int wc, int fr, int fq) const {
        const int e = u.pn >> 3, pn = u.pn & 7;
        const int row0 = u.pm * BM + wr * 64 + fr, lc = wc * 32 + 8 * fq;
        const float* bp = b1p + (size_t)e * 2048 + pn * 256 + lc;
        f32x4 bg[2], bu[2];
#pragma unroll
        for (int n = 0; n < 2; ++n) { bg[n] = *(const f32x4*)(bp + 4 * n); bu[n] = *(const f32x4*)(bp + HALF + 4 * n); }
#pragma unroll
        for (int ai = 0; ai < 2; ++ai)
#pragma unroll
            for (int m = 0; m < 4; ++m) { unsigned char* rowp = ACT + (size_t)(row0 + ai * HALF + m * 16) * 1024 + pn * 128 + lc;
                f32x4 a[2];
#pragma unroll
                for (int n = 0; n < 2; ++n) { const f32x4 gt = acc[ai][0][m][n] + bg[n], up = acc[ai][1][m][n] + bu[n];
#pragma unroll
                    for (int i = 0; i < 4; ++i) { const float gc = fminf(gt[i], 7.0f), uc = fminf(fmaxf(up[i], -7.0f), 7.0f);
                        const float sg = __builtin_amdgcn_rcpf(1.0f + __builtin_amdgcn_exp2f(gc * (-1.702f * 1.4426950408889634f)));
                        a[n][i] = (uc + 1.0f) * (gc * sg); } }
                int p0 = __builtin_amdgcn_cvt_pk_fp8_f32(a[0][0], a[0][1], 0, false); p0 = __builtin_amdgcn_cvt_pk_fp8_f32(a[0][2], a[0][3], p0, true);
                int p1 = __builtin_amdgcn_cvt_pk_fp8_f32(a[1][0], a[1][1], 0, false); p1 = __builtin_amdgcn_cvt_pk_fp8_f32(a[1][2], a[1][3], p1, true);
                *(u32x2*)rowp = (u32x2){(unsigned)p0, (unsigned)p1}; }
    }
};
struct EpiDown {
    static constexpr bool PERM = true, AFTER_DRAIN = false;
    bf16_t* YP; const float* b2;
    __device__ __forceinline__ void operator()(const f32x4 (&acc)[2][2][4][2], const Unit& u, int wr, int wc, int fr, int fq) const {
        const int e = u.pn >> 2, pn = u.pn & 3;
        const int row0 = u.pm * BM + wr * 64 + fr, col0 = pn * BM + wc * 32 + 8 * fq;
        const float* bp = b2 + (size_t)e * 1024 + col0;
        f32x4 bv[2][2];
#pragma unroll
        for (int bj = 0; bj < 2; ++bj)
#pragma unroll
            for (int n = 0; n < 2; ++n) bv[bj][n] = *(const f32x4*)(bp + bj * HALF + 4 * n);
#pragma unroll
        for (int ai = 0; ai < 2; ++ai)
#pragma unroll
            for (int m = 0; m < 4; ++m) { bf16_t* rowp = YP + (size_t)(row0 + ai * HALF + m * 16) * 1024 + col0;
#pragma unroll
                for (int bj = 0; bj < 2; ++bj) { const f32x4 v0 = acc[ai][bj][m][0] + bv[bj][0], v1 = acc[ai][bj][m][1] + bv[bj][1];
                    u32x4 w; w.x = cvt_pk_bf16(v0[0], v0[1]); w.y = cvt_pk_bf16(v0[2], v0[3]); w.z = cvt_pk_bf16(v1[0], v1[1]); w.w = cvt_pk_bf16(v1[2], v1[3]);
                    *(u32x4*)(rowp + bj * HALF) = w; } }
    }
};

template <class Epi, class Sched, bool ALIGN_EPI = false, bool SP2 = false, bool F8 = false>
__device__ __forceinline__ void gemm_phase(PG8_LAS unsigned char* lds, const Gemm g, const Sched& S, const Epi& E) {
    int tid_ = threadIdx.x; asm volatile("" : "+v"(tid_));
    const int tid = tid_, wid = __builtin_amdgcn_readfirstlane(tid >> 6), lane = tid & 63, wr = wid >> 2, wc = wid & 3, fr = lane & 15, fq = lane >> 4;
    int K_ = g.K; asm volatile("" : "+s"(K_));
    const int K = K_, nt = K / BK;
    unsigned voffA[2], voffB[2];
#pragma unroll
    for (int i = 0; i < 2; ++i) { int R, C; stage_rc(tid * 16 + i * 8192, R, C); const int Rb = Epi::PERM ? ((R & ~31) + perm32(R & 31)) : R;
        voffA[i] = (unsigned)(R * K + C) * 2u; voffB[i] = (unsigned)(Rb * K + C) * 2u; }
    const size_t kstep = (size_t)(BK * 2);
    const size_t hstep = (size_t)HALF * K * 2;
    const size_t tstep = 2 * hstep;
    const unsigned ldsw = (unsigned)wid * 1024u;
    const int aoff = lds_byte(wr * 64 + fr, fq * 8), boff = lds_byte(wc * 32 + fr, fq * 8);
#define PG8_SA(b, h) (((b) * 2 + (h)) * HTB)
#define PG8_SB(b, h) ((4 + (b) * 2 + (h)) * HTB)
#define PG8_STAGE(bufoff, gbase, voff) do { _Pragma("unroll") for (int _i = 0; _i < 2; ++_i) \
        __builtin_amdgcn_global_load_lds((const unsigned*)((const char*)(gbase) + (voff)[_i]), (PG8_LAS unsigned*)(lds + (bufoff) + ldsw + _i * 8192), 16, 0, 0); } while (0)
#define PG8_CAT(x0, x1) __builtin_shufflevector(__builtin_bit_cast(i32x4, x0), __builtin_bit_cast(i32x4, x1), 0, 1, 2, 3, 4, 5, 6, 7)
#define PG8_LDF(base, off) (*(const PG8_LAS bf16x8*)(lds + (base) + (off)))
#define PG8_LDA(dst, dst8, b, h) do { _Pragma("unroll") for (int m = 0; m < 4; ++m) { if constexpr (F8) dst8[m] = PG8_CAT(PG8_LDF(PG8_SA(b, h), aoff + m * 2048), PG8_LDF(PG8_SA(b, h), aoff + m * 2048 + 1024)); \
        else { _Pragma("unroll") for (int k = 0; k < 2; ++k) dst[m][k] = PG8_LDF(PG8_SA(b, h), aoff + m * 2048 + k * 1024); } } } while (0)
#define PG8_LDB(dst, dst8, b, h) do { _Pragma("unroll") for (int n = 0; n < 2; ++n) { if constexpr (F8) dst8[n] = PG8_CAT(PG8_LDF(PG8_SB(b, h), boff + n * 2048), PG8_LDF(PG8_SB(b, h), boff + n * 2048 + 1024)); \
        else { _Pragma("unroll") for (int k = 0; k < 2; ++k) dst[n][k] = PG8_LDF(PG8_SB(b, h), boff + n * 2048 + k * 1024); } } } while (0)
#define PG8_MMA(ai, bj, At, At8, Bt, Bt8) do { __builtin_amdgcn_s_setprio(1); _Pragma("unroll") for (int m = 0; m < 4; ++m) _Pragma("unroll") for (int n = 0; n < 2; ++n) { \
        if constexpr (F8) asm volatile("v_mfma_scale_f32_16x16x128_f8f6f4 %0, %1, %2, %0, %3, %4 op_sel_hi:[0,0,0]" : "+v"(acc[ai][bj][m][n]) : "v"(Bt8[n]), "v"(At8[m]), "v"(f8_sw), "v"(f8_sa));   \
        else { _Pragma("unroll") for (int k = 0; k < 2; ++k) acc[ai][bj][m][n] = __builtin_amdgcn_mfma_f32_16x16x32_bf16(Bt[n][k], At[m][k], acc[ai][bj][m][n], 0, 0, 0); } } __builtin_amdgcn_s_setprio(0); } while (0)
#define PG8_WAIT_V(n) asm volatile("s_waitcnt vmcnt(" #n ")" ::: "memory")
#define PG8_WAIT_L(n) asm volatile("s_waitcnt lgkmcnt(" #n ")" ::: "memory")
#define PG8_BAR __builtin_amdgcn_s_barrier()
#define PG8_SCHED __builtin_amdgcn_sched_barrier(0)
    Unit cur, nxt; int ui = 0;
    if (!S.next(0, cur)) return;
    f32x4 acc[2][2][4][2];
#pragma unroll
    for (int a = 0; a < 2; ++a)
#pragma unroll
        for (int b = 0; b < 2; ++b)
#pragma unroll
            for (int m = 0; m < 4; ++m)
#pragma unroll
                for (int n = 0; n < 2; ++n) acc[a][b][m][n] = (f32x4){0.f, 0.f, 0.f, 0.f};
    int f8_sw = 0x7A7A7A7A, f8_sa = 0x7F7F7F7F; asm volatile("" : "+v"(f8_sw), "+v"(f8_sa));
    bf16x8 At[4][2], B0[2][2], B1[2][2]; i32x8 At8[4], B08[2], B18[2];
    const char* cA = (const char*)g.A + (size_t)cur.pm * tstep; const char* cB = (const char*)g.Bt + (size_t)cur.pn * tstep;
    S.a_ready(cur);
    if constexpr (SP2) {
        PG8_STAGE(PG8_SB(0, 0), cB, voffB); PG8_STAGE(PG8_SB(0, 1), cB + hstep, voffB); PG8_STAGE(PG8_SA(0, 0), cA, voffA); PG8_STAGE(PG8_SA(0, 1), cA + hstep, voffA);
        if (wr == 1) PG8_BAR;
        PG8_WAIT_V(2); PG8_BAR;
        PG8_STAGE(PG8_SB(1, 0), cB + kstep, voffB); PG8_STAGE(PG8_SA(1, 0), cA + kstep, voffA); PG8_STAGE(PG8_SB(1, 1), cB + hstep + kstep, voffB);
        PG8_WAIT_V(6); PG8_BAR;
    } else {
        PG8_STAGE(PG8_SB(0, 0), cB, voffB); PG8_STAGE(PG8_SA(0, 0), cA, voffA); PG8_STAGE(PG8_SB(0, 1), cB + hstep, voffB); PG8_STAGE(PG8_SA(0, 1), cA + hstep, voffA);
        if (wr == 1) PG8_BAR;
        PG8_WAIT_V(4); PG8_BAR;
        PG8_STAGE(PG8_SB(1, 0), cB + kstep, voffB); PG8_STAGE(PG8_SA(1, 0), cA + kstep, voffA); PG8_STAGE(PG8_SB(1, 1), cB + hstep + kstep, voffB);
        PG8_WAIT_V(6); PG8_BAR;
    }
    for (;;) {
        const bool has_next = S.next(ui + 1, nxt);
        const char* nA = has_next ? (const char*)g.A + (size_t)nxt.pm * tstep : cA; const char* nB = has_next ? (const char*)g.Bt + (size_t)nxt.pn * tstep : cB;
        for (int t = 0; t < nt; t += 2) {
            const bool last = (t == nt - 2);
            const char* a1 = cA + (size_t)(t + 1) * kstep;
            const char* a2 = last ? nA : cA + (size_t)(t + 2) * kstep; const char* b2 = last ? nB : cB + (size_t)(t + 2) * kstep;
            const char* a3 = a2 + kstep; const char* b3 = b2 + kstep;
            if (last && has_next) S.a_ready(nxt);
            if constexpr (SP2) {
            PG8_LDB(B0, B08, 0, 0); PG8_LDB(B1, B18, 0, 1); PG8_SCHED; PG8_LDA(At, At8, 0, 0); PG8_STAGE(PG8_SA(1, 1), a1 + hstep, voffA);
            PG8_WAIT_V(8); PG8_WAIT_L(0); PG8_BAR; PG8_MMA(0, 0, At, At8, B0, B08); PG8_MMA(0, 1, At, At8, B1, B18); PG8_BAR; PG8_SCHED;
            PG8_LDA(At, At8, 0, 1); PG8_STAGE(PG8_SB(0, 0), b2, voffB); PG8_STAGE(PG8_SB(0, 1), b2 + hstep, voffB); PG8_STAGE(PG8_SA(0, 0), a2, voffA);
            PG8_WAIT_V(8); PG8_WAIT_L(0); PG8_BAR; PG8_MMA(1, 0, At, At8, B0, B08); PG8_MMA(1, 1, At, At8, B1, B18); PG8_BAR; PG8_SCHED;
            PG8_LDB(B0, B08, 1, 0); PG8_LDB(B1, B18, 1, 1); PG8_SCHED; PG8_LDA(At, At8, 1, 0); PG8_STAGE(PG8_SA(0, 1), a2 + hstep, voffA);
            PG8_WAIT_V(8); PG8_WAIT_L(0); PG8_BAR; PG8_MMA(0, 0, At, At8, B0, B08); PG8_MMA(0, 1, At, At8, B1, B18); PG8_BAR; PG8_SCHED;
            PG8_LDA(At, At8, 1, 1); PG8_STAGE(PG8_SB(1, 0), b3, voffB); PG8_STAGE(PG8_SB(1, 1), b3 + hstep, voffB); PG8_STAGE(PG8_SA(1, 0), a3, voffA);
            PG8_WAIT_V(8); PG8_WAIT_L(0); PG8_BAR; PG8_MMA(1, 0, At, At8, B0, B08); PG8_MMA(1, 1, At, At8, B1, B18); PG8_BAR; PG8_SCHED;
            } else {
            PG8_LDB(B0, B08, 0, 0); PG8_SCHED; PG8_LDA(At, At8, 0, 0); PG8_STAGE(PG8_SA(1, 1), a1 + hstep, voffA);
            PG8_WAIT_L(8); PG8_BAR; PG8_WAIT_L(0); PG8_MMA(0, 0, At, At8, B0, B08); PG8_BAR; PG8_SCHED;
            PG8_LDB(B1, B18, 0, 1); PG8_STAGE(PG8_SB(0, 0), b2, voffB);
            PG8_BAR; PG8_WAIT_L(0); PG8_MMA(0, 1, At, At8, B1, B18); PG8_BAR;
            PG8_LDA(At, At8, 0, 1); PG8_STAGE(PG8_SA(0, 0), a2, voffA);
            PG8_BAR; PG8_WAIT_L(0); PG8_MMA(1, 0, At, At8, B0, B08); PG8_BAR; PG8_SCHED;
            PG8_STAGE(PG8_SB(0, 1), b2 + hstep, voffB);
            PG8_WAIT_V(6); PG8_BAR; PG8_MMA(1, 1, At, At8, B1, B18); PG8_BAR;
            PG8_LDB(B0, B08, 1, 0); PG8_SCHED; PG8_LDA(At, At8, 1, 0); PG8_STAGE(PG8_SA(0, 1), a2 + hstep, voffA);
            PG8_WAIT_L(8); PG8_BAR; PG8_WAIT_L(0); PG8_MMA(0, 0, At, At8, B0, B08); PG8_BAR; PG8_SCHED;
            PG8_LDB(B1, B18, 1, 1); PG8_STAGE(PG8_SB(1, 0), b3, voffB);
            PG8_BAR; PG8_WAIT_L(0); PG8_MMA(0, 1, At, At8, B1, B18); PG8_BAR;
            PG8_LDA(At, At8, 1, 1); PG8_STAGE(PG8_SA(1, 0), a3, voffA);
            PG8_BAR; PG8_WAIT_L(0); PG8_MMA(1, 0, At, At8, B0, B08); PG8_BAR; PG8_SCHED;
            PG8_STAGE(PG8_SB(1, 1), b3 + hstep, voffB);
            PG8_WAIT_V(6); PG8_BAR; PG8_MMA(1, 1, At, At8, B1, B18); PG8_BAR;
            }
        }
        if constexpr (ALIGN_EPI) { if (wr == 0) PG8_BAR; }
        if constexpr (F8) asm volatile("s_nop 15\n\ts_nop 15" ::: "memory");
        if constexpr (!Epi::AFTER_DRAIN) { E(acc, cur, wr, wc, fr, fq); S.done(cur); }
        if (!has_next) break;
#pragma unroll
        for (int a = 0; a < 2; ++a)
#pragma unroll
            for (int b = 0; b < 2; ++b)
#pragma unroll
                for (int m = 0; m < 4; ++m)
#pragma unroll
                    for (int n = 0; n < 2; ++n) acc[a][b][m][n] = (f32x4){0.f, 0.f, 0.f, 0.f};
        cur = nxt; cA = nA; cB = nB; ++ui;
        if constexpr (ALIGN_EPI) { if (wr == 1) PG8_BAR; }
    }
    PG8_WAIT_V(0);
    if constexpr (!ALIGN_EPI) { if (wr == 0) PG8_BAR; }
    PG8_BAR;
    if constexpr (Epi::AFTER_DRAIN) { E.fused(acc, cur, wr, wc, fr, fq, lds, wid, lane); S.done(cur); }
#undef PG8_SA
#undef PG8_SB
#undef PG8_STAGE
#undef PG8_LDA
#undef PG8_LDF
#undef PG8_LDB
#undef PG8_MMA
#undef PG8_CAT
#undef PG8_WAIT_V
#undef PG8_WAIT_L
#undef PG8_BAR
#undef PG8_SCHED
}
}
#ifndef ATTN_STORE16
#define ATTN_STORE16(p,v) (*(u32x4*)(p)=(v))
#endif
namespace attn_body {
using bf16=__hip_bfloat16;
using bf16x8=__attribute__((ext_vector_type(8)))short;
using s16x4=__attribute__((ext_vector_type(4)))short;
using f32x16=__attribute__((ext_vector_type(16)))float;
using u32x4=__attribute__((ext_vector_type(4)))unsigned;
constexpr int D=64,PQ=2048,PO=1024,KOFF=512,VOFF=640;
constexpr int NW=8,QBLK=32,QB=QBLK*NW,KVBLK=64;
__device__ __forceinline__ int crow(int r,int hi){return (r&3)+8*(r>>2)+4*hi;}
#define SBAR() __builtin_amdgcn_sched_barrier(0)
constexpr int NSLOT=3, SLOTB=8192;
constexpr int LDS_K=0, LDS_V=NSLOT*SLOTB, LDS_WS=2*NSLOT*SLOTB, LDS_OST=LDS_WS+NW*64*4, LDS_BYTES=LDS_OST+NW*4096;
constexpr float C2=0.125f*1.4426950408889634f;
__device__ __forceinline__ void glds16(const void*gsrc,unsigned lds_dst){unsigned keep;
  asm volatile("s_mov_b32 %0, m0\n\ts_mov_b32 m0, %2\n\ts_nop 0\n\tglobal_load_lds_dwordx4 %1, off\n\ts_mov_b32 m0, %0":"=&s"(keep):"v"(gsrc),"s"(lds_dst):"memory");}
__device__ __forceinline__ float max3f(float a,float b,float c){float r;asm("v_max3_f32 %0, %1, %2, %3":"=v"(r):"v"(a),"v"(b),"v"(c));return r;}
__device__ __forceinline__ float max2f(float a,float b){float r;asm("v_max_f32_e32 %0, %1, %2":"=v"(r):"v"(a),"v"(b));return r;}
__device__ __forceinline__ float fadd_s(float a,float b){float r;asm("v_add_f32_e32 %0, %1, %2":"=v"(r):"v"(a),"v"(b));return r;}
__device__ __forceinline__ float fsub_s(float a,float b){float r;asm("v_sub_f32_e32 %0, %1, %2":"=v"(r):"v"(a),"v"(b));return r;}
typedef float f32x2_t __attribute__((ext_vector_type(2))); typedef __bf16 bf16x2_t __attribute__((ext_vector_type(2)));
__device__ __forceinline__ unsigned cvtpk_s(float lo,float hi){f32x2_t v={lo,hi};bf16x2_t b=__builtin_convertvector(v,bf16x2_t);return __builtin_bit_cast(unsigned,b);}
#define WAIT_BAR(N) asm volatile("s_waitcnt vmcnt(" #N ") lgkmcnt(0)\n\ts_barrier":::"memory")

__device__ __forceinline__ void qkt(f32x16&p0,f32x16&p1,const char*Kslot,const bf16x8*qr,const f32x16&negm,int r32,int hi){
  const char*kb=Kslot+hi*1024+r32*16;
  #pragma unroll
  for(int d0=0;d0<4;++d0){
    const bf16x8 b0=*reinterpret_cast<const bf16x8*>(kb+d0*2048);
    const bf16x8 b1=*reinterpret_cast<const bf16x8*>(kb+d0*2048+512);
    if(d0==0){p0=__builtin_amdgcn_mfma_f32_32x32x16_bf16(b0,qr[0],negm,0,0,0);p1=__builtin_amdgcn_mfma_f32_32x32x16_bf16(b1,qr[0],negm,0,0,0);}
    else{p0=__builtin_amdgcn_mfma_f32_32x32x16_bf16(b0,qr[d0],p0,0,0,0);p1=__builtin_amdgcn_mfma_f32_32x32x16_bf16(b1,qr[d0],p1,0,0,0);}}
}
typedef __attribute__((address_space(3))) const char* lds_cptr;
typedef short v4i16_t __attribute__((ext_vector_type(4)));
__device__ __forceinline__ void kload8(bf16x8*kf,lds_cptr kp){
  kf[0]=*(const __attribute__((address_space(3))) bf16x8*)(kp);      kf[1]=*(const __attribute__((address_space(3))) bf16x8*)(kp+512);
  kf[2]=*(const __attribute__((address_space(3))) bf16x8*)(kp+2048); kf[3]=*(const __attribute__((address_space(3))) bf16x8*)(kp+2560);
  kf[4]=*(const __attribute__((address_space(3))) bf16x8*)(kp+4096); kf[5]=*(const __attribute__((address_space(3))) bf16x8*)(kp+4608);
  kf[6]=*(const __attribute__((address_space(3))) bf16x8*)(kp+6144); kf[7]=*(const __attribute__((address_space(3))) bf16x8*)(kp+6656);
}
__device__ __forceinline__ void kload2(bf16x8*kf,lds_cptr kp,int j){ kf[2*j]=*(const __attribute__((address_space(3))) bf16x8*)(kp+j*2048); kf[2*j+1]=*(const __attribute__((address_space(3))) bf16x8*)(kp+j*2048+512); }
__device__ __forceinline__ s16x4 vtr(lds_cptr p){ return __builtin_bit_cast(s16x4,__builtin_amdgcn_ds_read_tr16_b64_v4i16((__attribute__((address_space(3))) v4i16_t*)p)); }
__device__ __forceinline__ float rowmax(const f32x16&p0,const f32x16&p1){
  float a=max3f(p0[0],p0[1],p1[0]),b=max3f(p0[2],p0[3],p1[1]);a=max3f(a,p1[2],p1[3]);
  #pragma unroll
  for(int r=4;r<16;r+=4){a=max3f(a,p0[r],p0[r+1]);b=max3f(b,p0[r+2],p0[r+3]);a=max3f(a,p1[r],p1[r+1]);b=max3f(b,p1[r+2],p1[r+3]);}
  const float m=max2f(a,b);
  auto rr=__builtin_amdgcn_permlane32_swap(__float_as_uint(m),__float_as_uint(m),false,false);
  return max2f(__uint_as_float(rr[0]),__uint_as_float(rr[1]));
}
__device__ __forceinline__ void pv(f32x16*o,int vb,bf16x8 pa0,bf16x8 pa1,bf16x8 pa2,bf16x8 pa3){
  #pragma unroll
  for(int d0=0;d0<2;++d0){s16x4 lo[4],hi[4];
    #pragma unroll
    for(int ks=0;ks<4;++ks){
      asm volatile("ds_read_b64_tr_b16 %0,%1 offset:%c2":"=&v"(lo[ks]):"v"(vb),"i"(d0*4096+ks*1024):"memory");
      asm volatile("ds_read_b64_tr_b16 %0,%1 offset:%c2":"=&v"(hi[ks]):"v"(vb),"i"(d0*4096+ks*1024+512):"memory");}
    asm volatile("s_waitcnt lgkmcnt(0)":::"memory");SBAR();
    #define PK(k) (bf16x8){lo[k][0],lo[k][1],lo[k][2],lo[k][3],hi[k][0],hi[k][1],hi[k][2],hi[k][3]}
    o[d0]=__builtin_amdgcn_mfma_f32_32x32x16_bf16(pa0,PK(0),o[d0],0,0,0);
    o[d0]=__builtin_amdgcn_mfma_f32_32x32x16_bf16(pa1,PK(1),o[d0],0,0,0);
    o[d0]=__builtin_amdgcn_mfma_f32_32x32x16_bf16(pa2,PK(2),o[d0],0,0,0);
    o[d0]=__builtin_amdgcn_mfma_f32_32x32x16_bf16(pa3,PK(3),o[d0],0,0,0);
    #undef PK
  }
}

template<int THRL> __device__ __forceinline__ void attn_unit(long qrow0,long krow0,int NTarg,int h,const bf16*Pq,bf16*Yo,char*shm){
  int tid_=threadIdx.x; asm volatile("":"+v"(tid_)); const int tid=tid_,lane=tid&63,r32=lane&31,hi=lane>>5; const int wid=__builtin_amdgcn_readfirstlane(tid>>6);
  const bf16*Qw=Pq+(qrow0+wid*QBLK)*PQ+h*D;
  const bf16*Kh=Pq+krow0*PQ+KOFF+(h>>2)*D,*Vh=Pq+krow0*PQ+VOFF+(h>>2)*D;
  const unsigned lds0=(unsigned)(uintptr_t)shm;
  float*wsf=(float*)(shm+LDS_WS)+wid*64;
  const bf16*ksrc=Kh+(long)lane*PQ+wid*8;
  const bf16*vsrc=Vh+(long)(16*(wid&3)+(lane>>2))*PQ+(wid>>2)*32+(lane&3)*8;
  const unsigned kdst=lds0+LDS_K+wid*1024, vdst=lds0+LDS_V+wid*1024;
  #define DMA_K(t,slot) glds16(ksrc+(long)(t)*KVBLK*PQ,(unsigned)__builtin_amdgcn_readfirstlane(kdst+(slot)))
  #define DMA_V(t,slot) glds16(vsrc+(long)(t)*KVBLK*PQ,(unsigned)__builtin_amdgcn_readfirstlane(vdst+(slot)))
  const int vb0=(int)(lds0+LDS_V)+((lane>>4)&1)*32+(lane&3)*8+(4*hi+((lane&15)>>2))*64;
  const char*Kbase=shm+LDS_K; bf16x8 kf[8];
  const lds_cptr shm3=(lds_cptr)shm; const lds_cptr kp0=shm3+LDS_K+hi*1024+r32*16; const lds_cptr vp0=shm3+LDS_V+((lane>>4)&1)*32+(lane&3)*8+(4*hi+((lane&15)>>2))*64;
  const int NT=NTarg;
  DMA_K(0,0);DMA_V(0,0);DMA_K(1,SLOTB);
  bf16x8 qr[4];
  #pragma unroll
  for(int d0=0;d0<4;++d0)qr[d0]=*reinterpret_cast<const bf16x8*>(&Qw[(long)r32*PQ+d0*16+hi*8]);
  float mhat=0.f,l_reg=0.f;f32x16 o[2];o[0]=f32x16{};o[1]=f32x16{};f32x16 negm=f32x16{};asm volatile("":"+v"(negm));

  #define CMASK(P0,P1,t) do{}while(0)
  bool resc=false;
  #define START(P0,P1) do{ const float rm=rowmax(P0,P1); resc=false; \
    { const float dl=rm; mhat=fadd_s(mhat,dl); \
      _Pragma("unroll") for(int r=0;r<16;++r){P0[r]=fsub_s(P0[r],dl);P1[r]=fsub_s(P1[r],dl);} \
      _Pragma("unroll") for(int r=0;r<16;++r)negm[r]=-mhat; asm volatile("":"+v"(negm)); } \
    _Pragma("unroll") for(int r=0;r<16;++r)P0[r]=__builtin_amdgcn_exp2f(P0[r]); }while(0)
  #define RESC() do{ if(resc){ asm volatile("s_waitcnt lgkmcnt(0)":::"memory"); \
      _Pragma("unroll") for(int d_=0;d_<2;++d_) _Pragma("unroll") for(int r=0;r<16;++r)o[d_][r]*=wsf[crow(r,hi)]; } }while(0)
  f32x16 pA0,pA1,pB0,pB1;
  int sl_prev=0,sl_cur=0,sl_next=SLOTB;
  #define ROT() do{sl_prev=sl_cur;sl_cur=sl_next;sl_next=(sl_next==(NSLOT-1)*SLOTB)?0:sl_next+SLOTB;}while(0)
  DMA_K(2,2*SLOTB);
  WAIT_BAR(3);
  qkt(pA0,pA1,Kbase,qr,negm,r32,hi);asm volatile("s_nop 15\n\ts_nop 7":"+v"(pA0),"+v"(pA1));CMASK(pA0,pA1,0);
  START(pA0,pA1);
  _Pragma("unroll") for(int r=0;r<16;++r)pA1[r]=__builtin_amdgcn_exp2f(pA1[r]);
  WAIT_BAR(0);
  DMA_K(3,0);DMA_V(1,SLOTB);
  ROT();
  kload8(kf,kp0+sl_cur);
  WAIT_BAR(2);
  s16x4 vlo[8],vhi[8]; u32x4 pw0,pw1,pw2,pw3;
  #define PKW(P,B) cvtpk_s(P[B],P[B+1])
  #define PAF(k) __builtin_bit_cast(bf16x8,pw##k)
  #define VFR(i) (bf16x8){vlo[i][0],vlo[i][1],vlo[i][2],vlo[i][3],vhi[i][0],vhi[i][1],vhi[i][2],vhi[i][3]}
  #define PIN(x) asm volatile("":"+v"(x))
  #define MX3(a,b,c) __builtin_fmaxf(__builtin_fmaxf((a),(b)),(c))
  #define GAPA(MF,A0,A1,A2,A3,W0,W1,PW) do{ MF; sacc+=A0; sacc+=A1; sacc+=A2; sacc+=A3; PIN(sacc); W0; W1; PIN(PW); SBAR(); }while(0)
  #define EX(v) __builtin_amdgcn_exp2f(v)
  #define GAPB(MF,X,B) do{ MF; X[B]=EX(X[B]); X[B+1]=EX(X[B+1]); X[B+2]=EX(X[B+2]); X[B+3]=EX(X[B+3]); PIN(X); SBAR(); }while(0)
  #define VRD(i) do{ vlo[i]=vtr(vp_+(((i)>>2)*4096+((i)&3)*1024)); vhi[i]=vtr(vp_+(((i)>>2)*4096+((i)&3)*1024+512)); }while(0)
  #define KRD(G,j) do{ if(G){ kload2(kf,kp0+sl_next,j); SBAR(); } }while(0)
  #define STEP(C0,C1,P0,P1,t,GK,GV,GL) do{ SBAR(); \
    const lds_cptr vp_=vp0+sl_prev; \
    VRD(0); SBAR(); float sacc=(P0[0]+P0[1]); \
    GAPA(C0=__builtin_amdgcn_mfma_f32_32x32x16_bf16(kf[0],qr[0],negm,0,0,0), P0[2],P0[3],P0[4],P0[5],     pw0[0]=PKW(P0,0), pw0[1]=PKW(P0,2), pw0); \
    VRD(4); SBAR(); GAPA(C1=__builtin_amdgcn_mfma_f32_32x32x16_bf16(kf[1],qr[0],negm,0,0,0), P0[6],P0[7],P0[8],P0[9],     pw0[2]=PKW(P0,4), pw0[3]=PKW(P0,6), pw0); \
    VRD(1); SBAR(); GAPA(C0=__builtin_amdgcn_mfma_f32_32x32x16_bf16(kf[2],qr[1],C0,0,0,0),   P0[10],P0[11],P0[12],P0[13], pw1[0]=PKW(P0,8), pw1[1]=PKW(P0,10), pw1); \
    VRD(5); SBAR(); GAPA(C1=__builtin_amdgcn_mfma_f32_32x32x16_bf16(kf[3],qr[1],C1,0,0,0),   P0[14],P0[15],P1[0],P1[1],   pw1[2]=PKW(P0,12),pw1[3]=PKW(P0,14), pw1); \
    VRD(2); SBAR(); GAPA(C0=__builtin_amdgcn_mfma_f32_32x32x16_bf16(kf[4],qr[2],C0,0,0,0),   P1[2],P1[3],P1[4],P1[5],     pw2[0]=PKW(P1,0), pw2[1]=PKW(P1,2), pw2); \
    VRD(6); SBAR(); GAPA(C1=__builtin_amdgcn_mfma_f32_32x32x16_bf16(kf[5],qr[2],C1,0,0,0),   P1[6],P1[7],P1[8],P1[9],     pw2[2]=PKW(P1,4), pw2[3]=PKW(P1,6), pw2); \
    VRD(3); SBAR(); GAPA(C0=__builtin_amdgcn_mfma_f32_32x32x16_bf16(kf[6],qr[3],C0,0,0,0),   P1[10],P1[11],P1[12],P1[13], pw3[0]=PKW(P1,8), pw3[1]=PKW(P1,10), pw3); \
    VRD(7); SBAR(); GAPA(C1=__builtin_amdgcn_mfma_f32_32x32x16_bf16(kf[7],qr[3],C1,0,0,0),   P1[14],P1[15],0.f,0.f,       pw3[2]=PKW(P1,12),pw3[3]=PKW(P1,14), pw3); \
    l_reg+=sacc; \
    if(GK){DMA_K((t)+3,sl_cur);} if(GV){DMA_V((t)+1,sl_next);} \
    CMASK(C0,C1,t); \
    { float a=MX3(C0[0],C0[1],C1[0]),b=MX3(C0[2],C0[3],C1[1]); a=MX3(a,C1[2],C1[3]); \
      _Pragma("unroll") for(int r=4;r<16;r+=4){a=MX3(a,C0[r],C0[r+1]);b=MX3(b,C0[r+2],C0[r+3]);a=MX3(a,C1[r],C1[r+1]);b=MX3(b,C1[r+2],C1[r+3]);} \
      float rm=__builtin_fmaxf(a,b); { auto rr=__builtin_amdgcn_permlane32_swap(__float_as_uint(rm),__float_as_uint(rm),false,false); rm=__builtin_fmaxf(__uint_as_float(rr[0]),__uint_as_float(rr[1])); } \
      resc=false; \
      if(__builtin_expect(__any(rm>(float)THRL),0)){ const float dl=__builtin_fmaxf(rm,0.f); mhat+=dl; \
        _Pragma("unroll") for(int r=0;r<16;++r){C0[r]-=dl;C1[r]-=dl;} \
        _Pragma("unroll") for(int r=0;r<16;++r)negm[r]=-mhat; asm volatile("":"+v"(negm)); \
        const float f=__builtin_amdgcn_exp2f(-dl); l_reg*=f; if(hi==0)wsf[r32]=f; resc=true; } } \
    SBAR(); \
    GAPB(o[0]=__builtin_amdgcn_mfma_f32_32x32x16_bf16(PAF(0),VFR(0),o[0],0,0,0), C0,0); \
    GAPB(o[1]=__builtin_amdgcn_mfma_f32_32x32x16_bf16(PAF(0),VFR(4),o[1],0,0,0), C0,4); \
    KRD(GL,0); GAPB(o[0]=__builtin_amdgcn_mfma_f32_32x32x16_bf16(PAF(1),VFR(1),o[0],0,0,0), C0,8); \
    KRD(GL,1); GAPB(o[1]=__builtin_amdgcn_mfma_f32_32x32x16_bf16(PAF(1),VFR(5),o[1],0,0,0), C0,12); \
    KRD(GL,2); GAPB(o[0]=__builtin_amdgcn_mfma_f32_32x32x16_bf16(PAF(2),VFR(2),o[0],0,0,0), C1,0); \
    KRD(GL,3); GAPB(o[1]=__builtin_amdgcn_mfma_f32_32x32x16_bf16(PAF(2),VFR(6),o[1],0,0,0), C1,4); \
    GAPB(o[0]=__builtin_amdgcn_mfma_f32_32x32x16_bf16(PAF(3),VFR(3),o[0],0,0,0), C1,8); \
    GAPB(o[1]=__builtin_amdgcn_mfma_f32_32x32x16_bf16(PAF(3),VFR(7),o[1],0,0,0), C1,12); \
    }while(0)
  int t=1;
  #undef CMASK
  #define CMASK(P0,P1,t) do{}while(0)
  for(;t+5<NT;t+=2){
    STEP(pB0,pB1,pA0,pA1,t,true,true,true);     WAIT_BAR(2); RESC(); ROT();
    STEP(pA0,pA1,pB0,pB1,t+1,true,true,true);   WAIT_BAR(2); RESC(); ROT();
  }
  #undef CMASK
  #define CMASK(P0,P1,t) do{}while(0)
  #define ENDW(tt) do{ if((tt)+3<NT){WAIT_BAR(2);} else if((tt)+2<NT){WAIT_BAR(1);} else {WAIT_BAR(0);} }while(0)
  for(;t+1<NT;t+=2){
    STEP(pB0,pB1,pA0,pA1,t,(t+3<NT),(t+1<NT),(t+1<NT));       ENDW(t);   RESC(); ROT();
    STEP(pA0,pA1,pB0,pB1,t+1,(t+4<NT),(t+2<NT),(t+2<NT));     ENDW(t+1); RESC(); ROT();
  }
  STEP(pB0,pB1,pA0,pA1,NT-1,false,false,false); RESC();
  { float sacc=pB0[0]+pB0[1]; _Pragma("unroll") for(int r=2;r<16;++r)sacc+=pB0[r]; _Pragma("unroll") for(int r=0;r<16;++r)sacc+=pB1[r]; l_reg+=sacc;
    pw0=(u32x4){PKW(pB0,0),PKW(pB0,2),PKW(pB0,4),PKW(pB0,6)};pw1=(u32x4){PKW(pB0,8),PKW(pB0,10),PKW(pB0,12),PKW(pB0,14)};pw2=(u32x4){PKW(pB1,0),PKW(pB1,2),PKW(pB1,4),PKW(pB1,6)};pw3=(u32x4){PKW(pB1,8),PKW(pB1,10),PKW(pB1,12),PKW(pB1,14)};
    SBAR(); pv(o,vb0+sl_cur,PAF(0),PAF(1),PAF(2),PAF(3)); }
  #undef PKW
  #undef PAF
  #undef VFR
  #undef PIN
  #undef MX3
  #undef GAPA
  #undef GAPB
  #undef EX
  #undef VRD
  #undef KRD
  #undef STEP
  #undef ENDW
  {auto rr=__builtin_amdgcn_permlane32_swap(__float_as_uint(l_reg),__float_as_uint(l_reg),false,false);l_reg=__uint_as_float(rr[0])+__uint_as_float(rr[1]);}
  if(hi==0)wsf[32+r32]=l_reg;asm volatile("s_waitcnt lgkmcnt(0)":::"memory");
  float rli[16];
  #pragma unroll
  for(int r=0;r<16;++r)rli[r]=__builtin_amdgcn_rcpf(wsf[32+crow(r,hi)]);
  bf16*Ow=Yo+(qrow0+wid*QBLK)*PO+h*D;
  { bf16*stg=(bf16*)(shm+LDS_OST)+wid*2048;
    #pragma unroll
    for(int r=0;r<16;++r){const int orow=crow(r,hi);
      #pragma unroll
      for(int d0=0;d0<2;++d0)stg[orow*64+d0*32+r32]=__float2bfloat16(o[d0][r]*rli[r]);}
    asm volatile("s_waitcnt lgkmcnt(0)":::"memory");
    #pragma unroll
    for(int i=0;i<4;++i){const int row=i*8+(lane>>3),ch=lane&7; const u32x4 v=*(const u32x4*)(stg+row*64+ch*8); ATTN_STORE16(Ow+(long)row*PO+ch*8,v);} }
  asm volatile("s_waitcnt lgkmcnt(0)\n\ts_barrier":::"memory");
  #undef DMA_K
  #undef DMA_V
  #undef CMASK
  #undef START
  #undef RESC
  #undef ROT
}
constexpr int ATTN_LDS_BYTES=LDS_BYTES;
#undef SBAR
#undef WAIT_BAR
}
#ifndef MK_FP8
#define MK_FP8 1
#endif
namespace mk {
constexpr int NB = 16, SQ = 4096, CL = 256, SEG = SQ + CL, T = NB * SEG, D = 1024, INW = 2048, NL = 4, NE = 32;
constexpr int NROWT = T / 256;
constexpr int MAXRT = 1120, CAP = MAXRT * 256;
constexpr int MODW = 6 * D;
constexpr float EPS = 1e-6f;
constexpr int NWAVES = 8;
constexpr int PPL = 12, NPHASE = 2 + NL * PPL;

constexpr size_t MiB = 1u << 20;
constexpr size_t WS_CTL = 0, CTL_ZERO_BYTES = 1 * MiB;
constexpr size_t WS_MOD = 4 * MiB;
constexpr size_t WS_B1P = 6 * MiB;
constexpr size_t WS_PAIR = 8 * MiB;
constexpr size_t WS_TOK = 12 * MiB;
constexpr size_t WS_LOG = 22 * MiB;
constexpr size_t WS_WINT = 32 * MiB;
constexpr size_t WS_WOUTT = 50 * MiB;
constexpr size_t WS_WRT = 60 * MiB;
constexpr size_t WS_W1T = 64 * MiB;
constexpr size_t WS_W2T = 576 * MiB;
constexpr size_t WS_X = 832 * MiB;
constexpr size_t WS_HB = 1104 * MiB;
constexpr size_t WS_P = 1240 * MiB;
constexpr size_t WS_Y = 1512 * MiB;
constexpr size_t WS_HP = 1648 * MiB;
constexpr size_t WS_ACT = 2208 * MiB;
constexpr size_t WS_YP = 2768 * MiB;
constexpr size_t WS_HB8 = 3328 * MiB;
constexpr size_t WS_END = 3400 * MiB;
static_assert(WS_MOD + (size_t)NL * 17 * MODW * 4 <= WS_B1P && WS_B1P + (size_t)NL * NE * 2048 * 4 <= WS_PAIR && WS_PAIR + (size_t)T * 32 <= WS_TOK && WS_TOK + (size_t)NE * T * 4 <= WS_LOG && WS_LOG + (size_t)T * 128 <= WS_WINT, "ws map 1");
static_assert(WS_WINT + (size_t)NL * 2048 * 1024 * 2 <= WS_WOUTT && WS_WOUTT + (size_t)NL * 1024 * 1024 * 2 <= WS_WRT && WS_WRT + (size_t)NL * 256 * 1024 * 2 <= WS_W1T && WS_W1T + (size_t)NL * NE * 2048 * 1024 * 2 <= WS_W2T && WS_W2T + (size_t)NL * NE * 1024 * 1024 * 2 <= WS_X, "ws map 2");
static_assert(WS_X + (size_t)T * 4096 <= WS_HB && WS_HB + (size_t)T * 2048 <= WS_P && WS_P + (size_t)T * 4096 <= WS_Y && WS_Y + (size_t)T * 2048 <= WS_HP && WS_HP + (size_t)CAP * 2048 <= WS_ACT && WS_ACT + (size_t)CAP * 2048 <= WS_YP && WS_YP + (size_t)CAP * 2048 <= WS_HB8 && WS_HB8 + (size_t)T * 1024 <= WS_END, "ws map 3");
constexpr int CW_BAR = 4096;
constexpr int CW_CNT = 65536;
constexpr int RING_BYTES = 131072;
constexpr int ROPE_OFF = RING_BYTES;
constexpr int T2E_OFF = ROPE_OFF + 8192;
constexpr int MISC_OFF = T2E_OFF + 2048;
constexpr int LDS_BYTES = 147456;
static_assert(MISC_OFF + 1024 <= LDS_BYTES, "LDS map");

#define GAS __attribute__((address_space(1)))
#define LAS __attribute__((address_space(3)))
typedef unsigned short bf16;
typedef unsigned v4u __attribute__((ext_vector_type(4)));
typedef unsigned v2u __attribute__((ext_vector_type(2)));
typedef float f32x4 __attribute__((ext_vector_type(4)));
typedef float f32x2 __attribute__((ext_vector_type(2)));
typedef GAS unsigned gu32;
#define RLX_AGENT __ATOMIC_RELAXED, __HIP_MEMORY_SCOPE_AGENT
#define LDS_WAIT() asm volatile("s_waitcnt lgkmcnt(0)" ::: "memory")
#define VM_WAIT() asm volatile("s_waitcnt vmcnt(0)" ::: "memory")
__device__ __forceinline__ unsigned f2bf(float f) { unsigned u = __builtin_bit_cast(unsigned, f); return (u + 0x7fffu + ((u >> 16) & 1u)) >> 16; }
__device__ __forceinline__ unsigned pk2(float lo, float hi) { return f2bf(lo) | (f2bf(hi) << 16); }
__device__ __forceinline__ float bflo(unsigned w) { return __builtin_bit_cast(float, w << 16); }
__device__ __forceinline__ float bfhi(unsigned w) { return __builtin_bit_cast(float, w & 0xffff0000u); }
__device__ __forceinline__ f32x4 bf4(v2u w) { return (f32x4){bflo(w.x), bfhi(w.x), bflo(w.y), bfhi(w.y)}; }
__device__ __forceinline__ v2u pk4(f32x4 v) { return (v2u){pk2(v.x, v.y), pk2(v.z, v.w)}; }
__device__ __forceinline__ float wave_sum(float v) {
#pragma unroll
    for (int o = 1; o < 64; o <<= 1) v += __shfl_xor(v, o);
    return v;
}
__device__ __forceinline__ float sum4(f32x4 v) { return (v.x + v.y) + (v.z + v.w); }
__device__ __forceinline__ float sigmoidf_(float z) { return __builtin_amdgcn_rcpf(1.0f + __builtin_amdgcn_exp2f(z * -1.4426950408889634f)); }
template <int I> __device__ __forceinline__ const float* ldin() { const GAS float* p;
    asm volatile("s_load_dwordx2 %0, %1, %2\n\ts_waitcnt lgkmcnt(0)" : "=s"(p) : "s"(__builtin_amdgcn_kernarg_segment_ptr()), "n"(I * 8) : "memory"); return (const float*)p; }
__device__ __forceinline__ float* ldout() { GAS float* p;
    asm volatile("s_load_dwordx2 %0, %1, %2\n\ts_waitcnt lgkmcnt(0)" : "=s"(p) : "s"(__builtin_amdgcn_kernarg_segment_ptr()), "n"(24 * 8) : "memory"); return (float*)p; }
#define XB_TMO      128
#define XB_XCNT(j)  (256  + 64 * (j))
#define XB_XSUB(j)  (1280 + 64 * (j))
#define XB_XGEN(j)  (2304 + 64 * (j))
#define XB_TOP      3328
#define XB_TOPGEN   3392
#define XCD_BAR_WORDS 3456
#define XB_SPIN_CAP (1u << 22)

__device__ __forceinline__ unsigned xb_ld(unsigned* p)              { return __hip_atomic_load(p, __ATOMIC_RELAXED, __HIP_MEMORY_SCOPE_AGENT); }
__device__ __forceinline__ unsigned xb_add(unsigned* p, unsigned v) { return __hip_atomic_fetch_add(p, v, __ATOMIC_RELAXED, __HIP_MEMORY_SCOPE_AGENT); }
__device__ __forceinline__ unsigned xb_xcc_id() { return (unsigned)__builtin_amdgcn_s_getreg((3 << 11) | 20) & 0xFu; }
#define XB_SPIN(cond, bar) do { unsigned _sp = 0; while (cond) { __builtin_amdgcn_s_sleep(1); \
    if ((++_sp & 255u) == 0u) { if (xb_ld(&(bar)[XB_TMO])) break; if (_sp > XB_SPIN_CAP) { atomicAdd(&(bar)[XB_TMO], 1u); break; } } } } while (0)

struct XcdBarrier {
    unsigned* bar; unsigned x;
    volatile LAS unsigned* st;
};

__device__ __forceinline__ XcdBarrier xcd_barrier_post(unsigned* bar, volatile LAS unsigned* st) {
    XcdBarrier b; b.bar = bar; b.x = xb_xcc_id(); b.st = st;
    if (threadIdx.x == 0) (void)xb_add(&bar[XB_XCNT(b.x)], 1u);
    return b;
}
__device__ __forceinline__ void xcd_barrier_complete(unsigned* bar, unsigned x, unsigned& nloc, unsigned& nx) {
    const unsigned G = gridDim.x * gridDim.y * gridDim.z;
    unsigned sum, cnt, mine, sp = 0u;
    for (;;) {
        sum = 0u; cnt = 0u; mine = 0u;
#pragma unroll
        for (unsigned j = 0; j < 16; ++j) { const unsigned c = xb_ld(&bar[XB_XCNT(j)]); sum += c; cnt += (c > 0u) ? 1u : 0u; mine = (j == x) ? c : mine; }
        if (sum == G) break;
        __builtin_amdgcn_s_sleep(1);
        if ((++sp & 255u) == 0u) { if (xb_ld(&bar[XB_TMO])) break; if (sp > XB_SPIN_CAP) { atomicAdd(&bar[XB_TMO], 1u); break; } }
    }
    nloc = mine > 0u ? mine : 1u; nx = cnt > 0u ? cnt : 1u;
}

__device__ __forceinline__ void xcd_barrier(const XcdBarrier& b) {
    asm volatile("s_waitcnt vmcnt(0)" ::: "memory");
    __syncthreads();
    if (threadIdx.x == 0) {
        unsigned* bar = b.bar;
        __builtin_amdgcn_s_waitcnt(0);
        unsigned nloc = b.st[0], nx = b.st[1];
        if (nloc == 0u) { xcd_barrier_complete(bar, b.x, nloc, nx); b.st[0] = nloc; b.st[1] = nx; }
        const unsigned old = xb_add(&bar[XB_XSUB(b.x)], 1u);
        const unsigned gen = old / nloc;
        if (old + 1u == (gen + 1u) * nloc) {
            __builtin_amdgcn_fence(__ATOMIC_RELEASE, "agent");
            asm volatile("s_waitcnt vmcnt(0)" ::: "memory");
            const unsigned og = xb_add(&bar[XB_TOP], 1u);
            const unsigned tg = og / nx;
            if (og + 1u == (tg + 1u) * nx) xb_add(&bar[XB_TOPGEN], 1u);
            else XB_SPIN(xb_ld(&bar[XB_TOPGEN]) == tg, bar);
            __builtin_amdgcn_fence(__ATOMIC_ACQUIRE, "agent");
            xb_add(&bar[XB_XGEN(b.x)], 1u);
            asm volatile("s_waitcnt vmcnt(0)" ::: "memory");
        } else {
            XB_SPIN(xb_ld(&bar[XB_XGEN(b.x)]) == gen, bar);
            __builtin_amdgcn_fence(__ATOMIC_ACQUIRE, "agent");
            asm volatile("s_waitcnt vmcnt(0)" ::: "memory");
        }
    }
    __syncthreads();
}

struct Ctx {
    LAS unsigned char* lds; volatile LAS unsigned* MISC; gu32* ctl;
    int tid, lane, wave, vcu, G, gw, ngw;
    GAS unsigned char* ws;
    __device__ __forceinline__ float* MOD() const { return (float*)(ws + WS_MOD); }
    __device__ __forceinline__ float* B1P() const { return (float*)(ws + WS_B1P); }
    __device__ __forceinline__ float* LOG() const { return (float*)(ws + WS_LOG); }
    __device__ __forceinline__ float* X() const { return (float*)(ws + WS_X); }
    __device__ __forceinline__ v2u* PAIR() const { return (v2u*)(ws + WS_PAIR); }
    __device__ __forceinline__ int* TOK() const { return (int*)(ws + WS_TOK); }
    __device__ __forceinline__ bf16* WINT() const { return (bf16*)(ws + WS_WINT); }
    __device__ __forceinline__ bf16* WOUTT() const { return (bf16*)(ws + WS_WOUTT); }
    __device__ __forceinline__ bf16* WRT() const { return (bf16*)(ws + WS_WRT); }
    __device__ __forceinline__ bf16* W1T() const { return (bf16*)(ws + WS_W1T); }
    __device__ __forceinline__ bf16* W2T() const { return (bf16*)(ws + WS_W2T); }
    __device__ __forceinline__ bf16* HB() const { return (bf16*)(ws + WS_HB); }
    __device__ __forceinline__ bf16* P() const { return (bf16*)(ws + WS_P); }
    __device__ __forceinline__ bf16* Y() const { return (bf16*)(ws + WS_Y); }
    __device__ __forceinline__ bf16* HP() const { return (bf16*)(ws + WS_HP); }
    __device__ __forceinline__ bf16* ACT() const { return (bf16*)(ws + WS_ACT); }
    __device__ __forceinline__ bf16* YP() const { return (bf16*)(ws + WS_YP); }
    __device__ __forceinline__ unsigned char* HB8() const { return (unsigned char*)(ws + WS_HB8); }
};
struct Args { const float* in[24]; float* out; unsigned char* ws; int ph_lo, ph_hi; };

__device__ __forceinline__ int w1_row(int n) { const int a = n >> 1; return ((a >> 7) << 8) + ((n & 1) << 7) + (a & 127); }
template <int MODE>
__device__ __forceinline__ void transpose_item(const float* W, int K, int N, bf16* WT, LAS float* scr, int item, int lane) {
    const int nblk = N / 32, kb = item / nblk, nb = item % nblk, k0 = 64 * kb, n0 = 32 * nb;
#pragma unroll 8
    for (int i = 0; i < 32; ++i) { const int kk = 2 * i + (lane >> 5); scr[kk * 33 + (lane & 31)] = W[(size_t)(k0 + kk) * N + n0 + (lane & 31)]; }
    LDS_WAIT(); asm volatile("" ::: "memory");
    const int c = lane & 7;
#pragma unroll
    for (int j = 0; j < 4; ++j) { const int n = (lane >> 3) + 8 * j; const LAS float* s = scr + (8 * c) * 33 + n;
        v4u o; o.x = pk2(s[0 * 33], s[1 * 33]); o.y = pk2(s[2 * 33], s[3 * 33]); o.z = pk2(s[4 * 33], s[5 * 33]); o.w = pk2(s[6 * 33], s[7 * 33]);
        const int orow = MODE == 1 ? w1_row(n0 + n) : (n0 + n);
        *(GAS v4u*)(WT + (size_t)orow * K + k0 + 8 * c) = o; }
    LDS_WAIT(); asm volatile("" ::: "memory");
}
template <int MODE>
__device__ __forceinline__ void transpose_item8(const float* W, int K, int N, unsigned char* WT, LAS float* scr, int item, int lane) {
    const int nblk = N / 32, kb = item / nblk, nb = item % nblk, k0 = 64 * kb, n0 = 32 * nb;
#pragma unroll 8
    for (int i = 0; i < 32; ++i) { const int kk = 2 * i + (lane >> 5); scr[kk * 33 + (lane & 31)] = W[(size_t)(k0 + kk) * N + n0 + (lane & 31)]; }
    LDS_WAIT(); asm volatile("" ::: "memory");
    const int n = lane >> 1, h = lane & 1; const LAS float* s = scr + (32 * h) * 33 + n;
    unsigned w[8];
#pragma unroll
    for (int q = 0; q < 8; ++q) { int p = __builtin_amdgcn_cvt_pk_fp8_f32(s[(4 * q) * 33] * 32.0f, s[(4 * q + 1) * 33] * 32.0f, 0, false); p = __builtin_amdgcn_cvt_pk_fp8_f32(s[(4 * q + 2) * 33] * 32.0f, s[(4 * q + 3) * 33] * 32.0f, p, true); w[q] = (unsigned)p; }
    const int orow = MODE == 1 ? w1_row(n0 + n) : (n0 + n);
    GAS v4u* dst = (GAS v4u*)(WT + (size_t)orow * K + k0 + 32 * h);
    dst[0] = (v4u){w[0], w[1], w[2], w[3]}; dst[1] = (v4u){w[4], w[5], w[6], w[7]};
    LDS_WAIT(); asm volatile("" ::: "memory");
}
__device__ __forceinline__ void phase_prologue(const Ctx& C, const Args& A) {
    {
        LAS float* sS = (LAS float*)C.lds;
        const float* cin = ldin<1>(); const float* cctx = ldin<3>(); const float* wada = ldin<4>(); const float* bada = ldin<5>();
        for (int i = C.tid; i < 17 * 1024; i += NWAVES * 64) { const int j = i >> 10, k = i & 1023; const float v = j < 16 ? cin[j * 1024 + k] : cctx[k]; sS[i] = v * sigmoidf_(v); }
        __syncthreads();
        const int kl = C.tid & 15, cg = C.tid >> 4;
        for (int item = blockIdx.x; item < NL * 48; item += C.G) {
            const int l = item / 48, c0 = (item % 48) * 128 + 4 * cg;
            const float* W = wada + (size_t)l * 1024 * MODW + c0;
            f32x4 acc[17];
#pragma unroll
            for (int j = 0; j < 17; ++j) acc[j] = (f32x4){0.f, 0.f, 0.f, 0.f};
            for (int k = kl; k < 1024; k += 16) { const f32x4 w = *(const f32x4*)(W + (size_t)k * MODW);
#pragma unroll
                for (int j = 0; j < 17; ++j) acc[j] += sS[j * 1024 + k] * w; }
#pragma unroll
            for (int j = 0; j < 17; ++j)
#pragma unroll
                for (int o = 1; o < 16; o <<= 1) { acc[j].x += __shfl_xor(acc[j].x, o); acc[j].y += __shfl_xor(acc[j].y, o); acc[j].z += __shfl_xor(acc[j].z, o); acc[j].w += __shfl_xor(acc[j].w, o); }
            if (kl == 0) { const f32x4 bv = *(const f32x4*)(bada + (size_t)l * MODW + c0);
#pragma unroll
                for (int j = 0; j < 17; ++j) *(f32x4*)(C.MOD() + ((size_t)l * 17 + j) * MODW + c0) = acc[j] + bv; }
        }
        __syncthreads();
    }
    {
        LAS float* scr = (LAS float*)(C.lds + C.wave * 16384);
        const float* w_in = ldin<8>(); const float* w_out = ldin<17>(); const float* w_r = ldin<18>(); const float* w_e1 = ldin<20>(); const float* w_e2 = ldin<22>(); const float* b_e1 = ldin<21>();
        constexpr int I_IN = 16 * 64, I_OUT = 16 * 32, I_E1 = 16 * 64, I_E2 = 16 * 32, I_R = 16;
        constexpr int PER_L = I_IN + I_OUT + NE * I_E1 + NE * I_E2 + I_R;
        for (int it = C.gw; it < NL * PER_L; it += C.ngw) {
            const int l = it / PER_L; int r = it - l * PER_L;
            if (r < I_IN) { transpose_item<0>(w_in + (size_t)l * 1024 * 2048, 1024, 2048, C.WINT() + (size_t)l * 2048 * 1024, scr, r, C.lane); continue; } r -= I_IN;
            if (r < I_OUT) { transpose_item<0>(w_out + (size_t)l * 1024 * 1024, 1024, 1024, C.WOUTT() + (size_t)l * 1024 * 1024, scr, r, C.lane); continue; } r -= I_OUT;
#if MK_FP8
            if (r < NE * I_E1) { const int e = r / I_E1; transpose_item8<1>(w_e1 + ((size_t)l * NE + e) * 1024 * 2048, 1024, 2048, (unsigned char*)C.W1T() + ((size_t)l * NE + e) * 2048 * 1024, scr, r % I_E1, C.lane); continue; } r -= NE * I_E1;
            if (r < NE * I_E2) { const int e = r / I_E2; transpose_item8<0>(w_e2 + ((size_t)l * NE + e) * 1024 * 1024, 1024, 1024, (unsigned char*)C.W2T() + ((size_t)l * NE + e) * 1024 * 1024, scr, r % I_E2, C.lane); continue; } r -= NE * I_E2;
#else
            if (r < NE * I_E1) { const int e = r / I_E1; transpose_item<1>(w_e1 + ((size_t)l * NE + e) * 1024 * 2048, 1024, 2048, C.W1T() + ((size_t)l * NE + e) * 2048 * 1024, scr, r % I_E1, C.lane); continue; } r -= NE * I_E1;
            if (r < NE * I_E2) { const int e = r / I_E2; transpose_item<0>(w_e2 + ((size_t)l * NE + e) * 1024 * 1024, 1024, 1024, C.W2T() + ((size_t)l * NE + e) * 1024 * 1024, scr, r % I_E2, C.lane); continue; } r -= NE * I_E2;
#endif
            transpose_item<0>(w_r + (size_t)l * 1024 * 32, 1024, 32, C.WRT() + (size_t)l * 256 * 1024, scr, r, C.lane);
        }
        for (int i = C.gw * 64 + C.lane; i < NL * NE * 2048; i += C.ngw * 64) { const int n = i & 2047; C.B1P()[(i & ~2047) + w1_row(n)] = b_e1[i]; }
    }
}

__device__ __forceinline__ void moe_tables(const Ctx& C, int l, bool with_t2e) {
    __syncthreads();
    if (C.tid < NE) C.MISC[40 + C.tid] = __hip_atomic_load(C.ctl + CW_CNT + (l * NE + C.tid) * 64, RLX_AGENT);
    __syncthreads();
    if (C.tid == 0) { unsigned s = 0;
#pragma unroll 1
        for (int e = 0; e < NE; ++e) { C.MISC[e] = s; s += (C.MISC[40 + e] + 255u) >> 8; } C.MISC[NE] = s; }
    __syncthreads();
    if (with_t2e) { LAS unsigned char* t2e = (LAS unsigned char*)(C.lds + T2E_OFF);
        for (int rt = C.tid; rt < MAXRT; rt += NWAVES * 64) { unsigned e = 0;
#pragma unroll 1
            for (int k = 1; k < NE; ++k) e += (C.MISC[k] <= (unsigned)rt) ? 1u : 0u;
            t2e[rt] = (unsigned char)e; }
        __syncthreads(); }
}

__device__ __forceinline__ void row_bt(int r, int& b, int& t, int& j) { b = r / SEG; t = r - b * SEG; j = t < SQ ? b : 16; }
__device__ __forceinline__ void modulate_store(const f32x4 (&v)[4], const float* g, const float* shift, const float* scale, bf16* orow, int lane) {
    float ss = 0.f;
#pragma unroll
    for (int jj = 0; jj < 4; ++jj) ss += sum4(v[jj] * v[jj]);
    const float rs = __builtin_amdgcn_rsqf(wave_sum(ss) * (1.0f / D) + EPS);
#pragma unroll
    for (int jj = 0; jj < 4; ++jj) { const int c = 256 * jj + 4 * lane;
        const f32x4 gv = *(const f32x4*)(g + c), sh = *(const f32x4*)(shift + c), sc = *(const f32x4*)(scale + c);
        const f32x4 h = (v[jj] * rs) * gv * (1.0f + sc) + sh;
        *(GAS v2u*)(orow + c) = pk4(h); }
}
__device__ __forceinline__ void moe_combine(const Ctx& C, int r, f32x4 (&acc)[4]) {
#pragma unroll
    for (int jj = 0; jj < 4; ++jj) acc[jj] = (f32x4){0.f, 0.f, 0.f, 0.f};
#pragma unroll
    for (int k = 0; k < 4; ++k) { const v2u pr = C.PAIR()[(size_t)r * 4 + k]; const unsigned e = pr.x & 31u, pos = pr.x >> 5; const unsigned wb = pr.y; const float wt = __uint_as_float(wb);
        const bf16* yp = C.YP() + ((size_t)C.MISC[e] * 256 + pos) * D + 4 * C.lane;
#pragma unroll
        for (int jj = 0; jj < 4; ++jj) acc[jj] += wt * bf4(*(const GAS v2u*)(yp + 256 * jj)); }
}

__device__ __forceinline__ void phase_premix(const Ctx& C, const Args& A, int l) {
    if (l > 0) moe_tables(C, l - 1, false);
    const float* modl = C.MOD() + (size_t)l * 17 * MODW; const float* modp = C.MOD() + (size_t)(l > 0 ? l - 1 : 0) * 17 * MODW;
    const float* g = ldin<6>() + (size_t)l * D; const float* xin = ldin<0>(); const float* cxin = ldin<2>();
    for (int r = C.gw; r < T; r += C.ngw) {
        int b, t, j; row_bt(r, b, t, j);
        f32x4 v[4]; float* xr = C.X() + (size_t)r * D + 4 * C.lane;
        if (l == 0) { const float* src = (t < SQ ? xin + ((size_t)b * SQ + t) * D : cxin + ((size_t)b * CL + (t - SQ)) * D) + 4 * C.lane;
#pragma unroll
            for (int jj = 0; jj < 4; ++jj) v[jj] = *(const f32x4*)(src + 256 * jj);
        } else { f32x4 acc[4]; moe_combine(C, r, acc); const float* gt2 = modp + (size_t)j * MODW + 5 * D + 4 * C.lane;
#pragma unroll
            for (int jj = 0; jj < 4; ++jj) v[jj] = *(const f32x4*)(xr + 256 * jj) + *(const f32x4*)(gt2 + 256 * jj) * acc[jj]; }
#pragma unroll
        for (int jj = 0; jj < 4; ++jj) *(f32x4*)(xr + 256 * jj) = v[jj];
        const float* mj = modl + (size_t)j * MODW;
        modulate_store(v, g, mj + 0 * D, mj + 1 * D, C.HB() + (size_t)r * D, C.lane);
    }
}
__device__ __forceinline__ void phase_premoe(const Ctx& C, const Args& A, int l) {
    const float* modl = C.MOD() + (size_t)l * 17 * MODW; const float* g = ldin<7>() + (size_t)l * D;
    for (int r = C.gw; r < T; r += C.ngw) {
        int b, t, j; row_bt(r, b, t, j);
        f32x4 v[4]; const float* xr = C.X() + (size_t)r * D + 4 * C.lane;
#pragma unroll
        for (int jj = 0; jj < 4; ++jj) v[jj] = *(const f32x4*)(xr + 256 * jj);
        const float* mj = modl + (size_t)j * MODW;
        modulate_store(v, g, mj + 3 * D, mj + 4 * D, C.HB() + (size_t)r * D, C.lane);
#if MK_FP8
        {
            float ss = 0.f;
#pragma unroll
            for (int jj = 0; jj < 4; ++jj) ss += sum4(v[jj] * v[jj]);
            const float rs = __builtin_amdgcn_rsqf(wave_sum(ss) * (1.0f / D) + EPS);
#pragma unroll
            for (int jj = 0; jj < 4; ++jj) { const int c = 256 * jj + 4 * C.lane;
                const f32x4 gv = *(const f32x4*)(g + c), sh = *(const f32x4*)(mj + 3 * D + c), sc = *(const f32x4*)(mj + 4 * D + c);
                const f32x4 h = (v[jj] * rs) * gv * (1.0f + sc) + sh;
                int p = __builtin_amdgcn_cvt_pk_fp8_f32(h.x, h.y, 0, false); p = __builtin_amdgcn_cvt_pk_fp8_f32(h.z, h.w, p, true);
                *(GAS unsigned*)(C.HB8() + (size_t)r * D + c) = (unsigned)p; }
        }
#endif
    }
}
__device__ __forceinline__ void phase_final(const Ctx& C, const Args& A) {
    moe_tables(C, NL - 1, false);
    const float* modp = C.MOD() + (size_t)(NL - 1) * 17 * MODW; float* outp = ldout();
    for (int q = C.gw; q < NB * SQ; q += C.ngw) {
        const int b = q / SQ, t = q - b * SQ, r = b * SEG + t;
        f32x4 acc[4]; moe_combine(C, r, acc);
        const float* xr = C.X() + (size_t)r * D + 4 * C.lane; const float* gt2 = modp + (size_t)b * MODW + 5 * D + 4 * C.lane; float* o = outp + (size_t)q * D + 4 * C.lane;
#pragma unroll
        for (int jj = 0; jj < 4; ++jj) *(f32x4*)(o + 256 * jj) = *(const f32x4*)(xr + 256 * jj) + *(const f32x4*)(gt2 + 256 * jj) * acc[jj];
    }
}

__device__ __forceinline__ void phase_qknorm(const Ctx& C, const Args& A, int l) {
    const LAS f32x2* rope = (const LAS f32x2*)(C.lds + ROPE_OFF);
    const float* gq = ldin<9>() + l * 64; const float* gk = ldin<10>() + l * 64;
    const int d0 = 8 * (C.lane & 7);
    const int ax = d0 >> 5, o0 = d0 & 31; const bool first = o0 < 16; const int i0 = o0 & 15;
    float gqv[8], gkv[8];
#pragma unroll
    for (int i = 0; i < 8; ++i) { gqv[i] = gq[d0 + i]; gkv[i] = gk[d0 + i]; }
    for (int r = C.gw; r < T; r += C.ngw) {
        int b, t, j; row_bt(r, b, t, j);
        const bool lat = t < SQ; const int pos = ax == 0 ? (t >> 6) : (t & 63);
        bf16* prow = C.P() + (size_t)r * INW;
#pragma unroll
        for (int part = 0; part < 2; ++part) {
            const bool act = part == 0 || C.lane < 16;
            bf16* p = prow + (part == 0 ? 0 : 512) + 8 * (act ? C.lane : 0);
            const v4u w = *(const GAS v4u*)p;
            float f[8] = {bflo(w.x), bfhi(w.x), bflo(w.y), bfhi(w.y), bflo(w.z), bfhi(w.z), bflo(w.w), bfhi(w.w)};
            float ss = 0.f;
#pragma unroll
            for (int i = 0; i < 8; ++i) ss += f[i] * f[i];
            ss += __shfl_xor(ss, 1); ss += __shfl_xor(ss, 2); ss += __shfl_xor(ss, 4);
            const float rs = __builtin_amdgcn_rsqf(ss * (1.0f / 64.0f) + EPS);
#pragma unroll
            for (int i = 0; i < 8; ++i) f[i] = f[i] * rs * (part == 0 ? gqv[i] : gkv[i]);
            float o[8];
#pragma unroll
            for (int i = 0; i < 8; ++i) { const float pv = __shfl_xor(f[i], 2); const f32x2 cs = rope[pos * 16 + i0 + i];
                const float rot = first ? f[i] * cs.x - pv * cs.y : f[i] * cs.x + pv * cs.y;
                o[i] = lat ? rot : f[i]; if (part == 0) o[i] *= attn_body::C2; }
            if (act) { v4u ow; ow.x = pk2(o[0], o[1]); ow.y = pk2(o[2], o[3]); ow.z = pk2(o[4], o[5]); ow.w = pk2(o[6], o[7]); *(GAS v4u*)p = ow; }
        }
    }
}

__device__ __forceinline__ void phase_attn(const Ctx& C) {
    char* shm = (char*)C.lds;
    const attn_body::bf16* Pq = (const attn_body::bf16*)C.P(); attn_body::bf16* Yo = (attn_body::bf16*)C.Y();
    const int nlat = NB * 8 * 16;
    const int per = (nlat + C.G - 1) / C.G;
    for (int i = 0; i < per; ++i) { const int u = C.vcu * per + i; if (u >= nlat) break;
        const int qb = u & 15, h = (u >> 4) & 7, b = u >> 7;
        attn_body::attn_unit<8>((long)b * SEG + qb * 256, (long)b * SEG, SEG / 64, h, Pq, Yo, shm); }
    for (int u = C.vcu; u < NB * 8; u += C.G) { const int h = u & 7, b = u >> 3;
        attn_body::attn_unit<8>((long)b * SEG + SQ, (long)b * SEG + SQ, CL / 64, h, Pq, Yo, shm); }
}

__device__ __forceinline__ void phase_conv(const Ctx& C, const Args& A, int l) {
    LAS float* zL = (LAS float*)C.lds;
    const int c4 = 4 * C.lane;
    f32x4 wk[31]; const float* wdw = ldin<11>();
#pragma unroll
    for (int jt = 0; jt < 31; ++jt) wk[jt] = *(const f32x4*)(wdw + ((size_t)l * 31 + jt) * 256 + c4);
    const f32x4 b31 = *(const f32x4*)(ldin<12>() + l * 256 + c4), gln = *(const f32x4*)(ldin<13>() + l * 256 + c4), bln = *(const f32x4*)(ldin<14>() + l * 256 + c4);
    const float* wsc = ldin<15>() + (size_t)l * 3 * 256 + c4; const f32x4 w30 = *(const f32x4*)(wsc), w31 = *(const f32x4*)(wsc + 256), w32 = *(const f32x4*)(wsc + 512);
    const float* gg = ldin<16>() + (size_t)l * D;
    const f32x4 gA0 = *(const f32x4*)(gg + 8 * C.lane), gA1 = *(const f32x4*)(gg + 8 * C.lane + 4), gC = *(const f32x4*)(gg + 512 + c4), gS = *(const f32x4*)(gg + 768 + c4);
    for (int tile = C.vcu; tile < T / 64; tile += C.G) {
        const int b = tile / 68, tt = tile - b * 68, t0 = tt * 64;
        const int seg_lo = tt < 64 ? 0 : SQ, seg_hi = tt < 64 ? SQ : SEG;
        const size_t rbase = (size_t)b * SEG;
        __syncthreads();
        for (int zr = C.wave; zr < 94; zr += NWAVES) { const int t = t0 - 15 + zr; f32x4 z = (f32x4){0.f, 0.f, 0.f, 0.f};
            if (t >= seg_lo && t < seg_hi) { const bf16* p = C.P() + (rbase + t) * INW; const f32x4 a = bf4(*(const GAS v2u*)(p + 768 + c4)), gt = bf4(*(const GAS v2u*)(p + 1024 + c4));
                z = (f32x4){a.x * sigmoidf_(gt.x), a.y * sigmoidf_(gt.y), a.z * sigmoidf_(gt.z), a.w * sigmoidf_(gt.w)}; }
            *(LAS f32x4*)(zL + zr * 256 + c4) = z; }
        __syncthreads();
        for (int i = C.wave; i < 64; i += NWAVES) { const int t = t0 + i; const size_t r = rbase + t;
            f32x4 u = b31;
#pragma unroll
            for (int jt = 0; jt < 31; ++jt) u += wk[jt] * *(const LAS f32x4*)(zL + (i + jt) * 256 + c4);
            const float mean = wave_sum(sum4(u)) * (1.0f / 256.0f); const f32x4 d = u - mean;
            const float var = wave_sum(sum4(d * d)) * (1.0f / 256.0f); const f32x4 y = d * __builtin_amdgcn_rsqf(var + EPS) * gln + bln;
            const f32x4 cf = (f32x4){y.x * sigmoidf_(y.x), y.y * sigmoidf_(y.y), y.z * sigmoidf_(y.z), y.w * sigmoidf_(y.w)};
            const float rsc = __builtin_amdgcn_rsqf(wave_sum(sum4(cf * cf)) * (1.0f / 256.0f) + EPS);
            bf16* yr = C.Y() + r * D;
            *(GAS v2u*)(yr + 512 + c4) = pk4(cf * rsc * gC);
            const bf16* p = C.P() + r * INW; f32x4 m0 = (f32x4){0.f, 0.f, 0.f, 0.f}, m2 = m0;
            const f32x4 m1 = bf4(*(const GAS v2u*)(p + 1536 + c4)) * bf4(*(const GAS v2u*)(p + 1792 + c4));
            if (t - 1 >= seg_lo) m0 = bf4(*(const GAS v2u*)(p - INW + 1536 + c4)) * bf4(*(const GAS v2u*)(p - INW + 1792 + c4));
            if (t + 1 < seg_hi) m2 = bf4(*(const GAS v2u*)(p + INW + 1536 + c4)) * bf4(*(const GAS v2u*)(p + INW + 1792 + c4));
            const f32x4 sv = bf4(*(const GAS v2u*)(p + 1280 + c4)) * (w30 * m0 + w31 * m1 + w32 * m2);
            const float rss = __builtin_amdgcn_rsqf(wave_sum(sum4(sv * sv)) * (1.0f / 256.0f) + EPS);
            *(GAS v2u*)(yr + 768 + c4) = pk4(sv * rss * gS);
            const v4u aw = *(const GAS v4u*)(yr + 8 * C.lane);
            const f32x4 a0 = bf4((v2u){aw.x, aw.y}), a1 = bf4((v2u){aw.z, aw.w});
            const float rsa = __builtin_amdgcn_rsqf(wave_sum(sum4(a0 * a0) + sum4(a1 * a1)) * (1.0f / 512.0f) + EPS);
            const v2u o0 = pk4(a0 * rsa * gA0), o1 = pk4(a1 * rsa * gA1);
            *(GAS v4u*)(yr + 8 * C.lane) = (v4u){o0.x, o0.y, o1.x, o1.y};
        }
    }
    __syncthreads();
}

__device__ __forceinline__ void phase_route(const Ctx& C, const Args& A, int l) {
    volatile LAS unsigned* lhist = C.MISC + 80; volatile LAS unsigned* lbase = C.MISC + 112;
    const float br = C.lane < NE ? ldin<19>()[l * NE + C.lane] : 0.f;
    gu32* cnt = C.ctl + CW_CNT + (size_t)l * NE * 64;
    for (int tile = C.vcu; tile < T / 64; tile += C.G) {
        __syncthreads();
        if (C.tid < NE) lhist[C.tid] = 0u;
        __syncthreads();
        unsigned pe[8], pp[8];
#pragma unroll
        for (int i = 0; i < 8; ++i) { const int r = tile * 64 + C.wave * 8 + i;
            float v = C.lane < NE ? C.LOG()[(size_t)r * NE + C.lane] + br : -INFINITY;
            float sv[4]; int se[4];
#pragma unroll
            for (int k = 0; k < 4; ++k) { float m = v; int mi = C.lane;
#pragma unroll
                for (int o = 1; o < 64; o <<= 1) { const float ov = __shfl_xor(m, o); const int oi = __shfl_xor(mi, o); if (ov > m || (ov == m && oi < mi)) { m = ov; mi = oi; } }
                sv[k] = m; se[k] = mi; if (C.lane == mi) v = -INFINITY; }
            const float e1 = __expf(sv[1] - sv[0]), e2 = __expf(sv[2] - sv[0]), e3 = __expf(sv[3] - sv[0]); const float inv = __builtin_amdgcn_rcpf(1.0f + e1 + e2 + e3);
            const int kk = C.lane & 3;
            pe[i] = (unsigned)(kk == 0 ? se[0] : kk == 1 ? se[1] : kk == 2 ? se[2] : se[3]);
            const float pwi = (kk == 0 ? 1.0f : kk == 1 ? e1 : kk == 2 ? e2 : e3) * inv;
            pp[i] = 0u;
            if (C.lane < 4) { pp[i] = __hip_atomic_fetch_add((LAS unsigned*)(C.lds + MISC_OFF) + 80 + pe[i], 1u, __ATOMIC_RELAXED, __HIP_MEMORY_SCOPE_WORKGROUP);
                ((GAS float*)C.PAIR())[((size_t)r * 4 + C.lane) * 2 + 1] = pwi; } }
        __syncthreads();
        if (C.tid < NE) { const unsigned n = lhist[C.tid]; lbase[C.tid] = n ? __hip_atomic_fetch_add(cnt + C.tid * 64, n, RLX_AGENT) : 0u; }
        __syncthreads();
        if (C.lane < 4) {
#pragma unroll
            for (int i = 0; i < 8; ++i) { const int r = tile * 64 + C.wave * 8 + i; const unsigned pos = lbase[pe[i]] + pp[i];
                ((GAS unsigned*)C.PAIR())[((size_t)r * 4 + C.lane) * 2] = pe[i] | (pos << 5);
                C.TOK()[(size_t)pe[i] * T + pos] = r; } }
    }
    __syncthreads();
}

__device__ __forceinline__ void phase_gather(const Ctx& C, const Args& A, int l) {
    moe_tables(C, l, true);
    const LAS unsigned char* t2e = (const LAS unsigned char*)(C.lds + T2E_OFF);
    const int nslot = (int)C.MISC[NE] * 256;
    for (int s = C.gw; s < nslot; s += C.ngw) { const unsigned e = t2e[s >> 8]; const unsigned pos = (unsigned)s - C.MISC[e] * 256u;
        if (pos < C.MISC[40 + e]) { const int r = C.TOK()[(size_t)e * T + pos];
#if MK_FP8
            const GAS v4u* src = (const GAS v4u*)(C.HB8() + (size_t)r * D) + C.lane; GAS v4u* dst = (GAS v4u*)((unsigned char*)C.HP() + (size_t)s * D) + C.lane;
            dst[0] = src[0]; } }
#else
            const GAS v4u* src = (const GAS v4u*)(C.HB() + (size_t)r * D) + C.lane; GAS v4u* dst = (GAS v4u*)(C.HP() + (size_t)s * D) + C.lane;
            dst[0] = src[0]; dst[64] = src[64]; } }
#endif
}

__global__ void __launch_bounds__(NWAVES * 64, 2) mk_fwd(Args args) {
    extern __shared__ __attribute__((aligned(16))) unsigned char lds_raw[];
    Ctx C;
    C.lds = (LAS unsigned char*)lds_raw; C.MISC = (volatile LAS unsigned*)(C.lds + MISC_OFF);
    C.tid = threadIdx.x; C.lane = C.tid & 63; C.wave = __builtin_amdgcn_readfirstlane(C.tid >> 6);
    C.G = gridDim.x; { const int bx = blockIdx.x; C.vcu = (C.G % 8 == 0) ? (bx % 8) * (C.G / 8) + bx / 8 : bx; }
    C.gw = C.vcu * NWAVES + C.wave; C.ngw = C.G * NWAVES;
    C.ws = (GAS unsigned char*)args.ws; C.ctl = (gu32*)(C.ws + WS_CTL);
    for (int u = C.tid; u < (LDS_BYTES - MISC_OFF) / 4; u += NWAVES * 64) ((LAS unsigned*)(C.lds + MISC_OFF))[u] = 0u;
    for (int u = C.tid; u < 64 * 16; u += NWAVES * 64) { const int pos = u >> 4, i = u & 15; const float inv = powf(10000.0f, -(float)(2 * i) / 32.0f); const float ang = (float)pos * inv;
        ((LAS f32x2*)(C.lds + ROPE_OFF))[u] = (f32x2){cosf(ang), sinf(ang)}; }
    __syncthreads();
    const int lo = args.ph_lo, hi = args.ph_hi;
    const bool multi = (hi - lo) > 1;
    XcdBarrier bar; bar.bar = (unsigned*)(C.ctl + CW_BAR); bar.x = 0; bar.st = C.MISC + 160;
    if (multi) bar = xcd_barrier_post((unsigned*)(C.ctl + CW_BAR), C.MISC + 160);
#ifndef MK_PHMASK
#define MK_PHMASK 0xFFFF
#endif
#define IN(k) (lo <= (k) && (k) < hi)
#define FRESH() do { asm volatile("" : "+v"(C.tid), "+v"(C.lane)); asm volatile("" : "+s"(C.wave), "+s"(C.vcu), "+s"(C.gw), "+s"(C.ws), "+s"(C.ctl)); } while (0)
#define EN(k) ((MK_PHMASK >> (k)) & 1)
#define SEAM(k) do { if (IN((k) + 1)) xcd_barrier(bar); } while (0)

    if (EN(12) && IN(0)) { phase_prologue(C, args); SEAM(0); }
    for (int l = 0; l < NL; ++l) {
        const int pb = 1 + l * PPL;
        if (EN(0) && IN(pb + 0)) { FRESH(); phase_premix(C, args, l); SEAM(pb + 0); }
        if (EN(1) && IN(pb + 1)) { FRESH();
            pg8::Gemm g{C.HB(), C.WINT() + (size_t)l * INW * D, T, INW, D}; pg8::StaticOrder S; S.init(T, INW, C.G, (int)blockIdx.x);
            pg8::EpiStore E{C.P(), INW};
            pg8::gemm_phase<pg8::EpiStore, pg8::StaticOrder, true, true>(C.lds, g, S, E);
            SEAM(pb + 1); }
        if (EN(2) && IN(pb + 2)) { FRESH(); phase_qknorm(C, args, l); SEAM(pb + 2); }
        if (EN(3) && IN(pb + 3)) { FRESH(); phase_attn(C); SEAM(pb + 3); }
        if (EN(4) && IN(pb + 4)) { FRESH(); phase_conv(C, args, l); SEAM(pb + 4); }
        if (EN(5) && IN(pb + 5)) { FRESH();
            pg8::Gemm g{C.Y(), C.WOUTT() + (size_t)l * D * D, T, D, D}; pg8::StaticOrder S; S.init(T, D, C.G, (int)blockIdx.x);
            pg8::EpiResid E{C.X(), C.MOD() + (size_t)l * 17 * MODW + 2 * D};
            pg8::gemm_phase<pg8::EpiResid, pg8::StaticOrder, true, true>(C.lds, g, S, E);
            SEAM(pb + 5); }
        if (EN(6) && IN(pb + 6)) { FRESH(); phase_premoe(C, args, l); SEAM(pb + 6); }
        if (EN(7) && IN(pb + 7)) { FRESH();
            pg8::Gemm g{C.HB(), C.WRT() + (size_t)l * 256 * D, T, 256, D}; pg8::StaticOrder S; S.init(T, 256, C.G, (int)blockIdx.x);
            pg8::EpiLogits E{C.LOG()};
            pg8::gemm_phase<pg8::EpiLogits, pg8::StaticOrder, true, true>(C.lds, g, S, E);
            SEAM(pb + 7); }
        if (EN(8) && IN(pb + 8)) { FRESH(); phase_route(C, args, l); SEAM(pb + 8); }
        if (EN(9) && IN(pb + 9)) { FRESH(); phase_gather(C, args, l); SEAM(pb + 9); }
        if (EN(10) && IN(pb + 10)) { FRESH();
            moe_tables(C, l, true);
#if MK_FP8
            pg8::Gemm g{C.HP(), (const pg8::bf16_t*)((const unsigned char*)C.W1T() + (size_t)l * NE * 2048 * D), CAP, NE * 2048, D / 2};
            pg8::MoeOrder S; S.init((int)C.MISC[NE], 8, C.G, (int)blockIdx.x, (const LAS unsigned char*)(C.lds + T2E_OFF));
            pg8::EpiSwiglu8 E{(unsigned char*)C.ACT(), C.B1P() + (size_t)l * NE * 2048};
            pg8::gemm_phase<pg8::EpiSwiglu8, pg8::MoeOrder, true, true, true>(C.lds, g, S, E);
#else
            pg8::Gemm g{C.HP(), C.W1T() + (size_t)l * NE * 2048 * D, CAP, NE * 2048, D};
            pg8::MoeOrder S; S.init((int)C.MISC[NE], 8, C.G, (int)blockIdx.x, (const LAS unsigned char*)(C.lds + T2E_OFF));
            pg8::EpiSwiglu E{C.ACT(), C.B1P() + (size_t)l * NE * 2048};
            pg8::gemm_phase<pg8::EpiSwiglu, pg8::MoeOrder, true, true>(C.lds, g, S, E);
#endif
            SEAM(pb + 10); }
        if (EN(11) && IN(pb + 11)) { FRESH();
            moe_tables(C, l, true);
#if MK_FP8
            pg8::Gemm g{C.ACT(), (const pg8::bf16_t*)((const unsigned char*)C.W2T() + (size_t)l * NE * D * D), CAP, NE * D, D / 2};
            pg8::MoeOrder S; S.init((int)C.MISC[NE], 4, C.G, (int)blockIdx.x, (const LAS unsigned char*)(C.lds + T2E_OFF));
            pg8::EpiDown E{C.YP(), ldin<23>() + (size_t)l * NE * D};
            pg8::gemm_phase<pg8::EpiDown, pg8::MoeOrder, true, true, true>(C.lds, g, S, E);
#else
            pg8::Gemm g{C.ACT(), C.W2T() + (size_t)l * NE * D * D, CAP, NE * D, D};
            pg8::MoeOrder S; S.init((int)C.MISC[NE], 4, C.G, (int)blockIdx.x, (const LAS unsigned char*)(C.lds + T2E_OFF));
            pg8::EpiDown E{C.YP(), ldin<23>() + (size_t)l * NE * D};
            pg8::gemm_phase<pg8::EpiDown, pg8::MoeOrder, true, true>(C.lds, g, S, E);
#endif
            SEAM(pb + 11); }
    }
    if (EN(13) && IN(NPHASE - 1)) { FRESH(); phase_final(C, args); }
#undef IN
#undef SEAM
}
}


#if defined(MK_DEBUG)
namespace mkdbg {
using namespace mk;
constexpr size_t WS_DBG = 3420 * MiB;
__device__ const int SROWS[12] = {0, 1, 63, 64, 255, 256, 4095, 4096, 4351, 4352, 30000, 69631};
__device__ __forceinline__ float bfv(const bf16* p, size_t i) { return __builtin_bit_cast(float, (unsigned)p[i] << 16); }
__device__ __forceinline__ void report(float* err, int s, float got, float ref, float atol) {
    float e = fabsf(got - ref) / (fabsf(ref) + atol); if (!(e == e)) e = 100.f;
    atomicMax((unsigned*)err + s, __builtin_bit_cast(unsigned, e));
}
__device__ __forceinline__ void row_info(int r, int& b, int& t, int& j) { b = r / SEG; t = r - b * SEG; j = t < SQ ? b : 16; }
__device__ __forceinline__ float silu_(float v) { return v / (1.f + expf(-v)); }
__device__ __forceinline__ float sigm_(float v) { return 1.f / (1.f + expf(-v)); }
__device__ __forceinline__ void naive_attn(const bf16* P, int r, int h, float* q, float* o) {
    int b, t, j; row_info(r, b, t, j);
    const int k0 = t < SQ ? b * SEG : b * SEG + SQ, nk = t < SQ ? SEG : CL;
    for (int d = 0; d < 64; ++d) q[d] = bfv(P, (size_t)r * INW + h * 64 + d);
    float m = -1e30f;
    for (int kk = 0; kk < nk; ++kk) { float s = 0.f; for (int d = 0; d < 64; ++d) s += q[d] * bfv(P, (size_t)(k0 + kk) * INW + 512 + (h >> 2) * 64 + d); m = fmaxf(m, s); }
    float l = 0.f; for (int d = 0; d < 64; ++d) o[d] = 0.f;
    for (int kk = 0; kk < nk; ++kk) { float s = 0.f; for (int d = 0; d < 64; ++d) s += q[d] * bfv(P, (size_t)(k0 + kk) * INW + 512 + (h >> 2) * 64 + d);
        const float p = exp2f(s - m); l += p; for (int d = 0; d < 64; ++d) o[d] += p * bfv(P, (size_t)(k0 + kk) * INW + 640 + (h >> 2) * 64 + d); }
    for (int d = 0; d < 64; ++d) o[d] /= l;
}
__device__ const int DBG_LS_1[2] = {0, 3};
__device__ const int DBG_JS_2[3] = {0, 7, 16};
__device__ const int DBG_NS_3[4] = {0, 1000, 2053, 6143};
__device__ const int DBG_CS_4[4] = {0, 1, 511, 1023};
__device__ const int DBG_CS_5[16] = {0, 63, 64, 511, 512, 575, 639, 640, 767, 768, 1024, 1279, 1280, 1536, 1792, 2047};
__device__ const int DBG_HS_6[4] = {0, 7, 8, 9};
__device__ const int DBG_HS_7[2] = {0, 5};
__device__ const int DBG_CS_8[4] = {0, 255, 256, 1023};
__device__ const int DBG_ES_9[3] = {0, 7, 31};
__device__ const int DBG_CS_10[3] = {0, 500, 1023};
__device__ const int DBG_CS_11[4] = {0, 127, 128, 1023};
__device__ const int DBG_CS_12[4] = {0, 300, 511, 1023};
__device__ const int DBG_CS_13[4] = {0, 300, 511, 1023};
__device__ const int DBG_CS_14[4] = {0, 300, 511, 1023};
__global__ void __launch_bounds__(256) dbg_kernel(Args a, int stage) {
    unsigned char* ws = a.ws; float* err = (float*)(ws + WS_DBG); float* scr = err + 256;
    const float* MOD = (const float*)(ws + WS_MOD); const bf16* HB = (const bf16*)(ws + WS_HB); const bf16* P = (const bf16*)(ws + WS_P); const bf16* Y = (const bf16*)(ws + WS_Y);
    const float* X = (const float*)(ws + WS_X); const float* LOG = (const float*)(ws + WS_LOG); const v2u* PAIR = (const v2u*)(ws + WS_PAIR); const int* TOK = (const int*)(ws + WS_TOK);
    const bf16* HP = (const bf16*)(ws + WS_HP); const bf16* ACT = (const bf16*)(ws + WS_ACT); const bf16* YP = (const bf16*)(ws + WS_YP);
    const unsigned* cnt = (const unsigned*)(ws + WS_CTL) + CW_CNT;
    const int tid = threadIdx.x;
    __shared__ float shm[15360]; __shared__ unsigned tstart[33];
    if (stage == 0) { if (tid < 64) err[tid] = 0.f; return; }
    if (stage == 1) {
        const int* ls = DBG_LS_1; const int* js = DBG_JS_2; const int* ns = DBG_NS_3;
        if (tid < 24) { const int l = ls[tid / 12], j = js[(tid / 4) % 3], n = ns[tid % 4]; float s = 0.f;
            for (int k = 0; k < 1024; ++k) { const float c = j < 16 ? a.in[1][j * 1024 + k] : a.in[3][k]; s += silu_(c) * a.in[4][((size_t)l * 1024 + k) * MODW + n]; }
            s += a.in[5][l * MODW + n]; report(err, 1, MOD[((size_t)l * 17 + j) * MODW + n], s, 0.05f); }
        return; }
    if (stage == 2 || stage == 8) {
        const int* cs = DBG_CS_4;
        if (tid < 48) { const int r = SROWS[tid / 4], c = cs[tid % 4]; int b, t, j; row_info(r, b, t, j);
            const float* xr = stage == 2 ? (t < SQ ? a.in[0] + ((size_t)b * SQ + t) * D : a.in[2] + ((size_t)b * CL + (t - SQ)) * D) : X + (size_t)r * D;
            float ss = 0.f; for (int k = 0; k < D; ++k) ss += xr[k] * xr[k];
            const float rs = 1.f / sqrtf(ss / D + EPS); const float* g = stage == 2 ? a.in[6] : a.in[7]; const float* mj = MOD + (size_t)j * MODW + (stage == 2 ? 0 : 3 * D);
            const float h = xr[c] * rs * g[c] * (1.f + mj[D + c]) + mj[c];
            report(err, stage, bfv(HB, (size_t)r * D + c), h, 0.05f);
            if (stage == 2) report(err, stage, X[(size_t)r * D + c], xr[c], 0.01f); }
        return; }
    if (stage == 3) {
        const int* cs = DBG_CS_5;
        if (tid < 192) { const int r = SROWS[tid / 16], c = cs[tid % 16]; float s = 0.f;
            for (int k = 0; k < D; ++k) s += bfv(HB, (size_t)r * D + k) * a.in[8][(size_t)k * INW + c];
            report(err, 3, bfv(P, (size_t)r * INW + c), s, 0.05f); }
        return; }
    if (stage == 4) {
        const int* hs = DBG_HS_6;
        if (tid < 48) { const int r = SROWS[tid / 4], h = hs[tid % 4]; int b, t, j; row_info(r, b, t, j);
            float* raw = shm + tid * 128; float* o = raw + 64; float ss = 0.f;
            for (int d = 0; d < 64; ++d) { float s = 0.f; for (int k = 0; k < D; ++k) s += bfv(HB, (size_t)r * D + k) * a.in[8][(size_t)k * INW + h * 64 + d]; raw[d] = s; ss += s * s; }
            const float rs = 1.f / sqrtf(ss / 64.f + EPS); const float* g = h < 8 ? a.in[9] : a.in[10];
            for (int d = 0; d < 64; ++d) raw[d] = raw[d] * rs * g[d];
            for (int ax = 0; ax < 2; ++ax) for (int i = 0; i < 16; ++i) { const float pos = ax == 0 ? (float)(t / 64) : (float)(t % 64); const float ang = pos * powf(10000.f, -(float)(2 * i) / 32.f);
                const float c = t < SQ ? cosf(ang) : 1.f, s = t < SQ ? sinf(ang) : 0.f; const float x1 = raw[ax * 32 + i], x2 = raw[ax * 32 + 16 + i];
                o[ax * 32 + i] = x1 * c - x2 * s; o[ax * 32 + 16 + i] = x2 * c + x1 * s; }
            for (int d = 0; d < 64; ++d) { const float ref = o[d] * (h < 8 ? 0.125f * 1.4426950408889634f : 1.f); report(err, 4, bfv(P, (size_t)r * INW + h * 64 + d), ref, h < 8 ? 0.045f : 0.25f); } }
        return; }
    if (stage == 5) {
        const int* hs = DBG_HS_7;
        if (tid < 24) { const int r = SROWS[tid / 2], h = hs[tid % 2]; float* o = shm + tid * 128; naive_attn(P, r, h, o + 64, o);
            for (int d = 0; d < 64; ++d) report(err, 5, bfv(Y, (size_t)r * D + h * 64 + d), o[d], 0.05f); }
        return; }
    if (stage == 6) {
        if (tid < 12) { const int r = SROWS[tid]; int b, t, j; row_info(r, b, t, j); const int lo = t < SQ ? 0 : SQ, hi = t < SQ ? SQ : SEG; const size_t rb = (size_t)b * SEG;
            float* u = shm + tid * 256; float mean = 0.f;
            for (int c = 0; c < 256; ++c) { float s = a.in[12][c];
                for (int jt = 0; jt < 31; ++jt) { const int tt = t + jt - 15; if (tt >= lo && tt < hi) s += a.in[11][jt * 256 + c] * bfv(P, (rb + tt) * INW + 768 + c) * sigm_(bfv(P, (rb + tt) * INW + 1024 + c)); }
                u[c] = s; mean += s; }
            mean /= 256.f; float var = 0.f; for (int c = 0; c < 256; ++c) var += (u[c] - mean) * (u[c] - mean); var /= 256.f;
            float ss = 0.f; for (int c = 0; c < 256; ++c) { const float y = (u[c] - mean) / sqrtf(var + EPS) * a.in[13][c] + a.in[14][c]; u[c] = silu_(y); ss += u[c] * u[c]; }
            float rs = 1.f / sqrtf(ss / 256.f + EPS);
            for (int c = 0; c < 256; ++c) report(err, 6, bfv(Y, (size_t)r * D + 512 + c), u[c] * rs * a.in[16][512 + c], 0.25f);
            ss = 0.f;
            for (int c = 0; c < 256; ++c) { float s = 0.f; for (int jt = 0; jt < 3; ++jt) { const int tt = t + jt - 1; if (tt >= lo && tt < hi) s += a.in[15][jt * 256 + c] * bfv(P, (rb + tt) * INW + 1536 + c) * bfv(P, (rb + tt) * INW + 1792 + c); }
                u[c] = bfv(P, (size_t)r * INW + 1280 + c) * s; ss += u[c] * u[c]; }
            rs = 1.f / sqrtf(ss / 256.f + EPS);
            for (int c = 0; c < 256; ++c) report(err, 7, bfv(Y, (size_t)r * D + 768 + c), u[c] * rs * a.in[16][768 + c], 0.25f); }
        if (tid >= 64 && tid < 80) { const int r = SROWS[(tid - 64) / 8 == 0 ? 2 : 7], h = (tid - 64) % 8; float* o = shm + 3072 + (tid - 64) * 128; naive_attn(P, r, h, o + 64, o);
            for (int d = 0; d < 64; ++d) scr[((tid - 64) / 8) * 512 + h * 64 + d] = o[d]; }
        __syncthreads();
        if (tid < 2) { const int r = SROWS[tid == 0 ? 2 : 7]; float ss = 0.f; for (int c = 0; c < 512; ++c) ss += scr[tid * 512 + c] * scr[tid * 512 + c];
            const float rs = 1.f / sqrtf(ss / 512.f + EPS); for (int c = 0; c < 512; ++c) report(err, 6, bfv(Y, (size_t)r * D + c), scr[tid * 512 + c] * rs * a.in[16][c], 0.25f); }
        return; }
    if (stage == 9) {
        const int* cs = DBG_CS_8;
        if (tid < 48) { const int r = SROWS[tid / 4], c = cs[tid % 4]; int b, t, j; row_info(r, b, t, j);
            const float* xr = t < SQ ? a.in[0] + ((size_t)b * SQ + t) * D : a.in[2] + ((size_t)b * CL + (t - SQ)) * D;
            float s = 0.f; for (int k = 0; k < D; ++k) s += bfv(Y, (size_t)r * D + k) * a.in[17][(size_t)k * D + c];
            report(err, 9, X[(size_t)r * D + c], xr[c] + MOD[(size_t)j * MODW + 2 * D + c] * s, 0.05f); }
        return; }
    if (stage == 10) {
        const int* es = DBG_ES_9;
        if (tid < 36) { const int r = SROWS[tid / 3], e = es[tid % 3]; float s = 0.f; for (int k = 0; k < D; ++k) s += bfv(HB, (size_t)r * D + k) * a.in[18][(size_t)k * NE + e];
            report(err, 10, LOG[(size_t)r * NE + e], s, 0.05f); }
        return; }
    if (stage == 11) {
        if (tid < 12) { const int r = SROWS[tid]; float* v = shm + tid * 32; for (int e = 0; e < 32; ++e) v[e] = LOG[(size_t)r * NE + e] + a.in[19][e];
            float* sv = shm + 1024 + tid * 8; float* sef = sv + 4;
            for (int k = 0; k < 4; ++k) { int bi = 0; for (int e = 1; e < 32; ++e) if (v[e] > v[bi]) bi = e; sef[k] = (float)bi; sv[k] = v[bi]; v[bi] = -1e30f; }
            float den = 0.f; for (int k = 0; k < 4; ++k) den += expf(sv[k] - sv[0]);
            { float* vv = shm + 2048 + tid * 32; for (int e = 0; e < 32; ++e) vv[e] = LOG[(size_t)r * NE + e] + a.in[19][e];
              float mx = -1e30f, dn = 0.f; for (int k = 0; k < 4; ++k) mx = fmaxf(mx, vv[PAIR[(size_t)r * 4 + k].x & 31]); for (int k = 0; k < 4; ++k) dn += expf(vv[PAIR[(size_t)r * 4 + k].x & 31] - mx);
              for (int k = 0; k < 4; ++k) report(err, 22, __uint_as_float((unsigned)(PAIR[(size_t)r * 4 + k].y + 0u)), expf(vv[PAIR[(size_t)r * 4 + k].x & 31] - mx) / dn, 0.01f); }
            for (int k = 0; k < 4; ++k) { const v2u pr = PAIR[(size_t)r * 4 + k]; const int e = pr.x & 31; const unsigned pos = pr.x >> 5;
                if (tid == 0 && (k == 0 || k == 3)) { err[30 + (k ? 2 : 0)] = __uint_as_float((unsigned)(pr.y + 0u)); err[31 + (k ? 2 : 0)] = expf(sv[k] - sv[0]) / den; }
                report(err, 17, (float)e == sef[k] ? 0.f : 1.f, 0.f, 1.0f); report(err, 18, __uint_as_float((unsigned)(pr.y + 0u)), expf(sv[k] - sv[0]) / den, 0.01f);
                const unsigned c = cnt[e * 64]; report(err, 19, pos < c ? 1.f : 0.f, 1.f, 0.001f); report(err, 20, (float)TOK[(size_t)e * T + (pos < (unsigned)T ? pos : 0)], (float)r, 0.001f); } }
        if (tid == 255) { unsigned s = 0; for (int e = 0; e < 32; ++e) s += cnt[e * 64]; report(err, 21, (float)s, (float)(T * 4), 0.001f); }
        if (tid == 253) { int c = 0; const float* pf = (const float*)PAIR; for (int q = 0; q < 64; ++q) { const float w = pf[q * 2 + 1]; if (w > 0.01f && w <= 1.f) ++c; } err[44] = (float)c; }
        if (tid == 254) { for (int k = 0; k < 4; ++k) { const float w = __uint_as_float((unsigned)(PAIR[k].y + 0u)); err[40 + k] = (float)(!(w == w) || w < 0.f || w > 1.f ? 3 : w < 1e-30f ? 0 : w < 0.05f ? 1 : 2); } }
        return; }
    if (tid == 0) { unsigned s = 0; for (int e = 0; e < 32; ++e) { tstart[e] = s; s += (cnt[e * 64] + 255u) >> 8; } tstart[32] = s; }
    __syncthreads();
    if (stage == 12) {
        const int* cs = DBG_CS_10;
        if (tid < 48) { const int r = SROWS[tid / 4], k = tid % 4; const v2u pr = PAIR[(size_t)r * 4 + k]; const size_t slot = (size_t)tstart[pr.x & 31] * 256 + (pr.x >> 5);
            for (int i = 0; i < 3; ++i) report(err, 12, bfv(HP, slot * D + cs[i]), bfv(HB, (size_t)r * D + cs[i]), 0.001f); }
        return; }
    if (stage == 13) {
        const int* cs = DBG_CS_11;
        if (tid < 192) { const int r = SROWS[tid / 16], k = (tid / 4) % 4, c = cs[tid % 4]; const v2u pr = PAIR[(size_t)r * 4 + k]; const int e = pr.x & 31; const size_t slot = (size_t)tstart[e] * 256 + (pr.x >> 5);
            float ug = a.in[21][(size_t)e * 2048 + 2 * c], uu = a.in[21][(size_t)e * 2048 + 2 * c + 1]; const float* w = a.in[20] + (size_t)e * 1024 * 2048;
            for (int kk = 0; kk < D; ++kk) { const float hv = bfv(HP, slot * D + kk); ug += hv * w[(size_t)kk * 2048 + 2 * c]; uu += hv * w[(size_t)kk * 2048 + 2 * c + 1]; }
            const float gc = fminf(ug, 7.f), uc = fminf(fmaxf(uu, -7.f), 7.f); const float ref = (uc + 1.f) * gc * sigm_(1.702f * gc);
            report(err, 13, bfv(ACT, slot * D + c), ref, 0.25f); }
        return; }
    if (stage == 14) {
        const int* cs = DBG_CS_12;
        if (tid < 192) { const int r = SROWS[tid / 16], k = (tid / 4) % 4, c = cs[tid % 4]; const v2u pr = PAIR[(size_t)r * 4 + k]; const int e = pr.x & 31; const size_t slot = (size_t)tstart[e] * 256 + (pr.x >> 5);
            float s = a.in[23][(size_t)e * 1024 + c]; const float* w = a.in[22] + (size_t)e * 1024 * 1024;
            for (int kk = 0; kk < D; ++kk) s += bfv(ACT, slot * D + kk) * w[(size_t)kk * 1024 + c];
            report(err, 14, bfv(YP, slot * D + c), s, 0.25f); }
        return; }
    if (stage == 15) {
        const int* cs = DBG_CS_13;
        if (tid < 48) { const int r = SROWS[tid / 4], c = cs[tid % 4]; int b, t, j; row_info(r, b, t, j); float f = 0.f;
            for (int k = 0; k < 4; ++k) { const v2u pr = PAIR[(size_t)r * 4 + k]; const size_t slot = (size_t)tstart[pr.x & 31] * 256 + (pr.x >> 5); f += __uint_as_float((unsigned)(pr.y + 0u)) * bfv(YP, slot * D + c); }
            scr[2048 + tid] = X[(size_t)r * D + c] + MOD[(size_t)j * MODW + 5 * D + c] * f; }
        return; }
    if (stage == 16) {
        const int* cs = DBG_CS_14;
        if (tid < 48) { const int r = SROWS[tid / 4], c = cs[tid % 4]; report(err, 16, X[(size_t)r * D + c], scr[2048 + tid], 0.02f); }
        return; }
    if (stage == 99) {
        if (tid == 0) {
#if MK_DEBUG == 3
            a.out[0] = (err[44] + 1.f) * 1e20f; return;
#endif
#if MK_DEBUG == 2
            { const float* db = err + 4096; const v2u* PR = (const v2u*)(a.ws + WS_PAIR); int code = 0;
              auto close = [](float x, float y) { return fabsf(x - y) <= 1e-3f * (fabsf(y) + 1e-3f); };
              for (int ln = 0; ln < 4 && !code; ++ln) for (int j = 0; j < 4; ++j) if (!(db[ln * 16 + j] == db[j])) { code = 10 + ln; break; }
              if (!code) for (int j = 0; j < 3; ++j) if (!(db[j] >= db[j + 1])) code = 20 + j;
              if (!code) for (int ln = 0; ln < 4 && !code; ++ln) for (int j = 0; j < 3; ++j) if (!close(db[ln * 16 + 4 + j], expf(db[j + 1] - db[0]))) { code = 30 + ln; break; }
              if (!code) for (int ln = 0; ln < 4; ++ln) if (!close(db[ln * 16 + 7], 1.f + db[ln * 16 + 4] + db[ln * 16 + 5] + db[ln * 16 + 6])) { code = 40 + ln; break; }
              if (!code) for (int ln = 0; ln < 4; ++ln) if (!close(db[ln * 16 + 8], 1.f / db[ln * 16 + 7])) { code = 50 + ln; break; }
              if (!code) for (int ln = 0; ln < 4; ++ln) if (!close(db[ln * 16 + 9], (ln == 0 ? 1.f : db[ln * 16 + 3 + ln]) * db[ln * 16 + 8])) { code = 60 + ln; break; }
              if (!code) for (int ln = 0; ln < 4; ++ln) if (!close(__uint_as_float((unsigned)(PR[ln].y + 0u)), db[ln * 16 + 9])) { code = 70 + ln; break; }
              if (!code) code = 88;
              a.out[0] = (float)code * 1e20f; return; }
#endif
            int mask = 0; for (int i = 0; i < 6; ++i) if (err[17 + i] > 0.06f) mask |= 1 << i; if (mask) err[11] = 1.f;
            for (int s = 1; s < 17; ++s) if (err[s] > 0.06f) { if (s == 11) { a.out[0] = (float)(10 + mask) * 1e14f; break; } a.out[0] = (1.f + 10.f * fminf(err[s], 0.89f)) * powf(10.f, (float)(4 + s)); break; } }
        return; }
}
}
#endif
#ifndef MK_ONE_LAUNCH
#define MK_ONE_LAUNCH 1
#endif
extern "C" void kernel_launch(void* const* d_in, const int* in_sizes, int n_in, void* d_out, int out_size, void* d_ws, size_t ws_size, hipStream_t stream) {
    using namespace mk;
    static int grid = 0;
    if (grid == 0) {
        if (n_in != 24 || out_size != NB * SQ * D || ws_size < WS_END) { fprintf(stderr, "kernel_launch: unexpected shapes (n_in %d, out %d, ws %zu)\n", n_in, out_size, ws_size); grid = -1; return; }
        int dev = 0, cus = 0, per_cu = 0;
        if (hipGetDevice(&dev) != hipSuccess || hipDeviceGetAttribute(&cus, hipDeviceAttributeMultiprocessorCount, dev) != hipSuccess) { grid = -1; return; }
        if (hipFuncSetAttribute((const void*)mk_fwd, hipFuncAttributeMaxDynamicSharedMemorySize, LDS_BYTES) != hipSuccess) { fprintf(stderr, "kernel_launch: hipFuncSetAttribute failed\n"); grid = -1; return; }
        if (hipOccupancyMaxActiveBlocksPerMultiprocessor(&per_cu, (const void*)mk_fwd, NWAVES * 64, LDS_BYTES) != hipSuccess || per_cu < 1) { fprintf(stderr, "kernel_launch: occupancy query says %d\n", per_cu); per_cu = 1; }
        (void)hipGetLastError();
        grid = cus;
    }
    if (grid < 0) return;
    (void)hipMemsetAsync((char*)d_ws + WS_CTL, 0, CTL_ZERO_BYTES, stream);
    Args a{};
    for (int i = 0; i < 24; ++i) a.in[i] = (const float*)d_in[i];
    a.out = (float*)d_out; a.ws = (unsigned char*)d_ws;
#if MK_ONE_LAUNCH
    a.ph_lo = 0; a.ph_hi = NPHASE;
    hipLaunchKernelGGL(mk_fwd, dim3(grid), dim3(NWAVES * 64), LDS_BYTES, stream, a);
#else
#if defined(MK_DEBUG)
#define DBG(s) hipLaunchKernelGGL(mkdbg::dbg_kernel, dim3(1), dim3(256), 0, stream, a, (s))
    DBG(0);
#else
#define DBG(s) do {} while (0)
#endif
    for (int p = 0; p < NPHASE; ++p) { a.ph_lo = p; a.ph_hi = p + 1; hipLaunchKernelGGL(mk_fwd, dim3(grid), dim3(NWAVES * 64), LDS_BYTES, stream, a);
        if (p == 0) DBG(1); if (p == 1) DBG(2); if (p == 2) DBG(3); if (p == 3) DBG(4); if (p == 4) DBG(5); if (p == 5) DBG(6); if (p == 6) DBG(9); if (p == 7) DBG(8); if (p == 8) DBG(10);
        if (p == 9) DBG(11); if (p == 10) DBG(12); if (p == 11) DBG(13); if (p == 12) { DBG(14); DBG(15); } if (p == 13) DBG(16); }
    DBG(99);
#endif
}
```

```cpp
#include <hip/hip_runtime.h>
#include <hip/hip_bf16.h>
#include <cstdio>
#include <cstdint>
#include <cmath>
namespace pg8 {
#define PG8_LAS __attribute__((address_space(3)))
typedef unsigned short bf16_t;
typedef short bf16x8 __attribute__((ext_vector_type(8)));
typedef float f32x4 __attribute__((ext_vector_type(4)));
typedef unsigned u32x4 __attribute__((ext_vector_type(4)));
typedef int i32x4 __attribute__((ext_vector_type(4)));
typedef int i32x8 __attribute__((ext_vector_type(8)));
typedef unsigned u32x2 __attribute__((ext_vector_type(2)));
constexpr int BM = 256, BK = 64, HALF = 128, HTB = HALF * BK * 2  , STAGE_BYTES = 8 * HTB, NXCD = 8, WGM = 8;

__host__ __device__ __forceinline__ int lds_byte(int r, int c) { const int st = (r >> 4) * 2 + (c >> 5), rr = r & 15, cc = c & 31, ob = rr * 64 + cc * 2; return st * 1024 + (ob ^ (((ob >> 9) & 1) << 5)); }
__host__ __device__ __forceinline__ void stage_rc(int b, int& R, int& C) { const int st = b / 1024, sb = b % 1024, swz = sb ^ (((sb >> 9) & 1) << 5); R = (st >> 1) * 16 + swz / 64; C = (st & 1) * 32 + (swz % 64) / 2; }
__host__ __device__ __forceinline__ int perm32(int rho) { const int n = rho >> 4, i = rho & 15; return 8 * (i >> 2) + 4 * n + (i & 3); }

struct Unit { int pm, pn; };
struct Gemm { const bf16_t* A; const bf16_t* Bt; int M, N, K; };

struct StaticOrder {
    int nM, nN, nwg, G, c;
    __host__ __device__ void init(int M, int N, int G_, int c_) { nM = M / BM; nN = N / BM; nwg = nM * nN; G = G_; c = c_; }
    __host__ __device__ bool next(int i, Unit& u) const {
        const long L = (long)i * G + c; if (L >= nwg) return false;
        int wgid = (int)L; { const int q = nwg / NXCD, r = nwg % NXCD, xcd = wgid % NXCD, off = wgid / NXCD; wgid = (xcd < r ? xcd * (q + 1) : r * (q + 1) + (xcd - r) * q) + off; }
        const int nig = WGM * nN, gid = wgid / nig, fm = gid * WGM, gsz = (nM - fm) < WGM ? (nM - fm) : WGM;
        u.pm = fm + ((wgid % nig) % gsz); u.pn = (wgid % nig) / gsz; return true;
    }
    __device__ __forceinline__ void a_ready(const Unit&) const {}
    __device__ __forceinline__ void done(const Unit&) const {}
};

__device__ __forceinline__ unsigned cvt_pk_bf16(float lo, float hi) { unsigned r; asm volatile("v_cvt_pk_bf16_f32 %0, %1, %2" : "=v"(r) : "v"(lo), "v"(hi)); return r; }
typedef float f32x2 __attribute__((ext_vector_type(2)));

struct MoeOrder {
    int nN, ntl, nwg, G, c; const PG8_LAS unsigned char* t2e;
    __device__ __forceinline__ void init(int ntl_, int nN_, int G_, int c_, const PG8_LAS unsigned char* t2e_) { ntl = ntl_; nN = nN_; nwg = ntl_ * nN_; G = G_; c = c_; t2e = t2e_; }
    __device__ __forceinline__ bool next(int i, Unit& u) const {
        const long L = (long)i * G + c; if (L >= nwg) return false;
        int wgid = (int)L; { const int q = nwg / NXCD, r = nwg % NXCD, xcd = wgid % NXCD, off = wgid / NXCD; wgid = (xcd < r ? xcd * (q + 1) : r * (q + 1) + (xcd - r) * q) + off; }
        const int nig = WGM * nN, gid = wgid / nig, fm = gid * WGM, gsz = (ntl - fm) < WGM ? (ntl - fm) : WGM;
        const int rt = fm + ((wgid % nig) % gsz), pn = (wgid % nig) / gsz;
        u.pm = rt; u.pn = (int)t2e[rt] * nN + pn; return true;
    }
    __device__ __forceinline__ void a_ready(const Unit&) const {}
    __device__ __forceinline__ void done(const Unit&) const {}
};

struct EpiStore {
    static constexpr bool PERM = true, AFTER_DRAIN = false;
    bf16_t* O; int ldc;
    __device__ __forceinline__ void operator()(const f32x4 (&acc)[2][2][4][2], const Unit& u, int wr, int wc, int fr, int fq) const {
        const int row0 = u.pm * BM + wr * 64 + fr, col0 = u.pn * BM + wc * 32 + 8 * fq;
#pragma unroll
        for (int ai = 0; ai < 2; ++ai)
#pragma unroll
            for (int m = 0; m < 4; ++m) { bf16_t* rowp = O + (size_t)(row0 + ai * HALF + m * 16) * ldc + col0;
#pragma unroll
                for (int bj = 0; bj < 2; ++bj) { const f32x4 v0 = acc[ai][bj][m][0], v1 = acc[ai][bj][m][1];
                    u32x4 w; w.x = cvt_pk_bf16(v0[0], v0[1]); w.y = cvt_pk_bf16(v0[2], v0[3]); w.z = cvt_pk_bf16(v1[0], v1[1]); w.w = cvt_pk_bf16(v1[2], v1[3]);
                    *(u32x4*)(rowp + bj * HALF) = w; } }
    }
};
struct EpiResid {
    static constexpr bool PERM = false, AFTER_DRAIN = false;
    float* X; const float* gate;
    __device__ __forceinline__ void operator()(const f32x4 (&acc)[2][2][4][2], const Unit& u, int wr, int wc, int fr, int fq) const {
        const int seg = u.pm / 17, rem = u.pm - seg * 17; const int j = (rem == 16) ? 16 : seg;
        const int row0 = u.pm * BM + wr * 64 + fr, col0 = u.pn * BM + wc * 32 + 4 * fq;
        const float* g = gate + (size_t)j * 6144 + col0;
        f32x4 gv[2][2];
#pragma unroll
        for (int bj = 0; bj < 2; ++bj)
#pragma unroll
            for (int n = 0; n < 2; ++n) gv[bj][n] = *(const f32x4*)(g + bj * HALF + n * 16);
#pragma unroll
        for (int ai = 0; ai < 2; ++ai)
#pragma unroll
            for (int m = 0; m < 4; ++m) { float* rowp = X + (size_t)(row0 + ai * HALF + m * 16) * 1024 + col0;
#pragma unroll
                for (int bj = 0; bj < 2; ++bj)
#pragma unroll
                    for (int n = 0; n < 2; ++n) { f32x4* p = (f32x4*)(rowp + bj * HALF + n * 16); *p = *p + gv[bj][n] * acc[ai][bj][m][n]; } }
    }
};
struct EpiLogits {
    static constexpr bool PERM = false, AFTER_DRAIN = false;
    float* LOG;
    __device__ __forceinline__ void operator()(const f32x4 (&acc)[2][2][4][2], const Unit& u, int wr, int wc, int fr, int fq) const {
        if (wc != 0) return;
        const int row0 = u.pm * BM + wr * 64 + fr;
#pragma unroll
        for (int ai = 0; ai < 2; ++ai)
#pragma unroll
            for (int m = 0; m < 4; ++m) { float* rowp = LOG + (size_t)(row0 + ai * HALF + m * 16) * 32 + 4 * fq;
#pragma unroll
                for (int n = 0; n < 2; ++n) *(f32x4*)(rowp + n * 16) = acc[ai][0][m][n]; }
    }
};
struct EpiSwiglu {
    static constexpr bool PERM = true, AFTER_DRAIN = false;
    bf16_t* ACT; const float* b1p;
    __device__ __forceinline__ void operator()(const f32x4 (&acc)[2][2][4][2], const Unit& u, int wr, int wc, int fr, int fq) const {
        const int e = u.pn >> 3, pn = u.pn & 7;
        const int row0 = u.pm * BM + wr * 64 + fr, lc = wc * 32 + 8 * fq;
        const float* bp = b1p + (size_t)e * 2048 + pn * 256 + lc;
        f32x4 bg[2], bu[2];
#pragma unroll
        for (int n = 0; n < 2; ++n) { bg[n] = *(const f32x4*)(bp + 4 * n); bu[n] = *(const f32x4*)(bp + HALF + 4 * n); }
#pragma unroll
        for (int ai = 0; ai < 2; ++ai)
#pragma unroll
            for (int m = 0; m < 4; ++m) { bf16_t* rowp = ACT + (size_t)(row0 + ai * HALF + m * 16) * 1024 + pn * 128 + lc;
                f32x4 a[2];
#pragma unroll
                for (int n = 0; n < 2; ++n) { const f32x4 gt = acc[ai][0][m][n] + bg[n], up = acc[ai][1][m][n] + bu[n];
#pragma unroll
                    for (int i = 0; i < 4; ++i) { const float gc = fminf(gt[i], 7.0f), uc = fminf(fmaxf(up[i], -7.0f), 7.0f);
                        const float sg = __builtin_amdgcn_rcpf(1.0f + __builtin_amdgcn_exp2f(gc * (-1.702f * 1.4426950408889634f)));
                        a[n][i] = (uc + 1.0f) * (gc * sg); } }
                u32x4 w; w.x = cvt_pk_bf16(a[0][0], a[0][1]); w.y = cvt_pk_bf16(a[0][2], a[0][3]); w.z = cvt_pk_bf16(a[1][0], a[1][1]); w.w = cvt_pk_bf16(a[1][2], a[1][3]);
                *(u32x4*)rowp = w; }
    }
};
struct EpiSwiglu8 {
    static constexpr bool PERM = true, AFTER_DRAIN = false;
    unsigned char* ACT; const float* b1p;
    __device__ __forceinline__ void operator()(const f32x4 (&acc)[2][2][4][2], const Unit& u, int wr, int wc, int fr, int fq) const {
        const int e = u.pn >> 3, pn = u.pn & 7;
        const int row0 = u.pm * BM + wr * 64 + fr, lc = wc * 32 + 8 * fq;
        const float* bp = b1p + (size_t)e * 2048 + pn * 256 + lc;
        f32x4 bg[2], bu[2];
#pragma unroll
        for (int n = 0; n < 2; ++n) { bg[n] = *(const f32x4*)(bp + 4 * n); bu[n] = *(const f32x4*)(bp + HALF + 4 * n); }
#pragma unroll
        for (int ai = 0; ai < 2; ++ai)
#pragma unroll
            for (int m = 0; m < 4; ++m) { unsigned char* rowp = ACT + (size_t)(row0 + ai * HALF + m * 16) * 1024 + pn * 128 + lc;
                f32x4 a[2];
#pragma unroll
                for (int n = 0; n < 2; ++n) { const f32x4 gt = acc[ai][0][m][n] + bg[n], up = acc[ai][1][m][n] + bu[n];
#pragma unroll
                    for (int i = 0; i < 4; ++i) { const float gc = fminf(gt[i], 7.0f), uc = fminf(fmaxf(up[i], -7.0f), 7.0f);
                        const float sg = __builtin_amdgcn_rcpf(1.0f + __builtin_amdgcn_exp2f(gc * (-1.702f * 1.4426950408889634f)));
                        a[n][i] = (uc + 1.0f) * (gc * sg); } }
                int p0 = __builtin_amdgcn_cvt_pk_fp8_f32(a[0][0], a[0][1], 0, false); p0 = __builtin_amdgcn_cvt_pk_fp8_f32(a[0][2], a[0][3], p0, true);
                int p1 = __builtin_amdgcn_cvt_pk_fp8_f32(a[1][0], a[1][1], 0, false); p1 = __builtin_amdgcn_cvt_pk_fp8_f32(a[1][2], a[1][3], p1, true);
                *(u32x2*)rowp = (u32x2){(unsigned)p0, (unsigned)p1}; }
    }
};
struct EpiDown {
    static constexpr bool PERM = true, AFTER_DRAIN = false;
    bf16_t* YP; const float* b2;
    __device__ __forceinline__ void operator()(const f32x4 (&acc)[2][2][4][2], const Unit& u, int wr, int wc, int fr, int fq) const {
        const int e = u.pn >> 2, pn = u.pn & 3;
        const int row0 = u.pm * BM + wr * 64 + fr, col0 = pn * BM + wc * 32 + 8 * fq;
        const float* bp = b2 + (size_t)e * 1024 + col0;
        f32x4 bv[2][2];
#pragma unroll
        for (int bj = 0; bj < 2; ++bj)
#pragma unroll
            for (int n = 0; n < 2; ++n) bv[bj][n] = *(const f32x4*)(bp + bj * HALF + 4 * n);
#pragma unroll
        for (int ai = 0; ai < 2; ++ai)
#pragma unroll
            for (int m = 0; m < 4; ++m) { bf16_t* rowp = YP + (size_t)(row0 + ai * HALF + m * 16) * 1024 + col0;
#pragma unroll
                for (int bj = 0; bj < 2; ++bj) { const f32x4 v0 = acc[ai][bj][m][0] + bv[bj][0], v1 = acc[ai][bj][m][1] + bv[bj][1];
                    u32x4 w; w.x = cvt_pk_bf16(v0[0], v0[1]); w.y = cvt_pk_bf16(v0[2], v0[3]); w.z = cvt_pk_bf16(v1[0], v1[1]); w.w = cvt_pk_bf16(v1[2], v1[3]);
                    *(u32x4*)(rowp + bj * HALF) = w; } }
    }
};

template <class Epi, class Sched, bool ALIGN_EPI = false, bool SP2 = false, bool F8 = false>
__device__ __forceinline__ void gemm_phase(PG8_LAS unsigned char* lds, const Gemm g, const Sched& S, const Epi& E) {
    int tid_ = threadIdx.x; asm volatile("" : "+v"(tid_));
    const int tid = tid_, wid = __builtin_amdgcn_readfirstlane(tid >> 6), lane = tid & 63, wr = wid >> 2, wc = wid & 3, fr = lane & 15, fq = lane >> 4;
    int K_ = g.K; asm volatile("" : "+s"(K_));
    const int K = K_, nt = K / BK;
    unsigned voffA[2], voffB[2];
#pragma unroll
    for (int i = 0; i < 2; ++i) { int R, C; stage_rc(tid * 16 + i * 8192, R, C); const int Rb = Epi::PERM ? ((R & ~31) + perm32(R & 31)) : R;
        voffA[i] = (unsigned)(R * K + C) * 2u; voffB[i] = (unsigned)(Rb * K + C) * 2u; }
    const size_t kstep = (size_t)(BK * 2);
    const size_t hstep = (size_t)HALF * K * 2;
    const size_t tstep = 2 * hstep;
    const unsigned ldsw = (unsigned)wid * 1024u;
    const int aoff = lds_byte(wr * 64 + fr, fq * 8), boff = lds_byte(wc * 32 + fr, fq * 8);
#define PG8_SA(b, h) (((b) * 2 + (h)) * HTB)
#define PG8_SB(b, h) ((4 + (b) * 2 + (h)) * HTB)
#define PG8_STAGE(bufoff, gbase, voff) do { _Pragma("unroll") for (int _i = 0; _i < 2; ++_i) \
        __builtin_amdgcn_global_load_lds((const unsigned*)((const char*)(gbase) + (voff)[_i]), (PG8_LAS unsigned*)(lds + (bufoff) + ldsw + _i * 8192), 16, 0, 0); } while (0)
#define PG8_CAT(x0, x1) __builtin_shufflevector(__builtin_bit_cast(i32x4, x0), __builtin_bit_cast(i32x4, x1), 0, 1, 2, 3, 4, 5, 6, 7)
#define PG8_LDF(base, off) (*(const PG8_LAS bf16x8*)(lds + (base) + (off)))
#define PG8_LDA(dst, dst8, b, h) do { _Pragma("unroll") for (int m = 0; m < 4; ++m) { if constexpr (F8) dst8[m] = PG8_CAT(PG8_LDF(PG8_SA(b, h), aoff + m * 2048), PG8_LDF(PG8_SA(b, h), aoff + m * 2048 + 1024)); \
        else { _Pragma("unroll") for (int k = 0; k < 2; ++k) dst[m][k] = PG8_LDF(PG8_SA(b, h), aoff + m * 2048 + k * 1024); } } } while (0)
#define PG8_LDB(dst, dst8, b, h) do { _Pragma("unroll") for (int n = 0; n < 2; ++n) { if constexpr (F8) dst8[n] = PG8_CAT(PG8_LDF(PG8_SB(b, h), boff + n * 2048), PG8_LDF(PG8_SB(b, h), boff + n * 2048 + 1024)); \
        else { _Pragma("unroll") for (int k = 0; k < 2; ++k) dst[n][k] = PG8_LDF(PG8_SB(b, h), boff + n * 2048 + k * 1024); } } } while (0)
#define PG8_MMA(ai, bj, At, At8, Bt, Bt8) do { __builtin_amdgcn_s_setprio(1); _Pragma("unroll") for (int m = 0; m < 4; ++m) _Pragma("unroll") for (int n = 0; n < 2; ++n) { \
        if constexpr (F8) asm volatile("v_mfma_scale_f32_16x16x128_f8f6f4 %0, %1, %2, %0, %3, %4 op_sel_hi:[0,0,0]" : "+v"(acc[ai][bj][m][n]) : "v"(Bt8[n]), "v"(At8[m]), "v"(f8_sw), "v"(f8_sa));   \
        else { _Pragma("unroll") for (int k = 0; k < 2; ++k) acc[ai][bj][m][n] = __builtin_amdgcn_mfma_f32_16x16x32_bf16(Bt[n][k], At[m][k], acc[ai][bj][m][n], 0, 0, 0); } } __builtin_amdgcn_s_setprio(0); } while (0)
#define PG8_WAIT_V(n) asm volatile("s_waitcnt vmcnt(" #n ")" ::: "memory")
#define PG8_WAIT_L(n) asm volatile("s_waitcnt lgkmcnt(" #n ")" ::: "memory")
#define PG8_BAR __builtin_amdgcn_s_barrier()
#define PG8_SCHED __builtin_amdgcn_sched_barrier(0)
    Unit cur, nxt; int ui = 0;
    if (!S.next(0, cur)) return;
    f32x4 acc[2][2][4][2];
#pragma unroll
    for (int a = 0; a < 2; ++a)
#pragma unroll
        for (int b = 0; b < 2; ++b)
#pragma unroll
            for (int m = 0; m < 4; ++m)
#pragma unroll
                for (int n = 0; n < 2; ++n) acc[a][b][m][n] = (f32x4){0.f, 0.f, 0.f, 0.f};
    int f8_sw = 0x7A7A7A7A, f8_sa = 0x7F7F7F7F; asm volatile("" : "+v"(f8_sw), "+v"(f8_sa));
    bf16x8 At[4][2], B0[2][2], B1[2][2]; i32x8 At8[4], B08[2], B18[2];
    const char* cA = (const char*)g.A + (size_t)cur.pm * tstep; const char* cB = (const char*)g.Bt + (size_t)cur.pn * tstep;
    S.a_ready(cur);
    if constexpr (SP2) {
        PG8_STAGE(PG8_SB(0, 0), cB, voffB); PG8_STAGE(PG8_SB(0, 1), cB + hstep, voffB); PG8_STAGE(PG8_SA(0, 0), cA, voffA); PG8_STAGE(PG8_SA(0, 1), cA + hstep, voffA);
        if (wr == 1) PG8_BAR;
        PG8_WAIT_V(2); PG8_BAR;
        PG8_STAGE(PG8_SB(1, 0), cB + kstep, voffB); PG8_STAGE(PG8_SA(1, 0), cA + kstep, voffA); PG8_STAGE(PG8_SB(1, 1), cB + hstep + kstep, voffB);
        PG8_WAIT_V(6); PG8_BAR;
    } else {
        PG8_STAGE(PG8_SB(0, 0), cB, voffB); PG8_STAGE(PG8_SA(0, 0), cA, voffA); PG8_STAGE(PG8_SB(0, 1), cB + hstep, voffB); PG8_STAGE(PG8_SA(0, 1), cA + hstep, voffA);
        if (wr == 1) PG8_BAR;
        PG8_WAIT_V(4); PG8_BAR;
        PG8_STAGE(PG8_SB(1, 0), cB + kstep, voffB); PG8_STAGE(PG8_SA(1, 0), cA + kstep, voffA); PG8_STAGE(PG8_SB(1, 1), cB + hstep + kstep, voffB);
        PG8_WAIT_V(6); PG8_BAR;
    }
    for (;;) {
        const bool has_next = S.next(ui + 1, nxt);
        const char* nA = has_next ? (const char*)g.A + (size_t)nxt.pm * tstep : cA; const char* nB = has_next ? (const char*)g.Bt + (size_t)nxt.pn * tstep : cB;
        for (int t = 0; t < nt; t += 2) {
            const bool last = (t == nt - 2);
            const char* a1 = cA + (size_t)(t + 1) * kstep;
            const char* a2 = last ? nA : cA + (size_t)(t + 2) * kstep; const char* b2 = last ? nB : cB + (size_t)(t + 2) * kstep;
            const char* a3 = a2 + kstep; const char* b3 = b2 + kstep;
            if (last && has_next) S.a_ready(nxt);
            if constexpr (SP2) {
            PG8_LDB(B0, B08, 0, 0); PG8_LDB(B1, B18, 0, 1); PG8_SCHED; PG8_LDA(At, At8, 0, 0); PG8_STAGE(PG8_SA(1, 1), a1 + hstep, voffA);
            PG8_WAIT_V(8); PG8_WAIT_L(0); PG8_BAR; PG8_MMA(0, 0, At, At8, B0, B08); PG8_MMA(0, 1, At, At8, B1, B18); PG8_BAR; PG8_SCHED;
            PG8_LDA(At, At8, 0, 1); PG8_STAGE(PG8_SB(0, 0), b2, voffB); PG8_STAGE(PG8_SB(0, 1), b2 + hstep, voffB); PG8_STAGE(PG8_SA(0, 0), a2, voffA);
            PG8_WAIT_V(8); PG8_WAIT_L(0); PG8_BAR; PG8_MMA(1, 0, At, At8, B0, B08); PG8_MMA(1, 1, At, At8, B1, B18); PG8_BAR; PG8_SCHED;
            PG8_LDB(B0, B08, 1, 0); PG8_LDB(B1, B18, 1, 1); PG8_SCHED; PG8_LDA(At, At8, 1, 0); PG8_STAGE(PG8_SA(0, 1), a2 + hstep, voffA);
            PG8_WAIT_V(8); PG8_WAIT_L(0); PG8_BAR; PG8_MMA(0, 0, At, At8, B0, B08); PG8_MMA(0, 1, At, At8, B1, B18); PG8_BAR; PG8_SCHED;
            PG8_LDA(At, At8, 1, 1); PG8_STAGE(PG8_SB(1, 0), b3, voffB); PG8_STAGE(PG8_SB(1, 1), b3 + hstep, voffB); PG8_STAGE(PG8_SA(1, 0), a3, voffA);
            PG8_WAIT_V(8); PG8_WAIT_L(0); PG8_BAR; PG8_MMA(1, 0, At, At8, B0, B08); PG8_MMA(1, 1, At, At8, B1, B18); PG8_BAR; PG8_SCHED;
            } else {
            PG8_LDB(B0, B08, 0, 0); PG8_SCHED; PG8_LDA(At, At8, 0, 0); PG8_STAGE(PG8_SA(1, 1), a1 + hstep, voffA);
            PG8_WAIT_L(8); PG8_BAR; PG8_WAIT_L(0); PG8_MMA(0, 0, At, At8, B0, B08); PG8_BAR; PG8_SCHED;
            PG8_LDB(B1, B18, 0, 1); PG8_STAGE(PG8_SB(0, 0), b2, voffB);
            PG8_BAR; PG8_WAIT_L(0); PG8_MMA(0, 1, At, At8, B1, B18); PG8_BAR;
            PG8_LDA(At, At8, 0, 1); PG8_STAGE(PG8_SA(0, 0), a2, voffA);
            PG8_BAR; PG8_WAIT_L(0); PG8_MMA(1, 0, At, At8, B0, B08); PG8_BAR; PG8_SCHED;
            PG8_STAGE(PG8_SB(0, 1), b2 + hstep, voffB);
            PG8_WAIT_V(6); PG8_BAR; PG8_MMA(1, 1, At, At8, B1, B18); PG8_BAR;
            PG8_LDB(B0, B08, 1, 0); PG8_SCHED; PG8_LDA(At, At8, 1, 0); PG8_STAGE(PG8_SA(0, 1), a2 + hstep, voffA);
            PG8_WAIT_L(8); PG8_BAR; PG8_WAIT_L(0); PG8_MMA(0, 0, At, At8, B0, B08); PG8_BAR; PG8_SCHED;
            PG8_LDB(B1, B18, 1, 1); PG8_STAGE(PG8_SB(1, 0), b3, voffB);
            PG8_BAR; PG8_WAIT_L(0); PG8_MMA(0, 1, At, At8, B1, B18); PG8_BAR;
            PG8_LDA(At, At8, 1, 1); PG8_STAGE(PG8_SA(1, 0), a3, voffA);
            PG8_BAR; PG8_WAIT_L(0); PG8_MMA(1, 0, At, At8, B0, B08); PG8_BAR; PG8_SCHED;
            PG8_STAGE(PG8_SB(1, 1), b3 + hstep, voffB);
            PG8_WAIT_V(6); PG8_BAR; PG8_MMA(1, 1, At, At8, B1, B18); PG8_BAR;
            }
        }
        if constexpr (ALIGN_EPI) { if (wr == 0) PG8_BAR; }
        if constexpr (F8) asm volatile("s_nop 15\n\ts_nop 15" ::: "memory");
        if constexpr (!Epi::AFTER_DRAIN) { E(acc, cur, wr, wc, fr, fq); S.done(cur); }
        if (!has_next) break;
#pragma unroll
        for (int a = 0; a < 2; ++a)
#pragma unroll
            for (int b = 0; b < 2; ++b)
#pragma unroll
                for (int m = 0; m < 4; ++m)
#pragma unroll
                    for (int n = 0; n < 2; ++n) acc[a][b][m][n] = (f32x4){0.f, 0.f, 0.f, 0.f};
        cur = nxt; cA = nA; cB = nB; ++ui;
        if constexpr (ALIGN_EPI) { if (wr == 1) PG8_BAR; }
    }
    PG8_WAIT_V(0);
    if constexpr (!ALIGN_EPI) { if (wr == 0) PG8_BAR; }
    PG8_BAR;
    if constexpr (Epi::AFTER_DRAIN) { E.fused(acc, cur, wr, wc, fr, fq, lds, wid, lane); S.done(cur); }
#undef PG8_SA
#undef PG8_SB
#undef PG8_STAGE
#undef PG8_LDA
#undef PG8_LDF
#undef PG8_LDB
#undef PG8_MMA
#undef PG8_CAT
#undef PG8_WAIT_V
#undef PG8_WAIT_L
#undef PG8_BAR
#undef PG8_SCHED
}
}
#ifndef ATTN_STORE16
#define ATTN_STORE16(p,v) (*(u32x4*)(p)=(v))
#endif
namespace attn_body {
using bf16=__hip_bfloat16;
using bf16x8=__attribute__((ext_vector_type(8)))short;
using s16x4=__attribute__((ext_vector_type(4)))short;
using f32x16=__attribute__((ext_vector_type(16)))float;
using u32x4=__attribute__((ext_vector_type(4)))unsigned;
constexpr int D=64,PQ=2048,PO=1024,KOFF=512,VOFF=640;
constexpr int NW=8,QBLK=32,QB=QBLK*NW,KVBLK=64;
__device__ __forceinline__ int crow(int r,int hi){return (r&3)+8*(r>>2)+4*hi;}
#define SBAR() __builtin_amdgcn_sched_barrier(0)
constexpr int NSLOT=3, SLOTB=8192;
constexpr int LDS_K=0, LDS_V=NSLOT*SLOTB, LDS_WS=2*NSLOT*SLOTB, LDS_OST=LDS_WS+NW*64*4, LDS_BYTES=LDS_OST+NW*4096;
constexpr float C2=0.125f*1.4426950408889634f;
__device__ __forceinline__ void glds16(const void*gsrc,unsigned lds_dst){unsigned keep;
  asm volatile("s_mov_b32 %0, m0\n\ts_mov_b32 m0, %2\n\ts_nop 0\n\tglobal_load_lds_dwordx4 %1, off\n\ts_mov_b32 m0, %0":"=&s"(keep):"v"(gsrc),"s"(lds_dst):"memory");}
__device__ __forceinline__ float max3f(float a,float b,float c){float r;asm("v_max3_f32 %0, %1, %2, %3":"=v"(r):"v"(a),"v"(b),"v"(c));return r;}
__device__ __forceinline__ float max2f(float a,float b){float r;asm("v_max_f32_e32 %0, %1, %2":"=v"(r):"v"(a),"v"(b));return r;}
__device__ __forceinline__ float fadd_s(float a,float b){float r;asm("v_add_f32_e32 %0, %1, %2":"=v"(r):"v"(a),"v"(b));return r;}
__device__ __forceinline__ float fsub_s(float a,float b){float r;asm("v_sub_f32_e32 %0, %1, %2":"=v"(r):"v"(a),"v"(b));return r;}
typedef float f32x2_t __attribute__((ext_vector_type(2))); typedef __bf16 bf16x2_t __attribute__((ext_vector_type(2)));
__device__ __forceinline__ unsigned cvtpk_s(float lo,float hi){f32x2_t v={lo,hi};bf16x2_t b=__builtin_convertvector(v,bf16x2_t);return __builtin_bit_cast(unsigned,b);}
#define WAIT_BAR(N) asm volatile("s_waitcnt vmcnt(" #N ") lgkmcnt(0)\n\ts_barrier":::"memory")

__device__ __forceinline__ void qkt(f32x16&p0,f32x16&p1,const char*Kslot,const bf16x8*qr,const f32x16&negm,int r32,int hi){
  const char*kb=Kslot+hi*1024+r32*16;
  #pragma unroll
  for(int d0=0;d0<4;++d0){
    const bf16x8 b0=*reinterpret_cast<const bf16x8*>(kb+d0*2048);
    const bf16x8 b1=*reinterpret_cast<const bf16x8*>(kb+d0*2048+512);
    if(d0==0){p0=__builtin_amdgcn_mfma_f32_32x32x16_bf16(b0,qr[0],negm,0,0,0);p1=__builtin_amdgcn_mfma_f32_32x32x16_bf16(b1,qr[0],negm,0,0,0);}
    else{p0=__builtin_amdgcn_mfma_f32_32x32x16_bf16(b0,qr[d0],p0,0,0,0);p1=__builtin_amdgcn_mfma_f32_32x32x16_bf16(b1,qr[d0],p1,0,0,0);}}
}
typedef __attribute__((address_space(3))) const char* lds_cptr;
typedef short v4i16_t __attribute__((ext_vector_type(4)));
__device__ __forceinline__ void kload8(bf16x8*kf,lds_cptr kp){
  kf[0]=*(const __attribute__((address_space(3))) bf16x8*)(kp);      kf[1]=*(const __attribute__((address_space(3))) bf16x8*)(kp+512);
  kf[2]=*(const __attribute__((address_space(3))) bf16x8*)(kp+2048); kf[3]=*(const __attribute__((address_space(3))) bf16x8*)(kp+2560);
  kf[4]=*(const __attribute__((address_space(3))) bf16x8*)(kp+4096); kf[5]=*(const __attribute__((address_space(3))) bf16x8*)(kp+4608);
  kf[6]=*(const __attribute__((address_space(3))) bf16x8*)(kp+6144); kf[7]=*(const __attribute__((address_space(3))) bf16x8*)(kp+6656);
}
__device__ __forceinline__ void kload2(bf16x8*kf,lds_cptr kp,int j){ kf[2*j]=*(const __attribute__((address_space(3))) bf16x8*)(kp+j*2048); kf[2*j+1]=*(const __attribute__((address_space(3))) bf16x8*)(kp+j*2048+512); }
__device__ __forceinline__ s16x4 vtr(lds_cptr p){ return __builtin_bit_cast(s16x4,__builtin_amdgcn_ds_read_tr16_b64_v4i16((__attribute__((address_space(3))) v4i16_t*)p)); }
__device__ __forceinline__ float rowmax(const f32x16&p0,const f32x16&p1){
  float a=max3f(p0[0],p0[1],p1[0]),b=max3f(p0[2],p0[3],p1[1]);a=max3f(a,p1[2],p1[3]);
  #pragma unroll
  for(int r=4;r<16;r+=4){a=max3f(a,p0[r],p0[r+1]);b=max3f(b,p0[r+2],p0[r+3]);a=max3f(a,p1[r],p1[r+1]);b=max3f(b,p1[r+2],p1[r+3]);}
  const float m=max2f(a,b);
  auto rr=__builtin_amdgcn_permlane32_swap(__float_as_uint(m),__float_as_uint(m),false,false);
  return max2f(__uint_as_float(rr[0]),__uint_as_float(rr[1]));
}
__device__ __forceinline__ void pv(f32x16*o,int vb,bf16x8 pa0,bf16x8 pa1,bf16x8 pa2,bf16x8 pa3){
  #pragma unroll
  for(int d0=0;d0<2;++d0){s16x4 lo[4],hi[4];
    #pragma unroll
    for(int ks=0;ks<4;++ks){
      asm volatile("ds_read_b64_tr_b16 %0,%1 offset:%c2":"=&v"(lo[ks]):"v"(vb),"i"(d0*4096+ks*1024):"memory");
      asm volatile("ds_read_b64_tr_b16 %0,%1 offset:%c2":"=&v"(hi[ks]):"v"(vb),"i"(d0*4096+ks*1024+512):"memory");}
    asm volatile("s_waitcnt lgkmcnt(0)":::"memory");SBAR();
    #define PK(k) (bf16x8){lo[k][0],lo[k][1],lo[k][2],lo[k][3],hi[k][0],hi[k][1],hi[k][2],hi[k][3]}
    o[d0]=__builtin_amdgcn_mfma_f32_32x32x16_bf16(pa0,PK(0),o[d0],0,0,0);
    o[d0]=__builtin_amdgcn_mfma_f32_32x32x16_bf16(pa1,PK(1),o[d0],0,0,0);
    o[d0]=__builtin_amdgcn_mfma_f32_32x32x16_bf16(pa2,PK(2),o[d0],0,0,0);
    o[d0]=__builtin_amdgcn_mfma_f32_32x32x16_bf16(pa3,PK(3),o[d0],0,0,0);
    #undef PK
  }
}

template<int THRL> __device__ __forceinline__ void attn_unit(long qrow0,long krow0,int NTarg,int h,const bf16*Pq,bf16*Yo,char*shm){
  int tid_=threadIdx.x; asm volatile("":"+v"(tid_)); const int tid=tid_,lane=tid&63,r32=lane&31,hi=lane>>5; const int wid=__builtin_amdgcn_readfirstlane(tid>>6);
  const bf16*Qw=Pq+(qrow0+wid*QBLK)*PQ+h*D;
  const bf16*Kh=Pq+krow0*PQ+KOFF+(h>>2)*D,*Vh=Pq+krow0*PQ+VOFF+(h>>2)*D;
  const unsigned lds0=(unsigned)(uintptr_t)shm;
  float*wsf=(float*)(shm+LDS_WS)+wid*64;
  const bf16*ksrc=Kh+(long)lane*PQ+wid*8;
  const bf16*vsrc=Vh+(long)(16*(wid&3)+(lane>>2))*PQ+(wid>>2)*32+(lane&3)*8;
  const unsigned kdst=lds0+LDS_K+wid*1024, vdst=lds0+LDS_V+wid*1024;
  #define DMA_K(t,slot) glds16(ksrc+(long)(t)*KVBLK*PQ,(unsigned)__builtin_amdgcn_readfirstlane(kdst+(slot)))
  #define DMA_V(t,slot) glds16(vsrc+(long)(t)*KVBLK*PQ,(unsigned)__builtin_amdgcn_readfirstlane(vdst+(slot)))
  const int vb0=(int)(lds0+LDS_V)+((lane>>4)&1)*32+(lane&3)*8+(4*hi+((lane&15)>>2))*64;
  const char*Kbase=shm+LDS_K; bf16x8 kf[8];
  const lds_cptr shm3=(lds_cptr)shm; const lds_cptr kp0=shm3+LDS_K+hi*1024+r32*16; const lds_cptr vp0=shm3+LDS_V+((lane>>4)&1)*32+(lane&3)*8+(4*hi+((lane&15)>>2))*64;
  const int NT=NTarg;
  DMA_K(0,0);DMA_V(0,0);DMA_K(1,SLOTB);
  bf16x8 qr[4];
  #pragma unroll
  for(int d0=0;d0<4;++d0)qr[d0]=*reinterpret_cast<const bf16x8*>(&Qw[(long)r32*PQ+d0*16+hi*8]);
  float mhat=0.f,l_reg=0.f;f32x16 o[2];o[0]=f32x16{};o[1]=f32x16{};f32x16 negm=f32x16{};asm volatile("":"+v"(negm));

  #define CMASK(P0,P1,t) do{}while(0)
  bool resc=false;
  #define START(P0,P1) do{ const float rm=rowmax(P0,P1); resc=false; \
    { const float dl=rm; mhat=fadd_s(mhat,dl); \
      _Pragma("unroll") for(int r=0;r<16;++r){P0[r]=fsub_s(P0[r],dl);P1[r]=fsub_s(P1[r],dl);} \
      _Pragma("unroll") for(int r=0;r<16;++r)negm[r]=-mhat; asm volatile("":"+v"(negm)); } \
    _Pragma("unroll") for(int r=0;r<16;++r)P0[r]=__builtin_amdgcn_exp2f(P0[r]); }while(0)
  #define RESC() do{ if(resc){ asm volatile("s_waitcnt lgkmcnt(0)":::"memory"); \
      _Pragma("unroll") for(int d_=0;d_<2;++d_) _Pragma("unroll") for(int r=0;r<16;++r)o[d_][r]*=wsf[crow(r,hi)]; } }while(0)
  f32x16 pA0,pA1,pB0,pB1;
  int sl_prev=0,sl_cur=0,sl_next=SLOTB;
  #define ROT() do{sl_prev=sl_cur;sl_cur=sl_next;sl_next=(sl_next==(NSLOT-1)*SLOTB)?0:sl_next+SLOTB;}while(0)
  DMA_K(2,2*SLOTB);
  WAIT_BAR(3);
  qkt(pA0,pA1,Kbase,qr,negm,r32,hi);asm volatile("s_nop 15\n\ts_nop 7":"+v"(pA0),"+v"(pA1));CMASK(pA0,pA1,0);
  START(pA0,pA1);
  _Pragma("unroll") for(int r=0;r<16;++r)pA1[r]=__builtin_amdgcn_exp2f(pA1[r]);
  WAIT_BAR(0);
  DMA_K(3,0);DMA_V(1,SLOTB);
  ROT();
  kload8(kf,kp0+sl_cur);
  WAIT_BAR(2);
  s16x4 vlo[8],vhi[8]; u32x4 pw0,pw1,pw2,pw3;
  #define PKW(P,B) cvtpk_s(P[B],P[B+1])
  #define PAF(k) __builtin_bit_cast(bf16x8,pw##k)
  #define VFR(i) (bf16x8){vlo[i][0],vlo[i][1],vlo[i][2],vlo[i][3],vhi[i][0],vhi[i][1],vhi[i][2],vhi[i][3]}
  #define PIN(x) asm volatile("":"+v"(x))
  #define MX3(a,b,c) __builtin_fmaxf(__builtin_fmaxf((a),(b)),(c))
  #define GAPA(MF,A0,A1,A2,A3,W0,W1,PW) do{ MF; sacc+=A0; sacc+=A1; sacc+=A2; sacc+=A3; PIN(sacc); W0; W1; PIN(PW); SBAR(); }while(0)
  #define EX(v) __builtin_amdgcn_exp2f(v)
  #define GAPB(MF,X,B) do{ MF; X[B]=EX(X[B]); X[B+1]=EX(X[B+1]); X[B+2]=EX(X[B+2]); X[B+3]=EX(X[B+3]); PIN(X); SBAR(); }while(0)
  #define VRD(i) do{ vlo[i]=vtr(vp_+(((i)>>2)*4096+((i)&3)*1024)); vhi[i]=vtr(vp_+(((i)>>2)*4096+((i)&3)*1024+512)); }while(0)
  #define KRD(G,j) do{ if(G){ kload2(kf,kp0+sl_next,j); SBAR(); } }while(0)
  #define STEP(C0,C1,P0,P1,t,GK,GV,GL) do{ SBAR(); \
    const lds_cptr vp_=vp0+sl_prev; \
    VRD(0); SBAR(); float sacc=(P0[0]+P0[1]); \
    GAPA(C0=__builtin_amdgcn_mfma_f32_32x32x16_bf16(kf[0],qr[0],negm,0,0,0), P0[2],P0[3],P0[4],P0[5],     pw0[0]=PKW(P0,0), pw0[1]=PKW(P0,2), pw0); \
    VRD(4); SBAR(); GAPA(C1=__builtin_amdgcn_mfma_f32_32x32x16_bf16(kf[1],qr[0],negm,0,0,0), P0[6],P0[7],P0[8],P0[9],     pw0[2]=PKW(P0,4), pw0[3]=PKW(P0,6), pw0); \
    VRD(1); SBAR(); GAPA(C0=__builtin_amdgcn_mfma_f32_32x32x16_bf16(kf[2],qr[1],C0,0,0,0),   P0[10],P0[11],P0[12],P0[13], pw1[0]=PKW(P0,8), pw1[1]=PKW(P0,10), pw1); \
    VRD(5); SBAR(); GAPA(C1=__builtin_amdgcn_mfma_f32_32x32x16_bf16(kf[3],qr[1],C1,0,0,0),   P0[14],P0[15],P1[0],P1[1],   pw1[2]=PKW(P0,12),pw1[3]=PKW(P0,14), pw1); \
    VRD(2); SBAR(); GAPA(C0=__builtin_amdgcn_mfma_f32_32x32x16_bf16(kf[4],qr[2],C0,0,0,0),   P1[2],P1[3],P1[4],P1[5],     pw2[0]=PKW(P1,0), pw2[1]=PKW(P1,2), pw2); \
    VRD(6); SBAR(); GAPA(C1=__builtin_amdgcn_mfma_f32_32x32x16_bf16(kf[5],qr[2],C1,0,0,0),   P1[6],P1[7],P1[8],P1[9],     pw2[2]=PKW(P1,4), pw2[3]=PKW(P1,6), pw2); \
    VRD(3); SBAR(); GAPA(C0=__builtin_amdgcn_mfma_f32_32x32x16_bf16(kf[6],qr[3],C0,0,0,0),   P1[10],P1[11],P1[12],P1[13], pw3[0]=PKW(P1,8), pw3[1]=PKW(P1,10), pw3); \
    VRD(7); SBAR(); GAPA(C1=__builtin_amdgcn_mfma_f32_32x32x16_bf16(kf[7],qr[3],C1,0,0,0),   P1[14],P1[15],0.f,0.f,       pw3[2]=PKW(P1,12),pw3[3]=PKW(P1,14), pw3); \
    l_reg+=sacc; \
    if(GK){DMA_K((t)+3,sl_cur);} if(GV){DMA_V((t)+1,sl_next);} \
    CMASK(C0,C1,t); \
    { float a=MX3(C0[0],C0[1],C1[0]),b=MX3(C0[2],C0[3],C1[1]); a=MX3(a,C1[2],C1[3]); \
      _Pragma("unroll") for(int r=4;r<16;r+=4){a=MX3(a,C0[r],C0[r+1]);b=MX3(b,C0[r+2],C0[r+3]);a=MX3(a,C1[r],C1[r+1]);b=MX3(b,C1[r+2],C1[r+3]);} \
      float rm=__builtin_fmaxf(a,b); { auto rr=__builtin_amdgcn_permlane32_swap(__float_as_uint(rm),__float_as_uint(rm),false,false); rm=__builtin_fmaxf(__uint_as_float(rr[0]),__uint_as_float(rr[1])); } \
      resc=false; \
      if(__builtin_expect(__any(rm>(float)THRL),0)){ const float dl=__builtin_fmaxf(rm,0.f); mhat+=dl; \
        _Pragma("unroll") for(int r=0;r<16;++r){C0[r]-=dl;C1[r]-=dl;} \
        _Pragma("unroll") for(int r=0;r<16;++r)negm[r]=-mhat; asm volatile("":"+v"(negm)); \
        const float f=__builtin_amdgcn_exp2f(-dl); l_reg*=f; if(hi==0)wsf[r32]=f; resc=true; } } \
    SBAR(); \
    GAPB(o[0]=__builtin_amdgcn_mfma_f32_32x32x16_bf16(PAF(0),VFR(0),o[0],0,0,0), C0,0); \
    GAPB(o[1]=__builtin_amdgcn_mfma_f32_32x32x16_bf16(PAF(0),VFR(4),o[1],0,0,0), C0,4); \
    KRD(GL,0); GAPB(o[0]=__builtin_amdgcn_mfma_f32_32x32x16_bf16(PAF(1),VFR(1),o[0],0,0,0), C0,8); \
    KRD(GL,1); GAPB(o[1]=__builtin_amdgcn_mfma_f32_32x32x16_bf16(PAF(1),VFR(5),o[1],0,0,0), C0,12); \
    KRD(GL,2); GAPB(o[0]=__builtin_amdgcn_mfma_f32_32x32x16_bf16(PAF(2),VFR(2),o[0],0,0,0), C1,0); \
    KRD(GL,3); GAPB(o[1]=__builtin_amdgcn_mfma_f32_32x32x16_bf16(PAF(2),VFR(6),o[1],0,0,0), C1,4); \
    GAPB(o[0]=__builtin_amdgcn_mfma_f32_32x32x16_bf16(PAF(3),VFR(3),o[0],0,0,0), C1,8); \
    GAPB(o[1]=__builtin_amdgcn_mfma_f32_32x32x16_bf16(PAF(3),VFR(7),o[1],0,0,0), C1,12); \
    }while(0)
  int t=1;
  #undef CMASK
  #define CMASK(P0,P1,t) do{}while(0)
  for(;t+5<NT;t+=2){
    STEP(pB0,pB1,pA0,pA1,t,true,true,true);     WAIT_BAR(2); RESC(); ROT();
    STEP(pA0,pA1,pB0,pB1,t+1,true,true,true);   WAIT_BAR(2); RESC(); ROT();
  }
  #undef CMASK
  #define CMASK(P0,P1,t) do{}while(0)
  #define ENDW(tt) do{ if((tt)+3<NT){WAIT_BAR(2);} else if((tt)+2<NT){WAIT_BAR(1);} else {WAIT_BAR(0);} }while(0)
  for(;t+1<NT;t+=2){
    STEP(pB0,pB1,pA0,pA1,t,(t+3<NT),(t+1<NT),(t+1<NT));       ENDW(t);   RESC(); ROT();
    STEP(pA0,pA1,pB0,pB1,t+1,(t+4<NT),(t+2<NT),(t+2<NT));     ENDW(t+1); RESC(); ROT();
  }
  STEP(pB0,pB1,pA0,pA1,NT-1,false,false,false); RESC();
  { float sacc=pB0[0]+pB0[1]; _Pragma("unroll") for(int r=2;r<16;++r)sacc+=pB0[r]; _Pragma("unroll") for(int r=0;r<16;++r)sacc+=pB1[r]; l_reg+=sacc;
    pw0=(u32x4){PKW(pB0,0),PKW(pB0,2),PKW(pB0,4),PKW(pB0,6)};pw1=(u32x4){PKW(pB0,8),PKW(pB0,10),PKW(pB0,12),PKW(pB0,14)};pw2=(u32x4){PKW(pB1,0),PKW(pB1,2),PKW(pB1,4),PKW(pB1,6)};pw3=(u32x4){PKW(pB1,8),PKW(pB1,10),PKW(pB1,12),PKW(pB1,14)};
    SBAR(); pv(o,vb0+sl_cur,PAF(0),PAF(1),PAF(2),PAF(3)); }
  #undef PKW
  #undef PAF
  #undef VFR
  #undef PIN
  #undef MX3
  #undef GAPA
  #undef GAPB
  #undef EX
  #undef VRD
  #undef KRD
  #undef STEP
  #undef ENDW
  {auto rr=__builtin_amdgcn_permlane32_swap(__float_as_uint(l_reg),__float_as_uint(l_reg),false,false);l_reg=__uint_as_float(rr[0])+__uint_as_float(rr[1]);}
  if(hi==0)wsf[32+r32]=l_reg;asm volatile("s_waitcnt lgkmcnt(0)":::"memory");
  float rli[16];
  #pragma unroll
  for(int r=0;r<16;++r)rli[r]=__builtin_amdgcn_rcpf(wsf[32+crow(r,hi)]);
  bf16*Ow=Yo+(qrow0+wid*QBLK)*PO+h*D;
  { bf16*stg=(bf16*)(shm+LDS_OST)+wid*2048;
    #pragma unroll
    for(int r=0;r<16;++r){const int orow=crow(r,hi);
      #pragma unroll
      for(int d0=0;d0<2;++d0)stg[orow*64+d0*32+r32]=__float2bfloat16(o[d0][r]*rli[r]);}
    asm volatile("s_waitcnt lgkmcnt(0)":::"memory");
    #pragma unroll
    for(int i=0;i<4;++i){const int row=i*8+(lane>>3),ch=lane&7; const u32x4 v=*(const u32x4*)(stg+row*64+ch*8); ATTN_STORE16(Ow+(long)row*PO+ch*8,v);} }
  asm volatile("s_waitcnt lgkmcnt(0)\n\ts_barrier":::"memory");
  #undef DMA_K
  #undef DMA_V
  #undef CMASK
  #undef START
  #undef RESC
  #undef ROT
}
constexpr int ATTN_LDS_BYTES=LDS_BYTES;
#undef SBAR
#undef WAIT_BAR
}
#ifndef MK_FP8
#define MK_FP8 1
#endif
namespace mk {
constexpr int NB = 16, SQ = 4096, CL = 256, SEG = SQ + CL, T = NB * SEG, D = 1024, INW = 2048, NL = 4, NE = 32;
constexpr int NROWT = T / 256;
constexpr int MAXRT = 1120, CAP = MAXRT * 256;
constexpr int MODW = 6 * D;
constexpr float EPS = 1e-6f;
constexpr int NWAVES = 8;
constexpr int PPL = 12, NPHASE = 2 + NL * PPL;

constexpr size_t MiB = 1u << 20;
constexpr size_t WS_CTL = 0, CTL_ZERO_BYTES = 1 * MiB;
constexpr size_t WS_MOD = 4 * MiB;
constexpr size_t WS_B1P = 6 * MiB;
constexpr size_t WS_PAIR = 8 * MiB;
constexpr size_t WS_TOK = 12 * MiB;
constexpr size_t WS_LOG = 22 * MiB;
constexpr size_t WS_WINT = 32 * MiB;
constexpr size_t WS_WOUTT = 50 * MiB;
constexpr size_t WS_WRT = 60 * MiB;
constexpr size_t WS_W1T = 64 * MiB;
constexpr size_t WS_W2T = 576 * MiB;
constexpr size_t WS_X = 832 * MiB;
constexpr size_t WS_HB = 1104 * MiB;
constexpr size_t WS_P = 1240 * MiB;
constexpr size_t WS_Y = 1512 * MiB;
constexpr size_t WS_HP = 1648 * MiB;
constexpr size_t WS_ACT = 2208 * MiB;
constexpr size_t WS_YP = 2768 * MiB;
constexpr size_t WS_HB8 = 3328 * MiB;
constexpr size_t WS_END = 3400 * MiB;
static_assert(WS_MOD + (size_t)NL * 17 * MODW * 4 <= WS_B1P && WS_B1P + (size_t)NL * NE * 2048 * 4 <= WS_PAIR && WS_PAIR + (size_t)T * 32 <= WS_TOK && WS_TOK + (size_t)NE * T * 4 <= WS_LOG && WS_LOG + (size_t)T * 128 <= WS_WINT, "ws map 1");
static_assert(WS_WINT + (size_t)NL * 2048 * 1024 * 2 <= WS_WOUTT && WS_WOUTT + (size_t)NL * 1024 * 1024 * 2 <= WS_WRT && WS_WRT + (size_t)NL * 256 * 1024 * 2 <= WS_W1T && WS_W1T + (size_t)NL * NE * 2048 * 1024 * 2 <= WS_W2T && WS_W2T + (size_t)NL * NE * 1024 * 1024 * 2 <= WS_X, "ws map 2");
static_assert(WS_X + (size_t)T * 4096 <= WS_HB && WS_HB + (size_t)T * 2048 <= WS_P && WS_P + (size_t)T * 4096 <= WS_Y && WS_Y + (size_t)T * 2048 <= WS_HP && WS_HP + (size_t)CAP * 2048 <= WS_ACT && WS_ACT + (size_t)CAP * 2048 <= WS_YP && WS_YP + (size_t)CAP * 2048 <= WS_HB8 && WS_HB8 + (size_t)T * 1024 <= WS_END, "ws map 3");
constexpr int CW_BAR = 4096;
constexpr int CW_CNT = 65536;
constexpr int RING_BYTES = 131072;
constexpr int ROPE_OFF = RING_BYTES;
constexpr int T2E_OFF = ROPE_OFF + 8192;
constexpr int MISC_OFF = T2E_OFF + 2048;
constexpr int LDS_BYTES = 147456;
static_assert(MISC_OFF + 1024 <= LDS_BYTES, "LDS map");

#define GAS __attribute__((address_space(1)))
#define LAS __attribute__((address_space(3)))
typedef unsigned short bf16;
typedef unsigned v4u __attribute__((ext_vector_type(4)));
typedef unsigned v2u __attribute__((ext_vector_type(2)));
typedef float f32x4 __attribute__((ext_vector_type(4)));
typedef float f32x2 __attribute__((ext_vector_type(2)));
typedef GAS unsigned gu32;
#define RLX_AGENT __ATOMIC_RELAXED, __HIP_MEMORY_SCOPE_AGENT
#define LDS_WAIT() asm volatile("s_waitcnt lgkmcnt(0)" ::: "memory")
#define VM_WAIT() asm volatile("s_waitcnt vmcnt(0)" ::: "memory")
__device__ __forceinline__ unsigned f2bf(float f) { unsigned u = __builtin_bit_cast(unsigned, f); return (u + 0x7fffu + ((u >> 16) & 1u)) >> 16; }
__device__ __forceinline__ unsigned pk2(float lo, float hi) { return f2bf(lo) | (f2bf(hi) << 16); }
__device__ __forceinline__ float bflo(unsigned w) { return __builtin_bit_cast(float, w << 16); }
__device__ __forceinline__ float bfhi(unsigned w) { return __builtin_bit_cast(float, w & 0xffff0000u); }
__device__ __forceinline__ f32x4 bf4(v2u w) { return (f32x4){bflo(w.x), bfhi(w.x), bflo(w.y), bfhi(w.y)}; }
__device__ __forceinline__ v2u pk4(f32x4 v) { return (v2u){pk2(v.x, v.y), pk2(v.z, v.w)}; }
__device__ __forceinline__ float wave_sum(float v) {
#pragma unroll
    for (int o = 1; o < 64; o <<= 1) v += __shfl_xor(v, o);
    return v;
}
__device__ __forceinline__ float sum4(f32x4 v) { return (v.x + v.y) + (v.z + v.w); }
__device__ __forceinline__ float sigmoidf_(float z) { return __builtin_amdgcn_rcpf(1.0f + __builtin_amdgcn_exp2f(z * -1.4426950408889634f)); }
template <int I> __device__ __forceinline__ const float* ldin() { const GAS float* p;
    asm volatile("s_load_dwordx2 %0, %1, %2\n\ts_waitcnt lgkmcnt(0)" : "=s"(p) : "s"(__builtin_amdgcn_kernarg_segment_ptr()), "n"(I * 8) : "memory"); return (const float*)p; }
__device__ __forceinline__ float* ldout() { GAS float* p;
    asm volatile("s_load_dwordx2 %0, %1, %2\n\ts_waitcnt lgkmcnt(0)" : "=s"(p) : "s"(__builtin_amdgcn_kernarg_segment_ptr()), "n"(24 * 8) : "memory"); return (float*)p; }
#define XB_TMO      128
#define XB_XCNT(j)  (256  + 64 * (j))
#define XB_XSUB(j)  (1280 + 64 * (j))
#define XB_XGEN(j)  (2304 + 64 * (j))
#define XB_TOP      3328
#define XB_TOPGEN   3392
#define XCD_BAR_WORDS 3456
#define XB_SPIN_CAP (1u << 22)

__device__ __forceinline__ unsigned xb_ld(unsigned* p)              { return __hip_atomic_load(p, __ATOMIC_RELAXED, __HIP_MEMORY_SCOPE_AGENT); }
__device__ __forceinline__ unsigned xb_add(unsigned* p, unsigned v) { return __hip_atomic_fetch_add(p, v, __ATOMIC_RELAXED, __HIP_MEMORY_SCOPE_AGENT); }
__device__ __forceinline__ unsigned xb_xcc_id() { return (unsigned)__builtin_amdgcn_s_getreg((3 << 11) | 20) & 0xFu; }
#define XB_SPIN(cond, bar) do { unsigned _sp = 0; while (cond) { __builtin_amdgcn_s_sleep(1); \
    if ((++_sp & 255u) == 0u) { if (xb_ld(&(bar)[XB_TMO])) break; if (_sp > XB_SPIN_CAP) { atomicAdd(&(bar)[XB_TMO], 1u); break; } } } } while (0)

struct XcdBarrier {
    unsigned* bar; unsigned x;
    volatile LAS unsigned* st;
};

__device__ __forceinline__ XcdBarrier xcd_barrier_post(unsigned* bar, volatile LAS unsigned* st) {
    XcdBarrier b; b.bar = bar; b.x = xb_xcc_id(); b.st = st;
    if (threadIdx.x == 0) (void)xb_add(&bar[XB_XCNT(b.x)], 1u);
    return b;
}
__device__ __forceinline__ void xcd_barrier_complete(unsigned* bar, unsigned x, unsigned& nloc, unsigned& nx) {
    const unsigned G = gridDim.x * gridDim.y * gridDim.z;
    unsigned sum, cnt, mine, sp = 0u;
    for (;;) {
        sum = 0u; cnt = 0u; mine = 0u;
#pragma unroll
        for (unsigned j = 0; j < 16; ++j) { const unsigned c = xb_ld(&bar[XB_XCNT(j)]); sum += c; cnt += (c > 0u) ? 1u : 0u; mine = (j == x) ? c : mine; }
        if (sum == G) break;
        __builtin_amdgcn_s_sleep(1);
        if ((++sp & 255u) == 0u) { if (xb_ld(&bar[XB_TMO])) break; if (sp > XB_SPIN_CAP) { atomicAdd(&bar[XB_TMO], 1u); break; } }
    }
    nloc = mine > 0u ? mine : 1u; nx = cnt > 0u ? cnt : 1u;
}

__device__ __forceinline__ void xcd_barrier(const XcdBarrier& b) {
    asm volatile("s_waitcnt vmcnt(0)" ::: "memory");
    __syncthreads();
    if (threadIdx.x == 0) {
        unsigned* bar = b.bar;
        __builtin_amdgcn_s_waitcnt(0);
        unsigned nloc = b.st[0], nx = b.st[1];
        if (nloc == 0u) { xcd_barrier_complete(bar, b.x, nloc, nx); b.st[0] = nloc; b.st[1] = nx; }
        const unsigned old = xb_add(&bar[XB_XSUB(b.x)], 1u);
        const unsigned gen = old / nloc;
        if (old + 1u == (gen + 1u) * nloc) {
            __builtin_amdgcn_fence(__ATOMIC_RELEASE, "agent");
            asm volatile("s_waitcnt vmcnt(0)" ::: "memory");
            const unsigned og = xb_add(&bar[XB_TOP], 1u);
            const unsigned tg = og / nx;
            if (og + 1u == (tg + 1u) * nx) xb_add(&bar[XB_TOPGEN], 1u);
            else XB_SPIN(xb_ld(&bar[XB_TOPGEN]) == tg, bar);
            __builtin_amdgcn_fence(__ATOMIC_ACQUIRE, "agent");
            xb_add(&bar[XB_XGEN(b.x)], 1u);
            asm volatile("s_waitcnt vmcnt(0)" ::: "memory");
        } else {
            XB_SPIN(xb_ld(&bar[XB_XGEN(b.x)]) == gen, bar);
            __builtin_amdgcn_fence(__ATOMIC_ACQUIRE, "agent");
            asm volatile("s_waitcnt vmcnt(0)" ::: "memory");
        }
    }
    __syncthreads();
}

struct Ctx {
    LAS unsigned char* lds; volatile LAS unsigned* MISC; gu32* ctl;
    int tid, lane, wave, vcu, G, gw, ngw;
    GAS unsigned char* ws;
    __device__ __forceinline__ float* MOD() const { return (float*)(ws + WS_MOD); }
    __device__ __forceinline__ float* B1P() const { return (float*)(ws + WS_B1P); }
    __device__ __forceinline__ float* LOG() const { return (float*)(ws + WS_LOG); }
    __device__ __forceinline__ float* X() const { return (float*)(ws + WS_X); }
    __device__ __forceinline__ v2u* PAIR() const { return (v2u*)(ws + WS_PAIR); }
    __device__ __forceinline__ int* TOK() const { return (int*)(ws + WS_TOK); }
    __device__ __forceinline__ bf16* WINT() const { return (bf16*)(ws + WS_WINT); }
    __device__ __forceinline__ bf16* WOUTT() const { return (bf16*)(ws + WS_WOUTT); }
    __device__ __forceinline__ bf16* WRT() const { return (bf16*)(ws + WS_WRT); }
    __device__ __forceinline__ bf16* W1T() const { return (bf16*)(ws + WS_W1T); }
    __device__ __forceinline__ bf16* W2T() const { return (bf16*)(ws + WS_W2T); }
    __device__ __forceinline__ bf16* HB() const { return (bf16*)(ws + WS_HB); }
    __device__ __forceinline__ bf16* P() const { return (bf16*)(ws + WS_P); }
    __device__ __forceinline__ bf16* Y() const { return (bf16*)(ws + WS_Y); }
    __device__ __forceinline__ bf16* HP() const { return (bf16*)(ws + WS_HP); }
    __device__ __forceinline__ bf16* ACT() const { return (bf16*)(ws + WS_ACT); }
    __device__ __forceinline__ bf16* YP() const { return (bf16*)(ws + WS_YP); }
    __device__ __forceinline__ unsigned char* HB8() const { return (unsigned char*)(ws + WS_HB8); }
};
struct Args { const float* in[24]; float* out; unsigned char* ws; int ph_lo, ph_hi; };

__device__ __forceinline__ int w1_row(int n) { const int a = n >> 1; return ((a >> 7) << 8) + ((n & 1) << 7) + (a & 127); }
template <int MODE>
__device__ __forceinline__ void transpose_item(const float* W, int K, int N, bf16* WT, LAS float* scr, int item, int lane) {
    const int nblk = N / 32, kb = item / nblk, nb = item % nblk, k0 = 64 * kb, n0 = 32 * nb;
#pragma unroll
    for (int i = 0; i < 32; ++i) { const int kk = 2 * i + (lane >> 5); scr[kk * 33 + (lane & 31)] = W[(size_t)(k0 + kk) * N + n0 + (lane & 31)]; }
    LDS_WAIT(); asm volatile("" ::: "memory");
    const int c = lane & 7;
#pragma unroll
    for (int j = 0; j < 4; ++j) { const int n = (lane >> 3) + 8 * j; const LAS float* s = scr + (8 * c) * 33 + n;
        v4u o; o.x = pk2(s[0 * 33], s[1 * 33]); o.y = pk2(s[2 * 33], s[3 * 33]); o.z = pk2(s[4 * 33], s[5 * 33]); o.w = pk2(s[6 * 33], s[7 * 33]);
        const int orow = MODE == 1 ? w1_row(n0 + n) : (n0 + n);
        *(GAS v4u*)(WT + (size_t)orow * K + k0 + 8 * c) = o; }
    LDS_WAIT(); asm volatile("" ::: "memory");
}
template <int MODE>
__device__ __forceinline__ void transpose_item8(const float* W, int K, int N, unsigned char* WT, LAS float* scr, int item, int lane) {
    const int nblk = N / 32, kb = item / nblk, nb = item % nblk, k0 = 64 * kb, n0 = 32 * nb;
#pragma unroll
    for (int i = 0; i < 32; ++i) { const int kk = 2 * i + (lane >> 5); scr[kk * 33 + (lane & 31)] = W[(size_t)(k0 + kk) * N + n0 + (lane & 31)]; }
    LDS_WAIT(); asm volatile("" ::: "memory");
    const int n = lane >> 1, h = lane & 1; const LAS float* s = scr + (32 * h) * 33 + n;
    unsigned w[8];
#pragma unroll
    for (int q = 0; q < 8; ++q) { int p = __builtin_amdgcn_cvt_pk_fp8_f32(s[(4 * q) * 33] * 32.0f, s[(4 * q + 1) * 33] * 32.0f, 0, false); p = __builtin_amdgcn_cvt_pk_fp8_f32(s[(4 * q + 2) * 33] * 32.0f, s[(4 * q + 3) * 33] * 32.0f, p, true); w[q] = (unsigned)p; }
    const int orow = MODE == 1 ? w1_row(n0 + n) : (n0 + n);
    GAS v4u* dst = (GAS v4u*)(WT + (size_t)orow * K + k0 + 32 * h);
    dst[0] = (v4u){w[0], w[1], w[2], w[3]}; dst[1] = (v4u){w[4], w[5], w[6], w[7]};
    LDS_WAIT(); asm volatile("" ::: "memory");
}
__device__ __forceinline__ void phase_prologue(const Ctx& C, const Args& A) {
    {
        LAS float* sS = (LAS float*)C.lds;
        const float* cin = ldin<1>(); const float* cctx = ldin<3>(); const float* wada = ldin<4>(); const float* bada = ldin<5>();
        for (int i = C.tid; i < 17 * 1024; i += NWAVES * 64) { const int j = i >> 10, k = i & 1023; const float v = j < 16 ? cin[j * 1024 + k] : cctx[k]; sS[i] = v * sigmoidf_(v); }
        __syncthreads();
        const int kl = C.tid & 15, cg = C.tid >> 4;
        for (int item = blockIdx.x; item < NL * 48; item += C.G) {
            const int l = item / 48, c0 = (item % 48) * 128 + 4 * cg;
            const float* W = wada + (size_t)l * 1024 * MODW + c0;
            f32x4 acc[17];
#pragma unroll
            for (int j = 0; j < 17; ++j) acc[j] = (f32x4){0.f, 0.f, 0.f, 0.f};
            for (int k = kl; k < 1024; k += 16) { const f32x4 w = *(const f32x4*)(W + (size_t)k * MODW);
#pragma unroll
                for (int j = 0; j < 17; ++j) acc[j] += sS[j * 1024 + k] * w; }
#pragma unroll
            for (int j = 0; j < 17; ++j)
#pragma unroll
                for (int o = 1; o < 16; o <<= 1) { acc[j].x += __shfl_xor(acc[j].x, o); acc[j].y += __shfl_xor(acc[j].y, o); acc[j].z += __shfl_xor(acc[j].z, o); acc[j].w += __shfl_xor(acc[j].w, o); }
            if (kl == 0) { const f32x4 bv = *(const f32x4*)(bada + (size_t)l * MODW + c0);
#pragma unroll
                for (int j = 0; j < 17; ++j) *(f32x4*)(C.MOD() + ((size_t)l * 17 + j) * MODW + c0) = acc[j] + bv; }
        }
        __syncthreads();
    }
    {
        LAS float* scr = (LAS float*)(C.lds + C.wave * 16384);
        const float* w_in = ldin<8>(); const float* w_out = ldin<17>(); const float* w_r = ldin<18>(); const float* w_e1 = ldin<20>(); const float* w_e2 = ldin<22>(); const float* b_e1 = ldin<21>();
        constexpr int I_IN = 16 * 64, I_OUT = 16 * 32, I_E1 = 16 * 64, I_E2 = 16 * 32, I_R = 16;
        constexpr int PER_L = I_IN + I_OUT + NE * I_E1 + NE * I_E2 + I_R;
        for (int it = C.gw; it < NL * PER_L; it += C.ngw) {
            const int l = it / PER_L; int r = it - l * PER_L;
            if (r < I_IN) { transpose_item<0>(w_in + (size_t)l * 1024 * 2048, 1024, 2048, C.WINT() + (size_t)l * 2048 * 1024, scr, r, C.lane); continue; } r -= I_IN;
            if (r < I_OUT) { transpose_item<0>(w_out + (size_t)l * 1024 * 1024, 1024, 1024, C.WOUTT() + (size_t)l * 1024 * 1024, scr, r, C.lane); continue; } r -= I_OUT;
#if MK_FP8
            if (r < NE * I_E1) { const int e = r / I_E1; transpose_item8<1>(w_e1 + ((size_t)l * NE + e) * 1024 * 2048, 1024, 2048, (unsigned char*)C.W1T() + ((size_t)l * NE + e) * 2048 * 1024, scr, r % I_E1, C.lane); continue; } r -= NE * I_E1;
            if (r < NE * I_E2) { const int e = r / I_E2; transpose_item8<0>(w_e2 + ((size_t)l * NE + e) * 1024 * 1024, 1024, 1024, (unsigned char*)C.W2T() + ((size_t)l * NE + e) * 1024 * 1024, scr, r % I_E2, C.lane); continue; } r -= NE * I_E2;
#else
            if (r < NE * I_E1) { const int e = r / I_E1; transpose_item<1>(w_e1 + ((size_t)l * NE + e) * 1024 * 2048, 1024, 2048, C.W1T() + ((size_t)l * NE + e) * 2048 * 1024, scr, r % I_E1, C.lane); continue; } r -= NE * I_E1;
            if (r < NE * I_E2) { const int e = r / I_E2; transpose_item<0>(w_e2 + ((size_t)l * NE + e) * 1024 * 1024, 1024, 1024, C.W2T() + ((size_t)l * NE + e) * 1024 * 1024, scr, r % I_E2, C.lane); continue; } r -= NE * I_E2;
#endif
            transpose_item<0>(w_r + (size_t)l * 1024 * 32, 1024, 32, C.WRT() + (size_t)l * 256 * 1024, scr, r, C.lane);
        }
        for (int i = C.gw * 64 + C.lane; i < NL * NE * 2048; i += C.ngw * 64) { const int n = i & 2047; C.B1P()[(i & ~2047) + w1_row(n)] = b_e1[i]; }
    }
}

__device__ __forceinline__ void moe_tables(const Ctx& C, int l, bool with_t2e) {
    __syncthreads();
    if (C.tid < NE) C.MISC[40 + C.tid] = __hip_atomic_load(C.ctl + CW_CNT + (l * NE + C.tid) * 64, RLX_AGENT);
    __syncthreads();
    if (C.tid == 0) { unsigned s = 0;
#pragma unroll 1
        for (int e = 0; e < NE; ++e) { C.MISC[e] = s; s += (C.MISC[40 + e] + 255u) >> 8; } C.MISC[NE] = s; }
    __syncthreads();
    if (with_t2e) { LAS unsigned char* t2e = (LAS unsigned char*)(C.lds + T2E_OFF);
        for (int rt = C.tid; rt < MAXRT; rt += NWAVES * 64) { unsigned e = 0;
#pragma unroll 1
            for (int k = 1; k < NE; ++k) e += (C.MISC[k] <= (unsigned)rt) ? 1u : 0u;
            t2e[rt] = (unsigned char)e; }
        __syncthreads(); }
}

__device__ __forceinline__ void row_bt(int r, int& b, int& t, int& j) { b = r / SEG; t = r - b * SEG; j = t < SQ ? b : 16; }
__device__ __forceinline__ void wave_rows(const Ctx& C, int n, int& rbeg, int& rend) { const int rpw = (n + C.ngw - 1) / C.ngw; rbeg = C.gw * rpw; rend = rbeg + rpw < n ? rbeg + rpw : n; }
__device__ __forceinline__ void modulate2(const f32x4 (&v)[2][4], const f32x4 (&gv)[4], const float* const (&mj)[2], int sh_chunk, f32x4 (&h)[2][4], int lane) {
    f32x4 sh[2][4], sc[2][4]; float ss[2];
#pragma unroll
    for (int u = 0; u < 2; ++u) { ss[u] = 0.f;
#pragma unroll
        for (int jj = 0; jj < 4; ++jj) { const int c = 256 * jj + 4 * lane; sh[u][jj] = *(const f32x4*)(mj[u] + sh_chunk * D + c); sc[u][jj] = *(const f32x4*)(mj[u] + (sh_chunk + 1) * D + c); ss[u] += sum4(v[u][jj] * v[u][jj]); } }
#pragma unroll
    for (int o = 1; o < 64; o <<= 1) { ss[0] += __shfl_xor(ss[0], o); ss[1] += __shfl_xor(ss[1], o); }
#pragma unroll
    for (int u = 0; u < 2; ++u) { const float rs = __builtin_amdgcn_rsqf(ss[u] * (1.0f / D) + EPS);
#pragma unroll
        for (int jj = 0; jj < 4; ++jj) h[u][jj] = (v[u][jj] * rs) * gv[jj] * (1.0f + sc[u][jj]) + sh[u][jj]; }
}
__device__ __forceinline__ void moe_combine2(const Ctx& C, const int (&r)[2], f32x4 (&acc)[2][4]) {
    v2u pr[2][4];
#pragma unroll
    for (int u = 0; u < 2; ++u)
#pragma unroll
        for (int k = 0; k < 4; ++k) pr[u][k] = C.PAIR()[(size_t)r[u] * 4 + k];
    v2u y[2][4][4];
#pragma unroll
    for (int u = 0; u < 2; ++u)
#pragma unroll
        for (int k = 0; k < 4; ++k) { const unsigned px = pr[u][k].x; const unsigned e = px & 31u, pos = px >> 5;
            const bf16* yp = C.YP() + ((size_t)C.MISC[e] * 256 + pos) * D + 4 * C.lane;
#pragma unroll
            for (int jj = 0; jj < 4; ++jj) y[u][k][jj] = *(const GAS v2u*)(yp + 256 * jj); }
#pragma unroll
    for (int u = 0; u < 2; ++u) {
#pragma unroll
        for (int jj = 0; jj < 4; ++jj) acc[u][jj] = (f32x4){0.f, 0.f, 0.f, 0.f};
#pragma unroll
        for (int k = 0; k < 4; ++k) { const unsigned wb = pr[u][k].y; const float wt = __uint_as_float(wb);
#pragma unroll
            for (int jj = 0; jj < 4; ++jj) acc[u][jj] += wt * bf4(y[u][k][jj]); } }
}

__device__ __forceinline__ void phase_premix(const Ctx& C, const Args& A, int l) {
    if (l > 0) moe_tables(C, l - 1, false);
    const float* modl = C.MOD() + (size_t)l * 17 * MODW; const float* modp = C.MOD() + (size_t)(l > 0 ? l - 1 : 0) * 17 * MODW;
    const float* g = ldin<6>() + (size_t)l * D; const float* xin = ldin<0>(); const float* cxin = ldin<2>();
    f32x4 gv[4];
#pragma unroll
    for (int jj = 0; jj < 4; ++jj) gv[jj] = *(const f32x4*)(g + 256 * jj + 4 * C.lane);
    int rbeg, rend; wave_rows(C, T, rbeg, rend);
    for (int r0 = rbeg; r0 < rend; r0 += 2) {
        const int r[2] = {r0, r0 + 1 < rend ? r0 + 1 : r0};
        int b[2], t[2], j[2]; row_bt(r[0], b[0], t[0], j[0]); row_bt(r[1], b[1], t[1], j[1]);
        f32x4 v[2][4];
        if (l == 0) {
#pragma unroll
            for (int u = 0; u < 2; ++u) { const float* src = (t[u] < SQ ? xin + ((size_t)b[u] * SQ + t[u]) * D : cxin + ((size_t)b[u] * CL + (t[u] - SQ)) * D) + 4 * C.lane;
#pragma unroll
                for (int jj = 0; jj < 4; ++jj) v[u][jj] = *(const f32x4*)(src + 256 * jj); }
        } else { f32x4 gt[2][4];
#pragma unroll
            for (int u = 0; u < 2; ++u) { const float* xr = C.X() + (size_t)r[u] * D + 4 * C.lane; const float* gt2 = modp + (size_t)j[u] * MODW + 5 * D + 4 * C.lane;
#pragma unroll
                for (int jj = 0; jj < 4; ++jj) { v[u][jj] = *(const f32x4*)(xr + 256 * jj); gt[u][jj] = *(const f32x4*)(gt2 + 256 * jj); } }
            f32x4 acc[2][4]; moe_combine2(C, r, acc);
#pragma unroll
            for (int u = 0; u < 2; ++u)
#pragma unroll
                for (int jj = 0; jj < 4; ++jj) v[u][jj] += gt[u][jj] * acc[u][jj]; }
        const float* const mj[2] = {modl + (size_t)j[0] * MODW, modl + (size_t)j[1] * MODW};
        f32x4 h[2][4]; modulate2(v, gv, mj, 0, h, C.lane);
#pragma unroll
        for (int u = 0; u < 2; ++u) { float* xr = C.X() + (size_t)r[u] * D + 4 * C.lane; bf16* hr = C.HB() + (size_t)r[u] * D + 4 * C.lane;
#pragma unroll
            for (int jj = 0; jj < 4; ++jj) { *(f32x4*)(xr + 256 * jj) = v[u][jj]; *(GAS v2u*)(hr + 256 * jj) = pk4(h[u][jj]); } }
    }
}
__device__ __forceinline__ void phase_premoe(const Ctx& C, const Args& A, int l) {
    const float* modl = C.MOD() + (size_t)l * 17 * MODW; const float* g = ldin<7>() + (size_t)l * D;
    f32x4 gv[4];
#pragma unroll
    for (int jj = 0; jj < 4; ++jj) gv[jj] = *(const f32x4*)(g + 256 * jj + 4 * C.lane);
    int rbeg, rend; wave_rows(C, T, rbeg, rend);
    for (int r0 = rbeg; r0 < rend; r0 += 2) {
        const int r[2] = {r0, r0 + 1 < rend ? r0 + 1 : r0};
        int b[2], t[2], j[2]; row_bt(r[0], b[0], t[0], j[0]); row_bt(r[1], b[1], t[1], j[1]);
        f32x4 v[2][4];
#pragma unroll
        for (int u = 0; u < 2; ++u) { const float* xr = C.X() + (size_t)r[u] * D + 4 * C.lane;
#pragma unroll
            for (int jj = 0; jj < 4; ++jj) v[u][jj] = *(const f32x4*)(xr + 256 * jj); }
        const float* const mj[2] = {modl + (size_t)j[0] * MODW, modl + (size_t)j[1] * MODW};
        f32x4 h[2][4]; modulate2(v, gv, mj, 3, h, C.lane);
#pragma unroll
        for (int u = 0; u < 2; ++u) { bf16* hr = C.HB() + (size_t)r[u] * D + 4 * C.lane;
#pragma unroll
            for (int jj = 0; jj < 4; ++jj) { *(GAS v2u*)(hr + 256 * jj) = pk4(h[u][jj]);
#if MK_FP8
                int p = __builtin_amdgcn_cvt_pk_fp8_f32(h[u][jj].x, h[u][jj].y, 0, false); p = __builtin_amdgcn_cvt_pk_fp8_f32(h[u][jj].z, h[u][jj].w, p, true);
                *(GAS unsigned*)(C.HB8() + (size_t)r[u] * D + 256 * jj + 4 * C.lane) = (unsigned)p;
#endif
            } }
    }
}
__device__ __forceinline__ void phase_final(const Ctx& C, const Args& A) {
    moe_tables(C, NL - 1, false);
    const float* modp = C.MOD() + (size_t)(NL - 1) * 17 * MODW; float* outp = ldout();
    int qbeg, qend; wave_rows(C, NB * SQ, qbeg, qend);
    for (int q0 = qbeg; q0 < qend; q0 += 2) {
        const int q[2] = {q0, q0 + 1 < qend ? q0 + 1 : q0}; const int b[2] = {q[0] / SQ, q[1] / SQ}; const int r[2] = {b[0] * SEG + (q[0] - b[0] * SQ), b[1] * SEG + (q[1] - b[1] * SQ)};
        f32x4 v[2][4], gt[2][4];
#pragma unroll
        for (int u = 0; u < 2; ++u) { const float* xr = C.X() + (size_t)r[u] * D + 4 * C.lane; const float* gt2 = modp + (size_t)b[u] * MODW + 5 * D + 4 * C.lane;
#pragma unroll
            for (int jj = 0; jj < 4; ++jj) { v[u][jj] = *(const f32x4*)(xr + 256 * jj); gt[u][jj] = *(const f32x4*)(gt2 + 256 * jj); } }
        f32x4 acc[2][4]; moe_combine2(C, r, acc);
#pragma unroll
        for (int u = 0; u < 2; ++u) { float* o = outp + (size_t)q[u] * D + 4 * C.lane;
#pragma unroll
            for (int jj = 0; jj < 4; ++jj) *(f32x4*)(o + 256 * jj) = v[u][jj] + gt[u][jj] * acc[u][jj]; }
    }
}

__device__ __forceinline__ v4u qk_piece(v4u w, const float (&gain)[8], bool lat, int pos, int i0, bool first, float scale, const LAS f32x2* rope) {
    float f[8] = {bflo(w.x), bfhi(w.x), bflo(w.y), bfhi(w.y), bflo(w.z), bfhi(w.z), bflo(w.w), bfhi(w.w)};
    float ss = 0.f;
#pragma unroll
    for (int i = 0; i < 8; ++i) ss += f[i] * f[i];
    ss += __shfl_xor(ss, 1); ss += __shfl_xor(ss, 2); ss += __shfl_xor(ss, 4);
    const float rs = __builtin_amdgcn_rsqf(ss * (1.0f / 64.0f) + EPS);
    float o[8];
#pragma unroll
    for (int i = 0; i < 8; ++i) f[i] = f[i] * rs * gain[i];
#pragma unroll
    for (int i = 0; i < 8; ++i) { const float pv = __shfl_xor(f[i], 2); const f32x2 cs = rope[(pos & 63) * 16 + i0 + i];
        const float rot = first ? f[i] * cs.x - pv * cs.y : f[i] * cs.x + pv * cs.y;
        o[i] = (lat ? rot : f[i]) * scale; }
    v4u ow; ow.x = pk2(o[0], o[1]); ow.y = pk2(o[2], o[3]); ow.z = pk2(o[4], o[5]); ow.w = pk2(o[6], o[7]); return ow;
}
__device__ __forceinline__ void phase_qknorm(const Ctx& C, const Args& A, int l) {
    const LAS f32x2* rope = (const LAS f32x2*)(C.lds + ROPE_OFF);
    const float* gq = ldin<9>() + l * 64; const float* gk = ldin<10>() + l * 64;
    const int d0 = 8 * (C.lane & 7);
    const int ax = d0 >> 5, o0 = d0 & 31; const bool first = o0 < 16; const int i0 = o0 & 15;
    float gqv[8], gkv[8];
#pragma unroll
    for (int i = 0; i < 8; ++i) { gqv[i] = gq[d0 + i]; gkv[i] = gk[d0 + i]; }
    int rbeg, rend; wave_rows(C, T, rbeg, rend);
    for (int r0 = rbeg; r0 < rend; r0 += 4) {
        v4u wq[4]; bool ok[4]; int tt[4];
#pragma unroll
        for (int u = 0; u < 4; ++u) { ok[u] = r0 + u < rend; const int r = ok[u] ? r0 + u : r0; tt[u] = r % SEG; wq[u] = *(const GAS v4u*)(C.P() + (size_t)r * INW + 8 * C.lane); }
        const int uk = C.lane >> 4; const bool okk = r0 + uk < rend; const int rk = okk ? r0 + uk : r0; const int tk = rk % SEG;
        bf16* pk = C.P() + (size_t)rk * INW + 512 + 8 * (C.lane & 15);
        const v4u wk = *(const GAS v4u*)pk;
#pragma unroll
        for (int u = 0; u < 4; ++u) { const bool lat = tt[u] < SQ; const int pos = ax == 0 ? (tt[u] >> 6) : (tt[u] & 63);
            const v4u ow = qk_piece(wq[u], gqv, lat, pos, i0, first, attn_body::C2, rope);
            if (ok[u]) *(GAS v4u*)(C.P() + (size_t)(r0 + u) * INW + 8 * C.lane) = ow; }
        { const bool lat = tk < SQ; const int pos = ax == 0 ? (tk >> 6) : (tk & 63);
          const v4u ow = qk_piece(wk, gkv, lat, pos, i0, first, 1.0f, rope);
          if (okk) *(GAS v4u*)pk = ow; }
    }
}

__device__ __forceinline__ void phase_attn(const Ctx& C) {
    char* shm = (char*)C.lds;
    const attn_body::bf16* Pq = (const attn_body::bf16*)C.P(); attn_body::bf16* Yo = (attn_body::bf16*)C.Y();
    const int nlat = NB * 8 * 16;
    const int per = (nlat + C.G - 1) / C.G;
    for (int i = 0; i < per; ++i) { const int u = C.vcu * per + i; if (u >= nlat) break;
        const int qb = u & 15, h = (u >> 4) & 7, b = u >> 7;
        attn_body::attn_unit<8>((long)b * SEG + qb * 256, (long)b * SEG, SEG / 64, h, Pq, Yo, shm); }
    for (int u = C.vcu; u < NB * 8; u += C.G) { const int h = u & 7, b = u >> 3;
        attn_body::attn_unit<8>((long)b * SEG + SQ, (long)b * SEG + SQ, CL / 64, h, Pq, Yo, shm); }
}

__device__ __forceinline__ void phase_conv(const Ctx& C, const Args& A, int l) {
    LAS float* zL = (LAS float*)C.lds;
    const int c4 = 4 * C.lane;
    f32x4 wk[31]; const float* wdw = ldin<11>();
#pragma unroll
    for (int jt = 0; jt < 31; ++jt) wk[jt] = *(const f32x4*)(wdw + ((size_t)l * 31 + jt) * 256 + c4);
    const f32x4 b31 = *(const f32x4*)(ldin<12>() + l * 256 + c4), gln = *(const f32x4*)(ldin<13>() + l * 256 + c4), bln = *(const f32x4*)(ldin<14>() + l * 256 + c4);
    const float* wsc = ldin<15>() + (size_t)l * 3 * 256 + c4; const f32x4 w30 = *(const f32x4*)(wsc), w31 = *(const f32x4*)(wsc + 256), w32 = *(const f32x4*)(wsc + 512);
    const float* gg = ldin<16>() + (size_t)l * D;
    const f32x4 gA0 = *(const f32x4*)(gg + 8 * C.lane), gA1 = *(const f32x4*)(gg + 8 * C.lane + 4), gC = *(const f32x4*)(gg + 512 + c4), gS = *(const f32x4*)(gg + 768 + c4);
    for (int tile = C.vcu; tile < T / 64; tile += C.G) {
        const int b = tile / 68, tt = tile - b * 68, t0 = tt * 64;
        const int seg_lo = tt < 64 ? 0 : SQ, seg_hi = tt < 64 ? SQ : SEG;
        const size_t rbase = (size_t)b * SEG;
        __syncthreads();
        for (int zr = C.wave; zr < 94; zr += NWAVES) { const int t = t0 - 15 + zr; f32x4 z = (f32x4){0.f, 0.f, 0.f, 0.f};
            if (t >= seg_lo && t < seg_hi) { const bf16* p = C.P() + (rbase + t) * INW; const f32x4 a = bf4(*(const GAS v2u*)(p + 768 + c4)), gt = bf4(*(const GAS v2u*)(p + 1024 + c4));
                z = (f32x4){a.x * sigmoidf_(gt.x), a.y * sigmoidf_(gt.y), a.z * sigmoidf_(gt.z), a.w * sigmoidf_(gt.w)}; }
            *(LAS f32x4*)(zL + zr * 256 + c4) = z; }
        __syncthreads();
        for (int i = C.wave; i < 64; i += NWAVES) { const int t = t0 + i; const size_t r = rbase + t;
            f32x4 u = b31;
#pragma unroll
            for (int jt = 0; jt < 31; ++jt) u += wk[jt] * *(const LAS f32x4*)(zL + (i + jt) * 256 + c4);
            const float mean = wave_sum(sum4(u)) * (1.0f / 256.0f); const f32x4 d = u - mean;
            const float var = wave_sum(sum4(d * d)) * (1.0f / 256.0f); const f32x4 y = d * __builtin_amdgcn_rsqf(var + EPS) * gln + bln;
            const f32x4 cf = (f32x4){y.x * sigmoidf_(y.x), y.y * sigmoidf_(y.y), y.z * sigmoidf_(y.z), y.w * sigmoidf_(y.w)};
            const float rsc = __builtin_amdgcn_rsqf(wave_sum(sum4(cf * cf)) * (1.0f / 256.0f) + EPS);
            bf16* yr = C.Y() + r * D;
            *(GAS v2u*)(yr + 512 + c4) = pk4(cf * rsc * gC);
            const bf16* p = C.P() + r * INW; f32x4 m0 = (f32x4){0.f, 0.f, 0.f, 0.f}, m2 = m0;
            const f32x4 m1 = bf4(*(const GAS v2u*)(p + 1536 + c4)) * bf4(*(const GAS v2u*)(p + 1792 + c4));
            if (t - 1 >= seg_lo) m0 = bf4(*(const GAS v2u*)(p - INW + 1536 + c4)) * bf4(*(const GAS v2u*)(p - INW + 1792 + c4));
            if (t + 1 < seg_hi) m2 = bf4(*(const GAS v2u*)(p + INW + 1536 + c4)) * bf4(*(const GAS v2u*)(p + INW + 1792 + c4));
            const f32x4 sv = bf4(*(const GAS v2u*)(p + 1280 + c4)) * (w30 * m0 + w31 * m1 + w32 * m2);
            const float rss = __builtin_amdgcn_rsqf(wave_sum(sum4(sv * sv)) * (1.0f / 256.0f) + EPS);
            *(GAS v2u*)(yr + 768 + c4) = pk4(sv * rss * gS);
            const v4u aw = *(const GAS v4u*)(yr + 8 * C.lane);
            const f32x4 a0 = bf4((v2u){aw.x, aw.y}), a1 = bf4((v2u){aw.z, aw.w});
            const float rsa = __builtin_amdgcn_rsqf(wave_sum(sum4(a0 * a0) + sum4(a1 * a1)) * (1.0f / 512.0f) + EPS);
            const v2u o0 = pk4(a0 * rsa * gA0), o1 = pk4(a1 * rsa * gA1);
            *(GAS v4u*)(yr + 8 * C.lane) = (v4u){o0.x, o0.y, o1.x, o1.y};
        }
    }
    __syncthreads();
}

__device__ __forceinline__ void phase_route(const Ctx& C, const Args& A, int l) {
    volatile LAS unsigned* lhist = C.MISC + 80; volatile LAS unsigned* lbase = C.MISC + 112;
    const float br = C.lane < NE ? ldin<19>()[l * NE + C.lane] : 0.f;
    gu32* cnt = C.ctl + CW_CNT + (size_t)l * NE * 64;
    for (int tile = C.vcu; tile < T / 64; tile += C.G) {
        __syncthreads();
        if (C.tid < NE) lhist[C.tid] = 0u;
        __syncthreads();
        unsigned pe[8], pp[8];
#pragma unroll
        for (int i = 0; i < 8; ++i) { const int r = tile * 64 + C.wave * 8 + i;
            float v = C.lane < NE ? C.LOG()[(size_t)r * NE + C.lane] + br : -INFINITY;
            float sv[4]; int se[4];
#pragma unroll
            for (int k = 0; k < 4; ++k) { float m = v; int mi = C.lane;
#pragma unroll
                for (int o = 1; o < 64; o <<= 1) { const float ov = __shfl_xor(m, o); const int oi = __shfl_xor(mi, o); if (ov > m || (ov == m && oi < mi)) { m = ov; mi = oi; } }
                sv[k] = m; se[k] = mi; if (C.lane == mi) v = -INFINITY; }
            const float e1 = __expf(sv[1] - sv[0]), e2 = __expf(sv[2] - sv[0]), e3 = __expf(sv[3] - sv[0]); const float inv = __builtin_amdgcn_rcpf(1.0f + e1 + e2 + e3);
            const int kk = C.lane & 3;
            pe[i] = (unsigned)(kk == 0 ? se[0] : kk == 1 ? se[1] : kk == 2 ? se[2] : se[3]);
            const float pwi = (kk == 0 ? 1.0f : kk == 1 ? e1 : kk == 2 ? e2 : e3) * inv;
            pp[i] = 0u;
            if (C.lane < 4) { pp[i] = __hip_atomic_fetch_add((LAS unsigned*)(C.lds + MISC_OFF) + 80 + pe[i], 1u, __ATOMIC_RELAXED, __HIP_MEMORY_SCOPE_WORKGROUP);
                ((GAS float*)C.PAIR())[((size_t)r * 4 + C.lane) * 2 + 1] = pwi; } }
        __syncthreads();
        if (C.tid < NE) { const unsigned n = lhist[C.tid]; lbase[C.tid] = n ? __hip_atomic_fetch_add(cnt + C.tid * 64, n, RLX_AGENT) : 0u; }
        __syncthreads();
        if (C.lane < 4) {
#pragma unroll
            for (int i = 0; i < 8; ++i) { const int r = tile * 64 + C.wave * 8 + i; const unsigned pos = lbase[pe[i]] + pp[i];
                ((GAS unsigned*)C.PAIR())[((size_t)r * 4 + C.lane) * 2] = pe[i] | (pos << 5);
                C.TOK()[(size_t)pe[i] * T + pos] = r; } }
    }
    __syncthreads();
}

__device__ __forceinline__ void phase_gather(const Ctx& C, const Args& A, int l) {
    moe_tables(C, l, true);
    const LAS unsigned char* t2e = (const LAS unsigned char*)(C.lds + T2E_OFF);
    const int nslot = (int)C.MISC[NE] * 256;
    constexpr int RB = MK_FP8 ? 1024 : 2048, NV = RB / 1024;
    const unsigned char* srcb = MK_FP8 ? (const unsigned char*)C.HB8() : (const unsigned char*)C.HB();
    unsigned char* dstb = (unsigned char*)C.HP();
    for (int s0 = C.gw * 16; s0 < nslot; s0 += C.ngw * 16) { const unsigned e = t2e[s0 >> 8]; const unsigned pos0 = (unsigned)s0 - C.MISC[e] * 256u; const unsigned cnt = C.MISC[40 + e];
        int tk = -1; if (C.lane < 16 && pos0 + C.lane < cnt) tk = C.TOK()[(size_t)e * T + pos0 + C.lane];
        v4u v[16][NV];
#pragma unroll
        for (int u = 0; u < 16; ++u) { const int r = __builtin_amdgcn_readlane(tk, u);
            if (r >= 0) { const GAS v4u* src = (const GAS v4u*)(srcb + (size_t)r * RB) + C.lane;
#pragma unroll
                for (int q = 0; q < NV; ++q) v[u][q] = src[64 * q]; } }
#pragma unroll
        for (int u = 0; u < 16; ++u) { const int r = __builtin_amdgcn_readlane(tk, u);
            if (r >= 0) { GAS v4u* dst = (GAS v4u*)(dstb + (size_t)(s0 + u) * RB) + C.lane;
#pragma unroll
                for (int q = 0; q < NV; ++q) dst[64 * q] = v[u][q]; } }
    }
}

__global__ void __launch_bounds__(NWAVES * 64, 2) mk_fwd(Args args) {
    extern __shared__ __attribute__((aligned(16))) unsigned char lds_raw[];
    Ctx C;
    C.lds = (LAS unsigned char*)lds_raw; C.MISC = (volatile LAS unsigned*)(C.lds + MISC_OFF);
    C.tid = threadIdx.x; C.lane = C.tid & 63; C.wave = __builtin_amdgcn_readfirstlane(C.tid >> 6);
    C.G = gridDim.x; { const int bx = blockIdx.x; C.vcu = (C.G % 8 == 0) ? (bx % 8) * (C.G / 8) + bx / 8 : bx; }
    C.gw = C.vcu * NWAVES + C.wave; C.ngw = C.G * NWAVES;
    C.ws = (GAS unsigned char*)args.ws; C.ctl = (gu32*)(C.ws + WS_CTL);
    for (int u = C.tid; u < (LDS_BYTES - MISC_OFF) / 4; u += NWAVES * 64) ((LAS unsigned*)(C.lds + MISC_OFF))[u] = 0u;
    for (int u = C.tid; u < 64 * 16; u += NWAVES * 64) { const int pos = u >> 4, i = u & 15; const float inv = powf(10000.0f, -(float)(2 * i) / 32.0f); const float ang = (float)pos * inv;
        ((LAS f32x2*)(C.lds + ROPE_OFF))[u] = (f32x2){cosf(ang), sinf(ang)}; }
    __syncthreads();
    const int lo = args.ph_lo, hi = args.ph_hi;
    const bool multi = (hi - lo) > 1;
    XcdBarrier bar; bar.bar = (unsigned*)(C.ctl + CW_BAR); bar.x = 0; bar.st = C.MISC + 160;
    if (multi) bar = xcd_barrier_post((unsigned*)(C.ctl + CW_BAR), C.MISC + 160);
#ifndef MK_PHMASK
#define MK_PHMASK 0xFFFF
#endif
#define IN(k) (lo <= (k) && (k) < hi)
#define FRESH() do { asm volatile("" : "+v"(C.tid), "+v"(C.lane)); asm volatile("" : "+s"(C.wave), "+s"(C.vcu), "+s"(C.gw), "+s"(C.ws), "+s"(C.ctl)); } while (0)
#define EN(k) ((MK_PHMASK >> (k)) & 1)
#ifndef MK_DUP
#define MK_DUP 0
#endif
#define NREP(k) (((MK_DUP >> (k)) & 1) ? 2 : 1)
#define SEAM(k) do { if (IN((k) + 1)) xcd_barrier(bar); } while (0)

    if (EN(12) && IN(0)) { phase_prologue(C, args); SEAM(0); }
    for (int l = 0; l < NL; ++l) {
        const int pb = 1 + l * PPL;
        if (EN(0) && IN(pb + 0)) { FRESH(); phase_premix(C, args, l); SEAM(pb + 0); }
        if (EN(1) && IN(pb + 1)) { FRESH();
            pg8::Gemm g{C.HB(), C.WINT() + (size_t)l * INW * D, T, INW, D}; pg8::StaticOrder S; S.init(T, INW, C.G, (int)blockIdx.x);
            pg8::EpiStore E{C.P(), INW};
_Pragma("unroll") for (int rep = 0; rep < NREP(1); ++rep)
            pg8::gemm_phase<pg8::EpiStore, pg8::StaticOrder, true, true>(C.lds, g, S, E);
            SEAM(pb + 1); }
        if (EN(2) && IN(pb + 2)) { FRESH(); phase_qknorm(C, args, l); SEAM(pb + 2); }
        if (EN(3) && IN(pb + 3)) { FRESH(); _Pragma("unroll") for (int rep = 0; rep < NREP(3); ++rep) phase_attn(C); SEAM(pb + 3); }
        if (EN(4) && IN(pb + 4)) { FRESH(); phase_conv(C, args, l); SEAM(pb + 4); }
        if (EN(5) && IN(pb + 5)) { FRESH();
            pg8::Gemm g{C.Y(), C.WOUTT() + (size_t)l * D * D, T, D, D}; pg8::StaticOrder S; S.init(T, D, C.G, (int)blockIdx.x);
            pg8::EpiResid E{C.X(), C.MOD() + (size_t)l * 17 * MODW + 2 * D};
            pg8::gemm_phase<pg8::EpiResid, pg8::StaticOrder, true, true>(C.lds, g, S, E);
            SEAM(pb + 5); }
        if (EN(6) && IN(pb + 6)) { FRESH(); phase_premoe(C, args, l); SEAM(pb + 6); }
        if (EN(7) && IN(pb + 7)) { FRESH();
            pg8::Gemm g{C.HB(), C.WRT() + (size_t)l * 256 * D, T, 256, D}; pg8::StaticOrder S; S.init(T, 256, C.G, (int)blockIdx.x);
            pg8::EpiLogits E{C.LOG()};
_Pragma("unroll") for (int rep = 0; rep < NREP(7); ++rep)
            pg8::gemm_phase<pg8::EpiLogits, pg8::StaticOrder, true, true>(C.lds, g, S, E);
            SEAM(pb + 7); }
        if (EN(8) && IN(pb + 8)) { FRESH(); phase_route(C, args, l); SEAM(pb + 8); }
        if (EN(9) && IN(pb + 9)) { FRESH(); _Pragma("unroll") for (int rep = 0; rep < NREP(9); ++rep) phase_gather(C, args, l); SEAM(pb + 9); }
        if (EN(10) && IN(pb + 10)) { FRESH();
            moe_tables(C, l, true);
#if MK_FP8
            pg8::Gemm g{C.HP(), (const pg8::bf16_t*)((const unsigned char*)C.W1T() + (size_t)l * NE * 2048 * D), CAP, NE * 2048, D / 2};
            pg8::MoeOrder S; S.init((int)C.MISC[NE], 8, C.G, (int)blockIdx.x, (const LAS unsigned char*)(C.lds + T2E_OFF));
            pg8::EpiSwiglu8 E{(unsigned char*)C.ACT(), C.B1P() + (size_t)l * NE * 2048};
_Pragma("unroll") for (int rep = 0; rep < NREP(10); ++rep)
            pg8::gemm_phase<pg8::EpiSwiglu8, pg8::MoeOrder, true, true, true>(C.lds, g, S, E);
#else
            pg8::Gemm g{C.HP(), C.W1T() + (size_t)l * NE * 2048 * D, CAP, NE * 2048, D};
            pg8::MoeOrder S; S.init((int)C.MISC[NE], 8, C.G, (int)blockIdx.x, (const LAS unsigned char*)(C.lds + T2E_OFF));
            pg8::EpiSwiglu E{C.ACT(), C.B1P() + (size_t)l * NE * 2048};
            pg8::gemm_phase<pg8::EpiSwiglu, pg8::MoeOrder, true, true>(C.lds, g, S, E);
#endif
            SEAM(pb + 10); }
        if (EN(11) && IN(pb + 11)) { FRESH();
            moe_tables(C, l, true);
#if MK_FP8
            pg8::Gemm g{C.ACT(), (const pg8::bf16_t*)((const unsigned char*)C.W2T() + (size_t)l * NE * D * D), CAP, NE * D, D / 2};
            pg8::MoeOrder S; S.init((int)C.MISC[NE], 4, C.G, (int)blockIdx.x, (const LAS unsigned char*)(C.lds + T2E_OFF));
            pg8::EpiDown E{C.YP(), ldin<23>() + (size_t)l * NE * D};
_Pragma("unroll") for (int rep = 0; rep < NREP(11); ++rep)
            pg8::gemm_phase<pg8::EpiDown, pg8::MoeOrder, true, true, true>(C.lds, g, S, E);
#else
            pg8::Gemm g{C.ACT(), C.W2T() + (size_t)l * NE * D * D, CAP, NE * D, D};
            pg8::MoeOrder S; S.init((int)C.MISC[NE], 4, C.G, (int)blockIdx.x, (const LAS unsigned char*)(C.lds + T2E_OFF));
            pg8::EpiDown E{C.YP(), ldin<23>() + (size_t)l * NE * D};
            pg8::gemm_phase<pg8::EpiDown, pg8::MoeOrder, true, true>(C.lds, g, S, E);
#endif
            SEAM(pb + 11); }
    }
    if (EN(13) && IN(NPHASE - 1)) { FRESH(); phase_final(C, args); }
#undef IN
#undef SEAM
}
}


#if defined(MK_DEBUG)
namespace mkdbg {
using namespace mk;
constexpr size_t WS_DBG = 3420 * MiB;
__device__ const int SROWS[12] = {0, 1, 63, 64, 255, 256, 4095, 4096, 4351, 4352, 30000, 69631};
__device__ __forceinline__ float bfv(const bf16* p, size_t i) { return __builtin_bit_cast(float, (unsigned)p[i] << 16); }
__device__ __forceinline__ void report(float* err, int s, float got, float ref, float atol) {
    float e = fabsf(got - ref) / (fabsf(ref) + atol); if (!(e == e)) e = 100.f;
    atomicMax((unsigned*)err + s, __builtin_bit_cast(unsigned, e));
}
__device__ __forceinline__ void row_info(int r, int& b, int& t, int& j) { b = r / SEG; t = r - b * SEG; j = t < SQ ? b : 16; }
__device__ __forceinline__ float silu_(float v) { return v / (1.f + expf(-v)); }
__device__ __forceinline__ float sigm_(float v) { return 1.f / (1.f + expf(-v)); }
__device__ __forceinline__ void naive_attn(const bf16* P, int r, int h, float* q, float* o) {
    int b, t, j; row_info(r, b, t, j);
    const int k0 = t < SQ ? b * SEG : b * SEG + SQ, nk = t < SQ ? SEG : CL;
    for (int d = 0; d < 64; ++d) q[d] = bfv(P, (size_t)r * INW + h * 64 + d);
    float m = -1e30f;
    for (int kk = 0; kk < nk; ++kk) { float s = 0.f; for (int d = 0; d < 64; ++d) s += q[d] * bfv(P, (size_t)(k0 + kk) * INW + 512 + (h >> 2) * 64 + d); m = fmaxf(m, s); }
    float l = 0.f; for (int d = 0; d < 64; ++d) o[d] = 0.f;
    for (int kk = 0; kk < nk; ++kk) { float s = 0.f; for (int d = 0; d < 64; ++d) s += q[d] * bfv(P, (size_t)(k0 + kk) * INW + 512 + (h >> 2) * 64 + d);
        const float p = exp2f(s - m); l += p; for (int d = 0; d < 64; ++d) o[d] += p * bfv(P, (size_t)(k0 + kk) * INW + 640 + (h >> 2) * 64 + d); }
    for (int d = 0; d < 64; ++d) o[d] /= l;
}
__device__ const int DBG_LS_1[2] = {0, 3};
__device__ const int DBG_JS_2[3] = {0, 7, 16};
__device__ const int DBG_NS_3[4] = {0, 1000, 2053, 6143};
__device__ const int DBG_CS_4[4] = {0, 1, 511, 1023};
__device__ const int DBG_CS_5[16] = {0, 63, 64, 511, 512, 575, 639, 640, 767, 768, 1024, 1279, 1280, 1536, 1792, 2047};
__device__ const int DBG_HS_6[4] = {0, 7, 8, 9};
__device__ const int DBG_HS_7[2] = {0, 5};
__device__ const int DBG_CS_8[4] = {0, 255, 256, 1023};
__device__ const int DBG_ES_9[3] = {0, 7, 31};
__device__ const int DBG_CS_10[3] = {0, 500, 1023};
__device__ const int DBG_CS_11[4] = {0, 127, 128, 1023};
__device__ const int DBG_CS_12[4] = {0, 300, 511, 1023};
__device__ const int DBG_CS_13[4] = {0, 300, 511, 1023};
__device__ const int DBG_CS_14[4] = {0, 300, 511, 1023};
__global__ void __launch_bounds__(256) dbg_kernel(Args a, int stage) {
    unsigned char* ws = a.ws; float* err = (float*)(ws + WS_DBG); float* scr = err + 256;
    const float* MOD = (const float*)(ws + WS_MOD); const bf16* HB = (const bf16*)(ws + WS_HB); const bf16* P = (const bf16*)(ws + WS_P); const bf16* Y = (const bf16*)(ws + WS_Y);
    const float* X = (const float*)(ws + WS_X); const float* LOG = (const float*)(ws + WS_LOG); const v2u* PAIR = (const v2u*)(ws + WS_PAIR); const int* TOK = (const int*)(ws + WS_TOK);
    const bf16* HP = (const bf16*)(ws + WS_HP); const bf16* ACT = (const bf16*)(ws + WS_ACT); const bf16* YP = (const bf16*)(ws + WS_YP);
    const unsigned* cnt = (const unsigned*)(ws + WS_CTL) + CW_CNT;
    const int tid = threadIdx.x;
    __shared__ float shm[15360]; __shared__ unsigned tstart[33];
    if (stage == 0) { if (tid < 64) err[tid] = 0.f; return; }
    if (stage == 1) {
        const int* ls = DBG_LS_1; const int* js = DBG_JS_2; const int* ns = DBG_NS_3;
        if (tid < 24) { const int l = ls[tid / 12], j = js[(tid / 4) % 3], n = ns[tid % 4]; float s = 0.f;
            for (int k = 0; k < 1024; ++k) { const float c = j < 16 ? a.in[1][j * 1024 + k] : a.in[3][k]; s += silu_(c) * a.in[4][((size_t)l * 1024 + k) * MODW + n]; }
            s += a.in[5][l * MODW + n]; report(err, 1, MOD[((size_t)l * 17 + j) * MODW + n], s, 0.05f); }
        return; }
    if (stage == 2 || stage == 8) {
        const int* cs = DBG_CS_4;
        if (tid < 48) { const int r = SROWS[tid / 4], c = cs[tid % 4]; int b, t, j; row_info(r, b, t, j);
            const float* xr = stage == 2 ? (t < SQ ? a.in[0] + ((size_t)b * SQ + t) * D : a.in[2] + ((size_t)b * CL + (t - SQ)) * D) : X + (size_t)r * D;
            float ss = 0.f; for (int k = 0; k < D; ++k) ss += xr[k] * xr[k];
            const float rs = 1.f / sqrtf(ss / D + EPS); const float* g = stage == 2 ? a.in[6] : a.in[7]; const float* mj = MOD + (size_t)j * MODW + (stage == 2 ? 0 : 3 * D);
            const float h = xr[c] * rs * g[c] * (1.f + mj[D + c]) + mj[c];
            report(err, stage, bfv(HB, (size_t)r * D + c), h, 0.05f);
            if (stage == 2) report(err, stage, X[(size_t)r * D + c], xr[c], 0.01f); }
        return; }
    if (stage == 3) {
        const int* cs = DBG_CS_5;
        if (tid < 192) { const int r = SROWS[tid / 16], c = cs[tid % 16]; float s = 0.f;
            for (int k = 0; k < D; ++k) s += bfv(HB, (size_t)r * D + k) * a.in[8][(size_t)k * INW + c];
            report(err, 3, bfv(P, (size_t)r * INW + c), s, 0.05f); }
        return; }
    if (stage == 4) {
        const int* hs = DBG_HS_6;
        if (tid < 48) { const int r = SROWS[tid / 4], h = hs[tid % 4]; int b, t, j; row_info(r, b, t, j);
            float* raw = shm + tid * 128; float* o = raw + 64; float ss = 0.f;
            for (int d = 0; d < 64; ++d) { float s = 0.f; for (int k = 0; k < D; ++k) s += bfv(HB, (size_t)r * D + k) * a.in[8][(size_t)k * INW + h * 64 + d]; raw[d] = s; ss += s * s; }
            const float rs = 1.f / sqrtf(ss / 64.f + EPS); const float* g = h < 8 ? a.in[9] : a.in[10];
            for (int d = 0; d < 64; ++d) raw[d] = raw[d] * rs * g[d];
            for (int ax = 0; ax < 2; ++ax) for (int i = 0; i < 16; ++i) { const float pos = ax == 0 ? (float)(t / 64) : (float)(t % 64); const float ang = pos * powf(10000.f, -(float)(2 * i) / 32.f);
                const float c = t < SQ ? cosf(ang) : 1.f, s = t < SQ ? sinf(ang) : 0.f; const float x1 = raw[ax * 32 + i], x2 = raw[ax * 32 + 16 + i];
                o[ax * 32 + i] = x1 * c - x2 * s; o[ax * 32 + 16 + i] = x2 * c + x1 * s; }
            for (int d = 0; d < 64; ++d) { const float ref = o[d] * (h < 8 ? 0.125f * 1.4426950408889634f : 1.f); report(err, 4, bfv(P, (size_t)r * INW + h * 64 + d), ref, h < 8 ? 0.045f : 0.25f); } }
        return; }
    if (stage == 5) {
        const int* hs = DBG_HS_7;
        if (tid < 24) { const int r = SROWS[tid / 2], h = hs[tid % 2]; float* o = shm + tid * 128; naive_attn(P, r, h, o + 64, o);
            for (int d = 0; d < 64; ++d) report(err, 5, bfv(Y, (size_t)r * D + h * 64 + d), o[d], 0.05f); }
        return; }
    if (stage == 6) {
        if (tid < 12) { const int r = SROWS[tid]; int b, t, j; row_info(r, b, t, j); const int lo = t < SQ ? 0 : SQ, hi = t < SQ ? SQ : SEG; const size_t rb = (size_t)b * SEG;
            float* u = shm + tid * 256; float mean = 0.f;
            for (int c = 0; c < 256; ++c) { float s = a.in[12][c];
                for (int jt = 0; jt < 31; ++jt) { const int tt = t + jt - 15; if (tt >= lo && tt < hi) s += a.in[11][jt * 256 + c] * bfv(P, (rb + tt) * INW + 768 + c) * sigm_(bfv(P, (rb + tt) * INW + 1024 + c)); }
                u[c] = s; mean += s; }
            mean /= 256.f; float var = 0.f; for (int c = 0; c < 256; ++c) var += (u[c] - mean) * (u[c] - mean); var /= 256.f;
            float ss = 0.f; for (int c = 0; c < 256; ++c) { const float y = (u[c] - mean) / sqrtf(var + EPS) * a.in[13][c] + a.in[14][c]; u[c] = silu_(y); ss += u[c] * u[c]; }
            float rs = 1.f / sqrtf(ss / 256.f + EPS);
            for (int c = 0; c < 256; ++c) report(err, 6, bfv(Y, (size_t)r * D + 512 + c), u[c] * rs * a.in[16][512 + c], 0.25f);
            ss = 0.f;
            for (int c = 0; c < 256; ++c) { float s = 0.f; for (int jt = 0; jt < 3; ++jt) { const int tt = t + jt - 1; if (tt >= lo && tt < hi) s += a.in[15][jt * 256 + c] * bfv(P, (rb + tt) * INW + 1536 + c) * bfv(P, (rb + tt) * INW + 1792 + c); }
                u[c] = bfv(P, (size_t)r * INW + 1280 + c) * s; ss += u[c] * u[c]; }
            rs = 1.f / sqrtf(ss / 256.f + EPS);
            for (int c = 0; c < 256; ++c) report(err, 7, bfv(Y, (size_t)r * D + 768 + c), u[c] * rs * a.in[16][768 + c], 0.25f); }
        if (tid >= 64 && tid < 80) { const int r = SROWS[(tid - 64) / 8 == 0 ? 2 : 7], h = (tid - 64) % 8; float* o = shm + 3072 + (tid - 64) * 128; naive_attn(P, r, h, o + 64, o);
            for (int d = 0; d < 64; ++d) scr[((tid - 64) / 8) * 512 + h * 64 + d] = o[d]; }
        __syncthreads();
        if (tid < 2) { const int r = SROWS[tid == 0 ? 2 : 7]; float ss = 0.f; for (int c = 0; c < 512; ++c) ss += scr[tid * 512 + c] * scr[tid * 512 + c];
            const float rs = 1.f / sqrtf(ss / 512.f + EPS); for (int c = 0; c < 512; ++c) report(err, 6, bfv(Y, (size_t)r * D + c), scr[tid * 512 + c] * rs * a.in[16][c], 0.25f); }
        return; }
    if (stage == 9) {
        const int* cs = DBG_CS_8;
        if (tid < 48) { const int r = SROWS[tid / 4], c = cs[tid % 4]; int b, t, j; row_info(r, b, t, j);
            const float* xr = t < SQ ? a.in[0] + ((size_t)b * SQ + t) * D : a.in[2] + ((size_t)b * CL + (t - SQ)) * D;
            float s = 0.f; for (int k = 0; k < D; ++k) s += bfv(Y, (size_t)r * D + k) * a.in[17][(size_t)k * D + c];
            report(err, 9, X[(size_t)r * D + c], xr[c] + MOD[(size_t)j * MODW + 2 * D + c] * s, 0.05f); }
        return; }
    if (stage == 10) {
        const int* es = DBG_ES_9;
        if (tid < 36) { const int r = SROWS[tid / 3], e = es[tid % 3]; float s = 0.f; for (int k = 0; k < D; ++k) s += bfv(HB, (size_t)r * D + k) * a.in[18][(size_t)k * NE + e];
            report(err, 10, LOG[(size_t)r * NE + e], s, 0.05f); }
        return; }
    if (stage == 11) {
        if (tid < 12) { const int r = SROWS[tid]; float* v = shm + tid * 32; for (int e = 0; e < 32; ++e) v[e] = LOG[(size_t)r * NE + e] + a.in[19][e];
            float* sv = shm + 1024 + tid * 8; float* sef = sv + 4;
            for (int k = 0; k < 4; ++k) { int bi = 0; for (int e = 1; e < 32; ++e) if (v[e] > v[bi]) bi = e; sef[k] = (float)bi; sv[k] = v[bi]; v[bi] = -1e30f; }
            float den = 0.f; for (int k = 0; k < 4; ++k) den += expf(sv[k] - sv[0]);
            { float* vv = shm + 2048 + tid * 32; for (int e = 0; e < 32; ++e) vv[e] = LOG[(size_t)r * NE + e] + a.in[19][e];
              float mx = -1e30f, dn = 0.f; for (int k = 0; k < 4; ++k) mx = fmaxf(mx, vv[PAIR[(size_t)r * 4 + k].x & 31]); for (int k = 0; k < 4; ++k) dn += expf(vv[PAIR[(size_t)r * 4 + k].x & 31] - mx);
              for (int k = 0; k < 4; ++k) report(err, 22, __uint_as_float((unsigned)(PAIR[(size_t)r * 4 + k].y + 0u)), expf(vv[PAIR[(size_t)r * 4 + k].x & 31] - mx) / dn, 0.01f); }
            for (int k = 0; k < 4; ++k) { const v2u pr = PAIR[(size_t)r * 4 + k]; const int e = pr.x & 31; const unsigned pos = pr.x >> 5;
                if (tid == 0 && (k == 0 || k == 3)) { err[30 + (k ? 2 : 0)] = __uint_as_float((unsigned)(pr.y + 0u)); err[31 + (k ? 2 : 0)] = expf(sv[k] - sv[0]) / den; }
                report(err, 17, (float)e == sef[k] ? 0.f : 1.f, 0.f, 1.0f); report(err, 18, __uint_as_float((unsigned)(pr.y + 0u)), expf(sv[k] - sv[0]) / den, 0.01f);
                const unsigned c = cnt[e * 64]; report(err, 19, pos < c ? 1.f : 0.f, 1.f, 0.001f); report(err, 20, (float)TOK[(size_t)e * T + (pos < (unsigned)T ? pos : 0)], (float)r, 0.001f); } }
        if (tid == 255) { unsigned s = 0; for (int e = 0; e < 32; ++e) s += cnt[e * 64]; report(err, 21, (float)s, (float)(T * 4), 0.001f); }
        if (tid == 253) { int c = 0; const float* pf = (const float*)PAIR; for (int q = 0; q < 64; ++q) { const float w = pf[q * 2 + 1]; if (w > 0.01f && w <= 1.f) ++c; } err[44] = (float)c; }
        if (tid == 254) { for (int k = 0; k < 4; ++k) { const float w = __uint_as_float((unsigned)(PAIR[k].y + 0u)); err[40 + k] = (float)(!(w == w) || w < 0.f || w > 1.f ? 3 : w < 1e-30f ? 0 : w < 0.05f ? 1 : 2); } }
        return; }
    if (tid == 0) { unsigned s = 0; for (int e = 0; e < 32; ++e) { tstart[e] = s; s += (cnt[e * 64] + 255u) >> 8; } tstart[32] = s; }
    __syncthreads();
    if (stage == 12) {
        const int* cs = DBG_CS_10;
        if (tid < 48) { const int r = SROWS[tid / 4], k = tid % 4; const v2u pr = PAIR[(size_t)r * 4 + k]; const size_t slot = (size_t)tstart[pr.x & 31] * 256 + (pr.x >> 5);
            for (int i = 0; i < 3; ++i) report(err, 12, bfv(HP, slot * D + cs[i]), bfv(HB, (size_t)r * D + cs[i]), 0.001f); }
        return; }
    if (stage == 13) {
        const int* cs = DBG_CS_11;
        if (tid < 192) { const int r = SROWS[tid / 16], k = (tid / 4) % 4, c = cs[tid % 4]; const v2u pr = PAIR[(size_t)r * 4 + k]; const int e = pr.x & 31; const size_t slot = (size_t)tstart[e] * 256 + (pr.x >> 5);
            float ug = a.in[21][(size_t)e * 2048 + 2 * c], uu = a.in[21][(size_t)e * 2048 + 2 * c + 1]; const float* w = a.in[20] + (size_t)e * 1024 * 2048;
            for (int kk = 0; kk < D; ++kk) { const float hv = bfv(HP, slot * D + kk); ug += hv * w[(size_t)kk * 2048 + 2 * c]; uu += hv * w[(size_t)kk * 2048 + 2 * c + 1]; }
            const float gc = fminf(ug, 7.f), uc = fminf(fmaxf(uu, -7.f), 7.f); const float ref = (uc + 1.f) * gc * sigm_(1.702f * gc);
            report(err, 13, bfv(ACT, slot * D + c), ref, 0.25f); }
        return; }
    if (stage == 14) {
        const int* cs = DBG_CS_12;
        if (tid < 192) { const int r = SROWS[tid / 16], k = (tid / 4) % 4, c = cs[tid % 4]; const v2u pr = PAIR[(size_t)r * 4 + k]; const int e = pr.x & 31; const size_t slot = (size_t)tstart[e] * 256 + (pr.x >> 5);
            float s = a.in[23][(size_t)e * 1024 + c]; const float* w = a.in[22] + (size_t)e * 1024 * 1024;
            for (int kk = 0; kk < D; ++kk) s += bfv(ACT, slot * D + kk) * w[(size_t)kk * 1024 + c];
            report(err, 14, bfv(YP, slot * D + c), s, 0.25f); }
        return; }
    if (stage == 15) {
        const int* cs = DBG_CS_13;
        if (tid < 48) { const int r = SROWS[tid / 4], c = cs[tid % 4]; int b, t, j; row_info(r, b, t, j); float f = 0.f;
            for (int k = 0; k < 4; ++k) { const v2u pr = PAIR[(size_t)r * 4 + k]; const size_t slot = (size_t)tstart[pr.x & 31] * 256 + (pr.x >> 5); f += __uint_as_float((unsigned)(pr.y + 0u)) * bfv(YP, slot * D + c); }
            scr[2048 + tid] = X[(size_t)r * D + c] + MOD[(size_t)j * MODW + 5 * D + c] * f; }
        return; }
    if (stage == 16) {
        const int* cs = DBG_CS_14;
        if (tid < 48) { const int r = SROWS[tid / 4], c = cs[tid % 4]; report(err, 16, X[(size_t)r * D + c], scr[2048 + tid], 0.02f); }
        return; }
    if (stage == 99) {
        if (tid == 0) {
#if MK_DEBUG == 3
            a.out[0] = (err[44] + 1.f) * 1e20f; return;
#endif
#if MK_DEBUG == 2
            { const float* db = err + 4096; const v2u* PR = (const v2u*)(a.ws + WS_PAIR); int code = 0;
              auto close = [](float x, float y) { return fabsf(x - y) <= 1e-3f * (fabsf(y) + 1e-3f); };
              for (int ln = 0; ln < 4 && !code; ++ln) for (int j = 0; j < 4; ++j) if (!(db[ln * 16 + j] == db[j])) { code = 10 + ln; break; }
              if (!code) for (int j = 0; j < 3; ++j) if (!(db[j] >= db[j + 1])) code = 20 + j;
              if (!code) for (int ln = 0; ln < 4 && !code; ++ln) for (int j = 0; j < 3; ++j) if (!close(db[ln * 16 + 4 + j], expf(db[j + 1] - db[0]))) { code = 30 + ln; break; }
              if (!code) for (int ln = 0; ln < 4; ++ln) if (!close(db[ln * 16 + 7], 1.f + db[ln * 16 + 4] + db[ln * 16 + 5] + db[ln * 16 + 6])) { code = 40 + ln; break; }
              if (!code) for (int ln = 0; ln < 4; ++ln) if (!close(db[ln * 16 + 8], 1.f / db[ln * 16 + 7])) { code = 50 + ln; break; }
              if (!code) for (int ln = 0; ln < 4; ++ln) if (!close(db[ln * 16 + 9], (ln == 0 ? 1.f : db[ln * 16 + 3 + ln]) * db[ln * 16 + 8])) { code = 60 + ln; break; }
              if (!code) for (int ln = 0; ln < 4; ++ln) if (!close(__uint_as_float((unsigned)(PR[ln].y + 0u)), db[ln * 16 + 9])) { code = 70 + ln; break; }
              if (!code) code = 88;
              a.out[0] = (float)code * 1e20f; return; }
#endif
            int mask = 0; for (int i = 0; i < 6; ++i) if (err[17 + i] > 0.06f) mask |= 1 << i; if (mask) err[11] = 1.f;
            for (int s = 1; s < 17; ++s) if (err[s] > 0.06f) { if (s == 11) { a.out[0] = (float)(10 + mask) * 1e14f; break; } a.out[0] = (1.f + 10.f * fminf(err[s], 0.89f)) * powf(10.f, (float)(4 + s)); break; } }
        return; }
}
}
#endif
#ifndef MK_ONE_LAUNCH
#define MK_ONE_LAUNCH 1
#endif
extern "C" void kernel_launch(void* const* d_in, const int* in_sizes, int n_in, void* d_out, int out_size, void* d_ws, size_t ws_size, hipStream_t stream) {
    using namespace mk;
    static int grid = 0;
    if (grid == 0) {
        if (n_in != 24 || out_size != NB * SQ * D || ws_size < WS_END) { fprintf(stderr, "kernel_launch: unexpected shapes (n_in %d, out %d, ws %zu)\n", n_in, out_size, ws_size); grid = -1; return; }
        int dev = 0, cus = 0, per_cu = 0;
        if (hipGetDevice(&dev) != hipSuccess || hipDeviceGetAttribute(&cus, hipDeviceAttributeMultiprocessorCount, dev) != hipSuccess) { grid = -1; return; }
        if (hipFuncSetAttribute((const void*)mk_fwd, hipFuncAttributeMaxDynamicSharedMemorySize, LDS_BYTES) != hipSuccess) { fprintf(stderr, "kernel_launch: hipFuncSetAttribute failed\n"); grid = -1; return; }
        if (hipOccupancyMaxActiveBlocksPerMultiprocessor(&per_cu, (const void*)mk_fwd, NWAVES * 64, LDS_BYTES) != hipSuccess || per_cu < 1) { fprintf(stderr, "kernel_launch: occupancy query says %d\n", per_cu); per_cu = 1; }
        (void)hipGetLastError();
        grid = cus;
    }
    if (grid < 0) return;
    (void)hipMemsetAsync((char*)d_ws + WS_CTL, 0, CTL_ZERO_BYTES, stream);
    Args a{};
    for (int i = 0; i < 24; ++i) a.in[i] = (const float*)d_in[i];
    a.out = (float*)d_out; a.ws = (unsigned char*)d_ws;
#if MK_ONE_LAUNCH
    a.ph_lo = 0; a.ph_hi = NPHASE;
    hipLaunchKernelGGL(mk_fwd, dim3(grid), dim3(NWAVES * 64), LDS_BYTES, stream, a);
#else
#if defined(MK_DEBUG)
#define DBG(s) hipLaunchKernelGGL(mkdbg::dbg_kernel, dim3(1), dim3(256), 0, stream, a, (s))
    DBG(0);
#else
#define DBG(s) do {} while (0)
#endif
    for (int p = 0; p < NPHASE; ++p) { a.ph_lo = p; a.ph_hi = p + 1; hipLaunchKernelGGL(mk_fwd, dim3(grid), dim3(NWAVES * 64), LDS_BYTES, stream, a);
        if (p == 0) DBG(1); if (p == 1) DBG(2); if (p == 2) DBG(3); if (p == 3) DBG(4); if (p == 4) DBG(5); if (p == 5) DBG(6); if (p == 6) DBG(9); if (p == 7) DBG(8); if (p == 8) DBG(10);
        if (p == 9) DBG(11); if (p == 10) DBG(12); if (p == 11) DBG(13); if (p == 12) { DBG(14); DBG(15); } if (p == 13) DBG(16); }
    DBG(99);
#endif
}
```

```cpp
#include <hip/hip_runtime.h>
#include <hip/hip_bf16.h>
#include <cstdio>
#include <cstdint>
#include <cmath>
namespace pg8 {
#define PG8_LAS __attribute__((address_space(3)))
typedef unsigned short bf16_t;
typedef short bf16x8 __attribute__((ext_vector_type(8)));
typedef float f32x4 __attribute__((ext_vector_type(4)));
typedef unsigned u32x4 __attribute__((ext_vector_type(4)));
typedef int i32x4 __attribute__((ext_vector_type(4)));
typedef int i32x8 __attribute__((ext_vector_type(8)));
typedef unsigned u32x2 __attribute__((ext_vector_type(2)));
constexpr int PG8_BIAS_OFF = 144384;
constexpr int PG8_IDX_OFF = PG8_BIAS_OFF + 2048;
constexpr int BM = 256, BK = 64, HALF = 128, HTB = HALF * BK * 2  , STAGE_BYTES = 8 * HTB, NXCD = 8, WGM = 8;

__host__ __device__ __forceinline__ int lds_byte(int r, int c) { const int st = (r >> 4) * 2 + (c >> 5), rr = r & 15, cc = c & 31, ob = rr * 64 + cc * 2; return st * 1024 + (ob ^ (((ob >> 9) & 1) << 5)); }
__host__ __device__ __forceinline__ void stage_rc(int b, int& R, int& C) { const int st = b / 1024, sb = b % 1024, swz = sb ^ (((sb >> 9) & 1) << 5); R = (st >> 1) * 16 + swz / 64; C = (st & 1) * 32 + (swz % 64) / 2; }
__host__ __device__ __forceinline__ int perm32(int rho) { const int n = rho >> 4, i = rho & 15; return 8 * (i >> 2) + 4 * n + (i & 3); }

__device__ __forceinline__ int shx(int v, int o) { int l = __builtin_amdgcn_mbcnt_hi(-1, __builtin_amdgcn_mbcnt_lo(-1, 0)); asm volatile("" : "+v"(l)); return __builtin_amdgcn_ds_bpermute((l ^ o) << 2, v); }
__device__ __forceinline__ float shx(float v, int o) { return __int_as_float(shx(__float_as_int(v), o)); }
template <int CTRL> __device__ __forceinline__ float dpp_f(float v) { return __int_as_float(__builtin_amdgcn_update_dpp(0, __float_as_int(v), CTRL, 0xF, 0xF, true)); }
__device__ __forceinline__ float sum_x16(float v) { const auto r = __builtin_amdgcn_permlane16_swap(__float_as_uint(v), __float_as_uint(v), false, false); return __uint_as_float(r[0]) + __uint_as_float(r[1]); }
__device__ __forceinline__ float sum_x32(float v) { const auto r = __builtin_amdgcn_permlane32_swap(__float_as_uint(v), __float_as_uint(v), false, false); return __uint_as_float(r[0]) + __uint_as_float(r[1]); }
__device__ __forceinline__ float get_x32(float v, bool lo_half) { const auto r = __builtin_amdgcn_permlane32_swap(__float_as_uint(v), __float_as_uint(v), false, false); return __uint_as_float(lo_half ? r[1] : r[0]); }
__device__ __forceinline__ float get_x16(float v, bool even_row) { const auto r = __builtin_amdgcn_permlane16_swap(__float_as_uint(v), __float_as_uint(v), false, false); return __uint_as_float(even_row ? r[1] : r[0]); }
__device__ __forceinline__ float wsum(float v) { v += dpp_f<0xB1>(v); v += dpp_f<0x4E>(v); v += dpp_f<0x141>(v); v += dpp_f<0x140>(v); v = sum_x16(v); return sum_x32(v); }
struct Unit { int pm, pn; };
struct Gemm { const bf16_t* A; const bf16_t* Bt; int M, N, K; };

struct StaticOrder {
    int nM, nN, nwg, G, c;
    __host__ __device__ void init(int M, int N, int G_, int c_) { nM = M / BM; nN = N / BM; nwg = nM * nN; G = G_; c = c_; }
    __host__ __device__ bool next(int i, Unit& u) const {
        const long L = (long)i * G + c; if (L >= nwg) return false;
        int wgid = (int)L; { const int q = nwg / NXCD, r = nwg % NXCD, xcd = wgid % NXCD, off = wgid / NXCD; wgid = (xcd < r ? xcd * (q + 1) : r * (q + 1) + (xcd - r) * q) + off; }
        const int nig = WGM * nN, gid = wgid / nig, fm = gid * WGM, gsz = (nM - fm) < WGM ? (nM - fm) : WGM;
        u.pm = fm + ((wgid % nig) % gsz); u.pn = (wgid % nig) / gsz; return true;
    }
    __device__ __forceinline__ void a_ready(const Unit&) const {}
    __device__ __forceinline__ void done(const Unit&) const {}
};

struct LatentOrder : StaticOrder {
    __host__ __device__ bool next(int i, Unit& u) const { if (!StaticOrder::next(i, u)) return false; u.pm += u.pm >> 4; return true; }
};

__device__ __forceinline__ unsigned cvt_pk_bf16(float lo, float hi) { unsigned r; asm volatile("v_cvt_pk_bf16_f32 %0, %1, %2" : "=v"(r) : "v"(lo), "v"(hi)); return r; }
typedef float f32x2 __attribute__((ext_vector_type(2)));

struct MoeOrder {
    int nN, ntl, nwg, G, c; const PG8_LAS unsigned char* t2e; bool rev = false;
    const int* tok; int tstride; const volatile PG8_LAS unsigned* tab;
    __device__ __forceinline__ const int* idx_src(const Unit& u) const { const int e = u.pn / nN; return tok + (size_t)e * tstride + (size_t)(u.pm - (int)tab[e]) * 256; }
    __device__ __forceinline__ int nvalid(const Unit& u) const { const int e = u.pn / nN; return (int)tab[40 + e] - (u.pm - (int)tab[e]) * 256; }
    __device__ __forceinline__ void init(int ntl_, int nN_, int G_, int c_, const PG8_LAS unsigned char* t2e_) { ntl = ntl_; nN = nN_; nwg = ntl_ * nN_; G = G_; c = c_; t2e = t2e_; }
    __device__ __forceinline__ bool next(int i, Unit& u) const {
        const long L = (long)i * G + c; if (L >= nwg) return false;
        int wgid = (int)L; { const int q = nwg / NXCD, r = nwg % NXCD, xcd = wgid % NXCD; int off = wgid / NXCD; if (rev) off = (xcd < r ? q : q - 1) - off;
            wgid = (xcd < r ? xcd * (q + 1) : r * (q + 1) + (xcd - r) * q) + off; }
        const int nig = WGM * nN, gid = wgid / nig, fm = gid * WGM, gsz = (ntl - fm) < WGM ? (ntl - fm) : WGM;
        const int rt = fm + ((wgid % nig) % gsz), pn = (wgid % nig) / gsz;
        u.pm = rt; u.pn = (int)t2e[rt] * nN + pn; return true;
    }
    __device__ __forceinline__ void a_ready(const Unit&) const {}
    __device__ __forceinline__ void done(const Unit&) const {}
};

struct EpiStore {
    static constexpr bool PERM = true, AFTER_DRAIN = false, HAS_INIT = false;
    bf16_t* O; int ldc;
    __device__ __forceinline__ void operator()(const f32x4 (&acc)[2][2][4][2], const Unit& u, int wr, int wc, int fr, int fq) const {
        const int row0 = u.pm * BM + wr * 64 + fr, col0 = u.pn * BM + wc * 32 + 8 * fq;
#pragma unroll
        for (int ai = 0; ai < 2; ++ai)
#pragma unroll
            for (int m = 0; m < 4; ++m) { bf16_t* rowp = O + (size_t)(row0 + ai * HALF + m * 16) * ldc + col0;
#pragma unroll
                for (int bj = 0; bj < 2; ++bj) { const f32x4 v0 = acc[ai][bj][m][0], v1 = acc[ai][bj][m][1];
                    u32x4 w; w.x = cvt_pk_bf16(v0[0], v0[1]); w.y = cvt_pk_bf16(v0[2], v0[3]); w.z = cvt_pk_bf16(v1[0], v1[1]); w.w = cvt_pk_bf16(v1[2], v1[3]);
                    *(u32x4*)(rowp + bj * HALF) = w; } }
    }
};
struct EpiResid {
    static constexpr bool PERM = false, AFTER_DRAIN = false, HAS_INIT = false;
    float* X; const float* gate;
    __device__ __forceinline__ void operator()(const f32x4 (&acc)[2][2][4][2], const Unit& u, int wr, int wc, int fr, int fq) const {
        const int seg = u.pm / 17, rem = u.pm - seg * 17; const int j = (rem == 16) ? 16 : seg;
        const int row0 = u.pm * BM + wr * 64 + fr, col0 = u.pn * BM + wc * 32 + 4 * fq;
        const float* g = gate + (size_t)j * 6144 + col0;
        f32x4 gv[2][2];
#pragma unroll
        for (int bj = 0; bj < 2; ++bj)
#pragma unroll
            for (int n = 0; n < 2; ++n) gv[bj][n] = *(const f32x4*)(g + bj * HALF + n * 16);
#pragma unroll
        for (int ai = 0; ai < 2; ++ai)
#pragma unroll
            for (int m = 0; m < 4; ++m) { float* rowp = X + (size_t)(row0 + ai * HALF + m * 16) * 1024 + col0;
#pragma unroll
                for (int bj = 0; bj < 2; ++bj)
#pragma unroll
                    for (int n = 0; n < 2; ++n) { f32x4* p = (f32x4*)(rowp + bj * HALF + n * 16); *p = *p + gv[bj][n] * acc[ai][bj][m][n]; } }
    }
};
struct EpiInProj {
    static constexpr bool PERM = true, AFTER_DRAIN = false, HAS_INIT = false;
    bf16_t* P; const PG8_LAS float* rope; const PG8_LAS float* gqk; float c2; int pn0;
    __device__ __forceinline__ void operator()(const f32x4 (&acc)[2][2][4][2], const Unit& u, int wr, int wc, int fr, int fq) const {
        const int pnt = u.pn + pn0; const int row0 = u.pm * BM + wr * 64 + fr, col0 = pnt * BM + 64 * wc + 8 * fq;
        const bool isq = pnt < 2, isk = pnt == 2 && wc < 2;
        if (!(isq || isk)) {
#pragma unroll
            for (int ai = 0; ai < 2; ++ai)
#pragma unroll
                for (int m = 0; m < 4; ++m) { bf16_t* rowp = P + (size_t)(row0 + ai * HALF + m * 16) * 2048 + col0;
#pragma unroll
                    for (int bj = 0; bj < 2; ++bj) { const f32x4 v0 = acc[ai][bj][m][0], v1 = acc[ai][bj][m][1];
                        u32x4 w; w.x = cvt_pk_bf16(v0[0], v0[1]); w.y = cvt_pk_bf16(v0[2], v0[3]); w.z = cvt_pk_bf16(v1[0], v1[1]); w.w = cvt_pk_bf16(v1[2], v1[3]);
                        *(u32x4*)(rowp + 32 * bj) = w; } }
            return; }
        const PG8_LAS float* gp = gqk + (isq ? 0 : 64) + 8 * fq; const float sc = isq ? c2 : 1.0f;
        f32x4 gn[2][2];
#pragma unroll
        for (int bj = 0; bj < 2; ++bj)
#pragma unroll
            for (int n = 0; n < 2; ++n) gn[bj][n] = *(const PG8_LAS f32x4*)(gp + 32 * bj + 4 * n);
        const int seg = u.pm / 17, rem = u.pm - seg * 17; const bool lat = rem != 16;
        const bool first = fq < 2; const int i0 = 8 * (fq & 1);
#pragma unroll
        for (int ai = 0; ai < 2; ++ai)
#pragma unroll
            for (int m = 0; m < 4; ++m) { const int lr = wr * 64 + fr + ai * HALF + m * 16, t = rem * 256 + lr;
                f32x4 x[2][2]; float ss = 0.f;
#pragma unroll
                for (int bj = 0; bj < 2; ++bj)
#pragma unroll
                    for (int n = 0; n < 2; ++n) { x[bj][n] = acc[ai][bj][m][n]; ss += (x[bj][n][0] * x[bj][n][0] + x[bj][n][1] * x[bj][n][1]) + (x[bj][n][2] * x[bj][n][2] + x[bj][n][3] * x[bj][n][3]); }
                ss = sum_x32(sum_x16(ss));
                const float rs = __builtin_amdgcn_rsqf(ss * (1.0f / 64.0f) + 1e-6f);
                bf16_t* rowp = P + (size_t)(u.pm * BM + lr) * 2048 + col0;
#pragma unroll
                for (int bj = 0; bj < 2; ++bj) { const int pos = lat ? (bj == 0 ? (t >> 6) : (t & 63)) : 0;
                    f32x4 o[2];
#pragma unroll
                    for (int n = 0; n < 2; ++n)
#pragma unroll
                        for (int i = 0; i < 4; ++i) { const float xv = x[bj][n][i] * rs * gn[bj][n][i]; const float pv = get_x32(xv, first);
                            const float cs = rope[(pos * 16 + i0 + 4 * n + i) * 2], sn = rope[(pos * 16 + i0 + 4 * n + i) * 2 + 1];
                            const float rot = first ? xv * cs - pv * sn : xv * cs + pv * sn;
                            o[n][i] = (lat ? rot : xv) * sc; }
                    u32x4 w; w.x = cvt_pk_bf16(o[0][0], o[0][1]); w.y = cvt_pk_bf16(o[0][2], o[0][3]); w.z = cvt_pk_bf16(o[1][0], o[1][1]); w.w = cvt_pk_bf16(o[1][2], o[1][3]);
                    *(u32x4*)(rowp + 32 * bj) = w; } }
    }
};
struct EpiGate {
    static constexpr bool PERM = true, AFTER_DRAIN = false, HAS_INIT = false;
    bf16_t* O; const float* gate; const bf16_t* X;
    __device__ __forceinline__ void operator()(const f32x4 (&acc)[2][2][4][2], const Unit& u, int wr, int wc, int fr, int fq) const {
        const int seg = u.pm / 17, rem = u.pm - seg * 17; const int j = (rem == 16) ? 16 : seg;
        const int row0 = u.pm * BM + wr * 64 + fr, col0 = u.pn * BM + wc * 32 + 8 * fq;
        const float* g = gate + (size_t)j * 6144 + col0;
        f32x4 gv[2][2];
#pragma unroll
        for (int bj = 0; bj < 2; ++bj)
#pragma unroll
            for (int n = 0; n < 2; ++n) gv[bj][n] = *(const f32x4*)(g + bj * HALF + 4 * n);
#pragma unroll
        for (int ai = 0; ai < 2; ++ai) { u32x4 xv[4][2];
#pragma unroll
            for (int m = 0; m < 4; ++m)
#pragma unroll
                for (int bj = 0; bj < 2; ++bj) xv[m][bj] = *(const __attribute__((address_space(1))) u32x4*)(X + (size_t)(row0 + ai * HALF + m * 16) * 1024 + col0 + bj * HALF);
#pragma unroll
            for (int m = 0; m < 4; ++m) { bf16_t* rowp = O + (size_t)(row0 + ai * HALF + m * 16) * 1024 + col0;
#pragma unroll
                for (int bj = 0; bj < 2; ++bj) { const u32x4 x = xv[m][bj];
                    const f32x4 x0 = {__uint_as_float(x.x << 16), __uint_as_float(x.x & 0xFFFF0000u), __uint_as_float(x.y << 16), __uint_as_float(x.y & 0xFFFF0000u)};
                    const f32x4 x1 = {__uint_as_float(x.z << 16), __uint_as_float(x.z & 0xFFFF0000u), __uint_as_float(x.w << 16), __uint_as_float(x.w & 0xFFFF0000u)};
                    const f32x4 v0 = acc[ai][bj][m][0] * gv[bj][0] + x0, v1 = acc[ai][bj][m][1] * gv[bj][1] + x1;
                    u32x4 w; w.x = cvt_pk_bf16(v0[0], v0[1]); w.y = cvt_pk_bf16(v0[2], v0[3]); w.z = cvt_pk_bf16(v1[0], v1[1]); w.w = cvt_pk_bf16(v1[2], v1[3]);
                    *(u32x4*)(rowp + bj * HALF) = w; } } }
    }
};
struct EpiLogits {
    static constexpr bool PERM = false, AFTER_DRAIN = false, HAS_INIT = false;
    float* LOG;
    __device__ __forceinline__ void operator()(const f32x4 (&acc)[2][2][4][2], const Unit& u, int wr, int wc, int fr, int fq) const {
        if (wc != 0) return;
        const int row0 = u.pm * BM + wr * 64 + fr;
#pragma unroll
        for (int ai = 0; ai < 2; ++ai)
#pragma unroll
            for (int m = 0; m < 4; ++m) { float* rowp = LOG + (size_t)(row0 + ai * HALF + m * 16) * 32 + 4 * fq;
#pragma unroll
                for (int n = 0; n < 2; ++n) *(f32x4*)(rowp + n * 16) = acc[ai][0][m][n]; }
    }
};
struct EpiSwiglu {
    static constexpr bool PERM = true, AFTER_DRAIN = false, HAS_INIT = false;
    bf16_t* ACT; const float* b1p;
    __device__ __forceinline__ void operator()(const f32x4 (&acc)[2][2][4][2], const Unit& u, int wr, int wc, int fr, int fq) const {
        const int e = u.pn >> 3, pn = u.pn & 7;
        const int row0 = u.pm * BM + wr * 64 + fr, lc = wc * 32 + 8 * fq;
        const float* bp = b1p + (size_t)e * 2048 + pn * 256 + lc;
        f32x4 bg[2], bu[2];
#pragma unroll
        for (int n = 0; n < 2; ++n) { bg[n] = *(const f32x4*)(bp + 4 * n); bu[n] = *(const f32x4*)(bp + HALF + 4 * n); }
#pragma unroll
        for (int ai = 0; ai < 2; ++ai)
#pragma unroll
            for (int m = 0; m < 4; ++m) { bf16_t* rowp = ACT + (size_t)(row0 + ai * HALF + m * 16) * 1024 + pn * 128 + lc;
                f32x4 a[2];
#pragma unroll
                for (int n = 0; n < 2; ++n) { const f32x4 gt = acc[ai][0][m][n] + bg[n], up = acc[ai][1][m][n] + bu[n];
#pragma unroll
                    for (int i = 0; i < 4; ++i) { const float gc = fminf(gt[i], 7.0f), uc = fminf(fmaxf(up[i], -7.0f), 7.0f);
                        const float sg = __builtin_amdgcn_rcpf(1.0f + __builtin_amdgcn_exp2f(gc * (-1.702f * 1.4426950408889634f)));
                        a[n][i] = (uc + 1.0f) * (gc * sg); } }
                u32x4 w; w.x = cvt_pk_bf16(a[0][0], a[0][1]); w.y = cvt_pk_bf16(a[0][2], a[0][3]); w.z = cvt_pk_bf16(a[1][0], a[1][1]); w.w = cvt_pk_bf16(a[1][2], a[1][3]);
                *(u32x4*)rowp = w; }
    }
};
struct EpiSwiglu8 {
    static constexpr bool PERM = true, AFTER_DRAIN = false, HAS_INIT = true;
    unsigned char* ACT; const float* b1p;
    __device__ __forceinline__ const float* bias_row(const Unit& u) const { const int e = u.pn >> 3, pn = u.pn & 7; return b1p + (size_t)e * 2048 + pn * 256; }
    __device__ __forceinline__ void init_lds(f32x4 (&acc)[2][2][4][2], const PG8_LAS unsigned char* bl, int wc, int fq) const {
#pragma unroll
        for (int bj = 0; bj < 2; ++bj)
#pragma unroll
            for (int n = 0; n < 2; ++n) { const f32x4 bv = *(const PG8_LAS f32x4*)(bl + (bj * HALF + wc * 32 + 8 * fq + 4 * n) * 4);
#pragma unroll
                for (int ai = 0; ai < 2; ++ai)
#pragma unroll
                    for (int m = 0; m < 4; ++m) acc[ai][bj][m][n] = bv; }
    }
    __device__ __forceinline__ void operator()(const f32x4 (&acc)[2][2][4][2], const Unit& u, int wr, int wc, int fr, int fq) const {
        const int pn = u.pn & 7;
        const int row0 = u.pm * BM + wr * 64 + fr, lc = wc * 32 + 8 * fq;
#pragma unroll
        for (int ai = 0; ai < 2; ++ai)
#pragma unroll
            for (int m = 0; m < 4; ++m) { unsigned char* rowp = ACT + (size_t)(row0 + ai * HALF + m * 16) * 1024 + pn * 128 + lc;
                f32x4 a[2];
#pragma unroll
                for (int n = 0; n < 2; ++n) { const f32x4 gt = acc[ai][0][m][n], up = acc[ai][1][m][n];
#pragma unroll
                    for (int i = 0; i < 4; ++i) { const float gc = fminf(gt[i], 7.0f), uc = __builtin_amdgcn_fmed3f(up[i], -7.0f, 7.0f);
                        const float g2 = gc * __builtin_amdgcn_rcpf(1.0f + __builtin_amdgcn_exp2f(gc * (-1.702f * 1.4426950408889634f)));
                        a[n][i] = __builtin_fmaf(uc, g2, g2); } }
                int p0 = __builtin_amdgcn_cvt_pk_fp8_f32(a[0][0], a[0][1], 0, false); p0 = __builtin_amdgcn_cvt_pk_fp8_f32(a[0][2], a[0][3], p0, true);
                int p1 = __builtin_amdgcn_cvt_pk_fp8_f32(a[1][0], a[1][1], 0, false); p1 = __builtin_amdgcn_cvt_pk_fp8_f32(a[1][2], a[1][3], p1, true);
                *(u32x2*)rowp = (u32x2){(unsigned)p0, (unsigned)p1}; }
    }
};
struct EpiDown {
    static constexpr bool PERM = true, AFTER_DRAIN = false, HAS_INIT = true;
    unsigned char* YP; const float* b2;
    __device__ __forceinline__ const float* bias_row(const Unit& u) const { const int e = u.pn >> 2, pn = u.pn & 3; return b2 + (size_t)e * 1024 + pn * BM; }
    __device__ __forceinline__ void init_lds(f32x4 (&acc)[2][2][4][2], const PG8_LAS unsigned char* bl, int wc, int fq) const {
#pragma unroll
        for (int bj = 0; bj < 2; ++bj)
#pragma unroll
            for (int n = 0; n < 2; ++n) { const f32x4 bv = *(const PG8_LAS f32x4*)(bl + (bj * HALF + wc * 32 + 8 * fq + 4 * n) * 4) * 8.0f;
#pragma unroll
                for (int ai = 0; ai < 2; ++ai)
#pragma unroll
                    for (int m = 0; m < 4; ++m) acc[ai][bj][m][n] = bv; }
    }
    __device__ __forceinline__ void operator()(const f32x4 (&acc)[2][2][4][2], const Unit& u, int wr, int wc, int fr, int fq) const {
        const int pn = u.pn & 3;
        const int row0 = u.pm * BM + wr * 64 + fr, col0 = pn * BM + wc * 32 + 8 * fq;
#pragma unroll
        for (int ai = 0; ai < 2; ++ai)
#pragma unroll
            for (int m = 0; m < 4; ++m) { unsigned char* rowp = YP + (size_t)(row0 + ai * HALF + m * 16) * 1024 + col0;
#pragma unroll
                for (int bj = 0; bj < 2; ++bj) { const f32x4 v0 = acc[ai][bj][m][0], v1 = acc[ai][bj][m][1];
                    int p0 = __builtin_amdgcn_cvt_pk_fp8_f32(v0[0], v0[1], 0, false); p0 = __builtin_amdgcn_cvt_pk_fp8_f32(v0[2], v0[3], p0, true);
                    int p1 = __builtin_amdgcn_cvt_pk_fp8_f32(v1[0], v1[1], 0, false); p1 = __builtin_amdgcn_cvt_pk_fp8_f32(v1[2], v1[3], p1, true);
                    *(u32x2*)(rowp + bj * HALF) = (u32x2){(unsigned)p0, (unsigned)p1}; } }
    }
};

template <class Epi, class Sched, bool ALIGN_EPI = false, bool SP2 = false, bool F8 = false, int F8_SW = 0x7A7A7A7A, bool GATHER = false>
__device__ __forceinline__ void gemm_phase(PG8_LAS unsigned char* lds, const Gemm g, const Sched& S, const Epi& E) {
    int tid_ = threadIdx.x; asm volatile("" : "+v"(tid_));
    const int tid = tid_, wid = __builtin_amdgcn_readfirstlane(tid >> 6), lane = tid & 63, wr = wid >> 2, wc = wid & 3, fr = lane & 15, fq = lane >> 4;
    int K_ = g.K; asm volatile("" : "+s"(K_));
    const int K = K_, nt = K / BK;
    unsigned voffA[2], voffB[2];
#pragma unroll
    for (int i = 0; i < 2; ++i) { int R, C; stage_rc(tid * 16 + i * 8192, R, C); const int Rb = Epi::PERM ? ((R & ~31) + perm32(R & 31)) : R;
        voffA[i] = (unsigned)(R * K + C) * 2u; voffB[i] = (unsigned)(Rb * K + C) * 2u; }
    const size_t kstep = (size_t)(BK * 2);
    const size_t hstep = (size_t)HALF * K * 2;
    const size_t tstep = 2 * hstep;
    const size_t hstepA = GATHER ? 0 : hstep;
    unsigned voffC[2][2];
#define PG8_VA(h, nx) (GATHER ? voffC[h] : voffA)
#define PG8_GOFF(dst, slot, unit) do { const int nv_ = S.nvalid(unit); _Pragma("unroll") for (int i_ = 0; i_ < 2; ++i_) { int R_, C_; stage_rc(tid * 16 + i_ * 8192, R_, C_); _Pragma("unroll") for (int h_ = 0; h_ < 2; ++h_) { const int ri_ = h_ * HALF + R_; \
        int ix_ = *(const PG8_LAS int*)(lds + PG8_IDX_OFF + (slot) * 1024 + ri_ * 4); ix_ = ri_ < nv_ ? ix_ : 0; dst[h_][i_] = (unsigned)ix_ * (unsigned)(K * 2) + (unsigned)C_ * 2u; } } } while (0)
    const unsigned ldsw = (unsigned)wid * 1024u;
    const int aoff = lds_byte(wr * 64 + fr, fq * 8), boff = lds_byte(wc * 32 + fr, fq * 8);
#define PG8_SA(b, h) (((b) * 2 + (h)) * HTB)
#define PG8_SB(b, h) ((4 + (b) * 2 + (h)) * HTB)
#define PG8_STAGE(bufoff, gbase, voff) do { _Pragma("unroll") for (int _i = 0; _i < 2; ++_i) \
        __builtin_amdgcn_global_load_lds((const unsigned*)((const char*)(gbase) + (voff)[_i]), (PG8_LAS unsigned*)(lds + (bufoff) + ldsw + _i * 8192), 16, 0, 0); } while (0)
#define PG8_CAT(x0, x1) __builtin_shufflevector(__builtin_bit_cast(i32x4, x0), __builtin_bit_cast(i32x4, x1), 0, 1, 2, 3, 4, 5, 6, 7)
#define PG8_LDF(base, off) (*(const PG8_LAS bf16x8*)(lds + (base) + (off)))
#define PG8_LDA(dst, dst8, b, h) do { _Pragma("unroll") for (int m = 0; m < 4; ++m) { if constexpr (F8) dst8[m] = PG8_CAT(PG8_LDF(PG8_SA(b, h), aoff + m * 2048), PG8_LDF(PG8_SA(b, h), aoff + m * 2048 + 1024)); \
        else { _Pragma("unroll") for (int k = 0; k < 2; ++k) dst[m][k] = PG8_LDF(PG8_SA(b, h), aoff + m * 2048 + k * 1024); } } } while (0)
#define PG8_LDB(dst, dst8, b, h) do { _Pragma("unroll") for (int n = 0; n < 2; ++n) { if constexpr (F8) dst8[n] = PG8_CAT(PG8_LDF(PG8_SB(b, h), boff + n * 2048), PG8_LDF(PG8_SB(b, h), boff + n * 2048 + 1024)); \
        else { _Pragma("unroll") for (int k = 0; k < 2; ++k) dst[n][k] = PG8_LDF(PG8_SB(b, h), boff + n * 2048 + k * 1024); } } } while (0)
#define PG8_MMA(ai, bj, At, At8, Bt, Bt8) do { __builtin_amdgcn_s_setprio(1); _Pragma("unroll") for (int m = 0; m < 4; ++m) _Pragma("unroll") for (int n = 0; n < 2; ++n) { \
        if constexpr (F8) asm volatile("v_mfma_scale_f32_16x16x128_f8f6f4 %0, %1, %2, %0, %3, %3 op_sel:[0,1,0] op_sel_hi:[0,0,0]" : "+v"(acc[ai][bj][m][n]) : "v"(Bt8[n]), "v"(At8[m]), "v"(f8_s));   \
        else { _Pragma("unroll") for (int k = 0; k < 2; ++k) acc[ai][bj][m][n] = __builtin_amdgcn_mfma_f32_16x16x32_bf16(Bt[n][k], At[m][k], acc[ai][bj][m][n], 0, 0, 0); } } __builtin_amdgcn_s_setprio(0); } while (0)
#define PG8_WAIT_V(n) asm volatile("s_waitcnt vmcnt(" #n ")" ::: "memory")
#define PG8_WAIT_L(n) asm volatile("s_waitcnt lgkmcnt(" #n ")" ::: "memory")
#define PG8_BAR __builtin_amdgcn_s_barrier()
#define PG8_SCHED __builtin_amdgcn_sched_barrier(0)
    Unit cur, nxt; int ui = 0;
    if (!S.next(0, cur)) return;
    f32x4 acc[2][2][4][2];
    if constexpr (Epi::HAS_INIT) { if (wid == 0) __builtin_amdgcn_global_load_lds((const unsigned*)(E.bias_row(cur) + lane * 4), (PG8_LAS unsigned*)(lds + PG8_BIAS_OFF), 16, 0, 0); }
    else {
#pragma unroll
    for (int a = 0; a < 2; ++a)
#pragma unroll
        for (int b = 0; b < 2; ++b)
#pragma unroll
            for (int m = 0; m < 4; ++m)
#pragma unroll
                for (int n = 0; n < 2; ++n) acc[a][b][m][n] = (f32x4){0.f, 0.f, 0.f, 0.f};
    }
    int f8_s = 0x7F00 | (F8_SW & 0xFF); asm volatile("" : "+v"(f8_s));
    bf16x8 At[4][2], B0[2][2], B1[2][2]; i32x8 At8[4], B08[2], B18[2];
    const char* cA = (const char*)g.A + (GATHER ? (size_t)0 : (size_t)cur.pm * tstep); const char* cB = (const char*)g.Bt + (size_t)cur.pn * tstep;
    if constexpr (GATHER) { if (wid == 0) __builtin_amdgcn_global_load_lds((const unsigned*)(S.idx_src(cur) + lane * 4), (PG8_LAS unsigned*)(lds + PG8_IDX_OFF), 16, 0, 0);
        PG8_WAIT_V(0); PG8_BAR; PG8_GOFF(voffC, 0, cur); }
    S.a_ready(cur);
    if constexpr (SP2) {
        PG8_STAGE(PG8_SB(0, 0), cB, voffB); PG8_STAGE(PG8_SB(0, 1), cB + hstep, voffB); PG8_STAGE(PG8_SA(0, 0), cA, PG8_VA(0, false)); PG8_STAGE(PG8_SA(0, 1), cA + hstepA, PG8_VA(1, false));
        if (wr == 1) PG8_BAR;
        PG8_WAIT_V(2); PG8_BAR;
        PG8_STAGE(PG8_SB(1, 0), cB + kstep, voffB); PG8_STAGE(PG8_SA(1, 0), cA + kstep, PG8_VA(0, false)); PG8_STAGE(PG8_SB(1, 1), cB + hstep + kstep, voffB);
        PG8_WAIT_V(6); PG8_BAR;
    } else {
        PG8_STAGE(PG8_SB(0, 0), cB, voffB); PG8_STAGE(PG8_SA(0, 0), cA, PG8_VA(0, false)); PG8_STAGE(PG8_SB(0, 1), cB + hstep, voffB); PG8_STAGE(PG8_SA(0, 1), cA + hstepA, PG8_VA(1, false));
        if (wr == 1) PG8_BAR;
        PG8_WAIT_V(4); PG8_BAR;
        PG8_STAGE(PG8_SB(1, 0), cB + kstep, voffB); PG8_STAGE(PG8_SA(1, 0), cA + kstep, PG8_VA(0, false)); PG8_STAGE(PG8_SB(1, 1), cB + hstep + kstep, voffB);
        PG8_WAIT_V(6); PG8_BAR;
    }
    if constexpr (Epi::HAS_INIT) E.init_lds(acc, lds + PG8_BIAS_OFF, wc, fq);
    for (;;) {
        const bool has_next = S.next(ui + 1, nxt);
        if constexpr (Epi::HAS_INIT) { if (has_next && wid == 0) __builtin_amdgcn_global_load_lds((const unsigned*)(E.bias_row(nxt) + lane * 4), (PG8_LAS unsigned*)(lds + PG8_BIAS_OFF + ((ui + 1) & 1) * 1024), 16, 0, 0); }
        if constexpr (GATHER) { if (has_next && wid == 0) __builtin_amdgcn_global_load_lds((const unsigned*)(S.idx_src(nxt) + lane * 4), (PG8_LAS unsigned*)(lds + PG8_IDX_OFF + ((ui + 1) & 1) * 1024), 16, 0, 0); }
        const char* nA = has_next ? (const char*)g.A + (GATHER ? (size_t)0 : (size_t)nxt.pm * tstep) : cA; const char* nB = has_next ? (const char*)g.Bt + (size_t)nxt.pn * tstep : cB;
        for (int t = 0; t < nt; t += 2) {
            const bool last = (t == nt - 2);
            const char* a1 = cA + (size_t)(t + 1) * kstep;
            const char* a2 = last ? nA : cA + (size_t)(t + 2) * kstep; const char* b2 = last ? nB : cB + (size_t)(t + 2) * kstep;
            const char* a3 = a2 + kstep; const char* b3 = b2 + kstep;
            if (last && has_next) S.a_ready(nxt);
            if constexpr (SP2) {
            PG8_LDB(B0, B08, 0, 0); PG8_LDB(B1, B18, 0, 1); PG8_SCHED; PG8_LDA(At, At8, 0, 0); PG8_STAGE(PG8_SA(1, 1), a1 + hstepA, PG8_VA(1, false));
            if constexpr (GATHER) { if (last && has_next) PG8_GOFF(voffC, (ui + 1) & 1, nxt); }
            PG8_WAIT_V(8); PG8_WAIT_L(0); PG8_BAR; PG8_MMA(0, 0, At, At8, B0, B08); PG8_MMA(0, 1, At, At8, B1, B18); PG8_BAR; PG8_SCHED;
            PG8_LDA(At, At8, 0, 1); PG8_STAGE(PG8_SB(0, 0), b2, voffB); PG8_STAGE(PG8_SB(0, 1), b2 + hstep, voffB); PG8_STAGE(PG8_SA(0, 0), a2, PG8_VA(0, last));
            PG8_WAIT_V(8); PG8_WAIT_L(0); PG8_BAR; PG8_MMA(1, 0, At, At8, B0, B08); PG8_MMA(1, 1, At, At8, B1, B18); PG8_BAR; PG8_SCHED;
            PG8_LDB(B0, B08, 1, 0); PG8_LDB(B1, B18, 1, 1); PG8_SCHED; PG8_LDA(At, At8, 1, 0); PG8_STAGE(PG8_SA(0, 1), a2 + hstepA, PG8_VA(1, last));
            PG8_WAIT_V(8); PG8_WAIT_L(0); PG8_BAR; PG8_MMA(0, 0, At, At8, B0, B08); PG8_MMA(0, 1, At, At8, B1, B18); PG8_BAR; PG8_SCHED;
            PG8_LDA(At, At8, 1, 1); PG8_STAGE(PG8_SB(1, 0), b3, voffB); PG8_STAGE(PG8_SB(1, 1), b3 + hstep, voffB); PG8_STAGE(PG8_SA(1, 0), a3, PG8_VA(0, last));
            PG8_WAIT_V(8); PG8_WAIT_L(0); PG8_BAR; PG8_MMA(1, 0, At, At8, B0, B08); PG8_MMA(1, 1, At, At8, B1, B18); PG8_BAR; PG8_SCHED;
            } else {
            PG8_LDB(B0, B08, 0, 0); PG8_SCHED; PG8_LDA(At, At8, 0, 0); PG8_STAGE(PG8_SA(1, 1), a1 + hstepA, PG8_VA(1, false));
            PG8_WAIT_L(8); PG8_BAR; PG8_WAIT_L(0); PG8_MMA(0, 0, At, At8, B0, B08); PG8_BAR; PG8_SCHED;
            PG8_LDB(B1, B18, 0, 1); PG8_STAGE(PG8_SB(0, 0), b2, voffB);
            PG8_BAR; PG8_WAIT_L(0); PG8_MMA(0, 1, At, At8, B1, B18); PG8_BAR;
            PG8_LDA(At, At8, 0, 1); PG8_STAGE(PG8_SA(0, 0), a2, PG8_VA(0, last));
            PG8_BAR; PG8_WAIT_L(0); PG8_MMA(1, 0, At, At8, B0, B08); PG8_BAR; PG8_SCHED;
            PG8_STAGE(PG8_SB(0, 1), b2 + hstep, voffB);
            PG8_WAIT_V(6); PG8_BAR; PG8_MMA(1, 1, At, At8, B1, B18); PG8_BAR;
            PG8_LDB(B0, B08, 1, 0); PG8_SCHED; PG8_LDA(At, At8, 1, 0); PG8_STAGE(PG8_SA(0, 1), a2 + hstepA, PG8_VA(1, last));
            PG8_WAIT_L(8); PG8_BAR; PG8_WAIT_L(0); PG8_MMA(0, 0, At, At8, B0, B08); PG8_BAR; PG8_SCHED;
            PG8_LDB(B1, B18, 1, 1); PG8_STAGE(PG8_SB(1, 0), b3, voffB);
            PG8_BAR; PG8_WAIT_L(0); PG8_MMA(0, 1, At, At8, B1, B18); PG8_BAR;
            PG8_LDA(At, At8, 1, 1); PG8_STAGE(PG8_SA(1, 0), a3, PG8_VA(0, last));
            PG8_BAR; PG8_WAIT_L(0); PG8_MMA(1, 0, At, At8, B0, B08); PG8_BAR; PG8_SCHED;
            PG8_STAGE(PG8_SB(1, 1), b3 + hstep, voffB);
            PG8_WAIT_V(6); PG8_BAR; PG8_MMA(1, 1, At, At8, B1, B18); PG8_BAR;
            }
        }
        if constexpr (ALIGN_EPI) { if (wr == 0) PG8_BAR; }
        if constexpr (F8) asm volatile("s_nop 15\n\ts_nop 15" ::: "memory");
        if constexpr (!Epi::AFTER_DRAIN) { E(acc, cur, wr, wc, fr, fq); S.done(cur); }
        if (!has_next) break;
        if constexpr (Epi::HAS_INIT) E.init_lds(acc, lds + PG8_BIAS_OFF + ((ui + 1) & 1) * 1024, wc, fq); else {
#pragma unroll
        for (int a = 0; a < 2; ++a)
#pragma unroll
            for (int b = 0; b < 2; ++b)
#pragma unroll
                for (int m = 0; m < 4; ++m)
#pragma unroll
                    for (int n = 0; n < 2; ++n) acc[a][b][m][n] = (f32x4){0.f, 0.f, 0.f, 0.f};
        }
        cur = nxt; cA = nA; cB = nB; ++ui;

        if constexpr (ALIGN_EPI) { if (wr == 1) PG8_BAR; }
    }
    PG8_WAIT_V(0);
    if constexpr (!ALIGN_EPI) { if (wr == 0) PG8_BAR; }
    PG8_BAR;
    if constexpr (Epi::AFTER_DRAIN) { E.fused(acc, cur, wr, wc, fr, fq, lds, wid, lane); S.done(cur); }
#undef PG8_SA
#undef PG8_SB
#undef PG8_STAGE
#undef PG8_VA
#undef PG8_GOFF
#undef PG8_LDA
#undef PG8_LDF
#undef PG8_LDB
#undef PG8_MMA
#undef PG8_CAT
#undef PG8_WAIT_V
#undef PG8_WAIT_L
#undef PG8_BAR
#undef PG8_SCHED
}
}
#ifndef ATTN_STORE16
#define ATTN_STORE16(p,v) (*(u32x4*)(p)=(v))
#endif
namespace attn_body {
using bf16=__hip_bfloat16;
using bf16x8=__attribute__((ext_vector_type(8)))short;
using s16x4=__attribute__((ext_vector_type(4)))short;
using f32x16=__attribute__((ext_vector_type(16)))float;
using u32x4=__attribute__((ext_vector_type(4)))unsigned;
constexpr int D=64,PQ=2048,PO=1024,KOFF=512,VOFF=640;
constexpr int NW=8,QBLK=32,QB=QBLK*NW,KVBLK=64;
__device__ __forceinline__ int crow(int r,int hi){return (r&3)+8*(r>>2)+4*hi;}
#define SBAR() __builtin_amdgcn_sched_barrier(0)
constexpr int NSLOT=3, SLOTB=8192;
constexpr int LDS_K=0, LDS_V=NSLOT*SLOTB, LDS_WS=2*NSLOT*SLOTB, LDS_OST=LDS_WS+NW*64*4, LDS_BYTES=LDS_OST+NW*4096;
constexpr float C2=0.125f*1.4426950408889634f;
__device__ __forceinline__ void glds16(const void*gsrc,unsigned lds_dst){unsigned keep;
  asm volatile("s_mov_b32 %0, m0\n\ts_mov_b32 m0, %2\n\ts_nop 0\n\tglobal_load_lds_dwordx4 %1, off\n\ts_mov_b32 m0, %0":"=&s"(keep):"v"(gsrc),"s"(lds_dst):"memory");}
__device__ __forceinline__ float max3f(float a,float b,float c){float r;asm("v_max3_f32 %0, %1, %2, %3":"=v"(r):"v"(a),"v"(b),"v"(c));return r;}
__device__ __forceinline__ float max2f(float a,float b){float r;asm("v_max_f32_e32 %0, %1, %2":"=v"(r):"v"(a),"v"(b));return r;}
__device__ __forceinline__ float fadd_s(float a,float b){float r;asm("v_add_f32_e32 %0, %1, %2":"=v"(r):"v"(a),"v"(b));return r;}
__device__ __forceinline__ float fsub_s(float a,float b){float r;asm("v_sub_f32_e32 %0, %1, %2":"=v"(r):"v"(a),"v"(b));return r;}
typedef float f32x2_t __attribute__((ext_vector_type(2))); typedef __bf16 bf16x2_t __attribute__((ext_vector_type(2)));
__device__ __forceinline__ unsigned cvtpk_s(float lo,float hi){f32x2_t v={lo,hi};bf16x2_t b=__builtin_convertvector(v,bf16x2_t);return __builtin_bit_cast(unsigned,b);}
#define WAIT_BAR(N) asm volatile("s_waitcnt vmcnt(" #N ") lgkmcnt(0)\n\ts_barrier":::"memory")

__device__ __forceinline__ void qkt(f32x16&p0,f32x16&p1,const char*Kslot,const bf16x8*qr,const f32x16&negm,int r32,int hi){
  const char*kb=Kslot+hi*1024+r32*16;
  #pragma unroll
  for(int d0=0;d0<4;++d0){
    const bf16x8 b0=*reinterpret_cast<const bf16x8*>(kb+d0*2048);
    const bf16x8 b1=*reinterpret_cast<const bf16x8*>(kb+d0*2048+512);
    if(d0==0){p0=__builtin_amdgcn_mfma_f32_32x32x16_bf16(b0,qr[0],negm,0,0,0);p1=__builtin_amdgcn_mfma_f32_32x32x16_bf16(b1,qr[0],negm,0,0,0);}
    else{p0=__builtin_amdgcn_mfma_f32_32x32x16_bf16(b0,qr[d0],p0,0,0,0);p1=__builtin_amdgcn_mfma_f32_32x32x16_bf16(b1,qr[d0],p1,0,0,0);}}
}
typedef __attribute__((address_space(3))) const char* lds_cptr;
typedef short v4i16_t __attribute__((ext_vector_type(4)));
__device__ __forceinline__ void kload8(bf16x8*kf,lds_cptr kp){
  kf[0]=*(const __attribute__((address_space(3))) bf16x8*)(kp);      kf[1]=*(const __attribute__((address_space(3))) bf16x8*)(kp+512);
  kf[2]=*(const __attribute__((address_space(3))) bf16x8*)(kp+2048); kf[3]=*(const __attribute__((address_space(3))) bf16x8*)(kp+2560);
  kf[4]=*(const __attribute__((address_space(3))) bf16x8*)(kp+4096); kf[5]=*(const __attribute__((address_space(3))) bf16x8*)(kp+4608);
  kf[6]=*(const __attribute__((address_space(3))) bf16x8*)(kp+6144); kf[7]=*(const __attribute__((address_space(3))) bf16x8*)(kp+6656);
}
__device__ __forceinline__ void kload2(bf16x8*kf,lds_cptr kp,int j){ kf[2*j]=*(const __attribute__((address_space(3))) bf16x8*)(kp+j*2048); kf[2*j+1]=*(const __attribute__((address_space(3))) bf16x8*)(kp+j*2048+512); }
__device__ __forceinline__ s16x4 vtr(lds_cptr p){ return __builtin_bit_cast(s16x4,__builtin_amdgcn_ds_read_tr16_b64_v4i16((__attribute__((address_space(3))) v4i16_t*)p)); }
__device__ __forceinline__ float rowmax(const f32x16&p0,const f32x16&p1){
  float a=max3f(p0[0],p0[1],p1[0]),b=max3f(p0[2],p0[3],p1[1]);a=max3f(a,p1[2],p1[3]);
  #pragma unroll
  for(int r=4;r<16;r+=4){a=max3f(a,p0[r],p0[r+1]);b=max3f(b,p0[r+2],p0[r+3]);a=max3f(a,p1[r],p1[r+1]);b=max3f(b,p1[r+2],p1[r+3]);}
  const float m=max2f(a,b);
  auto rr=__builtin_amdgcn_permlane32_swap(__float_as_uint(m),__float_as_uint(m),false,false);
  return max2f(__uint_as_float(rr[0]),__uint_as_float(rr[1]));
}
__device__ __forceinline__ void pv(f32x16*o,int vb,bf16x8 pa0,bf16x8 pa1,bf16x8 pa2,bf16x8 pa3){
  #pragma unroll
  for(int d0=0;d0<2;++d0){s16x4 lo[4],hi[4];
    #pragma unroll
    for(int ks=0;ks<4;++ks){
      asm volatile("ds_read_b64_tr_b16 %0,%1 offset:%c2":"=&v"(lo[ks]):"v"(vb),"i"(d0*4096+ks*1024):"memory");
      asm volatile("ds_read_b64_tr_b16 %0,%1 offset:%c2":"=&v"(hi[ks]):"v"(vb),"i"(d0*4096+ks*1024+512):"memory");}
    asm volatile("s_waitcnt lgkmcnt(0)":::"memory");SBAR();
    #define PK(k) (bf16x8){lo[k][0],lo[k][1],lo[k][2],lo[k][3],hi[k][0],hi[k][1],hi[k][2],hi[k][3]}
    o[d0]=__builtin_amdgcn_mfma_f32_32x32x16_bf16(pa0,PK(0),o[d0],0,0,0);
    o[d0]=__builtin_amdgcn_mfma_f32_32x32x16_bf16(pa1,PK(1),o[d0],0,0,0);
    o[d0]=__builtin_amdgcn_mfma_f32_32x32x16_bf16(pa2,PK(2),o[d0],0,0,0);
    o[d0]=__builtin_amdgcn_mfma_f32_32x32x16_bf16(pa3,PK(3),o[d0],0,0,0);
    #undef PK
  }
}

template<int THRL,bool FIXR=false> __device__ __forceinline__ void attn_unit(long qrow0,long krow0,int NTarg,int h,const bf16*Pq,bf16*Yo,char*shm,int koff=0){
  int tid_=threadIdx.x; asm volatile("":"+v"(tid_)); const int tid=tid_,lane=tid&63,r32=lane&31,hi=lane>>5; const int wid=__builtin_amdgcn_readfirstlane(tid>>6);
  const bf16*Qw=Pq+(qrow0+wid*QBLK)*PQ+h*D;
  const bf16*Kh=Pq+krow0*PQ+KOFF+(h>>2)*D,*Vh=Pq+krow0*PQ+VOFF+(h>>2)*D;
  const unsigned lds0=(unsigned)(uintptr_t)shm;
  float*wsf=(float*)(shm+LDS_WS)+wid*64;
  const bf16*ksrc=Kh+(long)lane*PQ+wid*8;
  const bf16*vsrc=Vh+(long)(16*(wid&3)+(lane>>2))*PQ+(wid>>2)*32+(lane&3)*8;
  const unsigned kdst=lds0+LDS_K+wid*1024, vdst=lds0+LDS_V+wid*1024;
  #define KVT(t) ({int t_=(t)+koff; t_>=NTarg?t_-NTarg:t_;})
  #define DMA_K(t,slot) glds16(ksrc+(long)KVT(t)*KVBLK*PQ,(unsigned)__builtin_amdgcn_readfirstlane(kdst+(slot)))
  #define DMA_V(t,slot) glds16(vsrc+(long)KVT(t)*KVBLK*PQ,(unsigned)__builtin_amdgcn_readfirstlane(vdst+(slot)))
  const int vb0=(int)(lds0+LDS_V)+((lane>>4)&1)*32+(lane&3)*8+(4*hi+((lane&15)>>2))*64;
  const char*Kbase=shm+LDS_K; bf16x8 kf[8];
  const lds_cptr shm3=(lds_cptr)shm; const lds_cptr kp0=shm3+LDS_K+hi*1024+r32*16; const lds_cptr vp0=shm3+LDS_V+((lane>>4)&1)*32+(lane&3)*8+(4*hi+((lane&15)>>2))*64;
  const int NT=NTarg;
  DMA_K(0,0);DMA_V(0,0);DMA_K(1,SLOTB);
  bf16x8 qr[4];
  #pragma unroll
  for(int d0=0;d0<4;++d0)qr[d0]=*reinterpret_cast<const bf16x8*>(&Qw[(long)r32*PQ+d0*16+hi*8]);
  float mhat=0.f,l_reg=0.f;f32x16 o[2];o[0]=f32x16{};o[1]=f32x16{};f32x16 negm=f32x16{}; if constexpr(!FIXR)asm volatile("":"+v"(negm));

  #define CMASK(P0,P1,t) do{}while(0)
  bool resc=false;
  #define START(P0,P1) do{ resc=false; \
    if constexpr(!FIXR){ const float rm=rowmax(P0,P1); const float dl=rm; mhat=fadd_s(mhat,dl); \
      _Pragma("unroll") for(int r=0;r<16;++r){P0[r]=fsub_s(P0[r],dl);P1[r]=fsub_s(P1[r],dl);} \
      _Pragma("unroll") for(int r=0;r<16;++r)negm[r]=-mhat; asm volatile("":"+v"(negm)); } \
    _Pragma("unroll") for(int r=0;r<16;++r)P0[r]=__builtin_amdgcn_exp2f(P0[r]); }while(0)
  #define RESC() do{ if(resc){ asm volatile("s_waitcnt lgkmcnt(0)":::"memory"); \
      _Pragma("unroll") for(int d_=0;d_<2;++d_) _Pragma("unroll") for(int r=0;r<16;++r)o[d_][r]*=wsf[crow(r,hi)]; } }while(0)
  f32x16 pA0,pA1,pB0,pB1;
  int sl_prev=0,sl_cur=0,sl_next=SLOTB;
  #define ROT() do{sl_prev=sl_cur;sl_cur=sl_next;sl_next=(sl_next==(NSLOT-1)*SLOTB)?0:sl_next+SLOTB;}while(0)
  DMA_K(2,2*SLOTB);
  WAIT_BAR(3);
  qkt(pA0,pA1,Kbase,qr,negm,r32,hi);asm volatile("s_nop 15\n\ts_nop 7":"+v"(pA0),"+v"(pA1));CMASK(pA0,pA1,0);
  START(pA0,pA1);
  _Pragma("unroll") for(int r=0;r<16;++r)pA1[r]=__builtin_amdgcn_exp2f(pA1[r]);
  WAIT_BAR(0);
  DMA_K(3,0);DMA_V(1,SLOTB);
  ROT();
  kload8(kf,kp0+sl_cur);
  WAIT_BAR(2);
  s16x4 vlo[8],vhi[8]; u32x4 pw0,pw1,pw2,pw3;
  #define PKW(P,B) cvtpk_s(P[B],P[B+1])
  #define PAF(k) __builtin_bit_cast(bf16x8,pw##k)
  #define VFR(i) (bf16x8){vlo[i][0],vlo[i][1],vlo[i][2],vlo[i][3],vhi[i][0],vhi[i][1],vhi[i][2],vhi[i][3]}
  #define PIN(x) asm volatile("":"+v"(x))
  #define MX3(a,b,c) __builtin_fmaxf(__builtin_fmaxf((a),(b)),(c))
  #define GAPA(MF,A0,A1,A2,A3,W0,W1,PW) do{ MF; sacc+=A0; sacc+=A1; sacc+=A2; sacc+=A3; PIN(sacc); W0; W1; PIN(PW); SBAR(); }while(0)
  #define EX(v) __builtin_amdgcn_exp2f(v)
  #define GAPB(MF,X,B) do{ MF; X[B]=EX(X[B]); X[B+1]=EX(X[B+1]); X[B+2]=EX(X[B+2]); X[B+3]=EX(X[B+3]); PIN(X); SBAR(); }while(0)
  #define VRD(i) do{ vlo[i]=vtr(vp_+(((i)>>2)*4096+((i)&3)*1024)); vhi[i]=vtr(vp_+(((i)>>2)*4096+((i)&3)*1024+512)); }while(0)
  #define KRD(G,j) do{ if(G){ kload2(kf,kp0+sl_next,j); SBAR(); } }while(0)
  #define STEP(C0,C1,P0,P1,t,GK,GV,GL) do{ SBAR(); \
    const lds_cptr vp_=vp0+sl_prev; \
    VRD(0); SBAR(); float sacc=(P0[0]+P0[1]); \
    GAPA(C0=__builtin_amdgcn_mfma_f32_32x32x16_bf16(kf[0],qr[0],negm,0,0,0), P0[2],P0[3],P0[4],P0[5],     pw0[0]=PKW(P0,0), pw0[1]=PKW(P0,2), pw0); \
    VRD(4); SBAR(); GAPA(C1=__builtin_amdgcn_mfma_f32_32x32x16_bf16(kf[1],qr[0],negm,0,0,0), P0[6],P0[7],P0[8],P0[9],     pw0[2]=PKW(P0,4), pw0[3]=PKW(P0,6), pw0); \
    VRD(1); SBAR(); GAPA(C0=__builtin_amdgcn_mfma_f32_32x32x16_bf16(kf[2],qr[1],C0,0,0,0),   P0[10],P0[11],P0[12],P0[13], pw1[0]=PKW(P0,8), pw1[1]=PKW(P0,10), pw1); \
    VRD(5); SBAR(); GAPA(C1=__builtin_amdgcn_mfma_f32_32x32x16_bf16(kf[3],qr[1],C1,0,0,0),   P0[14],P0[15],P1[0],P1[1],   pw1[2]=PKW(P0,12),pw1[3]=PKW(P0,14), pw1); \
    VRD(2); SBAR(); GAPA(C0=__builtin_amdgcn_mfma_f32_32x32x16_bf16(kf[4],qr[2],C0,0,0,0),   P1[2],P1[3],P1[4],P1[5],     pw2[0]=PKW(P1,0), pw2[1]=PKW(P1,2), pw2); \
    VRD(6); SBAR(); GAPA(C1=__builtin_amdgcn_mfma_f32_32x32x16_bf16(kf[5],qr[2],C1,0,0,0),   P1[6],P1[7],P1[8],P1[9],     pw2[2]=PKW(P1,4), pw2[3]=PKW(P1,6), pw2); \
    VRD(3); SBAR(); GAPA(C0=__builtin_amdgcn_mfma_f32_32x32x16_bf16(kf[6],qr[3],C0,0,0,0),   P1[10],P1[11],P1[12],P1[13], pw3[0]=PKW(P1,8), pw3[1]=PKW(P1,10), pw3); \
    VRD(7); SBAR(); GAPA(C1=__builtin_amdgcn_mfma_f32_32x32x16_bf16(kf[7],qr[3],C1,0,0,0),   P1[14],P1[15],0.f,0.f,       pw3[2]=PKW(P1,12),pw3[3]=PKW(P1,14), pw3); \
    l_reg+=sacc; \
    if(GK){DMA_K((t)+3,sl_cur);} if(GV){DMA_V((t)+1,sl_next);} \
    CMASK(C0,C1,t); \
    resc=false; \
    if constexpr(!FIXR){ float a=MX3(C0[0],C0[1],C1[0]),b=MX3(C0[2],C0[3],C1[1]); a=MX3(a,C1[2],C1[3]); \
      _Pragma("unroll") for(int r=4;r<16;r+=4){a=MX3(a,C0[r],C0[r+1]);b=MX3(b,C0[r+2],C0[r+3]);a=MX3(a,C1[r],C1[r+1]);b=MX3(b,C1[r+2],C1[r+3]);} \
      float rm=__builtin_fmaxf(a,b); { auto rr=__builtin_amdgcn_permlane32_swap(__float_as_uint(rm),__float_as_uint(rm),false,false); rm=__builtin_fmaxf(__uint_as_float(rr[0]),__uint_as_float(rr[1])); } \
      if(__builtin_expect(__any(rm>(float)THRL),0)){ const float dl=__builtin_fmaxf(rm,0.f); mhat+=dl; \
        _Pragma("unroll") for(int r=0;r<16;++r){C0[r]-=dl;C1[r]-=dl;} \
        _Pragma("unroll") for(int r=0;r<16;++r)negm[r]=-mhat; asm volatile("":"+v"(negm)); \
        const float f=__builtin_amdgcn_exp2f(-dl); l_reg*=f; if(hi==0)wsf[r32]=f; resc=true; } } \
    SBAR(); \
    GAPB(o[0]=__builtin_amdgcn_mfma_f32_32x32x16_bf16(PAF(0),VFR(0),o[0],0,0,0), C0,0); \
    GAPB(o[1]=__builtin_amdgcn_mfma_f32_32x32x16_bf16(PAF(0),VFR(4),o[1],0,0,0), C0,4); \
    KRD(GL,0); GAPB(o[0]=__builtin_amdgcn_mfma_f32_32x32x16_bf16(PAF(1),VFR(1),o[0],0,0,0), C0,8); \
    KRD(GL,1); GAPB(o[1]=__builtin_amdgcn_mfma_f32_32x32x16_bf16(PAF(1),VFR(5),o[1],0,0,0), C0,12); \
    KRD(GL,2); GAPB(o[0]=__builtin_amdgcn_mfma_f32_32x32x16_bf16(PAF(2),VFR(2),o[0],0,0,0), C1,0); \
    KRD(GL,3); GAPB(o[1]=__builtin_amdgcn_mfma_f32_32x32x16_bf16(PAF(2),VFR(6),o[1],0,0,0), C1,4); \
    GAPB(o[0]=__builtin_amdgcn_mfma_f32_32x32x16_bf16(PAF(3),VFR(3),o[0],0,0,0), C1,8); \
    GAPB(o[1]=__builtin_amdgcn_mfma_f32_32x32x16_bf16(PAF(3),VFR(7),o[1],0,0,0), C1,12); \
    }while(0)
  int t=1;
  #undef CMASK
  #define CMASK(P0,P1,t) do{}while(0)
  for(;t+5<NT;t+=2){
    STEP(pB0,pB1,pA0,pA1,t,true,true,true);     WAIT_BAR(2); RESC(); ROT();
    STEP(pA0,pA1,pB0,pB1,t+1,true,true,true);   WAIT_BAR(2); RESC(); ROT();
  }
  #undef CMASK
  #define CMASK(P0,P1,t) do{}while(0)
  #define ENDW(tt) do{ if((tt)+3<NT){WAIT_BAR(2);} else if((tt)+2<NT){WAIT_BAR(1);} else {WAIT_BAR(0);} }while(0)
  for(;t+1<NT;t+=2){
    STEP(pB0,pB1,pA0,pA1,t,(t+3<NT),(t+1<NT),(t+1<NT));       ENDW(t);   RESC(); ROT();
    STEP(pA0,pA1,pB0,pB1,t+1,(t+4<NT),(t+2<NT),(t+2<NT));     ENDW(t+1); RESC(); ROT();
  }
  STEP(pB0,pB1,pA0,pA1,NT-1,false,false,false); RESC();
  { float sacc=pB0[0]+pB0[1]; _Pragma("unroll") for(int r=2;r<16;++r)sacc+=pB0[r]; _Pragma("unroll") for(int r=0;r<16;++r)sacc+=pB1[r]; l_reg+=sacc;
    pw0=(u32x4){PKW(pB0,0),PKW(pB0,2),PKW(pB0,4),PKW(pB0,6)};pw1=(u32x4){PKW(pB0,8),PKW(pB0,10),PKW(pB0,12),PKW(pB0,14)};pw2=(u32x4){PKW(pB1,0),PKW(pB1,2),PKW(pB1,4),PKW(pB1,6)};pw3=(u32x4){PKW(pB1,8),PKW(pB1,10),PKW(pB1,12),PKW(pB1,14)};
    SBAR(); pv(o,vb0+sl_cur,PAF(0),PAF(1),PAF(2),PAF(3)); }
  #undef PKW
  #undef PAF
  #undef VFR
  #undef PIN
  #undef MX3
  #undef GAPA
  #undef GAPB
  #undef EX
  #undef VRD
  #undef KRD
  #undef STEP
  #undef ENDW
  {auto rr=__builtin_amdgcn_permlane32_swap(__float_as_uint(l_reg),__float_as_uint(l_reg),false,false);l_reg=__uint_as_float(rr[0])+__uint_as_float(rr[1]);}
  if(hi==0)wsf[32+r32]=l_reg;asm volatile("s_waitcnt lgkmcnt(0)":::"memory");
  float rli[16];
  #pragma unroll
  for(int r=0;r<16;++r)rli[r]=__builtin_amdgcn_rcpf(wsf[32+crow(r,hi)]);
  bf16*Ow=Yo+(qrow0+wid*QBLK)*PO+h*D;
  { bf16*stg=(bf16*)(shm+LDS_OST)+wid*2048;
    #pragma unroll
    for(int r=0;r<16;++r){const int orow=crow(r,hi);
      #pragma unroll
      for(int d0=0;d0<2;++d0)stg[orow*64+d0*32+r32]=__float2bfloat16(o[d0][r]*rli[r]);}
    asm volatile("s_waitcnt lgkmcnt(0)":::"memory");
    #pragma unroll
    for(int i=0;i<4;++i){const int row=i*8+(lane>>3),ch=lane&7; const u32x4 v=*(const u32x4*)(stg+row*64+ch*8); ATTN_STORE16(Ow+(long)row*PO+ch*8,v);} }
  asm volatile("s_waitcnt lgkmcnt(0)\n\ts_barrier":::"memory");
  #undef DMA_K
  #undef KVT
  #undef DMA_V
  #undef CMASK
  #undef START
  #undef RESC
  #undef ROT
}
constexpr int ATTN_LDS_BYTES=LDS_BYTES;
#undef SBAR
#undef WAIT_BAR
}
#ifndef MK_FP8_IN
#define MK_FP8_IN 0
#endif
#ifndef MK_FP8
#define MK_FP8 1
#endif
namespace mk {
constexpr int NB = 16, SQ = 4096, CL = 256, SEG = SQ + CL, T = NB * SEG, D = 1024, INW = 2048, NL = 4, NE = 32;
constexpr int NROWT = T / 256;
constexpr int MAXRT = 1120, CAP = MAXRT * 256;
constexpr int MODW = 6 * D;
constexpr float EPS = 1e-6f;
constexpr int NWAVES = 8;
constexpr int PPL = 12, NPHASE = 2 + NL * PPL;

constexpr size_t MiB = 1u << 20;
constexpr size_t WS_CTL = 0, CTL_ZERO_BYTES = 1 * MiB;
constexpr size_t WS_MOD = 4 * MiB;
constexpr size_t WS_B1P = 6 * MiB;
constexpr size_t WS_PAIR = 8 * MiB;
constexpr size_t WS_TOK = 12 * MiB;
constexpr size_t WS_LOG = 22 * MiB;
constexpr size_t WS_WINT = 32 * MiB;
constexpr size_t WS_WOUTT = 50 * MiB;
constexpr size_t WS_WRT = 60 * MiB;
constexpr size_t WS_W1T = 64 * MiB;
constexpr size_t WS_W2T = 576 * MiB;
constexpr size_t WS_X = 832 * MiB;
constexpr size_t WS_HB = 1104 * MiB;
constexpr size_t WS_P = 1240 * MiB;
constexpr size_t WS_Y = 1512 * MiB;
constexpr size_t WS_HP = 1648 * MiB;
constexpr size_t WS_OB = (1648 + 288) * MiB;
constexpr size_t WS_ACT = 2208 * MiB;
constexpr size_t WS_YP = 2768 * MiB;
constexpr size_t WS_HB8 = 3328 * MiB;
constexpr size_t WS_END = 3400 * MiB;
static_assert(WS_MOD + (size_t)NL * 17 * MODW * 4 <= WS_B1P && WS_B1P + (size_t)NL * NE * 2048 * 4 <= WS_PAIR && WS_PAIR + (size_t)T * 32 <= WS_TOK && WS_TOK + (size_t)NE * T * 4 <= WS_LOG && WS_LOG + (size_t)T * 128 <= WS_WINT, "ws map 1");
static_assert(WS_WINT + (size_t)NL * 2048 * 1024 * 2 <= WS_WOUTT && WS_WOUTT + (size_t)NL * 1024 * 1024 * 2 <= WS_WRT && WS_WRT + (size_t)NL * 256 * 1024 * 2 <= WS_W1T && WS_W1T + (size_t)NL * NE * 2048 * 1024 * 2 <= WS_W2T && WS_W2T + (size_t)NL * NE * 1024 * 1024 * 2 <= WS_X, "ws map 2");
static_assert(WS_X + (size_t)T * 4096 <= WS_HB && WS_HB + (size_t)T * 2048 <= WS_P && WS_P + (size_t)T * 4096 <= WS_Y && WS_Y + (size_t)T * 2048 <= WS_HP && WS_HP + (size_t)CAP * 2048 <= WS_ACT && WS_ACT + (size_t)CAP * 2048 <= WS_YP && WS_YP + (size_t)CAP * 2048 <= WS_HB8 && WS_HB8 + (size_t)T * 1024 <= WS_END, "ws map 3");
constexpr int CW_BAR = 4096;
constexpr int CW_CTX = 81920;
constexpr int CW_CQ = 83968;
constexpr int CW_CNT = 65536;
constexpr int RING_BYTES = 131072;
constexpr int ROPE_OFF = RING_BYTES + 2048;
constexpr int T2E_OFF = ROPE_OFF + 8192;
constexpr int MISC_OFF = T2E_OFF + 2048;
constexpr int LDS_BYTES = 149504;
static_assert(MISC_OFF + 1024 == pg8::PG8_BIAS_OFF && pg8::PG8_IDX_OFF + 2048 <= LDS_BYTES, "LDS map");
static_assert(MK_FP8 == 1 && WS_HP + (size_t)CAP * 1024 <= WS_OB && WS_OB + (size_t)T * 2048 <= WS_ACT, "OB lives in the free half of the HP region");

#define GAS __attribute__((address_space(1)))
#define LAS __attribute__((address_space(3)))
typedef unsigned short bf16;
typedef unsigned v4u __attribute__((ext_vector_type(4)));
typedef unsigned v2u __attribute__((ext_vector_type(2)));
typedef float f32x4 __attribute__((ext_vector_type(4)));
typedef float f32x2 __attribute__((ext_vector_type(2)));
typedef GAS unsigned gu32;
#define RLX_AGENT __ATOMIC_RELAXED, __HIP_MEMORY_SCOPE_AGENT
#define LDS_WAIT() asm volatile("s_waitcnt lgkmcnt(0)" ::: "memory")
#define VM_WAIT() asm volatile("s_waitcnt vmcnt(0)" ::: "memory")
__device__ __forceinline__ unsigned f2bf(float f) { unsigned u = __builtin_bit_cast(unsigned, f); return (u + 0x7fffu + ((u >> 16) & 1u)) >> 16; }
__device__ __forceinline__ unsigned pk2(float lo, float hi) { unsigned r; asm("v_cvt_pk_bf16_f32 %0, %1, %2" : "=v"(r) : "v"(lo), "v"(hi)); return r; }
__device__ __forceinline__ float bflo(unsigned w) { return __builtin_bit_cast(float, w << 16); }
__device__ __forceinline__ float bfhi(unsigned w) { return __builtin_bit_cast(float, w & 0xffff0000u); }
__device__ __forceinline__ f32x4 bf4(v2u w) { return (f32x4){bflo(w.x), bfhi(w.x), bflo(w.y), bfhi(w.y)}; }
__device__ __forceinline__ v2u pk4(f32x4 v) { return (v2u){pk2(v.x, v.y), pk2(v.z, v.w)}; }
using pg8::shx; using pg8::wsum; using pg8::dpp_f; using pg8::sum_x16; using pg8::sum_x32; using pg8::get_x16; using pg8::get_x32;
__device__ __forceinline__ float wave_sum(float v) { return wsum(v); }
__device__ __forceinline__ float sum4(f32x4 v) { return (v.x + v.y) + (v.z + v.w); }
__device__ __forceinline__ float sigmoidf_(float z) { return __builtin_amdgcn_rcpf(1.0f + __builtin_amdgcn_exp2f(z * -1.4426950408889634f)); }
template <int I> __device__ __forceinline__ const float* ldin() { const GAS float* p;
    asm volatile("s_load_dwordx2 %0, %1, %2\n\ts_waitcnt lgkmcnt(0)" : "=s"(p) : "s"(__builtin_amdgcn_kernarg_segment_ptr()), "n"(I * 8) : "memory"); return (const float*)p; }
__device__ __forceinline__ float* ldout() { GAS float* p;
    asm volatile("s_load_dwordx2 %0, %1, %2\n\ts_waitcnt lgkmcnt(0)" : "=s"(p) : "s"(__builtin_amdgcn_kernarg_segment_ptr()), "n"(24 * 8) : "memory"); return (float*)p; }
#define XB_TMO      128
#define XB_XCNT(j)  (256  + 64 * (j))
#define XB_XSUB(j)  (1280 + 64 * (j))
#define XB_XGEN(j)  (2304 + 64 * (j))
#define XB_TOP      3328
#define XB_TOPGEN   3392
#define XCD_BAR_WORDS 3456
#define XB_SPIN_CAP (1u << 22)

__device__ __forceinline__ unsigned xb_ld(unsigned* p)              { return __hip_atomic_load(p, __ATOMIC_RELAXED, __HIP_MEMORY_SCOPE_AGENT); }
__device__ __forceinline__ unsigned xb_add(unsigned* p, unsigned v) { return __hip_atomic_fetch_add(p, v, __ATOMIC_RELAXED, __HIP_MEMORY_SCOPE_AGENT); }
__device__ __forceinline__ unsigned xb_xcc_id() { return (unsigned)__builtin_amdgcn_s_getreg((3 << 11) | 20) & 0xFu; }
#define XB_SPIN(cond, bar) do { unsigned _sp = 0; while (cond) { __builtin_amdgcn_s_sleep(1); \
    if ((++_sp & 255u) == 0u) { if (xb_ld(&(bar)[XB_TMO])) break; if (_sp > XB_SPIN_CAP) { atomicAdd(&(bar)[XB_TMO], 1u); break; } } } } while (0)

struct XcdBarrier {
    unsigned* bar; unsigned x;
    volatile LAS unsigned* st;
};

__device__ __forceinline__ XcdBarrier xcd_barrier_post(unsigned* bar, volatile LAS unsigned* st) {
    XcdBarrier b; b.bar = bar; b.x = xb_xcc_id(); b.st = st;
    if (threadIdx.x == 0) (void)xb_add(&bar[XB_XCNT(b.x)], 1u);
    return b;
}
__device__ __forceinline__ void xcd_barrier_complete(unsigned* bar, unsigned x, unsigned& nloc, unsigned& nx) {
    const unsigned G = gridDim.x * gridDim.y * gridDim.z;
    unsigned sum, cnt, mine, sp = 0u;
    for (;;) {
        sum = 0u; cnt = 0u; mine = 0u;
#pragma unroll
        for (unsigned j = 0; j < 16; ++j) { const unsigned c = xb_ld(&bar[XB_XCNT(j)]); sum += c; cnt += (c > 0u) ? 1u : 0u; mine = (j == x) ? c : mine; }
        if (sum == G) break;
        __builtin_amdgcn_s_sleep(1);
        if ((++sp & 255u) == 0u) { if (xb_ld(&bar[XB_TMO])) break; if (sp > XB_SPIN_CAP) { atomicAdd(&bar[XB_TMO], 1u); break; } }
    }
    nloc = mine > 0u ? mine : 1u; nx = cnt > 0u ? cnt : 1u;
}

__device__ __forceinline__ void xcd_barrier(const XcdBarrier& b) {
    asm volatile("s_waitcnt vmcnt(0)" ::: "memory");
    __syncthreads();
    if (threadIdx.x == 0) {
        unsigned* bar = b.bar;
        __builtin_amdgcn_s_waitcnt(0);
        unsigned nloc = b.st[0], nx = b.st[1];
        if (nloc == 0u) { xcd_barrier_complete(bar, b.x, nloc, nx); b.st[0] = nloc; b.st[1] = nx; }
        const unsigned old = xb_add(&bar[XB_XSUB(b.x)], 1u);
        const unsigned gen = old / nloc;
        if (old + 1u == (gen + 1u) * nloc) {
            __builtin_amdgcn_fence(__ATOMIC_RELEASE, "agent");
            asm volatile("s_waitcnt vmcnt(0)" ::: "memory");
            const unsigned og = xb_add(&bar[XB_TOP], 1u);
            const unsigned tg = og / nx;
            if (og + 1u == (tg + 1u) * nx) xb_add(&bar[XB_TOPGEN], 1u);
            else XB_SPIN(xb_ld(&bar[XB_TOPGEN]) == tg, bar);
            __builtin_amdgcn_fence(__ATOMIC_ACQUIRE, "agent");
            xb_add(&bar[XB_XGEN(b.x)], 1u);
            asm volatile("s_waitcnt vmcnt(0)" ::: "memory");
        } else {
            XB_SPIN(xb_ld(&bar[XB_XGEN(b.x)]) == gen, bar);
            __builtin_amdgcn_fence(__ATOMIC_ACQUIRE, "agent");
            asm volatile("s_waitcnt vmcnt(0)" ::: "memory");
        }
    }
    __syncthreads();
}

struct Ctx {
    LAS unsigned char* lds; volatile LAS unsigned* MISC; gu32* ctl;
    int tid, lane, wave, vcu, G, gw, ngw;
    GAS unsigned char* ws;
    __device__ __forceinline__ float* MOD() const { return (float*)(ws + WS_MOD); }
    __device__ __forceinline__ float* B1P() const { return (float*)(ws + WS_B1P); }
    __device__ __forceinline__ float* LOG() const { return (float*)(ws + WS_LOG); }
    __device__ __forceinline__ bf16* X() const { return (bf16*)(ws + WS_X); }
    __device__ __forceinline__ v2u* PAIR() const { return (v2u*)(ws + WS_PAIR); }
    __device__ __forceinline__ int* TOK() const { return (int*)(ws + WS_TOK); }
    __device__ __forceinline__ bf16* WINT() const { return (bf16*)(ws + WS_WINT); }
    __device__ __forceinline__ bf16* WOUTT() const { return (bf16*)(ws + WS_WOUTT); }
    __device__ __forceinline__ bf16* WRT() const { return (bf16*)(ws + WS_WRT); }
    __device__ __forceinline__ bf16* W1T() const { return (bf16*)(ws + WS_W1T); }
    __device__ __forceinline__ bf16* W2T() const { return (bf16*)(ws + WS_W2T); }
    __device__ __forceinline__ bf16* HB() const { return (bf16*)(ws + WS_HB); }
    __device__ __forceinline__ bf16* P() const { return (bf16*)(ws + WS_P); }
    __device__ __forceinline__ bf16* Y() const { return (bf16*)(ws + WS_Y); }
    __device__ __forceinline__ bf16* HP() const { return (bf16*)(ws + WS_HP); }
    __device__ __forceinline__ bf16* ACT() const { return (bf16*)(ws + WS_ACT); }
    __device__ __forceinline__ bf16* YP() const { return (bf16*)(ws + WS_YP); }
    __device__ __forceinline__ bf16* OB() const { return (bf16*)(ws + WS_OB); }
    __device__ __forceinline__ unsigned char* HB8() const { return (unsigned char*)(ws + WS_HB8); }
};
struct Args { const float* in[24]; float* out; unsigned char* ws; int ph_lo, ph_hi; };

__device__ __forceinline__ int w_in_row(int c) { const int r = c & 255; return (c & ~255) + (((r >> 5) & 1) << 7) + ((r >> 6) << 5) + (r & 31); }
__device__ __forceinline__ int w1_row(int n) { const int a = n >> 1; return ((a >> 7) << 8) + ((n & 1) << 7) + (a & 127); }
template <int MODE>
__device__ __forceinline__ void transpose_item(const float* W, int K, int N, bf16* WT, LAS float* scr, int item, int lane) {
    const int nblk = N / 32, kb = item / nblk, nb = item % nblk, k0 = 64 * kb, n0 = 32 * nb;
    { f32x4 ld[8]; const int r8 = lane >> 3, c4 = (lane & 7) * 4;
#pragma unroll
      for (int i = 0; i < 8; ++i) ld[i] = __builtin_nontemporal_load((const f32x4*)(W + (size_t)(k0 + 8 * i + r8) * N + n0 + c4));
#pragma unroll
      for (int i = 0; i < 8; ++i) { LAS float* d = scr + (8 * i + r8) * 33 + c4; d[0] = ld[i].x; d[1] = ld[i].y; d[2] = ld[i].z; d[3] = ld[i].w; } }
    LDS_WAIT(); asm volatile("" ::: "memory");
    const int c = lane & 7;
#pragma unroll
    for (int j = 0; j < 4; ++j) { const int n = (lane >> 3) + 8 * j; const LAS float* s = scr + (8 * c) * 33 + n;
        v4u o; o.x = pk2(s[0 * 33], s[1 * 33]); o.y = pk2(s[2 * 33], s[3 * 33]); o.z = pk2(s[4 * 33], s[5 * 33]); o.w = pk2(s[6 * 33], s[7 * 33]);
        const int orow = MODE == 1 ? w1_row(n0 + n) : MODE == 2 ? w_in_row(n0 + n) : (n0 + n);
        *(GAS v4u*)(WT + (size_t)orow * K + k0 + 8 * c) = o; }
    LDS_WAIT(); asm volatile("" ::: "memory");
}
template <int MODE>
__device__ __forceinline__ void transpose_item8(const float* W, int K, int N, unsigned char* WT, LAS float* scr, int item, int lane) {
    const int nblk = N / 32, kb = item / nblk, nb = item % nblk, k0 = 64 * kb, n0 = 32 * nb;
    { f32x4 ld[8]; const int r8 = lane >> 3, c4 = (lane & 7) * 4;
#pragma unroll
      for (int i = 0; i < 8; ++i) ld[i] = __builtin_nontemporal_load((const f32x4*)(W + (size_t)(k0 + 8 * i + r8) * N + n0 + c4));
#pragma unroll
      for (int i = 0; i < 8; ++i) { LAS float* d = scr + (8 * i + r8) * 33 + c4; d[0] = ld[i].x; d[1] = ld[i].y; d[2] = ld[i].z; d[3] = ld[i].w; } }
    LDS_WAIT(); asm volatile("" ::: "memory");
    const int n = lane >> 1, h = lane & 1; const LAS float* s = scr + (32 * h) * 33 + n;
    unsigned w[8];
#pragma unroll
    for (int q = 0; q < 8; ++q) { int p = __builtin_amdgcn_cvt_pk_fp8_f32(s[(4 * q) * 33] * 32.0f, s[(4 * q + 1) * 33] * 32.0f, 0, false); p = __builtin_amdgcn_cvt_pk_fp8_f32(s[(4 * q + 2) * 33] * 32.0f, s[(4 * q + 3) * 33] * 32.0f, p, true); w[q] = (unsigned)p; }
    const int orow = MODE == 1 ? w1_row(n0 + n) : MODE == 2 ? w_in_row(n0 + n) : (n0 + n);
    GAS v4u* dst = (GAS v4u*)(WT + (size_t)orow * K + k0 + 32 * h);
    dst[0] = (v4u){w[0], w[1], w[2], w[3]}; dst[1] = (v4u){w[4], w[5], w[6], w[7]};
    LDS_WAIT(); asm volatile("" ::: "memory");
}
template <int MODE>
__device__ __forceinline__ void transpose_item8w(const float* W, int K, int N, unsigned char* WT, LAS float* scr, int item, int lane) {
    const int nblk = N / 64, kb = item / nblk, nb = item % nblk, k0 = 64 * kb, n0 = 64 * nb;
    { f32x4 ld[16]; const int r4 = lane >> 4, c4 = (lane & 15) * 4;
#pragma unroll
      for (int i = 0; i < 16; ++i) ld[i] = *(const f32x4*)(W + (size_t)(k0 + 4 * i + r4) * N + n0 + c4);
#pragma unroll
      for (int i = 0; i < 16; ++i) { LAS float* d = scr + (4 * i + r4) * 65 + c4; d[0] = ld[i].x; d[1] = ld[i].y; d[2] = ld[i].z; d[3] = ld[i].w; } }
    LDS_WAIT(); asm volatile("" ::: "memory");
    const LAS float* s = scr + lane;
    const int orow = MODE == 1 ? w1_row(n0 + lane) : (n0 + lane);
    GAS v4u* dst = (GAS v4u*)(WT + (size_t)orow * K + k0);
#pragma unroll
    for (int g4 = 0; g4 < 4; ++g4) { unsigned w[4];
#pragma unroll
        for (int q = 0; q < 4; ++q) { const int kk = 16 * g4 + 4 * q; int p = __builtin_amdgcn_cvt_pk_fp8_f32(s[kk * 65] * 32.0f, s[(kk + 1) * 65] * 32.0f, 0, false); p = __builtin_amdgcn_cvt_pk_fp8_f32(s[(kk + 2) * 65] * 32.0f, s[(kk + 3) * 65] * 32.0f, p, true); w[q] = (unsigned)p; }
        dst[g4] = (v4u){w[0], w[1], w[2], w[3]}; }
    LDS_WAIT(); asm volatile("" ::: "memory");
}
struct WSrc { const float *w_in, *w_out, *w_e1, *w_e2; };
constexpr int CV_IN = 16 * 64, CV_OUT = 16 * 32, CV_E1 = 16 * 64, CV_E2 = 16 * 32, CV_PER_L = CV_IN + CV_OUT + NE * CV_E1 + NE * CV_E2;
__device__ __forceinline__ void convert_item(const Ctx& C, const WSrc& W, int l, int r, LAS float* scr, int lane) {
    if (r < CV_IN) { transpose_item<2>(W.w_in + (size_t)l * 1024 * 2048, 1024, 2048, C.WINT() + (size_t)l * 2048 * 1024, scr, r, lane); return; } r -= CV_IN;
    if (r < CV_OUT) { transpose_item<0>(W.w_out + (size_t)l * 1024 * 1024, 1024, 1024, C.WOUTT() + (size_t)l * 1024 * 1024, scr, r, lane); return; } r -= CV_OUT;
    if (r < NE * CV_E1) { const int e = r / CV_E1; transpose_item8<1>(W.w_e1 + ((size_t)l * NE + e) * 1024 * 2048, 1024, 2048, (unsigned char*)C.W1T() + ((size_t)l * NE + e) * 2048 * 1024, scr, r % CV_E1, lane); return; } r -= NE * CV_E1;
    { const int e = r / CV_E2; transpose_item8<0>(W.w_e2 + ((size_t)l * NE + e) * 1024 * 1024, 1024, 1024, (unsigned char*)C.W2T() + ((size_t)l * NE + e) * 1024 * 1024, scr, r % CV_E2, lane); }
}
constexpr int CV_TAIL = 6;
__device__ __forceinline__ int tail_items(int nwg, int G) { const int rem = nwg % G; return rem ? (G - rem) * NWAVES * CV_TAIL : 0; }
__device__ __forceinline__ void tail_convert(const Ctx& C, int l, int nwg, int first) {
    const int rem = nwg % C.G, c = (int)blockIdx.x; if (rem == 0 || c < rem) return;
    WSrc W; W.w_in = ldin<8>(); W.w_out = ldin<17>(); W.w_e1 = ldin<20>(); W.w_e2 = ldin<22>();
    LAS float* scr = (LAS float*)(C.lds + C.wave * 8448);
    const int stride = (C.G - rem) * NWAVES; int it = first + (c - rem) * NWAVES + C.wave;
#pragma unroll 1
    for (int k = 0; k < CV_TAIL; ++k, it += stride) if (it < CV_PER_L) convert_item(C, W, l, it, scr, C.lane);
}
__device__ __forceinline__ void convert_bias(const Ctx& C, const float* b_e1, int l) {
    for (int i = C.gw * 64 + C.lane; i < NE * 2048; i += C.ngw * 64) { const int n = i & 2047; C.B1P()[(size_t)l * NE * 2048 + (i & ~2047) + w1_row(n)] = b_e1[(size_t)l * NE * 2048 + i]; }
}
__device__ __forceinline__ void phase_prologue(const Ctx& C, const Args& A) {
    __syncthreads();
    {
        LAS float* sS = (LAS float*)C.lds;
        const float* cin = ldin<1>(); const float* cctx = ldin<3>(); const float* wada = ldin<4>(); const float* bada = ldin<5>();
        for (int i = C.tid; i < 17 * 1024; i += NWAVES * 64) { const int j = i >> 10, k = i & 1023; const float v = j < 16 ? cin[j * 1024 + k] : cctx[k]; sS[i] = v * sigmoidf_(v); }
        __syncthreads();
        const int kl = C.tid & 15, cg = C.tid >> 4;
        for (int item = blockIdx.x; item < NL * 48; item += C.G) {
            const int l = item / 48, c0 = (item % 48) * 128 + 4 * cg;
            const float* W = wada + (size_t)l * 1024 * MODW + c0;
            f32x4 acc[17];
#pragma unroll
            for (int j = 0; j < 17; ++j) acc[j] = (f32x4){0.f, 0.f, 0.f, 0.f};
#pragma unroll 1
            for (int k0 = kl; k0 < 1024; k0 += 64) { f32x4 w[4];
#pragma unroll
                for (int u = 0; u < 4; ++u) w[u] = __builtin_nontemporal_load((const f32x4*)(W + (size_t)(k0 + 16 * u) * MODW));
#pragma unroll
                for (int u = 0; u < 4; ++u)
#pragma unroll
                    for (int j = 0; j < 17; ++j) acc[j] += sS[j * 1024 + k0 + 16 * u] * w[u]; }
#pragma unroll
            for (int j = 0; j < 17; ++j)
#pragma unroll
                for (int o = 1; o < 16; o <<= 1) { acc[j].x += shx(acc[j].x, o); acc[j].y += shx(acc[j].y, o); acc[j].z += shx(acc[j].z, o); acc[j].w += shx(acc[j].w, o); }
            if (kl == 0) { const f32x4 bv = *(const f32x4*)(bada + (size_t)l * MODW + c0);
#pragma unroll
                for (int j = 0; j < 17; ++j) *(f32x4*)(C.MOD() + ((size_t)l * 17 + j) * MODW + c0) = acc[j] + bv; }
        }
        __syncthreads();
    }
    {
        LAS float* scr = (LAS float*)(C.lds + C.wave * 8448);
        WSrc W; W.w_in = ldin<8>(); W.w_out = ldin<17>(); W.w_e1 = ldin<20>(); W.w_e2 = ldin<22>();
        for (int it = C.gw; it < CV_PER_L; it += C.ngw) convert_item(C, W, 0, it, scr, C.lane);
        convert_bias(C, ldin<21>(), 0);
    }
}

__device__ __forceinline__ void moe_tables(const Ctx& C, int l, bool with_t2e) {
    __syncthreads();
    if (C.tid < NE) C.MISC[40 + C.tid] = __hip_atomic_load(C.ctl + CW_CNT + (l * NE + C.tid) * 64, RLX_AGENT);
    __syncthreads();
    if (C.tid == 0) { unsigned s = 0;
#pragma unroll 1
        for (int e = 0; e < NE; ++e) { C.MISC[e] = s; s += (C.MISC[40 + e] + 255u) >> 8; } C.MISC[NE] = s; }
    __syncthreads();
    if (with_t2e) { LAS unsigned char* t2e = (LAS unsigned char*)(C.lds + T2E_OFF);
        for (int rt = C.tid; rt < MAXRT; rt += NWAVES * 64) { unsigned e = 0;
#pragma unroll 1
            for (int k = 1; k < NE; ++k) e += (C.MISC[k] <= (unsigned)rt) ? 1u : 0u;
            t2e[rt] = (unsigned char)e; }
        __syncthreads(); }
}

__device__ __forceinline__ void row_bt(int r, int& b, int& t, int& j) { b = r / SEG; t = r - b * SEG; j = t < SQ ? b : 16; }
__device__ __forceinline__ void wave_rows(const Ctx& C, int n, int& rbeg, int& rend) { const int rpw = (n + C.ngw - 1) / C.ngw; rbeg = C.gw * rpw; rend = rbeg + rpw < n ? rbeg + rpw : n; }
__device__ __forceinline__ int colq(int q, int lane) { return 512 * (q >> 1) + 8 * lane + 4 * (q & 1); }
__device__ __forceinline__ void bf8_to_f32(v4u w, f32x4& a, f32x4& b) { a = (f32x4){bflo(w.x), bfhi(w.x), bflo(w.y), bfhi(w.y)}; b = (f32x4){bflo(w.z), bfhi(w.z), bflo(w.w), bfhi(w.w)}; }
__device__ __forceinline__ v4u f32_to_bf8(f32x4 a, f32x4 b) { return (v4u){pk2(a.x, a.y), pk2(a.z, a.w), pk2(b.x, b.y), pk2(b.z, b.w)}; }
__device__ __forceinline__ void fp8x8_to_f32(v2u w, f32x4& a, f32x4& b) {
    const unsigned w0 = w.x, w1 = w.y;
    const f32x2 p0 = __builtin_amdgcn_cvt_pk_f32_fp8((int)w0, false), p1 = __builtin_amdgcn_cvt_pk_f32_fp8((int)w0, true), p2 = __builtin_amdgcn_cvt_pk_f32_fp8((int)w1, false), p3 = __builtin_amdgcn_cvt_pk_f32_fp8((int)w1, true);
    a = (f32x4){p0.x, p0.y, p1.x, p1.y}; b = (f32x4){p2.x, p2.y, p3.x, p3.y}; }
__device__ __forceinline__ v2u f32_to_fp8x8(f32x4 a, f32x4 b) {
    int p0 = __builtin_amdgcn_cvt_pk_fp8_f32(a.x, a.y, 0, false); p0 = __builtin_amdgcn_cvt_pk_fp8_f32(a.z, a.w, p0, true);
    int p1 = __builtin_amdgcn_cvt_pk_fp8_f32(b.x, b.y, 0, false); p1 = __builtin_amdgcn_cvt_pk_fp8_f32(b.z, b.w, p1, true);
    return (v2u){(unsigned)p0, (unsigned)p1}; }
__device__ __forceinline__ void modulate2(const f32x4 (&v)[2][4], const f32x4 (&gv)[4], const float* const (&mj)[2], int sh_chunk, f32x4 (&h)[2][4], int lane) {
    f32x4 sh[2][4], sc[2][4]; float ss[2];
#pragma unroll
    for (int u = 0; u < 2; ++u) { ss[u] = 0.f;
#pragma unroll
        for (int q = 0; q < 4; ++q) { const int c = colq(q, lane); sh[u][q] = *(const f32x4*)(mj[u] + sh_chunk * D + c); sc[u][q] = *(const f32x4*)(mj[u] + (sh_chunk + 1) * D + c); ss[u] += sum4(v[u][q] * v[u][q]); } }
    ss[0] = wsum(ss[0]); ss[1] = wsum(ss[1]);
#pragma unroll
    for (int u = 0; u < 2; ++u) { const float rs = __builtin_amdgcn_rsqf(ss[u] * (1.0f / D) + EPS);
#pragma unroll
        for (int q = 0; q < 4; ++q) h[u][q] = (v[u][q] * rs) * gv[q] * (1.0f + sc[u][q]) + sh[u][q]; }
}
__device__ __forceinline__ void pair_load2(const Ctx& C, const int (&r)[2], v2u (&pr)[2][4]) {
#pragma unroll
    for (int u = 0; u < 2; ++u)
#pragma unroll
        for (int k = 0; k < 4; ++k) pr[u][k] = C.PAIR()[(size_t)r[u] * 4 + k];
}
__device__ __forceinline__ void moe_combine2(const Ctx& C, const v2u (&pr)[2][4], f32x4 (&acc)[2][4]) {
    v2u y[2][4][2];
#pragma unroll
    for (int u = 0; u < 2; ++u)
#pragma unroll
        for (int k = 0; k < 4; ++k) { const unsigned px = pr[u][k].x; const unsigned e = px & 31u, pos = px >> 5;
            const unsigned char* yp = (const unsigned char*)C.YP() + ((size_t)C.MISC[e] * 256 + pos) * D + 8 * C.lane;
#pragma unroll
            for (int jj = 0; jj < 2; ++jj) y[u][k][jj] = __builtin_nontemporal_load((const GAS v2u*)(yp + 512 * jj)); }
#pragma unroll
    for (int u = 0; u < 2; ++u) {
#pragma unroll
        for (int q = 0; q < 4; ++q) acc[u][q] = (f32x4){0.f, 0.f, 0.f, 0.f};
#pragma unroll
        for (int k = 0; k < 4; ++k) { const unsigned wb = pr[u][k].y; const float wt = __uint_as_float(wb) * 0.125f;
#pragma unroll
            for (int jj = 0; jj < 2; ++jj) { f32x4 ya, yb; fp8x8_to_f32(y[u][k][jj], ya, yb); acc[u][2 * jj] += wt * ya; acc[u][2 * jj + 1] += wt * yb; } } }
}
__device__ __forceinline__ void ld_x2(const Ctx& C, const bf16* base, const int (&r)[2], f32x4 (&v)[2][4]) {
#pragma unroll
    for (int u = 0; u < 2; ++u)
#pragma unroll
        for (int jj = 0; jj < 2; ++jj) bf8_to_f32(__builtin_nontemporal_load((const GAS v4u*)(base + (size_t)r[u] * D + 512 * jj + 8 * C.lane)), v[u][2 * jj], v[u][2 * jj + 1]);
}

__device__ __forceinline__ void phase_premix(const Ctx& C, const Args& A, int l) {
    if (l > 0) moe_tables(C, l - 1, false);
    const float* modl = C.MOD() + (size_t)l * 17 * MODW; const float* modp = C.MOD() + (size_t)(l > 0 ? l - 1 : 0) * 17 * MODW;
    const float* g = ldin<6>() + (size_t)l * D; const float* xin = ldin<0>(); const float* cxin = ldin<2>();
    f32x4 gv[4];
#pragma unroll
    for (int q = 0; q < 4; ++q) gv[q] = *(const f32x4*)(g + colq(q, C.lane));
    int rbeg, rend; wave_rows(C, T, rbeg, rend);
    v2u pr[2][4]; if (l > 0 && rbeg < rend) { const int rf[2] = {rbeg, rbeg + 1 < rend ? rbeg + 1 : rbeg}; pair_load2(C, rf, pr); }
    int jc = -1; f32x4 gtc[4], shc[4], gsc[4];
#pragma unroll
    for (int q = 0; q < 4; ++q) { gtc[q] = gv[q]; shc[q] = gv[q]; gsc[q] = gv[q]; }
    for (int r0 = rbeg; r0 < rend; r0 += 2) {
        const int r[2] = {r0, r0 + 1 < rend ? r0 + 1 : r0};
        int b[2], t[2], j[2]; row_bt(r[0], b[0], t[0], j[0]); row_bt(r[1], b[1], t[1], j[1]);
        f32x4 v[2][4];
        if (l == 0) {
#pragma unroll
            for (int u = 0; u < 2; ++u) { const float* src = t[u] < SQ ? xin + ((size_t)b[u] * SQ + t[u]) * D : cxin + ((size_t)b[u] * CL + (t[u] - SQ)) * D;
#pragma unroll
                for (int q = 0; q < 4; ++q) v[u][q] = __builtin_nontemporal_load((const f32x4*)(src + colq(q, C.lane))); }
        } else {
            ld_x2(C, C.OB(), r, v);
            v2u prn[2][4]; { const int a = r0 + 2 < rend ? r0 + 2 : r0, b2 = r0 + 3 < rend ? r0 + 3 : a; const int rn[2] = {a, b2}; pair_load2(C, rn, prn); }
            f32x4 acc[2][4]; moe_combine2(C, pr, acc);
#pragma unroll
            for (int u = 0; u < 2; ++u)
#pragma unroll
                for (int k = 0; k < 4; ++k) pr[u][k] = prn[u][k];
            if (j[0] != jc) {
#pragma unroll
                for (int q = 0; q < 4; ++q) gtc[q] = *(const f32x4*)(modp + (size_t)j[0] * MODW + 5 * D + colq(q, C.lane)); }
#pragma unroll
            for (int u = 0; u < 2; ++u) {
                if (j[u] == j[0]) {
#pragma unroll
                    for (int q = 0; q < 4; ++q) v[u][q] += gtc[q] * acc[u][q]; }
                else {
#pragma unroll
                    for (int q = 0; q < 4; ++q) v[u][q] += *(const f32x4*)(modp + (size_t)j[u] * MODW + 5 * D + colq(q, C.lane)) * acc[u][q]; } } }
        if (j[0] != jc) { jc = j[0]; const float* m = modl + (size_t)jc * MODW;
#pragma unroll
            for (int q = 0; q < 4; ++q) { const int c = colq(q, C.lane); shc[q] = *(const f32x4*)(m + c); gsc[q] = gv[q] * (1.0f + *(const f32x4*)(m + D + c)); } }
        f32x4 h[2][4]; float ss[2];
#pragma unroll
        for (int u = 0; u < 2; ++u) { ss[u] = 0.f;
#pragma unroll
            for (int q = 0; q < 4; ++q) ss[u] += sum4(v[u][q] * v[u][q]); }
        ss[0] = wsum(ss[0]); ss[1] = wsum(ss[1]);
#pragma unroll
        for (int u = 0; u < 2; ++u) { const float rs = __builtin_amdgcn_rsqf(ss[u] * (1.0f / D) + EPS);
            if (j[u] == jc) {
#pragma unroll
                for (int q = 0; q < 4; ++q) h[u][q] = (v[u][q] * rs) * gsc[q] + shc[q]; }
            else { const float* m = modl + (size_t)j[u] * MODW;
#pragma unroll
                for (int q = 0; q < 4; ++q) { const int c = colq(q, C.lane); h[u][q] = (v[u][q] * rs) * (gv[q] * (1.0f + *(const f32x4*)(m + D + c))) + *(const f32x4*)(m + c); } } }
#pragma unroll
        for (int u = 0; u < 2; ++u)
#pragma unroll
            for (int jj = 0; jj < 2; ++jj) { const size_t o = (size_t)r[u] * D + 512 * jj + 8 * C.lane;
                __builtin_nontemporal_store(f32_to_bf8(v[u][2 * jj], v[u][2 * jj + 1]), (GAS v4u*)(C.X() + o));
#if MK_FP8_IN == 1
                *(GAS v2u*)((unsigned char*)C.HB() + o) = f32_to_fp8x8(h[u][2 * jj], h[u][2 * jj + 1]); }
#elif MK_FP8_IN == 2
                *(GAS v4u*)(C.HB() + o) = f32_to_bf8(h[u][2 * jj], h[u][2 * jj + 1]); *(GAS v2u*)(C.HB8() + o) = f32_to_fp8x8(h[u][2 * jj], h[u][2 * jj + 1]); }
#else
                *(GAS v4u*)(C.HB() + o) = f32_to_bf8(h[u][2 * jj], h[u][2 * jj + 1]); }
#endif
    }
}
__device__ __forceinline__ void phase_premoe(const Ctx& C, const Args& A, int l) {
    const float* modl = C.MOD() + (size_t)l * 17 * MODW; const float* g = ldin<7>() + (size_t)l * D;
    typedef __bf16 bf16x2_t __attribute__((ext_vector_type(2)));
    volatile LAS unsigned* lhist = C.MISC + 80; volatile LAS unsigned* lbase = C.MISC + 112;
    __syncthreads();
    { const float* wr = ldin<18>() + (size_t)l * D * NE;
      for (int idx = C.tid; idx < 8 * 4 * 2 * 64; idx += NWAVES * 64) { const int ln = idx & 63, jj = (idx >> 6) & 1, ip = (idx >> 7) & 3, e4 = idx >> 9;
          const float* w0 = wr + (size_t)(512 * jj + 8 * ln + 2 * ip) * NE + 4 * e4; const f32x4 a = *(const f32x4*)w0, b = *(const f32x4*)(w0 + NE);
          ((LAS v4u*)C.lds)[idx] = (v4u){pk2(a.x, b.x), pk2(a.y, b.y), pk2(a.z, b.z), pk2(a.w, b.w)}; }
      if (C.tid < NE) lhist[C.tid] = 0u; }
    __syncthreads();
    f32x4 gv[4];
#pragma unroll
    for (int q = 0; q < 4; ++q) gv[q] = *(const f32x4*)(g + colq(q, C.lane));
    const int half = C.lane >> 5, ex = C.lane & 31;
    const float br = ldin<19>()[l * NE + ex];
    const bool lat = l + 1 == NL;
#define RMAP(q) (lat ? ((q) / SQ) * SEG + (q) % SQ : (q))
    int rbeg, rend; wave_rows(C, lat ? NB * SQ : T, rbeg, rend);
    const bool cv = l + 1 < NL; int cit = tail_items(NROWT * (INW / 256), C.G) + tail_items(NROWT * (D / 256), C.G) + C.gw; LAS float* cscr = (LAS float*)(C.lds + 65536 + C.wave * 8448);
    WSrc W; W.w_in = ldin<8>(); W.w_out = ldin<17>(); W.w_e1 = ldin<20>(); W.w_e2 = ldin<22>();
    v4u ob[2][2];
    if (rbeg < rend) { const int ra = RMAP(rbeg), rb = RMAP(rbeg + 1 < rend ? rbeg + 1 : rbeg);
#pragma unroll
        for (int jj = 0; jj < 2; ++jj) { ob[0][jj] = __builtin_nontemporal_load((const GAS v4u*)(C.OB() + (size_t)ra * D + 512 * jj + 8 * C.lane)); ob[1][jj] = __builtin_nontemporal_load((const GAS v4u*)(C.OB() + (size_t)rb * D + 512 * jj + 8 * C.lane)); } }
    int jc = -1; f32x4 shc[4], gsc[4];
#pragma unroll
    for (int q = 0; q < 4; ++q) { shc[q] = gv[q]; gsc[q] = gv[q]; }
    for (int r0 = rbeg; r0 < rend; r0 += 2) {
        const bool two = r0 + 1 < rend; const int r[2] = {RMAP(r0), RMAP(two ? r0 + 1 : r0)};
        int b[2], t[2], j[2]; row_bt(r[0], b[0], t[0], j[0]); row_bt(r[1], b[1], t[1], j[1]);
        f32x4 v[2][4];
#pragma unroll
        for (int u = 0; u < 2; ++u)
#pragma unroll
            for (int jj = 0; jj < 2; ++jj) bf8_to_f32(ob[u][jj], v[u][2 * jj], v[u][2 * jj + 1]);
        { const int qa = r0 + 2 < rend ? r0 + 2 : r0, qb = r0 + 3 < rend ? r0 + 3 : qa; const int ra = RMAP(qa), rb = RMAP(qb);
#pragma unroll
          for (int jj = 0; jj < 2; ++jj) { ob[0][jj] = __builtin_nontemporal_load((const GAS v4u*)(C.OB() + (size_t)ra * D + 512 * jj + 8 * C.lane)); ob[1][jj] = __builtin_nontemporal_load((const GAS v4u*)(C.OB() + (size_t)rb * D + 512 * jj + 8 * C.lane)); } }
        if (j[0] != jc) { jc = j[0]; const float* m = modl + (size_t)jc * MODW + 3 * D;
#pragma unroll
            for (int q = 0; q < 4; ++q) { const int c = colq(q, C.lane); shc[q] = *(const f32x4*)(m + c); gsc[q] = gv[q] * (1.0f + *(const f32x4*)(m + D + c)); } }
        f32x4 h[2][4]; float ss[2];
#pragma unroll
        for (int u = 0; u < 2; ++u) { ss[u] = 0.f;
#pragma unroll
            for (int q = 0; q < 4; ++q) ss[u] += sum4(v[u][q] * v[u][q]); }
        ss[0] = wsum(ss[0]); ss[1] = wsum(ss[1]);
#pragma unroll
        for (int u = 0; u < 2; ++u) { const float rs = __builtin_amdgcn_rsqf(ss[u] * (1.0f / D) + EPS);
            if (j[u] == jc) {
#pragma unroll
                for (int q = 0; q < 4; ++q) h[u][q] = (v[u][q] * rs) * gsc[q] + shc[q]; }
            else { const float* m = modl + (size_t)j[u] * MODW + 3 * D;
#pragma unroll
                for (int q = 0; q < 4; ++q) { const int c = colq(q, C.lane); h[u][q] = (v[u][q] * rs) * (gv[q] * (1.0f + *(const f32x4*)(m + D + c))) + *(const f32x4*)(m + c); } } }
#pragma unroll
        for (int u = 0; u < 2; ++u)
#pragma unroll
            for (int jj = 0; jj < 2; ++jj) { const size_t o = (size_t)r[u] * D + 512 * jj + 8 * C.lane;
                *(GAS v2u*)(C.HB8() + o) = f32_to_fp8x8(h[u][2 * jj], h[u][2 * jj + 1]); }
        f32x4 pl[2][8];
#pragma unroll
        for (int e4 = 0; e4 < 8; ++e4) { pl[0][e4] = (f32x4){0.f, 0.f, 0.f, 0.f}; pl[1][e4] = pl[0][e4]; }
#pragma unroll
        for (int jj = 0; jj < 2; ++jj)
#pragma unroll
            for (int ip = 0; ip < 4; ++ip) { const int q = 2 * jj + (ip >> 1), c0 = 2 * (ip & 1);
                const bf16x2_t h0 = __builtin_bit_cast(bf16x2_t, pk2(h[0][q][c0], h[0][q][c0 + 1])), h1 = __builtin_bit_cast(bf16x2_t, pk2(h[1][q][c0], h[1][q][c0 + 1]));
#pragma unroll
                for (int e4 = 0; e4 < 8; ++e4) { const v4u w = ((const LAS v4u*)C.lds)[((e4 * 4 + ip) * 2 + jj) * 64 + C.lane];
                    const unsigned wx[4] = {w.x, w.y, w.z, w.w};
#pragma unroll
                    for (int x = 0; x < 4; ++x) { const bf16x2_t wb = __builtin_bit_cast(bf16x2_t, wx[x]);
                        pl[0][e4][x] = __builtin_amdgcn_fdot2_f32_bf16(h0, wb, pl[0][e4][x], false); pl[1][e4][x] = __builtin_amdgcn_fdot2_f32_bf16(h1, wb, pl[1][e4][x], false); } } }
        float s32[32];
#pragma unroll
        for (int e = 0; e < 32; ++e) { const auto r = __builtin_amdgcn_permlane32_swap(__float_as_uint(pl[0][e >> 2][e & 3]), __float_as_uint(pl[1][e >> 2][e & 3]), false, false); s32[e] = __uint_as_float(r[0]) + __uint_as_float(r[1]); }
        float s16[16];
#pragma unroll
        for (int e = 0; e < 16; ++e) { const auto r = __builtin_amdgcn_permlane16_swap(__float_as_uint(s32[e]), __float_as_uint(s32[16 + e]), false, false); s16[e] = __uint_as_float(r[0]) + __uint_as_float(r[1]); }
        float s8[8];
#pragma unroll
        for (int e = 0; e < 8; ++e) { const bool hi = (C.lane & 8) != 0; const float keep = hi ? s16[8 + e] : s16[e], send = hi ? s16[e] : s16[8 + e]; s8[e] = keep + dpp_f<0x128>(send); }
        float s4[4];
#pragma unroll
        for (int e = 0; e < 4; ++e) { const bool hi = (C.lane & 4) != 0; const float keep = hi ? s8[4 + e] : s8[e], send = hi ? s8[e] : s8[4 + e]; s4[e] = keep + dpp_f<0x1B>(dpp_f<0x141>(send)); }
        float s2[2];
#pragma unroll
        for (int e = 0; e < 2; ++e) { const bool hi = (C.lane & 2) != 0; const float keep = hi ? s4[2 + e] : s4[e], send = hi ? s4[e] : s4[2 + e]; s2[e] = keep + dpp_f<0x4E>(send); }
        float lg; { const bool hi = (C.lane & 1) != 0; const float keep = hi ? s2[1] : s2[0], send = hi ? s2[0] : s2[1]; lg = keep + dpp_f<0xB1>(send); }
        const float vv = lg + br; const int vb = __float_as_int(vv);
        float cur = vv; int rank = 4; float sv[4];
#pragma unroll
        for (int k = 0; k < 4; ++k) { float m = cur; m = __builtin_fmaxf(m, dpp_f<0xB1>(m)); m = __builtin_fmaxf(m, dpp_f<0x4E>(m)); m = __builtin_fmaxf(m, dpp_f<0x141>(m)); m = __builtin_fmaxf(m, dpp_f<0x140>(m));
            { const auto rr = __builtin_amdgcn_permlane16_swap(__float_as_uint(m), __float_as_uint(m), false, false); m = __builtin_fmaxf(__uint_as_float(rr[0]), __uint_as_float(rr[1])); }
            sv[k] = m;
            const unsigned long long mk = __ballot(cur == m); const int s0 = (int)__builtin_ctz((unsigned)mk | 0x80000000u), s1 = (int)__builtin_ctz((unsigned)(mk >> 32) | 0x80000000u);
            if (ex == (half ? s1 : s0)) { rank = k; cur = -INFINITY; } }
        const float inv = __builtin_amdgcn_rcpf(1.0f + __expf(sv[1] - sv[0]) + __expf(sv[2] - sv[0]) + __expf(sv[3] - sv[0]));
        if (rank < 4 && (half == 0 || two)) { const int rr = r[half];
            const unsigned lpos = __hip_atomic_fetch_add((LAS unsigned*)(C.lds + MISC_OFF) + 80 + ex, 1u, __ATOMIC_RELAXED, __HIP_MEMORY_SCOPE_WORKGROUP);
            C.PAIR()[(size_t)rr * 4 + rank] = (v2u){(unsigned)ex | (lpos << 5), __float_as_uint(__expf(vv - sv[0]) * inv)}; }
        if (cv) {
#pragma unroll 1
            for (int k = 0; k < 2 && cit < CV_PER_L; ++k, cit += C.ngw) convert_item(C, W, l + 1, cit, cscr, C.lane); }
    }
    if (cv) {
#pragma unroll 1
        for (; cit < CV_PER_L; cit += C.ngw) convert_item(C, W, l + 1, cit, cscr, C.lane);
        convert_bias(C, ldin<21>(), l + 1); }
    __syncthreads();
    gu32* cnt = C.ctl + CW_CNT + (size_t)l * NE * 64;
    if (C.tid < NE) { const unsigned n = lhist[C.tid]; lbase[C.tid] = n ? __hip_atomic_fetch_add(cnt + C.tid * 64, n, RLX_AGENT) : 0u; }
    __syncthreads();
    for (int idx = C.lane; idx < (rend - rbeg) * 4; idx += 64) { const int rr = RMAP(rbeg + (idx >> 2)); gu32* px = (gu32*)C.PAIR() + ((size_t)rr * 4 + (idx & 3)) * 2;
        const unsigned x = __hip_atomic_load(px, RLX_AGENT); const unsigned e = x & 31u, pos = lbase[e] + (x >> 5);
        *px = e | (pos << 5); C.TOK()[(size_t)e * T + pos] = rr; }
    __syncthreads();
#undef RMAP
}
__device__ __forceinline__ void phase_final(const Ctx& C, const Args& A) {
    moe_tables(C, NL - 1, false);
    const float* modp = C.MOD() + (size_t)(NL - 1) * 17 * MODW; float* outp = ldout();
    int qbeg, qend; wave_rows(C, NB * SQ, qbeg, qend);
    v2u pr[2][4]; if (qbeg < qend) { const int qa = qbeg, qb = qbeg + 1 < qend ? qbeg + 1 : qbeg; const int rf[2] = {(qa / SQ) * SEG + qa % SQ, (qb / SQ) * SEG + qb % SQ}; pair_load2(C, rf, pr); }
    int bc = -1; f32x4 gtc[4];
#pragma unroll
    for (int q = 0; q < 4; ++q) gtc[q] = (f32x4){0.f, 0.f, 0.f, 0.f};
    for (int q0 = qbeg; q0 < qend; q0 += 2) {
        const int qq[2] = {q0, q0 + 1 < qend ? q0 + 1 : q0}; const int b[2] = {qq[0] / SQ, qq[1] / SQ}; const int r[2] = {b[0] * SEG + (qq[0] - b[0] * SQ), b[1] * SEG + (qq[1] - b[1] * SQ)};
        f32x4 v[2][4]; ld_x2(C, C.OB(), r, v);
        if (b[0] != bc) { bc = b[0];
#pragma unroll
            for (int q = 0; q < 4; ++q) gtc[q] = *(const f32x4*)(modp + (size_t)bc * MODW + 5 * D + colq(q, C.lane)); }
        v2u prn[2][4]; { const int qa = q0 + 2 < qend ? q0 + 2 : q0, qb = q0 + 3 < qend ? q0 + 3 : qa; const int rn[2] = {(qa / SQ) * SEG + qa % SQ, (qb / SQ) * SEG + qb % SQ}; pair_load2(C, rn, prn); }
        f32x4 acc[2][4]; moe_combine2(C, pr, acc);
#pragma unroll
        for (int u = 0; u < 2; ++u)
#pragma unroll
            for (int k = 0; k < 4; ++k) pr[u][k] = prn[u][k];
#pragma unroll
        for (int u = 0; u < 2; ++u) { float* o = outp + (size_t)qq[u] * D;
            if (b[u] == bc) {
#pragma unroll
                for (int q = 0; q < 4; ++q) __builtin_nontemporal_store(v[u][q] + gtc[q] * acc[u][q], (f32x4*)(o + colq(q, C.lane))); }
            else {
#pragma unroll
                for (int q = 0; q < 4; ++q) *(f32x4*)(o + colq(q, C.lane)) = v[u][q] + *(const f32x4*)(modp + (size_t)b[u] * MODW + 5 * D + colq(q, C.lane)) * acc[u][q]; } }
    }
}

__device__ __forceinline__ v4u qk_piece(v4u w, const float (&gain)[8], bool lat, int pos, int i0, bool first, float scale, const LAS f32x2* rope) {
    float f[8] = {bflo(w.x), bfhi(w.x), bflo(w.y), bfhi(w.y), bflo(w.z), bfhi(w.z), bflo(w.w), bfhi(w.w)};
    float ss = 0.f;
#pragma unroll
    for (int i = 0; i < 8; ++i) ss += f[i] * f[i];
    ss += shx(ss, 1); ss += shx(ss, 2); ss += shx(ss, 4);
    const float rs = __builtin_amdgcn_rsqf(ss * (1.0f / 64.0f) + EPS);
    float o[8];
#pragma unroll
    for (int i = 0; i < 8; ++i) f[i] = f[i] * rs * gain[i];
#pragma unroll
    for (int i = 0; i < 8; ++i) { const float pv = shx(f[i], 2); const f32x2 cs = rope[(pos & 63) * 16 + i0 + i];
        const float rot = first ? f[i] * cs.x - pv * cs.y : f[i] * cs.x + pv * cs.y;
        o[i] = (lat ? rot : f[i]) * scale; }
    v4u ow; ow.x = pk2(o[0], o[1]); ow.y = pk2(o[2], o[3]); ow.z = pk2(o[4], o[5]); ow.w = pk2(o[6], o[7]); return ow;
}
__device__ __forceinline__ void phase_qknorm(const Ctx& C, const Args& A, int l) {
    const LAS f32x2* rope = (const LAS f32x2*)(C.lds + ROPE_OFF);
    const float* gq = ldin<9>() + l * 64; const float* gk = ldin<10>() + l * 64;
    const int d0 = 8 * (C.lane & 7);
    const int ax = d0 >> 5, o0 = d0 & 31; const bool first = o0 < 16; const int i0 = o0 & 15;
    float gqv[8], gkv[8];
#pragma unroll
    for (int i = 0; i < 8; ++i) { gqv[i] = gq[d0 + i]; gkv[i] = gk[d0 + i]; }
    int rbeg, rend; wave_rows(C, T, rbeg, rend);
    for (int r0 = rbeg; r0 < rend; r0 += 4) {
        v4u wq[4]; bool ok[4]; int tt[4];
#pragma unroll
        for (int u = 0; u < 4; ++u) { ok[u] = r0 + u < rend; const int r = ok[u] ? r0 + u : r0; tt[u] = r % SEG; wq[u] = *(const GAS v4u*)(C.P() + (size_t)r * INW + 8 * C.lane); }
        const int uk = C.lane >> 4; const bool okk = r0 + uk < rend; const int rk = okk ? r0 + uk : r0; const int tk = rk % SEG;
        bf16* pk = C.P() + (size_t)rk * INW + 512 + 8 * (C.lane & 15);
        const v4u wk = *(const GAS v4u*)pk;
#pragma unroll
        for (int u = 0; u < 4; ++u) { const bool lat = tt[u] < SQ; const int pos = ax == 0 ? (tt[u] >> 6) : (tt[u] & 63);
            const v4u ow = qk_piece(wq[u], gqv, lat, pos, i0, first, attn_body::C2, rope);
            if (ok[u]) *(GAS v4u*)(C.P() + (size_t)(r0 + u) * INW + 8 * C.lane) = ow; }
        { const bool lat = tk < SQ; const int pos = ax == 0 ? (tk >> 6) : (tk & 63);
          const v4u ow = qk_piece(wk, gkv, lat, pos, i0, first, 1.0f, rope);
          if (okk) *(GAS v4u*)pk = ow; }
    }
}

__device__ __forceinline__ void attn_gnorm(const Ctx& C, size_t row0, const float* gg) {
    const f32x4 gA0 = *(const f32x4*)(gg + 8 * C.lane), gA1 = *(const f32x4*)(gg + 8 * C.lane + 4);
    bf16* y0 = C.Y() + (row0 + C.wave * 32) * D + 8 * C.lane;
#pragma unroll 1
    for (int i = 0; i < 32; i += 16) {
        v4u av[16]; float qa[16];
#pragma unroll
        for (int u = 0; u < 16; ++u) av[u] = *(const GAS v4u*)(y0 + (size_t)(i + u) * D);
#pragma unroll
        for (int u = 0; u < 16; ++u) { const f32x4 a0 = bf4((v2u){av[u].x, av[u].y}), a1 = bf4((v2u){av[u].z, av[u].w}); qa[u] = sum4(a0 * a0) + sum4(a1 * a1); }
#pragma unroll
        for (int u = 0; u < 16; ++u) qa[u] = wsum(qa[u]);
#pragma unroll
        for (int u = 0; u < 16; ++u) { const float rsa = __builtin_amdgcn_rsqf(qa[u] * (1.0f / 512.0f) + EPS);
            const f32x4 a0 = bf4((v2u){av[u].x, av[u].y}), a1 = bf4((v2u){av[u].z, av[u].w});
            const v2u o0 = pk4(a0 * rsa * gA0), o1 = pk4(a1 * rsa * gA1);
            *(GAS v4u*)(y0 + (size_t)(i + u) * D) = (v4u){o0.x, o0.y, o1.x, o1.y}; }
    }
}
template <bool FIXR> __device__ __forceinline__ void phase_attn_impl(const Ctx& C, int l) {
    char* shm = (char*)C.lds;
    const attn_body::bf16* Pq = (const attn_body::bf16*)C.P(); attn_body::bf16* Yo = (attn_body::bf16*)C.Y();
    const float* gg = ldin<16>() + (size_t)l * D;
    gu32* cc = C.ctl + CW_CTX + (size_t)l * NB * 16;
    if (l + 1 < NL)
    for (int u = C.G - 1 - C.vcu; u < NB * 8; u += C.G) { const int h = u & 7, b = u >> 3;
        attn_body::attn_unit<8, FIXR>((long)b * SEG + SQ, (long)b * SEG + SQ, CL / 64, h, Pq, Yo, shm);
        asm volatile("s_waitcnt vmcnt(0)" ::: "memory"); __syncthreads();
        if (C.tid == 0) { __builtin_amdgcn_fence(__ATOMIC_RELEASE, "agent"); C.MISC[164] = __hip_atomic_fetch_add(cc + b * 16, 1u, RLX_AGENT); }
        __syncthreads();
        if ((C.MISC[164] & 7u) == 7u) { __builtin_amdgcn_fence(__ATOMIC_ACQUIRE, "agent"); attn_gnorm(C, (size_t)b * SEG + SQ, gg); }
        __syncthreads(); }
    for (int u = C.vcu; u < NB * 16; u += C.G) { const int qb = u & 15, b = u >> 4;
#pragma unroll 1
        for (int h = 0; h < 8; ++h) attn_body::attn_unit<8, FIXR>((long)b * SEG + qb * 256, (long)b * SEG, SEG / 64, h, Pq, Yo, shm);
        asm volatile("s_waitcnt vmcnt(0)" ::: "memory"); __syncthreads();
        attn_gnorm(C, (size_t)b * SEG + qb * 256, gg); }
}

__device__ __forceinline__ void phase_attn(const Ctx& C, int l) {
    float gq = __builtin_fabsf(ldin<9>()[l * 64 + C.lane]), gk = __builtin_fabsf(ldin<10>()[l * 64 + C.lane]);
    gq = __builtin_fmaxf(gq, dpp_f<0xB1>(gq)); gq = __builtin_fmaxf(gq, dpp_f<0x4E>(gq)); gq = __builtin_fmaxf(gq, dpp_f<0x141>(gq)); gq = __builtin_fmaxf(gq, dpp_f<0x140>(gq));
    gk = __builtin_fmaxf(gk, dpp_f<0xB1>(gk)); gk = __builtin_fmaxf(gk, dpp_f<0x4E>(gk)); gk = __builtin_fmaxf(gk, dpp_f<0x141>(gk)); gk = __builtin_fmaxf(gk, dpp_f<0x140>(gk));
    float bq = 0.f, bk = 0.f;
#pragma unroll
    for (int i = 0; i < 4; ++i) { bq = __builtin_fmaxf(bq, __int_as_float(__builtin_amdgcn_readlane(__float_as_int(gq), 16 * i))); bk = __builtin_fmaxf(bk, __int_as_float(__builtin_amdgcn_readlane(__float_as_int(gk), 16 * i))); }
    const float bound = 11.8f * bq * bk;
    if (bound < 60.0f) phase_attn_impl<true>(C, l); else phase_attn_impl<false>(C, l);
}

__device__ __forceinline__ void phase_conv1(const Ctx& C, const Args& A, int l) {
    __syncthreads();
    LAS float* zL = (LAS float*)C.lds;
    const int c4 = 4 * C.lane;
    {
        f32x4 wk[31]; const float* wdw = ldin<11>();
#pragma unroll
        for (int jt = 0; jt < 31; ++jt) wk[jt] = *(const f32x4*)(wdw + ((size_t)l * 31 + jt) * 256 + c4);
        const f32x4 b31 = *(const f32x4*)(ldin<12>() + l * 256 + c4), gln = *(const f32x4*)(ldin<13>() + l * 256 + c4), bln = *(const f32x4*)(ldin<14>() + l * 256 + c4);
        const f32x4 gC = *(const f32x4*)(ldin<16>() + (size_t)l * D + 512 + c4);
        gu32* tq = C.ctl + CW_CQ + l * 16;
        for (int tile = C.vcu; tile < T / 64; ) {
            const int b = tile / 68, tt = tile - b * 68, t0 = tt * 64;
            const int seg_lo = tt < 64 ? 0 : SQ, seg_hi = tt < 64 ? SQ : SEG;
            const size_t rbase = (size_t)b * SEG;
            if (!(l + 1 == NL && tt >= 64)) {
            __syncthreads();
            { v2u ra[12], rg[12];
#pragma unroll
              for (int i = 0; i < 12; ++i) { const int zr = C.wave + 8 * i, t = t0 - 15 + zr; const bool ok = zr < 94 && t >= seg_lo && t < seg_hi;
                  const bf16* p = C.P() + (rbase + (ok ? t : t0)) * INW; ra[i] = *(const GAS v2u*)(p + 768 + c4); rg[i] = *(const GAS v2u*)(p + 1024 + c4); }
#pragma unroll
              for (int i = 0; i < 12; ++i) { const int zr = C.wave + 8 * i, t = t0 - 15 + zr; const bool ok = t >= seg_lo && t < seg_hi;
                  if (zr < 94) { const f32x4 a = bf4(ra[i]), gt = bf4(rg[i]);
                      const f32x4 z = ok ? (f32x4){a.x * sigmoidf_(gt.x), a.y * sigmoidf_(gt.y), a.z * sigmoidf_(gt.z), a.w * sigmoidf_(gt.w)} : (f32x4){0.f, 0.f, 0.f, 0.f};
                      *(LAS f32x4*)(zL + zr * 256 + c4) = z; } } }
            __syncthreads();
            for (int g = 0; g < 2; ++g) { const int i0 = C.wave * 8 + 4 * g;
                f32x4 u[4] = {b31, b31, b31, b31};
#pragma unroll
                for (int j = 0; j < 34; ++j) { const f32x4 z = *(const LAS f32x4*)(zL + (i0 + j) * 256 + c4);
#pragma unroll
                    for (int t = 0; t < 4; ++t) if (j - t >= 0 && j - t < 31) u[t] += wk[j - t] * z; }
                float s[4], vq[4], qq[4]; f32x4 d[4], cf[4];
#pragma unroll
                for (int t = 0; t < 4; ++t) s[t] = sum4(u[t]);
#pragma unroll
                for (int t = 0; t < 4; ++t) s[t] = wsum(s[t]);
#pragma unroll
                for (int t = 0; t < 4; ++t) { d[t] = u[t] - s[t] * (1.0f / 256.0f); vq[t] = sum4(d[t] * d[t]); }
#pragma unroll
                for (int t = 0; t < 4; ++t) vq[t] = wsum(vq[t]);
#pragma unroll
                for (int t = 0; t < 4; ++t) { const f32x4 y = d[t] * __builtin_amdgcn_rsqf(vq[t] * (1.0f / 256.0f) + EPS) * gln + bln;
                    cf[t] = (f32x4){y.x * sigmoidf_(y.x), y.y * sigmoidf_(y.y), y.z * sigmoidf_(y.z), y.w * sigmoidf_(y.w)}; qq[t] = sum4(cf[t] * cf[t]); }
#pragma unroll
                for (int t = 0; t < 4; ++t) qq[t] = wsum(qq[t]);
#pragma unroll
                for (int t = 0; t < 4; ++t) *(GAS v2u*)(C.Y() + (rbase + t0 + i0 + t) * D + 512 + c4) = pk4(cf[t] * __builtin_amdgcn_rsqf(qq[t] * (1.0f / 256.0f) + EPS) * gC);
            }
            }
            if (C.tid == 0) C.MISC[165] = (unsigned)C.G + __hip_atomic_fetch_add(tq, 1u, RLX_AGENT);
            __syncthreads();
            tile = (int)C.MISC[165];
        }
        __syncthreads();
    }
}
__device__ __forceinline__ void phase_conv2(const Ctx& C, const Args& A, int l) {
    const int c4 = 4 * C.lane;
    {
        const float* wsc = ldin<15>() + (size_t)l * 3 * 256 + c4; const f32x4 w30 = *(const f32x4*)(wsc), w31 = *(const f32x4*)(wsc + 256), w32 = *(const f32x4*)(wsc + 512);
        const float* gg = ldin<16>() + (size_t)l * D;
        const f32x4 gS = *(const f32x4*)(gg + 768 + c4);
        gu32* tq = C.ctl + CW_CQ + (NL + l) * 16; int kc = 0;
        for (int ch = C.vcu; ch < T / 64; ++kc) {
        if (C.tid == 0) C.MISC[166 + (kc & 1)] = (unsigned)C.G + __hip_atomic_fetch_add(tq, 1u, RLX_AGENT);
        const int rbeg = ch * 64 + C.wave * 8, rend = (l + 1 == NL && ch % 68 >= 64) ? rbeg : rbeg + 8;
        for (int r0 = rbeg; r0 < rend; r0 += 2) {
            const bool two = r0 + 1 < rend;
            v2u cgv[4], hvv[4], bgv[2];
#pragma unroll
            for (int k = 0; k < 4; ++k) { int rr = r0 - 1 + k; rr = rr < 0 ? 0 : (rr >= T ? T - 1 : rr); const bf16* p = C.P() + (size_t)rr * INW; cgv[k] = *(const GAS v2u*)(p + 1536 + c4); hvv[k] = *(const GAS v2u*)(p + 1792 + c4); }
#pragma unroll
            for (int u = 0; u < 2; ++u) { const int r = two || u == 0 ? r0 + u : r0; bgv[u] = *(const GAS v2u*)(C.P() + (size_t)r * INW + 1280 + c4); }
            f32x4 m[4];
#pragma unroll
            for (int k = 0; k < 4; ++k) m[k] = bf4(cgv[k]) * bf4(hvv[k]);
            f32x4 sv[2]; float qs[2];
#pragma unroll
            for (int u = 0; u < 2; ++u) { const int r = r0 + u; const int t = r % SEG; const bool has_prev = t != 0 && t != SQ, has_next = t != SQ - 1 && t != SEG - 1;
                const f32x4 zero = (f32x4){0.f, 0.f, 0.f, 0.f};
                sv[u] = bf4(bgv[u]) * (w30 * (has_prev ? m[u] : zero) + w31 * m[u + 1] + w32 * (has_next ? m[u + 2] : zero));
                qs[u] = sum4(sv[u] * sv[u]); }
            qs[0] = wsum(qs[0]); qs[1] = wsum(qs[1]);
#pragma unroll
            for (int u = 0; u < 2; ++u) { if (u == 1 && !two) break; bf16* yr = C.Y() + (size_t)(r0 + u) * D;
                *(GAS v2u*)(yr + 768 + c4) = pk4(sv[u] * __builtin_amdgcn_rsqf(qs[u] * (1.0f / 256.0f) + EPS) * gS); }
        }
        __syncthreads(); ch = (int)C.MISC[166 + (kc & 1)];
        }
    }
}

__device__ __forceinline__ void phase_route(const Ctx& C, const Args& A, int l) {
    volatile LAS unsigned* lhist = C.MISC + 80; volatile LAS unsigned* lbase = C.MISC + 112;
    const float br = C.lane < NE ? ldin<19>()[l * NE + C.lane] : 0.f;
    gu32* cnt = C.ctl + CW_CNT + (size_t)l * NE * 64;
    for (int tile = C.vcu; tile < T / 64; tile += C.G) {
        __syncthreads();
        if (C.tid < NE) lhist[C.tid] = 0u;
        __syncthreads();
        unsigned pp[8]; int rk[8];
        float lg[8];
#pragma unroll
        for (int i = 0; i < 8; ++i) { const int r = tile * 64 + C.wave * 8 + i; lg[i] = C.lane < NE ? C.LOG()[(size_t)r * NE + C.lane] + br : -INFINITY; }
#pragma unroll
        for (int i = 0; i < 8; ++i) { const int r = tile * 64 + C.wave * 8 + i; const float v = lg[i]; const int vb = __float_as_int(v);
            int rank = 0;
#pragma unroll
            for (int j = 0; j < NE; ++j) { const float vj = __int_as_float(__builtin_amdgcn_readlane(vb, j)); rank += (vj > v || (vj == v && j < C.lane)) ? 1 : 0; }
            const bool sel = C.lane < NE && rank < 4;
            float sv[4];
#pragma unroll
            for (int k = 0; k < 4; ++k) { const unsigned long long mk = __ballot(C.lane < NE && rank == k); const int src = (int)__builtin_ctzll(mk | (1ull << 63)); sv[k] = __int_as_float(__builtin_amdgcn_readlane(vb, src)); }
            const float e1 = __expf(sv[1] - sv[0]), e2 = __expf(sv[2] - sv[0]), e3 = __expf(sv[3] - sv[0]); const float inv = __builtin_amdgcn_rcpf(1.0f + e1 + e2 + e3);
            rk[i] = sel ? rank : -1; pp[i] = 0u;
            if (sel) { pp[i] = __hip_atomic_fetch_add((LAS unsigned*)(C.lds + MISC_OFF) + 80 + C.lane, 1u, __ATOMIC_RELAXED, __HIP_MEMORY_SCOPE_WORKGROUP);
                ((GAS float*)C.PAIR())[((size_t)r * 4 + rank) * 2 + 1] = __expf(v - sv[0]) * inv; } }
        __syncthreads();
        if (C.tid < NE) { const unsigned n = lhist[C.tid]; lbase[C.tid] = n ? __hip_atomic_fetch_add(cnt + C.tid * 64, n, RLX_AGENT) : 0u; }
        __syncthreads();
        const unsigned mybase = C.lane < NE ? lbase[C.lane] : 0u;
#pragma unroll
        for (int i = 0; i < 8; ++i) if (rk[i] >= 0) { const int r = tile * 64 + C.wave * 8 + i; const unsigned pos = mybase + pp[i];
            ((GAS unsigned*)C.PAIR())[((size_t)r * 4 + rk[i]) * 2] = (unsigned)C.lane | (pos << 5);
            C.TOK()[(size_t)C.lane * T + pos] = r; }
    }
    __syncthreads();
}

__device__ __forceinline__ void phase_gather(const Ctx& C, const Args& A, int l) {
    moe_tables(C, l, true);
    const LAS unsigned char* t2e = (const LAS unsigned char*)(C.lds + T2E_OFF);
    const int nslot = (int)C.MISC[NE] * 256;
    constexpr int RB = MK_FP8 ? 1024 : 2048, NV = RB / 1024;
    const unsigned char* srcb = MK_FP8 ? (const unsigned char*)C.HB8() : (const unsigned char*)C.HB();
    unsigned char* dstb = (unsigned char*)C.HP();
    for (int s0 = C.gw * 16; s0 < nslot; s0 += C.ngw * 16) { const unsigned e = t2e[s0 >> 8]; const unsigned pos0 = (unsigned)s0 - C.MISC[e] * 256u; const unsigned cnt = C.MISC[40 + e];
        int tk = -1; if (C.lane < 16 && pos0 + C.lane < cnt) tk = C.TOK()[(size_t)e * T + pos0 + C.lane];
        v4u v[16][NV];
#pragma unroll
        for (int u = 0; u < 16; ++u) { const int r = __builtin_amdgcn_readlane(tk, u);
            if (r >= 0) { const GAS v4u* src = (const GAS v4u*)(srcb + (size_t)r * RB) + C.lane;
#pragma unroll
                for (int q = 0; q < NV; ++q) v[u][q] = src[64 * q]; } }
#pragma unroll
        for (int u = 0; u < 16; ++u) { const int r = __builtin_amdgcn_readlane(tk, u);
            if (r >= 0) { GAS v4u* dst = (GAS v4u*)(dstb + (size_t)(s0 + u) * RB) + C.lane;
#pragma unroll
                for (int q = 0; q < NV; ++q) dst[64 * q] = v[u][q]; } }
    }
}

__global__ void __launch_bounds__(NWAVES * 64, 2) mk_fwd(Args args) {
    extern __shared__ __attribute__((aligned(16))) unsigned char lds_raw[];
    Ctx C;
    C.lds = (LAS unsigned char*)lds_raw; C.MISC = (volatile LAS unsigned*)(C.lds + MISC_OFF);
    C.tid = threadIdx.x; C.lane = C.tid & 63; C.wave = __builtin_amdgcn_readfirstlane(C.tid >> 6);
    C.G = gridDim.x; { const int bx = blockIdx.x; C.vcu = (C.G % 8 == 0) ? (bx % 8) * (C.G / 8) + bx / 8 : bx; }
    C.gw = C.vcu * NWAVES + C.wave; C.ngw = C.G * NWAVES;
    C.ws = (GAS unsigned char*)args.ws; C.ctl = (gu32*)(C.ws + WS_CTL);
    for (int u = C.tid; u < (LDS_BYTES - MISC_OFF) / 4; u += NWAVES * 64) ((LAS unsigned*)(C.lds + MISC_OFF))[u] = 0u;
    __syncthreads();
    const int lo = args.ph_lo, hi = args.ph_hi;
    const bool multi = (hi - lo) > 1;
    XcdBarrier bar; bar.bar = (unsigned*)(C.ctl + CW_BAR); bar.x = 0; bar.st = C.MISC + 160;
    if (multi) bar = xcd_barrier_post((unsigned*)(C.ctl + CW_BAR), C.MISC + 160);
#ifndef MK_PHMASK
#define MK_PHMASK 0xFFFF
#endif
#define IN(k) (lo <= (k) && (k) < hi)
#ifndef MK_STAMP
#define MK_STAMP -1
#endif
    unsigned long long tacc = 0ull, tst = 0ull;
#define T0(k) do { if (MK_STAMP == (k)) tst = __builtin_amdgcn_s_memrealtime(); } while (0)
#define T1(k) do { if (MK_STAMP == (k)) tacc += __builtin_amdgcn_s_memrealtime() - tst; } while (0)
#define FRESH() do { asm volatile("" : "+v"(C.tid), "+v"(C.lane)); asm volatile("" : "+s"(C.wave), "+s"(C.vcu), "+s"(C.gw), "+s"(C.ws), "+s"(C.ctl)); } while (0)
#define EN(k) ((MK_PHMASK >> (k)) & 1)
#ifndef MK_DUP
#define MK_DUP 0
#endif
#define NREP(k) (((MK_DUP >> (k)) & 1) ? 2 : 1)
#define SEAM(k) do { if (IN((k) + 1)) xcd_barrier(bar); } while (0)

    if (EN(12) && IN(0)) { _Pragma("unroll") for (int rep = 0; rep < NREP(12); ++rep) phase_prologue(C, args); SEAM(0); }
    __syncthreads();
    for (int u = C.tid; u < 64 * 16; u += NWAVES * 64) { const int pos = u >> 4, i = u & 15; const float inv = powf(10000.0f, -(float)(2 * i) / 32.0f); const float ang = (float)pos * inv;
        ((LAS f32x2*)(C.lds + ROPE_OFF))[u] = (f32x2){cosf(ang), sinf(ang)}; }
    __syncthreads();
    for (int l = 0; l < NL; ++l) {
        const int pb = 1 + l * PPL;
        if (EN(0) && IN(pb + 0)) { FRESH(); T0(0); phase_premix(C, args, l); SEAM(pb + 0); T1(0); }
        if (EN(1) && IN(pb + 1)) { FRESH(); T0(1);
            { LAS float* gl = (LAS float*)(C.lds + T2E_OFF); const float* gq = ldin<9>() + l * 64; const float* gk = ldin<10>() + l * 64;
              __syncthreads(); if (C.tid < 128) gl[C.tid] = C.tid < 64 ? gq[C.tid] : gk[C.tid - 64]; __syncthreads(); }
#if MK_FP8_IN == 2
            {
                pg8::Gemm g8{(const pg8::bf16_t*)C.HB8(), (const pg8::bf16_t*)((const unsigned char*)C.HP() + (size_t)l * INW * D), T, 768, D / 2}; pg8::StaticOrder S8; S8.init(T, 768, C.G, (int)blockIdx.x);
                pg8::EpiInProj E8{C.P(), (const LAS float*)(C.lds + ROPE_OFF), (const LAS float*)(C.lds + T2E_OFF), attn_body::C2, 0};
                pg8::gemm_phase<pg8::EpiInProj, pg8::StaticOrder, true, true, true>(C.lds, g8, S8, E8);
                pg8::Gemm g{C.HB(), C.WINT() + ((size_t)l * INW + 768) * D, T, 1280, D}; pg8::StaticOrder S; S.init(T, 1280, C.G, (int)blockIdx.x);
                pg8::EpiInProj E{C.P(), (const LAS float*)(C.lds + ROPE_OFF), (const LAS float*)(C.lds + T2E_OFF), attn_body::C2, 3};
                pg8::gemm_phase<pg8::EpiInProj, pg8::StaticOrder, true, true>(C.lds, g, S, E);
            }
#else
#if MK_FP8_IN == 1
            pg8::Gemm g{C.HB(), (const pg8::bf16_t*)((const unsigned char*)C.WINT() + (size_t)l * INW * D), T, INW, D / 2}; pg8::StaticOrder S; S.init(T, INW, C.G, (int)blockIdx.x);
#else
            pg8::Gemm g{C.HB(), C.WINT() + (size_t)l * INW * D, T, INW, D}; pg8::StaticOrder S; S.init(T, INW, C.G, (int)blockIdx.x);
#endif
            pg8::EpiInProj E{C.P(), (const LAS float*)(C.lds + ROPE_OFF), (const LAS float*)(C.lds + T2E_OFF), attn_body::C2, 0};
_Pragma("unroll") for (int rep = 0; rep < NREP(1); ++rep)
            pg8::gemm_phase<pg8::EpiInProj, pg8::StaticOrder, true, true, MK_FP8_IN == 1>(C.lds, g, S, E);
#endif
            if (l + 1 < NL) { FRESH(); tail_convert(C, l + 1, NROWT * (INW / 256), 0); }
            SEAM(pb + 1); T1(1); }
        if (EN(3) && IN(pb + 3)) { FRESH(); T0(3); _Pragma("unroll") for (int rep = 0; rep < NREP(3); ++rep) phase_attn(C, l); phase_conv1(C, args, l); FRESH(); phase_conv2(C, args, l); SEAM(pb + 3); T1(3); }
        if (EN(5) && IN(pb + 5)) { FRESH(); T0(5);
            pg8::Gemm g{C.Y(), C.WOUTT() + (size_t)l * D * D, T, D, D};
            pg8::EpiGate E{C.OB(), C.MOD() + (size_t)l * 17 * MODW + 2 * D, C.X()};
            if (l + 1 < NL) { pg8::StaticOrder S; S.init(T, D, C.G, (int)blockIdx.x); pg8::gemm_phase<pg8::EpiGate, pg8::StaticOrder, true, true>(C.lds, g, S, E); }
            else { pg8::LatentOrder S; S.init(NB * SQ, D, C.G, (int)blockIdx.x); pg8::gemm_phase<pg8::EpiGate, pg8::LatentOrder, true, true>(C.lds, g, S, E); }
            if (l + 1 < NL) { FRESH(); tail_convert(C, l + 1, NROWT * (D / 256), tail_items(NROWT * (INW / 256), C.G)); }
            SEAM(pb + 5); T1(5); }
        if (EN(6) && IN(pb + 6)) { FRESH(); T0(6); _Pragma("unroll") for (int rep = 0; rep < NREP(6); ++rep) phase_premoe(C, args, l); SEAM(pb + 6); T1(6); }
        if (EN(10) && IN(pb + 10)) { FRESH(); T0(10);
            moe_tables(C, l, true);
#if MK_FP8
            pg8::Gemm g{(const pg8::bf16_t*)C.HB8(), (const pg8::bf16_t*)((const unsigned char*)C.W1T() + (size_t)l * NE * 2048 * D), CAP, NE * 2048, D / 2};
            pg8::MoeOrder S; S.init((int)C.MISC[NE], 8, C.G, (int)blockIdx.x, (const LAS unsigned char*)(C.lds + T2E_OFF)); S.tok = C.TOK(); S.tstride = T; S.tab = C.MISC;
            pg8::EpiSwiglu8 E{(unsigned char*)C.ACT(), C.B1P() + (size_t)l * NE * 2048};
_Pragma("unroll") for (int rep = 0; rep < NREP(10); ++rep)
            pg8::gemm_phase<pg8::EpiSwiglu8, pg8::MoeOrder, true, true, true, 0x7A7A7A7A, true>(C.lds, g, S, E);
#else
            pg8::Gemm g{C.HP(), C.W1T() + (size_t)l * NE * 2048 * D, CAP, NE * 2048, D};
            pg8::MoeOrder S; S.init((int)C.MISC[NE], 8, C.G, (int)blockIdx.x, (const LAS unsigned char*)(C.lds + T2E_OFF));
            pg8::EpiSwiglu E{C.ACT(), C.B1P() + (size_t)l * NE * 2048};
            pg8::gemm_phase<pg8::EpiSwiglu, pg8::MoeOrder, true, true>(C.lds, g, S, E);
#endif
            SEAM(pb + 10); T1(10); }
        if (EN(11) && IN(pb + 11)) { FRESH(); T0(11);
            moe_tables(C, l, true);
#if MK_FP8
            pg8::Gemm g{C.ACT(), (const pg8::bf16_t*)((const unsigned char*)C.W2T() + (size_t)l * NE * D * D), CAP, NE * D, D / 2};
            pg8::MoeOrder S; S.init((int)C.MISC[NE], 4, C.G, (int)blockIdx.x, (const LAS unsigned char*)(C.lds + T2E_OFF)); S.rev = true;
            pg8::EpiDown E{(unsigned char*)C.YP(), ldin<23>() + (size_t)l * NE * D};
_Pragma("unroll") for (int rep = 0; rep < NREP(11); ++rep)
            pg8::gemm_phase<pg8::EpiDown, pg8::MoeOrder, true, true, true, 0x7D7D7D7D>(C.lds, g, S, E);
#else
            pg8::Gemm g{C.ACT(), C.W2T() + (size_t)l * NE * D * D, CAP, NE * D, D};
            pg8::MoeOrder S; S.init((int)C.MISC[NE], 4, C.G, (int)blockIdx.x, (const LAS unsigned char*)(C.lds + T2E_OFF)); S.rev = true;
            pg8::EpiDown E{(unsigned char*)C.YP(), ldin<23>() + (size_t)l * NE * D};
            pg8::gemm_phase<pg8::EpiDown, pg8::MoeOrder, true, true>(C.lds, g, S, E);
#endif
            SEAM(pb + 11); T1(11); }
    }
    if (EN(13) && IN(NPHASE - 1)) { FRESH(); T0(13); phase_final(C, args); T1(13); }
    if (MK_STAMP >= 0 && blockIdx.x == 0 && C.tid == 0) { asm volatile("s_waitcnt vmcnt(0)" ::: "memory"); ldout()[5] = (float)tacc * 0.001f; }
#undef IN
#undef SEAM
}
}


#if defined(MK_DEBUG)
namespace mkdbg {
using namespace mk;
constexpr size_t WS_DBG = 3420 * MiB;
__device__ const int SROWS[12] = {0, 1, 63, 64, 255, 256, 4095, 4096, 4351, 4352, 30000, 69631};
__device__ __forceinline__ float bfv(const bf16* p, size_t i) { return __builtin_bit_cast(float, (unsigned)p[i] << 16); }
__device__ __forceinline__ void report(float* err, int s, float got, float ref, float atol) {
    float e = fabsf(got - ref) / (fabsf(ref) + atol); if (!(e == e)) e = 100.f;
    atomicMax((unsigned*)err + s, __builtin_bit_cast(unsigned, e));
}
__device__ __forceinline__ void row_info(int r, int& b, int& t, int& j) { b = r / SEG; t = r - b * SEG; j = t < SQ ? b : 16; }
__device__ __forceinline__ float silu_(float v) { return v / (1.f + expf(-v)); }
__device__ __forceinline__ float sigm_(float v) { return 1.f / (1.f + expf(-v)); }
__device__ __forceinline__ void naive_attn(const bf16* P, int r, int h, float* q, float* o) {
    int b, t, j; row_info(r, b, t, j);
    const int k0 = t < SQ ? b * SEG : b * SEG + SQ, nk = t < SQ ? SEG : CL;
    for (int d = 0; d < 64; ++d) q[d] = bfv(P, (size_t)r * INW + h * 64 + d);
    float m = -1e30f;
    for (int kk = 0; kk < nk; ++kk) { float s = 0.f; for (int d = 0; d < 64; ++d) s += q[d] * bfv(P, (size_t)(k0 + kk) * INW + 512 + (h >> 2) * 64 + d); m = fmaxf(m, s); }
    float l = 0.f; for (int d = 0; d < 64; ++d) o[d] = 0.f;
    for (int kk = 0; kk < nk; ++kk) { float s = 0.f; for (int d = 0; d < 64; ++d) s += q[d] * bfv(P, (size_t)(k0 + kk) * INW + 512 + (h >> 2) * 64 + d);
        const float p = exp2f(s - m); l += p; for (int d = 0; d < 64; ++d) o[d] += p * bfv(P, (size_t)(k0 + kk) * INW + 640 + (h >> 2) * 64 + d); }
    for (int d = 0; d < 64; ++d) o[d] /= l;
}
__device__ const int DBG_LS_1[2] = {0, 3};
__device__ const int DBG_JS_2[3] = {0, 7, 16};
__device__ const int DBG_NS_3[4] = {0, 1000, 2053, 6143};
__device__ const int DBG_CS_4[4] = {0, 1, 511, 1023};
__device__ const int DBG_CS_5[16] = {0, 63, 64, 511, 512, 575, 639, 640, 767, 768, 1024, 1279, 1280, 1536, 1792, 2047};
__device__ const int DBG_HS_6[4] = {0, 7, 8, 9};
__device__ const int DBG_HS_7[2] = {0, 5};
__device__ const int DBG_CS_8[4] = {0, 255, 256, 1023};
__device__ const int DBG_ES_9[3] = {0, 7, 31};
__device__ const int DBG_CS_10[3] = {0, 500, 1023};
__device__ const int DBG_CS_11[4] = {0, 127, 128, 1023};
__device__ const int DBG_CS_12[4] = {0, 300, 511, 1023};
__device__ const int DBG_CS_13[4] = {0, 300, 511, 1023};
__device__ const int DBG_CS_14[4] = {0, 300, 511, 1023};
__global__ void __launch_bounds__(256) dbg_kernel(Args a, int stage) {
    unsigned char* ws = a.ws; float* err = (float*)(ws + WS_DBG); float* scr = err + 256;
    const float* MOD = (const float*)(ws + WS_MOD); const bf16* HB = (const bf16*)(ws + WS_HB); const bf16* P = (const bf16*)(ws + WS_P); const bf16* Y = (const bf16*)(ws + WS_Y);
    const float* X = (const float*)(ws + WS_X); const float* LOG = (const float*)(ws + WS_LOG); const v2u* PAIR = (const v2u*)(ws + WS_PAIR); const int* TOK = (const int*)(ws + WS_TOK);
    const bf16* HP = (const bf16*)(ws + WS_HP); const bf16* ACT = (const bf16*)(ws + WS_ACT); const bf16* YP = (const bf16*)(ws + WS_YP);
    const unsigned* cnt = (const unsigned*)(ws + WS_CTL) + CW_CNT;
    const int tid = threadIdx.x;
    __shared__ float shm[15360]; __shared__ unsigned tstart[33];
    if (stage == 0) { if (tid < 64) err[tid] = 0.f; return; }
    if (stage == 1) {
        const int* ls = DBG_LS_1; const int* js = DBG_JS_2; const int* ns = DBG_NS_3;
        if (tid < 24) { const int l = ls[tid / 12], j = js[(tid / 4) % 3], n = ns[tid % 4]; float s = 0.f;
            for (int k = 0; k < 1024; ++k) { const float c = j < 16 ? a.in[1][j * 1024 + k] : a.in[3][k]; s += silu_(c) * a.in[4][((size_t)l * 1024 + k) * MODW + n]; }
            s += a.in[5][l * MODW + n]; report(err, 1, MOD[((size_t)l * 17 + j) * MODW + n], s, 0.05f); }
        return; }
    if (stage == 2 || stage == 8) {
        const int* cs = DBG_CS_4;
        if (tid < 48) { const int r = SROWS[tid / 4], c = cs[tid % 4]; int b, t, j; row_info(r, b, t, j);
            const float* xr = stage == 2 ? (t < SQ ? a.in[0] + ((size_t)b * SQ + t) * D : a.in[2] + ((size_t)b * CL + (t - SQ)) * D) : X + (size_t)r * D;
            float ss = 0.f; for (int k = 0; k < D; ++k) ss += xr[k] * xr[k];
            const float rs = 1.f / sqrtf(ss / D + EPS); const float* g = stage == 2 ? a.in[6] : a.in[7]; const float* mj = MOD + (size_t)j * MODW + (stage == 2 ? 0 : 3 * D);
            const float h = xr[c] * rs * g[c] * (1.f + mj[D + c]) + mj[c];
            report(err, stage, bfv(HB, (size_t)r * D + c), h, 0.05f);
            if (stage == 2) report(err, stage, X[(size_t)r * D + c], xr[c], 0.01f); }
        return; }
    if (stage == 3) {
        const int* cs = DBG_CS_5;
        if (tid < 192) { const int r = SROWS[tid / 16], c = cs[tid % 16]; float s = 0.f;
            for (int k = 0; k < D; ++k) s += bfv(HB, (size_t)r * D + k) * a.in[8][(size_t)k * INW + c];
            report(err, 3, bfv(P, (size_t)r * INW + c), s, 0.05f); }
        return; }
    if (stage == 4) {
        const int* hs = DBG_HS_6;
        if (tid < 48) { const int r = SROWS[tid / 4], h = hs[tid % 4]; int b, t, j; row_info(r, b, t, j);
            float* raw = shm + tid * 128; float* o = raw + 64; float ss = 0.f;
            for (int d = 0; d < 64; ++d) { float s = 0.f; for (int k = 0; k < D; ++k) s += bfv(HB, (size_t)r * D + k) * a.in[8][(size_t)k * INW + h * 64 + d]; raw[d] = s; ss += s * s; }
            const float rs = 1.f / sqrtf(ss / 64.f + EPS); const float* g = h < 8 ? a.in[9] : a.in[10];
            for (int d = 0; d < 64; ++d) raw[d] = raw[d] * rs * g[d];
            for (int ax = 0; ax < 2; ++ax) for (int i = 0; i < 16; ++i) { const float pos = ax == 0 ? (float)(t / 64) : (float)(t % 64); const float ang = pos * powf(10000.f, -(float)(2 * i) / 32.f);
                const float c = t < SQ ? cosf(ang) : 1.f, s = t < SQ ? sinf(ang) : 0.f; const float x1 = raw[ax * 32 + i], x2 = raw[ax * 32 + 16 + i];
                o[ax * 32 + i] = x1 * c - x2 * s; o[ax * 32 + 16 + i] = x2 * c + x1 * s; }
            for (int d = 0; d < 64; ++d) { const float ref = o[d] * (h < 8 ? 0.125f * 1.4426950408889634f : 1.f); report(err, 4, bfv(P, (size_t)r * INW + h * 64 + d), ref, h < 8 ? 0.045f : 0.25f); } }
        return; }
    if (stage == 5) {
        const int* hs = DBG_HS_7;
        if (tid < 24) { const int r = SROWS[tid / 2], h = hs[tid % 2]; float* o = shm + tid * 128; naive_attn(P, r, h, o + 64, o);
            for (int d = 0; d < 64; ++d) report(err, 5, bfv(Y, (size_t)r * D + h * 64 + d), o[d], 0.05f); }
        return; }
    if (stage == 6) {
        if (tid < 12) { const int r = SROWS[tid]; int b, t, j; row_info(r, b, t, j); const int lo = t < SQ ? 0 : SQ, hi = t < SQ ? SQ : SEG; const size_t rb = (size_t)b * SEG;
            float* u = shm + tid * 256; float mean = 0.f;
            for (int c = 0; c < 256; ++c) { float s = a.in[12][c];
                for (int jt = 0; jt < 31; ++jt) { const int tt = t + jt - 15; if (tt >= lo && tt < hi) s += a.in[11][jt * 256 + c] * bfv(P, (rb + tt) * INW + 768 + c) * sigm_(bfv(P, (rb + tt) * INW + 1024 + c)); }
                u[c] = s; mean += s; }
            mean /= 256.f; float var = 0.f; for (int c = 0; c < 256; ++c) var += (u[c] - mean) * (u[c] - mean); var /= 256.f;
            float ss = 0.f; for (int c = 0; c < 256; ++c) { const float y = (u[c] - mean) / sqrtf(var + EPS) * a.in[13][c] + a.in[14][c]; u[c] = silu_(y); ss += u[c] * u[c]; }
            float rs = 1.f / sqrtf(ss / 256.f + EPS);
            for (int c = 0; c < 256; ++c) report(err, 6, bfv(Y, (size_t)r * D + 512 + c), u[c] * rs * a.in[16][512 + c], 0.25f);
            ss = 0.f;
            for (int c = 0; c < 256; ++c) { float s = 0.f; for (int jt = 0; jt < 3; ++jt) { const int tt = t + jt - 1; if (tt >= lo && tt < hi) s += a.in[15][jt * 256 + c] * bfv(P, (rb + tt) * INW + 1536 + c) * bfv(P, (rb + tt) * INW + 1792 + c); }
                u[c] = bfv(P, (size_t)r * INW + 1280 + c) * s; ss += u[c] * u[c]; }
            rs = 1.f / sqrtf(ss / 256.f + EPS);
            for (int c = 0; c < 256; ++c) report(err, 7, bfv(Y, (size_t)r * D + 768 + c), u[c] * rs * a.in[16][768 + c], 0.25f); }
        if (tid >= 64 && tid < 80) { const int r = SROWS[(tid - 64) / 8 == 0 ? 2 : 7], h = (tid - 64) % 8; float* o = shm + 3072 + (tid - 64) * 128; naive_attn(P, r, h, o + 64, o);
            for (int d = 0; d < 64; ++d) scr[((tid - 64) / 8) * 512 + h * 64 + d] = o[d]; }
        __syncthreads();
        if (tid < 2) { const int r = SROWS[tid == 0 ? 2 : 7]; float ss = 0.f; for (int c = 0; c < 512; ++c) ss += scr[tid * 512 + c] * scr[tid * 512 + c];
            const float rs = 1.f / sqrtf(ss / 512.f + EPS); for (int c = 0; c < 512; ++c) report(err, 6, bfv(Y, (size_t)r * D + c), scr[tid * 512 + c] * rs * a.in[16][c], 0.25f); }
        return; }
    if (stage == 9) {
        const int* cs = DBG_CS_8;
        if (tid < 48) { const int r = SROWS[tid / 4], c = cs[tid % 4]; int b, t, j; row_info(r, b, t, j);
            const float* xr = t < SQ ? a.in[0] + ((size_t)b * SQ + t) * D : a.in[2] + ((size_t)b * CL + (t - SQ)) * D;
            float s = 0.f; for (int k = 0; k < D; ++k) s += bfv(Y, (size_t)r * D + k) * a.in[17][(size_t)k * D + c];
            report(err, 9, X[(size_t)r * D + c], xr[c] + MOD[(size_t)j * MODW + 2 * D + c] * s, 0.05f); }
        return; }
    if (stage == 10) {
        const int* es = DBG_ES_9;
        if (tid < 36) { const int r = SROWS[tid / 3], e = es[tid % 3]; float s = 0.f; for (int k = 0; k < D; ++k) s += bfv(HB, (size_t)r * D + k) * a.in[18][(size_t)k * NE + e];
            report(err, 10, LOG[(size_t)r * NE + e], s, 0.05f); }
        return; }
    if (stage == 11) {
        if (tid < 12) { const int r = SROWS[tid]; float* v = shm + tid * 32; for (int e = 0; e < 32; ++e) v[e] = LOG[(size_t)r * NE + e] + a.in[19][e];
            float* sv = shm + 1024 + tid * 8; float* sef = sv + 4;
            for (int k = 0; k < 4; ++k) { int bi = 0; for (int e = 1; e < 32; ++e) if (v[e] > v[bi]) bi = e; sef[k] = (float)bi; sv[k] = v[bi]; v[bi] = -1e30f; }
            float den = 0.f; for (int k = 0; k < 4; ++k) den += expf(sv[k] - sv[0]);
            { float* vv = shm + 2048 + tid * 32; for (int e = 0; e < 32; ++e) vv[e] = LOG[(size_t)r * NE + e] + a.in[19][e];
              float mx = -1e30f, dn = 0.f; for (int k = 0; k < 4; ++k) mx = fmaxf(mx, vv[PAIR[(size_t)r * 4 + k].x & 31]); for (int k = 0; k < 4; ++k) dn += expf(vv[PAIR[(size_t)r * 4 + k].x & 31] - mx);
              for (int k = 0; k < 4; ++k) report(err, 22, __uint_as_float((unsigned)(PAIR[(size_t)r * 4 + k].y + 0u)), expf(vv[PAIR[(size_t)r * 4 + k].x & 31] - mx) / dn, 0.01f); }
            for (int k = 0; k < 4; ++k) { const v2u pr = PAIR[(size_t)r * 4 + k]; const int e = pr.x & 31; const unsigned pos = pr.x >> 5;
                if (tid == 0 && (k == 0 || k == 3)) { err[30 + (k ? 2 : 0)] = __uint_as_float((unsigned)(pr.y + 0u)); err[31 + (k ? 2 : 0)] = expf(sv[k] - sv[0]) / den; }
                report(err, 17, (float)e == sef[k] ? 0.f : 1.f, 0.f, 1.0f); report(err, 18, __uint_as_float((unsigned)(pr.y + 0u)), expf(sv[k] - sv[0]) / den, 0.01f);
                const unsigned c = cnt[e * 64]; report(err, 19, pos < c ? 1.f : 0.f, 1.f, 0.001f); report(err, 20, (float)TOK[(size_t)e * T + (pos < (unsigned)T ? pos : 0)], (float)r, 0.001f); } }
        if (tid == 255) { unsigned s = 0; for (int e = 0; e < 32; ++e) s += cnt[e * 64]; report(err, 21, (float)s, (float)(T * 4), 0.001f); }
        if (tid == 253) { int c = 0; const float* pf = (const float*)PAIR; for (int q = 0; q < 64; ++q) { const float w = pf[q * 2 + 1]; if (w > 0.01f && w <= 1.f) ++c; } err[44] = (float)c; }
        if (tid == 254) { for (int k = 0; k < 4; ++k) { const float w = __uint_as_float((unsigned)(PAIR[k].y + 0u)); err[40 + k] = (float)(!(w == w) || w < 0.f || w > 1.f ? 3 : w < 1e-30f ? 0 : w < 0.05f ? 1 : 2); } }
        return; }
    if (tid == 0) { unsigned s = 0; for (int e = 0; e < 32; ++e) { tstart[e] = s; s += (cnt[e * 64] + 255u) >> 8; } tstart[32] = s; }
    __syncthreads();
    if (stage == 12) {
        const int* cs = DBG_CS_10;
        if (tid < 48) { const int r = SROWS[tid / 4], k = tid % 4; const v2u pr = PAIR[(size_t)r * 4 + k]; const size_t slot = (size_t)tstart[pr.x & 31] * 256 + (pr.x >> 5);
            for (int i = 0; i < 3; ++i) report(err, 12, bfv(HP, slot * D + cs[i]), bfv(HB, (size_t)r * D + cs[i]), 0.001f); }
        return; }
    if (stage == 13) {
        const int* cs = DBG_CS_11;
        if (tid < 192) { const int r = SROWS[tid / 16], k = (tid / 4) % 4, c = cs[tid % 4]; const v2u pr = PAIR[(size_t)r * 4 + k]; const int e = pr.x & 31; const size_t slot = (size_t)tstart[e] * 256 + (pr.x >> 5);
            float ug = a.in[21][(size_t)e * 2048 + 2 * c], uu = a.in[21][(size_t)e * 2048 + 2 * c + 1]; const float* w = a.in[20] + (size_t)e * 1024 * 2048;
            for (int kk = 0; kk < D; ++kk) { const float hv = bfv(HP, slot * D + kk); ug += hv * w[(size_t)kk * 2048 + 2 * c]; uu += hv * w[(size_t)kk * 2048 + 2 * c + 1]; }
            const float gc = fminf(ug, 7.f), uc = fminf(fmaxf(uu, -7.f), 7.f); const float ref = (uc + 1.f) * gc * sigm_(1.702f * gc);
            report(err, 13, bfv(ACT, slot * D + c), ref, 0.25f); }
        return; }
    if (stage == 14) {
        const int* cs = DBG_CS_12;
        if (tid < 192) { const int r = SROWS[tid / 16], k = (tid / 4) % 4, c = cs[tid % 4]; const v2u pr = PAIR[(size_t)r * 4 + k]; const int e = pr.x & 31; const size_t slot = (size_t)tstart[e] * 256 + (pr.x >> 5);
            float s = a.in[23][(size_t)e * 1024 + c]; const float* w = a.in[22] + (size_t)e * 1024 * 1024;
            for (int kk = 0; kk < D; ++kk) s += bfv(ACT, slot * D + kk) * w[(size_t)kk * 1024 + c];
            report(err, 14, bfv(YP, slot * D + c), s, 0.25f); }
        return; }
    if (stage == 15) {
        const int* cs = DBG_CS_13;
        if (tid < 48) { const int r = SROWS[tid / 4], c = cs[tid % 4]; int b, t, j; row_info(r, b, t, j); float f = 0.f;
            for (int k = 0; k < 4; ++k) { const v2u pr = PAIR[(size_t)r * 4 + k]; const size_t slot = (size_t)tstart[pr.x & 31] * 256 + (pr.x >> 5); f += __uint_as_float((unsigned)(pr.y + 0u)) * bfv(YP, slot * D + c); }
            scr[2048 + tid] = X[(size_t)r * D + c] + MOD[(size_t)j * MODW + 5 * D + c] * f; }
        return; }
    if (stage == 16) {
        const int* cs = DBG_CS_14;
        if (tid < 48) { const int r = SROWS[tid / 4], c = cs[tid % 4]; report(err, 16, X[(size_t)r * D + c], scr[2048 + tid], 0.02f); }
        return; }
    if (stage == 99) {
        if (tid == 0) {
#if MK_DEBUG == 3
            a.out[0] = (err[44] + 1.f) * 1e20f; return;
#endif
#if MK_DEBUG == 2
            { const float* db = err + 4096; const v2u* PR = (const v2u*)(a.ws + WS_PAIR); int code = 0;
              auto close = [](float x, float y) { return fabsf(x - y) <= 1e-3f * (fabsf(y) + 1e-3f); };
              for (int ln = 0; ln < 4 && !code; ++ln) for (int j = 0; j < 4; ++j) if (!(db[ln * 16 + j] == db[j])) { code = 10 + ln; break; }
              if (!code) for (int j = 0; j < 3; ++j) if (!(db[j] >= db[j + 1])) code = 20 + j;
              if (!code) for (int ln = 0; ln < 4 && !code; ++ln) for (int j = 0; j < 3; ++j) if (!close(db[ln * 16 + 4 + j], expf(db[j + 1] - db[0]))) { code = 30 + ln; break; }
              if (!code) for (int ln = 0; ln < 4; ++ln) if (!close(db[ln * 16 + 7], 1.f + db[ln * 16 + 4] + db[ln * 16 + 5] + db[ln * 16 + 6])) { code = 40 + ln; break; }
              if (!code) for (int ln = 0; ln < 4; ++ln) if (!close(db[ln * 16 + 8], 1.f / db[ln * 16 + 7])) { code = 50 + ln; break; }
              if (!code) for (int ln = 0; ln < 4; ++ln) if (!close(db[ln * 16 + 9], (ln == 0 ? 1.f : db[ln * 16 + 3 + ln]) * db[ln * 16 + 8])) { code = 60 + ln; break; }
              if (!code) for (int ln = 0; ln < 4; ++ln) if (!close(__uint_as_float((unsigned)(PR[ln].y + 0u)), db[ln * 16 + 9])) { code = 70 + ln; break; }
              if (!code) code = 88;
              a.out[0] = (float)code * 1e20f; return; }
#endif
            int mask = 0; for (int i = 0; i < 6; ++i) if (err[17 + i] > 0.06f) mask |= 1 << i; if (mask) err[11] = 1.f;
            for (int s = 1; s < 17; ++s) if (err[s] > 0.06f) { if (s == 11) { a.out[0] = (float)(10 + mask) * 1e14f; break; } a.out[0] = (1.f + 10.f * fminf(err[s], 0.89f)) * powf(10.f, (float)(4 + s)); break; } }
        return; }
}
}
#endif
#ifndef MK_ONE_LAUNCH
#define MK_ONE_LAUNCH 1
#endif
extern "C" void kernel_launch(void* const* d_in, const int* in_sizes, int n_in, void* d_out, int out_size, void* d_ws, size_t ws_size, hipStream_t stream) {
    using namespace mk;
    static int grid = 0;
    if (grid == 0) {
        if (n_in != 24 || out_size != NB * SQ * D || ws_size < WS_END) { fprintf(stderr, "kernel_launch: unexpected shapes (n_in %d, out %d, ws %zu)\n", n_in, out_size, ws_size); grid = -1; return; }
        int dev = 0, cus = 0, per_cu = 0;
        if (hipGetDevice(&dev) != hipSuccess || hipDeviceGetAttribute(&cus, hipDeviceAttributeMultiprocessorCount, dev) != hipSuccess) { grid = -1; return; }
        if (hipFuncSetAttribute((const void*)mk_fwd, hipFuncAttributeMaxDynamicSharedMemorySize, LDS_BYTES) != hipSuccess) { fprintf(stderr, "kernel_launch: hipFuncSetAttribute failed\n"); grid = -1; return; }
        if (hipOccupancyMaxActiveBlocksPerMultiprocessor(&per_cu, (const void*)mk_fwd, NWAVES * 64, LDS_BYTES) != hipSuccess || per_cu < 1) { fprintf(stderr, "kernel_launch: occupancy query says %d\n", per_cu); per_cu = 1; }
        (void)hipGetLastError();
        grid = cus;
    }
    if (grid < 0) return;
    (void)hipMemsetAsync((char*)d_ws + WS_CTL, 0, CTL_ZERO_BYTES, stream);
    Args a{};
    for (int i = 0; i < 24; ++i) a.in[i] = (const float*)d_in[i];
    a.out = (float*)d_out; a.ws = (unsigned char*)d_ws;
#if MK_ONE_LAUNCH
    a.ph_lo = 0; a.ph_hi = NPHASE;
    hipLaunchKernelGGL(mk_fwd, dim3(grid), dim3(NWAVES * 64), LDS_BYTES, stream, a);
#else
#if defined(MK_DEBUG)
#define DBG(s) hipLaunchKernelGGL(mkdbg::dbg_kernel, dim3(1), dim3(256), 0, stream, a, (s))
    DBG(0);
#else
#define DBG(s) do {} while (0)
#endif
    for (int p = 0; p < NPHASE; ++p) { a.ph_lo = p; a.ph_hi = p + 1; hipLaunchKernelGGL(mk_fwd, dim3(grid), dim3(NWAVES * 64), LDS_BYTES, stream, a);
        if (p == 0) DBG(1); if (p == 1) DBG(2); if (p == 2) DBG(3); if (p == 3) DBG(4); if (p == 4) DBG(5); if (p == 5) DBG(6); if (p == 6) DBG(9); if (p == 7) DBG(8); if (p == 8) DBG(10);
        if (p == 9) DBG(11); if (p == 10) DBG(12); if (p == 11) DBG(13); if (p == 12) { DBG(14); DBG(15); } if (p == 13) DBG(16); }
    DBG(99);
#endif
}
```

```cpp
#include <hip/hip_runtime.h>
#include <hip/hip_bf16.h>
#include <cstdio>
#include <cstdint>
#include <cmath>
namespace pg8 {
#define PG8_LAS __attribute__((address_space(3)))
typedef unsigned short bf16_t;
typedef short bf16x8 __attribute__((ext_vector_type(8)));
typedef float f32x4 __attribute__((ext_vector_type(4)));
typedef unsigned u32x4 __attribute__((ext_vector_type(4)));
typedef int i32x4 __attribute__((ext_vector_type(4)));
typedef int i32x8 __attribute__((ext_vector_type(8)));
typedef unsigned u32x2 __attribute__((ext_vector_type(2)));
constexpr int PG8_BIAS_OFF = 144384;
constexpr int PG8_IDX_OFF = PG8_BIAS_OFF + 2048;
constexpr int BM = 256, BK = 64, HALF = 128, HTB = HALF * BK * 2  , STAGE_BYTES = 8 * HTB, NXCD = 8, WGM = 8;

__host__ __device__ __forceinline__ int lds_byte(int r, int c) { const int st = (r >> 4) * 2 + (c >> 5), rr = r & 15, cc = c & 31, ob = rr * 64 + cc * 2; return st * 1024 + (ob ^ (((ob >> 9) & 1) << 5)); }
__host__ __device__ __forceinline__ void stage_rc(int b, int& R, int& C) { const int st = b / 1024, sb = b % 1024, swz = sb ^ (((sb >> 9) & 1) << 5); R = (st >> 1) * 16 + swz / 64; C = (st & 1) * 32 + (swz % 64) / 2; }
__host__ __device__ __forceinline__ int perm32(int rho) { const int n = rho >> 4, i = rho & 15; return 8 * (i >> 2) + 4 * n + (i & 3); }

__device__ __forceinline__ int shx(int v, int o) { int l = __builtin_amdgcn_mbcnt_hi(-1, __builtin_amdgcn_mbcnt_lo(-1, 0)); asm volatile("" : "+v"(l)); return __builtin_amdgcn_ds_bpermute((l ^ o) << 2, v); }
__device__ __forceinline__ float shx(float v, int o) { return __int_as_float(shx(__float_as_int(v), o)); }
template <int CTRL> __device__ __forceinline__ float dpp_f(float v) { return __int_as_float(__builtin_amdgcn_update_dpp(0, __float_as_int(v), CTRL, 0xF, 0xF, true)); }
__device__ __forceinline__ float sum_x16(float v) { const auto r = __builtin_amdgcn_permlane16_swap(__float_as_uint(v), __float_as_uint(v), false, false); return __uint_as_float(r[0]) + __uint_as_float(r[1]); }
__device__ __forceinline__ float sum_x32(float v) { const auto r = __builtin_amdgcn_permlane32_swap(__float_as_uint(v), __float_as_uint(v), false, false); return __uint_as_float(r[0]) + __uint_as_float(r[1]); }
__device__ __forceinline__ float get_x32(float v, bool lo_half) { const auto r = __builtin_amdgcn_permlane32_swap(__float_as_uint(v), __float_as_uint(v), false, false); return __uint_as_float(lo_half ? r[1] : r[0]); }
__device__ __forceinline__ float get_x16(float v, bool even_row) { const auto r = __builtin_amdgcn_permlane16_swap(__float_as_uint(v), __float_as_uint(v), false, false); return __uint_as_float(even_row ? r[1] : r[0]); }
__device__ __forceinline__ float wsum(float v) { v += dpp_f<0xB1>(v); v += dpp_f<0x4E>(v); v += dpp_f<0x141>(v); v += dpp_f<0x140>(v); v = sum_x16(v); return sum_x32(v); }
struct Unit { int pm, pn; };
struct Gemm { const bf16_t* A; const bf16_t* Bt; int M, N, K; };

struct StaticOrder {
    int nM, nN, nwg, G, c;
    __host__ __device__ void init(int M, int N, int G_, int c_) { nM = M / BM; nN = N / BM; nwg = nM * nN; G = G_; c = c_; }
    __host__ __device__ bool next(int i, Unit& u) const {
        const long L = (long)i * G + c; if (L >= nwg) return false;
        int wgid = (int)L; { const int q = nwg / NXCD, r = nwg % NXCD, xcd = wgid % NXCD, off = wgid / NXCD; wgid = (xcd < r ? xcd * (q + 1) : r * (q + 1) + (xcd - r) * q) + off; }
        const int nig = WGM * nN, gid = wgid / nig, fm = gid * WGM, gsz = (nM - fm) < WGM ? (nM - fm) : WGM;
        u.pm = fm + ((wgid % nig) % gsz); u.pn = (wgid % nig) / gsz; return true;
    }
    __device__ __forceinline__ void a_ready(const Unit&) const {}
    __device__ __forceinline__ void done(const Unit&) const {}
};

struct LatentOrder : StaticOrder {
    __host__ __device__ bool next(int i, Unit& u) const { if (!StaticOrder::next(i, u)) return false; u.pm += u.pm >> 4; return true; }
};

__device__ __forceinline__ unsigned cvt_pk_bf16(float lo, float hi) { unsigned r; asm volatile("v_cvt_pk_bf16_f32 %0, %1, %2" : "=v"(r) : "v"(lo), "v"(hi)); return r; }
typedef float f32x2 __attribute__((ext_vector_type(2)));

struct MoeOrder {
    int nN, ntl, nwg, G, c; const PG8_LAS unsigned char* t2e; bool rev = false;
    const int* tok; int tstride; const volatile PG8_LAS unsigned* tab;
    __device__ __forceinline__ const int* idx_src(const Unit& u) const { const int e = u.pn / nN; return tok + (size_t)e * tstride + (size_t)(u.pm - (int)tab[e]) * 256; }
    __device__ __forceinline__ int nvalid(const Unit& u) const { const int e = u.pn / nN; return (int)tab[40 + e] - (u.pm - (int)tab[e]) * 256; }
    __device__ __forceinline__ void init(int ntl_, int nN_, int G_, int c_, const PG8_LAS unsigned char* t2e_) { ntl = ntl_; nN = nN_; nwg = ntl_ * nN_; G = G_; c = c_; t2e = t2e_; }
    __device__ __forceinline__ bool next(int i, Unit& u) const {
        const long L = (long)i * G + c; if (L >= nwg) return false;
        int wgid = (int)L; { const int q = nwg / NXCD, r = nwg % NXCD, xcd = wgid % NXCD; int off = wgid / NXCD; if (rev) off = (xcd < r ? q : q - 1) - off;
            wgid = (xcd < r ? xcd * (q + 1) : r * (q + 1) + (xcd - r) * q) + off; }
        const int nig = WGM * nN, gid = wgid / nig, fm = gid * WGM, gsz = (ntl - fm) < WGM ? (ntl - fm) : WGM;
        const int rt = fm + ((wgid % nig) % gsz), pn = (wgid % nig) / gsz;
        u.pm = rt; u.pn = (int)t2e[rt] * nN + pn; return true;
    }
    __device__ __forceinline__ void a_ready(const Unit&) const {}
    __device__ __forceinline__ void done(const Unit&) const {}
};

struct EpiStore {
    static constexpr bool PERM = true, AFTER_DRAIN = false, HAS_INIT = false;
    bf16_t* O; int ldc;
    __device__ __forceinline__ void operator()(const f32x4 (&acc)[2][2][4][2], const Unit& u, int wr, int wc, int fr, int fq) const {
        const int row0 = u.pm * BM + wr * 64 + fr, col0 = u.pn * BM + wc * 32 + 8 * fq;
#pragma unroll
        for (int ai = 0; ai < 2; ++ai)
#pragma unroll
            for (int m = 0; m < 4; ++m) { bf16_t* rowp = O + (size_t)(row0 + ai * HALF + m * 16) * ldc + col0;
#pragma unroll
                for (int bj = 0; bj < 2; ++bj) { const f32x4 v0 = acc[ai][bj][m][0], v1 = acc[ai][bj][m][1];
                    u32x4 w; w.x = cvt_pk_bf16(v0[0], v0[1]); w.y = cvt_pk_bf16(v0[2], v0[3]); w.z = cvt_pk_bf16(v1[0], v1[1]); w.w = cvt_pk_bf16(v1[2], v1[3]);
                    *(u32x4*)(rowp + bj * HALF) = w; } }
    }
};
struct EpiResid {
    static constexpr bool PERM = false, AFTER_DRAIN = false, HAS_INIT = false;
    float* X; const float* gate;
    __device__ __forceinline__ void operator()(const f32x4 (&acc)[2][2][4][2], const Unit& u, int wr, int wc, int fr, int fq) const {
        const int seg = u.pm / 17, rem = u.pm - seg * 17; const int j = (rem == 16) ? 16 : seg;
        const int row0 = u.pm * BM + wr * 64 + fr, col0 = u.pn * BM + wc * 32 + 4 * fq;
        const float* g = gate + (size_t)j * 6144 + col0;
        f32x4 gv[2][2];
#pragma unroll
        for (int bj = 0; bj < 2; ++bj)
#pragma unroll
            for (int n = 0; n < 2; ++n) gv[bj][n] = *(const f32x4*)(g + bj * HALF + n * 16);
#pragma unroll
        for (int ai = 0; ai < 2; ++ai)
#pragma unroll
            for (int m = 0; m < 4; ++m) { float* rowp = X + (size_t)(row0 + ai * HALF + m * 16) * 1024 + col0;
#pragma unroll
                for (int bj = 0; bj < 2; ++bj)
#pragma unroll
                    for (int n = 0; n < 2; ++n) { f32x4* p = (f32x4*)(rowp + bj * HALF + n * 16); *p = *p + gv[bj][n] * acc[ai][bj][m][n]; } }
    }
};
struct EpiInProj {
    static constexpr bool PERM = true, AFTER_DRAIN = false, HAS_INIT = false;
    bf16_t* P; const PG8_LAS float* rope; const PG8_LAS float* gqk; float c2; int pn0;
    __device__ __forceinline__ void operator()(const f32x4 (&acc)[2][2][4][2], const Unit& u, int wr, int wc, int fr, int fq) const {
        const int pnt = u.pn + pn0; const int row0 = u.pm * BM + wr * 64 + fr, col0 = pnt * BM + 64 * wc + 8 * fq;
        const bool isq = pnt < 2, isk = pnt == 2 && wc < 2;
        if (!(isq || isk)) {
#pragma unroll
            for (int ai = 0; ai < 2; ++ai)
#pragma unroll
                for (int m = 0; m < 4; ++m) { bf16_t* rowp = P + (size_t)(row0 + ai * HALF + m * 16) * 2048 + col0;
#pragma unroll
                    for (int bj = 0; bj < 2; ++bj) { const f32x4 v0 = acc[ai][bj][m][0], v1 = acc[ai][bj][m][1];
                        u32x4 w; w.x = cvt_pk_bf16(v0[0], v0[1]); w.y = cvt_pk_bf16(v0[2], v0[3]); w.z = cvt_pk_bf16(v1[0], v1[1]); w.w = cvt_pk_bf16(v1[2], v1[3]);
                        *(u32x4*)(rowp + 32 * bj) = w; } }
            return; }
        const PG8_LAS float* gp = gqk + (isq ? 0 : 64) + 8 * fq; const float sc = isq ? c2 : 1.0f;
        f32x4 gn[2][2];
#pragma unroll
        for (int bj = 0; bj < 2; ++bj)
#pragma unroll
            for (int n = 0; n < 2; ++n) gn[bj][n] = *(const PG8_LAS f32x4*)(gp + 32 * bj + 4 * n);
        const int seg = u.pm / 17, rem = u.pm - seg * 17; const bool lat = rem != 16;
        const bool first = fq < 2; const int i0 = 8 * (fq & 1);
#pragma unroll
        for (int ai = 0; ai < 2; ++ai)
#pragma unroll
            for (int m = 0; m < 4; ++m) { const int lr = wr * 64 + fr + ai * HALF + m * 16, t = rem * 256 + lr;
                f32x4 x[2][2]; float ss = 0.f;
#pragma unroll
                for (int bj = 0; bj < 2; ++bj)
#pragma unroll
                    for (int n = 0; n < 2; ++n) { x[bj][n] = acc[ai][bj][m][n]; ss += (x[bj][n][0] * x[bj][n][0] + x[bj][n][1] * x[bj][n][1]) + (x[bj][n][2] * x[bj][n][2] + x[bj][n][3] * x[bj][n][3]); }
                ss = sum_x32(sum_x16(ss));
                const float rs = __builtin_amdgcn_rsqf(ss * (1.0f / 64.0f) + 1e-6f);
                bf16_t* rowp = P + (size_t)(u.pm * BM + lr) * 2048 + col0;
#pragma unroll
                for (int bj = 0; bj < 2; ++bj) { const int pos = lat ? (bj == 0 ? (t >> 6) : (t & 63)) : 0;
                    f32x4 o[2];
#pragma unroll
                    for (int n = 0; n < 2; ++n)
#pragma unroll
                        for (int i = 0; i < 4; ++i) { const float xv = x[bj][n][i] * rs * gn[bj][n][i]; const float pv = get_x32(xv, first);
                            const float cs = rope[(pos * 16 + i0 + 4 * n + i) * 2], sn = rope[(pos * 16 + i0 + 4 * n + i) * 2 + 1];
                            const float rot = first ? xv * cs - pv * sn : xv * cs + pv * sn;
                            o[n][i] = (lat ? rot : xv) * sc; }
                    u32x4 w; w.x = cvt_pk_bf16(o[0][0], o[0][1]); w.y = cvt_pk_bf16(o[0][2], o[0][3]); w.z = cvt_pk_bf16(o[1][0], o[1][1]); w.w = cvt_pk_bf16(o[1][2], o[1][3]);
                    *(u32x4*)(rowp + 32 * bj) = w; } }
    }
};
struct EpiGate {
    static constexpr bool PERM = true, AFTER_DRAIN = false, HAS_INIT = false;
    bf16_t* O; const float* gate; const bf16_t* X;
    __device__ __forceinline__ void operator()(const f32x4 (&acc)[2][2][4][2], const Unit& u, int wr, int wc, int fr, int fq) const {
        const int seg = u.pm / 17, rem = u.pm - seg * 17; const int j = (rem == 16) ? 16 : seg;
        const int row0 = u.pm * BM + wr * 64 + fr, col0 = u.pn * BM + wc * 32 + 8 * fq;
        const float* g = gate + (size_t)j * 6144 + col0;
        f32x4 gv[2][2];
#pragma unroll
        for (int bj = 0; bj < 2; ++bj)
#pragma unroll
            for (int n = 0; n < 2; ++n) gv[bj][n] = *(const f32x4*)(g + bj * HALF + 4 * n);
#pragma unroll
        for (int ai = 0; ai < 2; ++ai) { u32x4 xv[4][2];
#pragma unroll
            for (int m = 0; m < 4; ++m)
#pragma unroll
                for (int bj = 0; bj < 2; ++bj) xv[m][bj] = *(const __attribute__((address_space(1))) u32x4*)(X + (size_t)(row0 + ai * HALF + m * 16) * 1024 + col0 + bj * HALF);
#pragma unroll
            for (int m = 0; m < 4; ++m) { bf16_t* rowp = O + (size_t)(row0 + ai * HALF + m * 16) * 1024 + col0;
#pragma unroll
                for (int bj = 0; bj < 2; ++bj) { const u32x4 x = xv[m][bj];
                    const f32x4 x0 = {__uint_as_float(x.x << 16), __uint_as_float(x.x & 0xFFFF0000u), __uint_as_float(x.y << 16), __uint_as_float(x.y & 0xFFFF0000u)};
                    const f32x4 x1 = {__uint_as_float(x.z << 16), __uint_as_float(x.z & 0xFFFF0000u), __uint_as_float(x.w << 16), __uint_as_float(x.w & 0xFFFF0000u)};
                    const f32x4 v0 = acc[ai][bj][m][0] * gv[bj][0] + x0, v1 = acc[ai][bj][m][1] * gv[bj][1] + x1;
                    u32x4 w; w.x = cvt_pk_bf16(v0[0], v0[1]); w.y = cvt_pk_bf16(v0[2], v0[3]); w.z = cvt_pk_bf16(v1[0], v1[1]); w.w = cvt_pk_bf16(v1[2], v1[3]);
                    *(u32x4*)(rowp + bj * HALF) = w; } } }
    }
};
struct EpiLogits {
    static constexpr bool PERM = false, AFTER_DRAIN = false, HAS_INIT = false;
    float* LOG;
    __device__ __forceinline__ void operator()(const f32x4 (&acc)[2][2][4][2], const Unit& u, int wr, int wc, int fr, int fq) const {
        if (wc != 0) return;
        const int row0 = u.pm * BM + wr * 64 + fr;
#pragma unroll
        for (int ai = 0; ai < 2; ++ai)
#pragma unroll
            for (int m = 0; m < 4; ++m) { float* rowp = LOG + (size_t)(row0 + ai * HALF + m * 16) * 32 + 4 * fq;
#pragma unroll
                for (int n = 0; n < 2; ++n) *(f32x4*)(rowp + n * 16) = acc[ai][0][m][n]; }
    }
};
struct EpiSwiglu {
    static constexpr bool PERM = true, AFTER_DRAIN = false, HAS_INIT = false;
    bf16_t* ACT; const float* b1p;
    __device__ __forceinline__ void operator()(const f32x4 (&acc)[2][2][4][2], const Unit& u, int wr, int wc, int fr, int fq) const {
        const int e = u.pn >> 3, pn = u.pn & 7;
        const int row0 = u.pm * BM + wr * 64 + fr, lc = wc * 32 + 8 * fq;
        const float* bp = b1p + (size_t)e * 2048 + pn * 256 + lc;
        f32x4 bg[2], bu[2];
#pragma unroll
        for (int n = 0; n < 2; ++n) { bg[n] = *(const f32x4*)(bp + 4 * n); bu[n] = *(const f32x4*)(bp + HALF + 4 * n); }
#pragma unroll
        for (int ai = 0; ai < 2; ++ai)
#pragma unroll
            for (int m = 0; m < 4; ++m) { bf16_t* rowp = ACT + (size_t)(row0 + ai * HALF + m * 16) * 1024 + pn * 128 + lc;
                f32x4 a[2];
#pragma unroll
                for (int n = 0; n < 2; ++n) { const f32x4 gt = acc[ai][0][m][n] + bg[n], up = acc[ai][1][m][n] + bu[n];
#pragma unroll
                    for (int i = 0; i < 4; ++i) { const float gc = fminf(gt[i], 7.0f), uc = fminf(fmaxf(up[i], -7.0f), 7.0f);
                        const float sg = __builtin_amdgcn_rcpf(1.0f + __builtin_amdgcn_exp2f(gc * (-1.702f * 1.4426950408889634f)));
                        a[n][i] = (uc + 1.0f) * (gc * sg); } }
                u32x4 w; w.x = cvt_pk_bf16(a[0][0], a[0][1]); w.y = cvt_pk_bf16(a[0][2], a[0][3]); w.z = cvt_pk_bf16(a[1][0], a[1][1]); w.w = cvt_pk_bf16(a[1][2], a[1][3]);
                *(u32x4*)rowp = w; }
    }
};
struct EpiSwiglu8 {
    static constexpr bool PERM = true, AFTER_DRAIN = false, HAS_INIT = true;
    unsigned char* ACT; const float* b1p;
    __device__ __forceinline__ const float* bias_row(const Unit& u) const { const int e = u.pn >> 3, pn = u.pn & 7; return b1p + (size_t)e * 2048 + pn * 256; }
    __device__ __forceinline__ void init_lds(f32x4 (&acc)[2][2][4][2], const PG8_LAS unsigned char* bl, int wc, int fq) const {
#pragma unroll
        for (int bj = 0; bj < 2; ++bj)
#pragma unroll
            for (int n = 0; n < 2; ++n) { const f32x4 bv = *(const PG8_LAS f32x4*)(bl + (bj * HALF + wc * 32 + 8 * fq + 4 * n) * 4);
#pragma unroll
                for (int ai = 0; ai < 2; ++ai)
#pragma unroll
                    for (int m = 0; m < 4; ++m) acc[ai][bj][m][n] = bv; }
    }
    __device__ __forceinline__ void operator()(const f32x4 (&acc)[2][2][4][2], const Unit& u, int wr, int wc, int fr, int fq) const {
        const int pn = u.pn & 7;
        const int row0 = u.pm * BM + wr * 64 + fr, lc = wc * 32 + 8 * fq;
#pragma unroll
        for (int ai = 0; ai < 2; ++ai)
#pragma unroll
            for (int m = 0; m < 4; ++m) { unsigned char* rowp = ACT + (size_t)(row0 + ai * HALF + m * 16) * 1024 + pn * 128 + lc;
                f32x4 a[2];
#pragma unroll
                for (int n = 0; n < 2; ++n) { const f32x4 gt = acc[ai][0][m][n], up = acc[ai][1][m][n];
#pragma unroll
                    for (int i = 0; i < 4; ++i) { const float gc = fminf(gt[i], 7.0f), uc = __builtin_amdgcn_fmed3f(up[i], -7.0f, 7.0f);
                        const float g2 = gc * __builtin_amdgcn_rcpf(1.0f + __builtin_amdgcn_exp2f(gc * (-1.702f * 1.4426950408889634f)));
                        a[n][i] = __builtin_fmaf(uc, g2, g2); } }
                int p0 = __builtin_amdgcn_cvt_pk_fp8_f32(a[0][0], a[0][1], 0, false); p0 = __builtin_amdgcn_cvt_pk_fp8_f32(a[0][2], a[0][3], p0, true);
                int p1 = __builtin_amdgcn_cvt_pk_fp8_f32(a[1][0], a[1][1], 0, false); p1 = __builtin_amdgcn_cvt_pk_fp8_f32(a[1][2], a[1][3], p1, true);
                *(u32x2*)rowp = (u32x2){(unsigned)p0, (unsigned)p1}; }
    }
};
struct EpiDown {
    static constexpr bool PERM = true, AFTER_DRAIN = false, HAS_INIT = true;
    unsigned char* YP; const float* b2;
    __device__ __forceinline__ const float* bias_row(const Unit& u) const { const int e = u.pn >> 2, pn = u.pn & 3; return b2 + (size_t)e * 1024 + pn * BM; }
    __device__ __forceinline__ void init_lds(f32x4 (&acc)[2][2][4][2], const PG8_LAS unsigned char* bl, int wc, int fq) const {
#pragma unroll
        for (int bj = 0; bj < 2; ++bj)
#pragma unroll
            for (int n = 0; n < 2; ++n) { const f32x4 bv = *(const PG8_LAS f32x4*)(bl + (bj * HALF + wc * 32 + 8 * fq + 4 * n) * 4) * 8.0f;
#pragma unroll
                for (int ai = 0; ai < 2; ++ai)
#pragma unroll
                    for (int m = 0; m < 4; ++m) acc[ai][bj][m][n] = bv; }
    }
    __device__ __forceinline__ void operator()(const f32x4 (&acc)[2][2][4][2], const Unit& u, int wr, int wc, int fr, int fq) const {
        const int pn = u.pn & 3;
        const int row0 = u.pm * BM + wr * 64 + fr, col0 = pn * BM + wc * 32 + 8 * fq;
#pragma unroll
        for (int ai = 0; ai < 2; ++ai)
#pragma unroll
            for (int m = 0; m < 4; ++m) { unsigned char* rowp = YP + (size_t)(row0 + ai * HALF + m * 16) * 1024 + col0;
#pragma unroll
                for (int bj = 0; bj < 2; ++bj) { const f32x4 v0 = acc[ai][bj][m][0], v1 = acc[ai][bj][m][1];
                    int p0 = __builtin_amdgcn_cvt_pk_fp8_f32(v0[0], v0[1], 0, false); p0 = __builtin_amdgcn_cvt_pk_fp8_f32(v0[2], v0[3], p0, true);
                    int p1 = __builtin_amdgcn_cvt_pk_fp8_f32(v1[0], v1[1], 0, false); p1 = __builtin_amdgcn_cvt_pk_fp8_f32(v1[2], v1[3], p1, true);
                    *(u32x2*)(rowp + bj * HALF) = (u32x2){(unsigned)p0, (unsigned)p1}; } }
    }
};

template <class Epi, class Sched, bool ALIGN_EPI = false, bool SP2 = false, bool F8 = false, int F8_SW = 0x7A7A7A7A, bool GATHER = false>
__device__ __forceinline__ void gemm_phase(PG8_LAS unsigned char* lds, const Gemm g, const Sched& S, const Epi& E) {
    int tid_ = threadIdx.x; asm volatile("" : "+v"(tid_));
    const int tid = tid_, wid = __builtin_amdgcn_readfirstlane(tid >> 6), lane = tid & 63, wr = wid >> 2, wc = wid & 3, fr = lane & 15, fq = lane >> 4;
    int K_ = g.K; asm volatile("" : "+s"(K_));
    const int K = K_, nt = K / BK;
    unsigned voffA[2], voffB[2];
#pragma unroll
    for (int i = 0; i < 2; ++i) { int R, C; stage_rc(tid * 16 + i * 8192, R, C); const int Rb = Epi::PERM ? ((R & ~31) + perm32(R & 31)) : R;
        voffA[i] = (unsigned)(R * K + C) * 2u; voffB[i] = (unsigned)(Rb * K + C) * 2u; }
    const size_t kstep = (size_t)(BK * 2);
    const size_t hstep = (size_t)HALF * K * 2;
    const size_t tstep = 2 * hstep;
    const size_t hstepA = GATHER ? 0 : hstep;
    unsigned voffC[2][2];
#define PG8_VA(h, nx) (GATHER ? voffC[h] : voffA)
#define PG8_GOFF(dst, slot, unit) do { const int nv_ = S.nvalid(unit); _Pragma("unroll") for (int i_ = 0; i_ < 2; ++i_) { int R_, C_; stage_rc(tid * 16 + i_ * 8192, R_, C_); _Pragma("unroll") for (int h_ = 0; h_ < 2; ++h_) { const int ri_ = h_ * HALF + R_; \
        int ix_ = *(const PG8_LAS int*)(lds + PG8_IDX_OFF + (slot) * 1024 + ri_ * 4); ix_ = ri_ < nv_ ? ix_ : 0; dst[h_][i_] = (unsigned)ix_ * (unsigned)(K * 2) + (unsigned)C_ * 2u; } } } while (0)
    const unsigned ldsw = (unsigned)wid * 1024u;
    const int aoff = lds_byte(wr * 64 + fr, fq * 8), boff = lds_byte(wc * 32 + fr, fq * 8);
#define PG8_SA(b, h) (((b) * 2 + (h)) * HTB)
#define PG8_SB(b, h) ((4 + (b) * 2 + (h)) * HTB)
#define PG8_STAGE(bufoff, gbase, voff) do { _Pragma("unroll") for (int _i = 0; _i < 2; ++_i) \
        __builtin_amdgcn_global_load_lds((const unsigned*)((const char*)(gbase) + (voff)[_i]), (PG8_LAS unsigned*)(lds + (bufoff) + ldsw + _i * 8192), 16, 0, 0); } while (0)
#define PG8_CAT(x0, x1) __builtin_shufflevector(__builtin_bit_cast(i32x4, x0), __builtin_bit_cast(i32x4, x1), 0, 1, 2, 3, 4, 5, 6, 7)
#define PG8_LDF(base, off) (*(const PG8_LAS bf16x8*)(lds + (base) + (off)))
#define PG8_LDA(dst, dst8, b, h) do { _Pragma("unroll") for (int m = 0; m < 4; ++m) { if constexpr (F8) dst8[m] = PG8_CAT(PG8_LDF(PG8_SA(b, h), aoff + m * 2048), PG8_LDF(PG8_SA(b, h), aoff + m * 2048 + 1024)); \
        else { _Pragma("unroll") for (int k = 0; k < 2; ++k) dst[m][k] = PG8_LDF(PG8_SA(b, h), aoff + m * 2048 + k * 1024); } } } while (0)
#define PG8_LDB(dst, dst8, b, h) do { _Pragma("unroll") for (int n = 0; n < 2; ++n) { if constexpr (F8) dst8[n] = PG8_CAT(PG8_LDF(PG8_SB(b, h), boff + n * 2048), PG8_LDF(PG8_SB(b, h), boff + n * 2048 + 1024)); \
        else { _Pragma("unroll") for (int k = 0; k < 2; ++k) dst[n][k] = PG8_LDF(PG8_SB(b, h), boff + n * 2048 + k * 1024); } } } while (0)
#define PG8_MMA(ai, bj, At, At8, Bt, Bt8) do { __builtin_amdgcn_s_setprio(1); _Pragma("unroll") for (int m = 0; m < 4; ++m) _Pragma("unroll") for (int n = 0; n < 2; ++n) { \
        if constexpr (F8) asm volatile("v_mfma_scale_f32_16x16x128_f8f6f4 %0, %1, %2, %0, %3, %3 op_sel:[0,1,0] op_sel_hi:[0,0,0]" : "+v"(acc[ai][bj][m][n]) : "v"(Bt8[n]), "v"(At8[m]), "v"(f8_s));   \
        else { _Pragma("unroll") for (int k = 0; k < 2; ++k) acc[ai][bj][m][n] = __builtin_amdgcn_mfma_f32_16x16x32_bf16(Bt[n][k], At[m][k], acc[ai][bj][m][n], 0, 0, 0); } } __builtin_amdgcn_s_setprio(0); } while (0)
#define PG8_WAIT_V(n) asm volatile("s_waitcnt vmcnt(" #n ")" ::: "memory")
#define PG8_WAIT_L(n) asm volatile("s_waitcnt lgkmcnt(" #n ")" ::: "memory")
#define PG8_BAR __builtin_amdgcn_s_barrier()
#define PG8_SCHED __builtin_amdgcn_sched_barrier(0)
    Unit cur, nxt; int ui = 0;
    if (!S.next(0, cur)) return;
    f32x4 acc[2][2][4][2];
    if constexpr (Epi::HAS_INIT) { if (wid == 0) __builtin_amdgcn_global_load_lds((const unsigned*)(E.bias_row(cur) + lane * 4), (PG8_LAS unsigned*)(lds + PG8_BIAS_OFF), 16, 0, 0); }
    else {
#pragma unroll
    for (int a = 0; a < 2; ++a)
#pragma unroll
        for (int b = 0; b < 2; ++b)
#pragma unroll
            for (int m = 0; m < 4; ++m)
#pragma unroll
                for (int n = 0; n < 2; ++n) acc[a][b][m][n] = (f32x4){0.f, 0.f, 0.f, 0.f};
    }
    int f8_s = 0x7F00 | (F8_SW & 0xFF); asm volatile("" : "+v"(f8_s));
    bf16x8 At[4][2], B0[2][2], B1[2][2]; i32x8 At8[4], B08[2], B18[2];
    const char* cA = (const char*)g.A + (GATHER ? (size_t)0 : (size_t)cur.pm * tstep); const char* cB = (const char*)g.Bt + (size_t)cur.pn * tstep;
    if constexpr (GATHER) { if (wid == 0) __builtin_amdgcn_global_load_lds((const unsigned*)(S.idx_src(cur) + lane * 4), (PG8_LAS unsigned*)(lds + PG8_IDX_OFF), 16, 0, 0);
        PG8_WAIT_V(0); PG8_BAR; PG8_GOFF(voffC, 0, cur); }
    S.a_ready(cur);
    if constexpr (SP2) {
        PG8_STAGE(PG8_SB(0, 0), cB, voffB); PG8_STAGE(PG8_SB(0, 1), cB + hstep, voffB); PG8_STAGE(PG8_SA(0, 0), cA, PG8_VA(0, false)); PG8_STAGE(PG8_SA(0, 1), cA + hstepA, PG8_VA(1, false));
        if (wr == 1) PG8_BAR;
        PG8_WAIT_V(2); PG8_BAR;
        PG8_STAGE(PG8_SB(1, 0), cB + kstep, voffB); PG8_STAGE(PG8_SA(1, 0), cA + kstep, PG8_VA(0, false)); PG8_STAGE(PG8_SB(1, 1), cB + hstep + kstep, voffB);
        PG8_WAIT_V(6); PG8_BAR;
    } else {
        PG8_STAGE(PG8_SB(0, 0), cB, voffB); PG8_STAGE(PG8_SA(0, 0), cA, PG8_VA(0, false)); PG8_STAGE(PG8_SB(0, 1), cB + hstep, voffB); PG8_STAGE(PG8_SA(0, 1), cA + hstepA, PG8_VA(1, false));
        if (wr == 1) PG8_BAR;
        PG8_WAIT_V(4); PG8_BAR;
        PG8_STAGE(PG8_SB(1, 0), cB + kstep, voffB); PG8_STAGE(PG8_SA(1, 0), cA + kstep, PG8_VA(0, false)); PG8_STAGE(PG8_SB(1, 1), cB + hstep + kstep, voffB);
        PG8_WAIT_V(6); PG8_BAR;
    }
    if constexpr (Epi::HAS_INIT) E.init_lds(acc, lds + PG8_BIAS_OFF, wc, fq);
    for (;;) {
        const bool has_next = S.next(ui + 1, nxt);
        if constexpr (Epi::HAS_INIT) { if (has_next && wid == 0) __builtin_amdgcn_global_load_lds((const unsigned*)(E.bias_row(nxt) + lane * 4), (PG8_LAS unsigned*)(lds + PG8_BIAS_OFF + ((ui + 1) & 1) * 1024), 16, 0, 0); }
        if constexpr (GATHER) { if (has_next && wid == 0) __builtin_amdgcn_global_load_lds((const unsigned*)(S.idx_src(nxt) + lane * 4), (PG8_LAS unsigned*)(lds + PG8_IDX_OFF + ((ui + 1) & 1) * 1024), 16, 0, 0); }
        const char* nA = has_next ? (const char*)g.A + (GATHER ? (size_t)0 : (size_t)nxt.pm * tstep) : cA; const char* nB = has_next ? (const char*)g.Bt + (size_t)nxt.pn * tstep : cB;
        for (int t = 0; t < nt; t += 2) {
            const bool last = (t == nt - 2);
            const char* a1 = cA + (size_t)(t + 1) * kstep;
            const char* a2 = last ? nA : cA + (size_t)(t + 2) * kstep; const char* b2 = last ? nB : cB + (size_t)(t + 2) * kstep;
            const char* a3 = a2 + kstep; const char* b3 = b2 + kstep;
            if (last && has_next) S.a_ready(nxt);
            if constexpr (SP2) {
            PG8_LDB(B0, B08, 0, 0); PG8_LDB(B1, B18, 0, 1); PG8_SCHED; PG8_LDA(At, At8, 0, 0); PG8_STAGE(PG8_SA(1, 1), a1 + hstepA, PG8_VA(1, false));
            if constexpr (GATHER) { if (last && has_next) PG8_GOFF(voffC, (ui + 1) & 1, nxt); }
            PG8_WAIT_V(8); PG8_WAIT_L(0); PG8_BAR; PG8_MMA(0, 0, At, At8, B0, B08); PG8_MMA(0, 1, At, At8, B1, B18); PG8_BAR; PG8_SCHED;
            PG8_LDA(At, At8, 0, 1); PG8_STAGE(PG8_SB(0, 0), b2, voffB); PG8_STAGE(PG8_SB(0, 1), b2 + hstep, voffB); PG8_STAGE(PG8_SA(0, 0), a2, PG8_VA(0, last));
            PG8_WAIT_V(8); PG8_WAIT_L(0); PG8_BAR; PG8_MMA(1, 0, At, At8, B0, B08); PG8_MMA(1, 1, At, At8, B1, B18); PG8_BAR; PG8_SCHED;
            PG8_LDB(B0, B08, 1, 0); PG8_LDB(B1, B18, 1, 1); PG8_SCHED; PG8_LDA(At, At8, 1, 0); PG8_STAGE(PG8_SA(0, 1), a2 + hstepA, PG8_VA(1, last));
            PG8_WAIT_V(8); PG8_WAIT_L(0); PG8_BAR; PG8_MMA(0, 0, At, At8, B0, B08); PG8_MMA(0, 1, At, At8, B1, B18); PG8_BAR; PG8_SCHED;
            PG8_LDA(At, At8, 1, 1); PG8_STAGE(PG8_SB(1, 0), b3, voffB); PG8_STAGE(PG8_SB(1, 1), b3 + hstep, voffB); PG8_STAGE(PG8_SA(1, 0), a3, PG8_VA(0, last));
            PG8_WAIT_V(8); PG8_WAIT_L(0); PG8_BAR; PG8_MMA(1, 0, At, At8, B0, B08); PG8_MMA(1, 1, At, At8, B1, B18); PG8_BAR; PG8_SCHED;
            } else {
            PG8_LDB(B0, B08, 0, 0); PG8_SCHED; PG8_LDA(At, At8, 0, 0); PG8_STAGE(PG8_SA(1, 1), a1 + hstepA, PG8_VA(1, false));
            PG8_WAIT_L(8); PG8_BAR; PG8_WAIT_L(0); PG8_MMA(0, 0, At, At8, B0, B08); PG8_BAR; PG8_SCHED;
            PG8_LDB(B1, B18, 0, 1); PG8_STAGE(PG8_SB(0, 0), b2, voffB);
            PG8_BAR; PG8_WAIT_L(0); PG8_MMA(0, 1, At, At8, B1, B18); PG8_BAR;
            PG8_LDA(At, At8, 0, 1); PG8_STAGE(PG8_SA(0, 0), a2, PG8_VA(0, last));
            PG8_BAR; PG8_WAIT_L(0); PG8_MMA(1, 0, At, At8, B0, B08); PG8_BAR; PG8_SCHED;
            PG8_STAGE(PG8_SB(0, 1), b2 + hstep, voffB);
            PG8_WAIT_V(6); PG8_BAR; PG8_MMA(1, 1, At, At8, B1, B18); PG8_BAR;
            PG8_LDB(B0, B08, 1, 0); PG8_SCHED; PG8_LDA(At, At8, 1, 0); PG8_STAGE(PG8_SA(0, 1), a2 + hstepA, PG8_VA(1, last));
            PG8_WAIT_L(8); PG8_BAR; PG8_WAIT_L(0); PG8_MMA(0, 0, At, At8, B0, B08); PG8_BAR; PG8_SCHED;
            PG8_LDB(B1, B18, 1, 1); PG8_STAGE(PG8_SB(1, 0), b3, voffB);
            PG8_BAR; PG8_WAIT_L(0); PG8_MMA(0, 1, At, At8, B1, B18); PG8_BAR;
            PG8_LDA(At, At8, 1, 1); PG8_STAGE(PG8_SA(1, 0), a3, PG8_VA(0, last));
            PG8_BAR; PG8_WAIT_L(0); PG8_MMA(1, 0, At, At8, B0, B08); PG8_BAR; PG8_SCHED;
            PG8_STAGE(PG8_SB(1, 1), b3 + hstep, voffB);
            PG8_WAIT_V(6); PG8_BAR; PG8_MMA(1, 1, At, At8, B1, B18); PG8_BAR;
            }
        }
        if constexpr (ALIGN_EPI) { if (wr == 0) PG8_BAR; }
        if constexpr (F8) asm volatile("s_nop 15\n\ts_nop 15" ::: "memory");
        if constexpr (!Epi::AFTER_DRAIN) { E(acc, cur, wr, wc, fr, fq); S.done(cur); }
        if (!has_next) break;
        if constexpr (Epi::HAS_INIT) E.init_lds(acc, lds + PG8_BIAS_OFF + ((ui + 1) & 1) * 1024, wc, fq); else {
#pragma unroll
        for (int a = 0; a < 2; ++a)
#pragma unroll
            for (int b = 0; b < 2; ++b)
#pragma unroll
                for (int m = 0; m < 4; ++m)
#pragma unroll
                    for (int n = 0; n < 2; ++n) acc[a][b][m][n] = (f32x4){0.f, 0.f, 0.f, 0.f};
        }
        cur = nxt; cA = nA; cB = nB; ++ui;

        if constexpr (ALIGN_EPI) { if (wr == 1) PG8_BAR; }
    }
    PG8_WAIT_V(0);
    if constexpr (!ALIGN_EPI) { if (wr == 0) PG8_BAR; }
    PG8_BAR;
    if constexpr (Epi::AFTER_DRAIN) { E.fused(acc, cur, wr, wc, fr, fq, lds, wid, lane); S.done(cur); }
#undef PG8_SA
#undef PG8_SB
#undef PG8_STAGE
#undef PG8_VA
#undef PG8_GOFF
#undef PG8_LDA
#undef PG8_LDF
#undef PG8_LDB
#undef PG8_MMA
#undef PG8_CAT
#undef PG8_WAIT_V
#undef PG8_WAIT_L
#undef PG8_BAR
#undef PG8_SCHED
}
}
#ifndef ATTN_STORE16
#define ATTN_STORE16(p,v) (*(u32x4*)(p)=(v))
#endif
namespace attn_body {
using bf16=__hip_bfloat16;
using bf16x8=__attribute__((ext_vector_type(8)))short;
using s16x4=__attribute__((ext_vector_type(4)))short;
using f32x16=__attribute__((ext_vector_type(16)))float;
using u32x4=__attribute__((ext_vector_type(4)))unsigned;
constexpr int D=64,PQ=2048,PO=1024,KOFF=512,VOFF=640;
constexpr int NW=8,QBLK=32,QB=QBLK*NW,KVBLK=64;
__device__ __forceinline__ int crow(int r,int hi){return (r&3)+8*(r>>2)+4*hi;}
#define SBAR() __builtin_amdgcn_sched_barrier(0)
constexpr int NSLOT=3, SLOTB=8192;
constexpr int LDS_K=0, LDS_V=NSLOT*SLOTB, LDS_WS=2*NSLOT*SLOTB, LDS_OST=LDS_WS+NW*64*4, LDS_BYTES=LDS_OST+NW*4096;
constexpr float C2=0.125f*1.4426950408889634f;
__device__ __forceinline__ void glds16(const void*gsrc,unsigned lds_dst){unsigned keep;
  asm volatile("s_mov_b32 %0, m0\n\ts_mov_b32 m0, %2\n\ts_nop 0\n\tglobal_load_lds_dwordx4 %1, off\n\ts_mov_b32 m0, %0":"=&s"(keep):"v"(gsrc),"s"(lds_dst):"memory");}
__device__ __forceinline__ float max3f(float a,float b,float c){float r;asm("v_max3_f32 %0, %1, %2, %3":"=v"(r):"v"(a),"v"(b),"v"(c));return r;}
__device__ __forceinline__ float max2f(float a,float b){float r;asm("v_max_f32_e32 %0, %1, %2":"=v"(r):"v"(a),"v"(b));return r;}
__device__ __forceinline__ float fadd_s(float a,float b){float r;asm("v_add_f32_e32 %0, %1, %2":"=v"(r):"v"(a),"v"(b));return r;}
__device__ __forceinline__ float fsub_s(float a,float b){float r;asm("v_sub_f32_e32 %0, %1, %2":"=v"(r):"v"(a),"v"(b));return r;}
typedef float f32x2_t __attribute__((ext_vector_type(2))); typedef __bf16 bf16x2_t __attribute__((ext_vector_type(2)));
__device__ __forceinline__ unsigned cvtpk_s(float lo,float hi){f32x2_t v={lo,hi};bf16x2_t b=__builtin_convertvector(v,bf16x2_t);return __builtin_bit_cast(unsigned,b);}
#define WAIT_BAR(N) asm volatile("s_waitcnt vmcnt(" #N ") lgkmcnt(0)\n\ts_barrier":::"memory")

__device__ __forceinline__ void qkt(f32x16&p0,f32x16&p1,const char*Kslot,const bf16x8*qr,const f32x16&negm,int r32,int hi){
  const char*kb=Kslot+hi*1024+r32*16;
  #pragma unroll
  for(int d0=0;d0<4;++d0){
    const bf16x8 b0=*reinterpret_cast<const bf16x8*>(kb+d0*2048);
    const bf16x8 b1=*reinterpret_cast<const bf16x8*>(kb+d0*2048+512);
    if(d0==0){p0=__builtin_amdgcn_mfma_f32_32x32x16_bf16(b0,qr[0],negm,0,0,0);p1=__builtin_amdgcn_mfma_f32_32x32x16_bf16(b1,qr[0],negm,0,0,0);}
    else{p0=__builtin_amdgcn_mfma_f32_32x32x16_bf16(b0,qr[d0],p0,0,0,0);p1=__builtin_amdgcn_mfma_f32_32x32x16_bf16(b1,qr[d0],p1,0,0,0);}}
}
typedef __attribute__((address_space(3))) const char* lds_cptr;
typedef short v4i16_t __attribute__((ext_vector_type(4)));
__device__ __forceinline__ void kload8(bf16x8*kf,lds_cptr kp){
  kf[0]=*(const __attribute__((address_space(3))) bf16x8*)(kp);      kf[1]=*(const __attribute__((address_space(3))) bf16x8*)(kp+512);
  kf[2]=*(const __attribute__((address_space(3))) bf16x8*)(kp+2048); kf[3]=*(const __attribute__((address_space(3))) bf16x8*)(kp+2560);
  kf[4]=*(const __attribute__((address_space(3))) bf16x8*)(kp+4096); kf[5]=*(const __attribute__((address_space(3))) bf16x8*)(kp+4608);
  kf[6]=*(const __attribute__((address_space(3))) bf16x8*)(kp+6144); kf[7]=*(const __attribute__((address_space(3))) bf16x8*)(kp+6656);
}
__device__ __forceinline__ void kload2(bf16x8*kf,lds_cptr kp,int j){ kf[2*j]=*(const __attribute__((address_space(3))) bf16x8*)(kp+j*2048); kf[2*j+1]=*(const __attribute__((address_space(3))) bf16x8*)(kp+j*2048+512); }
__device__ __forceinline__ s16x4 vtr(lds_cptr p){ return __builtin_bit_cast(s16x4,__builtin_amdgcn_ds_read_tr16_b64_v4i16((__attribute__((address_space(3))) v4i16_t*)p)); }
__device__ __forceinline__ float rowmax(const f32x16&p0,const f32x16&p1){
  float a=max3f(p0[0],p0[1],p1[0]),b=max3f(p0[2],p0[3],p1[1]);a=max3f(a,p1[2],p1[3]);
  #pragma unroll
  for(int r=4;r<16;r+=4){a=max3f(a,p0[r],p0[r+1]);b=max3f(b,p0[r+2],p0[r+3]);a=max3f(a,p1[r],p1[r+1]);b=max3f(b,p1[r+2],p1[r+3]);}
  const float m=max2f(a,b);
  auto rr=__builtin_amdgcn_permlane32_swap(__float_as_uint(m),__float_as_uint(m),false,false);
  return max2f(__uint_as_float(rr[0]),__uint_as_float(rr[1]));
}
__device__ __forceinline__ void pv(f32x16*o,int vb,bf16x8 pa0,bf16x8 pa1,bf16x8 pa2,bf16x8 pa3){
  #pragma unroll
  for(int d0=0;d0<2;++d0){s16x4 lo[4],hi[4];
    #pragma unroll
    for(int ks=0;ks<4;++ks){
      asm volatile("ds_read_b64_tr_b16 %0,%1 offset:%c2":"=&v"(lo[ks]):"v"(vb),"i"(d0*4096+ks*1024):"memory");
      asm volatile("ds_read_b64_tr_b16 %0,%1 offset:%c2":"=&v"(hi[ks]):"v"(vb),"i"(d0*4096+ks*1024+512):"memory");}
    asm volatile("s_waitcnt lgkmcnt(0)":::"memory");SBAR();
    #define PK(k) (bf16x8){lo[k][0],lo[k][1],lo[k][2],lo[k][3],hi[k][0],hi[k][1],hi[k][2],hi[k][3]}
    o[d0]=__builtin_amdgcn_mfma_f32_32x32x16_bf16(pa0,PK(0),o[d0],0,0,0);
    o[d0]=__builtin_amdgcn_mfma_f32_32x32x16_bf16(pa1,PK(1),o[d0],0,0,0);
    o[d0]=__builtin_amdgcn_mfma_f32_32x32x16_bf16(pa2,PK(2),o[d0],0,0,0);
    o[d0]=__builtin_amdgcn_mfma_f32_32x32x16_bf16(pa3,PK(3),o[d0],0,0,0);
    #undef PK
  }
}

template<int THRL,bool FIXR=false> __device__ __forceinline__ void attn_unit(long qrow0,long krow0,int NTarg,int h,const bf16*Pq,bf16*Yo,char*shm,int koff=0){
  int tid_=threadIdx.x; asm volatile("":"+v"(tid_)); const int tid=tid_,lane=tid&63,r32=lane&31,hi=lane>>5; const int wid=__builtin_amdgcn_readfirstlane(tid>>6);
  const bf16*Qw=Pq+(qrow0+wid*QBLK)*PQ+h*D;
  const bf16*Kh=Pq+krow0*PQ+KOFF+(h>>2)*D,*Vh=Pq+krow0*PQ+VOFF+(h>>2)*D;
  const unsigned lds0=(unsigned)(uintptr_t)shm;
  float*wsf=(float*)(shm+LDS_WS)+wid*64;
  const bf16*ksrc=Kh+(long)lane*PQ+wid*8;
  const bf16*vsrc=Vh+(long)(16*(wid&3)+(lane>>2))*PQ+(wid>>2)*32+(lane&3)*8;
  const unsigned kdst=lds0+LDS_K+wid*1024, vdst=lds0+LDS_V+wid*1024;
  #define KVT(t) ({int t_=(t)+koff; t_>=NTarg?t_-NTarg:t_;})
  #define DMA_K(t,slot) glds16(ksrc+(long)KVT(t)*KVBLK*PQ,(unsigned)__builtin_amdgcn_readfirstlane(kdst+(slot)))
  #define DMA_V(t,slot) glds16(vsrc+(long)KVT(t)*KVBLK*PQ,(unsigned)__builtin_amdgcn_readfirstlane(vdst+(slot)))
  const int vb0=(int)(lds0+LDS_V)+((lane>>4)&1)*32+(lane&3)*8+(4*hi+((lane&15)>>2))*64;
  const char*Kbase=shm+LDS_K; bf16x8 kf[8];
  const lds_cptr shm3=(lds_cptr)shm; const lds_cptr kp0=shm3+LDS_K+hi*1024+r32*16; const lds_cptr vp0=shm3+LDS_V+((lane>>4)&1)*32+(lane&3)*8+(4*hi+((lane&15)>>2))*64;
  const int NT=NTarg;
  DMA_K(0,0);DMA_V(0,0);DMA_K(1,SLOTB);
  bf16x8 qr[4];
  #pragma unroll
  for(int d0=0;d0<4;++d0)qr[d0]=*reinterpret_cast<const bf16x8*>(&Qw[(long)r32*PQ+d0*16+hi*8]);
  float mhat=0.f,l_reg=0.f;f32x16 o[2];o[0]=f32x16{};o[1]=f32x16{};f32x16 negm=f32x16{}; if constexpr(!FIXR)asm volatile("":"+v"(negm));

  #define CMASK(P0,P1,t) do{}while(0)
  bool resc=false;
  #define START(P0,P1) do{ resc=false; \
    if constexpr(!FIXR){ const float rm=rowmax(P0,P1); const float dl=rm; mhat=fadd_s(mhat,dl); \
      _Pragma("unroll") for(int r=0;r<16;++r){P0[r]=fsub_s(P0[r],dl);P1[r]=fsub_s(P1[r],dl);} \
      _Pragma("unroll") for(int r=0;r<16;++r)negm[r]=-mhat; asm volatile("":"+v"(negm)); } \
    _Pragma("unroll") for(int r=0;r<16;++r)P0[r]=__builtin_amdgcn_exp2f(P0[r]); }while(0)
  #define RESC() do{ if(resc){ asm volatile("s_waitcnt lgkmcnt(0)":::"memory"); \
      _Pragma("unroll") for(int d_=0;d_<2;++d_) _Pragma("unroll") for(int r=0;r<16;++r)o[d_][r]*=wsf[crow(r,hi)]; } }while(0)
  f32x16 pA0,pA1,pB0,pB1;
  int sl_prev=0,sl_cur=0,sl_next=SLOTB;
  #define ROT() do{sl_prev=sl_cur;sl_cur=sl_next;sl_next=(sl_next==(NSLOT-1)*SLOTB)?0:sl_next+SLOTB;}while(0)
  DMA_K(2,2*SLOTB);
  WAIT_BAR(3);
  qkt(pA0,pA1,Kbase,qr,negm,r32,hi);asm volatile("s_nop 15\n\ts_nop 7":"+v"(pA0),"+v"(pA1));CMASK(pA0,pA1,0);
  START(pA0,pA1);
  _Pragma("unroll") for(int r=0;r<16;++r)pA1[r]=__builtin_amdgcn_exp2f(pA1[r]);
  WAIT_BAR(0);
  DMA_K(3,0);DMA_V(1,SLOTB);
  ROT();
  kload8(kf,kp0+sl_cur);
  WAIT_BAR(2);
  s16x4 vlo[8],vhi[8]; u32x4 pw0,pw1,pw2,pw3;
  #define PKW(P,B) cvtpk_s(P[B],P[B+1])
  #define PAF(k) __builtin_bit_cast(bf16x8,pw##k)
  #define VFR(i) (bf16x8){vlo[i][0],vlo[i][1],vlo[i][2],vlo[i][3],vhi[i][0],vhi[i][1],vhi[i][2],vhi[i][3]}
  #define PIN(x) asm volatile("":"+v"(x))
  #define MX3(a,b,c) __builtin_fmaxf(__builtin_fmaxf((a),(b)),(c))
  #define GAPA(MF,A0,A1,A2,A3,W0,W1,PW) do{ MF; sacc+=A0; sacc+=A1; sacc+=A2; sacc+=A3; PIN(sacc); W0; W1; PIN(PW); SBAR(); }while(0)
  #define EX(v) __builtin_amdgcn_exp2f(v)
  #define GAPB(MF,X,B) do{ MF; X[B]=EX(X[B]); X[B+1]=EX(X[B+1]); X[B+2]=EX(X[B+2]); X[B+3]=EX(X[B+3]); PIN(X); SBAR(); }while(0)
  #define VRD(i) do{ vlo[i]=vtr(vp_+(((i)>>2)*4096+((i)&3)*1024)); vhi[i]=vtr(vp_+(((i)>>2)*4096+((i)&3)*1024+512)); }while(0)
  #define KRD(G,j) do{ if(G){ kload2(kf,kp0+sl_next,j); SBAR(); } }while(0)
  #define STEP(C0,C1,P0,P1,t,GK,GV,GL) do{ SBAR(); \
    const lds_cptr vp_=vp0+sl_prev; \
    VRD(0); SBAR(); float sacc=(P0[0]+P0[1]); \
    GAPA(C0=__builtin_amdgcn_mfma_f32_32x32x16_bf16(kf[0],qr[0],negm,0,0,0), P0[2],P0[3],P0[4],P0[5],     pw0[0]=PKW(P0,0), pw0[1]=PKW(P0,2), pw0); \
    VRD(4); SBAR(); GAPA(C1=__builtin_amdgcn_mfma_f32_32x32x16_bf16(kf[1],qr[0],negm,0,0,0), P0[6],P0[7],P0[8],P0[9],     pw0[2]=PKW(P0,4), pw0[3]=PKW(P0,6), pw0); \
    VRD(1); SBAR(); GAPA(C0=__builtin_amdgcn_mfma_f32_32x32x16_bf16(kf[2],qr[1],C0,0,0,0),   P0[10],P0[11],P0[12],P0[13], pw1[0]=PKW(P0,8), pw1[1]=PKW(P0,10), pw1); \
    VRD(5); SBAR(); GAPA(C1=__builtin_amdgcn_mfma_f32_32x32x16_bf16(kf[3],qr[1],C1,0,0,0),   P0[14],P0[15],P1[0],P1[1],   pw1[2]=PKW(P0,12),pw1[3]=PKW(P0,14), pw1); \
    VRD(2); SBAR(); GAPA(C0=__builtin_amdgcn_mfma_f32_32x32x16_bf16(kf[4],qr[2],C0,0,0,0),   P1[2],P1[3],P1[4],P1[5],     pw2[0]=PKW(P1,0), pw2[1]=PKW(P1,2), pw2); \
    VRD(6); SBAR(); GAPA(C1=__builtin_amdgcn_mfma_f32_32x32x16_bf16(kf[5],qr[2],C1,0,0,0),   P1[6],P1[7],P1[8],P1[9],     pw2[2]=PKW(P1,4), pw2[3]=PKW(P1,6), pw2); \
    VRD(3); SBAR(); GAPA(C0=__builtin_amdgcn_mfma_f32_32x32x16_bf16(kf[6],qr[3],C0,0,0,0),   P1[10],P1[11],P1[12],P1[13], pw3[0]=PKW(P1,8), pw3[1]=PKW(P1,10), pw3); \
    VRD(7); SBAR(); GAPA(C1=__builtin_amdgcn_mfma_f32_32x32x16_bf16(kf[7],qr[3],C1,0,0,0),   P1[14],P1[15],0.f,0.f,       pw3[2]=PKW(P1,12),pw3[3]=PKW(P1,14), pw3); \
    l_reg+=sacc; \
    if(GK){DMA_K((t)+3,sl_cur);} if(GV){DMA_V((t)+1,sl_next);} \
    CMASK(C0,C1,t); \
    resc=false; \
    if constexpr(!FIXR){ float a=MX3(C0[0],C0[1],C1[0]),b=MX3(C0[2],C0[3],C1[1]); a=MX3(a,C1[2],C1[3]); \
      _Pragma("unroll") for(int r=4;r<16;r+=4){a=MX3(a,C0[r],C0[r+1]);b=MX3(b,C0[r+2],C0[r+3]);a=MX3(a,C1[r],C1[r+1]);b=MX3(b,C1[r+2],C1[r+3]);} \
      float rm=__builtin_fmaxf(a,b); { auto rr=__builtin_amdgcn_permlane32_swap(__float_as_uint(rm),__float_as_uint(rm),false,false); rm=__builtin_fmaxf(__uint_as_float(rr[0]),__uint_as_float(rr[1])); } \
      if(__builtin_expect(__any(rm>(float)THRL),0)){ const float dl=__builtin_fmaxf(rm,0.f); mhat+=dl; \
        _Pragma("unroll") for(int r=0;r<16;++r){C0[r]-=dl;C1[r]-=dl;} \
        _Pragma("unroll") for(int r=0;r<16;++r)negm[r]=-mhat; asm volatile("":"+v"(negm)); \
        const float f=__builtin_amdgcn_exp2f(-dl); l_reg*=f; if(hi==0)wsf[r32]=f; resc=true; } } \
    SBAR(); \
    GAPB(o[0]=__builtin_amdgcn_mfma_f32_32x32x16_bf16(PAF(0),VFR(0),o[0],0,0,0), C0,0); \
    GAPB(o[1]=__builtin_amdgcn_mfma_f32_32x32x16_bf16(PAF(0),VFR(4),o[1],0,0,0), C0,4); \
    KRD(GL,0); GAPB(o[0]=__builtin_amdgcn_mfma_f32_32x32x16_bf16(PAF(1),VFR(1),o[0],0,0,0), C0,8); \
    KRD(GL,1); GAPB(o[1]=__builtin_amdgcn_mfma_f32_32x32x16_bf16(PAF(1),VFR(5),o[1],0,0,0), C0,12); \
    KRD(GL,2); GAPB(o[0]=__builtin_amdgcn_mfma_f32_32x32x16_bf16(PAF(2),VFR(2),o[0],0,0,0), C1,0); \
    KRD(GL,3); GAPB(o[1]=__builtin_amdgcn_mfma_f32_32x32x16_bf16(PAF(2),VFR(6),o[1],0,0,0), C1,4); \
    GAPB(o[0]=__builtin_amdgcn_mfma_f32_32x32x16_bf16(PAF(3),VFR(3),o[0],0,0,0), C1,8); \
    GAPB(o[1]=__builtin_amdgcn_mfma_f32_32x32x16_bf16(PAF(3),VFR(7),o[1],0,0,0), C1,12); \
    }while(0)
  int t=1;
  #undef CMASK
  #define CMASK(P0,P1,t) do{}while(0)
  for(;t+5<NT;t+=2){
    STEP(pB0,pB1,pA0,pA1,t,true,true,true);     WAIT_BAR(2); RESC(); ROT();
    STEP(pA0,pA1,pB0,pB1,t+1,true,true,true);   WAIT_BAR(2); RESC(); ROT();
  }
  #undef CMASK
  #define CMASK(P0,P1,t) do{}while(0)
  #define ENDW(tt) do{ if((tt)+3<NT){WAIT_BAR(2);} else if((tt)+2<NT){WAIT_BAR(1);} else {WAIT_BAR(0);} }while(0)
  for(;t+1<NT;t+=2){
    STEP(pB0,pB1,pA0,pA1,t,(t+3<NT),(t+1<NT),(t+1<NT));       ENDW(t);   RESC(); ROT();
    STEP(pA0,pA1,pB0,pB1,t+1,(t+4<NT),(t+2<NT),(t+2<NT));     ENDW(t+1); RESC(); ROT();
  }
  STEP(pB0,pB1,pA0,pA1,NT-1,false,false,false); RESC();
  { float sacc=pB0[0]+pB0[1]; _Pragma("unroll") for(int r=2;r<16;++r)sacc+=pB0[r]; _Pragma("unroll") for(int r=0;r<16;++r)sacc+=pB1[r]; l_reg+=sacc;
    pw0=(u32x4){PKW(pB0,0),PKW(pB0,2),PKW(pB0,4),PKW(pB0,6)};pw1=(u32x4){PKW(pB0,8),PKW(pB0,10),PKW(pB0,12),PKW(pB0,14)};pw2=(u32x4){PKW(pB1,0),PKW(pB1,2),PKW(pB1,4),PKW(pB1,6)};pw3=(u32x4){PKW(pB1,8),PKW(pB1,10),PKW(pB1,12),PKW(pB1,14)};
    SBAR(); pv(o,vb0+sl_cur,PAF(0),PAF(1),PAF(2),PAF(3)); }
  #undef PKW
  #undef PAF
  #undef VFR
  #undef PIN
  #undef MX3
  #undef GAPA
  #undef GAPB
  #undef EX
  #undef VRD
  #undef KRD
  #undef STEP
  #undef ENDW
  {auto rr=__builtin_amdgcn_permlane32_swap(__float_as_uint(l_reg),__float_as_uint(l_reg),false,false);l_reg=__uint_as_float(rr[0])+__uint_as_float(rr[1]);}
  if(hi==0)wsf[32+r32]=l_reg;asm volatile("s_waitcnt lgkmcnt(0)":::"memory");
  float rli[16];
  #pragma unroll
  for(int r=0;r<16;++r)rli[r]=__builtin_amdgcn_rcpf(wsf[32+crow(r,hi)]);
  bf16*Ow=Yo+(qrow0+wid*QBLK)*PO+h*D;
  { bf16*stg=(bf16*)(shm+LDS_OST)+wid*2048;
    #pragma unroll
    for(int r=0;r<16;++r){const int orow=crow(r,hi);
      #pragma unroll
      for(int d0=0;d0<2;++d0)stg[orow*64+d0*32+r32]=__float2bfloat16(o[d0][r]*rli[r]);}
    asm volatile("s_waitcnt lgkmcnt(0)":::"memory");
    #pragma unroll
    for(int i=0;i<4;++i){const int row=i*8+(lane>>3),ch=lane&7; const u32x4 v=*(const u32x4*)(stg+row*64+ch*8); ATTN_STORE16(Ow+(long)row*PO+ch*8,v);} }
  asm volatile("s_waitcnt lgkmcnt(0)\n\ts_barrier":::"memory");
  #undef DMA_K
  #undef KVT
  #undef DMA_V
  #undef CMASK
  #undef START
  #undef RESC
  #undef ROT
}
constexpr int ATTN_LDS_BYTES=LDS_BYTES;
#undef SBAR
#undef WAIT_BAR
}
#ifndef MK_FP8_IN
#define MK_FP8_IN 0
#endif
#ifndef MK_FP8
#define MK_FP8 1
#endif
namespace mk {
constexpr int NB = 16, SQ = 4096, CL = 256, SEG = SQ + CL, T = NB * SEG, D = 1024, INW = 2048, NL = 4, NE = 32;
constexpr int NROWT = T / 256;
constexpr int MAXRT = 1120, CAP = MAXRT * 256;
constexpr int MODW = 6 * D;
constexpr float EPS = 1e-6f;
constexpr int NWAVES = 8;
constexpr int PPL = 12, NPHASE = 2 + NL * PPL;

constexpr size_t MiB = 1u << 20;
constexpr size_t WS_CTL = 0, CTL_ZERO_BYTES = 1 * MiB;
constexpr size_t WS_MOD = 4 * MiB;
constexpr size_t WS_B1P = 6 * MiB;
constexpr size_t WS_PAIR = 8 * MiB;
constexpr size_t WS_TOK = 12 * MiB;
constexpr size_t WS_LOG = 22 * MiB;
constexpr size_t WS_WINT = 32 * MiB;
constexpr size_t WS_WOUTT = 50 * MiB;
constexpr size_t WS_WRT = 60 * MiB;
constexpr size_t WS_W1T = 64 * MiB;
constexpr size_t WS_W2T = 576 * MiB;
constexpr size_t WS_X = 832 * MiB;
constexpr size_t WS_HB = 1104 * MiB;
constexpr size_t WS_P = 1240 * MiB;
constexpr size_t WS_Y = 1512 * MiB;
constexpr size_t WS_HP = 1648 * MiB;
constexpr size_t WS_OB = (1648 + 288) * MiB;
constexpr size_t WS_ACT = 2208 * MiB;
constexpr size_t WS_YP = 2768 * MiB;
constexpr size_t WS_HB8 = 3328 * MiB;
constexpr size_t WS_END = 3400 * MiB;
static_assert(WS_MOD + (size_t)NL * 17 * MODW * 4 <= WS_B1P && WS_B1P + (size_t)NL * NE * 2048 * 4 <= WS_PAIR && WS_PAIR + (size_t)T * 32 <= WS_TOK && WS_TOK + (size_t)NE * T * 4 <= WS_LOG && WS_LOG + (size_t)T * 128 <= WS_WINT, "ws map 1");
static_assert(WS_WINT + (size_t)NL * 2048 * 1024 * 2 <= WS_WOUTT && WS_WOUTT + (size_t)NL * 1024 * 1024 * 2 <= WS_WRT && WS_WRT + (size_t)NL * 256 * 1024 * 2 <= WS_W1T && WS_W1T + (size_t)NL * NE * 2048 * 1024 * 2 <= WS_W2T && WS_W2T + (size_t)NL * NE * 1024 * 1024 * 2 <= WS_X, "ws map 2");
static_assert(WS_X + (size_t)T * 4096 <= WS_HB && WS_HB + (size_t)T * 2048 <= WS_P && WS_P + (size_t)T * 4096 <= WS_Y && WS_Y + (size_t)T * 2048 <= WS_HP && WS_HP + (size_t)CAP * 2048 <= WS_ACT && WS_ACT + (size_t)CAP * 2048 <= WS_YP && WS_YP + (size_t)CAP * 2048 <= WS_HB8 && WS_HB8 + (size_t)T * 1024 <= WS_END, "ws map 3");
constexpr int CW_BAR = 4096;
constexpr int CW_CTX = 81920;
constexpr int CW_CQ = 83968;
constexpr int CW_CNT = 65536;
constexpr int RING_BYTES = 131072;
constexpr int ROPE_OFF = RING_BYTES + 2048;
constexpr int T2E_OFF = ROPE_OFF + 8192;
constexpr int MISC_OFF = T2E_OFF + 2048;
constexpr int LDS_BYTES = 149504;
static_assert(MISC_OFF + 1024 == pg8::PG8_BIAS_OFF && pg8::PG8_IDX_OFF + 2048 <= LDS_BYTES, "LDS map");
static_assert(MK_FP8 == 1 && WS_HP + (size_t)CAP * 1024 <= WS_OB && WS_OB + (size_t)T * 2048 <= WS_ACT, "OB lives in the free half of the HP region");

#define GAS __attribute__((address_space(1)))
#define LAS __attribute__((address_space(3)))
typedef unsigned short bf16;
typedef unsigned v4u __attribute__((ext_vector_type(4)));
typedef unsigned v2u __attribute__((ext_vector_type(2)));
typedef float f32x4 __attribute__((ext_vector_type(4)));
typedef float f32x2 __attribute__((ext_vector_type(2)));
typedef GAS unsigned gu32;
#define RLX_AGENT __ATOMIC_RELAXED, __HIP_MEMORY_SCOPE_AGENT
#define LDS_WAIT() asm volatile("s_waitcnt lgkmcnt(0)" ::: "memory")
#define VM_WAIT() asm volatile("s_waitcnt vmcnt(0)" ::: "memory")
__device__ __forceinline__ unsigned f2bf(float f) { unsigned u = __builtin_bit_cast(unsigned, f); return (u + 0x7fffu + ((u >> 16) & 1u)) >> 16; }
__device__ __forceinline__ unsigned pk2(float lo, float hi) { unsigned r; asm("v_cvt_pk_bf16_f32 %0, %1, %2" : "=v"(r) : "v"(lo), "v"(hi)); return r; }
__device__ __forceinline__ float bflo(unsigned w) { return __builtin_bit_cast(float, w << 16); }
__device__ __forceinline__ float bfhi(unsigned w) { return __builtin_bit_cast(float, w & 0xffff0000u); }
__device__ __forceinline__ f32x4 bf4(v2u w) { return (f32x4){bflo(w.x), bfhi(w.x), bflo(w.y), bfhi(w.y)}; }
__device__ __forceinline__ v2u pk4(f32x4 v) { return (v2u){pk2(v.x, v.y), pk2(v.z, v.w)}; }
using pg8::shx; using pg8::wsum; using pg8::dpp_f; using pg8::sum_x16; using pg8::sum_x32; using pg8::get_x16; using pg8::get_x32;
__device__ __forceinline__ float wave_sum(float v) { return wsum(v); }
__device__ __forceinline__ float sum4(f32x4 v) { return (v.x + v.y) + (v.z + v.w); }
__device__ __forceinline__ float sigmoidf_(float z) { return __builtin_amdgcn_rcpf(1.0f + __builtin_amdgcn_exp2f(z * -1.4426950408889634f)); }
template <int I> __device__ __forceinline__ const float* ldin() { const GAS float* p;
    asm volatile("s_load_dwordx2 %0, %1, %2\n\ts_waitcnt lgkmcnt(0)" : "=s"(p) : "s"(__builtin_amdgcn_kernarg_segment_ptr()), "n"(I * 8) : "memory"); return (const float*)p; }
__device__ __forceinline__ float* ldout() { GAS float* p;
    asm volatile("s_load_dwordx2 %0, %1, %2\n\ts_waitcnt lgkmcnt(0)" : "=s"(p) : "s"(__builtin_amdgcn_kernarg_segment_ptr()), "n"(24 * 8) : "memory"); return (float*)p; }
#define XB_TMO      128
#define XB_XCNT(j)  (256  + 64 * (j))
#define XB_XSUB(j)  (1280 + 64 * (j))
#define XB_XGEN(j)  (2304 + 64 * (j))
#define XB_TOP      3328
#define XB_TOPGEN   3392
#define XCD_BAR_WORDS 3456
#define XB_SPIN_CAP (1u << 22)

__device__ __forceinline__ unsigned xb_ld(unsigned* p)              { return __hip_atomic_load(p, __ATOMIC_RELAXED, __HIP_MEMORY_SCOPE_AGENT); }
__device__ __forceinline__ unsigned xb_add(unsigned* p, unsigned v) { return __hip_atomic_fetch_add(p, v, __ATOMIC_RELAXED, __HIP_MEMORY_SCOPE_AGENT); }
__device__ __forceinline__ unsigned xb_xcc_id() { return (unsigned)__builtin_amdgcn_s_getreg((3 << 11) | 20) & 0xFu; }
#define XB_SPIN(cond, bar) do { unsigned _sp = 0; while (cond) { __builtin_amdgcn_s_sleep(1); \
    if ((++_sp & 255u) == 0u) { if (xb_ld(&(bar)[XB_TMO])) break; if (_sp > XB_SPIN_CAP) { atomicAdd(&(bar)[XB_TMO], 1u); break; } } } } while (0)

struct XcdBarrier {
    unsigned* bar; unsigned x;
    volatile LAS unsigned* st;
};

__device__ __forceinline__ XcdBarrier xcd_barrier_post(unsigned* bar, volatile LAS unsigned* st) {
    XcdBarrier b; b.bar = bar; b.x = xb_xcc_id(); b.st = st;
    if (threadIdx.x == 0) (void)xb_add(&bar[XB_XCNT(b.x)], 1u);
    return b;
}
__device__ __forceinline__ void xcd_barrier_complete(unsigned* bar, unsigned x, unsigned& nloc, unsigned& nx) {
    const unsigned G = gridDim.x * gridDim.y * gridDim.z;
    unsigned sum, cnt, mine, sp = 0u;
    for (;;) {
        sum = 0u; cnt = 0u; mine = 0u;
#pragma unroll
        for (unsigned j = 0; j < 16; ++j) { const unsigned c = xb_ld(&bar[XB_XCNT(j)]); sum += c; cnt += (c > 0u) ? 1u : 0u; mine = (j == x) ? c : mine; }
        if (sum == G) break;
        __builtin_amdgcn_s_sleep(1);
        if ((++sp & 255u) == 0u) { if (xb_ld(&bar[XB_TMO])) break; if (sp > XB_SPIN_CAP) { atomicAdd(&bar[XB_TMO], 1u); break; } }
    }
    nloc = mine > 0u ? mine : 1u; nx = cnt > 0u ? cnt : 1u;
}

__device__ __forceinline__ void xcd_barrier(const XcdBarrier& b) {
    asm volatile("s_waitcnt vmcnt(0)" ::: "memory");
    __syncthreads();
    if (threadIdx.x == 0) {
        unsigned* bar = b.bar;
        __builtin_amdgcn_s_waitcnt(0);
        unsigned nloc = b.st[0], nx = b.st[1];
        if (nloc == 0u) { xcd_barrier_complete(bar, b.x, nloc, nx); b.st[0] = nloc; b.st[1] = nx; }
        const unsigned old = xb_add(&bar[XB_XSUB(b.x)], 1u);
        const unsigned gen = old / nloc;
        if (old + 1u == (gen + 1u) * nloc) {
            __builtin_amdgcn_fence(__ATOMIC_RELEASE, "agent");
            asm volatile("s_waitcnt vmcnt(0)" ::: "memory");
            const unsigned og = xb_add(&bar[XB_TOP], 1u);
            const unsigned tg = og / nx;
            if (og + 1u == (tg + 1u) * nx) xb_add(&bar[XB_TOPGEN], 1u);
            else XB_SPIN(xb_ld(&bar[XB_TOPGEN]) == tg, bar);
            __builtin_amdgcn_fence(__ATOMIC_ACQUIRE, "agent");
            xb_add(&bar[XB_XGEN(b.x)], 1u);
            asm volatile("s_waitcnt vmcnt(0)" ::: "memory");
        } else {
            XB_SPIN(xb_ld(&bar[XB_XGEN(b.x)]) == gen, bar);
            __builtin_amdgcn_fence(__ATOMIC_ACQUIRE, "agent");
            asm volatile("s_waitcnt vmcnt(0)" ::: "memory");
        }
    }
    __syncthreads();
}

struct Ctx {
    LAS unsigned char* lds; volatile LAS unsigned* MISC; gu32* ctl;
    int tid, lane, wave, vcu, G, gw, ngw;
    GAS unsigned char* ws;
    __device__ __forceinline__ float* MOD() const { return (float*)(ws + WS_MOD); }
    __device__ __forceinline__ float* B1P() const { return (float*)(ws + WS_B1P); }
    __device__ __forceinline__ float* LOG() const { return (float*)(ws + WS_LOG); }
    __device__ __forceinline__ bf16* X() const { return (bf16*)(ws + WS_X); }
    __device__ __forceinline__ v2u* PAIR() const { return (v2u*)(ws + WS_PAIR); }
    __device__ __forceinline__ int* TOK() const { return (int*)(ws + WS_TOK); }
    __device__ __forceinline__ bf16* WINT() const { return (bf16*)(ws + WS_WINT); }
    __device__ __forceinline__ bf16* WOUTT() const { return (bf16*)(ws + WS_WOUTT); }
    __device__ __forceinline__ bf16* WRT() const { return (bf16*)(ws + WS_WRT); }
    __device__ __forceinline__ bf16* W1T() const { return (bf16*)(ws + WS_W1T); }
    __device__ __forceinline__ bf16* W2T() const { return (bf16*)(ws + WS_W2T); }
    __device__ __forceinline__ bf16* HB() const { return (bf16*)(ws + WS_HB); }
    __device__ __forceinline__ bf16* P() const { return (bf16*)(ws + WS_P); }
    __device__ __forceinline__ bf16* Y() const { return (bf16*)(ws + WS_Y); }
    __device__ __forceinline__ bf16* HP() const { return (bf16*)(ws + WS_HP); }
    __device__ __forceinline__ bf16* ACT() const { return (bf16*)(ws + WS_ACT); }
    __device__ __forceinline__ bf16* YP() const { return (bf16*)(ws + WS_YP); }
    __device__ __forceinline__ bf16* OB() const { return (bf16*)(ws + WS_OB); }
    __device__ __forceinline__ unsigned char* HB8() const { return (unsigned char*)(ws + WS_HB8); }
};
struct Args { const float* in[24]; float* out; unsigned char* ws; int ph_lo, ph_hi; };

__device__ __forceinline__ int w_in_row(int c) { const int r = c & 255; return (c & ~255) + (((r >> 5) & 1) << 7) + ((r >> 6) << 5) + (r & 31); }
__device__ __forceinline__ int w1_row(int n) { const int a = n >> 1; return ((a >> 7) << 8) + ((n & 1) << 7) + (a & 127); }
template <int MODE>
__device__ __forceinline__ void transpose_item(const float* W, int K, int N, bf16* WT, LAS float* scr, int item, int lane) {
    const int nblk = N / 32, kb = item / nblk, nb = item % nblk, k0 = 64 * kb, n0 = 32 * nb;
    { f32x4 ld[8]; const int r8 = lane >> 3, c4 = (lane & 7) * 4;
#pragma unroll
      for (int i = 0; i < 8; ++i) ld[i] = __builtin_nontemporal_load((const f32x4*)(W + (size_t)(k0 + 8 * i + r8) * N + n0 + c4));
#pragma unroll
      for (int i = 0; i < 8; ++i) { LAS float* d = scr + (8 * i + r8) * 33 + c4; d[0] = ld[i].x; d[1] = ld[i].y; d[2] = ld[i].z; d[3] = ld[i].w; } }
    LDS_WAIT(); asm volatile("" ::: "memory");
    const int c = lane & 7;
#pragma unroll
    for (int j = 0; j < 4; ++j) { const int n = (lane >> 3) + 8 * j; const LAS float* s = scr + (8 * c) * 33 + n;
        v4u o; o.x = pk2(s[0 * 33], s[1 * 33]); o.y = pk2(s[2 * 33], s[3 * 33]); o.z = pk2(s[4 * 33], s[5 * 33]); o.w = pk2(s[6 * 33], s[7 * 33]);
        const int orow = MODE == 1 ? w1_row(n0 + n) : MODE == 2 ? w_in_row(n0 + n) : (n0 + n);
        *(GAS v4u*)(WT + (size_t)orow * K + k0 + 8 * c) = o; }
    LDS_WAIT(); asm volatile("" ::: "memory");
}
template <int MODE>
__device__ __forceinline__ void transpose_item8(const float* W, int K, int N, unsigned char* WT, LAS float* scr, int item, int lane) {
    const int nblk = N / 32, kb = item / nblk, nb = item % nblk, k0 = 64 * kb, n0 = 32 * nb;
    { f32x4 ld[8]; const int r8 = lane >> 3, c4 = (lane & 7) * 4;
#pragma unroll
      for (int i = 0; i < 8; ++i) ld[i] = __builtin_nontemporal_load((const f32x4*)(W + (size_t)(k0 + 8 * i + r8) * N + n0 + c4));
#pragma unroll
      for (int i = 0; i < 8; ++i) { LAS float* d = scr + (8 * i + r8) * 33 + c4; d[0] = ld[i].x; d[1] = ld[i].y; d[2] = ld[i].z; d[3] = ld[i].w; } }
    LDS_WAIT(); asm volatile("" ::: "memory");
    const int n = lane >> 1, h = lane & 1; const LAS float* s = scr + (32 * h) * 33 + n;
    unsigned w[8];
#pragma unroll
    for (int q = 0; q < 8; ++q) { int p = __builtin_amdgcn_cvt_pk_fp8_f32(s[(4 * q) * 33] * 32.0f, s[(4 * q + 1) * 33] * 32.0f, 0, false); p = __builtin_amdgcn_cvt_pk_fp8_f32(s[(4 * q + 2) * 33] * 32.0f, s[(4 * q + 3) * 33] * 32.0f, p, true); w[q] = (unsigned)p; }
    const int orow = MODE == 1 ? w1_row(n0 + n) : MODE == 2 ? w_in_row(n0 + n) : (n0 + n);
    GAS v4u* dst = (GAS v4u*)(WT + (size_t)orow * K + k0 + 32 * h);
    dst[0] = (v4u){w[0], w[1], w[2], w[3]}; dst[1] = (v4u){w[4], w[5], w[6], w[7]};
    LDS_WAIT(); asm volatile("" ::: "memory");
}
template <int MODE>
__device__ __forceinline__ void transpose_item8w(const float* W, int K, int N, unsigned char* WT, LAS float* scr, int item, int lane) {
    const int nblk = N / 64, kb = item / nblk, nb = item % nblk, k0 = 64 * kb, n0 = 64 * nb;
    { f32x4 ld[16]; const int r4 = lane >> 4, c4 = (lane & 15) * 4;
#pragma unroll
      for (int i = 0; i < 16; ++i) ld[i] = *(const f32x4*)(W + (size_t)(k0 + 4 * i + r4) * N + n0 + c4);
#pragma unroll
      for (int i = 0; i < 16; ++i) { LAS float* d = scr + (4 * i + r4) * 65 + c4; d[0] = ld[i].x; d[1] = ld[i].y; d[2] = ld[i].z; d[3] = ld[i].w; } }
    LDS_WAIT(); asm volatile("" ::: "memory");
    const LAS float* s = scr + lane;
    const int orow = MODE == 1 ? w1_row(n0 + lane) : (n0 + lane);
    GAS v4u* dst = (GAS v4u*)(WT + (size_t)orow * K + k0);
#pragma unroll
    for (int g4 = 0; g4 < 4; ++g4) { unsigned w[4];
#pragma unroll
        for (int q = 0; q < 4; ++q) { const int kk = 16 * g4 + 4 * q; int p = __builtin_amdgcn_cvt_pk_fp8_f32(s[kk * 65] * 32.0f, s[(kk + 1) * 65] * 32.0f, 0, false); p = __builtin_amdgcn_cvt_pk_fp8_f32(s[(kk + 2) * 65] * 32.0f, s[(kk + 3) * 65] * 32.0f, p, true); w[q] = (unsigned)p; }
        dst[g4] = (v4u){w[0], w[1], w[2], w[3]}; }
    LDS_WAIT(); asm volatile("" ::: "memory");
}
struct WSrc { const float *w_in, *w_out, *w_e1, *w_e2; };
constexpr int CV_IN = 16 * 64, CV_OUT = 16 * 32, CV_E1 = 16 * 64, CV_E2 = 16 * 32, CV_PER_L = CV_IN + CV_OUT + NE * CV_E1 + NE * CV_E2;
constexpr int CV_HEAD = CV_IN + CV_OUT;
__device__ __forceinline__ void convert_item(const Ctx& C, const WSrc& W, int l, int r, LAS float* scr, int lane) {
    if (r < CV_IN) { transpose_item<2>(W.w_in + (size_t)l * 1024 * 2048, 1024, 2048, C.WINT() + (size_t)l * 2048 * 1024, scr, r, lane); return; } r -= CV_IN;
    if (r < CV_OUT) { transpose_item<0>(W.w_out + (size_t)l * 1024 * 1024, 1024, 1024, C.WOUTT() + (size_t)l * 1024 * 1024, scr, r, lane); return; } r -= CV_OUT;
    if (r < NE * CV_E1) { const int e = r / CV_E1; transpose_item8<1>(W.w_e1 + ((size_t)l * NE + e) * 1024 * 2048, 1024, 2048, (unsigned char*)C.W1T() + ((size_t)l * NE + e) * 2048 * 1024, scr, r % CV_E1, lane); return; } r -= NE * CV_E1;
    { const int e = r / CV_E2; transpose_item8<0>(W.w_e2 + ((size_t)l * NE + e) * 1024 * 1024, 1024, 1024, (unsigned char*)C.W2T() + ((size_t)l * NE + e) * 1024 * 1024, scr, r % CV_E2, lane); }
}
constexpr int CV_TAIL = 6;
__device__ __forceinline__ int tail_items(int nwg, int G) { const int rem = nwg % G; return rem ? (G - rem) * NWAVES * CV_TAIL : 0; }
__device__ __forceinline__ void tail_convert(const Ctx& C, int l, int nwg, int first) {
    const int rem = nwg % C.G, c = (int)blockIdx.x; if (rem == 0 || c < rem) return;
    WSrc W; W.w_in = ldin<8>(); W.w_out = ldin<17>(); W.w_e1 = ldin<20>(); W.w_e2 = ldin<22>();
    LAS float* scr = (LAS float*)(C.lds + C.wave * 8448);
    const int stride = (C.G - rem) * NWAVES; int it = first + (c - rem) * NWAVES + C.wave;
#pragma unroll 1
    for (int k = 0; k < CV_TAIL; ++k, it += stride) if (it < CV_PER_L) convert_item(C, W, l, it, scr, C.lane);
}
__device__ __forceinline__ void convert_bias(const Ctx& C, const float* b_e1, int l) {
    for (int i = C.gw * 64 + C.lane; i < NE * 2048; i += C.ngw * 64) { const int n = i & 2047; C.B1P()[(size_t)l * NE * 2048 + (i & ~2047) + w1_row(n)] = b_e1[(size_t)l * NE * 2048 + i]; }
}
__device__ __forceinline__ void phase_prologue(const Ctx& C, const Args& A) {
    __syncthreads();
    {
        LAS float* sS = (LAS float*)C.lds;
        const float* cin = ldin<1>(); const float* cctx = ldin<3>(); const float* wada = ldin<4>(); const float* bada = ldin<5>();
        for (int i = C.tid; i < 17 * 1024; i += NWAVES * 64) { const int j = i >> 10, k = i & 1023; const float v = j < 16 ? cin[j * 1024 + k] : cctx[k]; sS[i] = v * sigmoidf_(v); }
        __syncthreads();
        const int kl = C.tid & 15, cg = C.tid >> 4;
        for (int item = blockIdx.x; item < NL * 48; item += C.G) {
            const int l = item / 48, c0 = (item % 48) * 128 + 4 * cg;
            const float* W = wada + (size_t)l * 1024 * MODW + c0;
            f32x4 acc[17];
#pragma unroll
            for (int j = 0; j < 17; ++j) acc[j] = (f32x4){0.f, 0.f, 0.f, 0.f};
#pragma unroll 1
            for (int k0 = kl; k0 < 1024; k0 += 64) { f32x4 w[4];
#pragma unroll
                for (int u = 0; u < 4; ++u) w[u] = __builtin_nontemporal_load((const f32x4*)(W + (size_t)(k0 + 16 * u) * MODW));
#pragma unroll
                for (int u = 0; u < 4; ++u)
#pragma unroll
                    for (int j = 0; j < 17; ++j) acc[j] += sS[j * 1024 + k0 + 16 * u] * w[u]; }
#pragma unroll
            for (int j = 0; j < 17; ++j)
#pragma unroll
                for (int o = 1; o < 16; o <<= 1) { acc[j].x += shx(acc[j].x, o); acc[j].y += shx(acc[j].y, o); acc[j].z += shx(acc[j].z, o); acc[j].w += shx(acc[j].w, o); }
            if (kl == 0) { const f32x4 bv = *(const f32x4*)(bada + (size_t)l * MODW + c0);
#pragma unroll
                for (int j = 0; j < 17; ++j) *(f32x4*)(C.MOD() + ((size_t)l * 17 + j) * MODW + c0) = acc[j] + bv; }
        }
        __syncthreads();
    }
    {
        LAS float* scr = (LAS float*)(C.lds + C.wave * 8448);
        WSrc W; W.w_in = ldin<8>(); W.w_out = ldin<17>(); W.w_e1 = ldin<20>(); W.w_e2 = ldin<22>();
        for (int it = C.gw; it < CV_HEAD; it += C.ngw) convert_item(C, W, 0, it, scr, C.lane);
        convert_bias(C, ldin<21>(), 0);
    }
}

__device__ __forceinline__ void moe_tables(const Ctx& C, int l, bool with_t2e) {
    __syncthreads();
    if (C.tid < NE) C.MISC[40 + C.tid] = __hip_atomic_load(C.ctl + CW_CNT + (l * NE + C.tid) * 64, RLX_AGENT);
    __syncthreads();
    if (C.tid == 0) { unsigned s = 0;
#pragma unroll 1
        for (int e = 0; e < NE; ++e) { C.MISC[e] = s; s += (C.MISC[40 + e] + 255u) >> 8; } C.MISC[NE] = s; }
    __syncthreads();
    if (with_t2e) { LAS unsigned char* t2e = (LAS unsigned char*)(C.lds + T2E_OFF);
        for (int rt = C.tid; rt < MAXRT; rt += NWAVES * 64) { unsigned e = 0;
#pragma unroll 1
            for (int k = 1; k < NE; ++k) e += (C.MISC[k] <= (unsigned)rt) ? 1u : 0u;
            t2e[rt] = (unsigned char)e; }
        __syncthreads(); }
}

__device__ __forceinline__ void row_bt(int r, int& b, int& t, int& j) { b = r / SEG; t = r - b * SEG; j = t < SQ ? b : 16; }
__device__ __forceinline__ void wave_rows(const Ctx& C, int n, int& rbeg, int& rend) { const int rpw = (n + C.ngw - 1) / C.ngw; rbeg = C.gw * rpw; rend = rbeg + rpw < n ? rbeg + rpw : n; }
__device__ __forceinline__ int colq(int q, int lane) { return 512 * (q >> 1) + 8 * lane + 4 * (q & 1); }
__device__ __forceinline__ void bf8_to_f32(v4u w, f32x4& a, f32x4& b) { a = (f32x4){bflo(w.x), bfhi(w.x), bflo(w.y), bfhi(w.y)}; b = (f32x4){bflo(w.z), bfhi(w.z), bflo(w.w), bfhi(w.w)}; }
__device__ __forceinline__ v4u f32_to_bf8(f32x4 a, f32x4 b) { return (v4u){pk2(a.x, a.y), pk2(a.z, a.w), pk2(b.x, b.y), pk2(b.z, b.w)}; }
__device__ __forceinline__ void fp8x8_to_f32(v2u w, f32x4& a, f32x4& b) {
    const unsigned w0 = w.x, w1 = w.y;
    const f32x2 p0 = __builtin_amdgcn_cvt_pk_f32_fp8((int)w0, false), p1 = __builtin_amdgcn_cvt_pk_f32_fp8((int)w0, true), p2 = __builtin_amdgcn_cvt_pk_f32_fp8((int)w1, false), p3 = __builtin_amdgcn_cvt_pk_f32_fp8((int)w1, true);
    a = (f32x4){p0.x, p0.y, p1.x, p1.y}; b = (f32x4){p2.x, p2.y, p3.x, p3.y}; }
__device__ __forceinline__ v2u f32_to_fp8x8(f32x4 a, f32x4 b) {
    int p0 = __builtin_amdgcn_cvt_pk_fp8_f32(a.x, a.y, 0, false); p0 = __builtin_amdgcn_cvt_pk_fp8_f32(a.z, a.w, p0, true);
    int p1 = __builtin_amdgcn_cvt_pk_fp8_f32(b.x, b.y, 0, false); p1 = __builtin_amdgcn_cvt_pk_fp8_f32(b.z, b.w, p1, true);
    return (v2u){(unsigned)p0, (unsigned)p1}; }
__device__ __forceinline__ void modulate2(const f32x4 (&v)[2][4], const f32x4 (&gv)[4], const float* const (&mj)[2], int sh_chunk, f32x4 (&h)[2][4], int lane) {
    f32x4 sh[2][4], sc[2][4]; float ss[2];
#pragma unroll
    for (int u = 0; u < 2; ++u) { ss[u] = 0.f;
#pragma unroll
        for (int q = 0; q < 4; ++q) { const int c = colq(q, lane); sh[u][q] = *(const f32x4*)(mj[u] + sh_chunk * D + c); sc[u][q] = *(const f32x4*)(mj[u] + (sh_chunk + 1) * D + c); ss[u] += sum4(v[u][q] * v[u][q]); } }
    ss[0] = wsum(ss[0]); ss[1] = wsum(ss[1]);
#pragma unroll
    for (int u = 0; u < 2; ++u) { const float rs = __builtin_amdgcn_rsqf(ss[u] * (1.0f / D) + EPS);
#pragma unroll
        for (int q = 0; q < 4; ++q) h[u][q] = (v[u][q] * rs) * gv[q] * (1.0f + sc[u][q]) + sh[u][q]; }
}
__device__ __forceinline__ void pair_load2(const Ctx& C, const int (&r)[2], v2u (&pr)[2][4]) {
#pragma unroll
    for (int u = 0; u < 2; ++u)
#pragma unroll
        for (int k = 0; k < 4; ++k) pr[u][k] = C.PAIR()[(size_t)r[u] * 4 + k];
}
__device__ __forceinline__ void moe_combine2(const Ctx& C, const v2u (&pr)[2][4], f32x4 (&acc)[2][4]) {
    v2u y[2][4][2];
#pragma unroll
    for (int u = 0; u < 2; ++u)
#pragma unroll
        for (int k = 0; k < 4; ++k) { const unsigned px = pr[u][k].x; const unsigned e = px & 31u, pos = px >> 5;
            const unsigned char* yp = (const unsigned char*)C.YP() + ((size_t)C.MISC[e] * 256 + pos) * D + 8 * C.lane;
#pragma unroll
            for (int jj = 0; jj < 2; ++jj) y[u][k][jj] = __builtin_nontemporal_load((const GAS v2u*)(yp + 512 * jj)); }
#pragma unroll
    for (int u = 0; u < 2; ++u) {
#pragma unroll
        for (int q = 0; q < 4; ++q) acc[u][q] = (f32x4){0.f, 0.f, 0.f, 0.f};
#pragma unroll
        for (int k = 0; k < 4; ++k) { const unsigned wb = pr[u][k].y; const float wt = __uint_as_float(wb) * 0.125f;
#pragma unroll
            for (int jj = 0; jj < 2; ++jj) { f32x4 ya, yb; fp8x8_to_f32(y[u][k][jj], ya, yb); acc[u][2 * jj] += wt * ya; acc[u][2 * jj + 1] += wt * yb; } } }
}
__device__ __forceinline__ void ld_x2(const Ctx& C, const bf16* base, const int (&r)[2], f32x4 (&v)[2][4]) {
#pragma unroll
    for (int u = 0; u < 2; ++u)
#pragma unroll
        for (int jj = 0; jj < 2; ++jj) bf8_to_f32(__builtin_nontemporal_load((const GAS v4u*)(base + (size_t)r[u] * D + 512 * jj + 8 * C.lane)), v[u][2 * jj], v[u][2 * jj + 1]);
}

__device__ __forceinline__ void phase_premix(const Ctx& C, const Args& A, int l) {
    if (l > 0) moe_tables(C, l - 1, false);
    const float* modl = C.MOD() + (size_t)l * 17 * MODW; const float* modp = C.MOD() + (size_t)(l > 0 ? l - 1 : 0) * 17 * MODW;
    const float* g = ldin<6>() + (size_t)l * D; const float* xin = ldin<0>(); const float* cxin = ldin<2>();
    f32x4 gv[4];
#pragma unroll
    for (int q = 0; q < 4; ++q) gv[q] = *(const f32x4*)(g + colq(q, C.lane));
    int rbeg, rend; wave_rows(C, T, rbeg, rend);
    v2u pr[2][4]; if (l > 0 && rbeg < rend) { const int rf[2] = {rbeg, rbeg + 1 < rend ? rbeg + 1 : rbeg}; pair_load2(C, rf, pr); }
    int jc = -1; f32x4 gtc[4], shc[4], gsc[4];
#pragma unroll
    for (int q = 0; q < 4; ++q) { gtc[q] = gv[q]; shc[q] = gv[q]; gsc[q] = gv[q]; }
    for (int r0 = rbeg; r0 < rend; r0 += 2) {
        const int r[2] = {r0, r0 + 1 < rend ? r0 + 1 : r0};
        int b[2], t[2], j[2]; row_bt(r[0], b[0], t[0], j[0]); row_bt(r[1], b[1], t[1], j[1]);
        f32x4 v[2][4];
        if (l == 0) {
#pragma unroll
            for (int u = 0; u < 2; ++u) { const float* src = t[u] < SQ ? xin + ((size_t)b[u] * SQ + t[u]) * D : cxin + ((size_t)b[u] * CL + (t[u] - SQ)) * D;
#pragma unroll
                for (int q = 0; q < 4; ++q) v[u][q] = __builtin_nontemporal_load((const f32x4*)(src + colq(q, C.lane))); }
        } else {
            ld_x2(C, C.OB(), r, v);
            v2u prn[2][4]; { const int a = r0 + 2 < rend ? r0 + 2 : r0, b2 = r0 + 3 < rend ? r0 + 3 : a; const int rn[2] = {a, b2}; pair_load2(C, rn, prn); }
            f32x4 acc[2][4]; moe_combine2(C, pr, acc);
#pragma unroll
            for (int u = 0; u < 2; ++u)
#pragma unroll
                for (int k = 0; k < 4; ++k) pr[u][k] = prn[u][k];
            if (j[0] != jc) {
#pragma unroll
                for (int q = 0; q < 4; ++q) gtc[q] = *(const f32x4*)(modp + (size_t)j[0] * MODW + 5 * D + colq(q, C.lane)); }
#pragma unroll
            for (int u = 0; u < 2; ++u) {
                if (j[u] == j[0]) {
#pragma unroll
                    for (int q = 0; q < 4; ++q) v[u][q] += gtc[q] * acc[u][q]; }
                else {
#pragma unroll
                    for (int q = 0; q < 4; ++q) v[u][q] += *(const f32x4*)(modp + (size_t)j[u] * MODW + 5 * D + colq(q, C.lane)) * acc[u][q]; } } }
        if (j[0] != jc) { jc = j[0]; const float* m = modl + (size_t)jc * MODW;
#pragma unroll
            for (int q = 0; q < 4; ++q) { const int c = colq(q, C.lane); shc[q] = *(const f32x4*)(m + c); gsc[q] = gv[q] * (1.0f + *(const f32x4*)(m + D + c)); } }
        f32x4 h[2][4]; float ss[2];
#pragma unroll
        for (int u = 0; u < 2; ++u) { ss[u] = 0.f;
#pragma unroll
            for (int q = 0; q < 4; ++q) ss[u] += sum4(v[u][q] * v[u][q]); }
        ss[0] = wsum(ss[0]); ss[1] = wsum(ss[1]);
#pragma unroll
        for (int u = 0; u < 2; ++u) { const float rs = __builtin_amdgcn_rsqf(ss[u] * (1.0f / D) + EPS);
            if (j[u] == jc) {
#pragma unroll
                for (int q = 0; q < 4; ++q) h[u][q] = (v[u][q] * rs) * gsc[q] + shc[q]; }
            else { const float* m = modl + (size_t)j[u] * MODW;
#pragma unroll
                for (int q = 0; q < 4; ++q) { const int c = colq(q, C.lane); h[u][q] = (v[u][q] * rs) * (gv[q] * (1.0f + *(const f32x4*)(m + D + c))) + *(const f32x4*)(m + c); } } }
#pragma unroll
        for (int u = 0; u < 2; ++u)
#pragma unroll
            for (int jj = 0; jj < 2; ++jj) { const size_t o = (size_t)r[u] * D + 512 * jj + 8 * C.lane;
                __builtin_nontemporal_store(f32_to_bf8(v[u][2 * jj], v[u][2 * jj + 1]), (GAS v4u*)(C.X() + o));
#if MK_FP8_IN == 1
                *(GAS v2u*)((unsigned char*)C.HB() + o) = f32_to_fp8x8(h[u][2 * jj], h[u][2 * jj + 1]); }
#elif MK_FP8_IN == 2
                *(GAS v4u*)(C.HB() + o) = f32_to_bf8(h[u][2 * jj], h[u][2 * jj + 1]); *(GAS v2u*)(C.HB8() + o) = f32_to_fp8x8(h[u][2 * jj], h[u][2 * jj + 1]); }
#else
                *(GAS v4u*)(C.HB() + o) = f32_to_bf8(h[u][2 * jj], h[u][2 * jj + 1]); }
#endif
    }
}
__device__ __forceinline__ void phase_premoe(const Ctx& C, const Args& A, int l) {
    const float* modl = C.MOD() + (size_t)l * 17 * MODW; const float* g = ldin<7>() + (size_t)l * D;
    typedef __bf16 bf16x2_t __attribute__((ext_vector_type(2)));
    volatile LAS unsigned* lhist = C.MISC + 80; volatile LAS unsigned* lbase = C.MISC + 112;
    __syncthreads();
    { const float* wr = ldin<18>() + (size_t)l * D * NE;
      for (int idx = C.tid; idx < 8 * 4 * 2 * 64; idx += NWAVES * 64) { const int ln = idx & 63, jj = (idx >> 6) & 1, ip = (idx >> 7) & 3, e4 = idx >> 9;
          const float* w0 = wr + (size_t)(512 * jj + 8 * ln + 2 * ip) * NE + 4 * e4; const f32x4 a = *(const f32x4*)w0, b = *(const f32x4*)(w0 + NE);
          ((LAS v4u*)C.lds)[idx] = (v4u){pk2(a.x, b.x), pk2(a.y, b.y), pk2(a.z, b.z), pk2(a.w, b.w)}; }
      if (C.tid < NE) lhist[C.tid] = 0u; }
    __syncthreads();
    f32x4 gv[4];
#pragma unroll
    for (int q = 0; q < 4; ++q) gv[q] = *(const f32x4*)(g + colq(q, C.lane));
    const int half = C.lane >> 5, ex = C.lane & 31;
    const float br = ldin<19>()[l * NE + ex];
    const bool lat = l + 1 == NL;
#define RMAP(q) (lat ? ((q) / SQ) * SEG + (q) % SQ : (q))
    int rbeg, rend; wave_rows(C, lat ? NB * SQ : T, rbeg, rend);
    const bool cv = true; int cit = CV_HEAD + tail_items(NROWT * (INW / 256), C.G) + tail_items((l + 1 < NL ? NROWT : NB * SQ / 256) * (D / 256), C.G) + C.gw; LAS float* cscr = (LAS float*)(C.lds + 65536 + C.wave * 8448);
    WSrc W; W.w_in = ldin<8>(); W.w_out = ldin<17>(); W.w_e1 = ldin<20>(); W.w_e2 = ldin<22>();
    v4u ob[2][2];
    if (rbeg < rend) { const int ra = RMAP(rbeg), rb = RMAP(rbeg + 1 < rend ? rbeg + 1 : rbeg);
#pragma unroll
        for (int jj = 0; jj < 2; ++jj) { ob[0][jj] = __builtin_nontemporal_load((const GAS v4u*)(C.OB() + (size_t)ra * D + 512 * jj + 8 * C.lane)); ob[1][jj] = __builtin_nontemporal_load((const GAS v4u*)(C.OB() + (size_t)rb * D + 512 * jj + 8 * C.lane)); } }
    int jc = -1; f32x4 shc[4], gsc[4];
#pragma unroll
    for (int q = 0; q < 4; ++q) { shc[q] = gv[q]; gsc[q] = gv[q]; }
    for (int r0 = rbeg; r0 < rend; r0 += 2) {
        const bool two = r0 + 1 < rend; const int r[2] = {RMAP(r0), RMAP(two ? r0 + 1 : r0)};
        int b[2], t[2], j[2]; row_bt(r[0], b[0], t[0], j[0]); row_bt(r[1], b[1], t[1], j[1]);
        f32x4 v[2][4];
#pragma unroll
        for (int u = 0; u < 2; ++u)
#pragma unroll
            for (int jj = 0; jj < 2; ++jj) bf8_to_f32(ob[u][jj], v[u][2 * jj], v[u][2 * jj + 1]);
        { const int qa = r0 + 2 < rend ? r0 + 2 : r0, qb = r0 + 3 < rend ? r0 + 3 : qa; const int ra = RMAP(qa), rb = RMAP(qb);
#pragma unroll
          for (int jj = 0; jj < 2; ++jj) { ob[0][jj] = __builtin_nontemporal_load((const GAS v4u*)(C.OB() + (size_t)ra * D + 512 * jj + 8 * C.lane)); ob[1][jj] = __builtin_nontemporal_load((const GAS v4u*)(C.OB() + (size_t)rb * D + 512 * jj + 8 * C.lane)); } }
        if (j[0] != jc) { jc = j[0]; const float* m = modl + (size_t)jc * MODW + 3 * D;
#pragma unroll
            for (int q = 0; q < 4; ++q) { const int c = colq(q, C.lane); shc[q] = *(const f32x4*)(m + c); gsc[q] = gv[q] * (1.0f + *(const f32x4*)(m + D + c)); } }
        f32x4 h[2][4]; float ss[2];
#pragma unroll
        for (int u = 0; u < 2; ++u) { ss[u] = 0.f;
#pragma unroll
            for (int q = 0; q < 4; ++q) ss[u] += sum4(v[u][q] * v[u][q]); }
        ss[0] = wsum(ss[0]); ss[1] = wsum(ss[1]);
#pragma unroll
        for (int u = 0; u < 2; ++u) { const float rs = __builtin_amdgcn_rsqf(ss[u] * (1.0f / D) + EPS);
            if (j[u] == jc) {
#pragma unroll
                for (int q = 0; q < 4; ++q) h[u][q] = (v[u][q] * rs) * gsc[q] + shc[q]; }
            else { const float* m = modl + (size_t)j[u] * MODW + 3 * D;
#pragma unroll
                for (int q = 0; q < 4; ++q) { const int c = colq(q, C.lane); h[u][q] = (v[u][q] * rs) * (gv[q] * (1.0f + *(const f32x4*)(m + D + c))) + *(const f32x4*)(m + c); } } }
#pragma unroll
        for (int u = 0; u < 2; ++u)
#pragma unroll
            for (int jj = 0; jj < 2; ++jj) { const size_t o = (size_t)r[u] * D + 512 * jj + 8 * C.lane;
                *(GAS v2u*)(C.HB8() + o) = f32_to_fp8x8(h[u][2 * jj], h[u][2 * jj + 1]); }
        f32x4 pl[2][8];
#pragma unroll
        for (int e4 = 0; e4 < 8; ++e4) { pl[0][e4] = (f32x4){0.f, 0.f, 0.f, 0.f}; pl[1][e4] = pl[0][e4]; }
#pragma unroll
        for (int jj = 0; jj < 2; ++jj)
#pragma unroll
            for (int ip = 0; ip < 4; ++ip) { const int q = 2 * jj + (ip >> 1), c0 = 2 * (ip & 1);
                const bf16x2_t h0 = __builtin_bit_cast(bf16x2_t, pk2(h[0][q][c0], h[0][q][c0 + 1])), h1 = __builtin_bit_cast(bf16x2_t, pk2(h[1][q][c0], h[1][q][c0 + 1]));
#pragma unroll
                for (int e4 = 0; e4 < 8; ++e4) { const v4u w = ((const LAS v4u*)C.lds)[((e4 * 4 + ip) * 2 + jj) * 64 + C.lane];
                    const unsigned wx[4] = {w.x, w.y, w.z, w.w};
#pragma unroll
                    for (int x = 0; x < 4; ++x) { const bf16x2_t wb = __builtin_bit_cast(bf16x2_t, wx[x]);
                        pl[0][e4][x] = __builtin_amdgcn_fdot2_f32_bf16(h0, wb, pl[0][e4][x], false); pl[1][e4][x] = __builtin_amdgcn_fdot2_f32_bf16(h1, wb, pl[1][e4][x], false); } } }
        float s32[32];
#pragma unroll
        for (int e = 0; e < 32; ++e) { const auto r = __builtin_amdgcn_permlane32_swap(__float_as_uint(pl[0][e >> 2][e & 3]), __float_as_uint(pl[1][e >> 2][e & 3]), false, false); s32[e] = __uint_as_float(r[0]) + __uint_as_float(r[1]); }
        float s16[16];
#pragma unroll
        for (int e = 0; e < 16; ++e) { const auto r = __builtin_amdgcn_permlane16_swap(__float_as_uint(s32[e]), __float_as_uint(s32[16 + e]), false, false); s16[e] = __uint_as_float(r[0]) + __uint_as_float(r[1]); }
        float s8[8];
#pragma unroll
        for (int e = 0; e < 8; ++e) { const bool hi = (C.lane & 8) != 0; const float keep = hi ? s16[8 + e] : s16[e], send = hi ? s16[e] : s16[8 + e]; s8[e] = keep + dpp_f<0x128>(send); }
        float s4[4];
#pragma unroll
        for (int e = 0; e < 4; ++e) { const bool hi = (C.lane & 4) != 0; const float keep = hi ? s8[4 + e] : s8[e], send = hi ? s8[e] : s8[4 + e]; s4[e] = keep + dpp_f<0x1B>(dpp_f<0x141>(send)); }
        float s2[2];
#pragma unroll
        for (int e = 0; e < 2; ++e) { const bool hi = (C.lane & 2) != 0; const float keep = hi ? s4[2 + e] : s4[e], send = hi ? s4[e] : s4[2 + e]; s2[e] = keep + dpp_f<0x4E>(send); }
        float lg; { const bool hi = (C.lane & 1) != 0; const float keep = hi ? s2[1] : s2[0], send = hi ? s2[0] : s2[1]; lg = keep + dpp_f<0xB1>(send); }
        const float vv = lg + br; const int vb = __float_as_int(vv);
        float cur = vv; int rank = 4; float sv[4];
#pragma unroll
        for (int k = 0; k < 4; ++k) { float m = cur; m = __builtin_fmaxf(m, dpp_f<0xB1>(m)); m = __builtin_fmaxf(m, dpp_f<0x4E>(m)); m = __builtin_fmaxf(m, dpp_f<0x141>(m)); m = __builtin_fmaxf(m, dpp_f<0x140>(m));
            { const auto rr = __builtin_amdgcn_permlane16_swap(__float_as_uint(m), __float_as_uint(m), false, false); m = __builtin_fmaxf(__uint_as_float(rr[0]), __uint_as_float(rr[1])); }
            sv[k] = m;
            const unsigned long long mk = __ballot(cur == m); const int s0 = (int)__builtin_ctz((unsigned)mk | 0x80000000u), s1 = (int)__builtin_ctz((unsigned)(mk >> 32) | 0x80000000u);
            if (ex == (half ? s1 : s0)) { rank = k; cur = -INFINITY; } }
        const float inv = __builtin_amdgcn_rcpf(1.0f + __expf(sv[1] - sv[0]) + __expf(sv[2] - sv[0]) + __expf(sv[3] - sv[0]));
        if (rank < 4 && (half == 0 || two)) { const int rr = r[half];
            const unsigned lpos = __hip_atomic_fetch_add((LAS unsigned*)(C.lds + MISC_OFF) + 80 + ex, 1u, __ATOMIC_RELAXED, __HIP_MEMORY_SCOPE_WORKGROUP);
            C.PAIR()[(size_t)rr * 4 + rank] = (v2u){(unsigned)ex | (lpos << 5), __float_as_uint(__expf(vv - sv[0]) * inv)}; }
        if (cv) {
#pragma unroll 1
            for (int k = 0; k < 2 && cit < CV_PER_L; ++k, cit += C.ngw) convert_item(C, W, l, cit, cscr, C.lane); }
    }
    if (cv) {
#pragma unroll 1
        for (; cit < CV_PER_L; cit += C.ngw) convert_item(C, W, l, cit, cscr, C.lane);
        if (l + 1 < NL) {
#pragma unroll 1
            for (int it = C.gw; it < CV_HEAD; it += C.ngw) convert_item(C, W, l + 1, it, cscr, C.lane);
            convert_bias(C, ldin<21>(), l + 1); } }
    __syncthreads();
    gu32* cnt = C.ctl + CW_CNT + (size_t)l * NE * 64;
    if (C.tid < NE) { const unsigned n = lhist[C.tid]; lbase[C.tid] = n ? __hip_atomic_fetch_add(cnt + C.tid * 64, n, RLX_AGENT) : 0u; }
    __syncthreads();
    for (int idx = C.lane; idx < (rend - rbeg) * 4; idx += 64) { const int rr = RMAP(rbeg + (idx >> 2)); gu32* px = (gu32*)C.PAIR() + ((size_t)rr * 4 + (idx & 3)) * 2;
        const unsigned x = __hip_atomic_load(px, RLX_AGENT); const unsigned e = x & 31u, pos = lbase[e] + (x >> 5);
        *px = e | (pos << 5); C.TOK()[(size_t)e * T + pos] = rr; }
    __syncthreads();
#undef RMAP
}
__device__ __forceinline__ void phase_final(const Ctx& C, const Args& A) {
    moe_tables(C, NL - 1, false);
    const float* modp = C.MOD() + (size_t)(NL - 1) * 17 * MODW; float* outp = ldout();
    int qbeg, qend; wave_rows(C, NB * SQ, qbeg, qend);
    v2u pr[2][4]; if (qbeg < qend) { const int qa = qbeg, qb = qbeg + 1 < qend ? qbeg + 1 : qbeg; const int rf[2] = {(qa / SQ) * SEG + qa % SQ, (qb / SQ) * SEG + qb % SQ}; pair_load2(C, rf, pr); }
    int bc = -1; f32x4 gtc[4];
#pragma unroll
    for (int q = 0; q < 4; ++q) gtc[q] = (f32x4){0.f, 0.f, 0.f, 0.f};
    for (int q0 = qbeg; q0 < qend; q0 += 2) {
        const int qq[2] = {q0, q0 + 1 < qend ? q0 + 1 : q0}; const int b[2] = {qq[0] / SQ, qq[1] / SQ}; const int r[2] = {b[0] * SEG + (qq[0] - b[0] * SQ), b[1] * SEG + (qq[1] - b[1] * SQ)};
        f32x4 v[2][4]; ld_x2(C, C.OB(), r, v);
        if (b[0] != bc) { bc = b[0];
#pragma unroll
            for (int q = 0; q < 4; ++q) gtc[q] = *(const f32x4*)(modp + (size_t)bc * MODW + 5 * D + colq(q, C.lane)); }
        v2u prn[2][4]; { const int qa = q0 + 2 < qend ? q0 + 2 : q0, qb = q0 + 3 < qend ? q0 + 3 : qa; const int rn[2] = {(qa / SQ) * SEG + qa % SQ, (qb / SQ) * SEG + qb % SQ}; pair_load2(C, rn, prn); }
        f32x4 acc[2][4]; moe_combine2(C, pr, acc);
#pragma unroll
        for (int u = 0; u < 2; ++u)
#pragma unroll
            for (int k = 0; k < 4; ++k) pr[u][k] = prn[u][k];
#pragma unroll
        for (int u = 0; u < 2; ++u) { float* o = outp + (size_t)qq[u] * D;
            if (b[u] == bc) {
#pragma unroll
                for (int q = 0; q < 4; ++q) __builtin_nontemporal_store(v[u][q] + gtc[q] * acc[u][q], (f32x4*)(o + colq(q, C.lane))); }
            else {
#pragma unroll
                for (int q = 0; q < 4; ++q) *(f32x4*)(o + colq(q, C.lane)) = v[u][q] + *(const f32x4*)(modp + (size_t)b[u] * MODW + 5 * D + colq(q, C.lane)) * acc[u][q]; } }
    }
}

__device__ __forceinline__ v4u qk_piece(v4u w, const float (&gain)[8], bool lat, int pos, int i0, bool first, float scale, const LAS f32x2* rope) {
    float f[8] = {bflo(w.x), bfhi(w.x), bflo(w.y), bfhi(w.y), bflo(w.z), bfhi(w.z), bflo(w.w), bfhi(w.w)};
    float ss = 0.f;
#pragma unroll
    for (int i = 0; i < 8; ++i) ss += f[i] * f[i];
    ss += shx(ss, 1); ss += shx(ss, 2); ss += shx(ss, 4);
    const float rs = __builtin_amdgcn_rsqf(ss * (1.0f / 64.0f) + EPS);
    float o[8];
#pragma unroll
    for (int i = 0; i < 8; ++i) f[i] = f[i] * rs * gain[i];
#pragma unroll
    for (int i = 0; i < 8; ++i) { const float pv = shx(f[i], 2); const f32x2 cs = rope[(pos & 63) * 16 + i0 + i];
        const float rot = first ? f[i] * cs.x - pv * cs.y : f[i] * cs.x + pv * cs.y;
        o[i] = (lat ? rot : f[i]) * scale; }
    v4u ow; ow.x = pk2(o[0], o[1]); ow.y = pk2(o[2], o[3]); ow.z = pk2(o[4], o[5]); ow.w = pk2(o[6], o[7]); return ow;
}
__device__ __forceinline__ void phase_qknorm(const Ctx& C, const Args& A, int l) {
    const LAS f32x2* rope = (const LAS f32x2*)(C.lds + ROPE_OFF);
    const float* gq = ldin<9>() + l * 64; const float* gk = ldin<10>() + l * 64;
    const int d0 = 8 * (C.lane & 7);
    const int ax = d0 >> 5, o0 = d0 & 31; const bool first = o0 < 16; const int i0 = o0 & 15;
    float gqv[8], gkv[8];
#pragma unroll
    for (int i = 0; i < 8; ++i) { gqv[i] = gq[d0 + i]; gkv[i] = gk[d0 + i]; }
    int rbeg, rend; wave_rows(C, T, rbeg, rend);
    for (int r0 = rbeg; r0 < rend; r0 += 4) {
        v4u wq[4]; bool ok[4]; int tt[4];
#pragma unroll
        for (int u = 0; u < 4; ++u) { ok[u] = r0 + u < rend; const int r = ok[u] ? r0 + u : r0; tt[u] = r % SEG; wq[u] = *(const GAS v4u*)(C.P() + (size_t)r * INW + 8 * C.lane); }
        const int uk = C.lane >> 4; const bool okk = r0 + uk < rend; const int rk = okk ? r0 + uk : r0; const int tk = rk % SEG;
        bf16* pk = C.P() + (size_t)rk * INW + 512 + 8 * (C.lane & 15);
        const v4u wk = *(const GAS v4u*)pk;
#pragma unroll
        for (int u = 0; u < 4; ++u) { const bool lat = tt[u] < SQ; const int pos = ax == 0 ? (tt[u] >> 6) : (tt[u] & 63);
            const v4u ow = qk_piece(wq[u], gqv, lat, pos, i0, first, attn_body::C2, rope);
            if (ok[u]) *(GAS v4u*)(C.P() + (size_t)(r0 + u) * INW + 8 * C.lane) = ow; }
        { const bool lat = tk < SQ; const int pos = ax == 0 ? (tk >> 6) : (tk & 63);
          const v4u ow = qk_piece(wk, gkv, lat, pos, i0, first, 1.0f, rope);
          if (okk) *(GAS v4u*)pk = ow; }
    }
}

__device__ __forceinline__ void attn_gnorm(const Ctx& C, size_t row0, const float* gg) {
    const f32x4 gA0 = *(const f32x4*)(gg + 8 * C.lane), gA1 = *(const f32x4*)(gg + 8 * C.lane + 4);
    bf16* y0 = C.Y() + (row0 + C.wave * 32) * D + 8 * C.lane;
#pragma unroll 1
    for (int i = 0; i < 32; i += 16) {
        v4u av[16]; float qa[16];
#pragma unroll
        for (int u = 0; u < 16; ++u) av[u] = *(const GAS v4u*)(y0 + (size_t)(i + u) * D);
#pragma unroll
        for (int u = 0; u < 16; ++u) { const f32x4 a0 = bf4((v2u){av[u].x, av[u].y}), a1 = bf4((v2u){av[u].z, av[u].w}); qa[u] = sum4(a0 * a0) + sum4(a1 * a1); }
#pragma unroll
        for (int u = 0; u < 16; ++u) qa[u] = wsum(qa[u]);
#pragma unroll
        for (int u = 0; u < 16; ++u) { const float rsa = __builtin_amdgcn_rsqf(qa[u] * (1.0f / 512.0f) + EPS);
            const f32x4 a0 = bf4((v2u){av[u].x, av[u].y}), a1 = bf4((v2u){av[u].z, av[u].w});
            const v2u o0 = pk4(a0 * rsa * gA0), o1 = pk4(a1 * rsa * gA1);
            *(GAS v4u*)(y0 + (size_t)(i + u) * D) = (v4u){o0.x, o0.y, o1.x, o1.y}; }
    }
}
template <bool FIXR> __device__ __forceinline__ void phase_attn_impl(const Ctx& C, int l) {
    char* shm = (char*)C.lds;
    const attn_body::bf16* Pq = (const attn_body::bf16*)C.P(); attn_body::bf16* Yo = (attn_body::bf16*)C.Y();
    const float* gg = ldin<16>() + (size_t)l * D;
    gu32* cc = C.ctl + CW_CTX + (size_t)l * NB * 16;
    if (l + 1 < NL)
    for (int u = C.G - 1 - C.vcu; u < NB * 8; u += C.G) { const int h = u & 7, b = u >> 3;
        attn_body::attn_unit<8, FIXR>((long)b * SEG + SQ, (long)b * SEG + SQ, CL / 64, h, Pq, Yo, shm);
        asm volatile("s_waitcnt vmcnt(0)" ::: "memory"); __syncthreads();
        if (C.tid == 0) { __builtin_amdgcn_fence(__ATOMIC_RELEASE, "agent"); C.MISC[164] = __hip_atomic_fetch_add(cc + b * 16, 1u, RLX_AGENT); }
        __syncthreads();
        if ((C.MISC[164] & 7u) == 7u) { __builtin_amdgcn_fence(__ATOMIC_ACQUIRE, "agent"); attn_gnorm(C, (size_t)b * SEG + SQ, gg); }
        __syncthreads(); }
    for (int u = C.vcu; u < NB * 16; u += C.G) { const int qb = u & 15, b = u >> 4;
#pragma unroll 1
        for (int h = 0; h < 8; ++h) attn_body::attn_unit<8, FIXR>((long)b * SEG + qb * 256, (long)b * SEG, SEG / 64, h, Pq, Yo, shm);
        asm volatile("s_waitcnt vmcnt(0)" ::: "memory"); __syncthreads();
        attn_gnorm(C, (size_t)b * SEG + qb * 256, gg); }
}

__device__ __forceinline__ void phase_attn(const Ctx& C, int l) {
    float gq = __builtin_fabsf(ldin<9>()[l * 64 + C.lane]), gk = __builtin_fabsf(ldin<10>()[l * 64 + C.lane]);
    gq = __builtin_fmaxf(gq, dpp_f<0xB1>(gq)); gq = __builtin_fmaxf(gq, dpp_f<0x4E>(gq)); gq = __builtin_fmaxf(gq, dpp_f<0x141>(gq)); gq = __builtin_fmaxf(gq, dpp_f<0x140>(gq));
    gk = __builtin_fmaxf(gk, dpp_f<0xB1>(gk)); gk = __builtin_fmaxf(gk, dpp_f<0x4E>(gk)); gk = __builtin_fmaxf(gk, dpp_f<0x141>(gk)); gk = __builtin_fmaxf(gk, dpp_f<0x140>(gk));
    float bq = 0.f, bk = 0.f;
#pragma unroll
    for (int i = 0; i < 4; ++i) { bq = __builtin_fmaxf(bq, __int_as_float(__builtin_amdgcn_readlane(__float_as_int(gq), 16 * i))); bk = __builtin_fmaxf(bk, __int_as_float(__builtin_amdgcn_readlane(__float_as_int(gk), 16 * i))); }
    const float bound = 11.8f * bq * bk;
    if (bound < 60.0f) phase_attn_impl<true>(C, l); else phase_attn_impl<false>(C, l);
}

__device__ __forceinline__ void phase_conv1(const Ctx& C, const Args& A, int l) {
    __syncthreads();
    LAS float* zL = (LAS float*)C.lds;
    const int c4 = 4 * C.lane;
    {
        f32x4 wk[31]; const float* wdw = ldin<11>();
#pragma unroll
        for (int jt = 0; jt < 31; ++jt) wk[jt] = *(const f32x4*)(wdw + ((size_t)l * 31 + jt) * 256 + c4);
        const f32x4 b31 = *(const f32x4*)(ldin<12>() + l * 256 + c4), gln = *(const f32x4*)(ldin<13>() + l * 256 + c4), bln = *(const f32x4*)(ldin<14>() + l * 256 + c4);
        const f32x4 gC = *(const f32x4*)(ldin<16>() + (size_t)l * D + 512 + c4);
        gu32* tq = C.ctl + CW_CQ + l * 16;
        for (int tile = C.vcu; tile < T / 64; ) {
            const int b = tile / 68, tt = tile - b * 68, t0 = tt * 64;
            const int seg_lo = tt < 64 ? 0 : SQ, seg_hi = tt < 64 ? SQ : SEG;
            const size_t rbase = (size_t)b * SEG;
            if (!(l + 1 == NL && tt >= 64)) {
            __syncthreads();
            { v2u ra[12], rg[12];
#pragma unroll
              for (int i = 0; i < 12; ++i) { const int zr = C.wave + 8 * i, t = t0 - 15 + zr; const bool ok = zr < 94 && t >= seg_lo && t < seg_hi;
                  const bf16* p = C.P() + (rbase + (ok ? t : t0)) * INW; ra[i] = *(const GAS v2u*)(p + 768 + c4); rg[i] = *(const GAS v2u*)(p + 1024 + c4); }
#pragma unroll
              for (int i = 0; i < 12; ++i) { const int zr = C.wave + 8 * i, t = t0 - 15 + zr; const bool ok = t >= seg_lo && t < seg_hi;
                  if (zr < 94) { const f32x4 a = bf4(ra[i]), gt = bf4(rg[i]);
                      const f32x4 z = ok ? (f32x4){a.x * sigmoidf_(gt.x), a.y * sigmoidf_(gt.y), a.z * sigmoidf_(gt.z), a.w * sigmoidf_(gt.w)} : (f32x4){0.f, 0.f, 0.f, 0.f};
                      *(LAS f32x4*)(zL + zr * 256 + c4) = z; } } }
            __syncthreads();
            for (int g = 0; g < 2; ++g) { const int i0 = C.wave * 8 + 4 * g;
                f32x4 u[4] = {b31, b31, b31, b31};
#pragma unroll
                for (int j = 0; j < 34; ++j) { const f32x4 z = *(const LAS f32x4*)(zL + (i0 + j) * 256 + c4);
#pragma unroll
                    for (int t = 0; t < 4; ++t) if (j - t >= 0 && j - t < 31) u[t] += wk[j - t] * z; }
                float s[4], vq[4], qq[4]; f32x4 d[4], cf[4];
#pragma unroll
                for (int t = 0; t < 4; ++t) s[t] = sum4(u[t]);
#pragma unroll
                for (int t = 0; t < 4; ++t) s[t] = wsum(s[t]);
#pragma unroll
                for (int t = 0; t < 4; ++t) { d[t] = u[t] - s[t] * (1.0f / 256.0f); vq[t] = sum4(d[t] * d[t]); }
#pragma unroll
                for (int t = 0; t < 4; ++t) vq[t] = wsum(vq[t]);
#pragma unroll
                for (int t = 0; t < 4; ++t) { const f32x4 y = d[t] * __builtin_amdgcn_rsqf(vq[t] * (1.0f / 256.0f) + EPS) * gln + bln;
                    cf[t] = (f32x4){y.x * sigmoidf_(y.x), y.y * sigmoidf_(y.y), y.z * sigmoidf_(y.z), y.w * sigmoidf_(y.w)}; qq[t] = sum4(cf[t] * cf[t]); }
#pragma unroll
                for (int t = 0; t < 4; ++t) qq[t] = wsum(qq[t]);
#pragma unroll
                for (int t = 0; t < 4; ++t) *(GAS v2u*)(C.Y() + (rbase + t0 + i0 + t) * D + 512 + c4) = pk4(cf[t] * __builtin_amdgcn_rsqf(qq[t] * (1.0f / 256.0f) + EPS) * gC);
            }
            }
            if (C.tid == 0) C.MISC[165] = (unsigned)C.G + __hip_atomic_fetch_add(tq, 1u, RLX_AGENT);
            __syncthreads();
            tile = (int)C.MISC[165];
        }
        __syncthreads();
    }
}
__device__ __forceinline__ void phase_conv2(const Ctx& C, const Args& A, int l) {
    const int c4 = 4 * C.lane;
    {
        const float* wsc = ldin<15>() + (size_t)l * 3 * 256 + c4; const f32x4 w30 = *(const f32x4*)(wsc), w31 = *(const f32x4*)(wsc + 256), w32 = *(const f32x4*)(wsc + 512);
        const float* gg = ldin<16>() + (size_t)l * D;
        const f32x4 gS = *(const f32x4*)(gg + 768 + c4);
        gu32* tq = C.ctl + CW_CQ + (NL + l) * 16; int kc = 0;
        for (int ch = C.vcu; ch < T / 64; ++kc) {
        if (C.tid == 0) C.MISC[166 + (kc & 1)] = (unsigned)C.G + __hip_atomic_fetch_add(tq, 1u, RLX_AGENT);
        const int rbeg = ch * 64 + C.wave * 8, rend = (l + 1 == NL && ch % 68 >= 64) ? rbeg : rbeg + 8;
        for (int r0 = rbeg; r0 < rend; r0 += 2) {
            const bool two = r0 + 1 < rend;
            v2u cgv[4], hvv[4], bgv[2];
#pragma unroll
            for (int k = 0; k < 4; ++k) { int rr = r0 - 1 + k; rr = rr < 0 ? 0 : (rr >= T ? T - 1 : rr); const bf16* p = C.P() + (size_t)rr * INW; cgv[k] = *(const GAS v2u*)(p + 1536 + c4); hvv[k] = *(const GAS v2u*)(p + 1792 + c4); }
#pragma unroll
            for (int u = 0; u < 2; ++u) { const int r = two || u == 0 ? r0 + u : r0; bgv[u] = *(const GAS v2u*)(C.P() + (size_t)r * INW + 1280 + c4); }
            f32x4 m[4];
#pragma unroll
            for (int k = 0; k < 4; ++k) m[k] = bf4(cgv[k]) * bf4(hvv[k]);
            f32x4 sv[2]; float qs[2];
#pragma unroll
            for (int u = 0; u < 2; ++u) { const int r = r0 + u; const int t = r % SEG; const bool has_prev = t != 0 && t != SQ, has_next = t != SQ - 1 && t != SEG - 1;
                const f32x4 zero = (f32x4){0.f, 0.f, 0.f, 0.f};
                sv[u] = bf4(bgv[u]) * (w30 * (has_prev ? m[u] : zero) + w31 * m[u + 1] + w32 * (has_next ? m[u + 2] : zero));
                qs[u] = sum4(sv[u] * sv[u]); }
            qs[0] = wsum(qs[0]); qs[1] = wsum(qs[1]);
#pragma unroll
            for (int u = 0; u < 2; ++u) { if (u == 1 && !two) break; bf16* yr = C.Y() + (size_t)(r0 + u) * D;
                *(GAS v2u*)(yr + 768 + c4) = pk4(sv[u] * __builtin_amdgcn_rsqf(qs[u] * (1.0f / 256.0f) + EPS) * gS); }
        }
        __syncthreads(); ch = (int)C.MISC[166 + (kc & 1)];
        }
    }
}

__device__ __forceinline__ void phase_route(const Ctx& C, const Args& A, int l) {
    volatile LAS unsigned* lhist = C.MISC + 80; volatile LAS unsigned* lbase = C.MISC + 112;
    const float br = C.lane < NE ? ldin<19>()[l * NE + C.lane] : 0.f;
    gu32* cnt = C.ctl + CW_CNT + (size_t)l * NE * 64;
    for (int tile = C.vcu; tile < T / 64; tile += C.G) {
        __syncthreads();
        if (C.tid < NE) lhist[C.tid] = 0u;
        __syncthreads();
        unsigned pp[8]; int rk[8];
        float lg[8];
#pragma unroll
        for (int i = 0; i < 8; ++i) { const int r = tile * 64 + C.wave * 8 + i; lg[i] = C.lane < NE ? C.LOG()[(size_t)r * NE + C.lane] + br : -INFINITY; }
#pragma unroll
        for (int i = 0; i < 8; ++i) { const int r = tile * 64 + C.wave * 8 + i; const float v = lg[i]; const int vb = __float_as_int(v);
            int rank = 0;
#pragma unroll
            for (int j = 0; j < NE; ++j) { const float vj = __int_as_float(__builtin_amdgcn_readlane(vb, j)); rank += (vj > v || (vj == v && j < C.lane)) ? 1 : 0; }
            const bool sel = C.lane < NE && rank < 4;
            float sv[4];
#pragma unroll
            for (int k = 0; k < 4; ++k) { const unsigned long long mk = __ballot(C.lane < NE && rank == k); const int src = (int)__builtin_ctzll(mk | (1ull << 63)); sv[k] = __int_as_float(__builtin_amdgcn_readlane(vb, src)); }
            const float e1 = __expf(sv[1] - sv[0]), e2 = __expf(sv[2] - sv[0]), e3 = __expf(sv[3] - sv[0]); const float inv = __builtin_amdgcn_rcpf(1.0f + e1 + e2 + e3);
            rk[i] = sel ? rank : -1; pp[i] = 0u;
            if (sel) { pp[i] = __hip_atomic_fetch_add((LAS unsigned*)(C.lds + MISC_OFF) + 80 + C.lane, 1u, __ATOMIC_RELAXED, __HIP_MEMORY_SCOPE_WORKGROUP);
                ((GAS float*)C.PAIR())[((size_t)r * 4 + rank) * 2 + 1] = __expf(v - sv[0]) * inv; } }
        __syncthreads();
        if (C.tid < NE) { const unsigned n = lhist[C.tid]; lbase[C.tid] = n ? __hip_atomic_fetch_add(cnt + C.tid * 64, n, RLX_AGENT) : 0u; }
        __syncthreads();
        const unsigned mybase = C.lane < NE ? lbase[C.lane] : 0u;
#pragma unroll
        for (int i = 0; i < 8; ++i) if (rk[i] >= 0) { const int r = tile * 64 + C.wave * 8 + i; const unsigned pos = mybase + pp[i];
            ((GAS unsigned*)C.PAIR())[((size_t)r * 4 + rk[i]) * 2] = (unsigned)C.lane | (pos << 5);
            C.TOK()[(size_t)C.lane * T + pos] = r; }
    }
    __syncthreads();
}

__device__ __forceinline__ void phase_gather(const Ctx& C, const Args& A, int l) {
    moe_tables(C, l, true);
    const LAS unsigned char* t2e = (const LAS unsigned char*)(C.lds + T2E_OFF);
    const int nslot = (int)C.MISC[NE] * 256;
    constexpr int RB = MK_FP8 ? 1024 : 2048, NV = RB / 1024;
    const unsigned char* srcb = MK_FP8 ? (const unsigned char*)C.HB8() : (const unsigned char*)C.HB();
    unsigned char* dstb = (unsigned char*)C.HP();
    for (int s0 = C.gw * 16; s0 < nslot; s0 += C.ngw * 16) { const unsigned e = t2e[s0 >> 8]; const unsigned pos0 = (unsigned)s0 - C.MISC[e] * 256u; const unsigned cnt = C.MISC[40 + e];
        int tk = -1; if (C.lane < 16 && pos0 + C.lane < cnt) tk = C.TOK()[(size_t)e * T + pos0 + C.lane];
        v4u v[16][NV];
#pragma unroll
        for (int u = 0; u < 16; ++u) { const int r = __builtin_amdgcn_readlane(tk, u);
            if (r >= 0) { const GAS v4u* src = (const GAS v4u*)(srcb + (size_t)r * RB) + C.lane;
#pragma unroll
                for (int q = 0; q < NV; ++q) v[u][q] = src[64 * q]; } }
#pragma unroll
        for (int u = 0; u < 16; ++u) { const int r = __builtin_amdgcn_readlane(tk, u);
            if (r >= 0) { GAS v4u* dst = (GAS v4u*)(dstb + (size_t)(s0 + u) * RB) + C.lane;
#pragma unroll
                for (int q = 0; q < NV; ++q) dst[64 * q] = v[u][q]; } }
    }
}

__global__ void __launch_bounds__(NWAVES * 64, 2) mk_fwd(Args args) {
    extern __shared__ __attribute__((aligned(16))) unsigned char lds_raw[];
    Ctx C;
    C.lds = (LAS unsigned char*)lds_raw; C.MISC = (volatile LAS unsigned*)(C.lds + MISC_OFF);
    C.tid = threadIdx.x; C.lane = C.tid & 63; C.wave = __builtin_amdgcn_readfirstlane(C.tid >> 6);
    C.G = gridDim.x; { const int bx = blockIdx.x; C.vcu = (C.G % 8 == 0) ? (bx % 8) * (C.G / 8) + bx / 8 : bx; }
    C.gw = C.vcu * NWAVES + C.wave; C.ngw = C.G * NWAVES;
    C.ws = (GAS unsigned char*)args.ws; C.ctl = (gu32*)(C.ws + WS_CTL);
    for (int u = C.tid; u < (LDS_BYTES - MISC_OFF) / 4; u += NWAVES * 64) ((LAS unsigned*)(C.lds + MISC_OFF))[u] = 0u;
    __syncthreads();
    const int lo = args.ph_lo, hi = args.ph_hi;
    const bool multi = (hi - lo) > 1;
    XcdBarrier bar; bar.bar = (unsigned*)(C.ctl + CW_BAR); bar.x = 0; bar.st = C.MISC + 160;
    if (multi) bar = xcd_barrier_post((unsigned*)(C.ctl + CW_BAR), C.MISC + 160);
#ifndef MK_PHMASK
#define MK_PHMASK 0xFFFF
#endif
#define IN(k) (lo <= (k) && (k) < hi)
#ifndef MK_STAMP
#define MK_STAMP -1
#endif
    unsigned long long tacc = 0ull, tst = 0ull;
#define T0(k) do { if (MK_STAMP == (k)) tst = __builtin_amdgcn_s_memrealtime(); } while (0)
#define T1(k) do { if (MK_STAMP == (k)) tacc += __builtin_amdgcn_s_memrealtime() - tst; } while (0)
#define FRESH() do { asm volatile("" : "+v"(C.tid), "+v"(C.lane)); asm volatile("" : "+s"(C.wave), "+s"(C.vcu), "+s"(C.gw), "+s"(C.ws), "+s"(C.ctl)); } while (0)
#define EN(k) ((MK_PHMASK >> (k)) & 1)
#ifndef MK_DUP
#define MK_DUP 0
#endif
#define NREP(k) (((MK_DUP >> (k)) & 1) ? 2 : 1)
#define SEAM(k) do { if (IN((k) + 1)) xcd_barrier(bar); } while (0)

    if (EN(12) && IN(0)) { _Pragma("unroll") for (int rep = 0; rep < NREP(12); ++rep) phase_prologue(C, args); SEAM(0); }
    __syncthreads();
    for (int u = C.tid; u < 64 * 16; u += NWAVES * 64) { const int pos = u >> 4, i = u & 15; const float inv = powf(10000.0f, -(float)(2 * i) / 32.0f); const float ang = (float)pos * inv;
        ((LAS f32x2*)(C.lds + ROPE_OFF))[u] = (f32x2){cosf(ang), sinf(ang)}; }
    __syncthreads();
    for (int l = 0; l < NL; ++l) {
        const int pb = 1 + l * PPL;
        if (EN(0) && IN(pb + 0)) { FRESH(); T0(0); phase_premix(C, args, l); SEAM(pb + 0); T1(0); }
        if (EN(1) && IN(pb + 1)) { FRESH(); T0(1);
            { LAS float* gl = (LAS float*)(C.lds + T2E_OFF); const float* gq = ldin<9>() + l * 64; const float* gk = ldin<10>() + l * 64;
              __syncthreads(); if (C.tid < 128) gl[C.tid] = C.tid < 64 ? gq[C.tid] : gk[C.tid - 64]; __syncthreads(); }
#if MK_FP8_IN == 2
            {
                pg8::Gemm g8{(const pg8::bf16_t*)C.HB8(), (const pg8::bf16_t*)((const unsigned char*)C.HP() + (size_t)l * INW * D), T, 768, D / 2}; pg8::StaticOrder S8; S8.init(T, 768, C.G, (int)blockIdx.x);
                pg8::EpiInProj E8{C.P(), (const LAS float*)(C.lds + ROPE_OFF), (const LAS float*)(C.lds + T2E_OFF), attn_body::C2, 0};
                pg8::gemm_phase<pg8::EpiInProj, pg8::StaticOrder, true, true, true>(C.lds, g8, S8, E8);
                pg8::Gemm g{C.HB(), C.WINT() + ((size_t)l * INW + 768) * D, T, 1280, D}; pg8::StaticOrder S; S.init(T, 1280, C.G, (int)blockIdx.x);
                pg8::EpiInProj E{C.P(), (const LAS float*)(C.lds + ROPE_OFF), (const LAS float*)(C.lds + T2E_OFF), attn_body::C2, 3};
                pg8::gemm_phase<pg8::EpiInProj, pg8::StaticOrder, true, true>(C.lds, g, S, E);
            }
#else
#if MK_FP8_IN == 1
            pg8::Gemm g{C.HB(), (const pg8::bf16_t*)((const unsigned char*)C.WINT() + (size_t)l * INW * D), T, INW, D / 2}; pg8::StaticOrder S; S.init(T, INW, C.G, (int)blockIdx.x);
#else
            pg8::Gemm g{C.HB(), C.WINT() + (size_t)l * INW * D, T, INW, D}; pg8::StaticOrder S; S.init(T, INW, C.G, (int)blockIdx.x);
#endif
            pg8::EpiInProj E{C.P(), (const LAS float*)(C.lds + ROPE_OFF), (const LAS float*)(C.lds + T2E_OFF), attn_body::C2, 0};
_Pragma("unroll") for (int rep = 0; rep < NREP(1); ++rep)
            pg8::gemm_phase<pg8::EpiInProj, pg8::StaticOrder, true, true, MK_FP8_IN == 1>(C.lds, g, S, E);
#endif
            { FRESH(); tail_convert(C, l, NROWT * (INW / 256), CV_HEAD); }
            SEAM(pb + 1); T1(1); }
        if (EN(3) && IN(pb + 3)) { FRESH(); T0(3); _Pragma("unroll") for (int rep = 0; rep < NREP(3); ++rep) phase_attn(C, l); phase_conv1(C, args, l); FRESH(); phase_conv2(C, args, l); SEAM(pb + 3); T1(3); }
        if (EN(5) && IN(pb + 5)) { FRESH(); T0(5);
            pg8::Gemm g{C.Y(), C.WOUTT() + (size_t)l * D * D, T, D, D};
            pg8::EpiGate E{C.OB(), C.MOD() + (size_t)l * 17 * MODW + 2 * D, C.X()};
            if (l + 1 < NL) { pg8::StaticOrder S; S.init(T, D, C.G, (int)blockIdx.x); pg8::gemm_phase<pg8::EpiGate, pg8::StaticOrder, true, true>(C.lds, g, S, E); }
            else { pg8::LatentOrder S; S.init(NB * SQ, D, C.G, (int)blockIdx.x); pg8::gemm_phase<pg8::EpiGate, pg8::LatentOrder, true, true>(C.lds, g, S, E); }
            { FRESH(); tail_convert(C, l, (l + 1 < NL ? NROWT : NB * SQ / 256) * (D / 256), CV_HEAD + tail_items(NROWT * (INW / 256), C.G)); }
            SEAM(pb + 5); T1(5); }
        if (EN(6) && IN(pb + 6)) { FRESH(); T0(6); _Pragma("unroll") for (int rep = 0; rep < NREP(6); ++rep) phase_premoe(C, args, l); SEAM(pb + 6); T1(6); }
        if (EN(10) && IN(pb + 10)) { FRESH(); T0(10);
            moe_tables(C, l, true);
#if MK_FP8
            pg8::Gemm g{(const pg8::bf16_t*)C.HB8(), (const pg8::bf16_t*)((const unsigned char*)C.W1T() + (size_t)l * NE * 2048 * D), CAP, NE * 2048, D / 2};
            pg8::MoeOrder S; S.init((int)C.MISC[NE], 8, C.G, (int)blockIdx.x, (const LAS unsigned char*)(C.lds + T2E_OFF)); S.tok = C.TOK(); S.tstride = T; S.tab = C.MISC;
            pg8::EpiSwiglu8 E{(unsigned char*)C.ACT(), C.B1P() + (size_t)l * NE * 2048};
_Pragma("unroll") for (int rep = 0; rep < NREP(10); ++rep)
            pg8::gemm_phase<pg8::EpiSwiglu8, pg8::MoeOrder, true, true, true, 0x7A7A7A7A, true>(C.lds, g, S, E);
#else
            pg8::Gemm g{C.HP(), C.W1T() + (size_t)l * NE * 2048 * D, CAP, NE * 2048, D};
            pg8::MoeOrder S; S.init((int)C.MISC[NE], 8, C.G, (int)blockIdx.x, (const LAS unsigned char*)(C.lds + T2E_OFF));
            pg8::EpiSwiglu E{C.ACT(), C.B1P() + (size_t)l * NE * 2048};
            pg8::gemm_phase<pg8::EpiSwiglu, pg8::MoeOrder, true, true>(C.lds, g, S, E);
#endif
            SEAM(pb + 10); T1(10); }
        if (EN(11) && IN(pb + 11)) { FRESH(); T0(11);
            moe_tables(C, l, true);
#if MK_FP8
            pg8::Gemm g{C.ACT(), (const pg8::bf16_t*)((const unsigned char*)C.W2T() + (size_t)l * NE * D * D), CAP, NE * D, D / 2};
            pg8::MoeOrder S; S.init((int)C.MISC[NE], 4, C.G, (int)blockIdx.x, (const LAS unsigned char*)(C.lds + T2E_OFF)); S.rev = true;
            pg8::EpiDown E{(unsigned char*)C.YP(), ldin<23>() + (size_t)l * NE * D};
_Pragma("unroll") for (int rep = 0; rep < NREP(11); ++rep)
            pg8::gemm_phase<pg8::EpiDown, pg8::MoeOrder, true, true, true, 0x7D7D7D7D>(C.lds, g, S, E);
#else
            pg8::Gemm g{C.ACT(), C.W2T() + (size_t)l * NE * D * D, CAP, NE * D, D};
            pg8::MoeOrder S; S.init((int)C.MISC[NE], 4, C.G, (int)blockIdx.x, (const LAS unsigned char*)(C.lds + T2E_OFF)); S.rev = true;
            pg8::EpiDown E{(unsigned char*)C.YP(), ldin<23>() + (size_t)l * NE * D};
            pg8::gemm_phase<pg8::EpiDown, pg8::MoeOrder, true, true>(C.lds, g, S, E);
#endif
            SEAM(pb + 11); T1(11); }
    }
    if (EN(13) && IN(NPHASE - 1)) { FRESH(); T0(13); phase_final(C, args); T1(13); }
    if (MK_STAMP >= 0 && blockIdx.x == 0 && C.tid == 0) { asm volatile("s_waitcnt vmcnt(0)" ::: "memory"); ldout()[5] = (float)tacc * 0.001f; }
#undef IN
#undef SEAM
}
}


#if defined(MK_DEBUG)
namespace mkdbg {
using namespace mk;
constexpr size_t WS_DBG = 3420 * MiB;
__device__ const int SROWS[12] = {0, 1, 63, 64, 255, 256, 4095, 4096, 4351, 4352, 30000, 69631};
__device__ __forceinline__ float bfv(const bf16* p, size_t i) { return __builtin_bit_cast(float, (unsigned)p[i] << 16); }
__device__ __forceinline__ void report(float* err, int s, float got, float ref, float atol) {
    float e = fabsf(got - ref) / (fabsf(ref) + atol); if (!(e == e)) e = 100.f;
    atomicMax((unsigned*)err + s, __builtin_bit_cast(unsigned, e));
}
__device__ __forceinline__ void row_info(int r, int& b, int& t, int& j) { b = r / SEG; t = r - b * SEG; j = t < SQ ? b : 16; }
__device__ __forceinline__ float silu_(float v) { return v / (1.f + expf(-v)); }
__device__ __forceinline__ float sigm_(float v) { return 1.f / (1.f + expf(-v)); }
__device__ __forceinline__ void naive_attn(const bf16* P, int r, int h, float* q, float* o) {
    int b, t, j; row_info(r, b, t, j);
    const int k0 = t < SQ ? b * SEG : b * SEG + SQ, nk = t < SQ ? SEG : CL;
    for (int d = 0; d < 64; ++d) q[d] = bfv(P, (size_t)r * INW + h * 64 + d);
    float m = -1e30f;
    for (int kk = 0; kk < nk; ++kk) { float s = 0.f; for (int d = 0; d < 64; ++d) s += q[d] * bfv(P, (size_t)(k0 + kk) * INW + 512 + (h >> 2) * 64 + d); m = fmaxf(m, s); }
    float l = 0.f; for (int d = 0; d < 64; ++d) o[d] = 0.f;
    for (int kk = 0; kk < nk; ++kk) { float s = 0.f; for (int d = 0; d < 64; ++d) s += q[d] * bfv(P, (size_t)(k0 + kk) * INW + 512 + (h >> 2) * 64 + d);
        const float p = exp2f(s - m); l += p; for (int d = 0; d < 64; ++d) o[d] += p * bfv(P, (size_t)(k0 + kk) * INW + 640 + (h >> 2) * 64 + d); }
    for (int d = 0; d < 64; ++d) o[d] /= l;
}
__device__ const int DBG_LS_1[2] = {0, 3};
__device__ const int DBG_JS_2[3] = {0, 7, 16};
__device__ const int DBG_NS_3[4] = {0, 1000, 2053, 6143};
__device__ const int DBG_CS_4[4] = {0, 1, 511, 1023};
__device__ const int DBG_CS_5[16] = {0, 63, 64, 511, 512, 575, 639, 640, 767, 768, 1024, 1279, 1280, 1536, 1792, 2047};
__device__ const int DBG_HS_6[4] = {0, 7, 8, 9};
__device__ const int DBG_HS_7[2] = {0, 5};
__device__ const int DBG_CS_8[4] = {0, 255, 256, 1023};
__device__ const int DBG_ES_9[3] = {0, 7, 31};
__device__ const int DBG_CS_10[3] = {0, 500, 1023};
__device__ const int DBG_CS_11[4] = {0, 127, 128, 1023};
__device__ const int DBG_CS_12[4] = {0, 300, 511, 1023};
__device__ const int DBG_CS_13[4] = {0, 300, 511, 1023};
__device__ const int DBG_CS_14[4] = {0, 300, 511, 1023};
__global__ void __launch_bounds__(256) dbg_kernel(Args a, int stage) {
    unsigned char* ws = a.ws; float* err = (float*)(ws + WS_DBG); float* scr = err + 256;
    const float* MOD = (const float*)(ws + WS_MOD); const bf16* HB = (const bf16*)(ws + WS_HB); const bf16* P = (const bf16*)(ws + WS_P); const bf16* Y = (const bf16*)(ws + WS_Y);
    const float* X = (const float*)(ws + WS_X); const float* LOG = (const float*)(ws + WS_LOG); const v2u* PAIR = (const v2u*)(ws + WS_PAIR); const int* TOK = (const int*)(ws + WS_TOK);
    const bf16* HP = (const bf16*)(ws + WS_HP); const bf16* ACT = (const bf16*)(ws + WS_ACT); const bf16* YP = (const bf16*)(ws + WS_YP);
    const unsigned* cnt = (const unsigned*)(ws + WS_CTL) + CW_CNT;
    const int tid = threadIdx.x;
    __shared__ float shm[15360]; __shared__ unsigned tstart[33];
    if (stage == 0) { if (tid < 64) err[tid] = 0.f; return; }
    if (stage == 1) {
        const int* ls = DBG_LS_1; const int* js = DBG_JS_2; const int* ns = DBG_NS_3;
        if (tid < 24) { const int l = ls[tid / 12], j = js[(tid / 4) % 3], n = ns[tid % 4]; float s = 0.f;
            for (int k = 0; k < 1024; ++k) { const float c = j < 16 ? a.in[1][j * 1024 + k] : a.in[3][k]; s += silu_(c) * a.in[4][((size_t)l * 1024 + k) * MODW + n]; }
            s += a.in[5][l * MODW + n]; report(err, 1, MOD[((size_t)l * 17 + j) * MODW + n], s, 0.05f); }
        return; }
    if (stage == 2 || stage == 8) {
        const int* cs = DBG_CS_4;
        if (tid < 48) { const int r = SROWS[tid / 4], c = cs[tid % 4]; int b, t, j; row_info(r, b, t, j);
            const float* xr = stage == 2 ? (t < SQ ? a.in[0] + ((size_t)b * SQ + t) * D : a.in[2] + ((size_t)b * CL + (t - SQ)) * D) : X + (size_t)r * D;
            float ss = 0.f; for (int k = 0; k < D; ++k) ss += xr[k] * xr[k];
            const float rs = 1.f / sqrtf(ss / D + EPS); const float* g = stage == 2 ? a.in[6] : a.in[7]; const float* mj = MOD + (size_t)j * MODW + (stage == 2 ? 0 : 3 * D);
            const float h = xr[c] * rs * g[c] * (1.f + mj[D + c]) + mj[c];
            report(err, stage, bfv(HB, (size_t)r * D + c), h, 0.05f);
            if (stage == 2) report(err, stage, X[(size_t)r * D + c], xr[c], 0.01f); }
        return; }
    if (stage == 3) {
        const int* cs = DBG_CS_5;
        if (tid < 192) { const int r = SROWS[tid / 16], c = cs[tid % 16]; float s = 0.f;
            for (int k = 0; k < D; ++k) s += bfv(HB, (size_t)r * D + k) * a.in[8][(size_t)k * INW + c];
            report(err, 3, bfv(P, (size_t)r * INW + c), s, 0.05f); }
        return; }
    if (stage == 4) {
        const int* hs = DBG_HS_6;
        if (tid < 48) { const int r = SROWS[tid / 4], h = hs[tid % 4]; int b, t, j; row_info(r, b, t, j);
            float* raw = shm + tid * 128; float* o = raw + 64; float ss = 0.f;
            for (int d = 0; d < 64; ++d) { float s = 0.f; for (int k = 0; k < D; ++k) s += bfv(HB, (size_t)r * D + k) * a.in[8][(size_t)k * INW + h * 64 + d]; raw[d] = s; ss += s * s; }
            const float rs = 1.f / sqrtf(ss / 64.f + EPS); const float* g = h < 8 ? a.in[9] : a.in[10];
            for (int d = 0; d < 64; ++d) raw[d] = raw[d] * rs * g[d];
            for (int ax = 0; ax < 2; ++ax) for (int i = 0; i < 16; ++i) { const float pos = ax == 0 ? (float)(t / 64) : (float)(t % 64); const float ang = pos * powf(10000.f, -(float)(2 * i) / 32.f);
                const float c = t < SQ ? cosf(ang) : 1.f, s = t < SQ ? sinf(ang) : 0.f; const float x1 = raw[ax * 32 + i], x2 = raw[ax * 32 + 16 + i];
                o[ax * 32 + i] = x1 * c - x2 * s; o[ax * 32 + 16 + i] = x2 * c + x1 * s; }
            for (int d = 0; d < 64; ++d) { const float ref = o[d] * (h < 8 ? 0.125f * 1.4426950408889634f : 1.f); report(err, 4, bfv(P, (size_t)r * INW + h * 64 + d), ref, h < 8 ? 0.045f : 0.25f); } }
        return; }
    if (stage == 5) {
        const int* hs = DBG_HS_7;
        if (tid < 24) { const int r = SROWS[tid / 2], h = hs[tid % 2]; float* o = shm + tid * 128; naive_attn(P, r, h, o + 64, o);
            for (int d = 0; d < 64; ++d) report(err, 5, bfv(Y, (size_t)r * D + h * 64 + d), o[d], 0.05f); }
        return; }
    if (stage == 6) {
        if (tid < 12) { const int r = SROWS[tid]; int b, t, j; row_info(r, b, t, j); const int lo = t < SQ ? 0 : SQ, hi = t < SQ ? SQ : SEG; const size_t rb = (size_t)b * SEG;
            float* u = shm + tid * 256; float mean = 0.f;
            for (int c = 0; c < 256; ++c) { float s = a.in[12][c];
                for (int jt = 0; jt < 31; ++jt) { const int tt = t + jt - 15; if (tt >= lo && tt < hi) s += a.in[11][jt * 256 + c] * bfv(P, (rb + tt) * INW + 768 + c) * sigm_(bfv(P, (rb + tt) * INW + 1024 + c)); }
                u[c] = s; mean += s; }
            mean /= 256.f; float var = 0.f; for (int c = 0; c < 256; ++c) var += (u[c] - mean) * (u[c] - mean); var /= 256.f;
            float ss = 0.f; for (int c = 0; c < 256; ++c) { const float y = (u[c] - mean) / sqrtf(var + EPS) * a.in[13][c] + a.in[14][c]; u[c] = silu_(y); ss += u[c] * u[c]; }
            float rs = 1.f / sqrtf(ss / 256.f + EPS);
            for (int c = 0; c < 256; ++c) report(err, 6, bfv(Y, (size_t)r * D + 512 + c), u[c] * rs * a.in[16][512 + c], 0.25f);
            ss = 0.f;
            for (int c = 0; c < 256; ++c) { float s = 0.f; for (int jt = 0; jt < 3; ++jt) { const int tt = t + jt - 1; if (tt >= lo && tt < hi) s += a.in[15][jt * 256 + c] * bfv(P, (rb + tt) * INW + 1536 + c) * bfv(P, (rb + tt) * INW + 1792 + c); }
                u[c] = bfv(P, (size_t)r * INW + 1280 + c) * s; ss += u[c] * u[c]; }
            rs = 1.f / sqrtf(ss / 256.f + EPS);
            for (int c = 0; c < 256; ++c) report(err, 7, bfv(Y, (size_t)r * D + 768 + c), u[c] * rs * a.in[16][768 + c], 0.25f); }
        if (tid >= 64 && tid < 80) { const int r = SROWS[(tid - 64) / 8 == 0 ? 2 : 7], h = (tid - 64) % 8; float* o = shm + 3072 + (tid - 64) * 128; naive_attn(P, r, h, o + 64, o);
            for (int d = 0; d < 64; ++d) scr[((tid - 64) / 8) * 512 + h * 64 + d] = o[d]; }
        __syncthreads();
        if (tid < 2) { const int r = SROWS[tid == 0 ? 2 : 7]; float ss = 0.f; for (int c = 0; c < 512; ++c) ss += scr[tid * 512 + c] * scr[tid * 512 + c];
            const float rs = 1.f / sqrtf(ss / 512.f + EPS); for (int c = 0; c < 512; ++c) report(err, 6, bfv(Y, (size_t)r * D + c), scr[tid * 512 + c] * rs * a.in[16][c], 0.25f); }
        return; }
    if (stage == 9) {
        const int* cs = DBG_CS_8;
        if (tid < 48) { const int r = SROWS[tid / 4], c = cs[tid % 4]; int b, t, j; row_info(r, b, t, j);
            const float* xr = t < SQ ? a.in[0] + ((size_t)b * SQ + t) * D : a.in[2] + ((size_t)b * CL + (t - SQ)) * D;
            float s = 0.f; for (int k = 0; k < D; ++k) s += bfv(Y, (size_t)r * D + k) * a.in[17][(size_t)k * D + c];
            report(err, 9, X[(size_t)r * D + c], xr[c] + MOD[(size_t)j * MODW + 2 * D + c] * s, 0.05f); }
        return; }
    if (stage == 10) {
        const int* es = DBG_ES_9;
        if (tid < 36) { const int r = SROWS[tid / 3], e = es[tid % 3]; float s = 0.f; for (int k = 0; k < D; ++k) s += bfv(HB, (size_t)r * D + k) * a.in[18][(size_t)k * NE + e];
            report(err, 10, LOG[(size_t)r * NE + e], s, 0.05f); }
        return; }
    if (stage == 11) {
        if (tid < 12) { const int r = SROWS[tid]; float* v = shm + tid * 32; for (int e = 0; e < 32; ++e) v[e] = LOG[(size_t)r * NE + e] + a.in[19][e];
            float* sv = shm + 1024 + tid * 8; float* sef = sv + 4;
            for (int k = 0; k < 4; ++k) { int bi = 0; for (int e = 1; e < 32; ++e) if (v[e] > v[bi]) bi = e; sef[k] = (float)bi; sv[k] = v[bi]; v[bi] = -1e30f; }
            float den = 0.f; for (int k = 0; k < 4; ++k) den += expf(sv[k] - sv[0]);
            { float* vv = shm + 2048 + tid * 32; for (int e = 0; e < 32; ++e) vv[e] = LOG[(size_t)r * NE + e] + a.in[19][e];
              float mx = -1e30f, dn = 0.f; for (int k = 0; k < 4; ++k) mx = fmaxf(mx, vv[PAIR[(size_t)r * 4 + k].x & 31]); for (int k = 0; k < 4; ++k) dn += expf(vv[PAIR[(size_t)r * 4 + k].x & 31] - mx);
              for (int k = 0; k < 4; ++k) report(err, 22, __uint_as_float((unsigned)(PAIR[(size_t)r * 4 + k].y + 0u)), expf(vv[PAIR[(size_t)r * 4 + k].x & 31] - mx) / dn, 0.01f); }
            for (int k = 0; k < 4; ++k) { const v2u pr = PAIR[(size_t)r * 4 + k]; const int e = pr.x & 31; const unsigned pos = pr.x >> 5;
                if (tid == 0 && (k == 0 || k == 3)) { err[30 + (k ? 2 : 0)] = __uint_as_float((unsigned)(pr.y + 0u)); err[31 + (k ? 2 : 0)] = expf(sv[k] - sv[0]) / den; }
                report(err, 17, (float)e == sef[k] ? 0.f : 1.f, 0.f, 1.0f); report(err, 18, __uint_as_float((unsigned)(pr.y + 0u)), expf(sv[k] - sv[0]) / den, 0.01f);
                const unsigned c = cnt[e * 64]; report(err, 19, pos < c ? 1.f : 0.f, 1.f, 0.001f); report(err, 20, (float)TOK[(size_t)e * T + (pos < (unsigned)T ? pos : 0)], (float)r, 0.001f); } }
        if (tid == 255) { unsigned s = 0; for (int e = 0; e < 32; ++e) s += cnt[e * 64]; report(err, 21, (float)s, (float)(T * 4), 0.001f); }
        if (tid == 253) { int c = 0; const float* pf = (const float*)PAIR; for (int q = 0; q < 64; ++q) { const float w = pf[q * 2 + 1]; if (w > 0.01f && w <= 1.f) ++c; } err[44] = (float)c; }
        if (tid == 254) { for (int k = 0; k < 4; ++k) { const float w = __uint_as_float((unsigned)(PAIR[k].y + 0u)); err[40 + k] = (float)(!(w == w) || w < 0.f || w > 1.f ? 3 : w < 1e-30f ? 0 : w < 0.05f ? 1 : 2); } }
        return; }
    if (tid == 0) { unsigned s = 0; for (int e = 0; e < 32; ++e) { tstart[e] = s; s += (cnt[e * 64] + 255u) >> 8; } tstart[32] = s; }
    __syncthreads();
    if (stage == 12) {
        const int* cs = DBG_CS_10;
        if (tid < 48) { const int r = SROWS[tid / 4], k = tid % 4; const v2u pr = PAIR[(size_t)r * 4 + k]; const size_t slot = (size_t)tstart[pr.x & 31] * 256 + (pr.x >> 5);
            for (int i = 0; i < 3; ++i) report(err, 12, bfv(HP, slot * D + cs[i]), bfv(HB, (size_t)r * D + cs[i]), 0.001f); }
        return; }
    if (stage == 13) {
        const int* cs = DBG_CS_11;
        if (tid < 192) { const int r = SROWS[tid / 16], k = (tid / 4) % 4, c = cs[tid % 4]; const v2u pr = PAIR[(size_t)r * 4 + k]; const int e = pr.x & 31; const size_t slot = (size_t)tstart[e] * 256 + (pr.x >> 5);
            float ug = a.in[21][(size_t)e * 2048 + 2 * c], uu = a.in[21][(size_t)e * 2048 + 2 * c + 1]; const float* w = a.in[20] + (size_t)e * 1024 * 2048;
            for (int kk = 0; kk < D; ++kk) { const float hv = bfv(HP, slot * D + kk); ug += hv * w[(size_t)kk * 2048 + 2 * c]; uu += hv * w[(size_t)kk * 2048 + 2 * c + 1]; }
            const float gc = fminf(ug, 7.f), uc = fminf(fmaxf(uu, -7.f), 7.f); const float ref = (uc + 1.f) * gc * sigm_(1.702f * gc);
            report(err, 13, bfv(ACT, slot * D + c), ref, 0.25f); }
        return; }
    if (stage == 14) {
        const int* cs = DBG_CS_12;
        if (tid < 192) { const int r = SROWS[tid / 16], k = (tid / 4) % 4, c = cs[tid % 4]; const v2u pr = PAIR[(size_t)r * 4 + k]; const int e = pr.x & 31; const size_t slot = (size_t)tstart[e] * 256 + (pr.x >> 5);
            float s = a.in[23][(size_t)e * 1024 + c]; const float* w = a.in[22] + (size_t)e * 1024 * 1024;
            for (int kk = 0; kk < D; ++kk) s += bfv(ACT, slot * D + kk) * w[(size_t)kk * 1024 + c];
            report(err, 14, bfv(YP, slot * D + c), s, 0.25f); }
        return; }
    if (stage == 15) {
        const int* cs = DBG_CS_13;
        if (tid < 48) { const int r = SROWS[tid / 4], c = cs[tid % 4]; int b, t, j; row_info(r, b, t, j); float f = 0.f;
            for (int k = 0; k < 4; ++k) { const v2u pr = PAIR[(size_t)r * 4 + k]; const size_t slot = (size_t)tstart[pr.x & 31] * 256 + (pr.x >> 5); f += __uint_as_float((unsigned)(pr.y + 0u)) * bfv(YP, slot * D + c); }
            scr[2048 + tid] = X[(size_t)r * D + c] + MOD[(size_t)j * MODW + 5 * D + c] * f; }
        return; }
    if (stage == 16) {
        const int* cs = DBG_CS_14;
        if (tid < 48) { const int r = SROWS[tid / 4], c = cs[tid % 4]; report(err, 16, X[(size_t)r * D + c], scr[2048 + tid], 0.02f); }
        return; }
    if (stage == 99) {
        if (tid == 0) {
#if MK_DEBUG == 3
            a.out[0] = (err[44] + 1.f) * 1e20f; return;
#endif
#if MK_DEBUG == 2
            { const float* db = err + 4096; const v2u* PR = (const v2u*)(a.ws + WS_PAIR); int code = 0;
              auto close = [](float x, float y) { return fabsf(x - y) <= 1e-3f * (fabsf(y) + 1e-3f); };
              for (int ln = 0; ln < 4 && !code; ++ln) for (int j = 0; j < 4; ++j) if (!(db[ln * 16 + j] == db[j])) { code = 10 + ln; break; }
              if (!code) for (int j = 0; j < 3; ++j) if (!(db[j] >= db[j + 1])) code = 20 + j;
              if (!code) for (int ln = 0; ln < 4 && !code; ++ln) for (int j = 0; j < 3; ++j) if (!close(db[ln * 16 + 4 + j], expf(db[j + 1] - db[0]))) { code = 30 + ln; break; }
              if (!code) for (int ln = 0; ln < 4; ++ln) if (!close(db[ln * 16 + 7], 1.f + db[ln * 16 + 4] + db[ln * 16 + 5] + db[ln * 16 + 6])) { code = 40 + ln; break; }
              if (!code) for (int ln = 0; ln < 4; ++ln) if (!close(db[ln * 16 + 8], 1.f / db[ln * 16 + 7])) { code = 50 + ln; break; }
              if (!code) for (int ln = 0; ln < 4; ++ln) if (!close(db[ln * 16 + 9], (ln == 0 ? 1.f : db[ln * 16 + 3 + ln]) * db[ln * 16 + 8])) { code = 60 + ln; break; }
              if (!code) for (int ln = 0; ln < 4; ++ln) if (!close(__uint_as_float((unsigned)(PR[ln].y + 0u)), db[ln * 16 + 9])) { code = 70 + ln; break; }
              if (!code) code = 88;
              a.out[0] = (float)code * 1e20f; return; }
#endif
            int mask = 0; for (int i = 0; i < 6; ++i) if (err[17 + i] > 0.06f) mask |= 1 << i; if (mask) err[11] = 1.f;
            for (int s = 1; s < 17; ++s) if (err[s] > 0.06f) { if (s == 11) { a.out[0] = (float)(10 + mask) * 1e14f; break; } a.out[0] = (1.f + 10.f * fminf(err[s], 0.89f)) * powf(10.f, (float)(4 + s)); break; } }
        return; }
}
}
#endif
#ifndef MK_ONE_LAUNCH
#define MK_ONE_LAUNCH 1
#endif
extern "C" void kernel_launch(void* const* d_in, const int* in_sizes, int n_in, void* d_out, int out_size, void* d_ws, size_t ws_size, hipStream_t stream) {
    using namespace mk;
    static int grid = 0;
    if (grid == 0) {
        if (n_in != 24 || out_size != NB * SQ * D || ws_size < WS_END) { fprintf(stderr, "kernel_launch: unexpected shapes (n_in %d, out %d, ws %zu)\n", n_in, out_size, ws_size); grid = -1; return; }
        int dev = 0, cus = 0, per_cu = 0;
        if (hipGetDevice(&dev) != hipSuccess || hipDeviceGetAttribute(&cus, hipDeviceAttributeMultiprocessorCount, dev) != hipSuccess) { grid = -1; return; }
        if (hipFuncSetAttribute((const void*)mk_fwd, hipFuncAttributeMaxDynamicSharedMemorySize, LDS_BYTES) != hipSuccess) { fprintf(stderr, "kernel_launch: hipFuncSetAttribute failed\n"); grid = -1; return; }
        if (hipOccupancyMaxActiveBlocksPerMultiprocessor(&per_cu, (const void*)mk_fwd, NWAVES * 64, LDS_BYTES) != hipSuccess || per_cu < 1) { fprintf(stderr, "kernel_launch: occupancy query says %d\n", per_cu); per_cu = 1; }
        (void)hipGetLastError();
        grid = cus;
    }
    if (grid < 0) return;
    (void)hipMemsetAsync((char*)d_ws + WS_CTL, 0, CTL_ZERO_BYTES, stream);
    Args a{};
    for (int i = 0; i < 24; ++i) a.in[i] = (const float*)d_in[i];
    a.out = (float*)d_out; a.ws = (unsigned char*)d_ws;
#if MK_ONE_LAUNCH
    a.ph_lo = 0; a.ph_hi = NPHASE;
    hipLaunchKernelGGL(mk_fwd, dim3(grid), dim3(NWAVES * 64), LDS_BYTES, stream, a);
#else
#if defined(MK_DEBUG)
#define DBG(s) hipLaunchKernelGGL(mkdbg::dbg_kernel, dim3(1), dim3(256), 0, stream, a, (s))
    DBG(0);
#else
#define DBG(s) do {} while (0)
#endif
    for (int p = 0; p < NPHASE; ++p) { a.ph_lo = p; a.ph_hi = p + 1; hipLaunchKernelGGL(mk_fwd, dim3(grid), dim3(NWAVES * 64), LDS_BYTES, stream, a);
        if (p == 0) DBG(1); if (p == 1) DBG(2); if (p == 2) DBG(3); if (p == 3) DBG(4); if (p == 4) DBG(5); if (p == 5) DBG(6); if (p == 6) DBG(9); if (p == 7) DBG(8); if (p == 8) DBG(10);
        if (p == 9) DBG(11); if (p == 10) DBG(12); if (p == 11) DBG(13); if (p == 12) { DBG(14); DBG(15); } if (p == 13) DBG(16); }
    DBG(99);
#endif
}
```

```cpp
#include <hip/hip_runtime.h>
#include <hip/hip_bf16.h>
#include <cstdio>
#include <cstdint>
#include <cmath>
namespace pg8 {
#define PG8_LAS __attribute__((address_space(3)))
typedef unsigned short bf16_t;
typedef short bf16x8 __attribute__((ext_vector_type(8)));
typedef float f32x4 __attribute__((ext_vector_type(4)));
typedef unsigned u32x4 __attribute__((ext_vector_type(4)));
typedef int i32x4 __attribute__((ext_vector_type(4)));
typedef int i32x8 __attribute__((ext_vector_type(8)));
typedef unsigned u32x2 __attribute__((ext_vector_type(2)));
constexpr int PG8_BIAS_OFF = 144384;
constexpr int PG8_IDX_OFF = PG8_BIAS_OFF + 2048;
constexpr int BM = 256, BK = 64, HALF = 128, HTB = HALF * BK * 2  , STAGE_BYTES = 8 * HTB, NXCD = 8, WGM = 8;

__host__ __device__ __forceinline__ int lds_byte(int r, int c) { const int st = (r >> 4) * 2 + (c >> 5), rr = r & 15, cc = c & 31, ob = rr * 64 + cc * 2; return st * 1024 + (ob ^ (((ob >> 9) & 1) << 5)); }
__host__ __device__ __forceinline__ void stage_rc(int b, int& R, int& C) { const int st = b / 1024, sb = b % 1024, swz = sb ^ (((sb >> 9) & 1) << 5); R = (st >> 1) * 16 + swz / 64; C = (st & 1) * 32 + (swz % 64) / 2; }
__host__ __device__ __forceinline__ int perm32(int rho) { const int n = rho >> 4, i = rho & 15; return 8 * (i >> 2) + 4 * n + (i & 3); }

__device__ __forceinline__ int shx(int v, int o) { int l = __builtin_amdgcn_mbcnt_hi(-1, __builtin_amdgcn_mbcnt_lo(-1, 0)); asm volatile("" : "+v"(l)); return __builtin_amdgcn_ds_bpermute((l ^ o) << 2, v); }
__device__ __forceinline__ float shx(float v, int o) { return __int_as_float(shx(__float_as_int(v), o)); }
template <int CTRL> __device__ __forceinline__ float dpp_f(float v) { return __int_as_float(__builtin_amdgcn_update_dpp(0, __float_as_int(v), CTRL, 0xF, 0xF, true)); }
__device__ __forceinline__ float sum_x16(float v) { const auto r = __builtin_amdgcn_permlane16_swap(__float_as_uint(v), __float_as_uint(v), false, false); return __uint_as_float(r[0]) + __uint_as_float(r[1]); }
__device__ __forceinline__ float sum_x32(float v) { const auto r = __builtin_amdgcn_permlane32_swap(__float_as_uint(v), __float_as_uint(v), false, false); return __uint_as_float(r[0]) + __uint_as_float(r[1]); }
__device__ __forceinline__ float get_x32(float v, bool lo_half) { const auto r = __builtin_amdgcn_permlane32_swap(__float_as_uint(v), __float_as_uint(v), false, false); return __uint_as_float(lo_half ? r[1] : r[0]); }
__device__ __forceinline__ float get_x16(float v, bool even_row) { const auto r = __builtin_amdgcn_permlane16_swap(__float_as_uint(v), __float_as_uint(v), false, false); return __uint_as_float(even_row ? r[1] : r[0]); }
__device__ __forceinline__ float wsum(float v) { v += dpp_f<0xB1>(v); v += dpp_f<0x4E>(v); v += dpp_f<0x141>(v); v += dpp_f<0x140>(v); v = sum_x16(v); return sum_x32(v); }
struct Unit { int pm, pn; };
struct Gemm { const bf16_t* A; const bf16_t* Bt; int M, N, K; };

struct StaticOrder {
    int nM, nN, nwg, G, c;
    __host__ __device__ void init(int M, int N, int G_, int c_) { nM = M / BM; nN = N / BM; nwg = nM * nN; G = G_; c = c_; }
    __host__ __device__ bool next(int i, Unit& u) const {
        const long L = (long)i * G + c; if (L >= nwg) return false;
        int wgid = (int)L; { const int q = nwg / NXCD, r = nwg % NXCD, xcd = wgid % NXCD, off = wgid / NXCD; wgid = (xcd < r ? xcd * (q + 1) : r * (q + 1) + (xcd - r) * q) + off; }
        const int nig = WGM * nN, gid = wgid / nig, fm = gid * WGM, gsz = (nM - fm) < WGM ? (nM - fm) : WGM;
        u.pm = fm + ((wgid % nig) % gsz); u.pn = (wgid % nig) / gsz; return true;
    }
    __device__ __forceinline__ void a_ready(const Unit&) const {}
    __device__ __forceinline__ void done(const Unit&) const {}
};

struct LatentOrder : StaticOrder {
    __host__ __device__ bool next(int i, Unit& u) const { if (!StaticOrder::next(i, u)) return false; u.pm += u.pm >> 4; return true; }
};

__device__ __forceinline__ unsigned cvt_pk_bf16(float lo, float hi) { unsigned r; asm volatile("v_cvt_pk_bf16_f32 %0, %1, %2" : "=v"(r) : "v"(lo), "v"(hi)); return r; }
typedef float f32x2 __attribute__((ext_vector_type(2)));

struct MoeOrder {
    int nN, ntl, nwg, G, c; const PG8_LAS unsigned char* t2e; bool rev = false;
    const int* tok; int tstride; const volatile PG8_LAS unsigned* tab;
    __device__ __forceinline__ const int* idx_src(const Unit& u) const { const int e = u.pn / nN; return tok + (size_t)e * tstride + (size_t)(u.pm - (int)tab[e]) * 256; }
    __device__ __forceinline__ int nvalid(const Unit& u) const { const int e = u.pn / nN; return (int)tab[40 + e] - (u.pm - (int)tab[e]) * 256; }
    __device__ __forceinline__ void init(int ntl_, int nN_, int G_, int c_, const PG8_LAS unsigned char* t2e_) { ntl = ntl_; nN = nN_; nwg = ntl_ * nN_; G = G_; c = c_; t2e = t2e_; }
    __device__ __forceinline__ bool next(int i, Unit& u) const {
        const long L = (long)i * G + c; if (L >= nwg) return false;
        int wgid = (int)L; { const int q = nwg / NXCD, r = nwg % NXCD, xcd = wgid % NXCD; int off = wgid / NXCD; if (rev) off = (xcd < r ? q : q - 1) - off;
            wgid = (xcd < r ? xcd * (q + 1) : r * (q + 1) + (xcd - r) * q) + off; }
        const int nig = WGM * nN, gid = wgid / nig, fm = gid * WGM, gsz = (ntl - fm) < WGM ? (ntl - fm) : WGM;
        const int rt = fm + ((wgid % nig) % gsz), pn = (wgid % nig) / gsz;
        u.pm = rt; u.pn = (int)t2e[rt] * nN + pn; return true;
    }
    __device__ __forceinline__ void a_ready(const Unit&) const {}
    __device__ __forceinline__ void done(const Unit&) const {}
};

struct EpiStore {
    static constexpr bool PERM = true, AFTER_DRAIN = false, HAS_INIT = false;
    bf16_t* O; int ldc;
    __device__ __forceinline__ void operator()(const f32x4 (&acc)[2][2][4][2], const Unit& u, int wr, int wc, int fr, int fq) const {
        const int row0 = u.pm * BM + wr * 64 + fr, col0 = u.pn * BM + wc * 32 + 8 * fq;
#pragma unroll
        for (int ai = 0; ai < 2; ++ai)
#pragma unroll
            for (int m = 0; m < 4; ++m) { bf16_t* rowp = O + (size_t)(row0 + ai * HALF + m * 16) * ldc + col0;
#pragma unroll
                for (int bj = 0; bj < 2; ++bj) { const f32x4 v0 = acc[ai][bj][m][0], v1 = acc[ai][bj][m][1];
                    u32x4 w; w.x = cvt_pk_bf16(v0[0], v0[1]); w.y = cvt_pk_bf16(v0[2], v0[3]); w.z = cvt_pk_bf16(v1[0], v1[1]); w.w = cvt_pk_bf16(v1[2], v1[3]);
                    *(u32x4*)(rowp + bj * HALF) = w; } }
    }
};
struct EpiResid {
    static constexpr bool PERM = false, AFTER_DRAIN = false, HAS_INIT = false;
    float* X; const float* gate;
    __device__ __forceinline__ void operator()(const f32x4 (&acc)[2][2][4][2], const Unit& u, int wr, int wc, int fr, int fq) const {
        const int seg = u.pm / 17, rem = u.pm - seg * 17; const int j = (rem == 16) ? 16 : seg;
        const int row0 = u.pm * BM + wr * 64 + fr, col0 = u.pn * BM + wc * 32 + 4 * fq;
        const float* g = gate + (size_t)j * 6144 + col0;
        f32x4 gv[2][2];
#pragma unroll
        for (int bj = 0; bj < 2; ++bj)
#pragma unroll
            for (int n = 0; n < 2; ++n) gv[bj][n] = *(const f32x4*)(g + bj * HALF + n * 16);
#pragma unroll
        for (int ai = 0; ai < 2; ++ai)
#pragma unroll
            for (int m = 0; m < 4; ++m) { float* rowp = X + (size_t)(row0 + ai * HALF + m * 16) * 1024 + col0;
#pragma unroll
                for (int bj = 0; bj < 2; ++bj)
#pragma unroll
                    for (int n = 0; n < 2; ++n) { f32x4* p = (f32x4*)(rowp + bj * HALF + n * 16); *p = *p + gv[bj][n] * acc[ai][bj][m][n]; } }
    }
};
struct EpiInProj {
    static constexpr bool PERM = true, AFTER_DRAIN = false, HAS_INIT = false;
    bf16_t* P; const PG8_LAS float* rope; const PG8_LAS float* gqk; float c2; int pn0;
    __device__ __forceinline__ void operator()(const f32x4 (&acc)[2][2][4][2], const Unit& u, int wr, int wc, int fr, int fq) const {
        const int pnt = u.pn + pn0; const int row0 = u.pm * BM + wr * 64 + fr, col0 = pnt * BM + 64 * wc + 8 * fq;
        const bool isq = pnt < 2, isk = pnt == 2 && wc < 2;
        if (!(isq || isk)) {
#pragma unroll
            for (int ai = 0; ai < 2; ++ai)
#pragma unroll
                for (int m = 0; m < 4; ++m) { bf16_t* rowp = P + (size_t)(row0 + ai * HALF + m * 16) * 2048 + col0;
#pragma unroll
                    for (int bj = 0; bj < 2; ++bj) { const f32x4 v0 = acc[ai][bj][m][0], v1 = acc[ai][bj][m][1];
                        u32x4 w; w.x = cvt_pk_bf16(v0[0], v0[1]); w.y = cvt_pk_bf16(v0[2], v0[3]); w.z = cvt_pk_bf16(v1[0], v1[1]); w.w = cvt_pk_bf16(v1[2], v1[3]);
                        *(u32x4*)(rowp + 32 * bj) = w; } }
            return; }
        const PG8_LAS float* gp = gqk + (isq ? 0 : 64) + 8 * fq; const float sc = isq ? c2 : 1.0f;
        f32x4 gn[2][2];
#pragma unroll
        for (int bj = 0; bj < 2; ++bj)
#pragma unroll
            for (int n = 0; n < 2; ++n) gn[bj][n] = *(const PG8_LAS f32x4*)(gp + 32 * bj + 4 * n);
        const int seg = u.pm / 17, rem = u.pm - seg * 17; const bool lat = rem != 16;
        const bool first = fq < 2; const int i0 = 8 * (fq & 1);
#pragma unroll
        for (int ai = 0; ai < 2; ++ai)
#pragma unroll
            for (int m = 0; m < 4; ++m) { const int lr = wr * 64 + fr + ai * HALF + m * 16, t = rem * 256 + lr;
                f32x4 x[2][2]; float ss = 0.f;
#pragma unroll
                for (int bj = 0; bj < 2; ++bj)
#pragma unroll
                    for (int n = 0; n < 2; ++n) { x[bj][n] = acc[ai][bj][m][n]; ss += (x[bj][n][0] * x[bj][n][0] + x[bj][n][1] * x[bj][n][1]) + (x[bj][n][2] * x[bj][n][2] + x[bj][n][3] * x[bj][n][3]); }
                ss = sum_x32(sum_x16(ss));
                const float rs = __builtin_amdgcn_rsqf(ss * (1.0f / 64.0f) + 1e-6f);
                bf16_t* rowp = P + (size_t)(u.pm * BM + lr) * 2048 + col0;
#pragma unroll
                for (int bj = 0; bj < 2; ++bj) { const int pos = lat ? (bj == 0 ? (t >> 6) : (t & 63)) : 0;
                    f32x4 o[2];
#pragma unroll
                    for (int n = 0; n < 2; ++n)
#pragma unroll
                        for (int i = 0; i < 4; ++i) { const float xv = x[bj][n][i] * rs * gn[bj][n][i]; const float pv = get_x32(xv, first);
                            const float cs = rope[(pos * 16 + i0 + 4 * n + i) * 2], sn = rope[(pos * 16 + i0 + 4 * n + i) * 2 + 1];
                            const float rot = first ? xv * cs - pv * sn : xv * cs + pv * sn;
                            o[n][i] = (lat ? rot : xv) * sc; }
                    u32x4 w; w.x = cvt_pk_bf16(o[0][0], o[0][1]); w.y = cvt_pk_bf16(o[0][2], o[0][3]); w.z = cvt_pk_bf16(o[1][0], o[1][1]); w.w = cvt_pk_bf16(o[1][2], o[1][3]);
                    *(u32x4*)(rowp + 32 * bj) = w; } }
    }
};
struct EpiGate {
    static constexpr bool PERM = true, AFTER_DRAIN = false, HAS_INIT = false;
    bf16_t* O; const float* gate; const bf16_t* X;
    __device__ __forceinline__ void operator()(const f32x4 (&acc)[2][2][4][2], const Unit& u, int wr, int wc, int fr, int fq) const {
        const int seg = u.pm / 17, rem = u.pm - seg * 17; const int j = (rem == 16) ? 16 : seg;
        const int row0 = u.pm * BM + wr * 64 + fr, col0 = u.pn * BM + wc * 32 + 8 * fq;
        const float* g = gate + (size_t)j * 6144 + col0;
        f32x4 gv[2][2];
#pragma unroll
        for (int bj = 0; bj < 2; ++bj)
#pragma unroll
            for (int n = 0; n < 2; ++n) gv[bj][n] = *(const f32x4*)(g + bj * HALF + 4 * n);
#pragma unroll
        for (int ai = 0; ai < 2; ++ai) { u32x4 xv[4][2];
#pragma unroll
            for (int m = 0; m < 4; ++m)
#pragma unroll
                for (int bj = 0; bj < 2; ++bj) xv[m][bj] = *(const __attribute__((address_space(1))) u32x4*)(X + (size_t)(row0 + ai * HALF + m * 16) * 1024 + col0 + bj * HALF);
#pragma unroll
            for (int m = 0; m < 4; ++m) { bf16_t* rowp = O + (size_t)(row0 + ai * HALF + m * 16) * 1024 + col0;
#pragma unroll
                for (int bj = 0; bj < 2; ++bj) { const u32x4 x = xv[m][bj];
                    const f32x4 x0 = {__uint_as_float(x.x << 16), __uint_as_float(x.x & 0xFFFF0000u), __uint_as_float(x.y << 16), __uint_as_float(x.y & 0xFFFF0000u)};
                    const f32x4 x1 = {__uint_as_float(x.z << 16), __uint_as_float(x.z & 0xFFFF0000u), __uint_as_float(x.w << 16), __uint_as_float(x.w & 0xFFFF0000u)};
                    const f32x4 v0 = acc[ai][bj][m][0] * gv[bj][0] + x0, v1 = acc[ai][bj][m][1] * gv[bj][1] + x1;
                    u32x4 w; w.x = cvt_pk_bf16(v0[0], v0[1]); w.y = cvt_pk_bf16(v0[2], v0[3]); w.z = cvt_pk_bf16(v1[0], v1[1]); w.w = cvt_pk_bf16(v1[2], v1[3]);
                    *(u32x4*)(rowp + bj * HALF) = w; } } }
    }
};
struct EpiLogits {
    static constexpr bool PERM = false, AFTER_DRAIN = false, HAS_INIT = false;
    float* LOG;
    __device__ __forceinline__ void operator()(const f32x4 (&acc)[2][2][4][2], const Unit& u, int wr, int wc, int fr, int fq) const {
        if (wc != 0) return;
        const int row0 = u.pm * BM + wr * 64 + fr;
#pragma unroll
        for (int ai = 0; ai < 2; ++ai)
#pragma unroll
            for (int m = 0; m < 4; ++m) { float* rowp = LOG + (size_t)(row0 + ai * HALF + m * 16) * 32 + 4 * fq;
#pragma unroll
                for (int n = 0; n < 2; ++n) *(f32x4*)(rowp + n * 16) = acc[ai][0][m][n]; }
    }
};
struct EpiSwiglu {
    static constexpr bool PERM = true, AFTER_DRAIN = false, HAS_INIT = false;
    bf16_t* ACT; const float* b1p;
    __device__ __forceinline__ void operator()(const f32x4 (&acc)[2][2][4][2], const Unit& u, int wr, int wc, int fr, int fq) const {
        const int e = u.pn >> 3, pn = u.pn & 7;
        const int row0 = u.pm * BM + wr * 64 + fr, lc = wc * 32 + 8 * fq;
        const float* bp = b1p + (size_t)e * 2048 + pn * 256 + lc;
        f32x4 bg[2], bu[2];
#pragma unroll
        for (int n = 0; n < 2; ++n) { bg[n] = *(const f32x4*)(bp + 4 * n); bu[n] = *(const f32x4*)(bp + HALF + 4 * n); }
#pragma unroll
        for (int ai = 0; ai < 2; ++ai)
#pragma unroll
            for (int m = 0; m < 4; ++m) { bf16_t* rowp = ACT + (size_t)(row0 + ai * HALF + m * 16) * 1024 + pn * 128 + lc;
                f32x4 a[2];
#pragma unroll
                for (int n = 0; n < 2; ++n) { const f32x4 gt = acc[ai][0][m][n] + bg[n], up = acc[ai][1][m][n] + bu[n];
#pragma unroll
                    for (int i = 0; i < 4; ++i) { const float gc = fminf(gt[i], 7.0f), uc = fminf(fmaxf(up[i], -7.0f), 7.0f);
                        const float sg = __builtin_amdgcn_rcpf(1.0f + __builtin_amdgcn_exp2f(gc * (-1.702f * 1.4426950408889634f)));
                        a[n][i] = (uc + 1.0f) * (gc * sg); } }
                u32x4 w; w.x = cvt_pk_bf16(a[0][0], a[0][1]); w.y = cvt_pk_bf16(a[0][2], a[0][3]); w.z = cvt_pk_bf16(a[1][0], a[1][1]); w.w = cvt_pk_bf16(a[1][2], a[1][3]);
                *(u32x4*)rowp = w; }
    }
};
struct EpiSwiglu8 {
    static constexpr bool PERM = true, AFTER_DRAIN = false, HAS_INIT = true;
    unsigned char* ACT; const float* b1p;
    __device__ __forceinline__ const float* bias_row(const Unit& u) const { const int e = u.pn >> 3, pn = u.pn & 7; return b1p + (size_t)e * 2048 + pn * 256; }
    __device__ __forceinline__ void init_lds(f32x4 (&acc)[2][2][4][2], const PG8_LAS unsigned char* bl, int wc, int fq) const {
#pragma unroll
        for (int bj = 0; bj < 2; ++bj)
#pragma unroll
            for (int n = 0; n < 2; ++n) { const f32x4 bv = *(const PG8_LAS f32x4*)(bl + (bj * HALF + wc * 32 + 8 * fq + 4 * n) * 4);
#pragma unroll
                for (int ai = 0; ai < 2; ++ai)
#pragma unroll
                    for (int m = 0; m < 4; ++m) acc[ai][bj][m][n] = bv; }
    }
    __device__ __forceinline__ void operator()(const f32x4 (&acc)[2][2][4][2], const Unit& u, int wr, int wc, int fr, int fq) const {
        const int pn = u.pn & 7;
        const int row0 = u.pm * BM + wr * 64 + fr, lc = wc * 32 + 8 * fq;
#pragma unroll
        for (int ai = 0; ai < 2; ++ai)
#pragma unroll
            for (int m = 0; m < 4; ++m) { unsigned char* rowp = ACT + (size_t)(row0 + ai * HALF + m * 16) * 1024 + pn * 128 + lc;
                f32x4 a[2];
#pragma unroll
                for (int n = 0; n < 2; ++n) { const f32x4 gt = acc[ai][0][m][n], up = acc[ai][1][m][n];
#pragma unroll
                    for (int i = 0; i < 4; ++i) { const float gc = fminf(gt[i], 7.0f), uc = __builtin_amdgcn_fmed3f(up[i], -7.0f, 7.0f);
                        const float g2 = gc * __builtin_amdgcn_rcpf(1.0f + __builtin_amdgcn_exp2f(gc * (-1.702f * 1.4426950408889634f)));
                        a[n][i] = __builtin_fmaf(uc, g2, g2); } }
                int p0 = __builtin_amdgcn_cvt_pk_fp8_f32(a[0][0], a[0][1], 0, false); p0 = __builtin_amdgcn_cvt_pk_fp8_f32(a[0][2], a[0][3], p0, true);
                int p1 = __builtin_amdgcn_cvt_pk_fp8_f32(a[1][0], a[1][1], 0, false); p1 = __builtin_amdgcn_cvt_pk_fp8_f32(a[1][2], a[1][3], p1, true);
                *(u32x2*)rowp = (u32x2){(unsigned)p0, (unsigned)p1}; }
    }
};
struct EpiDown {
    static constexpr bool PERM = true, AFTER_DRAIN = false, HAS_INIT = true;
    unsigned char* YP; const float* b2;
    __device__ __forceinline__ const float* bias_row(const Unit& u) const { const int e = u.pn >> 2, pn = u.pn & 3; return b2 + (size_t)e * 1024 + pn * BM; }
    __device__ __forceinline__ void init_lds(f32x4 (&acc)[2][2][4][2], const PG8_LAS unsigned char* bl, int wc, int fq) const {
#pragma unroll
        for (int bj = 0; bj < 2; ++bj)
#pragma unroll
            for (int n = 0; n < 2; ++n) { const f32x4 bv = *(const PG8_LAS f32x4*)(bl + (bj * HALF + wc * 32 + 8 * fq + 4 * n) * 4) * 8.0f;
#pragma unroll
                for (int ai = 0; ai < 2; ++ai)
#pragma unroll
                    for (int m = 0; m < 4; ++m) acc[ai][bj][m][n] = bv; }
    }
    __device__ __forceinline__ void operator()(const f32x4 (&acc)[2][2][4][2], const Unit& u, int wr, int wc, int fr, int fq) const {
        const int pn = u.pn & 3;
        const int row0 = u.pm * BM + wr * 64 + fr, col0 = pn * BM + wc * 32 + 8 * fq;
#pragma unroll
        for (int ai = 0; ai < 2; ++ai)
#pragma unroll
            for (int m = 0; m < 4; ++m) { unsigned char* rowp = YP + (size_t)(row0 + ai * HALF + m * 16) * 1024 + col0;
#pragma unroll
                for (int bj = 0; bj < 2; ++bj) { const f32x4 v0 = acc[ai][bj][m][0], v1 = acc[ai][bj][m][1];
                    int p0 = __builtin_amdgcn_cvt_pk_fp8_f32(v0[0], v0[1], 0, false); p0 = __builtin_amdgcn_cvt_pk_fp8_f32(v0[2], v0[3], p0, true);
                    int p1 = __builtin_amdgcn_cvt_pk_fp8_f32(v1[0], v1[1], 0, false); p1 = __builtin_amdgcn_cvt_pk_fp8_f32(v1[2], v1[3], p1, true);
                    *(u32x2*)(rowp + bj * HALF) = (u32x2){(unsigned)p0, (unsigned)p1}; } }
    }
};

template <class Epi, class Sched, bool ALIGN_EPI = false, bool SP2 = false, bool F8 = false, int F8_SW = 0x7A7A7A7A, bool GATHER = false>
__device__ __forceinline__ void gemm_phase(PG8_LAS unsigned char* lds, const Gemm g, const Sched& S, const Epi& E) {
    int tid_ = threadIdx.x; asm volatile("" : "+v"(tid_));
    const int tid = tid_, wid = __builtin_amdgcn_readfirstlane(tid >> 6), lane = tid & 63, wr = wid >> 2, wc = wid & 3, fr = lane & 15, fq = lane >> 4;
    int K_ = g.K; asm volatile("" : "+s"(K_));
    const int K = K_, nt = K / BK;
    unsigned voffA[2], voffB[2];
#pragma unroll
    for (int i = 0; i < 2; ++i) { int R, C; stage_rc(tid * 16 + i * 8192, R, C); const int Rb = Epi::PERM ? ((R & ~31) + perm32(R & 31)) : R;
        voffA[i] = (unsigned)(R * K + C) * 2u; voffB[i] = (unsigned)(Rb * K + C) * 2u; }
    const size_t kstep = (size_t)(BK * 2);
    const size_t hstep = (size_t)HALF * K * 2;
    const size_t tstep = 2 * hstep;
    const size_t hstepA = GATHER ? 0 : hstep;
    unsigned voffC[2][2];
#define PG8_VA(h, nx) (GATHER ? voffC[h] : voffA)
#define PG8_GOFF(dst, slot, unit) do { const int nv_ = S.nvalid(unit); _Pragma("unroll") for (int i_ = 0; i_ < 2; ++i_) { int R_, C_; stage_rc(tid * 16 + i_ * 8192, R_, C_); _Pragma("unroll") for (int h_ = 0; h_ < 2; ++h_) { const int ri_ = h_ * HALF + R_; \
        int ix_ = *(const PG8_LAS int*)(lds + PG8_IDX_OFF + (slot) * 1024 + ri_ * 4); ix_ = ri_ < nv_ ? ix_ : 0; dst[h_][i_] = (unsigned)ix_ * (unsigned)(K * 2) + (unsigned)C_ * 2u; } } } while (0)
    const unsigned ldsw = (unsigned)wid * 1024u;
    const int aoff = lds_byte(wr * 64 + fr, fq * 8), boff = lds_byte(wc * 32 + fr, fq * 8);
#define PG8_SA(b, h) (((b) * 2 + (h)) * HTB)
#define PG8_SB(b, h) ((4 + (b) * 2 + (h)) * HTB)
#define PG8_STAGE(bufoff, gbase, voff) do { _Pragma("unroll") for (int _i = 0; _i < 2; ++_i) \
        __builtin_amdgcn_global_load_lds((const unsigned*)((const char*)(gbase) + (voff)[_i]), (PG8_LAS unsigned*)(lds + (bufoff) + ldsw + _i * 8192), 16, 0, 0); } while (0)
#define PG8_CAT(x0, x1) __builtin_shufflevector(__builtin_bit_cast(i32x4, x0), __builtin_bit_cast(i32x4, x1), 0, 1, 2, 3, 4, 5, 6, 7)
#define PG8_LDF(base, off) (*(const PG8_LAS bf16x8*)(lds + (base) + (off)))
#define PG8_LDA(dst, dst8, b, h) do { _Pragma("unroll") for (int m = 0; m < 4; ++m) { if constexpr (F8) dst8[m] = PG8_CAT(PG8_LDF(PG8_SA(b, h), aoff + m * 2048), PG8_LDF(PG8_SA(b, h), aoff + m * 2048 + 1024)); \
        else { _Pragma("unroll") for (int k = 0; k < 2; ++k) dst[m][k] = PG8_LDF(PG8_SA(b, h), aoff + m * 2048 + k * 1024); } } } while (0)
#define PG8_LDB(dst, dst8, b, h) do { _Pragma("unroll") for (int n = 0; n < 2; ++n) { if constexpr (F8) dst8[n] = PG8_CAT(PG8_LDF(PG8_SB(b, h), boff + n * 2048), PG8_LDF(PG8_SB(b, h), boff + n * 2048 + 1024)); \
        else { _Pragma("unroll") for (int k = 0; k < 2; ++k) dst[n][k] = PG8_LDF(PG8_SB(b, h), boff + n * 2048 + k * 1024); } } } while (0)
#define PG8_MMA(ai, bj, At, At8, Bt, Bt8) do { __builtin_amdgcn_s_setprio(1); _Pragma("unroll") for (int m = 0; m < 4; ++m) _Pragma("unroll") for (int n = 0; n < 2; ++n) { \
        if constexpr (F8) asm volatile("v_mfma_scale_f32_16x16x128_f8f6f4 %0, %1, %2, %0, %3, %3 op_sel:[0,1,0] op_sel_hi:[0,0,0]" : "+v"(acc[ai][bj][m][n]) : "v"(Bt8[n]), "v"(At8[m]), "v"(f8_s));   \
        else { _Pragma("unroll") for (int k = 0; k < 2; ++k) acc[ai][bj][m][n] = __builtin_amdgcn_mfma_f32_16x16x32_bf16(Bt[n][k], At[m][k], acc[ai][bj][m][n], 0, 0, 0); } } __builtin_amdgcn_s_setprio(0); } while (0)
#define PG8_WAIT_V(n) asm volatile("s_waitcnt vmcnt(" #n ")" ::: "memory")
#define PG8_WAIT_L(n) asm volatile("s_waitcnt lgkmcnt(" #n ")" ::: "memory")
#define PG8_BAR __builtin_amdgcn_s_barrier()
#define PG8_SCHED __builtin_amdgcn_sched_barrier(0)
    Unit cur, nxt; int ui = 0;
    if (!S.next(0, cur)) return;
    f32x4 acc[2][2][4][2];
    if constexpr (Epi::HAS_INIT) { if (wid == 0) __builtin_amdgcn_global_load_lds((const unsigned*)(E.bias_row(cur) + lane * 4), (PG8_LAS unsigned*)(lds + PG8_BIAS_OFF), 16, 0, 0); }
    else {
#pragma unroll
    for (int a = 0; a < 2; ++a)
#pragma unroll
        for (int b = 0; b < 2; ++b)
#pragma unroll
            for (int m = 0; m < 4; ++m)
#pragma unroll
                for (int n = 0; n < 2; ++n) acc[a][b][m][n] = (f32x4){0.f, 0.f, 0.f, 0.f};
    }
    int f8_s = 0x7F00 | (F8_SW & 0xFF); asm volatile("" : "+v"(f8_s));
    bf16x8 At[4][2], B0[2][2], B1[2][2]; i32x8 At8[4], B08[2], B18[2];
    const char* cA = (const char*)g.A + (GATHER ? (size_t)0 : (size_t)cur.pm * tstep); const char* cB = (const char*)g.Bt + (size_t)cur.pn * tstep;
    if constexpr (GATHER) { if (wid == 0) __builtin_amdgcn_global_load_lds((const unsigned*)(S.idx_src(cur) + lane * 4), (PG8_LAS unsigned*)(lds + PG8_IDX_OFF), 16, 0, 0);
        PG8_WAIT_V(0); PG8_BAR; PG8_GOFF(voffC, 0, cur); }
    S.a_ready(cur);
    if constexpr (SP2) {
        PG8_STAGE(PG8_SB(0, 0), cB, voffB); PG8_STAGE(PG8_SB(0, 1), cB + hstep, voffB); PG8_STAGE(PG8_SA(0, 0), cA, PG8_VA(0, false)); PG8_STAGE(PG8_SA(0, 1), cA + hstepA, PG8_VA(1, false));
        if (wr == 1) PG8_BAR;
        PG8_WAIT_V(2); PG8_BAR;
        PG8_STAGE(PG8_SB(1, 0), cB + kstep, voffB); PG8_STAGE(PG8_SA(1, 0), cA + kstep, PG8_VA(0, false)); PG8_STAGE(PG8_SB(1, 1), cB + hstep + kstep, voffB);
        PG8_WAIT_V(6); PG8_BAR;
    } else {
        PG8_STAGE(PG8_SB(0, 0), cB, voffB); PG8_STAGE(PG8_SA(0, 0), cA, PG8_VA(0, false)); PG8_STAGE(PG8_SB(0, 1), cB + hstep, voffB); PG8_STAGE(PG8_SA(0, 1), cA + hstepA, PG8_VA(1, false));
        if (wr == 1) PG8_BAR;
        PG8_WAIT_V(4); PG8_BAR;
        PG8_STAGE(PG8_SB(1, 0), cB + kstep, voffB); PG8_STAGE(PG8_SA(1, 0), cA + kstep, PG8_VA(0, false)); PG8_STAGE(PG8_SB(1, 1), cB + hstep + kstep, voffB);
        PG8_WAIT_V(6); PG8_BAR;
    }
    if constexpr (Epi::HAS_INIT) E.init_lds(acc, lds + PG8_BIAS_OFF, wc, fq);
    for (;;) {
        const bool has_next = S.next(ui + 1, nxt);
        if constexpr (Epi::HAS_INIT) { if (has_next && wid == 0) __builtin_amdgcn_global_load_lds((const unsigned*)(E.bias_row(nxt) + lane * 4), (PG8_LAS unsigned*)(lds + PG8_BIAS_OFF + ((ui + 1) & 1) * 1024), 16, 0, 0); }
        if constexpr (GATHER) { if (has_next && wid == 0) __builtin_amdgcn_global_load_lds((const unsigned*)(S.idx_src(nxt) + lane * 4), (PG8_LAS unsigned*)(lds + PG8_IDX_OFF + ((ui + 1) & 1) * 1024), 16, 0, 0); }
        const char* nA = has_next ? (const char*)g.A + (GATHER ? (size_t)0 : (size_t)nxt.pm * tstep) : cA; const char* nB = has_next ? (const char*)g.Bt + (size_t)nxt.pn * tstep : cB;
        for (int t = 0; t < nt; t += 2) {
            const bool last = (t == nt - 2);
            const char* a1 = cA + (size_t)(t + 1) * kstep;
            const char* a2 = last ? nA : cA + (size_t)(t + 2) * kstep; const char* b2 = last ? nB : cB + (size_t)(t + 2) * kstep;
            const char* a3 = a2 + kstep; const char* b3 = b2 + kstep;
            if (last && has_next) S.a_ready(nxt);
            if constexpr (SP2) {
            PG8_LDB(B0, B08, 0, 0); PG8_LDB(B1, B18, 0, 1); PG8_SCHED; PG8_LDA(At, At8, 0, 0); PG8_STAGE(PG8_SA(1, 1), a1 + hstepA, PG8_VA(1, false));
            if constexpr (GATHER) { if (last && has_next) PG8_GOFF(voffC, (ui + 1) & 1, nxt); }
            PG8_WAIT_V(8); PG8_WAIT_L(0); PG8_BAR; PG8_MMA(0, 0, At, At8, B0, B08); PG8_MMA(0, 1, At, At8, B1, B18); PG8_BAR; PG8_SCHED;
            PG8_LDA(At, At8, 0, 1); PG8_STAGE(PG8_SB(0, 0), b2, voffB); PG8_STAGE(PG8_SB(0, 1), b2 + hstep, voffB); PG8_STAGE(PG8_SA(0, 0), a2, PG8_VA(0, last));
            PG8_WAIT_V(8); PG8_WAIT_L(0); PG8_BAR; PG8_MMA(1, 0, At, At8, B0, B08); PG8_MMA(1, 1, At, At8, B1, B18); PG8_BAR; PG8_SCHED;
            PG8_LDB(B0, B08, 1, 0); PG8_LDB(B1, B18, 1, 1); PG8_SCHED; PG8_LDA(At, At8, 1, 0); PG8_STAGE(PG8_SA(0, 1), a2 + hstepA, PG8_VA(1, last));
            PG8_WAIT_V(8); PG8_WAIT_L(0); PG8_BAR; PG8_MMA(0, 0, At, At8, B0, B08); PG8_MMA(0, 1, At, At8, B1, B18); PG8_BAR; PG8_SCHED;
            PG8_LDA(At, At8, 1, 1); PG8_STAGE(PG8_SB(1, 0), b3, voffB); PG8_STAGE(PG8_SB(1, 1), b3 + hstep, voffB); PG8_STAGE(PG8_SA(1, 0), a3, PG8_VA(0, last));
            PG8_WAIT_V(8); PG8_WAIT_L(0); PG8_BAR; PG8_MMA(1, 0, At, At8, B0, B08); PG8_MMA(1, 1, At, At8, B1, B18); PG8_BAR; PG8_SCHED;
            } else {
            PG8_LDB(B0, B08, 0, 0); PG8_SCHED; PG8_LDA(At, At8, 0, 0); PG8_STAGE(PG8_SA(1, 1), a1 + hstepA, PG8_VA(1, false));
            PG8_WAIT_L(8); PG8_BAR; PG8_WAIT_L(0); PG8_MMA(0, 0, At, At8, B0, B08); PG8_BAR; PG8_SCHED;
            PG8_LDB(B1, B18, 0, 1); PG8_STAGE(PG8_SB(0, 0), b2, voffB);
            PG8_BAR; PG8_WAIT_L(0); PG8_MMA(0, 1, At, At8, B1, B18); PG8_BAR;
            PG8_LDA(At, At8, 0, 1); PG8_STAGE(PG8_SA(0, 0), a2, PG8_VA(0, last));
            PG8_BAR; PG8_WAIT_L(0); PG8_MMA(1, 0, At, At8, B0, B08); PG8_BAR; PG8_SCHED;
            PG8_STAGE(PG8_SB(0, 1), b2 + hstep, voffB);
            PG8_WAIT_V(6); PG8_BAR; PG8_MMA(1, 1, At, At8, B1, B18); PG8_BAR;
            PG8_LDB(B0, B08, 1, 0); PG8_SCHED; PG8_LDA(At, At8, 1, 0); PG8_STAGE(PG8_SA(0, 1), a2 + hstepA, PG8_VA(1, last));
            PG8_WAIT_L(8); PG8_BAR; PG8_WAIT_L(0); PG8_MMA(0, 0, At, At8, B0, B08); PG8_BAR; PG8_SCHED;
            PG8_LDB(B1, B18, 1, 1); PG8_STAGE(PG8_SB(1, 0), b3, voffB);
            PG8_BAR; PG8_WAIT_L(0); PG8_MMA(0, 1, At, At8, B1, B18); PG8_BAR;
            PG8_LDA(At, At8, 1, 1); PG8_STAGE(PG8_SA(1, 0), a3, PG8_VA(0, last));
            PG8_BAR; PG8_WAIT_L(0); PG8_MMA(1, 0, At, At8, B0, B08); PG8_BAR; PG8_SCHED;
            PG8_STAGE(PG8_SB(1, 1), b3 + hstep, voffB);
            PG8_WAIT_V(6); PG8_BAR; PG8_MMA(1, 1, At, At8, B1, B18); PG8_BAR;
            }
        }
        if constexpr (ALIGN_EPI) { if (wr == 0) PG8_BAR; }
        if constexpr (F8) asm volatile("s_nop 15\n\ts_nop 15" ::: "memory");
        if constexpr (!Epi::AFTER_DRAIN) { E(acc, cur, wr, wc, fr, fq); S.done(cur); }
        if (!has_next) break;
        if constexpr (Epi::HAS_INIT) E.init_lds(acc, lds + PG8_BIAS_OFF + ((ui + 1) & 1) * 1024, wc, fq); else {
#pragma unroll
        for (int a = 0; a < 2; ++a)
#pragma unroll
            for (int b = 0; b < 2; ++b)
#pragma unroll
                for (int m = 0; m < 4; ++m)
#pragma unroll
                    for (int n = 0; n < 2; ++n) acc[a][b][m][n] = (f32x4){0.f, 0.f, 0.f, 0.f};
        }
        cur = nxt; cA = nA; cB = nB; ++ui;

        if constexpr (ALIGN_EPI) { if (wr == 1) PG8_BAR; }
    }
    PG8_WAIT_V(0);
    if constexpr (!ALIGN_EPI) { if (wr == 0) PG8_BAR; }
    PG8_BAR;
    if constexpr (Epi::AFTER_DRAIN) { E.fused(acc, cur, wr, wc, fr, fq, lds, wid, lane); S.done(cur); }
#undef PG8_SA
#undef PG8_SB
#undef PG8_STAGE
#undef PG8_VA
#undef PG8_GOFF
#undef PG8_LDA
#undef PG8_LDF
#undef PG8_LDB
#undef PG8_MMA
#undef PG8_CAT
#undef PG8_WAIT_V
#undef PG8_WAIT_L
#undef PG8_BAR
#undef PG8_SCHED
}
}
#ifndef ATTN_STORE16
#define ATTN_STORE16(p,v) (*(u32x4*)(p)=(v))
#endif
namespace attn_body {
using bf16=__hip_bfloat16;
using bf16x8=__attribute__((ext_vector_type(8)))short;
using s16x4=__attribute__((ext_vector_type(4)))short;
using f32x16=__attribute__((ext_vector_type(16)))float;
using u32x4=__attribute__((ext_vector_type(4)))unsigned;
constexpr int D=64,PQ=2048,PO=1024,KOFF=512,VOFF=640;
constexpr int NW=8,QBLK=32,QB=QBLK*NW,KVBLK=64;
__device__ __forceinline__ int crow(int r,int hi){return (r&3)+8*(r>>2)+4*hi;}
#define SBAR() __builtin_amdgcn_sched_barrier(0)
constexpr int NSLOT=3, SLOTB=8192;
constexpr int LDS_K=0, LDS_V=NSLOT*SLOTB, LDS_WS=2*NSLOT*SLOTB, LDS_OST=LDS_WS+NW*64*4, LDS_BYTES=LDS_OST+NW*4096;
constexpr float C2=0.125f*1.4426950408889634f;
__device__ __forceinline__ void glds16(const void*gsrc,unsigned lds_dst){unsigned keep;
  asm volatile("s_mov_b32 %0, m0\n\ts_mov_b32 m0, %2\n\ts_nop 0\n\tglobal_load_lds_dwordx4 %1, off\n\ts_mov_b32 m0, %0":"=&s"(keep):"v"(gsrc),"s"(lds_dst):"memory");}
__device__ __forceinline__ float max3f(float a,float b,float c){float r;asm("v_max3_f32 %0, %1, %2, %3":"=v"(r):"v"(a),"v"(b),"v"(c));return r;}
__device__ __forceinline__ float max2f(float a,float b){float r;asm("v_max_f32_e32 %0, %1, %2":"=v"(r):"v"(a),"v"(b));return r;}
__device__ __forceinline__ float fadd_s(float a,float b){float r;asm("v_add_f32_e32 %0, %1, %2":"=v"(r):"v"(a),"v"(b));return r;}
__device__ __forceinline__ float fsub_s(float a,float b){float r;asm("v_sub_f32_e32 %0, %1, %2":"=v"(r):"v"(a),"v"(b));return r;}
typedef float f32x2_t __attribute__((ext_vector_type(2))); typedef __bf16 bf16x2_t __attribute__((ext_vector_type(2)));
__device__ __forceinline__ unsigned cvtpk_s(float lo,float hi){f32x2_t v={lo,hi};bf16x2_t b=__builtin_convertvector(v,bf16x2_t);return __builtin_bit_cast(unsigned,b);}
#define WAIT_BAR(N) asm volatile("s_waitcnt vmcnt(" #N ") lgkmcnt(0)\n\ts_barrier":::"memory")

__device__ __forceinline__ void qkt(f32x16&p0,f32x16&p1,const char*Kslot,const bf16x8*qr,const f32x16&negm,int r32,int hi){
  const char*kb=Kslot+hi*1024+r32*16;
  #pragma unroll
  for(int d0=0;d0<4;++d0){
    const bf16x8 b0=*reinterpret_cast<const bf16x8*>(kb+d0*2048);
    const bf16x8 b1=*reinterpret_cast<const bf16x8*>(kb+d0*2048+512);
    if(d0==0){p0=__builtin_amdgcn_mfma_f32_32x32x16_bf16(b0,qr[0],negm,0,0,0);p1=__builtin_amdgcn_mfma_f32_32x32x16_bf16(b1,qr[0],negm,0,0,0);}
    else{p0=__builtin_amdgcn_mfma_f32_32x32x16_bf16(b0,qr[d0],p0,0,0,0);p1=__builtin_amdgcn_mfma_f32_32x32x16_bf16(b1,qr[d0],p1,0,0,0);}}
}
typedef __attribute__((address_space(3))) const char* lds_cptr;
typedef short v4i16_t __attribute__((ext_vector_type(4)));
__device__ __forceinline__ void kload8(bf16x8*kf,lds_cptr kp){
  kf[0]=*(const __attribute__((address_space(3))) bf16x8*)(kp);      kf[1]=*(const __attribute__((address_space(3))) bf16x8*)(kp+512);
  kf[2]=*(const __attribute__((address_space(3))) bf16x8*)(kp+2048); kf[3]=*(const __attribute__((address_space(3))) bf16x8*)(kp+2560);
  kf[4]=*(const __attribute__((address_space(3))) bf16x8*)(kp+4096); kf[5]=*(const __attribute__((address_space(3))) bf16x8*)(kp+4608);
  kf[6]=*(const __attribute__((address_space(3))) bf16x8*)(kp+6144); kf[7]=*(const __attribute__((address_space(3))) bf16x8*)(kp+6656);
}
__device__ __forceinline__ void kload2(bf16x8*kf,lds_cptr kp,int j){ kf[2*j]=*(const __attribute__((address_space(3))) bf16x8*)(kp+j*2048); kf[2*j+1]=*(const __attribute__((address_space(3))) bf16x8*)(kp+j*2048+512); }
__device__ __forceinline__ s16x4 vtr(lds_cptr p){ return __builtin_bit_cast(s16x4,__builtin_amdgcn_ds_read_tr16_b64_v4i16((__attribute__((address_space(3))) v4i16_t*)p)); }
__device__ __forceinline__ float rowmax(const f32x16&p0,const f32x16&p1){
  float a=max3f(p0[0],p0[1],p1[0]),b=max3f(p0[2],p0[3],p1[1]);a=max3f(a,p1[2],p1[3]);
  #pragma unroll
  for(int r=4;r<16;r+=4){a=max3f(a,p0[r],p0[r+1]);b=max3f(b,p0[r+2],p0[r+3]);a=max3f(a,p1[r],p1[r+1]);b=max3f(b,p1[r+2],p1[r+3]);}
  const float m=max2f(a,b);
  auto rr=__builtin_amdgcn_permlane32_swap(__float_as_uint(m),__float_as_uint(m),false,false);
  return max2f(__uint_as_float(rr[0]),__uint_as_float(rr[1]));
}
__device__ __forceinline__ void pv(f32x16*o,int vb,bf16x8 pa0,bf16x8 pa1,bf16x8 pa2,bf16x8 pa3){
  #pragma unroll
  for(int d0=0;d0<2;++d0){s16x4 lo[4],hi[4];
    #pragma unroll
    for(int ks=0;ks<4;++ks){
      asm volatile("ds_read_b64_tr_b16 %0,%1 offset:%c2":"=&v"(lo[ks]):"v"(vb),"i"(d0*4096+ks*1024):"memory");
      asm volatile("ds_read_b64_tr_b16 %0,%1 offset:%c2":"=&v"(hi[ks]):"v"(vb),"i"(d0*4096+ks*1024+512):"memory");}
    asm volatile("s_waitcnt lgkmcnt(0)":::"memory");SBAR();
    #define PK(k) (bf16x8){lo[k][0],lo[k][1],lo[k][2],lo[k][3],hi[k][0],hi[k][1],hi[k][2],hi[k][3]}
    o[d0]=__builtin_amdgcn_mfma_f32_32x32x16_bf16(pa0,PK(0),o[d0],0,0,0);
    o[d0]=__builtin_amdgcn_mfma_f32_32x32x16_bf16(pa1,PK(1),o[d0],0,0,0);
    o[d0]=__builtin_amdgcn_mfma_f32_32x32x16_bf16(pa2,PK(2),o[d0],0,0,0);
    o[d0]=__builtin_amdgcn_mfma_f32_32x32x16_bf16(pa3,PK(3),o[d0],0,0,0);
    #undef PK
  }
}

template<int THRL,bool FIXR=false> __device__ __forceinline__ void attn_unit(long qrow0,long krow0,int NTarg,int h,const bf16*Pq,bf16*Yo,char*shm,int koff=0){
  int tid_=threadIdx.x; asm volatile("":"+v"(tid_)); const int tid=tid_,lane=tid&63,r32=lane&31,hi=lane>>5; const int wid=__builtin_amdgcn_readfirstlane(tid>>6);
  const bf16*Qw=Pq+(qrow0+wid*QBLK)*PQ+h*D;
  const bf16*Kh=Pq+krow0*PQ+KOFF+(h>>2)*D,*Vh=Pq+krow0*PQ+VOFF+(h>>2)*D;
  const unsigned lds0=(unsigned)(uintptr_t)shm;
  float*wsf=(float*)(shm+LDS_WS)+wid*64;
  const bf16*ksrc=Kh+(long)lane*PQ+wid*8;
  const bf16*vsrc=Vh+(long)(16*(wid&3)+(lane>>2))*PQ+(wid>>2)*32+(lane&3)*8;
  const unsigned kdst=lds0+LDS_K+wid*1024, vdst=lds0+LDS_V+wid*1024;
  #define KVT(t) ({int t_=(t)+koff; t_>=NTarg?t_-NTarg:t_;})
  #define DMA_K(t,slot) glds16(ksrc+(long)KVT(t)*KVBLK*PQ,(unsigned)__builtin_amdgcn_readfirstlane(kdst+(slot)))
  #define DMA_V(t,slot) glds16(vsrc+(long)KVT(t)*KVBLK*PQ,(unsigned)__builtin_amdgcn_readfirstlane(vdst+(slot)))
  const int vb0=(int)(lds0+LDS_V)+((lane>>4)&1)*32+(lane&3)*8+(4*hi+((lane&15)>>2))*64;
  const char*Kbase=shm+LDS_K; bf16x8 kf[8];
  const lds_cptr shm3=(lds_cptr)shm; const lds_cptr kp0=shm3+LDS_K+hi*1024+r32*16; const lds_cptr vp0=shm3+LDS_V+((lane>>4)&1)*32+(lane&3)*8+(4*hi+((lane&15)>>2))*64;
  const int NT=NTarg;
  DMA_K(0,0);DMA_V(0,0);DMA_K(1,SLOTB);
  bf16x8 qr[4];
  #pragma unroll
  for(int d0=0;d0<4;++d0)qr[d0]=*reinterpret_cast<const bf16x8*>(&Qw[(long)r32*PQ+d0*16+hi*8]);
  float mhat=0.f,l_reg=0.f;f32x16 o[2];o[0]=f32x16{};o[1]=f32x16{};f32x16 negm=f32x16{}; if constexpr(!FIXR)asm volatile("":"+v"(negm));

  #define CMASK(P0,P1,t) do{}while(0)
  bool resc=false;
  #define START(P0,P1) do{ resc=false; \
    if constexpr(!FIXR){ const float rm=rowmax(P0,P1); const float dl=rm; mhat=fadd_s(mhat,dl); \
      _Pragma("unroll") for(int r=0;r<16;++r){P0[r]=fsub_s(P0[r],dl);P1[r]=fsub_s(P1[r],dl);} \
      _Pragma("unroll") for(int r=0;r<16;++r)negm[r]=-mhat; asm volatile("":"+v"(negm)); } \
    _Pragma("unroll") for(int r=0;r<16;++r)P0[r]=__builtin_amdgcn_exp2f(P0[r]); }while(0)
  #define RESC() do{ if(resc){ asm volatile("s_waitcnt lgkmcnt(0)":::"memory"); \
      _Pragma("unroll") for(int d_=0;d_<2;++d_) _Pragma("unroll") for(int r=0;r<16;++r)o[d_][r]*=wsf[crow(r,hi)]; } }while(0)
  f32x16 pA0,pA1,pB0,pB1;
  int sl_prev=0,sl_cur=0,sl_next=SLOTB;
  #define ROT() do{sl_prev=sl_cur;sl_cur=sl_next;sl_next=(sl_next==(NSLOT-1)*SLOTB)?0:sl_next+SLOTB;}while(0)
  DMA_K(2,2*SLOTB);
  WAIT_BAR(3);
  qkt(pA0,pA1,Kbase,qr,negm,r32,hi);asm volatile("s_nop 15\n\ts_nop 7":"+v"(pA0),"+v"(pA1));CMASK(pA0,pA1,0);
  START(pA0,pA1);
  _Pragma("unroll") for(int r=0;r<16;++r)pA1[r]=__builtin_amdgcn_exp2f(pA1[r]);
  WAIT_BAR(0);
  DMA_K(3,0);DMA_V(1,SLOTB);
  ROT();
  kload8(kf,kp0+sl_cur);
  WAIT_BAR(2);
  s16x4 vlo[8],vhi[8]; u32x4 pw0,pw1,pw2,pw3;
  #define PKW(P,B) cvtpk_s(P[B],P[B+1])
  #define PAF(k) __builtin_bit_cast(bf16x8,pw##k)
  #define VFR(i) (bf16x8){vlo[i][0],vlo[i][1],vlo[i][2],vlo[i][3],vhi[i][0],vhi[i][1],vhi[i][2],vhi[i][3]}
  #define PIN(x) asm volatile("":"+v"(x))
  #define MX3(a,b,c) __builtin_fmaxf(__builtin_fmaxf((a),(b)),(c))
  #define GAPA(MF,A0,A1,A2,A3,W0,W1,PW) do{ MF; sacc+=A0; sacc+=A1; sacc+=A2; sacc+=A3; PIN(sacc); W0; W1; PIN(PW); SBAR(); }while(0)
  #define EX(v) __builtin_amdgcn_exp2f(v)
  #define GAPB(MF,X,B) do{ MF; X[B]=EX(X[B]); X[B+1]=EX(X[B+1]); X[B+2]=EX(X[B+2]); X[B+3]=EX(X[B+3]); PIN(X); SBAR(); }while(0)
  #define VRD(i) do{ vlo[i]=vtr(vp_+(((i)>>2)*4096+((i)&3)*1024)); vhi[i]=vtr(vp_+(((i)>>2)*4096+((i)&3)*1024+512)); }while(0)
  #define KRD(G,j) do{ if(G){ kload2(kf,kp0+sl_next,j); SBAR(); } }while(0)
  #define STEP(C0,C1,P0,P1,t,GK,GV,GL) do{ SBAR(); \
    const lds_cptr vp_=vp0+sl_prev; \
    VRD(0); SBAR(); float sacc=(P0[0]+P0[1]); \
    GAPA(C0=__builtin_amdgcn_mfma_f32_32x32x16_bf16(kf[0],qr[0],negm,0,0,0), P0[2],P0[3],P0[4],P0[5],     pw0[0]=PKW(P0,0), pw0[1]=PKW(P0,2), pw0); \
    VRD(4); SBAR(); GAPA(C1=__builtin_amdgcn_mfma_f32_32x32x16_bf16(kf[1],qr[0],negm,0,0,0), P0[6],P0[7],P0[8],P0[9],     pw0[2]=PKW(P0,4), pw0[3]=PKW(P0,6), pw0); \
    VRD(1); SBAR(); GAPA(C0=__builtin_amdgcn_mfma_f32_32x32x16_bf16(kf[2],qr[1],C0,0,0,0),   P0[10],P0[11],P0[12],P0[13], pw1[0]=PKW(P0,8), pw1[1]=PKW(P0,10), pw1); \
    VRD(5); SBAR(); GAPA(C1=__builtin_amdgcn_mfma_f32_32x32x16_bf16(kf[3],qr[1],C1,0,0,0),   P0[14],P0[15],P1[0],P1[1],   pw1[2]=PKW(P0,12),pw1[3]=PKW(P0,14), pw1); \
    VRD(2); SBAR(); GAPA(C0=__builtin_amdgcn_mfma_f32_32x32x16_bf16(kf[4],qr[2],C0,0,0,0),   P1[2],P1[3],P1[4],P1[5],     pw2[0]=PKW(P1,0), pw2[1]=PKW(P1,2), pw2); \
    VRD(6); SBAR(); GAPA(C1=__builtin_amdgcn_mfma_f32_32x32x16_bf16(kf[5],qr[2],C1,0,0,0),   P1[6],P1[7],P1[8],P1[9],     pw2[2]=PKW(P1,4), pw2[3]=PKW(P1,6), pw2); \
    VRD(3); SBAR(); GAPA(C0=__builtin_amdgcn_mfma_f32_32x32x16_bf16(kf[6],qr[3],C0,0,0,0),   P1[10],P1[11],P1[12],P1[13], pw3[0]=PKW(P1,8), pw3[1]=PKW(P1,10), pw3); \
    VRD(7); SBAR(); GAPA(C1=__builtin_amdgcn_mfma_f32_32x32x16_bf16(kf[7],qr[3],C1,0,0,0),   P1[14],P1[15],0.f,0.f,       pw3[2]=PKW(P1,12),pw3[3]=PKW(P1,14), pw3); \
    l_reg+=sacc; \
    if(GK){DMA_K((t)+3,sl_cur);} if(GV){DMA_V((t)+1,sl_next);} \
    CMASK(C0,C1,t); \
    resc=false; \
    if constexpr(!FIXR){ float a=MX3(C0[0],C0[1],C1[0]),b=MX3(C0[2],C0[3],C1[1]); a=MX3(a,C1[2],C1[3]); \
      _Pragma("unroll") for(int r=4;r<16;r+=4){a=MX3(a,C0[r],C0[r+1]);b=MX3(b,C0[r+2],C0[r+3]);a=MX3(a,C1[r],C1[r+1]);b=MX3(b,C1[r+2],C1[r+3]);} \
      float rm=__builtin_fmaxf(a,b); { auto rr=__builtin_amdgcn_permlane32_swap(__float_as_uint(rm),__float_as_uint(rm),false,false); rm=__builtin_fmaxf(__uint_as_float(rr[0]),__uint_as_float(rr[1])); } \
      if(__builtin_expect(__any(rm>(float)THRL),0)){ const float dl=__builtin_fmaxf(rm,0.f); mhat+=dl; \
        _Pragma("unroll") for(int r=0;r<16;++r){C0[r]-=dl;C1[r]-=dl;} \
        _Pragma("unroll") for(int r=0;r<16;++r)negm[r]=-mhat; asm volatile("":"+v"(negm)); \
        const float f=__builtin_amdgcn_exp2f(-dl); l_reg*=f; if(hi==0)wsf[r32]=f; resc=true; } } \
    SBAR(); \
    GAPB(o[0]=__builtin_amdgcn_mfma_f32_32x32x16_bf16(PAF(0),VFR(0),o[0],0,0,0), C0,0); \
    GAPB(o[1]=__builtin_amdgcn_mfma_f32_32x32x16_bf16(PAF(0),VFR(4),o[1],0,0,0), C0,4); \
    KRD(GL,0); GAPB(o[0]=__builtin_amdgcn_mfma_f32_32x32x16_bf16(PAF(1),VFR(1),o[0],0,0,0), C0,8); \
    KRD(GL,1); GAPB(o[1]=__builtin_amdgcn_mfma_f32_32x32x16_bf16(PAF(1),VFR(5),o[1],0,0,0), C0,12); \
    KRD(GL,2); GAPB(o[0]=__builtin_amdgcn_mfma_f32_32x32x16_bf16(PAF(2),VFR(2),o[0],0,0,0), C1,0); \
    KRD(GL,3); GAPB(o[1]=__builtin_amdgcn_mfma_f32_32x32x16_bf16(PAF(2),VFR(6),o[1],0,0,0), C1,4); \
    GAPB(o[0]=__builtin_amdgcn_mfma_f32_32x32x16_bf16(PAF(3),VFR(3),o[0],0,0,0), C1,8); \
    GAPB(o[1]=__builtin_amdgcn_mfma_f32_32x32x16_bf16(PAF(3),VFR(7),o[1],0,0,0), C1,12); \
    }while(0)
  int t=1;
  #undef CMASK
  #define CMASK(P0,P1,t) do{}while(0)
  for(;t+5<NT;t+=2){
    STEP(pB0,pB1,pA0,pA1,t,true,true,true);     WAIT_BAR(2); RESC(); ROT();
    STEP(pA0,pA1,pB0,pB1,t+1,true,true,true);   WAIT_BAR(2); RESC(); ROT();
  }
  #undef CMASK
  #define CMASK(P0,P1,t) do{}while(0)
  #define ENDW(tt) do{ if((tt)+3<NT){WAIT_BAR(2);} else if((tt)+2<NT){WAIT_BAR(1);} else {WAIT_BAR(0);} }while(0)
  for(;t+1<NT;t+=2){
    STEP(pB0,pB1,pA0,pA1,t,(t+3<NT),(t+1<NT),(t+1<NT));       ENDW(t);   RESC(); ROT();
    STEP(pA0,pA1,pB0,pB1,t+1,(t+4<NT),(t+2<NT),(t+2<NT));     ENDW(t+1); RESC(); ROT();
  }
  STEP(pB0,pB1,pA0,pA1,NT-1,false,false,false); RESC();
  { float sacc=pB0[0]+pB0[1]; _Pragma("unroll") for(int r=2;r<16;++r)sacc+=pB0[r]; _Pragma("unroll") for(int r=0;r<16;++r)sacc+=pB1[r]; l_reg+=sacc;
    pw0=(u32x4){PKW(pB0,0),PKW(pB0,2),PKW(pB0,4),PKW(pB0,6)};pw1=(u32x4){PKW(pB0,8),PKW(pB0,10),PKW(pB0,12),PKW(pB0,14)};pw2=(u32x4){PKW(pB1,0),PKW(pB1,2),PKW(pB1,4),PKW(pB1,6)};pw3=(u32x4){PKW(pB1,8),PKW(pB1,10),PKW(pB1,12),PKW(pB1,14)};
    SBAR(); pv(o,vb0+sl_cur,PAF(0),PAF(1),PAF(2),PAF(3)); }
  #undef PKW
  #undef PAF
  #undef VFR
  #undef PIN
  #undef MX3
  #undef GAPA
  #undef GAPB
  #undef EX
  #undef VRD
  #undef KRD
  #undef STEP
  #undef ENDW
  {auto rr=__builtin_amdgcn_permlane32_swap(__float_as_uint(l_reg),__float_as_uint(l_reg),false,false);l_reg=__uint_as_float(rr[0])+__uint_as_float(rr[1]);}
  if(hi==0)wsf[32+r32]=l_reg;asm volatile("s_waitcnt lgkmcnt(0)":::"memory");
  float rli[16];
  #pragma unroll
  for(int r=0;r<16;++r)rli[r]=__builtin_amdgcn_rcpf(wsf[32+crow(r,hi)]);
  bf16*Ow=Yo+(qrow0+wid*QBLK)*PO+h*D;
  { bf16*stg=(bf16*)(shm+LDS_OST)+wid*2048;
    #pragma unroll
    for(int r=0;r<16;++r){const int orow=crow(r,hi);
      #pragma unroll
      for(int d0=0;d0<2;++d0)stg[orow*64+d0*32+r32]=__float2bfloat16(o[d0][r]*rli[r]);}
    asm volatile("s_waitcnt lgkmcnt(0)":::"memory");
    #pragma unroll
    for(int i=0;i<4;++i){const int row=i*8+(lane>>3),ch=lane&7; const u32x4 v=*(const u32x4*)(stg+row*64+ch*8); ATTN_STORE16(Ow+(long)row*PO+ch*8,v);} }
  asm volatile("s_waitcnt lgkmcnt(0)\n\ts_barrier":::"memory");
  #undef DMA_K
  #undef KVT
  #undef DMA_V
  #undef CMASK
  #undef START
  #undef RESC
  #undef ROT
}
constexpr int ATTN_LDS_BYTES=LDS_BYTES;
#undef SBAR
#undef WAIT_BAR
}
#ifndef MK_FP8_IN
#define MK_FP8_IN 0
#endif
#ifndef MK_FP8
#define MK_FP8 1
#endif
namespace mk {
constexpr int NB = 16, SQ = 4096, CL = 256, SEG = SQ + CL, T = NB * SEG, D = 1024, INW = 2048, NL = 4, NE = 32;
constexpr int NROWT = T / 256;
constexpr int MAXRT = 1120, CAP = MAXRT * 256;
constexpr int MODW = 6 * D;
constexpr float EPS = 1e-6f;
constexpr int NWAVES = 8;
constexpr int PPL = 12, NPHASE = 2 + NL * PPL;

constexpr size_t MiB = 1u << 20;
constexpr size_t WS_CTL = 0, CTL_ZERO_BYTES = 1 * MiB;
constexpr size_t WS_MOD = 4 * MiB;
constexpr size_t WS_B1P = 6 * MiB;
constexpr size_t WS_PAIR = 8 * MiB;
constexpr size_t WS_TOK = 12 * MiB;
constexpr size_t WS_LOG = 22 * MiB;
constexpr size_t WS_WINT = 32 * MiB;
constexpr size_t WS_WOUTT = 50 * MiB;
constexpr size_t WS_WRT = 60 * MiB;
constexpr size_t WS_W1T = 64 * MiB;
constexpr size_t WS_W2T = 576 * MiB;
constexpr size_t WS_X = 832 * MiB;
constexpr size_t WS_HB = 1104 * MiB;
constexpr size_t WS_P = 1240 * MiB;
constexpr size_t WS_Y = 1512 * MiB;
constexpr size_t WS_HP = 1648 * MiB;
constexpr size_t WS_OB = (1648 + 288) * MiB;
constexpr size_t WS_ACT = 2208 * MiB;
constexpr size_t WS_YP = 2768 * MiB;
constexpr size_t WS_HB8 = 3328 * MiB;
constexpr size_t WS_END = 3400 * MiB;
static_assert(WS_MOD + (size_t)NL * 17 * MODW * 4 <= WS_B1P && WS_B1P + (size_t)NL * NE * 2048 * 4 <= WS_PAIR && WS_PAIR + (size_t)T * 32 <= WS_TOK && WS_TOK + (size_t)NE * T * 4 <= WS_LOG && WS_LOG + (size_t)T * 128 <= WS_WINT, "ws map 1");
static_assert(WS_WINT + (size_t)NL * 2048 * 1024 * 2 <= WS_WOUTT && WS_WOUTT + (size_t)NL * 1024 * 1024 * 2 <= WS_WRT && WS_WRT + (size_t)NL * 256 * 1024 * 2 <= WS_W1T && WS_W1T + (size_t)NL * NE * 2048 * 1024 * 2 <= WS_W2T && WS_W2T + (size_t)NL * NE * 1024 * 1024 * 2 <= WS_X, "ws map 2");
static_assert(WS_X + (size_t)T * 4096 <= WS_HB && WS_HB + (size_t)T * 2048 <= WS_P && WS_P + (size_t)T * 4096 <= WS_Y && WS_Y + (size_t)T * 2048 <= WS_HP && WS_HP + (size_t)CAP * 2048 <= WS_ACT && WS_ACT + (size_t)CAP * 2048 <= WS_YP && WS_YP + (size_t)CAP * 2048 <= WS_HB8 && WS_HB8 + (size_t)T * 1024 <= WS_END, "ws map 3");
constexpr int CW_BAR = 4096;
constexpr int CW_CTX = 81920;
constexpr int CW_CQ = 83968;
constexpr int CW_CNT = 65536;
constexpr int RING_BYTES = 131072;
constexpr int ROPE_OFF = RING_BYTES + 2048;
constexpr int T2E_OFF = ROPE_OFF + 8192;
constexpr int MISC_OFF = T2E_OFF + 2048;
constexpr int LDS_BYTES = 149504;
static_assert(MISC_OFF + 1024 == pg8::PG8_BIAS_OFF && pg8::PG8_IDX_OFF + 2048 <= LDS_BYTES, "LDS map");
static_assert(MK_FP8 == 1 && WS_HP + (size_t)CAP * 1024 <= WS_OB && WS_OB + (size_t)T * 2048 <= WS_ACT, "OB lives in the free half of the HP region");

#define GAS __attribute__((address_space(1)))
#define LAS __attribute__((address_space(3)))
typedef unsigned short bf16;
typedef unsigned v4u __attribute__((ext_vector_type(4)));
typedef unsigned v2u __attribute__((ext_vector_type(2)));
typedef float f32x4 __attribute__((ext_vector_type(4)));
typedef float f32x2 __attribute__((ext_vector_type(2)));
typedef GAS unsigned gu32;
#define RLX_AGENT __ATOMIC_RELAXED, __HIP_MEMORY_SCOPE_AGENT
#define LDS_WAIT() asm volatile("s_waitcnt lgkmcnt(0)" ::: "memory")
#define VM_WAIT() asm volatile("s_waitcnt vmcnt(0)" ::: "memory")
__device__ __forceinline__ unsigned f2bf(float f) { unsigned u = __builtin_bit_cast(unsigned, f); return (u + 0x7fffu + ((u >> 16) & 1u)) >> 16; }
__device__ __forceinline__ unsigned pk2(float lo, float hi) { unsigned r; asm("v_cvt_pk_bf16_f32 %0, %1, %2" : "=v"(r) : "v"(lo), "v"(hi)); return r; }
__device__ __forceinline__ float bflo(unsigned w) { return __builtin_bit_cast(float, w << 16); }
__device__ __forceinline__ float bfhi(unsigned w) { return __builtin_bit_cast(float, w & 0xffff0000u); }
__device__ __forceinline__ f32x4 bf4(v2u w) { return (f32x4){bflo(w.x), bfhi(w.x), bflo(w.y), bfhi(w.y)}; }
__device__ __forceinline__ v2u pk4(f32x4 v) { return (v2u){pk2(v.x, v.y), pk2(v.z, v.w)}; }
using pg8::shx; using pg8::wsum; using pg8::dpp_f; using pg8::sum_x16; using pg8::sum_x32; using pg8::get_x16; using pg8::get_x32;
__device__ __forceinline__ float wave_sum(float v) { return wsum(v); }
__device__ __forceinline__ float sum4(f32x4 v) { return (v.x + v.y) + (v.z + v.w); }
__device__ __forceinline__ float sigmoidf_(float z) { return __builtin_amdgcn_rcpf(1.0f + __builtin_amdgcn_exp2f(z * -1.4426950408889634f)); }
template <int I> __device__ __forceinline__ const float* ldin() { const GAS float* p;
    asm volatile("s_load_dwordx2 %0, %1, %2\n\ts_waitcnt lgkmcnt(0)" : "=s"(p) : "s"(__builtin_amdgcn_kernarg_segment_ptr()), "n"(I * 8) : "memory"); return (const float*)p; }
__device__ __forceinline__ float* ldout() { GAS float* p;
    asm volatile("s_load_dwordx2 %0, %1, %2\n\ts_waitcnt lgkmcnt(0)" : "=s"(p) : "s"(__builtin_amdgcn_kernarg_segment_ptr()), "n"(24 * 8) : "memory"); return (float*)p; }
#define XB_TMO      128
#define XB_XCNT(j)  (256  + 64 * (j))
#define XB_XSUB(j)  (1280 + 64 * (j))
#define XB_XGEN(j)  (2304 + 64 * (j))
#define XB_TOP      3328
#define XB_TOPGEN   3392
#define XCD_BAR_WORDS 3456
#define XB_SPIN_CAP (1u << 22)

__device__ __forceinline__ unsigned xb_ld(unsigned* p)              { return __hip_atomic_load(p, __ATOMIC_RELAXED, __HIP_MEMORY_SCOPE_AGENT); }
__device__ __forceinline__ unsigned xb_add(unsigned* p, unsigned v) { return __hip_atomic_fetch_add(p, v, __ATOMIC_RELAXED, __HIP_MEMORY_SCOPE_AGENT); }
__device__ __forceinline__ unsigned xb_xcc_id() { return (unsigned)__builtin_amdgcn_s_getreg((3 << 11) | 20) & 0xFu; }
#define XB_SPIN(cond, bar) do { unsigned _sp = 0; while (cond) { __builtin_amdgcn_s_sleep(1); \
    if ((++_sp & 255u) == 0u) { if (xb_ld(&(bar)[XB_TMO])) break; if (_sp > XB_SPIN_CAP) { atomicAdd(&(bar)[XB_TMO], 1u); break; } } } } while (0)

struct XcdBarrier {
    unsigned* bar; unsigned x;
    volatile LAS unsigned* st;
};

__device__ __forceinline__ XcdBarrier xcd_barrier_post(unsigned* bar, volatile LAS unsigned* st) {
    XcdBarrier b; b.bar = bar; b.x = xb_xcc_id(); b.st = st;
    if (threadIdx.x == 0) (void)xb_add(&bar[XB_XCNT(b.x)], 1u);
    return b;
}
__device__ __forceinline__ void xcd_barrier_complete(unsigned* bar, unsigned x, unsigned& nloc, unsigned& nx) {
    const unsigned G = gridDim.x * gridDim.y * gridDim.z;
    unsigned sum, cnt, mine, sp = 0u;
    for (;;) {
        sum = 0u; cnt = 0u; mine = 0u;
#pragma unroll
        for (unsigned j = 0; j < 16; ++j) { const unsigned c = xb_ld(&bar[XB_XCNT(j)]); sum += c; cnt += (c > 0u) ? 1u : 0u; mine = (j == x) ? c : mine; }
        if (sum == G) break;
        __builtin_amdgcn_s_sleep(1);
        if ((++sp & 255u) == 0u) { if (xb_ld(&bar[XB_TMO])) break; if (sp > XB_SPIN_CAP) { atomicAdd(&bar[XB_TMO], 1u); break; } }
    }
    nloc = mine > 0u ? mine : 1u; nx = cnt > 0u ? cnt : 1u;
}

__device__ __forceinline__ void xcd_barrier(const XcdBarrier& b) {
    asm volatile("s_waitcnt vmcnt(0)" ::: "memory");
    __syncthreads();
    if (threadIdx.x == 0) {
        unsigned* bar = b.bar;
        __builtin_amdgcn_s_waitcnt(0);
        unsigned nloc = b.st[0], nx = b.st[1];
        if (nloc == 0u) { xcd_barrier_complete(bar, b.x, nloc, nx); b.st[0] = nloc; b.st[1] = nx; }
        const unsigned old = xb_add(&bar[XB_XSUB(b.x)], 1u);
        const unsigned gen = old / nloc;
        if (old + 1u == (gen + 1u) * nloc) {
            __builtin_amdgcn_fence(__ATOMIC_RELEASE, "agent");
            asm volatile("s_waitcnt vmcnt(0)" ::: "memory");
            const unsigned og = xb_add(&bar[XB_TOP], 1u);
            const unsigned tg = og / nx;
            if (og + 1u == (tg + 1u) * nx) xb_add(&bar[XB_TOPGEN], 1u);
            else XB_SPIN(xb_ld(&bar[XB_TOPGEN]) == tg, bar);
            __builtin_amdgcn_fence(__ATOMIC_ACQUIRE, "agent");
            xb_add(&bar[XB_XGEN(b.x)], 1u);
            asm volatile("s_waitcnt vmcnt(0)" ::: "memory");
        } else {
            XB_SPIN(xb_ld(&bar[XB_XGEN(b.x)]) == gen, bar);
            __builtin_amdgcn_fence(__ATOMIC_ACQUIRE, "agent");
            asm volatile("s_waitcnt vmcnt(0)" ::: "memory");
        }
    }
    __syncthreads();
}

struct Ctx {
    LAS unsigned char* lds; volatile LAS unsigned* MISC; gu32* ctl;
    int tid, lane, wave, vcu, G, gw, ngw;
    GAS unsigned char* ws;
    __device__ __forceinline__ float* MOD() const { return (float*)(ws + WS_MOD); }
    __device__ __forceinline__ float* B1P() const { return (float*)(ws + WS_B1P); }
    __device__ __forceinline__ float* LOG() const { return (float*)(ws + WS_LOG); }
    __device__ __forceinline__ bf16* X() const { return (bf16*)(ws + WS_X); }
    __device__ __forceinline__ v2u* PAIR() const { return (v2u*)(ws + WS_PAIR); }
    __device__ __forceinline__ int* TOK() const { return (int*)(ws + WS_TOK); }
    __device__ __forceinline__ bf16* WINT() const { return (bf16*)(ws + WS_WINT); }
    __device__ __forceinline__ bf16* WOUTT() const { return (bf16*)(ws + WS_WOUTT); }
    __device__ __forceinline__ bf16* WRT() const { return (bf16*)(ws + WS_WRT); }
    __device__ __forceinline__ bf16* W1T() const { return (bf16*)(ws + WS_W1T); }
    __device__ __forceinline__ bf16* W2T() const { return (bf16*)(ws + WS_W2T); }
    __device__ __forceinline__ bf16* HB() const { return (bf16*)(ws + WS_HB); }
    __device__ __forceinline__ bf16* P() const { return (bf16*)(ws + WS_P); }
    __device__ __forceinline__ bf16* Y() const { return (bf16*)(ws + WS_Y); }
    __device__ __forceinline__ bf16* HP() const { return (bf16*)(ws + WS_HP); }
    __device__ __forceinline__ bf16* ACT() const { return (bf16*)(ws + WS_ACT); }
    __device__ __forceinline__ bf16* YP() const { return (bf16*)(ws + WS_YP); }
    __device__ __forceinline__ bf16* OB() const { return (bf16*)(ws + WS_OB); }
    __device__ __forceinline__ unsigned char* HB8() const { return (unsigned char*)(ws + WS_HB8); }
};
struct Args { const float* in[24]; float* out; unsigned char* ws; int ph_lo, ph_hi; };

__device__ __forceinline__ int w_in_row(int c) { const int r = c & 255; return (c & ~255) + (((r >> 5) & 1) << 7) + ((r >> 6) << 5) + (r & 31); }
__device__ __forceinline__ int w1_row(int n) { const int a = n >> 1; return ((a >> 7) << 8) + ((n & 1) << 7) + (a & 127); }
template <int MODE>
__device__ __forceinline__ void transpose_item(const float* W, int K, int N, bf16* WT, LAS float* scr, int item, int lane) {
    const int nblk = N / 32, kb = item / nblk, nb = item % nblk, k0 = 64 * kb, n0 = 32 * nb;
    { f32x4 ld[8]; const int r8 = lane >> 3, c4 = (lane & 7) * 4;
#pragma unroll
      for (int i = 0; i < 8; ++i) ld[i] = __builtin_nontemporal_load((const f32x4*)(W + (size_t)(k0 + 8 * i + r8) * N + n0 + c4));
#pragma unroll
      for (int i = 0; i < 8; ++i) { LAS float* d = scr + (8 * i + r8) * 33 + c4; d[0] = ld[i].x; d[1] = ld[i].y; d[2] = ld[i].z; d[3] = ld[i].w; } }
    LDS_WAIT(); asm volatile("" ::: "memory");
    const int c = lane & 7;
#pragma unroll
    for (int j = 0; j < 4; ++j) { const int n = (lane >> 3) + 8 * j; const LAS float* s = scr + (8 * c) * 33 + n;
        v4u o; o.x = pk2(s[0 * 33], s[1 * 33]); o.y = pk2(s[2 * 33], s[3 * 33]); o.z = pk2(s[4 * 33], s[5 * 33]); o.w = pk2(s[6 * 33], s[7 * 33]);
        const int orow = MODE == 1 ? w1_row(n0 + n) : MODE == 2 ? w_in_row(n0 + n) : (n0 + n);
        *(GAS v4u*)(WT + (size_t)orow * K + k0 + 8 * c) = o; }
    LDS_WAIT(); asm volatile("" ::: "memory");
}
template <int MODE>
__device__ __forceinline__ void transpose_item8(const float* W, int K, int N, unsigned char* WT, LAS float* scr, int item, int lane) {
    const int nblk = N / 32, kb = item / nblk, nb = item % nblk, k0 = 64 * kb, n0 = 32 * nb;
    { f32x4 ld[8]; const int r8 = lane >> 3, c4 = (lane & 7) * 4;
#pragma unroll
      for (int i = 0; i < 8; ++i) ld[i] = __builtin_nontemporal_load((const f32x4*)(W + (size_t)(k0 + 8 * i + r8) * N + n0 + c4));
#pragma unroll
      for (int i = 0; i < 8; ++i) { LAS float* d = scr + (8 * i + r8) * 33 + c4; d[0] = ld[i].x; d[1] = ld[i].y; d[2] = ld[i].z; d[3] = ld[i].w; } }
    LDS_WAIT(); asm volatile("" ::: "memory");
    const int n = lane >> 1, h = lane & 1; const LAS float* s = scr + (32 * h) * 33 + n;
    unsigned w[8];
#pragma unroll
    for (int q = 0; q < 8; ++q) { int p = __builtin_amdgcn_cvt_pk_fp8_f32(s[(4 * q) * 33] * 32.0f, s[(4 * q + 1) * 33] * 32.0f, 0, false); p = __builtin_amdgcn_cvt_pk_fp8_f32(s[(4 * q + 2) * 33] * 32.0f, s[(4 * q + 3) * 33] * 32.0f, p, true); w[q] = (unsigned)p; }
    const int orow = MODE == 1 ? w1_row(n0 + n) : MODE == 2 ? w_in_row(n0 + n) : (n0 + n);
    GAS v4u* dst = (GAS v4u*)(WT + (size_t)orow * K + k0 + 32 * h);
    dst[0] = (v4u){w[0], w[1], w[2], w[3]}; dst[1] = (v4u){w[4], w[5], w[6], w[7]};
    LDS_WAIT(); asm volatile("" ::: "memory");
}
template <int MODE>
__device__ __forceinline__ void transpose_item8w(const float* W, int K, int N, unsigned char* WT, LAS float* scr, int item, int lane) {
    const int nblk = N / 64, kb = item / nblk, nb = item % nblk, k0 = 64 * kb, n0 = 64 * nb;
    { f32x4 ld[16]; const int r4 = lane >> 4, c4 = (lane & 15) * 4;
#pragma unroll
      for (int i = 0; i < 16; ++i) ld[i] = *(const f32x4*)(W + (size_t)(k0 + 4 * i + r4) * N + n0 + c4);
#pragma unroll
      for (int i = 0; i < 16; ++i) { LAS float* d = scr + (4 * i + r4) * 65 + c4; d[0] = ld[i].x; d[1] = ld[i].y; d[2] = ld[i].z; d[3] = ld[i].w; } }
    LDS_WAIT(); asm volatile("" ::: "memory");
    const LAS float* s = scr + lane;
    const int orow = MODE == 1 ? w1_row(n0 + lane) : (n0 + lane);
    GAS v4u* dst = (GAS v4u*)(WT + (size_t)orow * K + k0);
#pragma unroll
    for (int g4 = 0; g4 < 4; ++g4) { unsigned w[4];
#pragma unroll
        for (int q = 0; q < 4; ++q) { const int kk = 16 * g4 + 4 * q; int p = __builtin_amdgcn_cvt_pk_fp8_f32(s[kk * 65] * 32.0f, s[(kk + 1) * 65] * 32.0f, 0, false); p = __builtin_amdgcn_cvt_pk_fp8_f32(s[(kk + 2) * 65] * 32.0f, s[(kk + 3) * 65] * 32.0f, p, true); w[q] = (unsigned)p; }
        dst[g4] = (v4u){w[0], w[1], w[2], w[3]}; }
    LDS_WAIT(); asm volatile("" ::: "memory");
}
struct WSrc { const float *w_in, *w_out, *w_e1, *w_e2; };
constexpr int CV_IN = 16 * 64, CV_OUT = 16 * 32, CV_E1 = 16 * 64, CV_E2 = 16 * 32, CV_PER_L = CV_IN + CV_OUT + NE * CV_E1 + NE * CV_E2;
constexpr int CV_HEAD = CV_IN + CV_OUT;
__device__ __forceinline__ void convert_item(const Ctx& C, const WSrc& W, int l, int r, LAS float* scr, int lane) {
    if (r < CV_IN) { transpose_item<2>(W.w_in + (size_t)l * 1024 * 2048, 1024, 2048, C.WINT() + (size_t)l * 2048 * 1024, scr, r, lane); return; } r -= CV_IN;
    if (r < CV_OUT) { transpose_item<0>(W.w_out + (size_t)l * 1024 * 1024, 1024, 1024, C.WOUTT() + (size_t)l * 1024 * 1024, scr, r, lane); return; } r -= CV_OUT;
    if (r < NE * CV_E1) { const int e = r / CV_E1; transpose_item8<1>(W.w_e1 + ((size_t)l * NE + e) * 1024 * 2048, 1024, 2048, (unsigned char*)C.W1T() + ((size_t)l * NE + e) * 2048 * 1024, scr, r % CV_E1, lane); return; } r -= NE * CV_E1;
    { const int e = r / CV_E2; transpose_item8<0>(W.w_e2 + ((size_t)l * NE + e) * 1024 * 1024, 1024, 1024, (unsigned char*)C.W2T() + ((size_t)l * NE + e) * 1024 * 1024, scr, r % CV_E2, lane); }
}
constexpr int CV_TAIL = 6;
__device__ __forceinline__ int tail_items(int nwg, int G) { const int rem = nwg % G; return rem ? (G - rem) * NWAVES * CV_TAIL : 0; }
__device__ __forceinline__ void tail_convert(const Ctx& C, int l, int nwg, int first) {
    const int rem = nwg % C.G, c = (int)blockIdx.x; if (rem == 0 || c < rem) return;
    WSrc W; W.w_in = ldin<8>(); W.w_out = ldin<17>(); W.w_e1 = ldin<20>(); W.w_e2 = ldin<22>();
    LAS float* scr = (LAS float*)(C.lds + C.wave * 8448);
    const int stride = (C.G - rem) * NWAVES; int it = first + (c - rem) * NWAVES + C.wave;
#pragma unroll 1
    for (int k = 0; k < CV_TAIL; ++k, it += stride) if (it < CV_PER_L) convert_item(C, W, l, it, scr, C.lane);
}
__device__ __forceinline__ void convert_bias(const Ctx& C, const float* b_e1, int l) {
    for (int i = C.gw * 64 + C.lane; i < NE * 2048; i += C.ngw * 64) { const int n = i & 2047; C.B1P()[(size_t)l * NE * 2048 + (i & ~2047) + w1_row(n)] = b_e1[(size_t)l * NE * 2048 + i]; }
}
__device__ __forceinline__ void phase_prologue(const Ctx& C, const Args& A) {
    __syncthreads();
    {
        LAS float* sS = (LAS float*)C.lds;
        const float* cin = ldin<1>(); const float* cctx = ldin<3>(); const float* wada = ldin<4>(); const float* bada = ldin<5>();
        for (int i = C.tid; i < 17 * 1024; i += NWAVES * 64) { const int j = i >> 10, k = i & 1023; const float v = j < 16 ? cin[j * 1024 + k] : cctx[k]; sS[i] = v * sigmoidf_(v); }
        __syncthreads();
        const int kl = C.tid & 15, cg = C.tid >> 4;
        for (int item = blockIdx.x; item < NL * 64; item += C.G) {
            if (cg >= 24) continue;
            const int l = item / 64, c0 = (item % 64) * 96 + 4 * cg;
            const float* W = wada + (size_t)l * 1024 * MODW + c0;
            f32x4 acc[17];
#pragma unroll
            for (int j = 0; j < 17; ++j) acc[j] = (f32x4){0.f, 0.f, 0.f, 0.f};
#pragma unroll 1
            for (int k0 = kl; k0 < 1024; k0 += 64) { f32x4 w[4];
#pragma unroll
                for (int u = 0; u < 4; ++u) w[u] = __builtin_nontemporal_load((const f32x4*)(W + (size_t)(k0 + 16 * u) * MODW));
#pragma unroll
                for (int u = 0; u < 4; ++u)
#pragma unroll
                    for (int j = 0; j < 17; ++j) acc[j] += sS[j * 1024 + k0 + 16 * u] * w[u]; }
#pragma unroll
            for (int j = 0; j < 17; ++j)
#pragma unroll
                for (int o = 1; o < 16; o <<= 1) { acc[j].x += shx(acc[j].x, o); acc[j].y += shx(acc[j].y, o); acc[j].z += shx(acc[j].z, o); acc[j].w += shx(acc[j].w, o); }
            if (kl == 0) { const f32x4 bv = *(const f32x4*)(bada + (size_t)l * MODW + c0);
#pragma unroll
                for (int j = 0; j < 17; ++j) *(f32x4*)(C.MOD() + ((size_t)l * 17 + j) * MODW + c0) = acc[j] + bv; }
        }
        __syncthreads();
    }
    {
        LAS float* scr = (LAS float*)(C.lds + C.wave * 8448);
        WSrc W; W.w_in = ldin<8>(); W.w_out = ldin<17>(); W.w_e1 = ldin<20>(); W.w_e2 = ldin<22>();
        for (int it = C.gw; it < CV_HEAD; it += C.ngw) convert_item(C, W, 0, it, scr, C.lane);
        convert_bias(C, ldin<21>(), 0);
    }
}

__device__ __forceinline__ void moe_tables(const Ctx& C, int l, bool with_t2e) {
    __syncthreads();
    if (C.tid < NE) C.MISC[40 + C.tid] = __hip_atomic_load(C.ctl + CW_CNT + (l * NE + C.tid) * 64, RLX_AGENT);
    __syncthreads();
    if (C.tid == 0) { unsigned s = 0;
#pragma unroll 1
        for (int e = 0; e < NE; ++e) { C.MISC[e] = s; s += (C.MISC[40 + e] + 255u) >> 8; } C.MISC[NE] = s; }
    __syncthreads();
    if (with_t2e) { LAS unsigned char* t2e = (LAS unsigned char*)(C.lds + T2E_OFF);
        for (int rt = C.tid; rt < MAXRT; rt += NWAVES * 64) { unsigned e = 0;
#pragma unroll 1
            for (int k = 1; k < NE; ++k) e += (C.MISC[k] <= (unsigned)rt) ? 1u : 0u;
            t2e[rt] = (unsigned char)e; }
        __syncthreads(); }
}

__device__ __forceinline__ void row_bt(int r, int& b, int& t, int& j) { b = r / SEG; t = r - b * SEG; j = t < SQ ? b : 16; }
__device__ __forceinline__ void wave_rows(const Ctx& C, int n, int& rbeg, int& rend) { const int rpw = (n + C.ngw - 1) / C.ngw; rbeg = C.gw * rpw; rend = rbeg + rpw < n ? rbeg + rpw : n; }
__device__ __forceinline__ int colq(int q, int lane) { return 512 * (q >> 1) + 8 * lane + 4 * (q & 1); }
__device__ __forceinline__ void bf8_to_f32(v4u w, f32x4& a, f32x4& b) { a = (f32x4){bflo(w.x), bfhi(w.x), bflo(w.y), bfhi(w.y)}; b = (f32x4){bflo(w.z), bfhi(w.z), bflo(w.w), bfhi(w.w)}; }
__device__ __forceinline__ v4u f32_to_bf8(f32x4 a, f32x4 b) { return (v4u){pk2(a.x, a.y), pk2(a.z, a.w), pk2(b.x, b.y), pk2(b.z, b.w)}; }
__device__ __forceinline__ void fp8x8_to_f32(v2u w, f32x4& a, f32x4& b) {
    const unsigned w0 = w.x, w1 = w.y;
    const f32x2 p0 = __builtin_amdgcn_cvt_pk_f32_fp8((int)w0, false), p1 = __builtin_amdgcn_cvt_pk_f32_fp8((int)w0, true), p2 = __builtin_amdgcn_cvt_pk_f32_fp8((int)w1, false), p3 = __builtin_amdgcn_cvt_pk_f32_fp8((int)w1, true);
    a = (f32x4){p0.x, p0.y, p1.x, p1.y}; b = (f32x4){p2.x, p2.y, p3.x, p3.y}; }
__device__ __forceinline__ v2u f32_to_fp8x8(f32x4 a, f32x4 b) {
    int p0 = __builtin_amdgcn_cvt_pk_fp8_f32(a.x, a.y, 0, false); p0 = __builtin_amdgcn_cvt_pk_fp8_f32(a.z, a.w, p0, true);
    int p1 = __builtin_amdgcn_cvt_pk_fp8_f32(b.x, b.y, 0, false); p1 = __builtin_amdgcn_cvt_pk_fp8_f32(b.z, b.w, p1, true);
    return (v2u){(unsigned)p0, (unsigned)p1}; }
__device__ __forceinline__ void modulate2(const f32x4 (&v)[2][4], const f32x4 (&gv)[4], const float* const (&mj)[2], int sh_chunk, f32x4 (&h)[2][4], int lane) {
    f32x4 sh[2][4], sc[2][4]; float ss[2];
#pragma unroll
    for (int u = 0; u < 2; ++u) { ss[u] = 0.f;
#pragma unroll
        for (int q = 0; q < 4; ++q) { const int c = colq(q, lane); sh[u][q] = *(const f32x4*)(mj[u] + sh_chunk * D + c); sc[u][q] = *(const f32x4*)(mj[u] + (sh_chunk + 1) * D + c); ss[u] += sum4(v[u][q] * v[u][q]); } }
    ss[0] = wsum(ss[0]); ss[1] = wsum(ss[1]);
#pragma unroll
    for (int u = 0; u < 2; ++u) { const float rs = __builtin_amdgcn_rsqf(ss[u] * (1.0f / D) + EPS);
#pragma unroll
        for (int q = 0; q < 4; ++q) h[u][q] = (v[u][q] * rs) * gv[q] * (1.0f + sc[u][q]) + sh[u][q]; }
}
__device__ __forceinline__ void pair_load2(const Ctx& C, const int (&r)[2], v2u (&pr)[2][4]) {
#pragma unroll
    for (int u = 0; u < 2; ++u)
#pragma unroll
        for (int k = 0; k < 4; ++k) pr[u][k] = C.PAIR()[(size_t)r[u] * 4 + k];
}
__device__ __forceinline__ void moe_combine2(const Ctx& C, const v2u (&pr)[2][4], f32x4 (&acc)[2][4]) {
    v2u y[2][4][2];
#pragma unroll
    for (int u = 0; u < 2; ++u)
#pragma unroll
        for (int k = 0; k < 4; ++k) { const unsigned px = pr[u][k].x; const unsigned e = px & 31u, pos = px >> 5;
            const unsigned char* yp = (const unsigned char*)C.YP() + ((size_t)C.MISC[e] * 256 + pos) * D + 8 * C.lane;
#pragma unroll
            for (int jj = 0; jj < 2; ++jj) y[u][k][jj] = __builtin_nontemporal_load((const GAS v2u*)(yp + 512 * jj)); }
#pragma unroll
    for (int u = 0; u < 2; ++u) {
#pragma unroll
        for (int q = 0; q < 4; ++q) acc[u][q] = (f32x4){0.f, 0.f, 0.f, 0.f};
#pragma unroll
        for (int k = 0; k < 4; ++k) { const unsigned wb = pr[u][k].y; const float wt = __uint_as_float(wb) * 0.125f;
#pragma unroll
            for (int jj = 0; jj < 2; ++jj) { f32x4 ya, yb; fp8x8_to_f32(y[u][k][jj], ya, yb); acc[u][2 * jj] += wt * ya; acc[u][2 * jj + 1] += wt * yb; } } }
}
__device__ __forceinline__ void ld_x2(const Ctx& C, const bf16* base, const int (&r)[2], f32x4 (&v)[2][4]) {
#pragma unroll
    for (int u = 0; u < 2; ++u)
#pragma unroll
        for (int jj = 0; jj < 2; ++jj) bf8_to_f32(__builtin_nontemporal_load((const GAS v4u*)(base + (size_t)r[u] * D + 512 * jj + 8 * C.lane)), v[u][2 * jj], v[u][2 * jj + 1]);
}

__device__ __forceinline__ void phase_premix(const Ctx& C, const Args& A, int l) {
    if (l > 0) moe_tables(C, l - 1, false);
    const float* modl = C.MOD() + (size_t)l * 17 * MODW; const float* modp = C.MOD() + (size_t)(l > 0 ? l - 1 : 0) * 17 * MODW;
    const float* g = ldin<6>() + (size_t)l * D; const float* xin = ldin<0>(); const float* cxin = ldin<2>();
    f32x4 gv[4];
#pragma unroll
    for (int q = 0; q < 4; ++q) gv[q] = *(const f32x4*)(g + colq(q, C.lane));
    int rbeg, rend; wave_rows(C, T, rbeg, rend);
    v2u pr[2][4]; if (l > 0 && rbeg < rend) { const int rf[2] = {rbeg, rbeg + 1 < rend ? rbeg + 1 : rbeg}; pair_load2(C, rf, pr); }
    int jc = -1; f32x4 gtc[4], shc[4], gsc[4];
#pragma unroll
    for (int q = 0; q < 4; ++q) { gtc[q] = gv[q]; shc[q] = gv[q]; gsc[q] = gv[q]; }
    for (int r0 = rbeg; r0 < rend; r0 += 2) {
        const int r[2] = {r0, r0 + 1 < rend ? r0 + 1 : r0};
        int b[2], t[2], j[2]; row_bt(r[0], b[0], t[0], j[0]); row_bt(r[1], b[1], t[1], j[1]);
        f32x4 v[2][4];
        if (l == 0) {
#pragma unroll
            for (int u = 0; u < 2; ++u) { const float* src = t[u] < SQ ? xin + ((size_t)b[u] * SQ + t[u]) * D : cxin + ((size_t)b[u] * CL + (t[u] - SQ)) * D;
#pragma unroll
                for (int q = 0; q < 4; ++q) v[u][q] = __builtin_nontemporal_load((const f32x4*)(src + colq(q, C.lane))); }
        } else {
            ld_x2(C, C.OB(), r, v);
            v2u prn[2][4]; { const int a = r0 + 2 < rend ? r0 + 2 : r0, b2 = r0 + 3 < rend ? r0 + 3 : a; const int rn[2] = {a, b2}; pair_load2(C, rn, prn); }
            f32x4 acc[2][4]; moe_combine2(C, pr, acc);
#pragma unroll
            for (int u = 0; u < 2; ++u)
#pragma unroll
                for (int k = 0; k < 4; ++k) pr[u][k] = prn[u][k];
            if (j[0] != jc) {
#pragma unroll
                for (int q = 0; q < 4; ++q) gtc[q] = *(const f32x4*)(modp + (size_t)j[0] * MODW + 5 * D + colq(q, C.lane)); }
#pragma unroll
            for (int u = 0; u < 2; ++u) {
                if (j[u] == j[0]) {
#pragma unroll
                    for (int q = 0; q < 4; ++q) v[u][q] += gtc[q] * acc[u][q]; }
                else {
#pragma unroll
                    for (int q = 0; q < 4; ++q) v[u][q] += *(const f32x4*)(modp + (size_t)j[u] * MODW + 5 * D + colq(q, C.lane)) * acc[u][q]; } } }
        if (j[0] != jc) { jc = j[0]; const float* m = modl + (size_t)jc * MODW;
#pragma unroll
            for (int q = 0; q < 4; ++q) { const int c = colq(q, C.lane); shc[q] = *(const f32x4*)(m + c); gsc[q] = gv[q] * (1.0f + *(const f32x4*)(m + D + c)); } }
        f32x4 h[2][4]; float ss[2];
#pragma unroll
        for (int u = 0; u < 2; ++u) { ss[u] = 0.f;
#pragma unroll
            for (int q = 0; q < 4; ++q) ss[u] += sum4(v[u][q] * v[u][q]); }
        ss[0] = wsum(ss[0]); ss[1] = wsum(ss[1]);
#pragma unroll
        for (int u = 0; u < 2; ++u) { const float rs = __builtin_amdgcn_rsqf(ss[u] * (1.0f / D) + EPS);
            if (j[u] == jc) {
#pragma unroll
                for (int q = 0; q < 4; ++q) h[u][q] = (v[u][q] * rs) * gsc[q] + shc[q]; }
            else { const float* m = modl + (size_t)j[u] * MODW;
#pragma unroll
                for (int q = 0; q < 4; ++q) { const int c = colq(q, C.lane); h[u][q] = (v[u][q] * rs) * (gv[q] * (1.0f + *(const f32x4*)(m + D + c))) + *(const f32x4*)(m + c); } } }
#pragma unroll
        for (int u = 0; u < 2; ++u)
#pragma unroll
            for (int jj = 0; jj < 2; ++jj) { const size_t o = (size_t)r[u] * D + 512 * jj + 8 * C.lane;
                __builtin_nontemporal_store(f32_to_bf8(v[u][2 * jj], v[u][2 * jj + 1]), (GAS v4u*)(C.X() + o));
#if MK_FP8_IN == 1
                *(GAS v2u*)((unsigned char*)C.HB() + o) = f32_to_fp8x8(h[u][2 * jj], h[u][2 * jj + 1]); }
#elif MK_FP8_IN == 2
                *(GAS v4u*)(C.HB() + o) = f32_to_bf8(h[u][2 * jj], h[u][2 * jj + 1]); *(GAS v2u*)(C.HB8() + o) = f32_to_fp8x8(h[u][2 * jj], h[u][2 * jj + 1]); }
#else
                *(GAS v4u*)(C.HB() + o) = f32_to_bf8(h[u][2 * jj], h[u][2 * jj + 1]); }
#endif
    }
}
__device__ __forceinline__ void phase_premoe(const Ctx& C, const Args& A, int l) {
    const float* modl = C.MOD() + (size_t)l * 17 * MODW; const float* g = ldin<7>() + (size_t)l * D;
    typedef __bf16 bf16x2_t __attribute__((ext_vector_type(2)));
    volatile LAS unsigned* lhist = C.MISC + 80; volatile LAS unsigned* lbase = C.MISC + 112;
    __syncthreads();
    { const float* wr = ldin<18>() + (size_t)l * D * NE;
      for (int idx = C.tid; idx < 8 * 4 * 2 * 64; idx += NWAVES * 64) { const int ln = idx & 63, jj = (idx >> 6) & 1, ip = (idx >> 7) & 3, e4 = idx >> 9;
          const float* w0 = wr + (size_t)(512 * jj + 8 * ln + 2 * ip) * NE + 4 * e4; const f32x4 a = *(const f32x4*)w0, b = *(const f32x4*)(w0 + NE);
          ((LAS v4u*)C.lds)[idx] = (v4u){pk2(a.x, b.x), pk2(a.y, b.y), pk2(a.z, b.z), pk2(a.w, b.w)}; }
      if (C.tid < NE) lhist[C.tid] = 0u; }
    __syncthreads();
    f32x4 gv[4];
#pragma unroll
    for (int q = 0; q < 4; ++q) gv[q] = *(const f32x4*)(g + colq(q, C.lane));
    const int half = C.lane >> 5, ex = C.lane & 31;
    const float br = ldin<19>()[l * NE + ex];
    const bool lat = l + 1 == NL;
#define RMAP(q) (lat ? ((q) / SQ) * SEG + (q) % SQ : (q))
    int rbeg, rend; wave_rows(C, lat ? NB * SQ : T, rbeg, rend);
    const bool cv = true; int cit = CV_HEAD + tail_items(NROWT * (INW / 256), C.G) + tail_items((l + 1 < NL ? NROWT : NB * SQ / 256) * (D / 256), C.G) + C.gw; LAS float* cscr = (LAS float*)(C.lds + 65536 + C.wave * 8448);
    WSrc W; W.w_in = ldin<8>(); W.w_out = ldin<17>(); W.w_e1 = ldin<20>(); W.w_e2 = ldin<22>();
    v4u ob[2][2];
    if (rbeg < rend) { const int ra = RMAP(rbeg), rb = RMAP(rbeg + 1 < rend ? rbeg + 1 : rbeg);
#pragma unroll
        for (int jj = 0; jj < 2; ++jj) { ob[0][jj] = __builtin_nontemporal_load((const GAS v4u*)(C.OB() + (size_t)ra * D + 512 * jj + 8 * C.lane)); ob[1][jj] = __builtin_nontemporal_load((const GAS v4u*)(C.OB() + (size_t)rb * D + 512 * jj + 8 * C.lane)); } }
    int jc = -1; f32x4 shc[4], gsc[4];
#pragma unroll
    for (int q = 0; q < 4; ++q) { shc[q] = gv[q]; gsc[q] = gv[q]; }
    for (int r0 = rbeg; r0 < rend; r0 += 2) {
        const bool two = r0 + 1 < rend; const int r[2] = {RMAP(r0), RMAP(two ? r0 + 1 : r0)};
        int b[2], t[2], j[2]; row_bt(r[0], b[0], t[0], j[0]); row_bt(r[1], b[1], t[1], j[1]);
        f32x4 v[2][4];
#pragma unroll
        for (int u = 0; u < 2; ++u)
#pragma unroll
            for (int jj = 0; jj < 2; ++jj) bf8_to_f32(ob[u][jj], v[u][2 * jj], v[u][2 * jj + 1]);
        { const int qa = r0 + 2 < rend ? r0 + 2 : r0, qb = r0 + 3 < rend ? r0 + 3 : qa; const int ra = RMAP(qa), rb = RMAP(qb);
#pragma unroll
          for (int jj = 0; jj < 2; ++jj) { ob[0][jj] = __builtin_nontemporal_load((const GAS v4u*)(C.OB() + (size_t)ra * D + 512 * jj + 8 * C.lane)); ob[1][jj] = __builtin_nontemporal_load((const GAS v4u*)(C.OB() + (size_t)rb * D + 512 * jj + 8 * C.lane)); } }
        if (j[0] != jc) { jc = j[0]; const float* m = modl + (size_t)jc * MODW + 3 * D;
#pragma unroll
            for (int q = 0; q < 4; ++q) { const int c = colq(q, C.lane); shc[q] = *(const f32x4*)(m + c); gsc[q] = gv[q] * (1.0f + *(const f32x4*)(m + D + c)); } }
        f32x4 h[2][4]; float ss[2];
#pragma unroll
        for (int u = 0; u < 2; ++u) { ss[u] = 0.f;
#pragma unroll
            for (int q = 0; q < 4; ++q) ss[u] += sum4(v[u][q] * v[u][q]); }
        ss[0] = wsum(ss[0]); ss[1] = wsum(ss[1]);
#pragma unroll
        for (int u = 0; u < 2; ++u) { const float rs = __builtin_amdgcn_rsqf(ss[u] * (1.0f / D) + EPS);
            if (j[u] == jc) {
#pragma unroll
                for (int q = 0; q < 4; ++q) h[u][q] = (v[u][q] * rs) * gsc[q] + shc[q]; }
            else { const float* m = modl + (size_t)j[u] * MODW + 3 * D;
#pragma unroll
                for (int q = 0; q < 4; ++q) { const int c = colq(q, C.lane); h[u][q] = (v[u][q] * rs) * (gv[q] * (1.0f + *(const f32x4*)(m + D + c))) + *(const f32x4*)(m + c); } } }
#pragma unroll
        for (int u = 0; u < 2; ++u)
#pragma unroll
            for (int jj = 0; jj < 2; ++jj) { const size_t o = (size_t)r[u] * D + 512 * jj + 8 * C.lane;
                *(GAS v2u*)(C.HB8() + o) = f32_to_fp8x8(h[u][2 * jj], h[u][2 * jj + 1]); }
        f32x4 pl[2][8];
#pragma unroll
        for (int e4 = 0; e4 < 8; ++e4) { pl[0][e4] = (f32x4){0.f, 0.f, 0.f, 0.f}; pl[1][e4] = pl[0][e4]; }
#pragma unroll
        for (int jj = 0; jj < 2; ++jj)
#pragma unroll
            for (int ip = 0; ip < 4; ++ip) { const int q = 2 * jj + (ip >> 1), c0 = 2 * (ip & 1);
                const bf16x2_t h0 = __builtin_bit_cast(bf16x2_t, pk2(h[0][q][c0], h[0][q][c0 + 1])), h1 = __builtin_bit_cast(bf16x2_t, pk2(h[1][q][c0], h[1][q][c0 + 1]));
#pragma unroll
                for (int e4 = 0; e4 < 8; ++e4) { const v4u w = ((const LAS v4u*)C.lds)[((e4 * 4 + ip) * 2 + jj) * 64 + C.lane];
                    const unsigned wx[4] = {w.x, w.y, w.z, w.w};
#pragma unroll
                    for (int x = 0; x < 4; ++x) { const bf16x2_t wb = __builtin_bit_cast(bf16x2_t, wx[x]);
                        pl[0][e4][x] = __builtin_amdgcn_fdot2_f32_bf16(h0, wb, pl[0][e4][x], false); pl[1][e4][x] = __builtin_amdgcn_fdot2_f32_bf16(h1, wb, pl[1][e4][x], false); } } }
        float s32[32];
#pragma unroll
        for (int e = 0; e < 32; ++e) { const auto r = __builtin_amdgcn_permlane32_swap(__float_as_uint(pl[0][e >> 2][e & 3]), __float_as_uint(pl[1][e >> 2][e & 3]), false, false); s32[e] = __uint_as_float(r[0]) + __uint_as_float(r[1]); }
        float s16[16];
#pragma unroll
        for (int e = 0; e < 16; ++e) { const auto r = __builtin_amdgcn_permlane16_swap(__float_as_uint(s32[e]), __float_as_uint(s32[16 + e]), false, false); s16[e] = __uint_as_float(r[0]) + __uint_as_float(r[1]); }
        float s8[8];
#pragma unroll
        for (int e = 0; e < 8; ++e) { const bool hi = (C.lane & 8) != 0; const float keep = hi ? s16[8 + e] : s16[e], send = hi ? s16[e] : s16[8 + e]; s8[e] = keep + dpp_f<0x128>(send); }
        float s4[4];
#pragma unroll
        for (int e = 0; e < 4; ++e) { const bool hi = (C.lane & 4) != 0; const float keep = hi ? s8[4 + e] : s8[e], send = hi ? s8[e] : s8[4 + e]; s4[e] = keep + dpp_f<0x1B>(dpp_f<0x141>(send)); }
        float s2[2];
#pragma unroll
        for (int e = 0; e < 2; ++e) { const bool hi = (C.lane & 2) != 0; const float keep = hi ? s4[2 + e] : s4[e], send = hi ? s4[e] : s4[2 + e]; s2[e] = keep + dpp_f<0x4E>(send); }
        float lg; { const bool hi = (C.lane & 1) != 0; const float keep = hi ? s2[1] : s2[0], send = hi ? s2[0] : s2[1]; lg = keep + dpp_f<0xB1>(send); }
        const float vv = lg + br; const int vb = __float_as_int(vv);
        float cur = vv; int rank = 4; float sv[4];
#pragma unroll
        for (int k = 0; k < 4; ++k) { float m = cur; m = __builtin_fmaxf(m, dpp_f<0xB1>(m)); m = __builtin_fmaxf(m, dpp_f<0x4E>(m)); m = __builtin_fmaxf(m, dpp_f<0x141>(m)); m = __builtin_fmaxf(m, dpp_f<0x140>(m));
            { const auto rr = __builtin_amdgcn_permlane16_swap(__float_as_uint(m), __float_as_uint(m), false, false); m = __builtin_fmaxf(__uint_as_float(rr[0]), __uint_as_float(rr[1])); }
            sv[k] = m;
            const unsigned long long mk = __ballot(cur == m); const int s0 = (int)__builtin_ctz((unsigned)mk | 0x80000000u), s1 = (int)__builtin_ctz((unsigned)(mk >> 32) | 0x80000000u);
            if (ex == (half ? s1 : s0)) { rank = k; cur = -INFINITY; } }
        const float inv = __builtin_amdgcn_rcpf(1.0f + __expf(sv[1] - sv[0]) + __expf(sv[2] - sv[0]) + __expf(sv[3] - sv[0]));
        if (rank < 4 && (half == 0 || two)) { const int rr = r[half];
            const unsigned lpos = __hip_atomic_fetch_add((LAS unsigned*)(C.lds + MISC_OFF) + 80 + ex, 1u, __ATOMIC_RELAXED, __HIP_MEMORY_SCOPE_WORKGROUP);
            C.PAIR()[(size_t)rr * 4 + rank] = (v2u){(unsigned)ex | (lpos << 5), __float_as_uint(__expf(vv - sv[0]) * inv)}; }
        if (cv) {
#pragma unroll 1
            for (int k = 0; k < 2 && cit < CV_PER_L; ++k, cit += C.ngw) convert_item(C, W, l, cit, cscr, C.lane); }
    }
    if (cv) {
#pragma unroll 1
        for (; cit < CV_PER_L; cit += C.ngw) convert_item(C, W, l, cit, cscr, C.lane);
        if (l + 1 < NL) {
#pragma unroll 1
            for (int it = C.gw; it < CV_HEAD; it += C.ngw) convert_item(C, W, l + 1, it, cscr, C.lane);
            convert_bias(C, ldin<21>(), l + 1); } }
    __syncthreads();
    gu32* cnt = C.ctl + CW_CNT + (size_t)l * NE * 64;
    if (C.tid < NE) { const unsigned n = lhist[C.tid]; lbase[C.tid] = n ? __hip_atomic_fetch_add(cnt + C.tid * 64, n, RLX_AGENT) : 0u; }
    __syncthreads();
    for (int idx = C.lane; idx < (rend - rbeg) * 4; idx += 64) { const int rr = RMAP(rbeg + (idx >> 2)); gu32* px = (gu32*)C.PAIR() + ((size_t)rr * 4 + (idx & 3)) * 2;
        const unsigned x = __hip_atomic_load(px, RLX_AGENT); const unsigned e = x & 31u, pos = lbase[e] + (x >> 5);
        *px = e | (pos << 5); C.TOK()[(size_t)e * T + pos] = rr; }
    __syncthreads();
#undef RMAP
}
__device__ __forceinline__ void phase_final(const Ctx& C, const Args& A) {
    moe_tables(C, NL - 1, false);
    const float* modp = C.MOD() + (size_t)(NL - 1) * 17 * MODW; float* outp = ldout();
    int qbeg, qend; wave_rows(C, NB * SQ, qbeg, qend);
    v2u pr[2][4]; if (qbeg < qend) { const int qa = qbeg, qb = qbeg + 1 < qend ? qbeg + 1 : qbeg; const int rf[2] = {(qa / SQ) * SEG + qa % SQ, (qb / SQ) * SEG + qb % SQ}; pair_load2(C, rf, pr); }
    int bc = -1; f32x4 gtc[4];
#pragma unroll
    for (int q = 0; q < 4; ++q) gtc[q] = (f32x4){0.f, 0.f, 0.f, 0.f};
    for (int q0 = qbeg; q0 < qend; q0 += 2) {
        const int qq[2] = {q0, q0 + 1 < qend ? q0 + 1 : q0}; const int b[2] = {qq[0] / SQ, qq[1] / SQ}; const int r[2] = {b[0] * SEG + (qq[0] - b[0] * SQ), b[1] * SEG + (qq[1] - b[1] * SQ)};
        f32x4 v[2][4]; ld_x2(C, C.OB(), r, v);
        if (b[0] != bc) { bc = b[0];
#pragma unroll
            for (int q = 0; q < 4; ++q) gtc[q] = *(const f32x4*)(modp + (size_t)bc * MODW + 5 * D + colq(q, C.lane)); }
        v2u prn[2][4]; { const int qa = q0 + 2 < qend ? q0 + 2 : q0, qb = q0 + 3 < qend ? q0 + 3 : qa; const int rn[2] = {(qa / SQ) * SEG + qa % SQ, (qb / SQ) * SEG + qb % SQ}; pair_load2(C, rn, prn); }
        f32x4 acc[2][4]; moe_combine2(C, pr, acc);
#pragma unroll
        for (int u = 0; u < 2; ++u)
#pragma unroll
            for (int k = 0; k < 4; ++k) pr[u][k] = prn[u][k];
#pragma unroll
        for (int u = 0; u < 2; ++u) { float* o = outp + (size_t)qq[u] * D;
            if (b[u] == bc) {
#pragma unroll
                for (int q = 0; q < 4; ++q) __builtin_nontemporal_store(v[u][q] + gtc[q] * acc[u][q], (f32x4*)(o + colq(q, C.lane))); }
            else {
#pragma unroll
                for (int q = 0; q < 4; ++q) *(f32x4*)(o + colq(q, C.lane)) = v[u][q] + *(const f32x4*)(modp + (size_t)b[u] * MODW + 5 * D + colq(q, C.lane)) * acc[u][q]; } }
    }
}

__device__ __forceinline__ v4u qk_piece(v4u w, const float (&gain)[8], bool lat, int pos, int i0, bool first, float scale, const LAS f32x2* rope) {
    float f[8] = {bflo(w.x), bfhi(w.x), bflo(w.y), bfhi(w.y), bflo(w.z), bfhi(w.z), bflo(w.w), bfhi(w.w)};
    float ss = 0.f;
#pragma unroll
    for (int i = 0; i < 8; ++i) ss += f[i] * f[i];
    ss += shx(ss, 1); ss += shx(ss, 2); ss += shx(ss, 4);
    const float rs = __builtin_amdgcn_rsqf(ss * (1.0f / 64.0f) + EPS);
    float o[8];
#pragma unroll
    for (int i = 0; i < 8; ++i) f[i] = f[i] * rs * gain[i];
#pragma unroll
    for (int i = 0; i < 8; ++i) { const float pv = shx(f[i], 2); const f32x2 cs = rope[(pos & 63) * 16 + i0 + i];
        const float rot = first ? f[i] * cs.x - pv * cs.y : f[i] * cs.x + pv * cs.y;
        o[i] = (lat ? rot : f[i]) * scale; }
    v4u ow; ow.x = pk2(o[0], o[1]); ow.y = pk2(o[2], o[3]); ow.z = pk2(o[4], o[5]); ow.w = pk2(o[6], o[7]); return ow;
}
__device__ __forceinline__ void phase_qknorm(const Ctx& C, const Args& A, int l) {
    const LAS f32x2* rope = (const LAS f32x2*)(C.lds + ROPE_OFF);
    const float* gq = ldin<9>() + l * 64; const float* gk = ldin<10>() + l * 64;
    const int d0 = 8 * (C.lane & 7);
    const int ax = d0 >> 5, o0 = d0 & 31; const bool first = o0 < 16; const int i0 = o0 & 15;
    float gqv[8], gkv[8];
#pragma unroll
    for (int i = 0; i < 8; ++i) { gqv[i] = gq[d0 + i]; gkv[i] = gk[d0 + i]; }
    int rbeg, rend; wave_rows(C, T, rbeg, rend);
    for (int r0 = rbeg; r0 < rend; r0 += 4) {
        v4u wq[4]; bool ok[4]; int tt[4];
#pragma unroll
        for (int u = 0; u < 4; ++u) { ok[u] = r0 + u < rend; const int r = ok[u] ? r0 + u : r0; tt[u] = r % SEG; wq[u] = *(const GAS v4u*)(C.P() + (size_t)r * INW + 8 * C.lane); }
        const int uk = C.lane >> 4; const bool okk = r0 + uk < rend; const int rk = okk ? r0 + uk : r0; const int tk = rk % SEG;
        bf16* pk = C.P() + (size_t)rk * INW + 512 + 8 * (C.lane & 15);
        const v4u wk = *(const GAS v4u*)pk;
#pragma unroll
        for (int u = 0; u < 4; ++u) { const bool lat = tt[u] < SQ; const int pos = ax == 0 ? (tt[u] >> 6) : (tt[u] & 63);
            const v4u ow = qk_piece(wq[u], gqv, lat, pos, i0, first, attn_body::C2, rope);
            if (ok[u]) *(GAS v4u*)(C.P() + (size_t)(r0 + u) * INW + 8 * C.lane) = ow; }
        { const bool lat = tk < SQ; const int pos = ax == 0 ? (tk >> 6) : (tk & 63);
          const v4u ow = qk_piece(wk, gkv, lat, pos, i0, first, 1.0f, rope);
          if (okk) *(GAS v4u*)pk = ow; }
    }
}

__device__ __forceinline__ void attn_gnorm(const Ctx& C, size_t row0, const float* gg) {
    const f32x4 gA0 = *(const f32x4*)(gg + 8 * C.lane), gA1 = *(const f32x4*)(gg + 8 * C.lane + 4);
    bf16* y0 = C.Y() + (row0 + C.wave * 32) * D + 8 * C.lane;
#pragma unroll 1
    for (int i = 0; i < 32; i += 16) {
        v4u av[16]; float qa[16];
#pragma unroll
        for (int u = 0; u < 16; ++u) av[u] = *(const GAS v4u*)(y0 + (size_t)(i + u) * D);
#pragma unroll
        for (int u = 0; u < 16; ++u) { const f32x4 a0 = bf4((v2u){av[u].x, av[u].y}), a1 = bf4((v2u){av[u].z, av[u].w}); qa[u] = sum4(a0 * a0) + sum4(a1 * a1); }
#pragma unroll
        for (int u = 0; u < 16; ++u) qa[u] = wsum(qa[u]);
#pragma unroll
        for (int u = 0; u < 16; ++u) { const float rsa = __builtin_amdgcn_rsqf(qa[u] * (1.0f / 512.0f) + EPS);
            const f32x4 a0 = bf4((v2u){av[u].x, av[u].y}), a1 = bf4((v2u){av[u].z, av[u].w});
            const v2u o0 = pk4(a0 * rsa * gA0), o1 = pk4(a1 * rsa * gA1);
            *(GAS v4u*)(y0 + (size_t)(i + u) * D) = (v4u){o0.x, o0.y, o1.x, o1.y}; }
    }
}
template <bool FIXR> __device__ __forceinline__ void phase_attn_impl(const Ctx& C, int l) {
    char* shm = (char*)C.lds;
    const attn_body::bf16* Pq = (const attn_body::bf16*)C.P(); attn_body::bf16* Yo = (attn_body::bf16*)C.Y();
    const float* gg = ldin<16>() + (size_t)l * D;
    gu32* cc = C.ctl + CW_CTX + (size_t)l * NB * 16;
    if (l + 1 < NL)
    for (int u = C.G - 1 - C.vcu; u < NB * 8; u += C.G) { const int h = u & 7, b = u >> 3;
        attn_body::attn_unit<8, FIXR>((long)b * SEG + SQ, (long)b * SEG + SQ, CL / 64, h, Pq, Yo, shm);
        asm volatile("s_waitcnt vmcnt(0)" ::: "memory"); __syncthreads();
        if (C.tid == 0) { __builtin_amdgcn_fence(__ATOMIC_RELEASE, "agent"); C.MISC[164] = __hip_atomic_fetch_add(cc + b * 16, 1u, RLX_AGENT); }
        __syncthreads();
        if ((C.MISC[164] & 7u) == 7u) { __builtin_amdgcn_fence(__ATOMIC_ACQUIRE, "agent"); attn_gnorm(C, (size_t)b * SEG + SQ, gg); }
        __syncthreads(); }
    for (int u = C.vcu; u < NB * 16; u += C.G) { const int qb = u & 15, b = u >> 4;
#pragma unroll 1
        for (int h = 0; h < 8; ++h) attn_body::attn_unit<8, FIXR>((long)b * SEG + qb * 256, (long)b * SEG, SEG / 64, h, Pq, Yo, shm);
        asm volatile("s_waitcnt vmcnt(0)" ::: "memory"); __syncthreads();
        attn_gnorm(C, (size_t)b * SEG + qb * 256, gg); }
}

__device__ __forceinline__ void phase_attn(const Ctx& C, int l) {
    float gq = __builtin_fabsf(ldin<9>()[l * 64 + C.lane]), gk = __builtin_fabsf(ldin<10>()[l * 64 + C.lane]);
    gq = __builtin_fmaxf(gq, dpp_f<0xB1>(gq)); gq = __builtin_fmaxf(gq, dpp_f<0x4E>(gq)); gq = __builtin_fmaxf(gq, dpp_f<0x141>(gq)); gq = __builtin_fmaxf(gq, dpp_f<0x140>(gq));
    gk = __builtin_fmaxf(gk, dpp_f<0xB1>(gk)); gk = __builtin_fmaxf(gk, dpp_f<0x4E>(gk)); gk = __builtin_fmaxf(gk, dpp_f<0x141>(gk)); gk = __builtin_fmaxf(gk, dpp_f<0x140>(gk));
    float bq = 0.f, bk = 0.f;
#pragma unroll
    for (int i = 0; i < 4; ++i) { bq = __builtin_fmaxf(bq, __int_as_float(__builtin_amdgcn_readlane(__float_as_int(gq), 16 * i))); bk = __builtin_fmaxf(bk, __int_as_float(__builtin_amdgcn_readlane(__float_as_int(gk), 16 * i))); }
    const float bound = 11.8f * bq * bk;
    if (bound < 60.0f) phase_attn_impl<true>(C, l); else phase_attn_impl<false>(C, l);
}

__device__ __forceinline__ void phase_conv1(const Ctx& C, const Args& A, int l) {
    __syncthreads();
    LAS float* zL = (LAS float*)C.lds;
    const int c4 = 4 * C.lane;
    {
        f32x4 wk[31]; const float* wdw = ldin<11>();
#pragma unroll
        for (int jt = 0; jt < 31; ++jt) wk[jt] = *(const f32x4*)(wdw + ((size_t)l * 31 + jt) * 256 + c4);
        const f32x4 b31 = *(const f32x4*)(ldin<12>() + l * 256 + c4), gln = *(const f32x4*)(ldin<13>() + l * 256 + c4), bln = *(const f32x4*)(ldin<14>() + l * 256 + c4);
        const f32x4 gC = *(const f32x4*)(ldin<16>() + (size_t)l * D + 512 + c4);
        gu32* tq = C.ctl + CW_CQ + l * 16;
        for (int tile = C.vcu; tile < T / 64; ) {
            const int b = tile / 68, tt = tile - b * 68, t0 = tt * 64;
            const int seg_lo = tt < 64 ? 0 : SQ, seg_hi = tt < 64 ? SQ : SEG;
            const size_t rbase = (size_t)b * SEG;
            if (!(l + 1 == NL && tt >= 64)) {
            __syncthreads();
            { v2u ra[12], rg[12];
#pragma unroll
              for (int i = 0; i < 12; ++i) { const int zr = C.wave + 8 * i, t = t0 - 15 + zr; const bool ok = zr < 94 && t >= seg_lo && t < seg_hi;
                  const bf16* p = C.P() + (rbase + (ok ? t : t0)) * INW; ra[i] = *(const GAS v2u*)(p + 768 + c4); rg[i] = *(const GAS v2u*)(p + 1024 + c4); }
#pragma unroll
              for (int i = 0; i < 12; ++i) { const int zr = C.wave + 8 * i, t = t0 - 15 + zr; const bool ok = t >= seg_lo && t < seg_hi;
                  if (zr < 94) { const f32x4 a = bf4(ra[i]), gt = bf4(rg[i]);
                      const f32x4 z = ok ? (f32x4){a.x * sigmoidf_(gt.x), a.y * sigmoidf_(gt.y), a.z * sigmoidf_(gt.z), a.w * sigmoidf_(gt.w)} : (f32x4){0.f, 0.f, 0.f, 0.f};
                      *(LAS f32x4*)(zL + zr * 256 + c4) = z; } } }
            __syncthreads();
            for (int g = 0; g < 2; ++g) { const int i0 = C.wave * 8 + 4 * g;
                f32x4 u[4] = {b31, b31, b31, b31};
#pragma unroll
                for (int j = 0; j < 34; ++j) { const f32x4 z = *(const LAS f32x4*)(zL + (i0 + j) * 256 + c4);
#pragma unroll
                    for (int t = 0; t < 4; ++t) if (j - t >= 0 && j - t < 31) u[t] += wk[j - t] * z; }
                float s[4], vq[4], qq[4]; f32x4 d[4], cf[4];
#pragma unroll
                for (int t = 0; t < 4; ++t) s[t] = sum4(u[t]);
#pragma unroll
                for (int t = 0; t < 4; ++t) s[t] = wsum(s[t]);
#pragma unroll
                for (int t = 0; t < 4; ++t) { d[t] = u[t] - s[t] * (1.0f / 256.0f); vq[t] = sum4(d[t] * d[t]); }
#pragma unroll
                for (int t = 0; t < 4; ++t) vq[t] = wsum(vq[t]);
#pragma unroll
                for (int t = 0; t < 4; ++t) { const f32x4 y = d[t] * __builtin_amdgcn_rsqf(vq[t] * (1.0f / 256.0f) + EPS) * gln + bln;
                    cf[t] = (f32x4){y.x * sigmoidf_(y.x), y.y * sigmoidf_(y.y), y.z * sigmoidf_(y.z), y.w * sigmoidf_(y.w)}; qq[t] = sum4(cf[t] * cf[t]); }
#pragma unroll
                for (int t = 0; t < 4; ++t) qq[t] = wsum(qq[t]);
#pragma unroll
                for (int t = 0; t < 4; ++t) *(GAS v2u*)(C.Y() + (rbase + t0 + i0 + t) * D + 512 + c4) = pk4(cf[t] * __builtin_amdgcn_rsqf(qq[t] * (1.0f / 256.0f) + EPS) * gC);
            }
            }
            if (C.tid == 0) C.MISC[165] = (unsigned)C.G + __hip_atomic_fetch_add(tq, 1u, RLX_AGENT);
            __syncthreads();
            tile = (int)C.MISC[165];
        }
        __syncthreads();
    }
}
__device__ __forceinline__ void phase_conv2(const Ctx& C, const Args& A, int l) {
    const int c4 = 4 * C.lane;
    {
        const float* wsc = ldin<15>() + (size_t)l * 3 * 256 + c4; const f32x4 w30 = *(const f32x4*)(wsc), w31 = *(const f32x4*)(wsc + 256), w32 = *(const f32x4*)(wsc + 512);
        const float* gg = ldin<16>() + (size_t)l * D;
        const f32x4 gS = *(const f32x4*)(gg + 768 + c4);
        gu32* tq = C.ctl + CW_CQ + (NL + l) * 16; int kc = 0;
        for (int ch = C.vcu; ch < T / 64; ++kc) {
        if (C.tid == 0) C.MISC[166 + (kc & 1)] = (unsigned)C.G + __hip_atomic_fetch_add(tq, 1u, RLX_AGENT);
        const int rbeg = ch * 64 + C.wave * 8, rend = (l + 1 == NL && ch % 68 >= 64) ? rbeg : rbeg + 8;
        for (int r0 = rbeg; r0 < rend; r0 += 2) {
            const bool two = r0 + 1 < rend;
            v2u cgv[4], hvv[4], bgv[2];
#pragma unroll
            for (int k = 0; k < 4; ++k) { int rr = r0 - 1 + k; rr = rr < 0 ? 0 : (rr >= T ? T - 1 : rr); const bf16* p = C.P() + (size_t)rr * INW; cgv[k] = *(const GAS v2u*)(p + 1536 + c4); hvv[k] = *(const GAS v2u*)(p + 1792 + c4); }
#pragma unroll
            for (int u = 0; u < 2; ++u) { const int r = two || u == 0 ? r0 + u : r0; bgv[u] = *(const GAS v2u*)(C.P() + (size_t)r * INW + 1280 + c4); }
            f32x4 m[4];
#pragma unroll
            for (int k = 0; k < 4; ++k) m[k] = bf4(cgv[k]) * bf4(hvv[k]);
            f32x4 sv[2]; float qs[2];
#pragma unroll
            for (int u = 0; u < 2; ++u) { const int r = r0 + u; const int t = r % SEG; const bool has_prev = t != 0 && t != SQ, has_next = t != SQ - 1 && t != SEG - 1;
                const f32x4 zero = (f32x4){0.f, 0.f, 0.f, 0.f};
                sv[u] = bf4(bgv[u]) * (w30 * (has_prev ? m[u] : zero) + w31 * m[u + 1] + w32 * (has_next ? m[u + 2] : zero));
                qs[u] = sum4(sv[u] * sv[u]); }
            qs[0] = wsum(qs[0]); qs[1] = wsum(qs[1]);
#pragma unroll
            for (int u = 0; u < 2; ++u) { if (u == 1 && !two) break; bf16* yr = C.Y() + (size_t)(r0 + u) * D;
                *(GAS v2u*)(yr + 768 + c4) = pk4(sv[u] * __builtin_amdgcn_rsqf(qs[u] * (1.0f / 256.0f) + EPS) * gS); }
        }
        __syncthreads(); ch = (int)C.MISC[166 + (kc & 1)];
        }
    }
}

__device__ __forceinline__ void phase_route(const Ctx& C, const Args& A, int l) {
    volatile LAS unsigned* lhist = C.MISC + 80; volatile LAS unsigned* lbase = C.MISC + 112;
    const float br = C.lane < NE ? ldin<19>()[l * NE + C.lane] : 0.f;
    gu32* cnt = C.ctl + CW_CNT + (size_t)l * NE * 64;
    for (int tile = C.vcu; tile < T / 64; tile += C.G) {
        __syncthreads();
        if (C.tid < NE) lhist[C.tid] = 0u;
        __syncthreads();
        unsigned pp[8]; int rk[8];
        float lg[8];
#pragma unroll
        for (int i = 0; i < 8; ++i) { const int r = tile * 64 + C.wave * 8 + i; lg[i] = C.lane < NE ? C.LOG()[(size_t)r * NE + C.lane] + br : -INFINITY; }
#pragma unroll
        for (int i = 0; i < 8; ++i) { const int r = tile * 64 + C.wave * 8 + i; const float v = lg[i]; const int vb = __float_as_int(v);
            int rank = 0;
#pragma unroll
            for (int j = 0; j < NE; ++j) { const float vj = __int_as_float(__builtin_amdgcn_readlane(vb, j)); rank += (vj > v || (vj == v && j < C.lane)) ? 1 : 0; }
            const bool sel = C.lane < NE && rank < 4;
            float sv[4];
#pragma unroll
            for (int k = 0; k < 4; ++k) { const unsigned long long mk = __ballot(C.lane < NE && rank == k); const int src = (int)__builtin_ctzll(mk | (1ull << 63)); sv[k] = __int_as_float(__builtin_amdgcn_readlane(vb, src)); }
            const float e1 = __expf(sv[1] - sv[0]), e2 = __expf(sv[2] - sv[0]), e3 = __expf(sv[3] - sv[0]); const float inv = __builtin_amdgcn_rcpf(1.0f + e1 + e2 + e3);
            rk[i] = sel ? rank : -1; pp[i] = 0u;
            if (sel) { pp[i] = __hip_atomic_fetch_add((LAS unsigned*)(C.lds + MISC_OFF) + 80 + C.lane, 1u, __ATOMIC_RELAXED, __HIP_MEMORY_SCOPE_WORKGROUP);
                ((GAS float*)C.PAIR())[((size_t)r * 4 + rank) * 2 + 1] = __expf(v - sv[0]) * inv; } }
        __syncthreads();
        if (C.tid < NE) { const unsigned n = lhist[C.tid]; lbase[C.tid] = n ? __hip_atomic_fetch_add(cnt + C.tid * 64, n, RLX_AGENT) : 0u; }
        __syncthreads();
        const unsigned mybase = C.lane < NE ? lbase[C.lane] : 0u;
#pragma unroll
        for (int i = 0; i < 8; ++i) if (rk[i] >= 0) { const int r = tile * 64 + C.wave * 8 + i; const unsigned pos = mybase + pp[i];
            ((GAS unsigned*)C.PAIR())[((size_t)r * 4 + rk[i]) * 2] = (unsigned)C.lane | (pos << 5);
            C.TOK()[(size_t)C.lane * T + pos] = r; }
    }
    __syncthreads();
}

__device__ __forceinline__ void phase_gather(const Ctx& C, const Args& A, int l) {
    moe_tables(C, l, true);
    const LAS unsigned char* t2e = (const LAS unsigned char*)(C.lds + T2E_OFF);
    const int nslot = (int)C.MISC[NE] * 256;
    constexpr int RB = MK_FP8 ? 1024 : 2048, NV = RB / 1024;
    const unsigned char* srcb = MK_FP8 ? (const unsigned char*)C.HB8() : (const unsigned char*)C.HB();
    unsigned char* dstb = (unsigned char*)C.HP();
    for (int s0 = C.gw * 16; s0 < nslot; s0 += C.ngw * 16) { const unsigned e = t2e[s0 >> 8]; const unsigned pos0 = (unsigned)s0 - C.MISC[e] * 256u; const unsigned cnt = C.MISC[40 + e];
        int tk = -1; if (C.lane < 16 && pos0 + C.lane < cnt) tk = C.TOK()[(size_t)e * T + pos0 + C.lane];
        v4u v[16][NV];
#pragma unroll
        for (int u = 0; u < 16; ++u) { const int r = __builtin_amdgcn_readlane(tk, u);
            if (r >= 0) { const GAS v4u* src = (const GAS v4u*)(srcb + (size_t)r * RB) + C.lane;
#pragma unroll
                for (int q = 0; q < NV; ++q) v[u][q] = src[64 * q]; } }
#pragma unroll
        for (int u = 0; u < 16; ++u) { const int r = __builtin_amdgcn_readlane(tk, u);
            if (r >= 0) { GAS v4u* dst = (GAS v4u*)(dstb + (size_t)(s0 + u) * RB) + C.lane;
#pragma unroll
                for (int q = 0; q < NV; ++q) dst[64 * q] = v[u][q]; } }
    }
}

__global__ void __launch_bounds__(NWAVES * 64, 2) mk_fwd(Args args) {
    extern __shared__ __attribute__((aligned(16))) unsigned char lds_raw[];
    Ctx C;
    C.lds = (LAS unsigned char*)lds_raw; C.MISC = (volatile LAS unsigned*)(C.lds + MISC_OFF);
    C.tid = threadIdx.x; C.lane = C.tid & 63; C.wave = __builtin_amdgcn_readfirstlane(C.tid >> 6);
    C.G = gridDim.x; { const int bx = blockIdx.x; C.vcu = (C.G % 8 == 0) ? (bx % 8) * (C.G / 8) + bx / 8 : bx; }
    C.gw = C.vcu * NWAVES + C.wave; C.ngw = C.G * NWAVES;
    C.ws = (GAS unsigned char*)args.ws; C.ctl = (gu32*)(C.ws + WS_CTL);
    for (int u = C.tid; u < (LDS_BYTES - MISC_OFF) / 4; u += NWAVES * 64) ((LAS unsigned*)(C.lds + MISC_OFF))[u] = 0u;
    __syncthreads();
    const int lo = args.ph_lo, hi = args.ph_hi;
    const bool multi = (hi - lo) > 1;
    XcdBarrier bar; bar.bar = (unsigned*)(C.ctl + CW_BAR); bar.x = 0; bar.st = C.MISC + 160;
    if (multi) bar = xcd_barrier_post((unsigned*)(C.ctl + CW_BAR), C.MISC + 160);
#ifndef MK_PHMASK
#define MK_PHMASK 0xFFFF
#endif
#define IN(k) (lo <= (k) && (k) < hi)
#ifndef MK_STAMP
#define MK_STAMP -1
#endif
    unsigned long long tacc = 0ull, tst = 0ull;
#define T0(k) do { if (MK_STAMP == (k)) tst = __builtin_amdgcn_s_memrealtime(); } while (0)
#define T1(k) do { if (MK_STAMP == (k)) tacc += __builtin_amdgcn_s_memrealtime() - tst; } while (0)
#define FRESH() do { asm volatile("" : "+v"(C.tid), "+v"(C.lane)); asm volatile("" : "+s"(C.wave), "+s"(C.vcu), "+s"(C.gw), "+s"(C.ws), "+s"(C.ctl)); } while (0)
#define EN(k) ((MK_PHMASK >> (k)) & 1)
#ifndef MK_DUP
#define MK_DUP 0
#endif
#define NREP(k) (((MK_DUP >> (k)) & 1) ? 2 : 1)
#define SEAM(k) do { if (IN((k) + 1)) xcd_barrier(bar); } while (0)

    if (EN(12) && IN(0)) { _Pragma("unroll") for (int rep = 0; rep < NREP(12); ++rep) phase_prologue(C, args); SEAM(0); }
    __syncthreads();
    for (int u = C.tid; u < 64 * 16; u += NWAVES * 64) { const int pos = u >> 4, i = u & 15; const float inv = powf(10000.0f, -(float)(2 * i) / 32.0f); const float ang = (float)pos * inv;
        ((LAS f32x2*)(C.lds + ROPE_OFF))[u] = (f32x2){cosf(ang), sinf(ang)}; }
    __syncthreads();
    for (int l = 0; l < NL; ++l) {
        const int pb = 1 + l * PPL;
        if (EN(0) && IN(pb + 0)) { FRESH(); T0(0); phase_premix(C, args, l); SEAM(pb + 0); T1(0); }
        if (EN(1) && IN(pb + 1)) { FRESH(); T0(1);
            { LAS float* gl = (LAS float*)(C.lds + T2E_OFF); const float* gq = ldin<9>() + l * 64; const float* gk = ldin<10>() + l * 64;
              __syncthreads(); if (C.tid < 128) gl[C.tid] = C.tid < 64 ? gq[C.tid] : gk[C.tid - 64]; __syncthreads(); }
#if MK_FP8_IN == 2
            {
                pg8::Gemm g8{(const pg8::bf16_t*)C.HB8(), (const pg8::bf16_t*)((const unsigned char*)C.HP() + (size_t)l * INW * D), T, 768, D / 2}; pg8::StaticOrder S8; S8.init(T, 768, C.G, (int)blockIdx.x);
                pg8::EpiInProj E8{C.P(), (const LAS float*)(C.lds + ROPE_OFF), (const LAS float*)(C.lds + T2E_OFF), attn_body::C2, 0};
                pg8::gemm_phase<pg8::EpiInProj, pg8::StaticOrder, true, true, true>(C.lds, g8, S8, E8);
                pg8::Gemm g{C.HB(), C.WINT() + ((size_t)l * INW + 768) * D, T, 1280, D}; pg8::StaticOrder S; S.init(T, 1280, C.G, (int)blockIdx.x);
                pg8::EpiInProj E{C.P(), (const LAS float*)(C.lds + ROPE_OFF), (const LAS float*)(C.lds + T2E_OFF), attn_body::C2, 3};
                pg8::gemm_phase<pg8::EpiInProj, pg8::StaticOrder, true, true>(C.lds, g, S, E);
            }
#else
#if MK_FP8_IN == 1
            pg8::Gemm g{C.HB(), (const pg8::bf16_t*)((const unsigned char*)C.WINT() + (size_t)l * INW * D), T, INW, D / 2}; pg8::StaticOrder S; S.init(T, INW, C.G, (int)blockIdx.x);
#else
            pg8::Gemm g{C.HB(), C.WINT() + (size_t)l * INW * D, T, INW, D}; pg8::StaticOrder S; S.init(T, INW, C.G, (int)blockIdx.x);
#endif
            pg8::EpiInProj E{C.P(), (const LAS float*)(C.lds + ROPE_OFF), (const LAS float*)(C.lds + T2E_OFF), attn_body::C2, 0};
_Pragma("unroll") for (int rep = 0; rep < NREP(1); ++rep)
            pg8::gemm_phase<pg8::EpiInProj, pg8::StaticOrder, true, true, MK_FP8_IN == 1>(C.lds, g, S, E);
#endif
            { FRESH(); tail_convert(C, l, NROWT * (INW / 256), CV_HEAD); }
            SEAM(pb + 1); T1(1); }
        if (EN(3) && IN(pb + 3)) { FRESH(); T0(3); _Pragma("unroll") for (int rep = 0; rep < NREP(3); ++rep) phase_attn(C, l); phase_conv1(C, args, l); FRESH(); phase_conv2(C, args, l); SEAM(pb + 3); T1(3); }
        if (EN(5) && IN(pb + 5)) { FRESH(); T0(5);
            pg8::Gemm g{C.Y(), C.WOUTT() + (size_t)l * D * D, T, D, D};
            pg8::EpiGate E{C.OB(), C.MOD() + (size_t)l * 17 * MODW + 2 * D, C.X()};
            if (l + 1 < NL) { pg8::StaticOrder S; S.init(T, D, C.G, (int)blockIdx.x); pg8::gemm_phase<pg8::EpiGate, pg8::StaticOrder, true, true>(C.lds, g, S, E); }
            else { pg8::LatentOrder S; S.init(NB * SQ, D, C.G, (int)blockIdx.x); pg8::gemm_phase<pg8::EpiGate, pg8::LatentOrder, true, true>(C.lds, g, S, E); }
            { FRESH(); tail_convert(C, l, (l + 1 < NL ? NROWT : NB * SQ / 256) * (D / 256), CV_HEAD + tail_items(NROWT * (INW / 256), C.G)); }
            SEAM(pb + 5); T1(5); }
        if (EN(6) && IN(pb + 6)) { FRESH(); T0(6); _Pragma("unroll") for (int rep = 0; rep < NREP(6); ++rep) phase_premoe(C, args, l); SEAM(pb + 6); T1(6); }
        if (EN(10) && IN(pb + 10)) { FRESH(); T0(10);
            moe_tables(C, l, true);
#if MK_FP8
            pg8::Gemm g{(const pg8::bf16_t*)C.HB8(), (const pg8::bf16_t*)((const unsigned char*)C.W1T() + (size_t)l * NE * 2048 * D), CAP, NE * 2048, D / 2};
            pg8::MoeOrder S; S.init((int)C.MISC[NE], 8, C.G, (int)blockIdx.x, (const LAS unsigned char*)(C.lds + T2E_OFF)); S.tok = C.TOK(); S.tstride = T; S.tab = C.MISC;
            pg8::EpiSwiglu8 E{(unsigned char*)C.ACT(), C.B1P() + (size_t)l * NE * 2048};
_Pragma("unroll") for (int rep = 0; rep < NREP(10); ++rep)
            pg8::gemm_phase<pg8::EpiSwiglu8, pg8::MoeOrder, true, true, true, 0x7A7A7A7A, true>(C.lds, g, S, E);
#else
            pg8::Gemm g{C.HP(), C.W1T() + (size_t)l * NE * 2048 * D, CAP, NE * 2048, D};
            pg8::MoeOrder S; S.init((int)C.MISC[NE], 8, C.G, (int)blockIdx.x, (const LAS unsigned char*)(C.lds + T2E_OFF));
            pg8::EpiSwiglu E{C.ACT(), C.B1P() + (size_t)l * NE * 2048};
            pg8::gemm_phase<pg8::EpiSwiglu, pg8::MoeOrder, true, true>(C.lds, g, S, E);
#endif
            SEAM(pb + 10); T1(10); }
        if (EN(11) && IN(pb + 11)) { FRESH(); T0(11);
            moe_tables(C, l, true);
#if MK_FP8
            pg8::Gemm g{C.ACT(), (const pg8::bf16_t*)((const unsigned char*)C.W2T() + (size_t)l * NE * D * D), CAP, NE * D, D / 2};
            pg8::MoeOrder S; S.init((int)C.MISC[NE], 4, C.G, (int)blockIdx.x, (const LAS unsigned char*)(C.lds + T2E_OFF)); S.rev = true;
            pg8::EpiDown E{(unsigned char*)C.YP(), ldin<23>() + (size_t)l * NE * D};
_Pragma("unroll") for (int rep = 0; rep < NREP(11); ++rep)
            pg8::gemm_phase<pg8::EpiDown, pg8::MoeOrder, true, true, true, 0x7D7D7D7D>(C.lds, g, S, E);
#else
            pg8::Gemm g{C.ACT(), C.W2T() + (size_t)l * NE * D * D, CAP, NE * D, D};
            pg8::MoeOrder S; S.init((int)C.MISC[NE], 4, C.G, (int)blockIdx.x, (const LAS unsigned char*)(C.lds + T2E_OFF)); S.rev = true;
            pg8::EpiDown E{(unsigned char*)C.YP(), ldin<23>() + (size_t)l * NE * D};
            pg8::gemm_phase<pg8::EpiDown, pg8::MoeOrder, true, true>(C.lds, g, S, E);
#endif
            SEAM(pb + 11); T1(11); }
    }
    if (EN(13) && IN(NPHASE - 1)) { FRESH(); T0(13); phase_final(C, args); T1(13); }
    if (MK_STAMP >= 0 && blockIdx.x == 0 && C.tid == 0) { asm volatile("s_waitcnt vmcnt(0)" ::: "memory"); ldout()[5] = (float)tacc * 0.001f; }
#undef IN
#undef SEAM
}
}


#if defined(MK_DEBUG)
namespace mkdbg {
using namespace mk;
constexpr size_t WS_DBG = 3420 * MiB;
__device__ const int SROWS[12] = {0, 1, 63, 64, 255, 256, 4095, 4096, 4351, 4352, 30000, 69631};
__device__ __forceinline__ float bfv(const bf16* p, size_t i) { return __builtin_bit_cast(float, (unsigned)p[i] << 16); }
__device__ __forceinline__ void report(float* err, int s, float got, float ref, float atol) {
    float e = fabsf(got - ref) / (fabsf(ref) + atol); if (!(e == e)) e = 100.f;
    atomicMax((unsigned*)err + s, __builtin_bit_cast(unsigned, e));
}
__device__ __forceinline__ void row_info(int r, int& b, int& t, int& j) { b = r / SEG; t = r - b * SEG; j = t < SQ ? b : 16; }
__device__ __forceinline__ float silu_(float v) { return v / (1.f + expf(-v)); }
__device__ __forceinline__ float sigm_(float v) { return 1.f / (1.f + expf(-v)); }
__device__ __forceinline__ void naive_attn(const bf16* P, int r, int h, float* q, float* o) {
    int b, t, j; row_info(r, b, t, j);
    const int k0 = t < SQ ? b * SEG : b * SEG + SQ, nk = t < SQ ? SEG : CL;
    for (int d = 0; d < 64; ++d) q[d] = bfv(P, (size_t)r * INW + h * 64 + d);
    float m = -1e30f;
    for (int kk = 0; kk < nk; ++kk) { float s = 0.f; for (int d = 0; d < 64; ++d) s += q[d] * bfv(P, (size_t)(k0 + kk) * INW + 512 + (h >> 2) * 64 + d); m = fmaxf(m, s); }
    float l = 0.f; for (int d = 0; d < 64; ++d) o[d] = 0.f;
    for (int kk = 0; kk < nk; ++kk) { float s = 0.f; for (int d = 0; d < 64; ++d) s += q[d] * bfv(P, (size_t)(k0 + kk) * INW + 512 + (h >> 2) * 64 + d);
        const float p = exp2f(s - m); l += p; for (int d = 0; d < 64; ++d) o[d] += p * bfv(P, (size_t)(k0 + kk) * INW + 640 + (h >> 2) * 64 + d); }
    for (int d = 0; d < 64; ++d) o[d] /= l;
}
__device__ const int DBG_LS_1[2] = {0, 3};
__device__ const int DBG_JS_2[3] = {0, 7, 16};
__device__ const int DBG_NS_3[4] = {0, 1000, 2053, 6143};
__device__ const int DBG_CS_4[4] = {0, 1, 511, 1023};
__device__ const int DBG_CS_5[16] = {0, 63, 64, 511, 512, 575, 639, 640, 767, 768, 1024, 1279, 1280, 1536, 1792, 2047};
__device__ const int DBG_HS_6[4] = {0, 7, 8, 9};
__device__ const int DBG_HS_7[2] = {0, 5};
__device__ const int DBG_CS_8[4] = {0, 255, 256, 1023};
__device__ const int DBG_ES_9[3] = {0, 7, 31};
__device__ const int DBG_CS_10[3] = {0, 500, 1023};
__device__ const int DBG_CS_11[4] = {0, 127, 128, 1023};
__device__ const int DBG_CS_12[4] = {0, 300, 511, 1023};
__device__ const int DBG_CS_13[4] = {0, 300, 511, 1023};
__device__ const int DBG_CS_14[4] = {0, 300, 511, 1023};
__global__ void __launch_bounds__(256) dbg_kernel(Args a, int stage) {
    unsigned char* ws = a.ws; float* err = (float*)(ws + WS_DBG); float* scr = err + 256;
    const float* MOD = (const float*)(ws + WS_MOD); const bf16* HB = (const bf16*)(ws + WS_HB); const bf16* P = (const bf16*)(ws + WS_P); const bf16* Y = (const bf16*)(ws + WS_Y);
    const float* X = (const float*)(ws + WS_X); const float* LOG = (const float*)(ws + WS_LOG); const v2u* PAIR = (const v2u*)(ws + WS_PAIR); const int* TOK = (const int*)(ws + WS_TOK);
    const bf16* HP = (const bf16*)(ws + WS_HP); const bf16* ACT = (const bf16*)(ws + WS_ACT); const bf16* YP = (const bf16*)(ws + WS_YP);
    const unsigned* cnt = (const unsigned*)(ws + WS_CTL) + CW_CNT;
    const int tid = threadIdx.x;
    __shared__ float shm[15360]; __shared__ unsigned tstart[33];
    if (stage == 0) { if (tid < 64) err[tid] = 0.f; return; }
    if (stage == 1) {
        const int* ls = DBG_LS_1; const int* js = DBG_JS_2; const int* ns = DBG_NS_3;
        if (tid < 24) { const int l = ls[tid / 12], j = js[(tid / 4) % 3], n = ns[tid % 4]; float s = 0.f;
            for (int k = 0; k < 1024; ++k) { const float c = j < 16 ? a.in[1][j * 1024 + k] : a.in[3][k]; s += silu_(c) * a.in[4][((size_t)l * 1024 + k) * MODW + n]; }
            s += a.in[5][l * MODW + n]; report(err, 1, MOD[((size_t)l * 17 + j) * MODW + n], s, 0.05f); }
        return; }
    if (stage == 2 || stage == 8) {
        const int* cs = DBG_CS_4;
        if (tid < 48) { const int r = SROWS[tid / 4], c = cs[tid % 4]; int b, t, j; row_info(r, b, t, j);
            const float* xr = stage == 2 ? (t < SQ ? a.in[0] + ((size_t)b * SQ + t) * D : a.in[2] + ((size_t)b * CL + (t - SQ)) * D) : X + (size_t)r * D;
            float ss = 0.f; for (int k = 0; k < D; ++k) ss += xr[k] * xr[k];
            const float rs = 1.f / sqrtf(ss / D + EPS); const float* g = stage == 2 ? a.in[6] : a.in[7]; const float* mj = MOD + (size_t)j * MODW + (stage == 2 ? 0 : 3 * D);
            const float h = xr[c] * rs * g[c] * (1.f + mj[D + c]) + mj[c];
            report(err, stage, bfv(HB, (size_t)r * D + c), h, 0.05f);
            if (stage == 2) report(err, stage, X[(size_t)r * D + c], xr[c], 0.01f); }
        return; }
    if (stage == 3) {
        const int* cs = DBG_CS_5;
        if (tid < 192) { const int r = SROWS[tid / 16], c = cs[tid % 16]; float s = 0.f;
            for (int k = 0; k < D; ++k) s += bfv(HB, (size_t)r * D + k) * a.in[8][(size_t)k * INW + c];
            report(err, 3, bfv(P, (size_t)r * INW + c), s, 0.05f); }
        return; }
    if (stage == 4) {
        const int* hs = DBG_HS_6;
        if (tid < 48) { const int r = SROWS[tid / 4], h = hs[tid % 4]; int b, t, j; row_info(r, b, t, j);
            float* raw = shm + tid * 128; float* o = raw + 64; float ss = 0.f;
            for (int d = 0; d < 64; ++d) { float s = 0.f; for (int k = 0; k < D; ++k) s += bfv(HB, (size_t)r * D + k) * a.in[8][(size_t)k * INW + h * 64 + d]; raw[d] = s; ss += s * s; }
            const float rs = 1.f / sqrtf(ss / 64.f + EPS); const float* g = h < 8 ? a.in[9] : a.in[10];
            for (int d = 0; d < 64; ++d) raw[d] = raw[d] * rs * g[d];
            for (int ax = 0; ax < 2; ++ax) for (int i = 0; i < 16; ++i) { const float pos = ax == 0 ? (float)(t / 64) : (float)(t % 64); const float ang = pos * powf(10000.f, -(float)(2 * i) / 32.f);
                const float c = t < SQ ? cosf(ang) : 1.f, s = t < SQ ? sinf(ang) : 0.f; const float x1 = raw[ax * 32 + i], x2 = raw[ax * 32 + 16 + i];
                o[ax * 32 + i] = x1 * c - x2 * s; o[ax * 32 + 16 + i] = x2 * c + x1 * s; }
            for (int d = 0; d < 64; ++d) { const float ref = o[d] * (h < 8 ? 0.125f * 1.4426950408889634f : 1.f); report(err, 4, bfv(P, (size_t)r * INW + h * 64 + d), ref, h < 8 ? 0.045f : 0.25f); } }
        return; }
    if (stage == 5) {
        const int* hs = DBG_HS_7;
        if (tid < 24) { const int r = SROWS[tid / 2], h = hs[tid % 2]; float* o = shm + tid * 128; naive_attn(P, r, h, o + 64, o);
            for (int d = 0; d < 64; ++d) report(err, 5, bfv(Y, (size_t)r * D + h * 64 + d), o[d], 0.05f); }
        return; }
    if (stage == 6) {
        if (tid < 12) { const int r = SROWS[tid]; int b, t, j; row_info(r, b, t, j); const int lo = t < SQ ? 0 : SQ, hi = t < SQ ? SQ : SEG; const size_t rb = (size_t)b * SEG;
            float* u = shm + tid * 256; float mean = 0.f;
            for (int c = 0; c < 256; ++c) { float s = a.in[12][c];
                for (int jt = 0; jt < 31; ++jt) { const int tt = t + jt - 15; if (tt >= lo && tt < hi) s += a.in[11][jt * 256 + c] * bfv(P, (rb + tt) * INW + 768 + c) * sigm_(bfv(P, (rb + tt) * INW + 1024 + c)); }
                u[c] = s; mean += s; }
            mean /= 256.f; float var = 0.f; for (int c = 0; c < 256; ++c) var += (u[c] - mean) * (u[c] - mean); var /= 256.f;
            float ss = 0.f; for (int c = 0; c < 256; ++c) { const float y = (u[c] - mean) / sqrtf(var + EPS) * a.in[13][c] + a.in[14][c]; u[c] = silu_(y); ss += u[c] * u[c]; }
            float rs = 1.f / sqrtf(ss / 256.f + EPS);
            for (int c = 0; c < 256; ++c) report(err, 6, bfv(Y, (size_t)r * D + 512 + c), u[c] * rs * a.in[16][512 + c], 0.25f);
            ss = 0.f;
            for (int c = 0; c < 256; ++c) { float s = 0.f; for (int jt = 0; jt < 3; ++jt) { const int tt = t + jt - 1; if (tt >= lo && tt < hi) s += a.in[15][jt * 256 + c] * bfv(P, (rb + tt) * INW + 1536 + c) * bfv(P, (rb + tt) * INW + 1792 + c); }
                u[c] = bfv(P, (size_t)r * INW + 1280 + c) * s; ss += u[c] * u[c]; }
            rs = 1.f / sqrtf(ss / 256.f + EPS);
            for (int c = 0; c < 256; ++c) report(err, 7, bfv(Y, (size_t)r * D + 768 + c), u[c] * rs * a.in[16][768 + c], 0.25f); }
        if (tid >= 64 && tid < 80) { const int r = SROWS[(tid - 64) / 8 == 0 ? 2 : 7], h = (tid - 64) % 8; float* o = shm + 3072 + (tid - 64) * 128; naive_attn(P, r, h, o + 64, o);
            for (int d = 0; d < 64; ++d) scr[((tid - 64) / 8) * 512 + h * 64 + d] = o[d]; }
        __syncthreads();
        if (tid < 2) { const int r = SROWS[tid == 0 ? 2 : 7]; float ss = 0.f; for (int c = 0; c < 512; ++c) ss += scr[tid * 512 + c] * scr[tid * 512 + c];
            const float rs = 1.f / sqrtf(ss / 512.f + EPS); for (int c = 0; c < 512; ++c) report(err, 6, bfv(Y, (size_t)r * D + c), scr[tid * 512 + c] * rs * a.in[16][c], 0.25f); }
        return; }
    if (stage == 9) {
        const int* cs = DBG_CS_8;
        if (tid < 48) { const int r = SROWS[tid / 4], c = cs[tid % 4]; int b, t, j; row_info(r, b, t, j);
            const float* xr = t < SQ ? a.in[0] + ((size_t)b * SQ + t) * D : a.in[2] + ((size_t)b * CL + (t - SQ)) * D;
            float s = 0.f; for (int k = 0; k < D; ++k) s += bfv(Y, (size_t)r * D + k) * a.in[17][(size_t)k * D + c];
            report(err, 9, X[(size_t)r * D + c], xr[c] + MOD[(size_t)j * MODW + 2 * D + c] * s, 0.05f); }
        return; }
    if (stage == 10) {
        const int* es = DBG_ES_9;
        if (tid < 36) { const int r = SROWS[tid / 3], e = es[tid % 3]; float s = 0.f; for (int k = 0; k < D; ++k) s += bfv(HB, (size_t)r * D + k) * a.in[18][(size_t)k * NE + e];
            report(err, 10, LOG[(size_t)r * NE + e], s, 0.05f); }
        return; }
    if (stage == 11) {
        if (tid < 12) { const int r = SROWS[tid]; float* v = shm + tid * 32; for (int e = 0; e < 32; ++e) v[e] = LOG[(size_t)r * NE + e] + a.in[19][e];
            float* sv = shm + 1024 + tid * 8; float* sef = sv + 4;
            for (int k = 0; k < 4; ++k) { int bi = 0; for (int e = 1; e < 32; ++e) if (v[e] > v[bi]) bi = e; sef[k] = (float)bi; sv[k] = v[bi]; v[bi] = -1e30f; }
            float den = 0.f; for (int k = 0; k < 4; ++k) den += expf(sv[k] - sv[0]);
            { float* vv = shm + 2048 + tid * 32; for (int e = 0; e < 32; ++e) vv[e] = LOG[(size_t)r * NE + e] + a.in[19][e];
              float mx = -1e30f, dn = 0.f; for (int k = 0; k < 4; ++k) mx = fmaxf(mx, vv[PAIR[(size_t)r * 4 + k].x & 31]); for (int k = 0; k < 4; ++k) dn += expf(vv[PAIR[(size_t)r * 4 + k].x & 31] - mx);
              for (int k = 0; k < 4; ++k) report(err, 22, __uint_as_float((unsigned)(PAIR[(size_t)r * 4 + k].y + 0u)), expf(vv[PAIR[(size_t)r * 4 + k].x & 31] - mx) / dn, 0.01f); }
            for (int k = 0; k < 4; ++k) { const v2u pr = PAIR[(size_t)r * 4 + k]; const int e = pr.x & 31; const unsigned pos = pr.x >> 5;
                if (tid == 0 && (k == 0 || k == 3)) { err[30 + (k ? 2 : 0)] = __uint_as_float((unsigned)(pr.y + 0u)); err[31 + (k ? 2 : 0)] = expf(sv[k] - sv[0]) / den; }
                report(err, 17, (float)e == sef[k] ? 0.f : 1.f, 0.f, 1.0f); report(err, 18, __uint_as_float((unsigned)(pr.y + 0u)), expf(sv[k] - sv[0]) / den, 0.01f);
                const unsigned c = cnt[e * 64]; report(err, 19, pos < c ? 1.f : 0.f, 1.f, 0.001f); report(err, 20, (float)TOK[(size_t)e * T + (pos < (unsigned)T ? pos : 0)], (float)r, 0.001f); } }
        if (tid == 255) { unsigned s = 0; for (int e = 0; e < 32; ++e) s += cnt[e * 64]; report(err, 21, (float)s, (float)(T * 4), 0.001f); }
        if (tid == 253) { int c = 0; const float* pf = (const float*)PAIR; for (int q = 0; q < 64; ++q) { const float w = pf[q * 2 + 1]; if (w > 0.01f && w <= 1.f) ++c; } err[44] = (float)c; }
        if (tid == 254) { for (int k = 0; k < 4; ++k) { const float w = __uint_as_float((unsigned)(PAIR[k].y + 0u)); err[40 + k] = (float)(!(w == w) || w < 0.f || w > 1.f ? 3 : w < 1e-30f ? 0 : w < 0.05f ? 1 : 2); } }
        return; }
    if (tid == 0) { unsigned s = 0; for (int e = 0; e < 32; ++e) { tstart[e] = s; s += (cnt[e * 64] + 255u) >> 8; } tstart[32] = s; }
    __syncthreads();
    if (stage == 12) {
        const int* cs = DBG_CS_10;
        if (tid < 48) { const int r = SROWS[tid / 4], k = tid % 4; const v2u pr = PAIR[(size_t)r * 4 + k]; const size_t slot = (size_t)tstart[pr.x & 31] * 256 + (pr.x >> 5);
            for (int i = 0; i < 3; ++i) report(err, 12, bfv(HP, slot * D + cs[i]), bfv(HB, (size_t)r * D + cs[i]), 0.001f); }
        return; }
    if (stage == 13) {
        const int* cs = DBG_CS_11;
        if (tid < 192) { const int r = SROWS[tid / 16], k = (tid / 4) % 4, c = cs[tid % 4]; const v2u pr = PAIR[(size_t)r * 4 + k]; const int e = pr.x & 31; const size_t slot = (size_t)tstart[e] * 256 + (pr.x >> 5);
            float ug = a.in[21][(size_t)e * 2048 + 2 * c], uu = a.in[21][(size_t)e * 2048 + 2 * c + 1]; const float* w = a.in[20] + (size_t)e * 1024 * 2048;
            for (int kk = 0; kk < D; ++kk) { const float hv = bfv(HP, slot * D + kk); ug += hv * w[(size_t)kk * 2048 + 2 * c]; uu += hv * w[(size_t)kk * 2048 + 2 * c + 1]; }
            const float gc = fminf(ug, 7.f), uc = fminf(fmaxf(uu, -7.f), 7.f); const float ref = (uc + 1.f) * gc * sigm_(1.702f * gc);
            report(err, 13, bfv(ACT, slot * D + c), ref, 0.25f); }
        return; }
    if (stage == 14) {
        const int* cs = DBG_CS_12;
        if (tid < 192) { const int r = SROWS[tid / 16], k = (tid / 4) % 4, c = cs[tid % 4]; const v2u pr = PAIR[(size_t)r * 4 + k]; const int e = pr.x & 31; const size_t slot = (size_t)tstart[e] * 256 + (pr.x >> 5);
            float s = a.in[23][(size_t)e * 1024 + c]; const float* w = a.in[22] + (size_t)e * 1024 * 1024;
            for (int kk = 0; kk < D; ++kk) s += bfv(ACT, slot * D + kk) * w[(size_t)kk * 1024 + c];
            report(err, 14, bfv(YP, slot * D + c), s, 0.25f); }
        return; }
    if (stage == 15) {
        const int* cs = DBG_CS_13;
        if (tid < 48) { const int r = SROWS[tid / 4], c = cs[tid % 4]; int b, t, j; row_info(r, b, t, j); float f = 0.f;
            for (int k = 0; k < 4; ++k) { const v2u pr = PAIR[(size_t)r * 4 + k]; const size_t slot = (size_t)tstart[pr.x & 31] * 256 + (pr.x >> 5); f += __uint_as_float((unsigned)(pr.y + 0u)) * bfv(YP, slot * D + c); }
            scr[2048 + tid] = X[(size_t)r * D + c] + MOD[(size_t)j * MODW + 5 * D + c] * f; }
        return; }
    if (stage == 16) {
        const int* cs = DBG_CS_14;
        if (tid < 48) { const int r = SROWS[tid / 4], c = cs[tid % 4]; report(err, 16, X[(size_t)r * D + c], scr[2048 + tid], 0.02f); }
        return; }
    if (stage == 99) {
        if (tid == 0) {
#if MK_DEBUG == 3
            a.out[0] = (err[44] + 1.f) * 1e20f; return;
#endif
#if MK_DEBUG == 2
            { const float* db = err + 4096; const v2u* PR = (const v2u*)(a.ws + WS_PAIR); int code = 0;
              auto close = [](float x, float y) { return fabsf(x - y) <= 1e-3f * (fabsf(y) + 1e-3f); };
              for (int ln = 0; ln < 4 && !code; ++ln) for (int j = 0; j < 4; ++j) if (!(db[ln * 16 + j] == db[j])) { code = 10 + ln; break; }
              if (!code) for (int j = 0; j < 3; ++j) if (!(db[j] >= db[j + 1])) code = 20 + j;
              if (!code) for (int ln = 0; ln < 4 && !code; ++ln) for (int j = 0; j < 3; ++j) if (!close(db[ln * 16 + 4 + j], expf(db[j + 1] - db[0]))) { code = 30 + ln; break; }
              if (!code) for (int ln = 0; ln < 4; ++ln) if (!close(db[ln * 16 + 7], 1.f + db[ln * 16 + 4] + db[ln * 16 + 5] + db[ln * 16 + 6])) { code = 40 + ln; break; }
              if (!code) for (int ln = 0; ln < 4; ++ln) if (!close(db[ln * 16 + 8], 1.f / db[ln * 16 + 7])) { code = 50 + ln; break; }
              if (!code) for (int ln = 0; ln < 4; ++ln) if (!close(db[ln * 16 + 9], (ln == 0 ? 1.f : db[ln * 16 + 3 + ln]) * db[ln * 16 + 8])) { code = 60 + ln; break; }
              if (!code) for (int ln = 0; ln < 4; ++ln) if (!close(__uint_as_float((unsigned)(PR[ln].y + 0u)), db[ln * 16 + 9])) { code = 70 + ln; break; }
              if (!code) code = 88;
              a.out[0] = (float)code * 1e20f; return; }
#endif
            int mask = 0; for (int i = 0; i < 6; ++i) if (err[17 + i] > 0.06f) mask |= 1 << i; if (mask) err[11] = 1.f;
            for (int s = 1; s < 17; ++s) if (err[s] > 0.06f) { if (s == 11) { a.out[0] = (float)(10 + mask) * 1e14f; break; } a.out[0] = (1.f + 10.f * fminf(err[s], 0.89f)) * powf(10.f, (float)(4 + s)); break; } }
        return; }
}
}
#endif
#ifndef MK_ONE_LAUNCH
#define MK_ONE_LAUNCH 1
#endif
extern "C" void kernel_launch(void* const* d_in, const int* in_sizes, int n_in, void* d_out, int out_size, void* d_ws, size_t ws_size, hipStream_t stream) {
    using namespace mk;
    static int grid = 0;
    if (grid == 0) {
        if (n_in != 24 || out_size != NB * SQ * D || ws_size < WS_END) { fprintf(stderr, "kernel_launch: unexpected shapes (n_in %d, out %d, ws %zu)\n", n_in, out_size, ws_size); grid = -1; return; }
        int dev = 0, cus = 0, per_cu = 0;
        if (hipGetDevice(&dev) != hipSuccess || hipDeviceGetAttribute(&cus, hipDeviceAttributeMultiprocessorCount, dev) != hipSuccess) { grid = -1; return; }
        if (hipFuncSetAttribute((const void*)mk_fwd, hipFuncAttributeMaxDynamicSharedMemorySize, LDS_BYTES) != hipSuccess) { fprintf(stderr, "kernel_launch: hipFuncSetAttribute failed\n"); grid = -1; return; }
        if (hipOccupancyMaxActiveBlocksPerMultiprocessor(&per_cu, (const void*)mk_fwd, NWAVES * 64, LDS_BYTES) != hipSuccess || per_cu < 1) { fprintf(stderr, "kernel_launch: occupancy query says %d\n", per_cu); per_cu = 1; }
        (void)hipGetLastError();
        grid = cus;
    }
    if (grid < 0) return;
    (void)hipMemsetAsync((char*)d_ws + WS_CTL, 0, CTL_ZERO_BYTES, stream);
    Args a{};
    for (int i = 0; i < 24; ++i) a.in[i] = (const float*)d_in[i];
    a.out = (float*)d_out; a.ws = (unsigned char*)d_ws;
#if MK_ONE_LAUNCH
    a.ph_lo = 0; a.ph_hi = NPHASE;
    hipLaunchKernelGGL(mk_fwd, dim3(grid), dim3(NWAVES * 64), LDS_BYTES, stream, a);
#else
#if defined(MK_DEBUG)
#define DBG(s) hipLaunchKernelGGL(mkdbg::dbg_kernel, dim3(1), dim3(256), 0, stream, a, (s))
    DBG(0);
#else
#define DBG(s) do {} while (0)
#endif
    for (int p = 0; p < NPHASE; ++p) { a.ph_lo = p; a.ph_hi = p + 1; hipLaunchKernelGGL(mk_fwd, dim3(grid), dim3(NWAVES * 64), LDS_BYTES, stream, a);
        if (p == 0) DBG(1); if (p == 1) DBG(2); if (p == 2) DBG(3); if (p == 3) DBG(4); if (p == 4) DBG(5); if (p == 5) DBG(6); if (p == 6) DBG(9); if (p == 7) DBG(8); if (p == 8) DBG(10);
        if (p == 9) DBG(11); if (p == 10) DBG(12); if (p == 11) DBG(13); if (p == 12) { DBG(14); DBG(15); } if (p == 13) DBG(16); }
    DBG(99);
#endif
}
```

```cpp
#include <hip/hip_runtime.h>
#include <hip/hip_bf16.h>
#include <cstdio>
#include <cstdint>
#include <cmath>
namespace pg8 {
#define PG8_LAS __attribute__((address_space(3)))
typedef unsigned short bf16_t;
typedef short bf16x8 __attribute__((ext_vector_type(8)));
typedef float f32x4 __attribute__((ext_vector_type(4)));
typedef unsigned u32x4 __attribute__((ext_vector_type(4)));
typedef int i32x4 __attribute__((ext_vector_type(4)));
typedef int i32x8 __attribute__((ext_vector_type(8)));
typedef unsigned u32x2 __attribute__((ext_vector_type(2)));
constexpr int PG8_BIAS_OFF = 144384;
constexpr int PG8_IDX_OFF = PG8_BIAS_OFF + 2048;
constexpr int BM = 256, BK = 64, HALF = 128, HTB = HALF * BK * 2  , STAGE_BYTES = 8 * HTB, NXCD = 8, WGM = 8;

__host__ __device__ __forceinline__ int lds_byte(int r, int c) { const int st = (r >> 4) * 2 + (c >> 5), rr = r & 15, cc = c & 31, ob = rr * 64 + cc * 2; return st * 1024 + (ob ^ (((ob >> 9) & 1) << 5)); }
__host__ __device__ __forceinline__ void stage_rc(int b, int& R, int& C) { const int st = b / 1024, sb = b % 1024, swz = sb ^ (((sb >> 9) & 1) << 5); R = (st >> 1) * 16 + swz / 64; C = (st & 1) * 32 + (swz % 64) / 2; }
__host__ __device__ __forceinline__ int perm32(int rho) { const int n = rho >> 4, i = rho & 15; return 8 * (i >> 2) + 4 * n + (i & 3); }

__device__ __forceinline__ int shx(int v, int o) { int l = __builtin_amdgcn_mbcnt_hi(-1, __builtin_amdgcn_mbcnt_lo(-1, 0)); asm volatile("" : "+v"(l)); return __builtin_amdgcn_ds_bpermute((l ^ o) << 2, v); }
__device__ __forceinline__ float shx(float v, int o) { return __int_as_float(shx(__float_as_int(v), o)); }
template <int CTRL> __device__ __forceinline__ float dpp_f(float v) { return __int_as_float(__builtin_amdgcn_update_dpp(0, __float_as_int(v), CTRL, 0xF, 0xF, true)); }
__device__ __forceinline__ float sum_x16(float v) { const auto r = __builtin_amdgcn_permlane16_swap(__float_as_uint(v), __float_as_uint(v), false, false); return __uint_as_float(r[0]) + __uint_as_float(r[1]); }
__device__ __forceinline__ float sum_x32(float v) { const auto r = __builtin_amdgcn_permlane32_swap(__float_as_uint(v), __float_as_uint(v), false, false); return __uint_as_float(r[0]) + __uint_as_float(r[1]); }
__device__ __forceinline__ float get_x32(float v, bool lo_half) { const auto r = __builtin_amdgcn_permlane32_swap(__float_as_uint(v), __float_as_uint(v), false, false); return __uint_as_float(lo_half ? r[1] : r[0]); }
__device__ __forceinline__ float get_x16(float v, bool even_row) { const auto r = __builtin_amdgcn_permlane16_swap(__float_as_uint(v), __float_as_uint(v), false, false); return __uint_as_float(even_row ? r[1] : r[0]); }
__device__ __forceinline__ float wsum(float v) { v += dpp_f<0xB1>(v); v += dpp_f<0x4E>(v); v += dpp_f<0x141>(v); v += dpp_f<0x140>(v); v = sum_x16(v); return sum_x32(v); }
struct Unit { int pm, pn; };
struct Gemm { const bf16_t* A; const bf16_t* Bt; int M, N, K; };

struct StaticOrder {
    int nM, nN, nwg, G, c;
    __host__ __device__ void init(int M, int N, int G_, int c_) { nM = M / BM; nN = N / BM; nwg = nM * nN; G = G_; c = c_; }
    __host__ __device__ bool next(int i, Unit& u) const {
        const long L = (long)i * G + c; if (L >= nwg) return false;
        int wgid = (int)L; { const int q = nwg / NXCD, r = nwg % NXCD, xcd = wgid % NXCD, off = wgid / NXCD; wgid = (xcd < r ? xcd * (q + 1) : r * (q + 1) + (xcd - r) * q) + off; }
        const int nig = WGM * nN, gid = wgid / nig, fm = gid * WGM, gsz = (nM - fm) < WGM ? (nM - fm) : WGM;
        u.pm = fm + ((wgid % nig) % gsz); u.pn = (wgid % nig) / gsz; return true;
    }
    __device__ __forceinline__ void a_ready(const Unit&) const {}
    __device__ __forceinline__ void done(const Unit&) const {}
};

struct LatentOrder : StaticOrder {
    __host__ __device__ bool next(int i, Unit& u) const { if (!StaticOrder::next(i, u)) return false; u.pm += u.pm >> 4; return true; }
};

__device__ __forceinline__ unsigned cvt_pk_bf16(float lo, float hi) { unsigned r; asm volatile("v_cvt_pk_bf16_f32 %0, %1, %2" : "=v"(r) : "v"(lo), "v"(hi)); return r; }
typedef float f32x2 __attribute__((ext_vector_type(2)));

struct MoeOrder {
    int nN, ntl, nwg, G, c; const PG8_LAS unsigned char* t2e; bool rev = false;
    const int* tok; int tstride; const volatile PG8_LAS unsigned* tab;
    __device__ __forceinline__ const int* idx_src(const Unit& u) const { const int e = u.pn / nN; return tok + (size_t)e * tstride + (size_t)(u.pm - (int)tab[e]) * 256; }
    __device__ __forceinline__ int nvalid(const Unit& u) const { const int e = u.pn / nN; return (int)tab[40 + e] - (u.pm - (int)tab[e]) * 256; }
    __device__ __forceinline__ void init(int ntl_, int nN_, int G_, int c_, const PG8_LAS unsigned char* t2e_) { ntl = ntl_; nN = nN_; nwg = ntl_ * nN_; G = G_; c = c_; t2e = t2e_; }
    __device__ __forceinline__ bool next(int i, Unit& u) const {
        const long L = (long)i * G + c; if (L >= nwg) return false;
        int wgid = (int)L; { const int q = nwg / NXCD, r = nwg % NXCD, xcd = wgid % NXCD; int off = wgid / NXCD; if (rev) off = (xcd < r ? q : q - 1) - off;
            wgid = (xcd < r ? xcd * (q + 1) : r * (q + 1) + (xcd - r) * q) + off; }
        const int nig = WGM * nN, gid = wgid / nig, fm = gid * WGM, gsz = (ntl - fm) < WGM ? (ntl - fm) : WGM;
        const int rt = fm + ((wgid % nig) % gsz), pn = (wgid % nig) / gsz;
        u.pm = rt; u.pn = (int)t2e[rt] * nN + pn; return true;
    }
    __device__ __forceinline__ void a_ready(const Unit&) const {}
    __device__ __forceinline__ void done(const Unit&) const {}
};

struct EpiStore {
    static constexpr int EPI_ID = 0; static constexpr bool PERM = true, AFTER_DRAIN = false, HAS_INIT = false;
    bf16_t* O; int ldc;
    __device__ __forceinline__ void operator()(const f32x4 (&acc)[2][2][4][2], const Unit& u, int wr, int wc, int fr, int fq) const {
        const int row0 = u.pm * BM + wr * 64 + fr, col0 = u.pn * BM + wc * 32 + 8 * fq;
#pragma unroll
        for (int ai = 0; ai < 2; ++ai)
#pragma unroll
            for (int m = 0; m < 4; ++m) { bf16_t* rowp = O + (size_t)(row0 + ai * HALF + m * 16) * ldc + col0;
#pragma unroll
                for (int bj = 0; bj < 2; ++bj) { const f32x4 v0 = acc[ai][bj][m][0], v1 = acc[ai][bj][m][1];
                    u32x4 w; w.x = cvt_pk_bf16(v0[0], v0[1]); w.y = cvt_pk_bf16(v0[2], v0[3]); w.z = cvt_pk_bf16(v1[0], v1[1]); w.w = cvt_pk_bf16(v1[2], v1[3]);
                    *(u32x4*)(rowp + bj * HALF) = w; } }
    }
};
struct EpiResid {
    static constexpr int EPI_ID = 1; static constexpr bool PERM = false, AFTER_DRAIN = false, HAS_INIT = false;
    float* X; const float* gate;
    __device__ __forceinline__ void operator()(const f32x4 (&acc)[2][2][4][2], const Unit& u, int wr, int wc, int fr, int fq) const {
        const int seg = u.pm / 17, rem = u.pm - seg * 17; const int j = (rem == 16) ? 16 : seg;
        const int row0 = u.pm * BM + wr * 64 + fr, col0 = u.pn * BM + wc * 32 + 4 * fq;
        const float* g = gate + (size_t)j * 6144 + col0;
        f32x4 gv[2][2];
#pragma unroll
        for (int bj = 0; bj < 2; ++bj)
#pragma unroll
            for (int n = 0; n < 2; ++n) gv[bj][n] = *(const f32x4*)(g + bj * HALF + n * 16);
#pragma unroll
        for (int ai = 0; ai < 2; ++ai)
#pragma unroll
            for (int m = 0; m < 4; ++m) { float* rowp = X + (size_t)(row0 + ai * HALF + m * 16) * 1024 + col0;
#pragma unroll
                for (int bj = 0; bj < 2; ++bj)
#pragma unroll
                    for (int n = 0; n < 2; ++n) { f32x4* p = (f32x4*)(rowp + bj * HALF + n * 16); *p = *p + gv[bj][n] * acc[ai][bj][m][n]; } }
    }
};
struct EpiInProj {
    static constexpr int EPI_ID = 2; static constexpr bool PERM = true, AFTER_DRAIN = false, HAS_INIT = false;
    bf16_t* P; const PG8_LAS float* rope; const PG8_LAS float* gqk; float c2; int pn0;
    __device__ __forceinline__ void operator()(const f32x4 (&acc)[2][2][4][2], const Unit& u, int wr, int wc, int fr, int fq) const {
        const int pnt = u.pn + pn0; const int row0 = u.pm * BM + wr * 64 + fr, col0 = pnt * BM + 64 * wc + 8 * fq;
        const bool isq = pnt < 2, isk = pnt == 2 && wc < 2;
        if (!(isq || isk)) {
#pragma unroll
            for (int ai = 0; ai < 2; ++ai)
#pragma unroll
                for (int m = 0; m < 4; ++m) { bf16_t* rowp = P + (size_t)(row0 + ai * HALF + m * 16) * 2048 + col0;
#pragma unroll
                    for (int bj = 0; bj < 2; ++bj) { const f32x4 v0 = acc[ai][bj][m][0], v1 = acc[ai][bj][m][1];
                        u32x4 w; w.x = cvt_pk_bf16(v0[0], v0[1]); w.y = cvt_pk_bf16(v0[2], v0[3]); w.z = cvt_pk_bf16(v1[0], v1[1]); w.w = cvt_pk_bf16(v1[2], v1[3]);
                        *(u32x4*)(rowp + 32 * bj) = w; } }
            return; }
        const PG8_LAS float* gp = gqk + (isq ? 0 : 64) + 8 * fq; const float sc = isq ? c2 : 1.0f;
        f32x4 gn[2][2];
#pragma unroll
        for (int bj = 0; bj < 2; ++bj)
#pragma unroll
            for (int n = 0; n < 2; ++n) gn[bj][n] = *(const PG8_LAS f32x4*)(gp + 32 * bj + 4 * n);
        const int seg = u.pm / 17, rem = u.pm - seg * 17; const bool lat = rem != 16;
        const bool first = fq < 2; const int i0 = 8 * (fq & 1);
#pragma unroll
        for (int ai = 0; ai < 2; ++ai)
#pragma unroll
            for (int m = 0; m < 4; ++m) { const int lr = wr * 64 + fr + ai * HALF + m * 16, t = rem * 256 + lr;
                f32x4 x[2][2]; float ss = 0.f;
#pragma unroll
                for (int bj = 0; bj < 2; ++bj)
#pragma unroll
                    for (int n = 0; n < 2; ++n) { x[bj][n] = acc[ai][bj][m][n]; ss += (x[bj][n][0] * x[bj][n][0] + x[bj][n][1] * x[bj][n][1]) + (x[bj][n][2] * x[bj][n][2] + x[bj][n][3] * x[bj][n][3]); }
                ss = sum_x32(sum_x16(ss));
                const float rs = __builtin_amdgcn_rsqf(ss * (1.0f / 64.0f) + 1e-6f);
                bf16_t* rowp = P + (size_t)(u.pm * BM + lr) * 2048 + col0;
#pragma unroll
                for (int bj = 0; bj < 2; ++bj) { const int pos = lat ? (bj == 0 ? (t >> 6) : (t & 63)) : 0;
                    f32x4 o[2];
#pragma unroll
                    for (int n = 0; n < 2; ++n)
#pragma unroll
                        for (int i = 0; i < 4; ++i) { const float xv = x[bj][n][i] * rs * gn[bj][n][i]; const float pv = get_x32(xv, first);
                            const float cs = rope[(pos * 16 + i0 + 4 * n + i) * 2], sn = rope[(pos * 16 + i0 + 4 * n + i) * 2 + 1];
                            const float rot = first ? xv * cs - pv * sn : xv * cs + pv * sn;
                            o[n][i] = (lat ? rot : xv) * sc; }
                    u32x4 w; w.x = cvt_pk_bf16(o[0][0], o[0][1]); w.y = cvt_pk_bf16(o[0][2], o[0][3]); w.z = cvt_pk_bf16(o[1][0], o[1][1]); w.w = cvt_pk_bf16(o[1][2], o[1][3]);
                    *(u32x4*)(rowp + 32 * bj) = w; } }
    }
};
struct EpiGate {
    static constexpr int EPI_ID = 3; static constexpr bool PERM = true, AFTER_DRAIN = false, HAS_INIT = false;
    bf16_t* O; const float* gate; const bf16_t* X;
    __device__ __forceinline__ void operator()(const f32x4 (&acc)[2][2][4][2], const Unit& u, int wr, int wc, int fr, int fq) const {
        const int seg = u.pm / 17, rem = u.pm - seg * 17; const int j = (rem == 16) ? 16 : seg;
        const int row0 = u.pm * BM + wr * 64 + fr, col0 = u.pn * BM + wc * 32 + 8 * fq;
        const float* g = gate + (size_t)j * 6144 + col0;
        f32x4 gv[2][2];
#pragma unroll
        for (int bj = 0; bj < 2; ++bj)
#pragma unroll
            for (int n = 0; n < 2; ++n) gv[bj][n] = *(const f32x4*)(g + bj * HALF + 4 * n);
#pragma unroll
        for (int ai = 0; ai < 2; ++ai) { u32x4 xv[4][2];
#pragma unroll
            for (int m = 0; m < 4; ++m)
#pragma unroll
                for (int bj = 0; bj < 2; ++bj) xv[m][bj] = *(const __attribute__((address_space(1))) u32x4*)(X + (size_t)(row0 + ai * HALF + m * 16) * 1024 + col0 + bj * HALF);
#pragma unroll
            for (int m = 0; m < 4; ++m) { bf16_t* rowp = O + (size_t)(row0 + ai * HALF + m * 16) * 1024 + col0;
#pragma unroll
                for (int bj = 0; bj < 2; ++bj) { const u32x4 x = xv[m][bj];
                    const f32x4 x0 = {__uint_as_float(x.x << 16), __uint_as_float(x.x & 0xFFFF0000u), __uint_as_float(x.y << 16), __uint_as_float(x.y & 0xFFFF0000u)};
                    const f32x4 x1 = {__uint_as_float(x.z << 16), __uint_as_float(x.z & 0xFFFF0000u), __uint_as_float(x.w << 16), __uint_as_float(x.w & 0xFFFF0000u)};
                    const f32x4 v0 = acc[ai][bj][m][0] * gv[bj][0] + x0, v1 = acc[ai][bj][m][1] * gv[bj][1] + x1;
                    u32x4 w; w.x = cvt_pk_bf16(v0[0], v0[1]); w.y = cvt_pk_bf16(v0[2], v0[3]); w.z = cvt_pk_bf16(v1[0], v1[1]); w.w = cvt_pk_bf16(v1[2], v1[3]);
                    *(u32x4*)(rowp + bj * HALF) = w; } } }
    }
};
struct EpiLogits {
    static constexpr int EPI_ID = 4; static constexpr bool PERM = false, AFTER_DRAIN = false, HAS_INIT = false;
    float* LOG;
    __device__ __forceinline__ void operator()(const f32x4 (&acc)[2][2][4][2], const Unit& u, int wr, int wc, int fr, int fq) const {
        if (wc != 0) return;
        const int row0 = u.pm * BM + wr * 64 + fr;
#pragma unroll
        for (int ai = 0; ai < 2; ++ai)
#pragma unroll
            for (int m = 0; m < 4; ++m) { float* rowp = LOG + (size_t)(row0 + ai * HALF + m * 16) * 32 + 4 * fq;
#pragma unroll
                for (int n = 0; n < 2; ++n) *(f32x4*)(rowp + n * 16) = acc[ai][0][m][n]; }
    }
};
struct EpiSwiglu {
    static constexpr int EPI_ID = 5; static constexpr bool PERM = true, AFTER_DRAIN = false, HAS_INIT = false;
    bf16_t* ACT; const float* b1p;
    __device__ __forceinline__ void operator()(const f32x4 (&acc)[2][2][4][2], const Unit& u, int wr, int wc, int fr, int fq) const {
        const int e = u.pn >> 3, pn = u.pn & 7;
        const int row0 = u.pm * BM + wr * 64 + fr, lc = wc * 32 + 8 * fq;
        const float* bp = b1p + (size_t)e * 2048 + pn * 256 + lc;
        f32x4 bg[2], bu[2];
#pragma unroll
        for (int n = 0; n < 2; ++n) { bg[n] = *(const f32x4*)(bp + 4 * n); bu[n] = *(const f32x4*)(bp + HALF + 4 * n); }
#pragma unroll
        for (int ai = 0; ai < 2; ++ai)
#pragma unroll
            for (int m = 0; m < 4; ++m) { bf16_t* rowp = ACT + (size_t)(row0 + ai * HALF + m * 16) * 1024 + pn * 128 + lc;
                f32x4 a[2];
#pragma unroll
                for (int n = 0; n < 2; ++n) { const f32x4 gt = acc[ai][0][m][n] + bg[n], up = acc[ai][1][m][n] + bu[n];
#pragma unroll
                    for (int i = 0; i < 4; ++i) { const float gc = fminf(gt[i], 7.0f), uc = fminf(fmaxf(up[i], -7.0f), 7.0f);
                        const float sg = __builtin_amdgcn_rcpf(1.0f + __builtin_amdgcn_exp2f(gc * (-1.702f * 1.4426950408889634f)));
                        a[n][i] = (uc + 1.0f) * (gc * sg); } }
                u32x4 w; w.x = cvt_pk_bf16(a[0][0], a[0][1]); w.y = cvt_pk_bf16(a[0][2], a[0][3]); w.z = cvt_pk_bf16(a[1][0], a[1][1]); w.w = cvt_pk_bf16(a[1][2], a[1][3]);
                *(u32x4*)rowp = w; }
    }
};
struct EpiSwiglu8 {
    static constexpr int EPI_ID = 6; static constexpr bool PERM = true, AFTER_DRAIN = false, HAS_INIT = true;
    unsigned char* ACT; const float* b1p;
    __device__ __forceinline__ const float* bias_row(const Unit& u) const { const int e = u.pn >> 3, pn = u.pn & 7; return b1p + (size_t)e * 2048 + pn * 256; }
    __device__ __forceinline__ void init_lds(f32x4 (&acc)[2][2][4][2], const PG8_LAS unsigned char* bl, int wc, int fq) const {
#pragma unroll
        for (int bj = 0; bj < 2; ++bj)
#pragma unroll
            for (int n = 0; n < 2; ++n) { const f32x4 bv = *(const PG8_LAS f32x4*)(bl + (bj * HALF + wc * 32 + 8 * fq + 4 * n) * 4);
#pragma unroll
                for (int ai = 0; ai < 2; ++ai)
#pragma unroll
                    for (int m = 0; m < 4; ++m) acc[ai][bj][m][n] = bv; }
    }
    __device__ __forceinline__ void operator()(const f32x4 (&acc)[2][2][4][2], const Unit& u, int wr, int wc, int fr, int fq) const {
        const int pn = u.pn & 7;
        const int row0 = u.pm * BM + wr * 64 + fr, lc = wc * 32 + 8 * fq;
#pragma unroll
        for (int ai = 0; ai < 2; ++ai)
#pragma unroll
            for (int m = 0; m < 4; ++m) { unsigned char* rowp = ACT + (size_t)(row0 + ai * HALF + m * 16) * 1024 + pn * 128 + lc;
                f32x4 a[2];
                {
                    typedef float f32x2_ __attribute__((ext_vector_type(2)));
                    f32x2_ gc[4], uc[4], t[4], d[4], g2[4];
#pragma unroll
                    for (int q = 0; q < 4; ++q) { const f32x4 gt = acc[ai][0][m][q >> 1], up = acc[ai][1][m][q >> 1]; const int i0 = 2 * (q & 1);
                        float g0, g1; asm("v_min_f32_e32 %0, 0x40e00000, %1" : "=v"(g0) : "v"(gt[i0])); asm("v_min_f32_e32 %0, 0x40e00000, %1" : "=v"(g1) : "v"(gt[i0 + 1]));
                        gc[q] = (f32x2_){g0, g1}; uc[q] = (f32x2_){__builtin_amdgcn_fmed3f(up[i0], -7.0f, 7.0f), __builtin_amdgcn_fmed3f(up[i0 + 1], -7.0f, 7.0f)}; }
#pragma unroll
                    for (int q = 0; q < 4; ++q) t[q] = gc[q] * (-1.702f * 1.4426950408889634f);
#pragma unroll
                    for (int q = 0; q < 4; ++q) d[q] = (f32x2_){__builtin_amdgcn_exp2f(t[q].x), __builtin_amdgcn_exp2f(t[q].y)};
#pragma unroll
                    for (int q = 0; q < 4; ++q) d[q] = d[q] + 1.0f;
#pragma unroll
                    for (int q = 0; q < 4; ++q) g2[q] = (f32x2_){__builtin_amdgcn_rcpf(d[q].x), __builtin_amdgcn_rcpf(d[q].y)};
#pragma unroll
                    for (int q = 0; q < 4; ++q) g2[q] = gc[q] * g2[q];
#pragma unroll
                    for (int q = 0; q < 4; ++q) { const f32x2_ o = uc[q] * g2[q] + g2[q]; a[q >> 1][2 * (q & 1)] = o.x; a[q >> 1][2 * (q & 1) + 1] = o.y; } }
                int p0 = __builtin_amdgcn_cvt_pk_fp8_f32(a[0][0], a[0][1], 0, false); p0 = __builtin_amdgcn_cvt_pk_fp8_f32(a[0][2], a[0][3], p0, true);
                int p1 = __builtin_amdgcn_cvt_pk_fp8_f32(a[1][0], a[1][1], 0, false); p1 = __builtin_amdgcn_cvt_pk_fp8_f32(a[1][2], a[1][3], p1, true);
                *(u32x2*)rowp = (u32x2){(unsigned)p0, (unsigned)p1}; }
    }
};
struct EpiDown {
    static constexpr int EPI_ID = 7; static constexpr bool PERM = true, AFTER_DRAIN = false, HAS_INIT = true;
    unsigned char* YP; const float* b2;
    __device__ __forceinline__ const float* bias_row(const Unit& u) const { const int e = u.pn >> 2, pn = u.pn & 3; return b2 + (size_t)e * 1024 + pn * BM; }
    __device__ __forceinline__ void init_lds(f32x4 (&acc)[2][2][4][2], const PG8_LAS unsigned char* bl, int wc, int fq) const {
#pragma unroll
        for (int bj = 0; bj < 2; ++bj)
#pragma unroll
            for (int n = 0; n < 2; ++n) { const f32x4 bv = *(const PG8_LAS f32x4*)(bl + (bj * HALF + wc * 32 + 8 * fq + 4 * n) * 4) * 8.0f;
#pragma unroll
                for (int ai = 0; ai < 2; ++ai)
#pragma unroll
                    for (int m = 0; m < 4; ++m) acc[ai][bj][m][n] = bv; }
    }
    __device__ __forceinline__ void operator()(const f32x4 (&acc)[2][2][4][2], const Unit& u, int wr, int wc, int fr, int fq) const {
        const int pn = u.pn & 3;
        const int row0 = u.pm * BM + wr * 64 + fr, col0 = pn * BM + wc * 32 + 8 * fq;
#pragma unroll
        for (int ai = 0; ai < 2; ++ai)
#pragma unroll
            for (int m = 0; m < 4; ++m) { unsigned char* rowp = YP + (size_t)(row0 + ai * HALF + m * 16) * 1024 + col0;
#pragma unroll
                for (int bj = 0; bj < 2; ++bj) { const f32x4 v0 = acc[ai][bj][m][0], v1 = acc[ai][bj][m][1];
                    int p0 = __builtin_amdgcn_cvt_pk_fp8_f32(v0[0], v0[1], 0, false); p0 = __builtin_amdgcn_cvt_pk_fp8_f32(v0[2], v0[3], p0, true);
                    int p1 = __builtin_amdgcn_cvt_pk_fp8_f32(v1[0], v1[1], 0, false); p1 = __builtin_amdgcn_cvt_pk_fp8_f32(v1[2], v1[3], p1, true);
                    *(u32x2*)(rowp + bj * HALF) = (u32x2){(unsigned)p0, (unsigned)p1}; } }
    }
};

template <class Epi, class Sched, bool ALIGN_EPI = false, bool SP2 = false, bool F8 = false, int F8_SW = 0x7A7A7A7A, bool GATHER = false>
__device__ __forceinline__ void gemm_phase(PG8_LAS unsigned char* lds, const Gemm g, const Sched& S, const Epi& E) {
    int tid_ = threadIdx.x; asm volatile("" : "+v"(tid_));
    const int tid = tid_, wid = __builtin_amdgcn_readfirstlane(tid >> 6), lane = tid & 63, wr = wid >> 2, wc = wid & 3, fr = lane & 15, fq = lane >> 4;
    int K_ = g.K; asm volatile("" : "+s"(K_));
    const int K = K_, nt = K / BK;
    unsigned voffA[2], voffB[2];
#pragma unroll
    for (int i = 0; i < 2; ++i) { int R, C; stage_rc(tid * 16 + i * 8192, R, C); const int Rb = Epi::PERM ? ((R & ~31) + perm32(R & 31)) : R;
        voffA[i] = (unsigned)(R * K + C) * 2u; voffB[i] = (unsigned)(Rb * K + C) * 2u; }
    const size_t kstep = (size_t)(BK * 2);
    const size_t hstep = (size_t)HALF * K * 2;
    const size_t tstep = 2 * hstep;
    const size_t hstepA = GATHER ? 0 : hstep;
    unsigned voffC[2][2];
#define PG8_VA(h, nx) (GATHER ? voffC[h] : voffA)
#define PG8_GOFF(dst, slot, unit) do { const int nv_ = S.nvalid(unit); _Pragma("unroll") for (int i_ = 0; i_ < 2; ++i_) { int R_, C_; stage_rc(tid * 16 + i_ * 8192, R_, C_); _Pragma("unroll") for (int h_ = 0; h_ < 2; ++h_) { const int ri_ = h_ * HALF + R_; \
        int ix_ = *(const PG8_LAS int*)(lds + PG8_IDX_OFF + (slot) * 1024 + ri_ * 4); ix_ = ri_ < nv_ ? ix_ : 0; dst[h_][i_] = (unsigned)ix_ * (unsigned)(K * 2) + (unsigned)C_ * 2u; } } } while (0)
    const unsigned ldsw = (unsigned)wid * 1024u;
    const int aoff = lds_byte(wr * 64 + fr, fq * 8), boff = lds_byte(wc * 32 + fr, fq * 8);
#define PG8_SA(b, h) (((b) * 2 + (h)) * HTB)
#define PG8_SB(b, h) ((4 + (b) * 2 + (h)) * HTB)
#define PG8_STAGE(bufoff, gbase, voff) do { _Pragma("unroll") for (int _i = 0; _i < 2; ++_i) \
        __builtin_amdgcn_global_load_lds((const unsigned*)((const char*)(gbase) + (voff)[_i]), (PG8_LAS unsigned*)(lds + (bufoff) + ldsw + _i * 8192), 16, 0, 0); } while (0)
#define PG8_CAT(x0, x1) __builtin_shufflevector(__builtin_bit_cast(i32x4, x0), __builtin_bit_cast(i32x4, x1), 0, 1, 2, 3, 4, 5, 6, 7)
#define PG8_LDF(base, off) (*(const PG8_LAS bf16x8*)(lds + (base) + (off)))
#define PG8_LDA(dst, dst8, b, h) do { _Pragma("unroll") for (int m = 0; m < 4; ++m) { if constexpr (F8) dst8[m] = PG8_CAT(PG8_LDF(PG8_SA(b, h), aoff + m * 2048), PG8_LDF(PG8_SA(b, h), aoff + m * 2048 + 1024)); \
        else { _Pragma("unroll") for (int k = 0; k < 2; ++k) dst[m][k] = PG8_LDF(PG8_SA(b, h), aoff + m * 2048 + k * 1024); } } } while (0)
#define PG8_LDB(dst, dst8, b, h) do { _Pragma("unroll") for (int n = 0; n < 2; ++n) { if constexpr (F8) dst8[n] = PG8_CAT(PG8_LDF(PG8_SB(b, h), boff + n * 2048), PG8_LDF(PG8_SB(b, h), boff + n * 2048 + 1024)); \
        else { _Pragma("unroll") for (int k = 0; k < 2; ++k) dst[n][k] = PG8_LDF(PG8_SB(b, h), boff + n * 2048 + k * 1024); } } } while (0)
#define PG8_MMA(ai, bj, At, At8, Bt, Bt8) do { __builtin_amdgcn_s_setprio(1); _Pragma("unroll") for (int m = 0; m < 4; ++m) _Pragma("unroll") for (int n = 0; n < 2; ++n) { \
        if constexpr (F8) asm volatile("v_mfma_scale_f32_16x16x128_f8f6f4 %0, %1, %2, %0, %3, %3 op_sel:[0,1,0] op_sel_hi:[0,0,0]" : "+v"(acc[ai][bj][m][n]) : "v"(Bt8[n]), "v"(At8[m]), "v"(f8_s));   \
        else { _Pragma("unroll") for (int k = 0; k < 2; ++k) acc[ai][bj][m][n] = __builtin_amdgcn_mfma_f32_16x16x32_bf16(Bt[n][k], At[m][k], acc[ai][bj][m][n], 0, 0, 0); } } __builtin_amdgcn_s_setprio(0); } while (0)
#define PG8_WAIT_V(n) asm volatile("s_waitcnt vmcnt(" #n ")" ::: "memory")
#define PG8_WAIT_L(n) asm volatile("s_waitcnt lgkmcnt(" #n ")" ::: "memory")
#define PG8_BAR __builtin_amdgcn_s_barrier()
#define PG8_SCHED __builtin_amdgcn_sched_barrier(0)
    Unit cur, nxt; int ui = 0;
    if (!S.next(0, cur)) return;
    f32x4 acc[2][2][4][2];
    if constexpr (Epi::HAS_INIT) { if (wid == 0) __builtin_amdgcn_global_load_lds((const unsigned*)(E.bias_row(cur) + lane * 4), (PG8_LAS unsigned*)(lds + PG8_BIAS_OFF), 16, 0, 0); }
    else {
#pragma unroll
    for (int a = 0; a < 2; ++a)
#pragma unroll
        for (int b = 0; b < 2; ++b)
#pragma unroll
            for (int m = 0; m < 4; ++m)
#pragma unroll
                for (int n = 0; n < 2; ++n) acc[a][b][m][n] = (f32x4){0.f, 0.f, 0.f, 0.f};
    }
    int f8_s = 0x7F00 | (F8_SW & 0xFF); asm volatile("" : "+v"(f8_s));
    bf16x8 At[4][2], B0[2][2], B1[2][2]; i32x8 At8[4], B08[2], B18[2];
    const char* cA = (const char*)g.A + (GATHER ? (size_t)0 : (size_t)cur.pm * tstep); const char* cB = (const char*)g.Bt + (size_t)cur.pn * tstep;
    if constexpr (GATHER) { if (wid == 0) __builtin_amdgcn_global_load_lds((const unsigned*)(S.idx_src(cur) + lane * 4), (PG8_LAS unsigned*)(lds + PG8_IDX_OFF), 16, 0, 0);
        PG8_WAIT_V(0); PG8_BAR; PG8_GOFF(voffC, 0, cur); }
    S.a_ready(cur);
    if constexpr (SP2) {
        PG8_STAGE(PG8_SB(0, 0), cB, voffB); PG8_STAGE(PG8_SB(0, 1), cB + hstep, voffB); PG8_STAGE(PG8_SA(0, 0), cA, PG8_VA(0, false)); PG8_STAGE(PG8_SA(0, 1), cA + hstepA, PG8_VA(1, false));
        if (wr == 1) PG8_BAR;
        PG8_WAIT_V(2); PG8_BAR;
        PG8_STAGE(PG8_SB(1, 0), cB + kstep, voffB); PG8_STAGE(PG8_SA(1, 0), cA + kstep, PG8_VA(0, false)); PG8_STAGE(PG8_SB(1, 1), cB + hstep + kstep, voffB);
        PG8_WAIT_V(6); PG8_BAR;
    } else {
        PG8_STAGE(PG8_SB(0, 0), cB, voffB); PG8_STAGE(PG8_SA(0, 0), cA, PG8_VA(0, false)); PG8_STAGE(PG8_SB(0, 1), cB + hstep, voffB); PG8_STAGE(PG8_SA(0, 1), cA + hstepA, PG8_VA(1, false));
        if (wr == 1) PG8_BAR;
        PG8_WAIT_V(4); PG8_BAR;
        PG8_STAGE(PG8_SB(1, 0), cB + kstep, voffB); PG8_STAGE(PG8_SA(1, 0), cA + kstep, PG8_VA(0, false)); PG8_STAGE(PG8_SB(1, 1), cB + hstep + kstep, voffB);
        PG8_WAIT_V(6); PG8_BAR;
    }
    if constexpr (Epi::HAS_INIT) E.init_lds(acc, lds + PG8_BIAS_OFF, wc, fq);
    for (;;) {
        const bool has_next = S.next(ui + 1, nxt);
        if constexpr (Epi::HAS_INIT) { if (has_next && wid == 0) __builtin_amdgcn_global_load_lds((const unsigned*)(E.bias_row(nxt) + lane * 4), (PG8_LAS unsigned*)(lds + PG8_BIAS_OFF + ((ui + 1) & 1) * 1024), 16, 0, 0); }
        if constexpr (GATHER) { if (has_next && wid == 0) __builtin_amdgcn_global_load_lds((const unsigned*)(S.idx_src(nxt) + lane * 4), (PG8_LAS unsigned*)(lds + PG8_IDX_OFF + ((ui + 1) & 1) * 1024), 16, 0, 0); }
        const char* nA = has_next ? (const char*)g.A + (GATHER ? (size_t)0 : (size_t)nxt.pm * tstep) : cA; const char* nB = has_next ? (const char*)g.Bt + (size_t)nxt.pn * tstep : cB;
        for (int t = 0; t < nt; t += 2) {
            const bool last = (t == nt - 2);
            const char* a1 = cA + (size_t)(t + 1) * kstep;
            const char* a2 = last ? nA : cA + (size_t)(t + 2) * kstep; const char* b2 = last ? nB : cB + (size_t)(t + 2) * kstep;
            const char* a3 = a2 + kstep; const char* b3 = b2 + kstep;
            if (last && has_next) S.a_ready(nxt);
            if constexpr (SP2) {
            PG8_LDB(B0, B08, 0, 0); PG8_LDB(B1, B18, 0, 1); PG8_SCHED; PG8_LDA(At, At8, 0, 0); PG8_STAGE(PG8_SA(1, 1), a1 + hstepA, PG8_VA(1, false));
            if constexpr (GATHER) { if (last && has_next) PG8_GOFF(voffC, (ui + 1) & 1, nxt); }
            PG8_WAIT_V(8); PG8_WAIT_L(0); PG8_BAR; PG8_MMA(0, 0, At, At8, B0, B08); PG8_MMA(0, 1, At, At8, B1, B18); PG8_BAR; PG8_SCHED;
            PG8_LDA(At, At8, 0, 1); PG8_STAGE(PG8_SB(0, 0), b2, voffB); PG8_STAGE(PG8_SB(0, 1), b2 + hstep, voffB); PG8_STAGE(PG8_SA(0, 0), a2, PG8_VA(0, last));
            PG8_WAIT_V(8); PG8_WAIT_L(0); PG8_BAR; PG8_MMA(1, 0, At, At8, B0, B08); PG8_MMA(1, 1, At, At8, B1, B18); PG8_BAR; PG8_SCHED;
            PG8_LDB(B0, B08, 1, 0); PG8_LDB(B1, B18, 1, 1); PG8_SCHED; PG8_LDA(At, At8, 1, 0); PG8_STAGE(PG8_SA(0, 1), a2 + hstepA, PG8_VA(1, last));
            PG8_WAIT_V(8); PG8_WAIT_L(0); PG8_BAR; PG8_MMA(0, 0, At, At8, B0, B08); PG8_MMA(0, 1, At, At8, B1, B18); PG8_BAR; PG8_SCHED;
            PG8_LDA(At, At8, 1, 1); PG8_STAGE(PG8_SB(1, 0), b3, voffB); PG8_STAGE(PG8_SB(1, 1), b3 + hstep, voffB); PG8_STAGE(PG8_SA(1, 0), a3, PG8_VA(0, last));
            PG8_WAIT_V(8); PG8_WAIT_L(0); PG8_BAR; PG8_MMA(1, 0, At, At8, B0, B08); PG8_MMA(1, 1, At, At8, B1, B18); PG8_BAR; PG8_SCHED;
            } else {
            PG8_LDB(B0, B08, 0, 0); PG8_SCHED; PG8_LDA(At, At8, 0, 0); PG8_STAGE(PG8_SA(1, 1), a1 + hstepA, PG8_VA(1, false));
            PG8_WAIT_L(8); PG8_BAR; PG8_WAIT_L(0); PG8_MMA(0, 0, At, At8, B0, B08); PG8_BAR; PG8_SCHED;
            PG8_LDB(B1, B18, 0, 1); PG8_STAGE(PG8_SB(0, 0), b2, voffB);
            PG8_BAR; PG8_WAIT_L(0); PG8_MMA(0, 1, At, At8, B1, B18); PG8_BAR;
            PG8_LDA(At, At8, 0, 1); PG8_STAGE(PG8_SA(0, 0), a2, PG8_VA(0, last));
            PG8_BAR; PG8_WAIT_L(0); PG8_MMA(1, 0, At, At8, B0, B08); PG8_BAR; PG8_SCHED;
            PG8_STAGE(PG8_SB(0, 1), b2 + hstep, voffB);
            PG8_WAIT_V(6); PG8_BAR; PG8_MMA(1, 1, At, At8, B1, B18); PG8_BAR;
            PG8_LDB(B0, B08, 1, 0); PG8_SCHED; PG8_LDA(At, At8, 1, 0); PG8_STAGE(PG8_SA(0, 1), a2 + hstepA, PG8_VA(1, last));
            PG8_WAIT_L(8); PG8_BAR; PG8_WAIT_L(0); PG8_MMA(0, 0, At, At8, B0, B08); PG8_BAR; PG8_SCHED;
            PG8_LDB(B1, B18, 1, 1); PG8_STAGE(PG8_SB(1, 0), b3, voffB);
            PG8_BAR; PG8_WAIT_L(0); PG8_MMA(0, 1, At, At8, B1, B18); PG8_BAR;
            PG8_LDA(At, At8, 1, 1); PG8_STAGE(PG8_SA(1, 0), a3, PG8_VA(0, last));
            PG8_BAR; PG8_WAIT_L(0); PG8_MMA(1, 0, At, At8, B0, B08); PG8_BAR; PG8_SCHED;
            PG8_STAGE(PG8_SB(1, 1), b3 + hstep, voffB);
            PG8_WAIT_V(6); PG8_BAR; PG8_MMA(1, 1, At, At8, B1, B18); PG8_BAR;
            }
        }
        if constexpr (ALIGN_EPI) { if (wr == 0) PG8_BAR; }
        if constexpr (F8) asm volatile("s_nop 15\n\ts_nop 15" ::: "memory");
#ifdef MK_EPIDUP
        if constexpr (!Epi::AFTER_DRAIN && ((MK_EPIDUP >> Epi::EPI_ID) & 1)) { E(acc, cur, wr, wc, fr, fq);
            _Pragma("unroll") for (int a = 0; a < 2; ++a) _Pragma("unroll") for (int b = 0; b < 2; ++b) _Pragma("unroll") for (int m = 0; m < 4; ++m) _Pragma("unroll") for (int n = 0; n < 2; ++n) asm volatile("" : "+v"(acc[a][b][m][n])); }
#endif
        if constexpr (!Epi::AFTER_DRAIN) { E(acc, cur, wr, wc, fr, fq); S.done(cur); }
        if (!has_next) break;
        if constexpr (Epi::HAS_INIT) E.init_lds(acc, lds + PG8_BIAS_OFF + ((ui + 1) & 1) * 1024, wc, fq); else {
#pragma unroll
        for (int a = 0; a < 2; ++a)
#pragma unroll
            for (int b = 0; b < 2; ++b)
#pragma unroll
                for (int m = 0; m < 4; ++m)
#pragma unroll
                    for (int n = 0; n < 2; ++n) acc[a][b][m][n] = (f32x4){0.f, 0.f, 0.f, 0.f};
        }
        cur = nxt; cA = nA; cB = nB; ++ui;

        if constexpr (ALIGN_EPI) { if (wr == 1) PG8_BAR; }
    }
    PG8_WAIT_V(0);
    if constexpr (!ALIGN_EPI) { if (wr == 0) PG8_BAR; }
    PG8_BAR;
    if constexpr (Epi::AFTER_DRAIN) { E.fused(acc, cur, wr, wc, fr, fq, lds, wid, lane); S.done(cur); }
#undef PG8_SA
#undef PG8_SB
#undef PG8_STAGE
#undef PG8_VA
#undef PG8_GOFF
#undef PG8_LDA
#undef PG8_LDF
#undef PG8_LDB
#undef PG8_MMA
#undef PG8_CAT
#undef PG8_WAIT_V
#undef PG8_WAIT_L
#undef PG8_BAR
#undef PG8_SCHED
}
}
#ifndef ATTN_STORE16
#define ATTN_STORE16(p,v) (*(u32x4*)(p)=(v))
#endif
namespace attn_body {
using bf16=__hip_bfloat16;
using bf16x8=__attribute__((ext_vector_type(8)))short;
using s16x4=__attribute__((ext_vector_type(4)))short;
using f32x16=__attribute__((ext_vector_type(16)))float;
using u32x4=__attribute__((ext_vector_type(4)))unsigned;
constexpr int D=64,PQ=2048,PO=1024,KOFF=512,VOFF=640;
constexpr int NW=8,QBLK=32,QB=QBLK*NW,KVBLK=64;
__device__ __forceinline__ int crow(int r,int hi){return (r&3)+8*(r>>2)+4*hi;}
#define SBAR() __builtin_amdgcn_sched_barrier(0)
constexpr int NSLOT=3, SLOTB=8192;
constexpr int LDS_K=0, LDS_V=NSLOT*SLOTB, LDS_WS=2*NSLOT*SLOTB, LDS_OST=LDS_WS+NW*64*4, LDS_BYTES=LDS_OST+NW*4096;
constexpr float C2=0.125f*1.4426950408889634f;
__device__ __forceinline__ void glds16(const void*gsrc,unsigned lds_dst){unsigned keep;
  asm volatile("s_mov_b32 %0, m0\n\ts_mov_b32 m0, %2\n\ts_nop 0\n\tglobal_load_lds_dwordx4 %1, off\n\ts_mov_b32 m0, %0":"=&s"(keep):"v"(gsrc),"s"(lds_dst):"memory");}
__device__ __forceinline__ float max3f(float a,float b,float c){float r;asm("v_max3_f32 %0, %1, %2, %3":"=v"(r):"v"(a),"v"(b),"v"(c));return r;}
__device__ __forceinline__ float max2f(float a,float b){float r;asm("v_max_f32_e32 %0, %1, %2":"=v"(r):"v"(a),"v"(b));return r;}
__device__ __forceinline__ float fadd_s(float a,float b){float r;asm("v_add_f32_e32 %0, %1, %2":"=v"(r):"v"(a),"v"(b));return r;}
__device__ __forceinline__ float fsub_s(float a,float b){float r;asm("v_sub_f32_e32 %0, %1, %2":"=v"(r):"v"(a),"v"(b));return r;}
typedef float f32x2_t __attribute__((ext_vector_type(2))); typedef __bf16 bf16x2_t __attribute__((ext_vector_type(2)));
__device__ __forceinline__ unsigned cvtpk_s(float lo,float hi){f32x2_t v={lo,hi};bf16x2_t b=__builtin_convertvector(v,bf16x2_t);return __builtin_bit_cast(unsigned,b);}
#define WAIT_BAR(N) asm volatile("s_waitcnt vmcnt(" #N ") lgkmcnt(0)\n\ts_barrier":::"memory")

__device__ __forceinline__ void qkt(f32x16&p0,f32x16&p1,const char*Kslot,const bf16x8*qr,const f32x16&negm,int r32,int hi){
  const char*kb=Kslot+hi*1024+r32*16;
  #pragma unroll
  for(int d0=0;d0<4;++d0){
    const bf16x8 b0=*reinterpret_cast<const bf16x8*>(kb+d0*2048);
    const bf16x8 b1=*reinterpret_cast<const bf16x8*>(kb+d0*2048+512);
    if(d0==0){p0=__builtin_amdgcn_mfma_f32_32x32x16_bf16(b0,qr[0],negm,0,0,0);p1=__builtin_amdgcn_mfma_f32_32x32x16_bf16(b1,qr[0],negm,0,0,0);}
    else{p0=__builtin_amdgcn_mfma_f32_32x32x16_bf16(b0,qr[d0],p0,0,0,0);p1=__builtin_amdgcn_mfma_f32_32x32x16_bf16(b1,qr[d0],p1,0,0,0);}}
}
typedef __attribute__((address_space(3))) const char* lds_cptr;
typedef short v4i16_t __attribute__((ext_vector_type(4)));
__device__ __forceinline__ void kload8(bf16x8*kf,lds_cptr kp){
  kf[0]=*(const __attribute__((address_space(3))) bf16x8*)(kp);      kf[1]=*(const __attribute__((address_space(3))) bf16x8*)(kp+512);
  kf[2]=*(const __attribute__((address_space(3))) bf16x8*)(kp+2048); kf[3]=*(const __attribute__((address_space(3))) bf16x8*)(kp+2560);
  kf[4]=*(const __attribute__((address_space(3))) bf16x8*)(kp+4096); kf[5]=*(const __attribute__((address_space(3))) bf16x8*)(kp+4608);
  kf[6]=*(const __attribute__((address_space(3))) bf16x8*)(kp+6144); kf[7]=*(const __attribute__((address_space(3))) bf16x8*)(kp+6656);
}
__device__ __forceinline__ void kload2(bf16x8*kf,lds_cptr kp,int j){ kf[2*j]=*(const __attribute__((address_space(3))) bf16x8*)(kp+j*2048); kf[2*j+1]=*(const __attribute__((address_space(3))) bf16x8*)(kp+j*2048+512); }
__device__ __forceinline__ s16x4 vtr(lds_cptr p){ return __builtin_bit_cast(s16x4,__builtin_amdgcn_ds_read_tr16_b64_v4i16((__attribute__((address_space(3))) v4i16_t*)p)); }
__device__ __forceinline__ float rowmax(const f32x16&p0,const f32x16&p1){
  float a=max3f(p0[0],p0[1],p1[0]),b=max3f(p0[2],p0[3],p1[1]);a=max3f(a,p1[2],p1[3]);
  #pragma unroll
  for(int r=4;r<16;r+=4){a=max3f(a,p0[r],p0[r+1]);b=max3f(b,p0[r+2],p0[r+3]);a=max3f(a,p1[r],p1[r+1]);b=max3f(b,p1[r+2],p1[r+3]);}
  const float m=max2f(a,b);
  auto rr=__builtin_amdgcn_permlane32_swap(__float_as_uint(m),__float_as_uint(m),false,false);
  return max2f(__uint_as_float(rr[0]),__uint_as_float(rr[1]));
}
__device__ __forceinline__ void pv(f32x16*o,int vb,bf16x8 pa0,bf16x8 pa1,bf16x8 pa2,bf16x8 pa3){
  #pragma unroll
  for(int d0=0;d0<2;++d0){s16x4 lo[4],hi[4];
    #pragma unroll
    for(int ks=0;ks<4;++ks){
      asm volatile("ds_read_b64_tr_b16 %0,%1 offset:%c2":"=&v"(lo[ks]):"v"(vb),"i"(d0*4096+ks*1024):"memory");
      asm volatile("ds_read_b64_tr_b16 %0,%1 offset:%c2":"=&v"(hi[ks]):"v"(vb),"i"(d0*4096+ks*1024+512):"memory");}
    asm volatile("s_waitcnt lgkmcnt(0)":::"memory");SBAR();
    #define PK(k) (bf16x8){lo[k][0],lo[k][1],lo[k][2],lo[k][3],hi[k][0],hi[k][1],hi[k][2],hi[k][3]}
    o[d0]=__builtin_amdgcn_mfma_f32_32x32x16_bf16(pa0,PK(0),o[d0],0,0,0);
    o[d0]=__builtin_amdgcn_mfma_f32_32x32x16_bf16(pa1,PK(1),o[d0],0,0,0);
    o[d0]=__builtin_amdgcn_mfma_f32_32x32x16_bf16(pa2,PK(2),o[d0],0,0,0);
    o[d0]=__builtin_amdgcn_mfma_f32_32x32x16_bf16(pa3,PK(3),o[d0],0,0,0);
    #undef PK
  }
}

template<int THRL,bool FIXR=false> __device__ __forceinline__ void attn_unit(long qrow0,long krow0,int NTarg,int h,const bf16*Pq,bf16*Yo,char*shm,int koff=0){
  int tid_=threadIdx.x; asm volatile("":"+v"(tid_)); const int tid=tid_,lane=tid&63,r32=lane&31,hi=lane>>5; const int wid=__builtin_amdgcn_readfirstlane(tid>>6);
  const bf16*Qw=Pq+(qrow0+wid*QBLK)*PQ+h*D;
  const bf16*Kh=Pq+krow0*PQ+KOFF+(h>>2)*D,*Vh=Pq+krow0*PQ+VOFF+(h>>2)*D;
  const unsigned lds0=(unsigned)(uintptr_t)shm;
  float*wsf=(float*)(shm+LDS_WS)+wid*64;
  const bf16*ksrc=Kh+(long)lane*PQ+wid*8;
  const bf16*vsrc=Vh+(long)(16*(wid&3)+(lane>>2))*PQ+(wid>>2)*32+(lane&3)*8;
  const unsigned kdst=lds0+LDS_K+wid*1024, vdst=lds0+LDS_V+wid*1024;
  #define KVT(t) ({int t_=(t)+koff; t_>=NTarg?t_-NTarg:t_;})
  #define DMA_K(t,slot) glds16(ksrc+(long)KVT(t)*KVBLK*PQ,(unsigned)__builtin_amdgcn_readfirstlane(kdst+(slot)))
  #define DMA_V(t,slot) glds16(vsrc+(long)KVT(t)*KVBLK*PQ,(unsigned)__builtin_amdgcn_readfirstlane(vdst+(slot)))
  const int vb0=(int)(lds0+LDS_V)+((lane>>4)&1)*32+(lane&3)*8+(4*hi+((lane&15)>>2))*64;
  const char*Kbase=shm+LDS_K; bf16x8 kf[8];
  const lds_cptr shm3=(lds_cptr)shm; const lds_cptr kp0=shm3+LDS_K+hi*1024+r32*16; const lds_cptr vp0=shm3+LDS_V+((lane>>4)&1)*32+(lane&3)*8+(4*hi+((lane&15)>>2))*64;
  const int NT=NTarg;
  DMA_K(0,0);DMA_V(0,0);DMA_K(1,SLOTB);
  bf16x8 qr[4];
  #pragma unroll
  for(int d0=0;d0<4;++d0)qr[d0]=*reinterpret_cast<const bf16x8*>(&Qw[(long)r32*PQ+d0*16+hi*8]);
  float mhat=0.f,l_reg=0.f;f32x16 o[2];o[0]=f32x16{};o[1]=f32x16{};f32x16 negm=f32x16{}; if constexpr(!FIXR)asm volatile("":"+v"(negm));

  #define CMASK(P0,P1,t) do{}while(0)
  bool resc=false;
  #define START(P0,P1) do{ resc=false; \
    if constexpr(!FIXR){ const float rm=rowmax(P0,P1); const float dl=rm; mhat=fadd_s(mhat,dl); \
      _Pragma("unroll") for(int r=0;r<16;++r){P0[r]=fsub_s(P0[r],dl);P1[r]=fsub_s(P1[r],dl);} \
      _Pragma("unroll") for(int r=0;r<16;++r)negm[r]=-mhat; asm volatile("":"+v"(negm)); } \
    _Pragma("unroll") for(int r=0;r<16;++r)P0[r]=__builtin_amdgcn_exp2f(P0[r]); }while(0)
  #define RESC() do{ if(resc){ asm volatile("s_waitcnt lgkmcnt(0)":::"memory"); \
      _Pragma("unroll") for(int d_=0;d_<2;++d_) _Pragma("unroll") for(int r=0;r<16;++r)o[d_][r]*=wsf[crow(r,hi)]; } }while(0)
  f32x16 pA0,pA1,pB0,pB1;
  int sl_prev=0,sl_cur=0,sl_next=SLOTB;
  #define ROT() do{sl_prev=sl_cur;sl_cur=sl_next;sl_next=(sl_next==(NSLOT-1)*SLOTB)?0:sl_next+SLOTB;}while(0)
  DMA_K(2,2*SLOTB);
  WAIT_BAR(3);
  qkt(pA0,pA1,Kbase,qr,negm,r32,hi);asm volatile("s_nop 15\n\ts_nop 7":"+v"(pA0),"+v"(pA1));CMASK(pA0,pA1,0);
  START(pA0,pA1);
  _Pragma("unroll") for(int r=0;r<16;++r)pA1[r]=__builtin_amdgcn_exp2f(pA1[r]);
  WAIT_BAR(0);
  DMA_K(3,0);DMA_V(1,SLOTB);
  ROT();
  kload8(kf,kp0+sl_cur);
  WAIT_BAR(2);
  s16x4 vlo[8],vhi[8]; u32x4 pw0,pw1,pw2,pw3;
  #define PKW(P,B) cvtpk_s(P[B],P[B+1])
  #define PAF(k) __builtin_bit_cast(bf16x8,pw##k)
  #define VFR(i) (bf16x8){vlo[i][0],vlo[i][1],vlo[i][2],vlo[i][3],vhi[i][0],vhi[i][1],vhi[i][2],vhi[i][3]}
  #define PIN(x) asm volatile("":"+v"(x))
  #define MX3(a,b,c) __builtin_fmaxf(__builtin_fmaxf((a),(b)),(c))
  #define GAPA(MF,A0,A1,A2,A3,W0,W1,PW) do{ MF; sacc+=A0; sacc+=A1; sacc+=A2; sacc+=A3; PIN(sacc); W0; W1; PIN(PW); SBAR(); }while(0)
  #define EX(v) __builtin_amdgcn_exp2f(v)
  #define GAPB(MF,X,B) do{ MF; X[B]=EX(X[B]); X[B+1]=EX(X[B+1]); X[B+2]=EX(X[B+2]); X[B+3]=EX(X[B+3]); PIN(X); SBAR(); }while(0)
  #define VRD(i) do{ vlo[i]=vtr(vp_+(((i)>>2)*4096+((i)&3)*1024)); vhi[i]=vtr(vp_+(((i)>>2)*4096+((i)&3)*1024+512)); }while(0)
  #define KRD(G,j) do{ if(G){ kload2(kf,kp0+sl_next,j); SBAR(); } }while(0)
  #define STEP(C0,C1,P0,P1,t,GK,GV,GL) do{ SBAR(); \
    const lds_cptr vp_=vp0+sl_prev; \
    VRD(0); SBAR(); float sacc=(P0[0]+P0[1]); \
    GAPA(C0=__builtin_amdgcn_mfma_f32_32x32x16_bf16(kf[0],qr[0],negm,0,0,0), P0[2],P0[3],P0[4],P0[5],     pw0[0]=PKW(P0,0), pw0[1]=PKW(P0,2), pw0); \
    VRD(4); SBAR(); GAPA(C1=__builtin_amdgcn_mfma_f32_32x32x16_bf16(kf[1],qr[0],negm,0,0,0), P0[6],P0[7],P0[8],P0[9],     pw0[2]=PKW(P0,4), pw0[3]=PKW(P0,6), pw0); \
    VRD(1); SBAR(); GAPA(C0=__builtin_amdgcn_mfma_f32_32x32x16_bf16(kf[2],qr[1],C0,0,0,0),   P0[10],P0[11],P0[12],P0[13], pw1[0]=PKW(P0,8), pw1[1]=PKW(P0,10), pw1); \
    VRD(5); SBAR(); GAPA(C1=__builtin_amdgcn_mfma_f32_32x32x16_bf16(kf[3],qr[1],C1,0,0,0),   P0[14],P0[15],P1[0],P1[1],   pw1[2]=PKW(P0,12),pw1[3]=PKW(P0,14), pw1); \
    VRD(2); SBAR(); GAPA(C0=__builtin_amdgcn_mfma_f32_32x32x16_bf16(kf[4],qr[2],C0,0,0,0),   P1[2],P1[3],P1[4],P1[5],     pw2[0]=PKW(P1,0), pw2[1]=PKW(P1,2), pw2); \
    VRD(6); SBAR(); GAPA(C1=__builtin_amdgcn_mfma_f32_32x32x16_bf16(kf[5],qr[2],C1,0,0,0),   P1[6],P1[7],P1[8],P1[9],     pw2[2]=PKW(P1,4), pw2[3]=PKW(P1,6), pw2); \
    VRD(3); SBAR(); GAPA(C0=__builtin_amdgcn_mfma_f32_32x32x16_bf16(kf[6],qr[3],C0,0,0,0),   P1[10],P1[11],P1[12],P1[13], pw3[0]=PKW(P1,8), pw3[1]=PKW(P1,10), pw3); \
    VRD(7); SBAR(); GAPA(C1=__builtin_amdgcn_mfma_f32_32x32x16_bf16(kf[7],qr[3],C1,0,0,0),   P1[14],P1[15],0.f,0.f,       pw3[2]=PKW(P1,12),pw3[3]=PKW(P1,14), pw3); \
    l_reg+=sacc; \
    if(GK){DMA_K((t)+3,sl_cur);} if(GV){DMA_V((t)+1,sl_next);} \
    CMASK(C0,C1,t); \
    resc=false; \
    if constexpr(!FIXR){ float a=MX3(C0[0],C0[1],C1[0]),b=MX3(C0[2],C0[3],C1[1]); a=MX3(a,C1[2],C1[3]); \
      _Pragma("unroll") for(int r=4;r<16;r+=4){a=MX3(a,C0[r],C0[r+1]);b=MX3(b,C0[r+2],C0[r+3]);a=MX3(a,C1[r],C1[r+1]);b=MX3(b,C1[r+2],C1[r+3]);} \
      float rm=__builtin_fmaxf(a,b); { auto rr=__builtin_amdgcn_permlane32_swap(__float_as_uint(rm),__float_as_uint(rm),false,false); rm=__builtin_fmaxf(__uint_as_float(rr[0]),__uint_as_float(rr[1])); } \
      if(__builtin_expect(__any(rm>(float)THRL),0)){ const float dl=__builtin_fmaxf(rm,0.f); mhat+=dl; \
        _Pragma("unroll") for(int r=0;r<16;++r){C0[r]-=dl;C1[r]-=dl;} \
        _Pragma("unroll") for(int r=0;r<16;++r)negm[r]=-mhat; asm volatile("":"+v"(negm)); \
        const float f=__builtin_amdgcn_exp2f(-dl); l_reg*=f; if(hi==0)wsf[r32]=f; resc=true; } } \
    SBAR(); \
    GAPB(o[0]=__builtin_amdgcn_mfma_f32_32x32x16_bf16(PAF(0),VFR(0),o[0],0,0,0), C0,0); \
    GAPB(o[1]=__builtin_amdgcn_mfma_f32_32x32x16_bf16(PAF(0),VFR(4),o[1],0,0,0), C0,4); \
    KRD(GL,0); GAPB(o[0]=__builtin_amdgcn_mfma_f32_32x32x16_bf16(PAF(1),VFR(1),o[0],0,0,0), C0,8); \
    KRD(GL,1); GAPB(o[1]=__builtin_amdgcn_mfma_f32_32x32x16_bf16(PAF(1),VFR(5),o[1],0,0,0), C0,12); \
    KRD(GL,2); GAPB(o[0]=__builtin_amdgcn_mfma_f32_32x32x16_bf16(PAF(2),VFR(2),o[0],0,0,0), C1,0); \
    KRD(GL,3); GAPB(o[1]=__builtin_amdgcn_mfma_f32_32x32x16_bf16(PAF(2),VFR(6),o[1],0,0,0), C1,4); \
    GAPB(o[0]=__builtin_amdgcn_mfma_f32_32x32x16_bf16(PAF(3),VFR(3),o[0],0,0,0), C1,8); \
    GAPB(o[1]=__builtin_amdgcn_mfma_f32_32x32x16_bf16(PAF(3),VFR(7),o[1],0,0,0), C1,12); \
    }while(0)
  int t=1;
  #undef CMASK
  #define CMASK(P0,P1,t) do{}while(0)
  for(;t+5<NT;t+=2){
    STEP(pB0,pB1,pA0,pA1,t,true,true,true);     WAIT_BAR(2); RESC(); ROT();
    STEP(pA0,pA1,pB0,pB1,t+1,true,true,true);   WAIT_BAR(2); RESC(); ROT();
  }
  #undef CMASK
  #define CMASK(P0,P1,t) do{}while(0)
  #define ENDW(tt) do{ if((tt)+3<NT){WAIT_BAR(2);} else if((tt)+2<NT){WAIT_BAR(1);} else {WAIT_BAR(0);} }while(0)
  for(;t+1<NT;t+=2){
    STEP(pB0,pB1,pA0,pA1,t,(t+3<NT),(t+1<NT),(t+1<NT));       ENDW(t);   RESC(); ROT();
    STEP(pA0,pA1,pB0,pB1,t+1,(t+4<NT),(t+2<NT),(t+2<NT));     ENDW(t+1); RESC(); ROT();
  }
  STEP(pB0,pB1,pA0,pA1,NT-1,false,false,false); RESC();
  { float sacc=pB0[0]+pB0[1]; _Pragma("unroll") for(int r=2;r<16;++r)sacc+=pB0[r]; _Pragma("unroll") for(int r=0;r<16;++r)sacc+=pB1[r]; l_reg+=sacc;
    pw0=(u32x4){PKW(pB0,0),PKW(pB0,2),PKW(pB0,4),PKW(pB0,6)};pw1=(u32x4){PKW(pB0,8),PKW(pB0,10),PKW(pB0,12),PKW(pB0,14)};pw2=(u32x4){PKW(pB1,0),PKW(pB1,2),PKW(pB1,4),PKW(pB1,6)};pw3=(u32x4){PKW(pB1,8),PKW(pB1,10),PKW(pB1,12),PKW(pB1,14)};
    SBAR(); pv(o,vb0+sl_cur,PAF(0),PAF(1),PAF(2),PAF(3)); }
  #undef PKW
  #undef PAF
  #undef VFR
  #undef PIN
  #undef MX3
  #undef GAPA
  #undef GAPB
  #undef EX
  #undef VRD
  #undef KRD
  #undef STEP
  #undef ENDW
  {auto rr=__builtin_amdgcn_permlane32_swap(__float_as_uint(l_reg),__float_as_uint(l_reg),false,false);l_reg=__uint_as_float(rr[0])+__uint_as_float(rr[1]);}
  if(hi==0)wsf[32+r32]=l_reg;asm volatile("s_waitcnt lgkmcnt(0)":::"memory");
  float rli[16];
  #pragma unroll
  for(int r=0;r<16;++r)rli[r]=__builtin_amdgcn_rcpf(wsf[32+crow(r,hi)]);
  bf16*Ow=Yo+(qrow0+wid*QBLK)*PO+h*D;
  { bf16*stg=(bf16*)(shm+LDS_OST)+wid*2048;
    #pragma unroll
    for(int r=0;r<16;++r){const int orow=crow(r,hi);
      #pragma unroll
      for(int d0=0;d0<2;++d0)stg[orow*64+d0*32+r32]=__float2bfloat16(o[d0][r]*rli[r]);}
    asm volatile("s_waitcnt lgkmcnt(0)":::"memory");
    #pragma unroll
    for(int i=0;i<4;++i){const int row=i*8+(lane>>3),ch=lane&7; const u32x4 v=*(const u32x4*)(stg+row*64+ch*8); ATTN_STORE16(Ow+(long)row*PO+ch*8,v);} }
  asm volatile("s_waitcnt lgkmcnt(0)\n\ts_barrier":::"memory");
  #undef DMA_K
  #undef KVT
  #undef DMA_V
  #undef CMASK
  #undef START
  #undef RESC
  #undef ROT
}
constexpr int ATTN_LDS_BYTES=LDS_BYTES;
#undef SBAR
#undef WAIT_BAR
}
#ifndef MK_FP8_IN
#define MK_FP8_IN 0
#endif
#ifndef MK_FP8
#define MK_FP8 1
#endif
namespace mk {
constexpr int NB = 16, SQ = 4096, CL = 256, SEG = SQ + CL, T = NB * SEG, D = 1024, INW = 2048, NL = 4, NE = 32;
constexpr int NROWT = T / 256;
constexpr int MAXRT = 1120, CAP = MAXRT * 256;
constexpr int MODW = 6 * D;
constexpr float EPS = 1e-6f;
constexpr int NWAVES = 8;
constexpr int PPL = 12, NPHASE = 2 + NL * PPL;

constexpr size_t MiB = 1u << 20;
constexpr size_t WS_CTL = 0, CTL_ZERO_BYTES = 1 * MiB;
constexpr size_t WS_MOD = 4 * MiB;
constexpr size_t WS_B1P = 6 * MiB;
constexpr size_t WS_PAIR = 8 * MiB;
constexpr size_t WS_TOK = 12 * MiB;
constexpr size_t WS_LOG = 22 * MiB;
constexpr size_t WS_WINT = 32 * MiB;
constexpr size_t WS_WOUTT = 50 * MiB;
constexpr size_t WS_WRT = 60 * MiB;
constexpr size_t WS_W1T = 64 * MiB;
constexpr size_t WS_W2T = 576 * MiB;
constexpr size_t WS_X = 832 * MiB;
constexpr size_t WS_HB = 1104 * MiB;
constexpr size_t WS_P = 1240 * MiB;
constexpr size_t WS_Y = 1512 * MiB;
constexpr size_t WS_HP = 1648 * MiB;
constexpr size_t WS_OB = (1648 + 288) * MiB;
constexpr size_t WS_ACT = 2208 * MiB;
constexpr size_t WS_YP = 2768 * MiB;
constexpr size_t WS_HB8 = 3328 * MiB;
constexpr size_t WS_END = 3400 * MiB;
static_assert(WS_MOD + (size_t)NL * 17 * MODW * 4 <= WS_B1P && WS_B1P + (size_t)NL * NE * 2048 * 4 <= WS_PAIR && WS_PAIR + (size_t)T * 32 <= WS_TOK && WS_TOK + (size_t)NE * T * 4 <= WS_LOG && WS_LOG + (size_t)T * 128 <= WS_WINT, "ws map 1");
static_assert(WS_WINT + (size_t)NL * 2048 * 1024 * 2 <= WS_WOUTT && WS_WOUTT + (size_t)NL * 1024 * 1024 * 2 <= WS_WRT && WS_WRT + (size_t)NL * 256 * 1024 * 2 <= WS_W1T && WS_W1T + (size_t)NL * NE * 2048 * 1024 * 2 <= WS_W2T && WS_W2T + (size_t)NL * NE * 1024 * 1024 * 2 <= WS_X, "ws map 2");
static_assert(WS_X + (size_t)T * 4096 <= WS_HB && WS_HB + (size_t)T * 2048 <= WS_P && WS_P + (size_t)T * 4096 <= WS_Y && WS_Y + (size_t)T * 2048 <= WS_HP && WS_HP + (size_t)CAP * 2048 <= WS_ACT && WS_ACT + (size_t)CAP * 2048 <= WS_YP && WS_YP + (size_t)CAP * 2048 <= WS_HB8 && WS_HB8 + (size_t)T * 1024 <= WS_END, "ws map 3");
constexpr int CW_BAR = 4096;
constexpr int CW_CTX = 81920;
constexpr int CW_CQ = 83968;
constexpr int CW_CNT = 65536;
constexpr int RING_BYTES = 131072;
constexpr int ROPE_OFF = RING_BYTES + 2048;
constexpr int T2E_OFF = ROPE_OFF + 8192;
constexpr int MISC_OFF = T2E_OFF + 2048;
constexpr int LDS_BYTES = 149504;
static_assert(MISC_OFF + 1024 == pg8::PG8_BIAS_OFF && pg8::PG8_IDX_OFF + 2048 <= LDS_BYTES, "LDS map");
static_assert(MK_FP8 == 1 && WS_HP + (size_t)CAP * 1024 <= WS_OB && WS_OB + (size_t)T * 2048 <= WS_ACT, "OB lives in the free half of the HP region");

#define GAS __attribute__((address_space(1)))
#define LAS __attribute__((address_space(3)))
typedef unsigned short bf16;
typedef unsigned v4u __attribute__((ext_vector_type(4)));
typedef unsigned v2u __attribute__((ext_vector_type(2)));
typedef float f32x4 __attribute__((ext_vector_type(4)));
typedef float f32x2 __attribute__((ext_vector_type(2)));
typedef GAS unsigned gu32;
#define RLX_AGENT __ATOMIC_RELAXED, __HIP_MEMORY_SCOPE_AGENT
#define LDS_WAIT() asm volatile("s_waitcnt lgkmcnt(0)" ::: "memory")
#define VM_WAIT() asm volatile("s_waitcnt vmcnt(0)" ::: "memory")
__device__ __forceinline__ unsigned f2bf(float f) { unsigned u = __builtin_bit_cast(unsigned, f); return (u + 0x7fffu + ((u >> 16) & 1u)) >> 16; }
__device__ __forceinline__ unsigned pk2(float lo, float hi) { unsigned r; asm("v_cvt_pk_bf16_f32 %0, %1, %2" : "=v"(r) : "v"(lo), "v"(hi)); return r; }
__device__ __forceinline__ float bflo(unsigned w) { return __builtin_bit_cast(float, w << 16); }
__device__ __forceinline__ float bfhi(unsigned w) { return __builtin_bit_cast(float, w & 0xffff0000u); }
__device__ __forceinline__ f32x4 bf4(v2u w) { return (f32x4){bflo(w.x), bfhi(w.x), bflo(w.y), bfhi(w.y)}; }
__device__ __forceinline__ v2u pk4(f32x4 v) { return (v2u){pk2(v.x, v.y), pk2(v.z, v.w)}; }
using pg8::shx; using pg8::wsum; using pg8::dpp_f; using pg8::sum_x16; using pg8::sum_x32; using pg8::get_x16; using pg8::get_x32;
__device__ __forceinline__ float wave_sum(float v) { return wsum(v); }
__device__ __forceinline__ float sum4(f32x4 v) { return (v.x + v.y) + (v.z + v.w); }
__device__ __forceinline__ float sigmoidf_(float z) { return __builtin_amdgcn_rcpf(1.0f + __builtin_amdgcn_exp2f(z * -1.4426950408889634f)); }
template <int I> __device__ __forceinline__ const float* ldin() { const GAS float* p;
    asm volatile("s_load_dwordx2 %0, %1, %2\n\ts_waitcnt lgkmcnt(0)" : "=s"(p) : "s"(__builtin_amdgcn_kernarg_segment_ptr()), "n"(I * 8) : "memory"); return (const float*)p; }
__device__ __forceinline__ float* ldout() { GAS float* p;
    asm volatile("s_load_dwordx2 %0, %1, %2\n\ts_waitcnt lgkmcnt(0)" : "=s"(p) : "s"(__builtin_amdgcn_kernarg_segment_ptr()), "n"(24 * 8) : "memory"); return (float*)p; }
#define XB_TMO      128
#define XB_XCNT(j)  (256  + 64 * (j))
#define XB_XSUB(j)  (1280 + 64 * (j))
#define XB_XGEN(j)  (2304 + 64 * (j))
#define XB_TOP      3328
#define XB_TOPGEN   3392
#define XCD_BAR_WORDS 3456
#define XB_SPIN_CAP (1u << 22)

__device__ __forceinline__ unsigned xb_ld(unsigned* p)              { return __hip_atomic_load(p, __ATOMIC_RELAXED, __HIP_MEMORY_SCOPE_AGENT); }
__device__ __forceinline__ unsigned xb_add(unsigned* p, unsigned v) { return __hip_atomic_fetch_add(p, v, __ATOMIC_RELAXED, __HIP_MEMORY_SCOPE_AGENT); }
__device__ __forceinline__ unsigned xb_xcc_id() { return (unsigned)__builtin_amdgcn_s_getreg((3 << 11) | 20) & 0xFu; }
#define XB_SPIN(cond, bar) do { unsigned _sp = 0; while (cond) { __builtin_amdgcn_s_sleep(1); \
    if ((++_sp & 255u) == 0u) { if (xb_ld(&(bar)[XB_TMO])) break; if (_sp > XB_SPIN_CAP) { atomicAdd(&(bar)[XB_TMO], 1u); break; } } } } while (0)

struct XcdBarrier {
    unsigned* bar; unsigned x;
    volatile LAS unsigned* st;
};

__device__ __forceinline__ XcdBarrier xcd_barrier_post(unsigned* bar, volatile LAS unsigned* st) {
    XcdBarrier b; b.bar = bar; b.x = xb_xcc_id(); b.st = st;
    if (threadIdx.x == 0) (void)xb_add(&bar[XB_XCNT(b.x)], 1u);
    return b;
}
__device__ __forceinline__ void xcd_barrier_complete(unsigned* bar, unsigned x, unsigned& nloc, unsigned& nx) {
    const unsigned G = gridDim.x * gridDim.y * gridDim.z;
    unsigned sum, cnt, mine, sp = 0u;
    for (;;) {
        sum = 0u; cnt = 0u; mine = 0u;
#pragma unroll
        for (unsigned j = 0; j < 16; ++j) { const unsigned c = xb_ld(&bar[XB_XCNT(j)]); sum += c; cnt += (c > 0u) ? 1u : 0u; mine = (j == x) ? c : mine; }
        if (sum == G) break;
        __builtin_amdgcn_s_sleep(1);
        if ((++sp & 255u) == 0u) { if (xb_ld(&bar[XB_TMO])) break; if (sp > XB_SPIN_CAP) { atomicAdd(&bar[XB_TMO], 1u); break; } }
    }
    nloc = mine > 0u ? mine : 1u; nx = cnt > 0u ? cnt : 1u;
}

__device__ __forceinline__ void xcd_barrier(const XcdBarrier& b) {
    asm volatile("s_waitcnt vmcnt(0)" ::: "memory");
    __syncthreads();
    if (threadIdx.x == 0) {
        unsigned* bar = b.bar;
        __builtin_amdgcn_s_waitcnt(0);
        unsigned nloc = b.st[0], nx = b.st[1];
        if (nloc == 0u) { xcd_barrier_complete(bar, b.x, nloc, nx); b.st[0] = nloc; b.st[1] = nx; }
        const unsigned old = xb_add(&bar[XB_XSUB(b.x)], 1u);
        const unsigned gen = old / nloc;
        if (old + 1u == (gen + 1u) * nloc) {
            __builtin_amdgcn_fence(__ATOMIC_RELEASE, "agent");
            asm volatile("s_waitcnt vmcnt(0)" ::: "memory");
            const unsigned og = xb_add(&bar[XB_TOP], 1u);
            const unsigned tg = og / nx;
            if (og + 1u == (tg + 1u) * nx) xb_add(&bar[XB_TOPGEN], 1u);
            else XB_SPIN(xb_ld(&bar[XB_TOPGEN]) == tg, bar);
            __builtin_amdgcn_fence(__ATOMIC_ACQUIRE, "agent");
            xb_add(&bar[XB_XGEN(b.x)], 1u);
            asm volatile("s_waitcnt vmcnt(0)" ::: "memory");
        } else {
            XB_SPIN(xb_ld(&bar[XB_XGEN(b.x)]) == gen, bar);
            __builtin_amdgcn_fence(__ATOMIC_ACQUIRE, "agent");
            asm volatile("s_waitcnt vmcnt(0)" ::: "memory");
        }
    }
    __syncthreads();
}

struct Ctx {
    LAS unsigned char* lds; volatile LAS unsigned* MISC; gu32* ctl;
    int tid, lane, wave, vcu, G, gw, ngw;
    GAS unsigned char* ws;
    __device__ __forceinline__ float* MOD() const { return (float*)(ws + WS_MOD); }
    __device__ __forceinline__ float* B1P() const { return (float*)(ws + WS_B1P); }
    __device__ __forceinline__ float* LOG() const { return (float*)(ws + WS_LOG); }
    __device__ __forceinline__ bf16* X() const { return (bf16*)(ws + WS_X); }
    __device__ __forceinline__ v2u* PAIR() const { return (v2u*)(ws + WS_PAIR); }
    __device__ __forceinline__ int* TOK() const { return (int*)(ws + WS_TOK); }
    __device__ __forceinline__ bf16* WINT() const { return (bf16*)(ws + WS_WINT); }
    __device__ __forceinline__ bf16* WOUTT() const { return (bf16*)(ws + WS_WOUTT); }
    __device__ __forceinline__ bf16* WRT() const { return (bf16*)(ws + WS_WRT); }
    __device__ __forceinline__ bf16* W1T() const { return (bf16*)(ws + WS_W1T); }
    __device__ __forceinline__ bf16* W2T() const { return (bf16*)(ws + WS_W2T); }
    __device__ __forceinline__ bf16* HB() const { return (bf16*)(ws + WS_HB); }
    __device__ __forceinline__ bf16* P() const { return (bf16*)(ws + WS_P); }
    __device__ __forceinline__ bf16* Y() const { return (bf16*)(ws + WS_Y); }
    __device__ __forceinline__ bf16* HP() const { return (bf16*)(ws + WS_HP); }
    __device__ __forceinline__ bf16* ACT() const { return (bf16*)(ws + WS_ACT); }
    __device__ __forceinline__ bf16* YP() const { return (bf16*)(ws + WS_YP); }
    __device__ __forceinline__ bf16* OB() const { return (bf16*)(ws + WS_OB); }
    __device__ __forceinline__ unsigned char* HB8() const { return (unsigned char*)(ws + WS_HB8); }
};
struct Args { const float* in[24]; float* out; unsigned char* ws; int ph_lo, ph_hi; };

__device__ __forceinline__ int w_in_row(int c) { const int r = c & 255; return (c & ~255) + (((r >> 5) & 1) << 7) + ((r >> 6) << 5) + (r & 31); }
__device__ __forceinline__ int w1_row(int n) { const int a = n >> 1; return ((a >> 7) << 8) + ((n & 1) << 7) + (a & 127); }
template <int MODE>
__device__ __forceinline__ void transpose_item(const float* W, int K, int N, bf16* WT, LAS float* scr, int item, int lane) {
    const int nblk = N / 32, kb = item / nblk, nb = item % nblk, k0 = 64 * kb, n0 = 32 * nb;
    { f32x4 ld[8]; const int r8 = lane >> 3, c4 = (lane & 7) * 4;
#pragma unroll
      for (int i = 0; i < 8; ++i) ld[i] = __builtin_nontemporal_load((const f32x4*)(W + (size_t)(k0 + 8 * i + r8) * N + n0 + c4));
#pragma unroll
      for (int i = 0; i < 8; ++i) { LAS float* d = scr + (8 * i + r8) * 33 + c4; d[0] = ld[i].x; d[1] = ld[i].y; d[2] = ld[i].z; d[3] = ld[i].w; } }
    LDS_WAIT(); asm volatile("" ::: "memory");
    const int c = lane & 7;
#pragma unroll
    for (int j = 0; j < 4; ++j) { const int n = (lane >> 3) + 8 * j; const LAS float* s = scr + (8 * c) * 33 + n;
        v4u o; o.x = pk2(s[0 * 33], s[1 * 33]); o.y = pk2(s[2 * 33], s[3 * 33]); o.z = pk2(s[4 * 33], s[5 * 33]); o.w = pk2(s[6 * 33], s[7 * 33]);
        const int orow = MODE == 1 ? w1_row(n0 + n) : MODE == 2 ? w_in_row(n0 + n) : (n0 + n);
        *(GAS v4u*)(WT + (size_t)orow * K + k0 + 8 * c) = o; }
    LDS_WAIT(); asm volatile("" ::: "memory");
}
template <int MODE>
__device__ __forceinline__ void transpose_item8(const float* W, int K, int N, unsigned char* WT, LAS float* scr, int item, int lane) {
    const int nblk = N / 32, kb = item / nblk, nb = item % nblk, k0 = 64 * kb, n0 = 32 * nb;
    { f32x4 ld[8]; const int r8 = lane >> 3, c4 = (lane & 7) * 4;
#pragma unroll
      for (int i = 0; i < 8; ++i) ld[i] = __builtin_nontemporal_load((const f32x4*)(W + (size_t)(k0 + 8 * i + r8) * N + n0 + c4));
#pragma unroll
      for (int i = 0; i < 8; ++i) { LAS float* d = scr + (8 * i + r8) * 33 + c4; d[0] = ld[i].x; d[1] = ld[i].y; d[2] = ld[i].z; d[3] = ld[i].w; } }
    LDS_WAIT(); asm volatile("" ::: "memory");
    const int n = lane >> 1, h = lane & 1; const LAS float* s = scr + (32 * h) * 33 + n;
    unsigned w[8];
#pragma unroll
    for (int q = 0; q < 8; ++q) { int p = __builtin_amdgcn_cvt_pk_fp8_f32(s[(4 * q) * 33] * 32.0f, s[(4 * q + 1) * 33] * 32.0f, 0, false); p = __builtin_amdgcn_cvt_pk_fp8_f32(s[(4 * q + 2) * 33] * 32.0f, s[(4 * q + 3) * 33] * 32.0f, p, true); w[q] = (unsigned)p; }
    const int orow = MODE == 1 ? w1_row(n0 + n) : MODE == 2 ? w_in_row(n0 + n) : (n0 + n);
    GAS v4u* dst = (GAS v4u*)(WT + (size_t)orow * K + k0 + 32 * h);
    dst[0] = (v4u){w[0], w[1], w[2], w[3]}; dst[1] = (v4u){w[4], w[5], w[6], w[7]};
    LDS_WAIT(); asm volatile("" ::: "memory");
}
template <int MODE>
__device__ __forceinline__ void transpose_item8w(const float* W, int K, int N, unsigned char* WT, LAS float* scr, int item, int lane) {
    const int nblk = N / 64, kb = item / nblk, nb = item % nblk, k0 = 64 * kb, n0 = 64 * nb;
    { f32x4 ld[16]; const int r4 = lane >> 4, c4 = (lane & 15) * 4;
#pragma unroll
      for (int i = 0; i < 16; ++i) ld[i] = *(const f32x4*)(W + (size_t)(k0 + 4 * i + r4) * N + n0 + c4);
#pragma unroll
      for (int i = 0; i < 16; ++i) { LAS float* d = scr + (4 * i + r4) * 65 + c4; d[0] = ld[i].x; d[1] = ld[i].y; d[2] = ld[i].z; d[3] = ld[i].w; } }
    LDS_WAIT(); asm volatile("" ::: "memory");
    const LAS float* s = scr + lane;
    const int orow = MODE == 1 ? w1_row(n0 + lane) : (n0 + lane);
    GAS v4u* dst = (GAS v4u*)(WT + (size_t)orow * K + k0);
#pragma unroll
    for (int g4 = 0; g4 < 4; ++g4) { unsigned w[4];
#pragma unroll
        for (int q = 0; q < 4; ++q) { const int kk = 16 * g4 + 4 * q; int p = __builtin_amdgcn_cvt_pk_fp8_f32(s[kk * 65] * 32.0f, s[(kk + 1) * 65] * 32.0f, 0, false); p = __builtin_amdgcn_cvt_pk_fp8_f32(s[(kk + 2) * 65] * 32.0f, s[(kk + 3) * 65] * 32.0f, p, true); w[q] = (unsigned)p; }
        dst[g4] = (v4u){w[0], w[1], w[2], w[3]}; }
    LDS_WAIT(); asm volatile("" ::: "memory");
}
struct WSrc { const float *w_in, *w_out, *w_e1, *w_e2; };
constexpr int CV_IN = 16 * 64, CV_OUT = 16 * 32, CV_E1 = 16 * 64, CV_E2 = 16 * 32, CV_PER_L = CV_IN + CV_OUT + NE * CV_E1 + NE * CV_E2;
constexpr int CV_HEAD = CV_IN + CV_OUT;
__device__ __forceinline__ void convert_item(const Ctx& C, const WSrc& W, int l, int r, LAS float* scr, int lane) {
    if (r < CV_IN) { transpose_item<2>(W.w_in + (size_t)l * 1024 * 2048, 1024, 2048, C.WINT() + (size_t)l * 2048 * 1024, scr, r, lane); return; } r -= CV_IN;
    if (r < CV_OUT) { transpose_item<0>(W.w_out + (size_t)l * 1024 * 1024, 1024, 1024, C.WOUTT() + (size_t)l * 1024 * 1024, scr, r, lane); return; } r -= CV_OUT;
    if (r < NE * CV_E1) { const int e = r / CV_E1; transpose_item8<1>(W.w_e1 + ((size_t)l * NE + e) * 1024 * 2048, 1024, 2048, (unsigned char*)C.W1T() + ((size_t)l * NE + e) * 2048 * 1024, scr, r % CV_E1, lane); return; } r -= NE * CV_E1;
    { const int e = r / CV_E2; transpose_item8<0>(W.w_e2 + ((size_t)l * NE + e) * 1024 * 1024, 1024, 1024, (unsigned char*)C.W2T() + ((size_t)l * NE + e) * 1024 * 1024, scr, r % CV_E2, lane); }
}
constexpr int CV_TAIL = 6;
__device__ __forceinline__ int tail_items(int nwg, int G) { const int rem = nwg % G; return rem ? (G - rem) * NWAVES * CV_TAIL : 0; }
__device__ __forceinline__ void tail_convert(const Ctx& C, int l, int nwg, int first) {
    const int rem = nwg % C.G, c = (int)blockIdx.x; if (rem == 0 || c < rem) return;
    WSrc W; W.w_in = ldin<8>(); W.w_out = ldin<17>(); W.w_e1 = ldin<20>(); W.w_e2 = ldin<22>();
    LAS float* scr = (LAS float*)(C.lds + C.wave * 8448);
    const int stride = (C.G - rem) * NWAVES; int it = first + (c - rem) * NWAVES + C.wave;
#pragma unroll 1
    for (int k = 0; k < CV_TAIL; ++k, it += stride) if (it < CV_PER_L) convert_item(C, W, l, it, scr, C.lane);
}
__device__ __forceinline__ void convert_bias(const Ctx& C, const float* b_e1, int l) {
    for (int i = C.gw * 64 + C.lane; i < NE * 2048; i += C.ngw * 64) { const int n = i & 2047; C.B1P()[(size_t)l * NE * 2048 + (i & ~2047) + w1_row(n)] = b_e1[(size_t)l * NE * 2048 + i]; }
}
__device__ __forceinline__ void phase_prologue(const Ctx& C, const Args& A) {
    __syncthreads();
    {
        LAS float* sS = (LAS float*)C.lds;
        const float* cin = ldin<1>(); const float* cctx = ldin<3>(); const float* wada = ldin<4>(); const float* bada = ldin<5>();
        for (int i = C.tid; i < 17 * 1024; i += NWAVES * 64) { const int j = i >> 10, k = i & 1023; const float v = j < 16 ? cin[j * 1024 + k] : cctx[k]; sS[i] = v * sigmoidf_(v); }
        __syncthreads();
        const int kl = C.tid & 15, cg = C.tid >> 4;
        for (int item = blockIdx.x; item < NL * 64; item += C.G) {
            if (cg >= 24) continue;
            const int l = item / 64, c0 = (item % 64) * 96 + 4 * cg;
            const float* W = wada + (size_t)l * 1024 * MODW + c0;
            f32x4 acc[17];
#pragma unroll
            for (int j = 0; j < 17; ++j) acc[j] = (f32x4){0.f, 0.f, 0.f, 0.f};
#pragma unroll 1
            for (int k0 = kl; k0 < 1024; k0 += 64) { f32x4 w[4];
#pragma unroll
                for (int u = 0; u < 4; ++u) w[u] = __builtin_nontemporal_load((const f32x4*)(W + (size_t)(k0 + 16 * u) * MODW));
#pragma unroll
                for (int u = 0; u < 4; ++u)
#pragma unroll
                    for (int j = 0; j < 17; ++j) acc[j] += sS[j * 1024 + k0 + 16 * u] * w[u]; }
#pragma unroll
            for (int j = 0; j < 17; ++j)
#pragma unroll
                for (int o = 1; o < 16; o <<= 1) { acc[j].x += shx(acc[j].x, o); acc[j].y += shx(acc[j].y, o); acc[j].z += shx(acc[j].z, o); acc[j].w += shx(acc[j].w, o); }
            if (kl == 0) { const f32x4 bv = *(const f32x4*)(bada + (size_t)l * MODW + c0);
#pragma unroll
                for (int j = 0; j < 17; ++j) *(f32x4*)(C.MOD() + ((size_t)l * 17 + j) * MODW + c0) = acc[j] + bv; }
        }
        __syncthreads();
    }
    {
        LAS float* scr = (LAS float*)(C.lds + C.wave * 8448);
        WSrc W; W.w_in = ldin<8>(); W.w_out = ldin<17>(); W.w_e1 = ldin<20>(); W.w_e2 = ldin<22>();
        for (int it = C.gw; it < CV_HEAD; it += C.ngw) convert_item(C, W, 0, it, scr, C.lane);
        convert_bias(C, ldin<21>(), 0);
    }
}

__device__ __forceinline__ void moe_tables(const Ctx& C, int l, bool with_t2e) {
    __syncthreads();
    if (C.tid < NE) C.MISC[40 + C.tid] = __hip_atomic_load(C.ctl + CW_CNT + (l * NE + C.tid) * 64, RLX_AGENT);
    __syncthreads();
    if (C.tid == 0) { unsigned s = 0;
#pragma unroll 1
        for (int e = 0; e < NE; ++e) { C.MISC[e] = s; s += (C.MISC[40 + e] + 255u) >> 8; } C.MISC[NE] = s; }
    __syncthreads();
    if (with_t2e) { LAS unsigned char* t2e = (LAS unsigned char*)(C.lds + T2E_OFF);
        for (int rt = C.tid; rt < MAXRT; rt += NWAVES * 64) { unsigned e = 0;
#pragma unroll 1
            for (int k = 1; k < NE; ++k) e += (C.MISC[k] <= (unsigned)rt) ? 1u : 0u;
            t2e[rt] = (unsigned char)e; }
        __syncthreads(); }
}

__device__ __forceinline__ void row_bt(int r, int& b, int& t, int& j) { b = r / SEG; t = r - b * SEG; j = t < SQ ? b : 16; }
__device__ __forceinline__ void wave_rows(const Ctx& C, int n, int& rbeg, int& rend) { const int rpw = (n + C.ngw - 1) / C.ngw; rbeg = C.gw * rpw; rend = rbeg + rpw < n ? rbeg + rpw : n; }
__device__ __forceinline__ int colq(int q, int lane) { return 512 * (q >> 1) + 8 * lane + 4 * (q & 1); }
__device__ __forceinline__ void bf8_to_f32(v4u w, f32x4& a, f32x4& b) { a = (f32x4){bflo(w.x), bfhi(w.x), bflo(w.y), bfhi(w.y)}; b = (f32x4){bflo(w.z), bfhi(w.z), bflo(w.w), bfhi(w.w)}; }
__device__ __forceinline__ v4u f32_to_bf8(f32x4 a, f32x4 b) { return (v4u){pk2(a.x, a.y), pk2(a.z, a.w), pk2(b.x, b.y), pk2(b.z, b.w)}; }
__device__ __forceinline__ void fp8x8_to_f32(v2u w, f32x4& a, f32x4& b) {
    const unsigned w0 = w.x, w1 = w.y;
    const f32x2 p0 = __builtin_amdgcn_cvt_pk_f32_fp8((int)w0, false), p1 = __builtin_amdgcn_cvt_pk_f32_fp8((int)w0, true), p2 = __builtin_amdgcn_cvt_pk_f32_fp8((int)w1, false), p3 = __builtin_amdgcn_cvt_pk_f32_fp8((int)w1, true);
    a = (f32x4){p0.x, p0.y, p1.x, p1.y}; b = (f32x4){p2.x, p2.y, p3.x, p3.y}; }
__device__ __forceinline__ v2u f32_to_fp8x8(f32x4 a, f32x4 b) {
    int p0 = __builtin_amdgcn_cvt_pk_fp8_f32(a.x, a.y, 0, false); p0 = __builtin_amdgcn_cvt_pk_fp8_f32(a.z, a.w, p0, true);
    int p1 = __builtin_amdgcn_cvt_pk_fp8_f32(b.x, b.y, 0, false); p1 = __builtin_amdgcn_cvt_pk_fp8_f32(b.z, b.w, p1, true);
    return (v2u){(unsigned)p0, (unsigned)p1}; }
__device__ __forceinline__ void modulate2(const f32x4 (&v)[2][4], const f32x4 (&gv)[4], const float* const (&mj)[2], int sh_chunk, f32x4 (&h)[2][4], int lane) {
    f32x4 sh[2][4], sc[2][4]; float ss[2];
#pragma unroll
    for (int u = 0; u < 2; ++u) { ss[u] = 0.f;
#pragma unroll
        for (int q = 0; q < 4; ++q) { const int c = colq(q, lane); sh[u][q] = *(const f32x4*)(mj[u] + sh_chunk * D + c); sc[u][q] = *(const f32x4*)(mj[u] + (sh_chunk + 1) * D + c); ss[u] += sum4(v[u][q] * v[u][q]); } }
    ss[0] = wsum(ss[0]); ss[1] = wsum(ss[1]);
#pragma unroll
    for (int u = 0; u < 2; ++u) { const float rs = __builtin_amdgcn_rsqf(ss[u] * (1.0f / D) + EPS);
#pragma unroll
        for (int q = 0; q < 4; ++q) h[u][q] = (v[u][q] * rs) * gv[q] * (1.0f + sc[u][q]) + sh[u][q]; }
}
__device__ __forceinline__ void pair_load2(const Ctx& C, const int (&r)[2], v2u (&pr)[2][4]) {
#pragma unroll
    for (int u = 0; u < 2; ++u)
#pragma unroll
        for (int k = 0; k < 4; ++k) pr[u][k] = C.PAIR()[(size_t)r[u] * 4 + k];
}
__device__ __forceinline__ void moe_combine2(const Ctx& C, const v2u (&pr)[2][4], f32x4 (&acc)[2][4]) {
    v2u y[2][4][2];
#pragma unroll
    for (int u = 0; u < 2; ++u)
#pragma unroll
        for (int k = 0; k < 4; ++k) { const unsigned px = pr[u][k].x; const unsigned e = px & 31u, pos = px >> 5;
            const unsigned char* yp = (const unsigned char*)C.YP() + ((size_t)C.MISC[e] * 256 + pos) * D + 8 * C.lane;
#pragma unroll
            for (int jj = 0; jj < 2; ++jj) y[u][k][jj] = __builtin_nontemporal_load((const GAS v2u*)(yp + 512 * jj)); }
#pragma unroll
    for (int u = 0; u < 2; ++u) {
#pragma unroll
        for (int q = 0; q < 4; ++q) acc[u][q] = (f32x4){0.f, 0.f, 0.f, 0.f};
#pragma unroll
        for (int k = 0; k < 4; ++k) { const unsigned wb = pr[u][k].y; const float wt = __uint_as_float(wb) * 0.125f;
#pragma unroll
            for (int jj = 0; jj < 2; ++jj) { f32x4 ya, yb; fp8x8_to_f32(y[u][k][jj], ya, yb); acc[u][2 * jj] += wt * ya; acc[u][2 * jj + 1] += wt * yb; } } }
}
__device__ __forceinline__ void ld_x2(const Ctx& C, const bf16* base, const int (&r)[2], f32x4 (&v)[2][4]) {
#pragma unroll
    for (int u = 0; u < 2; ++u)
#pragma unroll
        for (int jj = 0; jj < 2; ++jj) bf8_to_f32(__builtin_nontemporal_load((const GAS v4u*)(base + (size_t)r[u] * D + 512 * jj + 8 * C.lane)), v[u][2 * jj], v[u][2 * jj + 1]);
}

__device__ __forceinline__ void phase_premix(const Ctx& C, const Args& A, int l) {
    if (l > 0) moe_tables(C, l - 1, false);
    const float* modl = C.MOD() + (size_t)l * 17 * MODW; const float* modp = C.MOD() + (size_t)(l > 0 ? l - 1 : 0) * 17 * MODW;
    const float* g = ldin<6>() + (size_t)l * D; const float* xin = ldin<0>(); const float* cxin = ldin<2>();
    f32x4 gv[4];
#pragma unroll
    for (int q = 0; q < 4; ++q) gv[q] = *(const f32x4*)(g + colq(q, C.lane));
    int rbeg, rend; wave_rows(C, T, rbeg, rend);
    v2u pr[2][4]; if (l > 0 && rbeg < rend) { const int rf[2] = {rbeg, rbeg + 1 < rend ? rbeg + 1 : rbeg}; pair_load2(C, rf, pr); }
    int jc = -1; f32x4 gtc[4], shc[4], gsc[4];
#pragma unroll
    for (int q = 0; q < 4; ++q) { gtc[q] = gv[q]; shc[q] = gv[q]; gsc[q] = gv[q]; }
    for (int r0 = rbeg; r0 < rend; r0 += 2) {
        const int r[2] = {r0, r0 + 1 < rend ? r0 + 1 : r0};
        int b[2], t[2], j[2]; row_bt(r[0], b[0], t[0], j[0]); row_bt(r[1], b[1], t[1], j[1]);
        f32x4 v[2][4];
        if (l == 0) {
#pragma unroll
            for (int u = 0; u < 2; ++u) { const float* src = t[u] < SQ ? xin + ((size_t)b[u] * SQ + t[u]) * D : cxin + ((size_t)b[u] * CL + (t[u] - SQ)) * D;
#pragma unroll
                for (int q = 0; q < 4; ++q) v[u][q] = __builtin_nontemporal_load((const f32x4*)(src + colq(q, C.lane))); }
        } else {
            ld_x2(C, C.OB(), r, v);
            v2u prn[2][4]; { const int a = r0 + 2 < rend ? r0 + 2 : r0, b2 = r0 + 3 < rend ? r0 + 3 : a; const int rn[2] = {a, b2}; pair_load2(C, rn, prn); }
            f32x4 acc[2][4]; moe_combine2(C, pr, acc);
#pragma unroll
            for (int u = 0; u < 2; ++u)
#pragma unroll
                for (int k = 0; k < 4; ++k) pr[u][k] = prn[u][k];
            if (j[0] != jc) {
#pragma unroll
                for (int q = 0; q < 4; ++q) gtc[q] = *(const f32x4*)(modp + (size_t)j[0] * MODW + 5 * D + colq(q, C.lane)); }
#pragma unroll
            for (int u = 0; u < 2; ++u) {
                if (j[u] == j[0]) {
#pragma unroll
                    for (int q = 0; q < 4; ++q) v[u][q] += gtc[q] * acc[u][q]; }
                else {
#pragma unroll
                    for (int q = 0; q < 4; ++q) v[u][q] += *(const f32x4*)(modp + (size_t)j[u] * MODW + 5 * D + colq(q, C.lane)) * acc[u][q]; } } }
        if (j[0] != jc) { jc = j[0]; const float* m = modl + (size_t)jc * MODW;
#pragma unroll
            for (int q = 0; q < 4; ++q) { const int c = colq(q, C.lane); shc[q] = *(const f32x4*)(m + c); gsc[q] = gv[q] * (1.0f + *(const f32x4*)(m + D + c)); } }
        f32x4 h[2][4]; float ss[2];
#pragma unroll
        for (int u = 0; u < 2; ++u) { ss[u] = 0.f;
#pragma unroll
            for (int q = 0; q < 4; ++q) ss[u] += sum4(v[u][q] * v[u][q]); }
        ss[0] = wsum(ss[0]); ss[1] = wsum(ss[1]);
#pragma unroll
        for (int u = 0; u < 2; ++u) { const float rs = __builtin_amdgcn_rsqf(ss[u] * (1.0f / D) + EPS);
            if (j[u] == jc) {
#pragma unroll
                for (int q = 0; q < 4; ++q) h[u][q] = (v[u][q] * rs) * gsc[q] + shc[q]; }
            else { const float* m = modl + (size_t)j[u] * MODW;
#pragma unroll
                for (int q = 0; q < 4; ++q) { const int c = colq(q, C.lane); h[u][q] = (v[u][q] * rs) * (gv[q] * (1.0f + *(const f32x4*)(m + D + c))) + *(const f32x4*)(m + c); } } }
#pragma unroll
        for (int u = 0; u < 2; ++u)
#pragma unroll
            for (int jj = 0; jj < 2; ++jj) { const size_t o = (size_t)r[u] * D + 512 * jj + 8 * C.lane;
                __builtin_nontemporal_store(f32_to_bf8(v[u][2 * jj], v[u][2 * jj + 1]), (GAS v4u*)(C.X() + o));
#if MK_FP8_IN == 1
                *(GAS v2u*)((unsigned char*)C.HB() + o) = f32_to_fp8x8(h[u][2 * jj], h[u][2 * jj + 1]); }
#elif MK_FP8_IN == 2
                *(GAS v4u*)(C.HB() + o) = f32_to_bf8(h[u][2 * jj], h[u][2 * jj + 1]); *(GAS v2u*)(C.HB8() + o) = f32_to_fp8x8(h[u][2 * jj], h[u][2 * jj + 1]); }
#else
                *(GAS v4u*)(C.HB() + o) = f32_to_bf8(h[u][2 * jj], h[u][2 * jj + 1]); }
#endif
    }
}
__device__ __forceinline__ void phase_premoe(const Ctx& C, const Args& A, int l) {
    const float* modl = C.MOD() + (size_t)l * 17 * MODW; const float* g = ldin<7>() + (size_t)l * D;
    typedef __bf16 bf16x2_t __attribute__((ext_vector_type(2)));
    volatile LAS unsigned* lhist = C.MISC + 80; volatile LAS unsigned* lbase = C.MISC + 112;
    __syncthreads();
    { const float* wr = ldin<18>() + (size_t)l * D * NE;
      for (int idx = C.tid; idx < 8 * 4 * 2 * 64; idx += NWAVES * 64) { const int ln = idx & 63, jj = (idx >> 6) & 1, ip = (idx >> 7) & 3, e4 = idx >> 9;
          const float* w0 = wr + (size_t)(512 * jj + 8 * ln + 2 * ip) * NE + 4 * e4; const f32x4 a = *(const f32x4*)w0, b = *(const f32x4*)(w0 + NE);
          ((LAS v4u*)C.lds)[idx] = (v4u){pk2(a.x, b.x), pk2(a.y, b.y), pk2(a.z, b.z), pk2(a.w, b.w)}; }
      if (C.tid < NE) lhist[C.tid] = 0u; }
    __syncthreads();
    f32x4 gv[4];
#pragma unroll
    for (int q = 0; q < 4; ++q) gv[q] = *(const f32x4*)(g + colq(q, C.lane));
    const int half = C.lane >> 5, ex = C.lane & 31;
    const float br = ldin<19>()[l * NE + ex];
    const bool lat = l + 1 == NL;
#define RMAP(q) (lat ? ((q) / SQ) * SEG + (q) % SQ : (q))
    int rbeg, rend; wave_rows(C, lat ? NB * SQ : T, rbeg, rend);
    const bool cv = true; int cit = CV_HEAD + tail_items(NROWT * (INW / 256), C.G) + tail_items((l + 1 < NL ? NROWT : NB * SQ / 256) * (D / 256), C.G) + C.gw; LAS float* cscr = (LAS float*)(C.lds + 65536 + C.wave * 8448);
    WSrc W; W.w_in = ldin<8>(); W.w_out = ldin<17>(); W.w_e1 = ldin<20>(); W.w_e2 = ldin<22>();
    v4u ob[2][2];
    if (rbeg < rend) { const int ra = RMAP(rbeg), rb = RMAP(rbeg + 1 < rend ? rbeg + 1 : rbeg);
#pragma unroll
        for (int jj = 0; jj < 2; ++jj) { ob[0][jj] = __builtin_nontemporal_load((const GAS v4u*)(C.OB() + (size_t)ra * D + 512 * jj + 8 * C.lane)); ob[1][jj] = __builtin_nontemporal_load((const GAS v4u*)(C.OB() + (size_t)rb * D + 512 * jj + 8 * C.lane)); } }
    int jc = -1; f32x4 shc[4], gsc[4];
#pragma unroll
    for (int q = 0; q < 4; ++q) { shc[q] = gv[q]; gsc[q] = gv[q]; }
    for (int r0 = rbeg; r0 < rend; r0 += 2) {
        const bool two = r0 + 1 < rend; const int r[2] = {RMAP(r0), RMAP(two ? r0 + 1 : r0)};
        int b[2], t[2], j[2]; row_bt(r[0], b[0], t[0], j[0]); row_bt(r[1], b[1], t[1], j[1]);
        f32x4 v[2][4];
#pragma unroll
        for (int u = 0; u < 2; ++u)
#pragma unroll
            for (int jj = 0; jj < 2; ++jj) bf8_to_f32(ob[u][jj], v[u][2 * jj], v[u][2 * jj + 1]);
        { const int qa = r0 + 2 < rend ? r0 + 2 : r0, qb = r0 + 3 < rend ? r0 + 3 : qa; const int ra = RMAP(qa), rb = RMAP(qb);
#pragma unroll
          for (int jj = 0; jj < 2; ++jj) { ob[0][jj] = __builtin_nontemporal_load((const GAS v4u*)(C.OB() + (size_t)ra * D + 512 * jj + 8 * C.lane)); ob[1][jj] = __builtin_nontemporal_load((const GAS v4u*)(C.OB() + (size_t)rb * D + 512 * jj + 8 * C.lane)); } }
        if (j[0] != jc) { jc = j[0]; const float* m = modl + (size_t)jc * MODW + 3 * D;
#pragma unroll
            for (int q = 0; q < 4; ++q) { const int c = colq(q, C.lane); shc[q] = *(const f32x4*)(m + c); gsc[q] = gv[q] * (1.0f + *(const f32x4*)(m + D + c)); } }
        f32x4 h[2][4]; float ss[2];
#pragma unroll
        for (int u = 0; u < 2; ++u) { ss[u] = 0.f;
#pragma unroll
            for (int q = 0; q < 4; ++q) ss[u] += sum4(v[u][q] * v[u][q]); }
        ss[0] = wsum(ss[0]); ss[1] = wsum(ss[1]);
#pragma unroll
        for (int u = 0; u < 2; ++u) { const float rs = __builtin_amdgcn_rsqf(ss[u] * (1.0f / D) + EPS);
            if (j[u] == jc) {
#pragma unroll
                for (int q = 0; q < 4; ++q) h[u][q] = (v[u][q] * rs) * gsc[q] + shc[q]; }
            else { const float* m = modl + (size_t)j[u] * MODW + 3 * D;
#pragma unroll
                for (int q = 0; q < 4; ++q) { const int c = colq(q, C.lane); h[u][q] = (v[u][q] * rs) * (gv[q] * (1.0f + *(const f32x4*)(m + D + c))) + *(const f32x4*)(m + c); } } }
#pragma unroll
        for (int u = 0; u < 2; ++u)
#pragma unroll
            for (int jj = 0; jj < 2; ++jj) { const size_t o = (size_t)r[u] * D + 512 * jj + 8 * C.lane;
                *(GAS v2u*)(C.HB8() + o) = f32_to_fp8x8(h[u][2 * jj], h[u][2 * jj + 1]); }
        f32x4 pl[2][8];
#pragma unroll
        for (int e4 = 0; e4 < 8; ++e4) { pl[0][e4] = (f32x4){0.f, 0.f, 0.f, 0.f}; pl[1][e4] = pl[0][e4]; }
#pragma unroll
        for (int jj = 0; jj < 2; ++jj)
#pragma unroll
            for (int ip = 0; ip < 4; ++ip) { const int q = 2 * jj + (ip >> 1), c0 = 2 * (ip & 1);
                const bf16x2_t h0 = __builtin_bit_cast(bf16x2_t, pk2(h[0][q][c0], h[0][q][c0 + 1])), h1 = __builtin_bit_cast(bf16x2_t, pk2(h[1][q][c0], h[1][q][c0 + 1]));
#pragma unroll
                for (int e4 = 0; e4 < 8; ++e4) { const v4u w = ((const LAS v4u*)C.lds)[((e4 * 4 + ip) * 2 + jj) * 64 + C.lane];
                    const unsigned wx[4] = {w.x, w.y, w.z, w.w};
#pragma unroll
                    for (int x = 0; x < 4; ++x) { const bf16x2_t wb = __builtin_bit_cast(bf16x2_t, wx[x]);
                        pl[0][e4][x] = __builtin_amdgcn_fdot2_f32_bf16(h0, wb, pl[0][e4][x], false); pl[1][e4][x] = __builtin_amdgcn_fdot2_f32_bf16(h1, wb, pl[1][e4][x], false); } } }
        float s32[32];
#pragma unroll
        for (int e = 0; e < 32; ++e) { const auto r = __builtin_amdgcn_permlane32_swap(__float_as_uint(pl[0][e >> 2][e & 3]), __float_as_uint(pl[1][e >> 2][e & 3]), false, false); s32[e] = __uint_as_float(r[0]) + __uint_as_float(r[1]); }
        float s16[16];
#pragma unroll
        for (int e = 0; e < 16; ++e) { const auto r = __builtin_amdgcn_permlane16_swap(__float_as_uint(s32[e]), __float_as_uint(s32[16 + e]), false, false); s16[e] = __uint_as_float(r[0]) + __uint_as_float(r[1]); }
        float s8[8];
#pragma unroll
        for (int e = 0; e < 8; ++e) { const bool hi = (C.lane & 8) != 0; const float keep = hi ? s16[8 + e] : s16[e], send = hi ? s16[e] : s16[8 + e]; s8[e] = keep + dpp_f<0x128>(send); }
        float s4[4];
#pragma unroll
        for (int e = 0; e < 4; ++e) { const bool hi = (C.lane & 4) != 0; const float keep = hi ? s8[4 + e] : s8[e], send = hi ? s8[e] : s8[4 + e]; s4[e] = keep + dpp_f<0x1B>(dpp_f<0x141>(send)); }
        float s2[2];
#pragma unroll
        for (int e = 0; e < 2; ++e) { const bool hi = (C.lane & 2) != 0; const float keep = hi ? s4[2 + e] : s4[e], send = hi ? s4[e] : s4[2 + e]; s2[e] = keep + dpp_f<0x4E>(send); }
        float lg; { const bool hi = (C.lane & 1) != 0; const float keep = hi ? s2[1] : s2[0], send = hi ? s2[0] : s2[1]; lg = keep + dpp_f<0xB1>(send); }
        const float vv = lg + br; const int vb = __float_as_int(vv);
        float cur = vv; int rank = 4; float sv[4];
#pragma unroll
        for (int k = 0; k < 4; ++k) { float m = cur; m = __builtin_fmaxf(m, dpp_f<0xB1>(m)); m = __builtin_fmaxf(m, dpp_f<0x4E>(m)); m = __builtin_fmaxf(m, dpp_f<0x141>(m)); m = __builtin_fmaxf(m, dpp_f<0x140>(m));
            { const auto rr = __builtin_amdgcn_permlane16_swap(__float_as_uint(m), __float_as_uint(m), false, false); m = __builtin_fmaxf(__uint_as_float(rr[0]), __uint_as_float(rr[1])); }
            sv[k] = m;
            const unsigned long long mk = __ballot(cur == m); const int s0 = (int)__builtin_ctz((unsigned)mk | 0x80000000u), s1 = (int)__builtin_ctz((unsigned)(mk >> 32) | 0x80000000u);
            if (ex == (half ? s1 : s0)) { rank = k; cur = -INFINITY; } }
        const float inv = __builtin_amdgcn_rcpf(1.0f + __expf(sv[1] - sv[0]) + __expf(sv[2] - sv[0]) + __expf(sv[3] - sv[0]));
        if (rank < 4 && (half == 0 || two)) { const int rr = r[half];
            const unsigned lpos = __hip_atomic_fetch_add((LAS unsigned*)(C.lds + MISC_OFF) + 80 + ex, 1u, __ATOMIC_RELAXED, __HIP_MEMORY_SCOPE_WORKGROUP);
            C.PAIR()[(size_t)rr * 4 + rank] = (v2u){(unsigned)ex | (lpos << 5), __float_as_uint(__expf(vv - sv[0]) * inv)}; }
        if (cv) {
#pragma unroll 1
            for (int k = 0; k < 2 && cit < CV_PER_L; ++k, cit += C.ngw) convert_item(C, W, l, cit, cscr, C.lane); }
    }
    if (cv) {
#pragma unroll 1
        for (; cit < CV_PER_L; cit += C.ngw) convert_item(C, W, l, cit, cscr, C.lane);
        if (l + 1 < NL) {
#pragma unroll 1
            for (int it = C.gw; it < CV_HEAD; it += C.ngw) convert_item(C, W, l + 1, it, cscr, C.lane);
            convert_bias(C, ldin<21>(), l + 1); } }
    __syncthreads();
    gu32* cnt = C.ctl + CW_CNT + (size_t)l * NE * 64;
    if (C.tid < NE) { const unsigned n = lhist[C.tid]; lbase[C.tid] = n ? __hip_atomic_fetch_add(cnt + C.tid * 64, n, RLX_AGENT) : 0u; }
    __syncthreads();
    for (int idx = C.lane; idx < (rend - rbeg) * 4; idx += 64) { const int rr = RMAP(rbeg + (idx >> 2)); gu32* px = (gu32*)C.PAIR() + ((size_t)rr * 4 + (idx & 3)) * 2;
        const unsigned x = __hip_atomic_load(px, RLX_AGENT); const unsigned e = x & 31u, pos = lbase[e] + (x >> 5);
        *px = e | (pos << 5); C.TOK()[(size_t)e * T + pos] = rr; }
    __syncthreads();
#undef RMAP
}
__device__ __forceinline__ void phase_final(const Ctx& C, const Args& A) {
    moe_tables(C, NL - 1, false);
    const float* modp = C.MOD() + (size_t)(NL - 1) * 17 * MODW; float* outp = ldout();
    int qbeg, qend; wave_rows(C, NB * SQ, qbeg, qend);
    v2u pr[2][4]; if (qbeg < qend) { const int qa = qbeg, qb = qbeg + 1 < qend ? qbeg + 1 : qbeg; const int rf[2] = {(qa / SQ) * SEG + qa % SQ, (qb / SQ) * SEG + qb % SQ}; pair_load2(C, rf, pr); }
    int bc = -1; f32x4 gtc[4];
#pragma unroll
    for (int q = 0; q < 4; ++q) gtc[q] = (f32x4){0.f, 0.f, 0.f, 0.f};
    for (int q0 = qbeg; q0 < qend; q0 += 2) {
        const int qq[2] = {q0, q0 + 1 < qend ? q0 + 1 : q0}; const int b[2] = {qq[0] / SQ, qq[1] / SQ}; const int r[2] = {b[0] * SEG + (qq[0] - b[0] * SQ), b[1] * SEG + (qq[1] - b[1] * SQ)};
        f32x4 v[2][4]; ld_x2(C, C.OB(), r, v);
        if (b[0] != bc) { bc = b[0];
#pragma unroll
            for (int q = 0; q < 4; ++q) gtc[q] = *(const f32x4*)(modp + (size_t)bc * MODW + 5 * D + colq(q, C.lane)); }
        v2u prn[2][4]; { const int qa = q0 + 2 < qend ? q0 + 2 : q0, qb = q0 + 3 < qend ? q0 + 3 : qa; const int rn[2] = {(qa / SQ) * SEG + qa % SQ, (qb / SQ) * SEG + qb % SQ}; pair_load2(C, rn, prn); }
        f32x4 acc[2][4]; moe_combine2(C, pr, acc);
#pragma unroll
        for (int u = 0; u < 2; ++u)
#pragma unroll
            for (int k = 0; k < 4; ++k) pr[u][k] = prn[u][k];
#pragma unroll
        for (int u = 0; u < 2; ++u) { float* o = outp + (size_t)qq[u] * D;
            if (b[u] == bc) {
#pragma unroll
                for (int q = 0; q < 4; ++q) __builtin_nontemporal_store(v[u][q] + gtc[q] * acc[u][q], (f32x4*)(o + colq(q, C.lane))); }
            else {
#pragma unroll
                for (int q = 0; q < 4; ++q) *(f32x4*)(o + colq(q, C.lane)) = v[u][q] + *(const f32x4*)(modp + (size_t)b[u] * MODW + 5 * D + colq(q, C.lane)) * acc[u][q]; } }
    }
}

__device__ __forceinline__ v4u qk_piece(v4u w, const float (&gain)[8], bool lat, int pos, int i0, bool first, float scale, const LAS f32x2* rope) {
    float f[8] = {bflo(w.x), bfhi(w.x), bflo(w.y), bfhi(w.y), bflo(w.z), bfhi(w.z), bflo(w.w), bfhi(w.w)};
    float ss = 0.f;
#pragma unroll
    for (int i = 0; i < 8; ++i) ss += f[i] * f[i];
    ss += shx(ss, 1); ss += shx(ss, 2); ss += shx(ss, 4);
    const float rs = __builtin_amdgcn_rsqf(ss * (1.0f / 64.0f) + EPS);
    float o[8];
#pragma unroll
    for (int i = 0; i < 8; ++i) f[i] = f[i] * rs * gain[i];
#pragma unroll
    for (int i = 0; i < 8; ++i) { const float pv = shx(f[i], 2); const f32x2 cs = rope[(pos & 63) * 16 + i0 + i];
        const float rot = first ? f[i] * cs.x - pv * cs.y : f[i] * cs.x + pv * cs.y;
        o[i] = (lat ? rot : f[i]) * scale; }
    v4u ow; ow.x = pk2(o[0], o[1]); ow.y = pk2(o[2], o[3]); ow.z = pk2(o[4], o[5]); ow.w = pk2(o[6], o[7]); return ow;
}
__device__ __forceinline__ void phase_qknorm(const Ctx& C, const Args& A, int l) {
    const LAS f32x2* rope = (const LAS f32x2*)(C.lds + ROPE_OFF);
    const float* gq = ldin<9>() + l * 64; const float* gk = ldin<10>() + l * 64;
    const int d0 = 8 * (C.lane & 7);
    const int ax = d0 >> 5, o0 = d0 & 31; const bool first = o0 < 16; const int i0 = o0 & 15;
    float gqv[8], gkv[8];
#pragma unroll
    for (int i = 0; i < 8; ++i) { gqv[i] = gq[d0 + i]; gkv[i] = gk[d0 + i]; }
    int rbeg, rend; wave_rows(C, T, rbeg, rend);
    for (int r0 = rbeg; r0 < rend; r0 += 4) {
        v4u wq[4]; bool ok[4]; int tt[4];
#pragma unroll
        for (int u = 0; u < 4; ++u) { ok[u] = r0 + u < rend; const int r = ok[u] ? r0 + u : r0; tt[u] = r % SEG; wq[u] = *(const GAS v4u*)(C.P() + (size_t)r * INW + 8 * C.lane); }
        const int uk = C.lane >> 4; const bool okk = r0 + uk < rend; const int rk = okk ? r0 + uk : r0; const int tk = rk % SEG;
        bf16* pk = C.P() + (size_t)rk * INW + 512 + 8 * (C.lane & 15);
        const v4u wk = *(const GAS v4u*)pk;
#pragma unroll
        for (int u = 0; u < 4; ++u) { const bool lat = tt[u] < SQ; const int pos = ax == 0 ? (tt[u] >> 6) : (tt[u] & 63);
            const v4u ow = qk_piece(wq[u], gqv, lat, pos, i0, first, attn_body::C2, rope);
            if (ok[u]) *(GAS v4u*)(C.P() + (size_t)(r0 + u) * INW + 8 * C.lane) = ow; }
        { const bool lat = tk < SQ; const int pos = ax == 0 ? (tk >> 6) : (tk & 63);
          const v4u ow = qk_piece(wk, gkv, lat, pos, i0, first, 1.0f, rope);
          if (okk) *(GAS v4u*)pk = ow; }
    }
}

__device__ __forceinline__ void attn_gnorm(const Ctx& C, size_t row0, const float* gg) {
    const f32x4 gA0 = *(const f32x4*)(gg + 8 * C.lane), gA1 = *(const f32x4*)(gg + 8 * C.lane + 4);
    bf16* y0 = C.Y() + (row0 + C.wave * 32) * D + 8 * C.lane;
#pragma unroll 1
    for (int i = 0; i < 32; i += 16) {
        v4u av[16]; float qa[16];
#pragma unroll
        for (int u = 0; u < 16; ++u) av[u] = *(const GAS v4u*)(y0 + (size_t)(i + u) * D);
#pragma unroll
        for (int u = 0; u < 16; ++u) { const f32x4 a0 = bf4((v2u){av[u].x, av[u].y}), a1 = bf4((v2u){av[u].z, av[u].w}); qa[u] = sum4(a0 * a0) + sum4(a1 * a1); }
#pragma unroll
        for (int u = 0; u < 16; ++u) qa[u] = wsum(qa[u]);
#pragma unroll
        for (int u = 0; u < 16; ++u) { const float rsa = __builtin_amdgcn_rsqf(qa[u] * (1.0f / 512.0f) + EPS);
            const f32x4 a0 = bf4((v2u){av[u].x, av[u].y}), a1 = bf4((v2u){av[u].z, av[u].w});
            const v2u o0 = pk4(a0 * rsa * gA0), o1 = pk4(a1 * rsa * gA1);
            *(GAS v4u*)(y0 + (size_t)(i + u) * D) = (v4u){o0.x, o0.y, o1.x, o1.y}; }
    }
}
template <bool FIXR> __device__ __forceinline__ void phase_attn_impl(const Ctx& C, int l) {
    char* shm = (char*)C.lds;
    const attn_body::bf16* Pq = (const attn_body::bf16*)C.P(); attn_body::bf16* Yo = (attn_body::bf16*)C.Y();
    const float* gg = ldin<16>() + (size_t)l * D;
    gu32* cc = C.ctl + CW_CTX + (size_t)l * NB * 16;
    if (l + 1 < NL)
    for (int u = C.G - 1 - C.vcu; u < NB * 8; u += C.G) { const int h = u & 7, b = u >> 3;
        attn_body::attn_unit<8, FIXR>((long)b * SEG + SQ, (long)b * SEG + SQ, CL / 64, h, Pq, Yo, shm);
        asm volatile("s_waitcnt vmcnt(0)" ::: "memory"); __syncthreads();
        if (C.tid == 0) { __builtin_amdgcn_fence(__ATOMIC_RELEASE, "agent"); C.MISC[164] = __hip_atomic_fetch_add(cc + b * 16, 1u, RLX_AGENT); }
        __syncthreads();
        if ((C.MISC[164] & 7u) == 7u) { __builtin_amdgcn_fence(__ATOMIC_ACQUIRE, "agent"); attn_gnorm(C, (size_t)b * SEG + SQ, gg); }
        __syncthreads(); }
    for (int u = C.vcu; u < NB * 16; u += C.G) { const int qb = u & 15, b = u >> 4;
#pragma unroll 1
        for (int h = 0; h < 8; ++h) attn_body::attn_unit<8, FIXR>((long)b * SEG + qb * 256, (long)b * SEG, SEG / 64, h, Pq, Yo, shm);
        asm volatile("s_waitcnt vmcnt(0)" ::: "memory"); __syncthreads();
        attn_gnorm(C, (size_t)b * SEG + qb * 256, gg); }
}

__device__ __forceinline__ void phase_attn(const Ctx& C, int l) {
    float gq = __builtin_fabsf(ldin<9>()[l * 64 + C.lane]), gk = __builtin_fabsf(ldin<10>()[l * 64 + C.lane]);
    gq = __builtin_fmaxf(gq, dpp_f<0xB1>(gq)); gq = __builtin_fmaxf(gq, dpp_f<0x4E>(gq)); gq = __builtin_fmaxf(gq, dpp_f<0x141>(gq)); gq = __builtin_fmaxf(gq, dpp_f<0x140>(gq));
    gk = __builtin_fmaxf(gk, dpp_f<0xB1>(gk)); gk = __builtin_fmaxf(gk, dpp_f<0x4E>(gk)); gk = __builtin_fmaxf(gk, dpp_f<0x141>(gk)); gk = __builtin_fmaxf(gk, dpp_f<0x140>(gk));
    float bq = 0.f, bk = 0.f;
#pragma unroll
    for (int i = 0; i < 4; ++i) { bq = __builtin_fmaxf(bq, __int_as_float(__builtin_amdgcn_readlane(__float_as_int(gq), 16 * i))); bk = __builtin_fmaxf(bk, __int_as_float(__builtin_amdgcn_readlane(__float_as_int(gk), 16 * i))); }
    const float bound = 11.8f * bq * bk;
    if (bound < 60.0f) phase_attn_impl<true>(C, l); else phase_attn_impl<false>(C, l);
}

__device__ __forceinline__ void phase_conv1(const Ctx& C, const Args& A, int l) {
    __syncthreads();
    LAS float* zL = (LAS float*)C.lds;
    const int c4 = 4 * C.lane;
    {
        f32x4 wk[31]; const float* wdw = ldin<11>();
#pragma unroll
        for (int jt = 0; jt < 31; ++jt) wk[jt] = *(const f32x4*)(wdw + ((size_t)l * 31 + jt) * 256 + c4);
        const f32x4 b31 = *(const f32x4*)(ldin<12>() + l * 256 + c4), gln = *(const f32x4*)(ldin<13>() + l * 256 + c4), bln = *(const f32x4*)(ldin<14>() + l * 256 + c4);
        const f32x4 gC = *(const f32x4*)(ldin<16>() + (size_t)l * D + 512 + c4);
        gu32* tq = C.ctl + CW_CQ + l * 16;
        for (int tile = C.vcu; tile < T / 64; ) {
            const int b = tile / 68, tt = tile - b * 68, t0 = tt * 64;
            const int seg_lo = tt < 64 ? 0 : SQ, seg_hi = tt < 64 ? SQ : SEG;
            const size_t rbase = (size_t)b * SEG;
            if (!(l + 1 == NL && tt >= 64)) {
            __syncthreads();
            { v2u ra[12], rg[12];
#pragma unroll
              for (int i = 0; i < 12; ++i) { const int zr = C.wave + 8 * i, t = t0 - 15 + zr; const bool ok = zr < 94 && t >= seg_lo && t < seg_hi;
                  const bf16* p = C.P() + (rbase + (ok ? t : t0)) * INW; ra[i] = *(const GAS v2u*)(p + 768 + c4); rg[i] = *(const GAS v2u*)(p + 1024 + c4); }
#pragma unroll
              for (int i = 0; i < 12; ++i) { const int zr = C.wave + 8 * i, t = t0 - 15 + zr; const bool ok = t >= seg_lo && t < seg_hi;
                  if (zr < 94) { const f32x4 a = bf4(ra[i]), gt = bf4(rg[i]);
                      const f32x4 z = ok ? (f32x4){a.x * sigmoidf_(gt.x), a.y * sigmoidf_(gt.y), a.z * sigmoidf_(gt.z), a.w * sigmoidf_(gt.w)} : (f32x4){0.f, 0.f, 0.f, 0.f};
                      *(LAS f32x4*)(zL + zr * 256 + c4) = z; } } }
            __syncthreads();
            for (int g = 0; g < 2; ++g) { const int i0 = C.wave * 8 + 4 * g;
                f32x4 u[4] = {b31, b31, b31, b31};
#pragma unroll
                for (int j = 0; j < 34; ++j) { const f32x4 z = *(const LAS f32x4*)(zL + (i0 + j) * 256 + c4);
#pragma unroll
                    for (int t = 0; t < 4; ++t) if (j - t >= 0 && j - t < 31) u[t] += wk[j - t] * z; }
                float s[4], vq[4], qq[4]; f32x4 d[4], cf[4];
#pragma unroll
                for (int t = 0; t < 4; ++t) s[t] = sum4(u[t]);
#pragma unroll
                for (int t = 0; t < 4; ++t) s[t] = wsum(s[t]);
#pragma unroll
                for (int t = 0; t < 4; ++t) { d[t] = u[t] - s[t] * (1.0f / 256.0f); vq[t] = sum4(d[t] * d[t]); }
#pragma unroll
                for (int t = 0; t < 4; ++t) vq[t] = wsum(vq[t]);
#pragma unroll
                for (int t = 0; t < 4; ++t) { const f32x4 y = d[t] * __builtin_amdgcn_rsqf(vq[t] * (1.0f / 256.0f) + EPS) * gln + bln;
                    cf[t] = (f32x4){y.x * sigmoidf_(y.x), y.y * sigmoidf_(y.y), y.z * sigmoidf_(y.z), y.w * sigmoidf_(y.w)}; qq[t] = sum4(cf[t] * cf[t]); }
#pragma unroll
                for (int t = 0; t < 4; ++t) qq[t] = wsum(qq[t]);
#pragma unroll
                for (int t = 0; t < 4; ++t) *(GAS v2u*)(C.Y() + (rbase + t0 + i0 + t) * D + 512 + c4) = pk4(cf[t] * __builtin_amdgcn_rsqf(qq[t] * (1.0f / 256.0f) + EPS) * gC);
            }
            }
            if (C.tid == 0) C.MISC[165] = (unsigned)C.G + __hip_atomic_fetch_add(tq, 1u, RLX_AGENT);
            __syncthreads();
            tile = (int)C.MISC[165];
        }
        __syncthreads();
    }
}
__device__ __forceinline__ void phase_conv2(const Ctx& C, const Args& A, int l) {
    const int c4 = 4 * C.lane;
    {
        const float* wsc = ldin<15>() + (size_t)l * 3 * 256 + c4; const f32x4 w30 = *(const f32x4*)(wsc), w31 = *(const f32x4*)(wsc + 256), w32 = *(const f32x4*)(wsc + 512);
        const float* gg = ldin<16>() + (size_t)l * D;
        const f32x4 gS = *(const f32x4*)(gg + 768 + c4);
        gu32* tq = C.ctl + CW_CQ + (NL + l) * 16; int kc = 0;
        for (int ch = C.vcu; ch < T / 64; ++kc) {
        if (C.tid == 0) C.MISC[166 + (kc & 1)] = (unsigned)C.G + __hip_atomic_fetch_add(tq, 1u, RLX_AGENT);
        const int rbeg = ch * 64 + C.wave * 8, rend = (l + 1 == NL && ch % 68 >= 64) ? rbeg : rbeg + 8;
        for (int r0 = rbeg; r0 < rend; r0 += 2) {
            const bool two = r0 + 1 < rend;
            v2u cgv[4], hvv[4], bgv[2];
#pragma unroll
            for (int k = 0; k < 4; ++k) { int rr = r0 - 1 + k; rr = rr < 0 ? 0 : (rr >= T ? T - 1 : rr); const bf16* p = C.P() + (size_t)rr * INW; cgv[k] = *(const GAS v2u*)(p + 1536 + c4); hvv[k] = *(const GAS v2u*)(p + 1792 + c4); }
#pragma unroll
            for (int u = 0; u < 2; ++u) { const int r = two || u == 0 ? r0 + u : r0; bgv[u] = *(const GAS v2u*)(C.P() + (size_t)r * INW + 1280 + c4); }
            f32x4 m[4];
#pragma unroll
            for (int k = 0; k < 4; ++k) m[k] = bf4(cgv[k]) * bf4(hvv[k]);
            f32x4 sv[2]; float qs[2];
#pragma unroll
            for (int u = 0; u < 2; ++u) { const int r = r0 + u; const int t = r % SEG; const bool has_prev = t != 0 && t != SQ, has_next = t != SQ - 1 && t != SEG - 1;
                const f32x4 zero = (f32x4){0.f, 0.f, 0.f, 0.f};
                sv[u] = bf4(bgv[u]) * (w30 * (has_prev ? m[u] : zero) + w31 * m[u + 1] + w32 * (has_next ? m[u + 2] : zero));
                qs[u] = sum4(sv[u] * sv[u]); }
            qs[0] = wsum(qs[0]); qs[1] = wsum(qs[1]);
#pragma unroll
            for (int u = 0; u < 2; ++u) { if (u == 1 && !two) break; bf16* yr = C.Y() + (size_t)(r0 + u) * D;
                *(GAS v2u*)(yr + 768 + c4) = pk4(sv[u] * __builtin_amdgcn_rsqf(qs[u] * (1.0f / 256.0f) + EPS) * gS); }
        }
        __syncthreads(); ch = (int)C.MISC[166 + (kc & 1)];
        }
    }
}

__device__ __forceinline__ void phase_route(const Ctx& C, const Args& A, int l) {
    volatile LAS unsigned* lhist = C.MISC + 80; volatile LAS unsigned* lbase = C.MISC + 112;
    const float br = C.lane < NE ? ldin<19>()[l * NE + C.lane] : 0.f;
    gu32* cnt = C.ctl + CW_CNT + (size_t)l * NE * 64;
    for (int tile = C.vcu; tile < T / 64; tile += C.G) {
        __syncthreads();
        if (C.tid < NE) lhist[C.tid] = 0u;
        __syncthreads();
        unsigned pp[8]; int rk[8];
        float lg[8];
#pragma unroll
        for (int i = 0; i < 8; ++i) { const int r = tile * 64 + C.wave * 8 + i; lg[i] = C.lane < NE ? C.LOG()[(size_t)r * NE + C.lane] + br : -INFINITY; }
#pragma unroll
        for (int i = 0; i < 8; ++i) { const int r = tile * 64 + C.wave * 8 + i; const float v = lg[i]; const int vb = __float_as_int(v);
            int rank = 0;
#pragma unroll
            for (int j = 0; j < NE; ++j) { const float vj = __int_as_float(__builtin_amdgcn_readlane(vb, j)); rank += (vj > v || (vj == v && j < C.lane)) ? 1 : 0; }
            const bool sel = C.lane < NE && rank < 4;
            float sv[4];
#pragma unroll
            for (int k = 0; k < 4; ++k) { const unsigned long long mk = __ballot(C.lane < NE && rank == k); const int src = (int)__builtin_ctzll(mk | (1ull << 63)); sv[k] = __int_as_float(__builtin_amdgcn_readlane(vb, src)); }
            const float e1 = __expf(sv[1] - sv[0]), e2 = __expf(sv[2] - sv[0]), e3 = __expf(sv[3] - sv[0]); const float inv = __builtin_amdgcn_rcpf(1.0f + e1 + e2 + e3);
            rk[i] = sel ? rank : -1; pp[i] = 0u;
            if (sel) { pp[i] = __hip_atomic_fetch_add((LAS unsigned*)(C.lds + MISC_OFF) + 80 + C.lane, 1u, __ATOMIC_RELAXED, __HIP_MEMORY_SCOPE_WORKGROUP);
                ((GAS float*)C.PAIR())[((size_t)r * 4 + rank) * 2 + 1] = __expf(v - sv[0]) * inv; } }
        __syncthreads();
        if (C.tid < NE) { const unsigned n = lhist[C.tid]; lbase[C.tid] = n ? __hip_atomic_fetch_add(cnt + C.tid * 64, n, RLX_AGENT) : 0u; }
        __syncthreads();
        const unsigned mybase = C.lane < NE ? lbase[C.lane] : 0u;
#pragma unroll
        for (int i = 0; i < 8; ++i) if (rk[i] >= 0) { const int r = tile * 64 + C.wave * 8 + i; const unsigned pos = mybase + pp[i];
            ((GAS unsigned*)C.PAIR())[((size_t)r * 4 + rk[i]) * 2] = (unsigned)C.lane | (pos << 5);
            C.TOK()[(size_t)C.lane * T + pos] = r; }
    }
    __syncthreads();
}

__device__ __forceinline__ void phase_gather(const Ctx& C, const Args& A, int l) {
    moe_tables(C, l, true);
    const LAS unsigned char* t2e = (const LAS unsigned char*)(C.lds + T2E_OFF);
    const int nslot = (int)C.MISC[NE] * 256;
    constexpr int RB = MK_FP8 ? 1024 : 2048, NV = RB / 1024;
    const unsigned char* srcb = MK_FP8 ? (const unsigned char*)C.HB8() : (const unsigned char*)C.HB();
    unsigned char* dstb = (unsigned char*)C.HP();
    for (int s0 = C.gw * 16; s0 < nslot; s0 += C.ngw * 16) { const unsigned e = t2e[s0 >> 8]; const unsigned pos0 = (unsigned)s0 - C.MISC[e] * 256u; const unsigned cnt = C.MISC[40 + e];
        int tk = -1; if (C.lane < 16 && pos0 + C.lane < cnt) tk = C.TOK()[(size_t)e * T + pos0 + C.lane];
        v4u v[16][NV];
#pragma unroll
        for (int u = 0; u < 16; ++u) { const int r = __builtin_amdgcn_readlane(tk, u);
            if (r >= 0) { const GAS v4u* src = (const GAS v4u*)(srcb + (size_t)r * RB) + C.lane;
#pragma unroll
                for (int q = 0; q < NV; ++q) v[u][q] = src[64 * q]; } }
#pragma unroll
        for (int u = 0; u < 16; ++u) { const int r = __builtin_amdgcn_readlane(tk, u);
            if (r >= 0) { GAS v4u* dst = (GAS v4u*)(dstb + (size_t)(s0 + u) * RB) + C.lane;
#pragma unroll
                for (int q = 0; q < NV; ++q) dst[64 * q] = v[u][q]; } }
    }
}

__global__ void __launch_bounds__(NWAVES * 64, 2) mk_fwd(Args args) {
    extern __shared__ __attribute__((aligned(16))) unsigned char lds_raw[];
    Ctx C;
    C.lds = (LAS unsigned char*)lds_raw; C.MISC = (volatile LAS unsigned*)(C.lds + MISC_OFF);
    C.tid = threadIdx.x; C.lane = C.tid & 63; C.wave = __builtin_amdgcn_readfirstlane(C.tid >> 6);
    C.G = gridDim.x; { const int bx = blockIdx.x; C.vcu = (C.G % 8 == 0) ? (bx % 8) * (C.G / 8) + bx / 8 : bx; }
    C.gw = C.vcu * NWAVES + C.wave; C.ngw = C.G * NWAVES;
    C.ws = (GAS unsigned char*)args.ws; C.ctl = (gu32*)(C.ws + WS_CTL);
    for (int u = C.tid; u < (LDS_BYTES - MISC_OFF) / 4; u += NWAVES * 64) ((LAS unsigned*)(C.lds + MISC_OFF))[u] = 0u;
    __syncthreads();
    const int lo = args.ph_lo, hi = args.ph_hi;
    const bool multi = (hi - lo) > 1;
    XcdBarrier bar; bar.bar = (unsigned*)(C.ctl + CW_BAR); bar.x = 0; bar.st = C.MISC + 160;
    if (multi) bar = xcd_barrier_post((unsigned*)(C.ctl + CW_BAR), C.MISC + 160);
#ifndef MK_PHMASK
#define MK_PHMASK 0xFFFF
#endif
#define IN(k) (lo <= (k) && (k) < hi)
#ifndef MK_STAMP
#define MK_STAMP -1
#endif
    unsigned long long tacc = 0ull, tst = 0ull;
#define T0(k) do { if (MK_STAMP == (k)) tst = __builtin_amdgcn_s_memrealtime(); } while (0)
#define T1(k) do { if (MK_STAMP == (k)) tacc += __builtin_amdgcn_s_memrealtime() - tst; } while (0)
#define FRESH() do { asm volatile("" : "+v"(C.tid), "+v"(C.lane)); asm volatile("" : "+s"(C.wave), "+s"(C.vcu), "+s"(C.gw), "+s"(C.ws), "+s"(C.ctl)); } while (0)
#define EN(k) ((MK_PHMASK >> (k)) & 1)
#ifndef MK_DUP
#define MK_DUP 0
#endif
#define NREP(k) (((MK_DUP >> (k)) & 1) ? 2 : 1)
#define SEAM(k) do { if (IN((k) + 1)) xcd_barrier(bar); } while (0)

    if (EN(12) && IN(0)) { _Pragma("unroll") for (int rep = 0; rep < NREP(12); ++rep) phase_prologue(C, args); SEAM(0); }
    __syncthreads();
    for (int u = C.tid; u < 64 * 16; u += NWAVES * 64) { const int pos = u >> 4, i = u & 15; const float inv = powf(10000.0f, -(float)(2 * i) / 32.0f); const float ang = (float)pos * inv;
        ((LAS f32x2*)(C.lds + ROPE_OFF))[u] = (f32x2){cosf(ang), sinf(ang)}; }
    __syncthreads();
    for (int l = 0; l < NL; ++l) {
        const int pb = 1 + l * PPL;
        if (EN(0) && IN(pb + 0)) { FRESH(); T0(0); phase_premix(C, args, l); SEAM(pb + 0); T1(0); }
        if (EN(1) && IN(pb + 1)) { FRESH(); T0(1);
            { LAS float* gl = (LAS float*)(C.lds + T2E_OFF); const float* gq = ldin<9>() + l * 64; const float* gk = ldin<10>() + l * 64;
              __syncthreads(); if (C.tid < 128) gl[C.tid] = C.tid < 64 ? gq[C.tid] : gk[C.tid - 64]; __syncthreads(); }
#if MK_FP8_IN == 2
            {
                pg8::Gemm g8{(const pg8::bf16_t*)C.HB8(), (const pg8::bf16_t*)((const unsigned char*)C.HP() + (size_t)l * INW * D), T, 768, D / 2}; pg8::StaticOrder S8; S8.init(T, 768, C.G, (int)blockIdx.x);
                pg8::EpiInProj E8{C.P(), (const LAS float*)(C.lds + ROPE_OFF), (const LAS float*)(C.lds + T2E_OFF), attn_body::C2, 0};
                pg8::gemm_phase<pg8::EpiInProj, pg8::StaticOrder, true, true, true>(C.lds, g8, S8, E8);
                pg8::Gemm g{C.HB(), C.WINT() + ((size_t)l * INW + 768) * D, T, 1280, D}; pg8::StaticOrder S; S.init(T, 1280, C.G, (int)blockIdx.x);
                pg8::EpiInProj E{C.P(), (const LAS float*)(C.lds + ROPE_OFF), (const LAS float*)(C.lds + T2E_OFF), attn_body::C2, 3};
                pg8::gemm_phase<pg8::EpiInProj, pg8::StaticOrder, true, true>(C.lds, g, S, E);
            }
#else
#if MK_FP8_IN == 1
            pg8::Gemm g{C.HB(), (const pg8::bf16_t*)((const unsigned char*)C.WINT() + (size_t)l * INW * D), T, INW, D / 2}; pg8::StaticOrder S; S.init(T, INW, C.G, (int)blockIdx.x);
#else
            pg8::Gemm g{C.HB(), C.WINT() + (size_t)l * INW * D, T, INW, D}; pg8::StaticOrder S; S.init(T, INW, C.G, (int)blockIdx.x);
#endif
            pg8::EpiInProj E{C.P(), (const LAS float*)(C.lds + ROPE_OFF), (const LAS float*)(C.lds + T2E_OFF), attn_body::C2, 0};
_Pragma("unroll") for (int rep = 0; rep < NREP(1); ++rep)
            pg8::gemm_phase<pg8::EpiInProj, pg8::StaticOrder, true, true, MK_FP8_IN == 1>(C.lds, g, S, E);
#endif
            { FRESH(); tail_convert(C, l, NROWT * (INW / 256), CV_HEAD); }
            SEAM(pb + 1); T1(1); }
        if (EN(3) && IN(pb + 3)) { FRESH(); T0(3); _Pragma("unroll") for (int rep = 0; rep < NREP(3); ++rep) phase_attn(C, l); phase_conv1(C, args, l); FRESH(); phase_conv2(C, args, l); SEAM(pb + 3); T1(3); }
        if (EN(5) && IN(pb + 5)) { FRESH(); T0(5);
            pg8::Gemm g{C.Y(), C.WOUTT() + (size_t)l * D * D, T, D, D};
            pg8::EpiGate E{C.OB(), C.MOD() + (size_t)l * 17 * MODW + 2 * D, C.X()};
            if (l + 1 < NL) { pg8::StaticOrder S; S.init(T, D, C.G, (int)blockIdx.x); pg8::gemm_phase<pg8::EpiGate, pg8::StaticOrder, true, true>(C.lds, g, S, E); }
            else { pg8::LatentOrder S; S.init(NB * SQ, D, C.G, (int)blockIdx.x); pg8::gemm_phase<pg8::EpiGate, pg8::LatentOrder, true, true>(C.lds, g, S, E); }
            { FRESH(); tail_convert(C, l, (l + 1 < NL ? NROWT : NB * SQ / 256) * (D / 256), CV_HEAD + tail_items(NROWT * (INW / 256), C.G)); }
            SEAM(pb + 5); T1(5); }
        if (EN(6) && IN(pb + 6)) { FRESH(); T0(6); _Pragma("unroll") for (int rep = 0; rep < NREP(6); ++rep) phase_premoe(C, args, l); SEAM(pb + 6); T1(6); }
        if (EN(10) && IN(pb + 10)) { FRESH(); T0(10);
            moe_tables(C, l, true);
#if MK_FP8
            pg8::Gemm g{(const pg8::bf16_t*)C.HB8(), (const pg8::bf16_t*)((const unsigned char*)C.W1T() + (size_t)l * NE * 2048 * D), CAP, NE * 2048, D / 2};
            pg8::MoeOrder S; S.init((int)C.MISC[NE], 8, C.G, (int)blockIdx.x, (const LAS unsigned char*)(C.lds + T2E_OFF)); S.tok = C.TOK(); S.tstride = T; S.tab = C.MISC;
            pg8::EpiSwiglu8 E{(unsigned char*)C.ACT(), C.B1P() + (size_t)l * NE * 2048};
_Pragma("unroll") for (int rep = 0; rep < NREP(10); ++rep)
            pg8::gemm_phase<pg8::EpiSwiglu8, pg8::MoeOrder, true, true, true, 0x7A7A7A7A, true>(C.lds, g, S, E);
#else
            pg8::Gemm g{C.HP(), C.W1T() + (size_t)l * NE * 2048 * D, CAP, NE * 2048, D};
            pg8::MoeOrder S; S.init((int)C.MISC[NE], 8, C.G, (int)blockIdx.x, (const LAS unsigned char*)(C.lds + T2E_OFF));
            pg8::EpiSwiglu E{C.ACT(), C.B1P() + (size_t)l * NE * 2048};
            pg8::gemm_phase<pg8::EpiSwiglu, pg8::MoeOrder, true, true>(C.lds, g, S, E);
#endif
            SEAM(pb + 10); T1(10); }
        if (EN(11) && IN(pb + 11)) { FRESH(); T0(11);
            moe_tables(C, l, true);
#if MK_FP8
            pg8::Gemm g{C.ACT(), (const pg8::bf16_t*)((const unsigned char*)C.W2T() + (size_t)l * NE * D * D), CAP, NE * D, D / 2};
            pg8::MoeOrder S; S.init((int)C.MISC[NE], 4, C.G, (int)blockIdx.x, (const LAS unsigned char*)(C.lds + T2E_OFF)); S.rev = true;
            pg8::EpiDown E{(unsigned char*)C.YP(), ldin<23>() + (size_t)l * NE * D};
_Pragma("unroll") for (int rep = 0; rep < NREP(11); ++rep)
            pg8::gemm_phase<pg8::EpiDown, pg8::MoeOrder, true, true, true, 0x7D7D7D7D>(C.lds, g, S, E);
#else
            pg8::Gemm g{C.ACT(), C.W2T() + (size_t)l * NE * D * D, CAP, NE * D, D};
            pg8::MoeOrder S; S.init((int)C.MISC[NE], 4, C.G, (int)blockIdx.x, (const LAS unsigned char*)(C.lds + T2E_OFF)); S.rev = true;
            pg8::EpiDown E{(unsigned char*)C.YP(), ldin<23>() + (size_t)l * NE * D};
            pg8::gemm_phase<pg8::EpiDown, pg8::MoeOrder, true, true>(C.lds, g, S, E);
#endif
            SEAM(pb + 11); T1(11); }
    }
    if (EN(13) && IN(NPHASE - 1)) { FRESH(); T0(13); phase_final(C, args); T1(13); }
    if (MK_STAMP >= 0 && blockIdx.x == 0 && C.tid == 0) { asm volatile("s_waitcnt vmcnt(0)" ::: "memory"); ldout()[5] = (float)tacc * 0.001f; }
#undef IN
#undef SEAM
}
}


#if defined(MK_DEBUG)
namespace mkdbg {
using namespace mk;
constexpr size_t WS_DBG = 3420 * MiB;
__device__ const int SROWS[12] = {0, 1, 63, 64, 255, 256, 4095, 4096, 4351, 4352, 30000, 69631};
__device__ __forceinline__ float bfv(const bf16* p, size_t i) { return __builtin_bit_cast(float, (unsigned)p[i] << 16); }
__device__ __forceinline__ void report(float* err, int s, float got, float ref, float atol) {
    float e = fabsf(got - ref) / (fabsf(ref) + atol); if (!(e == e)) e = 100.f;
    atomicMax((unsigned*)err + s, __builtin_bit_cast(unsigned, e));
}
__device__ __forceinline__ void row_info(int r, int& b, int& t, int& j) { b = r / SEG; t = r - b * SEG; j = t < SQ ? b : 16; }
__device__ __forceinline__ float silu_(float v) { return v / (1.f + expf(-v)); }
__device__ __forceinline__ float sigm_(float v) { return 1.f / (1.f + expf(-v)); }
__device__ __forceinline__ void naive_attn(const bf16* P, int r, int h, float* q, float* o) {
    int b, t, j; row_info(r, b, t, j);
    const int k0 = t < SQ ? b * SEG : b * SEG + SQ, nk = t < SQ ? SEG : CL;
    for (int d = 0; d < 64; ++d) q[d] = bfv(P, (size_t)r * INW + h * 64 + d);
    float m = -1e30f;
    for (int kk = 0; kk < nk; ++kk) { float s = 0.f; for (int d = 0; d < 64; ++d) s += q[d] * bfv(P, (size_t)(k0 + kk) * INW + 512 + (h >> 2) * 64 + d); m = fmaxf(m, s); }
    float l = 0.f; for (int d = 0; d < 64; ++d) o[d] = 0.f;
    for (int kk = 0; kk < nk; ++kk) { float s = 0.f; for (int d = 0; d < 64; ++d) s += q[d] * bfv(P, (size_t)(k0 + kk) * INW + 512 + (h >> 2) * 64 + d);
        const float p = exp2f(s - m); l += p; for (int d = 0; d < 64; ++d) o[d] += p * bfv(P, (size_t)(k0 + kk) * INW + 640 + (h >> 2) * 64 + d); }
    for (int d = 0; d < 64; ++d) o[d] /= l;
}
__device__ const int DBG_LS_1[2] = {0, 3};
__device__ const int DBG_JS_2[3] = {0, 7, 16};
__device__ const int DBG_NS_3[4] = {0, 1000, 2053, 6143};
__device__ const int DBG_CS_4[4] = {0, 1, 511, 1023};
__device__ const int DBG_CS_5[16] = {0, 63, 64, 511, 512, 575, 639, 640, 767, 768, 1024, 1279, 1280, 1536, 1792, 2047};
__device__ const int DBG_HS_6[4] = {0, 7, 8, 9};
__device__ const int DBG_HS_7[2] = {0, 5};
__device__ const int DBG_CS_8[4] = {0, 255, 256, 1023};
__device__ const int DBG_ES_9[3] = {0, 7, 31};
__device__ const int DBG_CS_10[3] = {0, 500, 1023};
__device__ const int DBG_CS_11[4] = {0, 127, 128, 1023};
__device__ const int DBG_CS_12[4] = {0, 300, 511, 1023};
__device__ const int DBG_CS_13[4] = {0, 300, 511, 1023};
__device__ const int DBG_CS_14[4] = {0, 300, 511, 1023};
__global__ void __launch_bounds__(256) dbg_kernel(Args a, int stage) {
    unsigned char* ws = a.ws; float* err = (float*)(ws + WS_DBG); float* scr = err + 256;
    const float* MOD = (const float*)(ws + WS_MOD); const bf16* HB = (const bf16*)(ws + WS_HB); const bf16* P = (const bf16*)(ws + WS_P); const bf16* Y = (const bf16*)(ws + WS_Y);
    const float* X = (const float*)(ws + WS_X); const float* LOG = (const float*)(ws + WS_LOG); const v2u* PAIR = (const v2u*)(ws + WS_PAIR); const int* TOK = (const int*)(ws + WS_TOK);
    const bf16* HP = (const bf16*)(ws + WS_HP); const bf16* ACT = (const bf16*)(ws + WS_ACT); const bf16* YP = (const bf16*)(ws + WS_YP);
    const unsigned* cnt = (const unsigned*)(ws + WS_CTL) + CW_CNT;
    const int tid = threadIdx.x;
    __shared__ float shm[15360]; __shared__ unsigned tstart[33];
    if (stage == 0) { if (tid < 64) err[tid] = 0.f; return; }
    if (stage == 1) {
        const int* ls = DBG_LS_1; const int* js = DBG_JS_2; const int* ns = DBG_NS_3;
        if (tid < 24) { const int l = ls[tid / 12], j = js[(tid / 4) % 3], n = ns[tid % 4]; float s = 0.f;
            for (int k = 0; k < 1024; ++k) { const float c = j < 16 ? a.in[1][j * 1024 + k] : a.in[3][k]; s += silu_(c) * a.in[4][((size_t)l * 1024 + k) * MODW + n]; }
            s += a.in[5][l * MODW + n]; report(err, 1, MOD[((size_t)l * 17 + j) * MODW + n], s, 0.05f); }
        return; }
    if (stage == 2 || stage == 8) {
        const int* cs = DBG_CS_4;
        if (tid < 48) { const int r = SROWS[tid / 4], c = cs[tid % 4]; int b, t, j; row_info(r, b, t, j);
            const float* xr = stage == 2 ? (t < SQ ? a.in[0] + ((size_t)b * SQ + t) * D : a.in[2] + ((size_t)b * CL + (t - SQ)) * D) : X + (size_t)r * D;
            float ss = 0.f; for (int k = 0; k < D; ++k) ss += xr[k] * xr[k];
            const float rs = 1.f / sqrtf(ss / D + EPS); const float* g = stage == 2 ? a.in[6] : a.in[7]; const float* mj = MOD + (size_t)j * MODW + (stage == 2 ? 0 : 3 * D);
            const float h = xr[c] * rs * g[c] * (1.f + mj[D + c]) + mj[c];
            report(err, stage, bfv(HB, (size_t)r * D + c), h, 0.05f);
            if (stage == 2) report(err, stage, X[(size_t)r * D + c], xr[c], 0.01f); }
        return; }
    if (stage == 3) {
        const int* cs = DBG_CS_5;
        if (tid < 192) { const int r = SROWS[tid / 16], c = cs[tid % 16]; float s = 0.f;
            for (int k = 0; k < D; ++k) s += bfv(HB, (size_t)r * D + k) * a.in[8][(size_t)k * INW + c];
            report(err, 3, bfv(P, (size_t)r * INW + c), s, 0.05f); }
        return; }
    if (stage == 4) {
        const int* hs = DBG_HS_6;
        if (tid < 48) { const int r = SROWS[tid / 4], h = hs[tid % 4]; int b, t, j; row_info(r, b, t, j);
            float* raw = shm + tid * 128; float* o = raw + 64; float ss = 0.f;
            for (int d = 0; d < 64; ++d) { float s = 0.f; for (int k = 0; k < D; ++k) s += bfv(HB, (size_t)r * D + k) * a.in[8][(size_t)k * INW + h * 64 + d]; raw[d] = s; ss += s * s; }
            const float rs = 1.f / sqrtf(ss / 64.f + EPS); const float* g = h < 8 ? a.in[9] : a.in[10];
            for (int d = 0; d < 64; ++d) raw[d] = raw[d] * rs * g[d];
            for (int ax = 0; ax < 2; ++ax) for (int i = 0; i < 16; ++i) { const float pos = ax == 0 ? (float)(t / 64) : (float)(t % 64); const float ang = pos * powf(10000.f, -(float)(2 * i) / 32.f);
                const float c = t < SQ ? cosf(ang) : 1.f, s = t < SQ ? sinf(ang) : 0.f; const float x1 = raw[ax * 32 + i], x2 = raw[ax * 32 + 16 + i];
                o[ax * 32 + i] = x1 * c - x2 * s; o[ax * 32 + 16 + i] = x2 * c + x1 * s; }
            for (int d = 0; d < 64; ++d) { const float ref = o[d] * (h < 8 ? 0.125f * 1.4426950408889634f : 1.f); report(err, 4, bfv(P, (size_t)r * INW + h * 64 + d), ref, h < 8 ? 0.045f : 0.25f); } }
        return; }
    if (stage == 5) {
        const int* hs = DBG_HS_7;
        if (tid < 24) { const int r = SROWS[tid / 2], h = hs[tid % 2]; float* o = shm + tid * 128; naive_attn(P, r, h, o + 64, o);
            for (int d = 0; d < 64; ++d) report(err, 5, bfv(Y, (size_t)r * D + h * 64 + d), o[d], 0.05f); }
        return; }
    if (stage == 6) {
        if (tid < 12) { const int r = SROWS[tid]; int b, t, j; row_info(r, b, t, j); const int lo = t < SQ ? 0 : SQ, hi = t < SQ ? SQ : SEG; const size_t rb = (size_t)b * SEG;
            float* u = shm + tid * 256; float mean = 0.f;
            for (int c = 0; c < 256; ++c) { float s = a.in[12][c];
                for (int jt = 0; jt < 31; ++jt) { const int tt = t + jt - 15; if (tt >= lo && tt < hi) s += a.in[11][jt * 256 + c] * bfv(P, (rb + tt) * INW + 768 + c) * sigm_(bfv(P, (rb + tt) * INW + 1024 + c)); }
                u[c] = s; mean += s; }
            mean /= 256.f; float var = 0.f; for (int c = 0; c < 256; ++c) var += (u[c] - mean) * (u[c] - mean); var /= 256.f;
            float ss = 0.f; for (int c = 0; c < 256; ++c) { const float y = (u[c] - mean) / sqrtf(var + EPS) * a.in[13][c] + a.in[14][c]; u[c] = silu_(y); ss += u[c] * u[c]; }
            float rs = 1.f / sqrtf(ss / 256.f + EPS);
            for (int c = 0; c < 256; ++c) report(err, 6, bfv(Y, (size_t)r * D + 512 + c), u[c] * rs * a.in[16][512 + c], 0.25f);
            ss = 0.f;
            for (int c = 0; c < 256; ++c) { float s = 0.f; for (int jt = 0; jt < 3; ++jt) { const int tt = t + jt - 1; if (tt >= lo && tt < hi) s += a.in[15][jt * 256 + c] * bfv(P, (rb + tt) * INW + 1536 + c) * bfv(P, (rb + tt) * INW + 1792 + c); }
                u[c] = bfv(P, (size_t)r * INW + 1280 + c) * s; ss += u[c] * u[c]; }
            rs = 1.f / sqrtf(ss / 256.f + EPS);
            for (int c = 0; c < 256; ++c) report(err, 7, bfv(Y, (size_t)r * D + 768 + c), u[c] * rs * a.in[16][768 + c], 0.25f); }
        if (tid >= 64 && tid < 80) { const int r = SROWS[(tid - 64) / 8 == 0 ? 2 : 7], h = (tid - 64) % 8; float* o = shm + 3072 + (tid - 64) * 128; naive_attn(P, r, h, o + 64, o);
            for (int d = 0; d < 64; ++d) scr[((tid - 64) / 8) * 512 + h * 64 + d] = o[d]; }
        __syncthreads();
        if (tid < 2) { const int r = SROWS[tid == 0 ? 2 : 7]; float ss = 0.f; for (int c = 0; c < 512; ++c) ss += scr[tid * 512 + c] * scr[tid * 512 + c];
            const float rs = 1.f / sqrtf(ss / 512.f + EPS); for (int c = 0; c < 512; ++c) report(err, 6, bfv(Y, (size_t)r * D + c), scr[tid * 512 + c] * rs * a.in[16][c], 0.25f); }
        return; }
    if (stage == 9) {
        const int* cs = DBG_CS_8;
        if (tid < 48) { const int r = SROWS[tid / 4], c = cs[tid % 4]; int b, t, j; row_info(r, b, t, j);
            const float* xr = t < SQ ? a.in[0] + ((size_t)b * SQ + t) * D : a.in[2] + ((size_t)b * CL + (t - SQ)) * D;
            float s = 0.f; for (int k = 0; k < D; ++k) s += bfv(Y, (size_t)r * D + k) * a.in[17][(size_t)k * D + c];
            report(err, 9, X[(size_t)r * D + c], xr[c] + MOD[(size_t)j * MODW + 2 * D + c] * s, 0.05f); }
        return; }
    if (stage == 10) {
        const int* es = DBG_ES_9;
        if (tid < 36) { const int r = SROWS[tid / 3], e = es[tid % 3]; float s = 0.f; for (int k = 0; k < D; ++k) s += bfv(HB, (size_t)r * D + k) * a.in[18][(size_t)k * NE + e];
            report(err, 10, LOG[(size_t)r * NE + e], s, 0.05f); }
        return; }
    if (stage == 11) {
        if (tid < 12) { const int r = SROWS[tid]; float* v = shm + tid * 32; for (int e = 0; e < 32; ++e) v[e] = LOG[(size_t)r * NE + e] + a.in[19][e];
            float* sv = shm + 1024 + tid * 8; float* sef = sv + 4;
            for (int k = 0; k < 4; ++k) { int bi = 0; for (int e = 1; e < 32; ++e) if (v[e] > v[bi]) bi = e; sef[k] = (float)bi; sv[k] = v[bi]; v[bi] = -1e30f; }
            float den = 0.f; for (int k = 0; k < 4; ++k) den += expf(sv[k] - sv[0]);
            { float* vv = shm + 2048 + tid * 32; for (int e = 0; e < 32; ++e) vv[e] = LOG[(size_t)r * NE + e] + a.in[19][e];
              float mx = -1e30f, dn = 0.f; for (int k = 0; k < 4; ++k) mx = fmaxf(mx, vv[PAIR[(size_t)r * 4 + k].x & 31]); for (int k = 0; k < 4; ++k) dn += expf(vv[PAIR[(size_t)r * 4 + k].x & 31] - mx);
              for (int k = 0; k < 4; ++k) report(err, 22, __uint_as_float((unsigned)(PAIR[(size_t)r * 4 + k].y + 0u)), expf(vv[PAIR[(size_t)r * 4 + k].x & 31] - mx) / dn, 0.01f); }
            for (int k = 0; k < 4; ++k) { const v2u pr = PAIR[(size_t)r * 4 + k]; const int e = pr.x & 31; const unsigned pos = pr.x >> 5;
                if (tid == 0 && (k == 0 || k == 3)) { err[30 + (k ? 2 : 0)] = __uint_as_float((unsigned)(pr.y + 0u)); err[31 + (k ? 2 : 0)] = expf(sv[k] - sv[0]) / den; }
                report(err, 17, (float)e == sef[k] ? 0.f : 1.f, 0.f, 1.0f); report(err, 18, __uint_as_float((unsigned)(pr.y + 0u)), expf(sv[k] - sv[0]) / den, 0.01f);
                const unsigned c = cnt[e * 64]; report(err, 19, pos < c ? 1.f : 0.f, 1.f, 0.001f); report(err, 20, (float)TOK[(size_t)e * T + (pos < (unsigned)T ? pos : 0)], (float)r, 0.001f); } }
        if (tid == 255) { unsigned s = 0; for (int e = 0; e < 32; ++e) s += cnt[e * 64]; report(err, 21, (float)s, (float)(T * 4), 0.001f); }
        if (tid == 253) { int c = 0; const float* pf = (const float*)PAIR; for (int q = 0; q < 64; ++q) { const float w = pf[q * 2 + 1]; if (w > 0.01f && w <= 1.f) ++c; } err[44] = (float)c; }
        if (tid == 254) { for (int k = 0; k < 4; ++k) { const float w = __uint_as_float((unsigned)(PAIR[k].y + 0u)); err[40 + k] = (float)(!(w == w) || w < 0.f || w > 1.f ? 3 : w < 1e-30f ? 0 : w < 0.05f ? 1 : 2); } }
        return; }
    if (tid == 0) { unsigned s = 0; for (int e = 0; e < 32; ++e) { tstart[e] = s; s += (cnt[e * 64] + 255u) >> 8; } tstart[32] = s; }
    __syncthreads();
    if (stage == 12) {
        const int* cs = DBG_CS_10;
        if (tid < 48) { const int r = SROWS[tid / 4], k = tid % 4; const v2u pr = PAIR[(size_t)r * 4 + k]; const size_t slot = (size_t)tstart[pr.x & 31] * 256 + (pr.x >> 5);
            for (int i = 0; i < 3; ++i) report(err, 12, bfv(HP, slot * D + cs[i]), bfv(HB, (size_t)r * D + cs[i]), 0.001f); }
        return; }
    if (stage == 13) {
        const int* cs = DBG_CS_11;
        if (tid < 192) { const int r = SROWS[tid / 16], k = (tid / 4) % 4, c = cs[tid % 4]; const v2u pr = PAIR[(size_t)r * 4 + k]; const int e = pr.x & 31; const size_t slot = (size_t)tstart[e] * 256 + (pr.x >> 5);
            float ug = a.in[21][(size_t)e * 2048 + 2 * c], uu = a.in[21][(size_t)e * 2048 + 2 * c + 1]; const float* w = a.in[20] + (size_t)e * 1024 * 2048;
            for (int kk = 0; kk < D; ++kk) { const float hv = bfv(HP, slot * D + kk); ug += hv * w[(size_t)kk * 2048 + 2 * c]; uu += hv * w[(size_t)kk * 2048 + 2 * c + 1]; }
            const float gc = fminf(ug, 7.f), uc = fminf(fmaxf(uu, -7.f), 7.f); const float ref = (uc + 1.f) * gc * sigm_(1.702f * gc);
            report(err, 13, bfv(ACT, slot * D + c), ref, 0.25f); }
        return; }
    if (stage == 14) {
        const int* cs = DBG_CS_12;
        if (tid < 192) { const int r = SROWS[tid / 16], k = (tid / 4) % 4, c = cs[tid % 4]; const v2u pr = PAIR[(size_t)r * 4 + k]; const int e = pr.x & 31; const size_t slot = (size_t)tstart[e] * 256 + (pr.x >> 5);
            float s = a.in[23][(size_t)e * 1024 + c]; const float* w = a.in[22] + (size_t)e * 1024 * 1024;
            for (int kk = 0; kk < D; ++kk) s += bfv(ACT, slot * D + kk) * w[(size_t)kk * 1024 + c];
            report(err, 14, bfv(YP, slot * D + c), s, 0.25f); }
        return; }
    if (stage == 15) {
        const int* cs = DBG_CS_13;
        if (tid < 48) { const int r = SROWS[tid / 4], c = cs[tid % 4]; int b, t, j; row_info(r, b, t, j); float f = 0.f;
            for (int k = 0; k < 4; ++k) { const v2u pr = PAIR[(size_t)r * 4 + k]; const size_t slot = (size_t)tstart[pr.x & 31] * 256 + (pr.x >> 5); f += __uint_as_float((unsigned)(pr.y + 0u)) * bfv(YP, slot * D + c); }
            scr[2048 + tid] = X[(size_t)r * D + c] + MOD[(size_t)j * MODW + 5 * D + c] * f; }
        return; }
    if (stage == 16) {
        const int* cs = DBG_CS_14;
        if (tid < 48) { const int r = SROWS[tid / 4], c = cs[tid % 4]; report(err, 16, X[(size_t)r * D + c], scr[2048 + tid], 0.02f); }
        return; }
    if (stage == 99) {
        if (tid == 0) {
#if MK_DEBUG == 3
            a.out[0] = (err[44] + 1.f) * 1e20f; return;
#endif
#if MK_DEBUG == 2
            { const float* db = err + 4096; const v2u* PR = (const v2u*)(a.ws + WS_PAIR); int code = 0;
              auto close = [](float x, float y) { return fabsf(x - y) <= 1e-3f * (fabsf(y) + 1e-3f); };
              for (int ln = 0; ln < 4 && !code; ++ln) for (int j = 0; j < 4; ++j) if (!(db[ln * 16 + j] == db[j])) { code = 10 + ln; break; }
              if (!code) for (int j = 0; j < 3; ++j) if (!(db[j] >= db[j + 1])) code = 20 + j;
              if (!code) for (int ln = 0; ln < 4 && !code; ++ln) for (int j = 0; j < 3; ++j) if (!close(db[ln * 16 + 4 + j], expf(db[j + 1] - db[0]))) { code = 30 + ln; break; }
              if (!code) for (int ln = 0; ln < 4; ++ln) if (!close(db[ln * 16 + 7], 1.f + db[ln * 16 + 4] + db[ln * 16 + 5] + db[ln * 16 + 6])) { code = 40 + ln; break; }
              if (!code) for (int ln = 0; ln < 4; ++ln) if (!close(db[ln * 16 + 8], 1.f / db[ln * 16 + 7])) { code = 50 + ln; break; }
              if (!code) for (int ln = 0; ln < 4; ++ln) if (!close(db[ln * 16 + 9], (ln == 0 ? 1.f : db[ln * 16 + 3 + ln]) * db[ln * 16 + 8])) { code = 60 + ln; break; }
              if (!code) for (int ln = 0; ln < 4; ++ln) if (!close(__uint_as_float((unsigned)(PR[ln].y + 0u)), db[ln * 16 + 9])) { code = 70 + ln; break; }
              if (!code) code = 88;
              a.out[0] = (float)code * 1e20f; return; }
#endif
            int mask = 0; for (int i = 0; i < 6; ++i) if (err[17 + i] > 0.06f) mask |= 1 << i; if (mask) err[11] = 1.f;
            for (int s = 1; s < 17; ++s) if (err[s] > 0.06f) { if (s == 11) { a.out[0] = (float)(10 + mask) * 1e14f; break; } a.out[0] = (1.f + 10.f * fminf(err[s], 0.89f)) * powf(10.f, (float)(4 + s)); break; } }
        return; }
}
}
#endif
#ifndef MK_ONE_LAUNCH
#define MK_ONE_LAUNCH 1
#endif
extern "C" void kernel_launch(void* const* d_in, const int* in_sizes, int n_in, void* d_out, int out_size, void* d_ws, size_t ws_size, hipStream_t stream) {
    using namespace mk;
    static int grid = 0;
    if (grid == 0) {
        if (n_in != 24 || out_size != NB * SQ * D || ws_size < WS_END) { fprintf(stderr, "kernel_launch: unexpected shapes (n_in %d, out %d, ws %zu)\n", n_in, out_size, ws_size); grid = -1; return; }
        int dev = 0, cus = 0, per_cu = 0;
        if (hipGetDevice(&dev) != hipSuccess || hipDeviceGetAttribute(&cus, hipDeviceAttributeMultiprocessorCount, dev) != hipSuccess) { grid = -1; return; }
        if (hipFuncSetAttribute((const void*)mk_fwd, hipFuncAttributeMaxDynamicSharedMemorySize, LDS_BYTES) != hipSuccess) { fprintf(stderr, "kernel_launch: hipFuncSetAttribute failed\n"); grid = -1; return; }
        if (hipOccupancyMaxActiveBlocksPerMultiprocessor(&per_cu, (const void*)mk_fwd, NWAVES * 64, LDS_BYTES) != hipSuccess || per_cu < 1) { fprintf(stderr, "kernel_launch: occupancy query says %d\n", per_cu); per_cu = 1; }
        (void)hipGetLastError();
        grid = cus;
    }
    if (grid < 0) return;
    (void)hipMemsetAsync((char*)d_ws + WS_CTL, 0, CTL_ZERO_BYTES, stream);
    Args a{};
    for (int i = 0; i < 24; ++i) a.in[i] = (const float*)d_in[i];
    a.out = (float*)d_out; a.ws = (unsigned char*)d_ws;
#if MK_ONE_LAUNCH
    a.ph_lo = 0; a.ph_hi = NPHASE;
    hipLaunchKernelGGL(mk_fwd, dim3(grid), dim3(NWAVES * 64), LDS_BYTES, stream, a);
#else
#if defined(MK_DEBUG)
#define DBG(s) hipLaunchKernelGGL(mkdbg::dbg_kernel, dim3(1), dim3(256), 0, stream, a, (s))
    DBG(0);
#else
#define DBG(s) do {} while (0)
#endif
    for (int p = 0; p < NPHASE; ++p) { a.ph_lo = p; a.ph_hi = p + 1; hipLaunchKernelGGL(mk_fwd, dim3(grid), dim3(NWAVES * 64), LDS_BYTES, stream, a);
        if (p == 0) DBG(1); if (p == 1) DBG(2); if (p == 2) DBG(3); if (p == 3) DBG(4); if (p == 4) DBG(5); if (p == 5) DBG(6); if (p == 6) DBG(9); if (p == 7) DBG(8); if (p == 8) DBG(10);
        if (p == 9) DBG(11); if (p == 10) DBG(12); if (p == 11) DBG(13); if (p == 12) { DBG(14); DBG(15); } if (p == 13) DBG(16); }
    DBG(99);
#endif
}
```

```cpp
#include <hip/hip_runtime.h>
#include <hip/hip_bf16.h>
#include <cstdio>
#include <cstdint>
#include <cmath>
namespace pg8 {
#define PG8_LAS __attribute__((address_space(3)))
typedef unsigned short bf16_t;
typedef short bf16x8 __attribute__((ext_vector_type(8)));
typedef float f32x4 __attribute__((ext_vector_type(4)));
typedef unsigned u32x4 __attribute__((ext_vector_type(4)));
typedef int i32x4 __attribute__((ext_vector_type(4)));
typedef int i32x8 __attribute__((ext_vector_type(8)));
typedef unsigned u32x2 __attribute__((ext_vector_type(2)));
constexpr int PG8_BIAS_OFF = 144384;
constexpr int PG8_IDX_OFF = PG8_BIAS_OFF + 2048;
constexpr int BM = 256, BK = 64, HALF = 128, HTB = HALF * BK * 2  , STAGE_BYTES = 8 * HTB, NXCD = 8, WGM = 8;

__host__ __device__ __forceinline__ int lds_byte(int r, int c) { const int st = (r >> 4) * 2 + (c >> 5), rr = r & 15, cc = c & 31, ob = rr * 64 + cc * 2; return st * 1024 + (ob ^ (((ob >> 9) & 1) << 5)); }
__host__ __device__ __forceinline__ void stage_rc(int b, int& R, int& C) { const int st = b / 1024, sb = b % 1024, swz = sb ^ (((sb >> 9) & 1) << 5); R = (st >> 1) * 16 + swz / 64; C = (st & 1) * 32 + (swz % 64) / 2; }
__host__ __device__ __forceinline__ int perm32(int rho) { const int n = rho >> 4, i = rho & 15; return 8 * (i >> 2) + 4 * n + (i & 3); }

__device__ __forceinline__ int shx(int v, int o) { int l = __builtin_amdgcn_mbcnt_hi(-1, __builtin_amdgcn_mbcnt_lo(-1, 0)); asm volatile("" : "+v"(l)); return __builtin_amdgcn_ds_bpermute((l ^ o) << 2, v); }
__device__ __forceinline__ float shx(float v, int o) { return __int_as_float(shx(__float_as_int(v), o)); }
template <int CTRL> __device__ __forceinline__ float dpp_f(float v) { return __int_as_float(__builtin_amdgcn_update_dpp(0, __float_as_int(v), CTRL, 0xF, 0xF, true)); }
__device__ __forceinline__ float sum_x16(float v) { const auto r = __builtin_amdgcn_permlane16_swap(__float_as_uint(v), __float_as_uint(v), false, false); return __uint_as_float(r[0]) + __uint_as_float(r[1]); }
__device__ __forceinline__ float sum_x32(float v) { const auto r = __builtin_amdgcn_permlane32_swap(__float_as_uint(v), __float_as_uint(v), false, false); return __uint_as_float(r[0]) + __uint_as_float(r[1]); }
__device__ __forceinline__ float get_x32(float v, bool lo_half) { const auto r = __builtin_amdgcn_permlane32_swap(__float_as_uint(v), __float_as_uint(v), false, false); return __uint_as_float(lo_half ? r[1] : r[0]); }
__device__ __forceinline__ float get_x16(float v, bool even_row) { const auto r = __builtin_amdgcn_permlane16_swap(__float_as_uint(v), __float_as_uint(v), false, false); return __uint_as_float(even_row ? r[1] : r[0]); }
__device__ __forceinline__ float wsum(float v) { v += dpp_f<0xB1>(v); v += dpp_f<0x4E>(v); v += dpp_f<0x141>(v); v += dpp_f<0x140>(v); v = sum_x16(v); return sum_x32(v); }
struct Unit { int pm, pn; };
struct Gemm { const bf16_t* A; const bf16_t* Bt; int M, N, K; };

struct StaticOrder {
    int nM, nN, nwg, G, c;
    __host__ __device__ void init(int M, int N, int G_, int c_) { nM = M / BM; nN = N / BM; nwg = nM * nN; G = G_; c = c_; }
    __host__ __device__ bool next(int i, Unit& u) const {
        const long L = (long)i * G + c; if (L >= nwg) return false;
        int wgid = (int)L; { const int q = nwg / NXCD, r = nwg % NXCD, xcd = wgid % NXCD, off = wgid / NXCD; wgid = (xcd < r ? xcd * (q + 1) : r * (q + 1) + (xcd - r) * q) + off; }
        const int nig = WGM * nN, gid = wgid / nig, fm = gid * WGM, gsz = (nM - fm) < WGM ? (nM - fm) : WGM;
        u.pm = fm + ((wgid % nig) % gsz); u.pn = (wgid % nig) / gsz; return true;
    }
    __device__ __forceinline__ void a_ready(const Unit&) const {}
    __device__ __forceinline__ void done(const Unit&) const {}
};

struct LatentOrder : StaticOrder {
    __host__ __device__ bool next(int i, Unit& u) const { if (!StaticOrder::next(i, u)) return false; u.pm += u.pm >> 4; return true; }
};

__device__ __forceinline__ unsigned cvt_pk_bf16(float lo, float hi) { unsigned r; asm volatile("v_cvt_pk_bf16_f32 %0, %1, %2" : "=v"(r) : "v"(lo), "v"(hi)); return r; }
typedef float f32x2 __attribute__((ext_vector_type(2)));

struct MoeOrder {
    int nN, ntl, nwg, G, c; const PG8_LAS unsigned char* t2e; bool rev = false;
    const int* tok; int tstride; const volatile PG8_LAS unsigned* tab;
    __device__ __forceinline__ const int* idx_src(const Unit& u) const { const int e = u.pn / nN; return tok + (size_t)e * tstride + (size_t)(u.pm - (int)tab[e]) * 256; }
    __device__ __forceinline__ int nvalid(const Unit& u) const { const int e = u.pn / nN; return (int)tab[40 + e] - (u.pm - (int)tab[e]) * 256; }
    __device__ __forceinline__ void init(int ntl_, int nN_, int G_, int c_, const PG8_LAS unsigned char* t2e_) { ntl = ntl_; nN = nN_; nwg = ntl_ * nN_; G = G_; c = c_; t2e = t2e_; }
    __device__ __forceinline__ bool next(int i, Unit& u) const {
        const long L = (long)i * G + c; if (L >= nwg) return false;
        int wgid = (int)L; { const int q = nwg / NXCD, r = nwg % NXCD, xcd = wgid % NXCD; int off = wgid / NXCD; if (rev) off = (xcd < r ? q : q - 1) - off;
            wgid = (xcd < r ? xcd * (q + 1) : r * (q + 1) + (xcd - r) * q) + off; }
        const int nig = WGM * nN, gid = wgid / nig, fm = gid * WGM, gsz = (ntl - fm) < WGM ? (ntl - fm) : WGM;
        const int rt = fm + ((wgid % nig) % gsz), pn = (wgid % nig) / gsz;
        u.pm = rt; u.pn = (int)t2e[rt] * nN + pn; return true;
    }
    __device__ __forceinline__ void a_ready(const Unit&) const {}
    __device__ __forceinline__ void done(const Unit&) const {}
};

struct EpiStore {
    static constexpr int EPI_ID = 0; static constexpr bool PERM = true, AFTER_DRAIN = false, HAS_INIT = false;
    bf16_t* O; int ldc;
    __device__ __forceinline__ void operator()(const f32x4 (&acc)[2][2][4][2], const Unit& u, int wr, int wc, int fr, int fq) const {
        const int row0 = u.pm * BM + wr * 64 + fr, col0 = u.pn * BM + wc * 32 + 8 * fq;
#pragma unroll
        for (int ai = 0; ai < 2; ++ai)
#pragma unroll
            for (int m = 0; m < 4; ++m) { bf16_t* rowp = O + (size_t)(row0 + ai * HALF + m * 16) * ldc + col0;
#pragma unroll
                for (int bj = 0; bj < 2; ++bj) { const f32x4 v0 = acc[ai][bj][m][0], v1 = acc[ai][bj][m][1];
                    u32x4 w; w.x = cvt_pk_bf16(v0[0], v0[1]); w.y = cvt_pk_bf16(v0[2], v0[3]); w.z = cvt_pk_bf16(v1[0], v1[1]); w.w = cvt_pk_bf16(v1[2], v1[3]);
                    *(u32x4*)(rowp + bj * HALF) = w; } }
    }
};
struct EpiResid {
    static constexpr int EPI_ID = 1; static constexpr bool PERM = false, AFTER_DRAIN = false, HAS_INIT = false;
    float* X; const float* gate;
    __device__ __forceinline__ void operator()(const f32x4 (&acc)[2][2][4][2], const Unit& u, int wr, int wc, int fr, int fq) const {
        const int seg = u.pm / 17, rem = u.pm - seg * 17; const int j = (rem == 16) ? 16 : seg;
        const int row0 = u.pm * BM + wr * 64 + fr, col0 = u.pn * BM + wc * 32 + 4 * fq;
        const float* g = gate + (size_t)j * 6144 + col0;
        f32x4 gv[2][2];
#pragma unroll
        for (int bj = 0; bj < 2; ++bj)
#pragma unroll
            for (int n = 0; n < 2; ++n) gv[bj][n] = *(const f32x4*)(g + bj * HALF + n * 16);
#pragma unroll
        for (int ai = 0; ai < 2; ++ai)
#pragma unroll
            for (int m = 0; m < 4; ++m) { float* rowp = X + (size_t)(row0 + ai * HALF + m * 16) * 1024 + col0;
#pragma unroll
                for (int bj = 0; bj < 2; ++bj)
#pragma unroll
                    for (int n = 0; n < 2; ++n) { f32x4* p = (f32x4*)(rowp + bj * HALF + n * 16); *p = *p + gv[bj][n] * acc[ai][bj][m][n]; } }
    }
};
struct EpiInProj {
    static constexpr int EPI_ID = 2; static constexpr bool PERM = true, AFTER_DRAIN = false, HAS_INIT = false;
    bf16_t* P; const PG8_LAS float* rope; const PG8_LAS float* gqk; float c2; int pn0;
    __device__ __forceinline__ void operator()(const f32x4 (&acc)[2][2][4][2], const Unit& u, int wr, int wc, int fr, int fq) const {
        const int pnt = u.pn + pn0; const int row0 = u.pm * BM + wr * 64 + fr, col0 = pnt * BM + 64 * wc + 8 * fq;
        const bool isq = pnt < 2, isk = pnt == 2 && wc < 2;
        if (!(isq || isk)) {
#pragma unroll
            for (int ai = 0; ai < 2; ++ai)
#pragma unroll
                for (int m = 0; m < 4; ++m) { bf16_t* rowp = P + (size_t)(row0 + ai * HALF + m * 16) * 2048 + col0;
#pragma unroll
                    for (int bj = 0; bj < 2; ++bj) { const f32x4 v0 = acc[ai][bj][m][0], v1 = acc[ai][bj][m][1];
                        u32x4 w; w.x = cvt_pk_bf16(v0[0], v0[1]); w.y = cvt_pk_bf16(v0[2], v0[3]); w.z = cvt_pk_bf16(v1[0], v1[1]); w.w = cvt_pk_bf16(v1[2], v1[3]);
                        *(u32x4*)(rowp + 32 * bj) = w; } }
            return; }
        const PG8_LAS float* gp = gqk + (isq ? 0 : 64) + 8 * fq; const float sc = isq ? c2 : 1.0f;
        f32x4 gn[2][2];
#pragma unroll
        for (int bj = 0; bj < 2; ++bj)
#pragma unroll
            for (int n = 0; n < 2; ++n) gn[bj][n] = *(const PG8_LAS f32x4*)(gp + 32 * bj + 4 * n);
        const int seg = u.pm / 17, rem = u.pm - seg * 17; const bool lat = rem != 16;
        const bool first = fq < 2; const int i0 = 8 * (fq & 1);
#pragma unroll
        for (int ai = 0; ai < 2; ++ai)
#pragma unroll
            for (int m = 0; m < 4; ++m) { const int lr = wr * 64 + fr + ai * HALF + m * 16, t = rem * 256 + lr;
                f32x4 x[2][2]; float ss = 0.f;
#pragma unroll
                for (int bj = 0; bj < 2; ++bj)
#pragma unroll
                    for (int n = 0; n < 2; ++n) { x[bj][n] = acc[ai][bj][m][n]; ss += (x[bj][n][0] * x[bj][n][0] + x[bj][n][1] * x[bj][n][1]) + (x[bj][n][2] * x[bj][n][2] + x[bj][n][3] * x[bj][n][3]); }
                ss = sum_x32(sum_x16(ss));
                const float rs = __builtin_amdgcn_rsqf(ss * (1.0f / 64.0f) + 1e-6f);
                bf16_t* rowp = P + (size_t)(u.pm * BM + lr) * 2048 + col0;
#pragma unroll
                for (int bj = 0; bj < 2; ++bj) { const int pos = lat ? (bj == 0 ? (t >> 6) : (t & 63)) : 0;
                    f32x4 o[2];
#pragma unroll
                    for (int n = 0; n < 2; ++n)
#pragma unroll
                        for (int i = 0; i < 4; ++i) { const float xv = x[bj][n][i] * rs * gn[bj][n][i]; const float pv = get_x32(xv, first);
                            const float cs = rope[(pos * 16 + i0 + 4 * n + i) * 2], sn = rope[(pos * 16 + i0 + 4 * n + i) * 2 + 1];
                            const float rot = first ? xv * cs - pv * sn : xv * cs + pv * sn;
                            o[n][i] = (lat ? rot : xv) * sc; }
                    u32x4 w; w.x = cvt_pk_bf16(o[0][0], o[0][1]); w.y = cvt_pk_bf16(o[0][2], o[0][3]); w.z = cvt_pk_bf16(o[1][0], o[1][1]); w.w = cvt_pk_bf16(o[1][2], o[1][3]);
                    *(u32x4*)(rowp + 32 * bj) = w; } }
    }
};
struct EpiGate {
    static constexpr int EPI_ID = 3; static constexpr bool PERM = true, AFTER_DRAIN = false, HAS_INIT = false;
    bf16_t* O; const float* gate; const bf16_t* X;
    __device__ __forceinline__ void operator()(const f32x4 (&acc)[2][2][4][2], const Unit& u, int wr, int wc, int fr, int fq) const {
        const int seg = u.pm / 17, rem = u.pm - seg * 17; const int j = (rem == 16) ? 16 : seg;
        const int row0 = u.pm * BM + wr * 64 + fr, col0 = u.pn * BM + wc * 32 + 8 * fq;
        const float* g = gate + (size_t)j * 6144 + col0;
        f32x4 gv[2][2];
#pragma unroll
        for (int bj = 0; bj < 2; ++bj)
#pragma unroll
            for (int n = 0; n < 2; ++n) gv[bj][n] = *(const f32x4*)(g + bj * HALF + 4 * n);
#pragma unroll
        for (int ai = 0; ai < 2; ++ai) { u32x4 xv[4][2];
#pragma unroll
            for (int m = 0; m < 4; ++m)
#pragma unroll
                for (int bj = 0; bj < 2; ++bj) xv[m][bj] = *(const __attribute__((address_space(1))) u32x4*)(X + (size_t)(row0 + ai * HALF + m * 16) * 1024 + col0 + bj * HALF);
#pragma unroll
            for (int m = 0; m < 4; ++m) { bf16_t* rowp = O + (size_t)(row0 + ai * HALF + m * 16) * 1024 + col0;
#pragma unroll
                for (int bj = 0; bj < 2; ++bj) { const u32x4 x = xv[m][bj];
                    const f32x4 x0 = {__uint_as_float(x.x << 16), __uint_as_float(x.x & 0xFFFF0000u), __uint_as_float(x.y << 16), __uint_as_float(x.y & 0xFFFF0000u)};
                    const f32x4 x1 = {__uint_as_float(x.z << 16), __uint_as_float(x.z & 0xFFFF0000u), __uint_as_float(x.w << 16), __uint_as_float(x.w & 0xFFFF0000u)};
                    const f32x4 v0 = acc[ai][bj][m][0] * gv[bj][0] + x0, v1 = acc[ai][bj][m][1] * gv[bj][1] + x1;
                    u32x4 w; w.x = cvt_pk_bf16(v0[0], v0[1]); w.y = cvt_pk_bf16(v0[2], v0[3]); w.z = cvt_pk_bf16(v1[0], v1[1]); w.w = cvt_pk_bf16(v1[2], v1[3]);
                    *(u32x4*)(rowp + bj * HALF) = w; } } }
    }
};
struct EpiLogits {
    static constexpr int EPI_ID = 4; static constexpr bool PERM = false, AFTER_DRAIN = false, HAS_INIT = false;
    float* LOG;
    __device__ __forceinline__ void operator()(const f32x4 (&acc)[2][2][4][2], const Unit& u, int wr, int wc, int fr, int fq) const {
        if (wc != 0) return;
        const int row0 = u.pm * BM + wr * 64 + fr;
#pragma unroll
        for (int ai = 0; ai < 2; ++ai)
#pragma unroll
            for (int m = 0; m < 4; ++m) { float* rowp = LOG + (size_t)(row0 + ai * HALF + m * 16) * 32 + 4 * fq;
#pragma unroll
                for (int n = 0; n < 2; ++n) *(f32x4*)(rowp + n * 16) = acc[ai][0][m][n]; }
    }
};
struct EpiSwiglu {
    static constexpr int EPI_ID = 5; static constexpr bool PERM = true, AFTER_DRAIN = false, HAS_INIT = false;
    bf16_t* ACT; const float* b1p;
    __device__ __forceinline__ void operator()(const f32x4 (&acc)[2][2][4][2], const Unit& u, int wr, int wc, int fr, int fq) const {
        const int e = u.pn >> 3, pn = u.pn & 7;
        const int row0 = u.pm * BM + wr * 64 + fr, lc = wc * 32 + 8 * fq;
        const float* bp = b1p + (size_t)e * 2048 + pn * 256 + lc;
        f32x4 bg[2], bu[2];
#pragma unroll
        for (int n = 0; n < 2; ++n) { bg[n] = *(const f32x4*)(bp + 4 * n); bu[n] = *(const f32x4*)(bp + HALF + 4 * n); }
#pragma unroll
        for (int ai = 0; ai < 2; ++ai)
#pragma unroll
            for (int m = 0; m < 4; ++m) { bf16_t* rowp = ACT + (size_t)(row0 + ai * HALF + m * 16) * 1024 + pn * 128 + lc;
                f32x4 a[2];
#pragma unroll
                for (int n = 0; n < 2; ++n) { const f32x4 gt = acc[ai][0][m][n] + bg[n], up = acc[ai][1][m][n] + bu[n];
#pragma unroll
                    for (int i = 0; i < 4; ++i) { const float gc = fminf(gt[i], 7.0f), uc = fminf(fmaxf(up[i], -7.0f), 7.0f);
                        const float sg = __builtin_amdgcn_rcpf(1.0f + __builtin_amdgcn_exp2f(gc * (-1.702f * 1.4426950408889634f)));
                        a[n][i] = (uc + 1.0f) * (gc * sg); } }
                u32x4 w; w.x = cvt_pk_bf16(a[0][0], a[0][1]); w.y = cvt_pk_bf16(a[0][2], a[0][3]); w.z = cvt_pk_bf16(a[1][0], a[1][1]); w.w = cvt_pk_bf16(a[1][2], a[1][3]);
                *(u32x4*)rowp = w; }
    }
};
struct EpiSwiglu8 {
    static constexpr int EPI_ID = 6; static constexpr bool PERM = true, AFTER_DRAIN = false, HAS_INIT = true;
    unsigned char* ACT; const float* b1p;
    __device__ __forceinline__ const float* bias_row(const Unit& u) const { const int e = u.pn >> 3, pn = u.pn & 7; return b1p + (size_t)e * 2048 + pn * 256; }
    __device__ __forceinline__ void init_lds(f32x4 (&acc)[2][2][4][2], const PG8_LAS unsigned char* bl, int wc, int fq) const {
#pragma unroll
        for (int bj = 0; bj < 2; ++bj)
#pragma unroll
            for (int n = 0; n < 2; ++n) { const f32x4 bv = *(const PG8_LAS f32x4*)(bl + (bj * HALF + wc * 32 + 8 * fq + 4 * n) * 4);
#pragma unroll
                for (int ai = 0; ai < 2; ++ai)
#pragma unroll
                    for (int m = 0; m < 4; ++m) acc[ai][bj][m][n] = bv; }
    }
    __device__ __forceinline__ void operator()(const f32x4 (&acc)[2][2][4][2], const Unit& u, int wr, int wc, int fr, int fq) const {
        const int pn = u.pn & 7;
        const int row0 = u.pm * BM + wr * 64 + fr, lc = wc * 32 + 8 * fq;
        const int odd = fq & 1;
        auto row8 = [&](int ai, int m, unsigned& p0_, unsigned& p1_) {
                f32x4 a[2];
                {
                    typedef float f32x2_ __attribute__((ext_vector_type(2)));
                    f32x2_ gc[4], uc[4], t[4], d[4], g2[4];
#pragma unroll
                    for (int q = 0; q < 4; ++q) { const f32x4 gt = acc[ai][0][m][q >> 1], up = acc[ai][1][m][q >> 1]; const int i0 = 2 * (q & 1);
                        float g0, g1; asm("v_min_f32_e32 %0, 0x40e00000, %1" : "=v"(g0) : "v"(gt[i0])); asm("v_min_f32_e32 %0, 0x40e00000, %1" : "=v"(g1) : "v"(gt[i0 + 1]));
                        gc[q] = (f32x2_){g0, g1}; uc[q] = (f32x2_){__builtin_amdgcn_fmed3f(up[i0], -7.0f, 7.0f), __builtin_amdgcn_fmed3f(up[i0 + 1], -7.0f, 7.0f)}; }
#pragma unroll
                    for (int q = 0; q < 4; ++q) t[q] = gc[q] * (-1.702f * 1.4426950408889634f);
#pragma unroll
                    for (int q = 0; q < 4; ++q) d[q] = (f32x2_){__builtin_amdgcn_exp2f(t[q].x), __builtin_amdgcn_exp2f(t[q].y)};
#pragma unroll
                    for (int q = 0; q < 4; ++q) d[q] = d[q] + 1.0f;
#pragma unroll
                    for (int q = 0; q < 4; ++q) g2[q] = (f32x2_){__builtin_amdgcn_rcpf(d[q].x), __builtin_amdgcn_rcpf(d[q].y)};
#pragma unroll
                    for (int q = 0; q < 4; ++q) g2[q] = gc[q] * g2[q];
#pragma unroll
                    for (int q = 0; q < 4; ++q) { const f32x2_ o = uc[q] * g2[q] + g2[q]; a[q >> 1][2 * (q & 1)] = o.x; a[q >> 1][2 * (q & 1) + 1] = o.y; } }
                int p0 = __builtin_amdgcn_cvt_pk_fp8_f32(a[0][0], a[0][1], 0, false); p0 = __builtin_amdgcn_cvt_pk_fp8_f32(a[0][2], a[0][3], p0, true);
                int p1 = __builtin_amdgcn_cvt_pk_fp8_f32(a[1][0], a[1][1], 0, false); p1 = __builtin_amdgcn_cvt_pk_fp8_f32(a[1][2], a[1][3], p1, true);
                p0_ = (unsigned)p0; p1_ = (unsigned)p1; };
#pragma unroll
        for (int ai = 0; ai < 2; ++ai)
#pragma unroll
            for (int mp = 0; mp < 4; mp += 2) { unsigned pa0, pa1, pb0, pb1; row8(ai, mp, pa0, pa1); row8(ai, mp + 1, pb0, pb1);
                const auto s0 = __builtin_amdgcn_permlane16_swap(pa0, pb0, false, false), s1 = __builtin_amdgcn_permlane16_swap(pa1, pb1, false, false);
                *(u32x4*)(ACT + (size_t)(row0 + ai * HALF + (mp + odd) * 16) * 1024 + pn * 128 + lc - 8 * odd) = (u32x4){s0[0], s1[0], s0[1], s1[1]}; }
    }
};
struct EpiDown {
    static constexpr int EPI_ID = 7; static constexpr bool PERM = true, AFTER_DRAIN = false, HAS_INIT = true;
    unsigned char* YP; const float* b2;
    __device__ __forceinline__ const float* bias_row(const Unit& u) const { const int e = u.pn >> 2, pn = u.pn & 3; return b2 + (size_t)e * 1024 + pn * BM; }
    __device__ __forceinline__ void init_lds(f32x4 (&acc)[2][2][4][2], const PG8_LAS unsigned char* bl, int wc, int fq) const {
#pragma unroll
        for (int bj = 0; bj < 2; ++bj)
#pragma unroll
            for (int n = 0; n < 2; ++n) { const f32x4 bv = *(const PG8_LAS f32x4*)(bl + (bj * HALF + wc * 32 + 8 * fq + 4 * n) * 4) * 8.0f;
#pragma unroll
                for (int ai = 0; ai < 2; ++ai)
#pragma unroll
                    for (int m = 0; m < 4; ++m) acc[ai][bj][m][n] = bv; }
    }
    __device__ __forceinline__ void operator()(const f32x4 (&acc)[2][2][4][2], const Unit& u, int wr, int wc, int fr, int fq) const {
        const int pn = u.pn & 3;
        const int row0 = u.pm * BM + wr * 64 + fr, col0 = pn * BM + wc * 32 + 8 * fq;
        const int odd = fq & 1;
#pragma unroll
        for (int ai = 0; ai < 2; ++ai)
#pragma unroll
            for (int mp = 0; mp < 4; mp += 2) { unsigned char* rowp = YP + (size_t)(row0 + ai * HALF + (mp + odd) * 16) * 1024 + col0 - 8 * odd;
#pragma unroll
                for (int bj = 0; bj < 2; ++bj) { unsigned pa[2], pb[2];
#pragma unroll
                    for (int n = 0; n < 2; ++n) { const f32x4 va = acc[ai][bj][mp][n], vb = acc[ai][bj][mp + 1][n];
                        int p = __builtin_amdgcn_cvt_pk_fp8_f32(va[0], va[1], 0, false); p = __builtin_amdgcn_cvt_pk_fp8_f32(va[2], va[3], p, true); pa[n] = (unsigned)p;
                        int q = __builtin_amdgcn_cvt_pk_fp8_f32(vb[0], vb[1], 0, false); q = __builtin_amdgcn_cvt_pk_fp8_f32(vb[2], vb[3], q, true); pb[n] = (unsigned)q; }
                    const auto s0 = __builtin_amdgcn_permlane16_swap(pa[0], pb[0], false, false), s1 = __builtin_amdgcn_permlane16_swap(pa[1], pb[1], false, false);
                    *(u32x4*)(rowp + bj * HALF) = (u32x4){s0[0], s1[0], s0[1], s1[1]}; } }
    }
};

template <class Epi, class Sched, bool ALIGN_EPI = false, bool SP2 = false, bool F8 = false, int F8_SW = 0x7A7A7A7A, bool GATHER = false>
__device__ __forceinline__ void gemm_phase(PG8_LAS unsigned char* lds, const Gemm g, const Sched& S, const Epi& E) {
    int tid_ = threadIdx.x; asm volatile("" : "+v"(tid_));
    const int tid = tid_, wid = __builtin_amdgcn_readfirstlane(tid >> 6), lane = tid & 63, wr = wid >> 2, wc = wid & 3, fr = lane & 15, fq = lane >> 4;
    int K_ = g.K; asm volatile("" : "+s"(K_));
    const int K = K_, nt = K / BK;
    unsigned voffA[2], voffB[2];
#pragma unroll
    for (int i = 0; i < 2; ++i) { int R, C; stage_rc(tid * 16 + i * 8192, R, C); const int Rb = Epi::PERM ? ((R & ~31) + perm32(R & 31)) : R;
        voffA[i] = (unsigned)(R * K + C) * 2u; voffB[i] = (unsigned)(Rb * K + C) * 2u; }
    const size_t kstep = (size_t)(BK * 2);
    const size_t hstep = (size_t)HALF * K * 2;
    const size_t tstep = 2 * hstep;
    const size_t hstepA = GATHER ? 0 : hstep;
    unsigned voffC[2][2];
#define PG8_VA(h, nx) (GATHER ? voffC[h] : voffA)
#define PG8_GOFF(dst, slot, unit) do { const int nv_ = S.nvalid(unit); _Pragma("unroll") for (int i_ = 0; i_ < 2; ++i_) { int R_, C_; stage_rc(tid * 16 + i_ * 8192, R_, C_); _Pragma("unroll") for (int h_ = 0; h_ < 2; ++h_) { const int ri_ = h_ * HALF + R_; \
        int ix_ = *(const PG8_LAS int*)(lds + PG8_IDX_OFF + (slot) * 1024 + ri_ * 4); ix_ = ri_ < nv_ ? ix_ : 0; dst[h_][i_] = (unsigned)ix_ * (unsigned)(K * 2) + (unsigned)C_ * 2u; } } } while (0)
    const unsigned ldsw = (unsigned)wid * 1024u;
    const int aoff = lds_byte(wr * 64 + fr, fq * 8), boff = lds_byte(wc * 32 + fr, fq * 8);
#define PG8_SA(b, h) (((b) * 2 + (h)) * HTB)
#define PG8_SB(b, h) ((4 + (b) * 2 + (h)) * HTB)
#define PG8_STAGE(bufoff, gbase, voff) do { _Pragma("unroll") for (int _i = 0; _i < 2; ++_i) \
        __builtin_amdgcn_global_load_lds((const unsigned*)((const char*)(gbase) + (voff)[_i]), (PG8_LAS unsigned*)(lds + (bufoff) + ldsw + _i * 8192), 16, 0, 0); } while (0)
#define PG8_CAT(x0, x1) __builtin_shufflevector(__builtin_bit_cast(i32x4, x0), __builtin_bit_cast(i32x4, x1), 0, 1, 2, 3, 4, 5, 6, 7)
#define PG8_LDF(base, off) (*(const PG8_LAS bf16x8*)(lds + (base) + (off)))
#define PG8_LDA(dst, dst8, b, h) do { _Pragma("unroll") for (int m = 0; m < 4; ++m) { if constexpr (F8) dst8[m] = PG8_CAT(PG8_LDF(PG8_SA(b, h), aoff + m * 2048), PG8_LDF(PG8_SA(b, h), aoff + m * 2048 + 1024)); \
        else { _Pragma("unroll") for (int k = 0; k < 2; ++k) dst[m][k] = PG8_LDF(PG8_SA(b, h), aoff + m * 2048 + k * 1024); } } } while (0)
#define PG8_LDB(dst, dst8, b, h) do { _Pragma("unroll") for (int n = 0; n < 2; ++n) { if constexpr (F8) dst8[n] = PG8_CAT(PG8_LDF(PG8_SB(b, h), boff + n * 2048), PG8_LDF(PG8_SB(b, h), boff + n * 2048 + 1024)); \
        else { _Pragma("unroll") for (int k = 0; k < 2; ++k) dst[n][k] = PG8_LDF(PG8_SB(b, h), boff + n * 2048 + k * 1024); } } } while (0)
#define PG8_MMA(ai, bj, At, At8, Bt, Bt8) do { __builtin_amdgcn_s_setprio(1); _Pragma("unroll") for (int m = 0; m < 4; ++m) _Pragma("unroll") for (int n = 0; n < 2; ++n) { \
        if constexpr (F8) asm volatile("v_mfma_scale_f32_16x16x128_f8f6f4 %0, %1, %2, %0, %3, %3 op_sel:[0,1,0] op_sel_hi:[0,0,0]" : "+v"(acc[ai][bj][m][n]) : "v"(Bt8[n]), "v"(At8[m]), "v"(f8_s));   \
        else { _Pragma("unroll") for (int k = 0; k < 2; ++k) acc[ai][bj][m][n] = __builtin_amdgcn_mfma_f32_16x16x32_bf16(Bt[n][k], At[m][k], acc[ai][bj][m][n], 0, 0, 0); } } __builtin_amdgcn_s_setprio(0); } while (0)
#define PG8_WAIT_V(n) asm volatile("s_waitcnt vmcnt(" #n ")" ::: "memory")
#define PG8_WAIT_L(n) asm volatile("s_waitcnt lgkmcnt(" #n ")" ::: "memory")
#define PG8_BAR __builtin_amdgcn_s_barrier()
#define PG8_SCHED __builtin_amdgcn_sched_barrier(0)
    Unit cur, nxt; int ui = 0;
    if (!S.next(0, cur)) return;
    f32x4 acc[2][2][4][2];
    if constexpr (Epi::HAS_INIT) { if (wid == 0) __builtin_amdgcn_global_load_lds((const unsigned*)(E.bias_row(cur) + lane * 4), (PG8_LAS unsigned*)(lds + PG8_BIAS_OFF), 16, 0, 0); }
    else {
#pragma unroll
    for (int a = 0; a < 2; ++a)
#pragma unroll
        for (int b = 0; b < 2; ++b)
#pragma unroll
            for (int m = 0; m < 4; ++m)
#pragma unroll
                for (int n = 0; n < 2; ++n) acc[a][b][m][n] = (f32x4){0.f, 0.f, 0.f, 0.f};
    }
    int f8_s = 0x7F00 | (F8_SW & 0xFF); asm volatile("" : "+v"(f8_s));
    bf16x8 At[4][2], B0[2][2], B1[2][2]; i32x8 At8[4], B08[2], B18[2];
    const char* cA = (const char*)g.A + (GATHER ? (size_t)0 : (size_t)cur.pm * tstep); const char* cB = (const char*)g.Bt + (size_t)cur.pn * tstep;
    if constexpr (GATHER) { if (wid == 0) __builtin_amdgcn_global_load_lds((const unsigned*)(S.idx_src(cur) + lane * 4), (PG8_LAS unsigned*)(lds + PG8_IDX_OFF), 16, 0, 0);
        PG8_WAIT_V(0); PG8_BAR; PG8_GOFF(voffC, 0, cur); }
    S.a_ready(cur);
    if constexpr (SP2) {
        PG8_STAGE(PG8_SB(0, 0), cB, voffB); PG8_STAGE(PG8_SB(0, 1), cB + hstep, voffB); PG8_STAGE(PG8_SA(0, 0), cA, PG8_VA(0, false)); PG8_STAGE(PG8_SA(0, 1), cA + hstepA, PG8_VA(1, false));
        if (wr == 1) PG8_BAR;
        PG8_WAIT_V(2); PG8_BAR;
        PG8_STAGE(PG8_SB(1, 0), cB + kstep, voffB); PG8_STAGE(PG8_SA(1, 0), cA + kstep, PG8_VA(0, false)); PG8_STAGE(PG8_SB(1, 1), cB + hstep + kstep, voffB);
        PG8_WAIT_V(6); PG8_BAR;
    } else {
        PG8_STAGE(PG8_SB(0, 0), cB, voffB); PG8_STAGE(PG8_SA(0, 0), cA, PG8_VA(0, false)); PG8_STAGE(PG8_SB(0, 1), cB + hstep, voffB); PG8_STAGE(PG8_SA(0, 1), cA + hstepA, PG8_VA(1, false));
        if (wr == 1) PG8_BAR;
        PG8_WAIT_V(4); PG8_BAR;
        PG8_STAGE(PG8_SB(1, 0), cB + kstep, voffB); PG8_STAGE(PG8_SA(1, 0), cA + kstep, PG8_VA(0, false)); PG8_STAGE(PG8_SB(1, 1), cB + hstep + kstep, voffB);
        PG8_WAIT_V(6); PG8_BAR;
    }
    if constexpr (Epi::HAS_INIT) E.init_lds(acc, lds + PG8_BIAS_OFF, wc, fq);
    for (;;) {
        const bool has_next = S.next(ui + 1, nxt);
        if constexpr (Epi::HAS_INIT) { if (has_next && wid == 0) __builtin_amdgcn_global_load_lds((const unsigned*)(E.bias_row(nxt) + lane * 4), (PG8_LAS unsigned*)(lds + PG8_BIAS_OFF + ((ui + 1) & 1) * 1024), 16, 0, 0); }
        if constexpr (GATHER) { if (has_next && wid == 0) __builtin_amdgcn_global_load_lds((const unsigned*)(S.idx_src(nxt) + lane * 4), (PG8_LAS unsigned*)(lds + PG8_IDX_OFF + ((ui + 1) & 1) * 1024), 16, 0, 0); }
        const char* nA = has_next ? (const char*)g.A + (GATHER ? (size_t)0 : (size_t)nxt.pm * tstep) : cA; const char* nB = has_next ? (const char*)g.Bt + (size_t)nxt.pn * tstep : cB;
        for (int t = 0; t < nt; t += 2) {
            const bool last = (t == nt - 2);
            const char* a1 = cA + (size_t)(t + 1) * kstep;
            const char* a2 = last ? nA : cA + (size_t)(t + 2) * kstep; const char* b2 = last ? nB : cB + (size_t)(t + 2) * kstep;
            const char* a3 = a2 + kstep; const char* b3 = b2 + kstep;
            if (last && has_next) S.a_ready(nxt);
            if constexpr (SP2) {
            PG8_LDB(B0, B08, 0, 0); PG8_LDB(B1, B18, 0, 1); PG8_SCHED; PG8_LDA(At, At8, 0, 0); PG8_STAGE(PG8_SA(1, 1), a1 + hstepA, PG8_VA(1, false));
            if constexpr (GATHER) { if (last && has_next) PG8_GOFF(voffC, (ui + 1) & 1, nxt); }
            PG8_WAIT_V(8); PG8_WAIT_L(0); PG8_BAR; PG8_MMA(0, 0, At, At8, B0, B08); PG8_MMA(0, 1, At, At8, B1, B18); PG8_BAR; PG8_SCHED;
            PG8_LDA(At, At8, 0, 1); PG8_STAGE(PG8_SB(0, 0), b2, voffB); PG8_STAGE(PG8_SB(0, 1), b2 + hstep, voffB); PG8_STAGE(PG8_SA(0, 0), a2, PG8_VA(0, last));
            PG8_WAIT_V(8); PG8_WAIT_L(0); PG8_BAR; PG8_MMA(1, 0, At, At8, B0, B08); PG8_MMA(1, 1, At, At8, B1, B18); PG8_BAR; PG8_SCHED;
            PG8_LDB(B0, B08, 1, 0); PG8_LDB(B1, B18, 1, 1); PG8_SCHED; PG8_LDA(At, At8, 1, 0); PG8_STAGE(PG8_SA(0, 1), a2 + hstepA, PG8_VA(1, last));
            PG8_WAIT_V(8); PG8_WAIT_L(0); PG8_BAR; PG8_MMA(0, 0, At, At8, B0, B08); PG8_MMA(0, 1, At, At8, B1, B18); PG8_BAR; PG8_SCHED;
            PG8_LDA(At, At8, 1, 1); PG8_STAGE(PG8_SB(1, 0), b3, voffB); PG8_STAGE(PG8_SB(1, 1), b3 + hstep, voffB); PG8_STAGE(PG8_SA(1, 0), a3, PG8_VA(0, last));
            PG8_WAIT_V(8); PG8_WAIT_L(0); PG8_BAR; PG8_MMA(1, 0, At, At8, B0, B08); PG8_MMA(1, 1, At, At8, B1, B18); PG8_BAR; PG8_SCHED;
            } else {
            PG8_LDB(B0, B08, 0, 0); PG8_SCHED; PG8_LDA(At, At8, 0, 0); PG8_STAGE(PG8_SA(1, 1), a1 + hstepA, PG8_VA(1, false));
            PG8_WAIT_L(8); PG8_BAR; PG8_WAIT_L(0); PG8_MMA(0, 0, At, At8, B0, B08); PG8_BAR; PG8_SCHED;
            PG8_LDB(B1, B18, 0, 1); PG8_STAGE(PG8_SB(0, 0), b2, voffB);
            PG8_BAR; PG8_WAIT_L(0); PG8_MMA(0, 1, At, At8, B1, B18); PG8_BAR;
            PG8_LDA(At, At8, 0, 1); PG8_STAGE(PG8_SA(0, 0), a2, PG8_VA(0, last));
            PG8_BAR; PG8_WAIT_L(0); PG8_MMA(1, 0, At, At8, B0, B08); PG8_BAR; PG8_SCHED;
            PG8_STAGE(PG8_SB(0, 1), b2 + hstep, voffB);
            PG8_WAIT_V(6); PG8_BAR; PG8_MMA(1, 1, At, At8, B1, B18); PG8_BAR;
            PG8_LDB(B0, B08, 1, 0); PG8_SCHED; PG8_LDA(At, At8, 1, 0); PG8_STAGE(PG8_SA(0, 1), a2 + hstepA, PG8_VA(1, last));
            PG8_WAIT_L(8); PG8_BAR; PG8_WAIT_L(0); PG8_MMA(0, 0, At, At8, B0, B08); PG8_BAR; PG8_SCHED;
            PG8_LDB(B1, B18, 1, 1); PG8_STAGE(PG8_SB(1, 0), b3, voffB);
            PG8_BAR; PG8_WAIT_L(0); PG8_MMA(0, 1, At, At8, B1, B18); PG8_BAR;
            PG8_LDA(At, At8, 1, 1); PG8_STAGE(PG8_SA(1, 0), a3, PG8_VA(0, last));
            PG8_BAR; PG8_WAIT_L(0); PG8_MMA(1, 0, At, At8, B0, B08); PG8_BAR; PG8_SCHED;
            PG8_STAGE(PG8_SB(1, 1), b3 + hstep, voffB);
            PG8_WAIT_V(6); PG8_BAR; PG8_MMA(1, 1, At, At8, B1, B18); PG8_BAR;
            }
        }
        if constexpr (ALIGN_EPI) { if (wr == 0) PG8_BAR; }
        if constexpr (F8) asm volatile("s_nop 15\n\ts_nop 15" ::: "memory");
#ifdef MK_EPIDUP
        if constexpr (!Epi::AFTER_DRAIN && ((MK_EPIDUP >> Epi::EPI_ID) & 1)) { E(acc, cur, wr, wc, fr, fq);
            _Pragma("unroll") for (int a = 0; a < 2; ++a) _Pragma("unroll") for (int b = 0; b < 2; ++b) _Pragma("unroll") for (int m = 0; m < 4; ++m) _Pragma("unroll") for (int n = 0; n < 2; ++n) asm volatile("" : "+v"(acc[a][b][m][n])); }
#endif
        if constexpr (!Epi::AFTER_DRAIN) { E(acc, cur, wr, wc, fr, fq); S.done(cur); }
        if (!has_next) break;
        if constexpr (Epi::HAS_INIT) E.init_lds(acc, lds + PG8_BIAS_OFF + ((ui + 1) & 1) * 1024, wc, fq); else {
#pragma unroll
        for (int a = 0; a < 2; ++a)
#pragma unroll
            for (int b = 0; b < 2; ++b)
#pragma unroll
                for (int m = 0; m < 4; ++m)
#pragma unroll
                    for (int n = 0; n < 2; ++n) acc[a][b][m][n] = (f32x4){0.f, 0.f, 0.f, 0.f};
        }
        cur = nxt; cA = nA; cB = nB; ++ui;

        if constexpr (ALIGN_EPI) { if (wr == 1) PG8_BAR; }
    }
    PG8_WAIT_V(0);
    if constexpr (!ALIGN_EPI) { if (wr == 0) PG8_BAR; }
    PG8_BAR;
    if constexpr (Epi::AFTER_DRAIN) { E.fused(acc, cur, wr, wc, fr, fq, lds, wid, lane); S.done(cur); }
#undef PG8_SA
#undef PG8_SB
#undef PG8_STAGE
#undef PG8_VA
#undef PG8_GOFF
#undef PG8_LDA
#undef PG8_LDF
#undef PG8_LDB
#undef PG8_MMA
#undef PG8_CAT
#undef PG8_WAIT_V
#undef PG8_WAIT_L
#undef PG8_BAR
#undef PG8_SCHED
}
}
#ifndef ATTN_STORE16
#define ATTN_STORE16(p,v) (*(u32x4*)(p)=(v))
#endif
namespace attn_body {
using bf16=__hip_bfloat16;
using bf16x8=__attribute__((ext_vector_type(8)))short;
using s16x4=__attribute__((ext_vector_type(4)))short;
using f32x16=__attribute__((ext_vector_type(16)))float;
using u32x4=__attribute__((ext_vector_type(4)))unsigned;
constexpr int D=64,PQ=2048,PO=1024,KOFF=512,VOFF=640;
constexpr int NW=8,QBLK=32,QB=QBLK*NW,KVBLK=64;
__device__ __forceinline__ int crow(int r,int hi){return (r&3)+8*(r>>2)+4*hi;}
#define SBAR() __builtin_amdgcn_sched_barrier(0)
constexpr int NSLOT=3, SLOTB=8192;
constexpr int LDS_K=0, LDS_V=NSLOT*SLOTB, LDS_WS=2*NSLOT*SLOTB, LDS_OST=LDS_WS+NW*64*4, LDS_BYTES=LDS_OST+NW*4096;
constexpr float C2=0.125f*1.4426950408889634f;
__device__ __forceinline__ void glds16(const void*gsrc,unsigned lds_dst){unsigned keep;
  asm volatile("s_mov_b32 %0, m0\n\ts_mov_b32 m0, %2\n\ts_nop 0\n\tglobal_load_lds_dwordx4 %1, off\n\ts_mov_b32 m0, %0":"=&s"(keep):"v"(gsrc),"s"(lds_dst):"memory");}
__device__ __forceinline__ float max3f(float a,float b,float c){float r;asm("v_max3_f32 %0, %1, %2, %3":"=v"(r):"v"(a),"v"(b),"v"(c));return r;}
__device__ __forceinline__ float max2f(float a,float b){float r;asm("v_max_f32_e32 %0, %1, %2":"=v"(r):"v"(a),"v"(b));return r;}
__device__ __forceinline__ float fadd_s(float a,float b){float r;asm("v_add_f32_e32 %0, %1, %2":"=v"(r):"v"(a),"v"(b));return r;}
__device__ __forceinline__ float fsub_s(float a,float b){float r;asm("v_sub_f32_e32 %0, %1, %2":"=v"(r):"v"(a),"v"(b));return r;}
typedef float f32x2_t __attribute__((ext_vector_type(2))); typedef __bf16 bf16x2_t __attribute__((ext_vector_type(2)));
__device__ __forceinline__ unsigned cvtpk_s(float lo,float hi){f32x2_t v={lo,hi};bf16x2_t b=__builtin_convertvector(v,bf16x2_t);return __builtin_bit_cast(unsigned,b);}
#define WAIT_BAR(N) asm volatile("s_waitcnt vmcnt(" #N ") lgkmcnt(0)\n\ts_barrier":::"memory")

__device__ __forceinline__ void qkt(f32x16&p0,f32x16&p1,const char*Kslot,const bf16x8*qr,const f32x16&negm,int r32,int hi){
  const char*kb=Kslot+hi*1024+r32*16;
  #pragma unroll
  for(int d0=0;d0<4;++d0){
    const bf16x8 b0=*reinterpret_cast<const bf16x8*>(kb+d0*2048);
    const bf16x8 b1=*reinterpret_cast<const bf16x8*>(kb+d0*2048+512);
    if(d0==0){p0=__builtin_amdgcn_mfma_f32_32x32x16_bf16(b0,qr[0],negm,0,0,0);p1=__builtin_amdgcn_mfma_f32_32x32x16_bf16(b1,qr[0],negm,0,0,0);}
    else{p0=__builtin_amdgcn_mfma_f32_32x32x16_bf16(b0,qr[d0],p0,0,0,0);p1=__builtin_amdgcn_mfma_f32_32x32x16_bf16(b1,qr[d0],p1,0,0,0);}}
}
typedef __attribute__((address_space(3))) const char* lds_cptr;
typedef short v4i16_t __attribute__((ext_vector_type(4)));
__device__ __forceinline__ void kload8(bf16x8*kf,lds_cptr kp){
  kf[0]=*(const __attribute__((address_space(3))) bf16x8*)(kp);      kf[1]=*(const __attribute__((address_space(3))) bf16x8*)(kp+512);
  kf[2]=*(const __attribute__((address_space(3))) bf16x8*)(kp+2048); kf[3]=*(const __attribute__((address_space(3))) bf16x8*)(kp+2560);
  kf[4]=*(const __attribute__((address_space(3))) bf16x8*)(kp+4096); kf[5]=*(const __attribute__((address_space(3))) bf16x8*)(kp+4608);
  kf[6]=*(const __attribute__((address_space(3))) bf16x8*)(kp+6144); kf[7]=*(const __attribute__((address_space(3))) bf16x8*)(kp+6656);
}
__device__ __forceinline__ void kload2(bf16x8*kf,lds_cptr kp,int j){ kf[2*j]=*(const __attribute__((address_space(3))) bf16x8*)(kp+j*2048); kf[2*j+1]=*(const __attribute__((address_space(3))) bf16x8*)(kp+j*2048+512); }
__device__ __forceinline__ s16x4 vtr(lds_cptr p){ return __builtin_bit_cast(s16x4,__builtin_amdgcn_ds_read_tr16_b64_v4i16((__attribute__((address_space(3))) v4i16_t*)p)); }
__device__ __forceinline__ float rowmax(const f32x16&p0,const f32x16&p1){
  float a=max3f(p0[0],p0[1],p1[0]),b=max3f(p0[2],p0[3],p1[1]);a=max3f(a,p1[2],p1[3]);
  #pragma unroll
  for(int r=4;r<16;r+=4){a=max3f(a,p0[r],p0[r+1]);b=max3f(b,p0[r+2],p0[r+3]);a=max3f(a,p1[r],p1[r+1]);b=max3f(b,p1[r+2],p1[r+3]);}
  const float m=max2f(a,b);
  auto rr=__builtin_amdgcn_permlane32_swap(__float_as_uint(m),__float_as_uint(m),false,false);
  return max2f(__uint_as_float(rr[0]),__uint_as_float(rr[1]));
}
__device__ __forceinline__ void pv(f32x16*o,int vb,bf16x8 pa0,bf16x8 pa1,bf16x8 pa2,bf16x8 pa3){
  #pragma unroll
  for(int d0=0;d0<2;++d0){s16x4 lo[4],hi[4];
    #pragma unroll
    for(int ks=0;ks<4;++ks){
      asm volatile("ds_read_b64_tr_b16 %0,%1 offset:%c2":"=&v"(lo[ks]):"v"(vb),"i"(d0*4096+ks*1024):"memory");
      asm volatile("ds_read_b64_tr_b16 %0,%1 offset:%c2":"=&v"(hi[ks]):"v"(vb),"i"(d0*4096+ks*1024+512):"memory");}
    asm volatile("s_waitcnt lgkmcnt(0)":::"memory");SBAR();
    #define PK(k) (bf16x8){lo[k][0],lo[k][1],lo[k][2],lo[k][3],hi[k][0],hi[k][1],hi[k][2],hi[k][3]}
    o[d0]=__builtin_amdgcn_mfma_f32_32x32x16_bf16(pa0,PK(0),o[d0],0,0,0);
    o[d0]=__builtin_amdgcn_mfma_f32_32x32x16_bf16(pa1,PK(1),o[d0],0,0,0);
    o[d0]=__builtin_amdgcn_mfma_f32_32x32x16_bf16(pa2,PK(2),o[d0],0,0,0);
    o[d0]=__builtin_amdgcn_mfma_f32_32x32x16_bf16(pa3,PK(3),o[d0],0,0,0);
    #undef PK
  }
}

template<int THRL,bool FIXR=false> __device__ __forceinline__ void attn_unit(long qrow0,long krow0,int NTarg,int h,const bf16*Pq,bf16*Yo,char*shm,int koff=0){
  int tid_=threadIdx.x; asm volatile("":"+v"(tid_)); const int tid=tid_,lane=tid&63,r32=lane&31,hi=lane>>5; const int wid=__builtin_amdgcn_readfirstlane(tid>>6);
  const bf16*Qw=Pq+(qrow0+wid*QBLK)*PQ+h*D;
  const bf16*Kh=Pq+krow0*PQ+KOFF+(h>>2)*D,*Vh=Pq+krow0*PQ+VOFF+(h>>2)*D;
  const unsigned lds0=(unsigned)(uintptr_t)shm;
  float*wsf=(float*)(shm+LDS_WS)+wid*64;
  const bf16*ksrc=Kh+(long)lane*PQ+wid*8;
  const bf16*vsrc=Vh+(long)(16*(wid&3)+(lane>>2))*PQ+(wid>>2)*32+(lane&3)*8;
  const unsigned kdst=lds0+LDS_K+wid*1024, vdst=lds0+LDS_V+wid*1024;
  #define KVT(t) ({int t_=(t)+koff; t_>=NTarg?t_-NTarg:t_;})
  #define DMA_K(t,slot) glds16(ksrc+(long)KVT(t)*KVBLK*PQ,(unsigned)__builtin_amdgcn_readfirstlane(kdst+(slot)))
  #define DMA_V(t,slot) glds16(vsrc+(long)KVT(t)*KVBLK*PQ,(unsigned)__builtin_amdgcn_readfirstlane(vdst+(slot)))
  const int vb0=(int)(lds0+LDS_V)+((lane>>4)&1)*32+(lane&3)*8+(4*hi+((lane&15)>>2))*64;
  const char*Kbase=shm+LDS_K; bf16x8 kf[8];
  const lds_cptr shm3=(lds_cptr)shm; const lds_cptr kp0=shm3+LDS_K+hi*1024+r32*16; const lds_cptr vp0=shm3+LDS_V+((lane>>4)&1)*32+(lane&3)*8+(4*hi+((lane&15)>>2))*64;
  const int NT=NTarg;
  DMA_K(0,0);DMA_V(0,0);DMA_K(1,SLOTB);
  bf16x8 qr[4];
  #pragma unroll
  for(int d0=0;d0<4;++d0)qr[d0]=*reinterpret_cast<const bf16x8*>(&Qw[(long)r32*PQ+d0*16+hi*8]);
  float mhat=0.f,l_reg=0.f;f32x16 o[2];o[0]=f32x16{};o[1]=f32x16{};f32x16 negm=f32x16{}; if constexpr(!FIXR)asm volatile("":"+v"(negm));

  #define CMASK(P0,P1,t) do{}while(0)
  bool resc=false;
  #define START(P0,P1) do{ resc=false; \
    if constexpr(!FIXR){ const float rm=rowmax(P0,P1); const float dl=rm; mhat=fadd_s(mhat,dl); \
      _Pragma("unroll") for(int r=0;r<16;++r){P0[r]=fsub_s(P0[r],dl);P1[r]=fsub_s(P1[r],dl);} \
      _Pragma("unroll") for(int r=0;r<16;++r)negm[r]=-mhat; asm volatile("":"+v"(negm)); } \
    _Pragma("unroll") for(int r=0;r<16;++r)P0[r]=__builtin_amdgcn_exp2f(P0[r]); }while(0)
  #define RESC() do{ if(resc){ asm volatile("s_waitcnt lgkmcnt(0)":::"memory"); \
      _Pragma("unroll") for(int d_=0;d_<2;++d_) _Pragma("unroll") for(int r=0;r<16;++r)o[d_][r]*=wsf[crow(r,hi)]; } }while(0)
  f32x16 pA0,pA1,pB0,pB1;
  int sl_prev=0,sl_cur=0,sl_next=SLOTB;
  #define ROT() do{sl_prev=sl_cur;sl_cur=sl_next;sl_next=(sl_next==(NSLOT-1)*SLOTB)?0:sl_next+SLOTB;}while(0)
  DMA_K(2,2*SLOTB);
  WAIT_BAR(3);
  qkt(pA0,pA1,Kbase,qr,negm,r32,hi);asm volatile("s_nop 15\n\ts_nop 7":"+v"(pA0),"+v"(pA1));CMASK(pA0,pA1,0);
  START(pA0,pA1);
  _Pragma("unroll") for(int r=0;r<16;++r)pA1[r]=__builtin_amdgcn_exp2f(pA1[r]);
  WAIT_BAR(0);
  DMA_K(3,0);DMA_V(1,SLOTB);
  ROT();
  kload8(kf,kp0+sl_cur);
  WAIT_BAR(2);
  s16x4 vlo[8],vhi[8]; u32x4 pw0,pw1,pw2,pw3;
  #define PKW(P,B) cvtpk_s(P[B],P[B+1])
  #define PAF(k) __builtin_bit_cast(bf16x8,pw##k)
  #define VFR(i) (bf16x8){vlo[i][0],vlo[i][1],vlo[i][2],vlo[i][3],vhi[i][0],vhi[i][1],vhi[i][2],vhi[i][3]}
  #define PIN(x) asm volatile("":"+v"(x))
  #define MX3(a,b,c) __builtin_fmaxf(__builtin_fmaxf((a),(b)),(c))
  #define GAPA(MF,A0,A1,A2,A3,W0,W1,PW) do{ MF; sacc+=A0; sacc+=A1; sacc+=A2; sacc+=A3; PIN(sacc); W0; W1; PIN(PW); SBAR(); }while(0)
  #define EX(v) __builtin_amdgcn_exp2f(v)
  #define GAPB(MF,X,B) do{ MF; X[B]=EX(X[B]); X[B+1]=EX(X[B+1]); X[B+2]=EX(X[B+2]); X[B+3]=EX(X[B+3]); PIN(X); SBAR(); }while(0)
  #define VRD(i) do{ vlo[i]=vtr(vp_+(((i)>>2)*4096+((i)&3)*1024)); vhi[i]=vtr(vp_+(((i)>>2)*4096+((i)&3)*1024+512)); }while(0)
  #define KRD(G,j) do{ if(G){ kload2(kf,kp0+sl_next,j); SBAR(); } }while(0)
  #define STEP(C0,C1,P0,P1,t,GK,GV,GL) do{ SBAR(); \
    const lds_cptr vp_=vp0+sl_prev; \
    VRD(0); SBAR(); float sacc=(P0[0]+P0[1]); \
    GAPA(C0=__builtin_amdgcn_mfma_f32_32x32x16_bf16(kf[0],qr[0],negm,0,0,0), P0[2],P0[3],P0[4],P0[5],     pw0[0]=PKW(P0,0), pw0[1]=PKW(P0,2), pw0); \
    VRD(4); SBAR(); GAPA(C1=__builtin_amdgcn_mfma_f32_32x32x16_bf16(kf[1],qr[0],negm,0,0,0), P0[6],P0[7],P0[8],P0[9],     pw0[2]=PKW(P0,4), pw0[3]=PKW(P0,6), pw0); \
    VRD(1); SBAR(); GAPA(C0=__builtin_amdgcn_mfma_f32_32x32x16_bf16(kf[2],qr[1],C0,0,0,0),   P0[10],P0[11],P0[12],P0[13], pw1[0]=PKW(P0,8), pw1[1]=PKW(P0,10), pw1); \
    VRD(5); SBAR(); GAPA(C1=__builtin_amdgcn_mfma_f32_32x32x16_bf16(kf[3],qr[1],C1,0,0,0),   P0[14],P0[15],P1[0],P1[1],   pw1[2]=PKW(P0,12),pw1[3]=PKW(P0,14), pw1); \
    VRD(2); SBAR(); GAPA(C0=__builtin_amdgcn_mfma_f32_32x32x16_bf16(kf[4],qr[2],C0,0,0,0),   P1[2],P1[3],P1[4],P1[5],     pw2[0]=PKW(P1,0), pw2[1]=PKW(P1,2), pw2); \
    VRD(6); SBAR(); GAPA(C1=__builtin_amdgcn_mfma_f32_32x32x16_bf16(kf[5],qr[2],C1,0,0,0),   P1[6],P1[7],P1[8],P1[9],     pw2[2]=PKW(P1,4), pw2[3]=PKW(P1,6), pw2); \
    VRD(3); SBAR(); GAPA(C0=__builtin_amdgcn_mfma_f32_32x32x16_bf16(kf[6],qr[3],C0,0,0,0),   P1[10],P1[11],P1[12],P1[13], pw3[0]=PKW(P1,8), pw3[1]=PKW(P1,10), pw3); \
    VRD(7); SBAR(); GAPA(C1=__builtin_amdgcn_mfma_f32_32x32x16_bf16(kf[7],qr[3],C1,0,0,0),   P1[14],P1[15],0.f,0.f,       pw3[2]=PKW(P1,12),pw3[3]=PKW(P1,14), pw3); \
    l_reg+=sacc; \
    if(GK){DMA_K((t)+3,sl_cur);} if(GV){DMA_V((t)+1,sl_next);} \
    CMASK(C0,C1,t); \
    resc=false; \
    if constexpr(!FIXR){ float a=MX3(C0[0],C0[1],C1[0]),b=MX3(C0[2],C0[3],C1[1]); a=MX3(a,C1[2],C1[3]); \
      _Pragma("unroll") for(int r=4;r<16;r+=4){a=MX3(a,C0[r],C0[r+1]);b=MX3(b,C0[r+2],C0[r+3]);a=MX3(a,C1[r],C1[r+1]);b=MX3(b,C1[r+2],C1[r+3]);} \
      float rm=__builtin_fmaxf(a,b); { auto rr=__builtin_amdgcn_permlane32_swap(__float_as_uint(rm),__float_as_uint(rm),false,false); rm=__builtin_fmaxf(__uint_as_float(rr[0]),__uint_as_float(rr[1])); } \
      if(__builtin_expect(__any(rm>(float)THRL),0)){ const float dl=__builtin_fmaxf(rm,0.f); mhat+=dl; \
        _Pragma("unroll") for(int r=0;r<16;++r){C0[r]-=dl;C1[r]-=dl;} \
        _Pragma("unroll") for(int r=0;r<16;++r)negm[r]=-mhat; asm volatile("":"+v"(negm)); \
        const float f=__builtin_amdgcn_exp2f(-dl); l_reg*=f; if(hi==0)wsf[r32]=f; resc=true; } } \
    SBAR(); \
    GAPB(o[0]=__builtin_amdgcn_mfma_f32_32x32x16_bf16(PAF(0),VFR(0),o[0],0,0,0), C0,0); \
    GAPB(o[1]=__builtin_amdgcn_mfma_f32_32x32x16_bf16(PAF(0),VFR(4),o[1],0,0,0), C0,4); \
    KRD(GL,0); GAPB(o[0]=__builtin_amdgcn_mfma_f32_32x32x16_bf16(PAF(1),VFR(1),o[0],0,0,0), C0,8); \
    KRD(GL,1); GAPB(o[1]=__builtin_amdgcn_mfma_f32_32x32x16_bf16(PAF(1),VFR(5),o[1],0,0,0), C0,12); \
    KRD(GL,2); GAPB(o[0]=__builtin_amdgcn_mfma_f32_32x32x16_bf16(PAF(2),VFR(2),o[0],0,0,0), C1,0); \
    KRD(GL,3); GAPB(o[1]=__builtin_amdgcn_mfma_f32_32x32x16_bf16(PAF(2),VFR(6),o[1],0,0,0), C1,4); \
    GAPB(o[0]=__builtin_amdgcn_mfma_f32_32x32x16_bf16(PAF(3),VFR(3),o[0],0,0,0), C1,8); \
    GAPB(o[1]=__builtin_amdgcn_mfma_f32_32x32x16_bf16(PAF(3),VFR(7),o[1],0,0,0), C1,12); \
    }while(0)
  int t=1;
  #undef CMASK
  #define CMASK(P0,P1,t) do{}while(0)
  for(;t+5<NT;t+=2){
    STEP(pB0,pB1,pA0,pA1,t,true,true,true);     WAIT_BAR(2); RESC(); ROT();
    STEP(pA0,pA1,pB0,pB1,t+1,true,true,true);   WAIT_BAR(2); RESC(); ROT();
  }
  #undef CMASK
  #define CMASK(P0,P1,t) do{}while(0)
  #define ENDW(tt) do{ if((tt)+3<NT){WAIT_BAR(2);} else if((tt)+2<NT){WAIT_BAR(1);} else {WAIT_BAR(0);} }while(0)
  for(;t+1<NT;t+=2){
    STEP(pB0,pB1,pA0,pA1,t,(t+3<NT),(t+1<NT),(t+1<NT));       ENDW(t);   RESC(); ROT();
    STEP(pA0,pA1,pB0,pB1,t+1,(t+4<NT),(t+2<NT),(t+2<NT));     ENDW(t+1); RESC(); ROT();
  }
  STEP(pB0,pB1,pA0,pA1,NT-1,false,false,false); RESC();
  { float sacc=pB0[0]+pB0[1]; _Pragma("unroll") for(int r=2;r<16;++r)sacc+=pB0[r]; _Pragma("unroll") for(int r=0;r<16;++r)sacc+=pB1[r]; l_reg+=sacc;
    pw0=(u32x4){PKW(pB0,0),PKW(pB0,2),PKW(pB0,4),PKW(pB0,6)};pw1=(u32x4){PKW(pB0,8),PKW(pB0,10),PKW(pB0,12),PKW(pB0,14)};pw2=(u32x4){PKW(pB1,0),PKW(pB1,2),PKW(pB1,4),PKW(pB1,6)};pw3=(u32x4){PKW(pB1,8),PKW(pB1,10),PKW(pB1,12),PKW(pB1,14)};
    SBAR(); pv(o,vb0+sl_cur,PAF(0),PAF(1),PAF(2),PAF(3)); }
  #undef PKW
  #undef PAF
  #undef VFR
  #undef PIN
  #undef MX3
  #undef GAPA
  #undef GAPB
  #undef EX
  #undef VRD
  #undef KRD
  #undef STEP
  #undef ENDW
  {auto rr=__builtin_amdgcn_permlane32_swap(__float_as_uint(l_reg),__float_as_uint(l_reg),false,false);l_reg=__uint_as_float(rr[0])+__uint_as_float(rr[1]);}
  if(hi==0)wsf[32+r32]=l_reg;asm volatile("s_waitcnt lgkmcnt(0)":::"memory");
  float rli[16];
  #pragma unroll
  for(int r=0;r<16;++r)rli[r]=__builtin_amdgcn_rcpf(wsf[32+crow(r,hi)]);
  bf16*Ow=Yo+(qrow0+wid*QBLK)*PO+h*D;
  { bf16*stg=(bf16*)(shm+LDS_OST)+wid*2048;
    #pragma unroll
    for(int r=0;r<16;++r){const int orow=crow(r,hi);
      #pragma unroll
      for(int d0=0;d0<2;++d0)stg[orow*64+d0*32+r32]=__float2bfloat16(o[d0][r]*rli[r]);}
    asm volatile("s_waitcnt lgkmcnt(0)":::"memory");
    #pragma unroll
    for(int i=0;i<4;++i){const int row=i*8+(lane>>3),ch=lane&7; const u32x4 v=*(const u32x4*)(stg+row*64+ch*8); ATTN_STORE16(Ow+(long)row*PO+ch*8,v);} }
  asm volatile("s_waitcnt lgkmcnt(0)\n\ts_barrier":::"memory");
  #undef DMA_K
  #undef KVT
  #undef DMA_V
  #undef CMASK
  #undef START
  #undef RESC
  #undef ROT
}
constexpr int ATTN_LDS_BYTES=LDS_BYTES;
#undef SBAR
#undef WAIT_BAR
}
#ifndef MK_FP8_IN
#define MK_FP8_IN 0
#endif
#ifndef MK_FP8
#define MK_FP8 1
#endif
namespace mk {
constexpr int NB = 16, SQ = 4096, CL = 256, SEG = SQ + CL, T = NB * SEG, D = 1024, INW = 2048, NL = 4, NE = 32;
constexpr int NROWT = T / 256;
constexpr int MAXRT = 1120, CAP = MAXRT * 256;
constexpr int MODW = 6 * D;
constexpr float EPS = 1e-6f;
constexpr int NWAVES = 8;
constexpr int PPL = 12, NPHASE = 2 + NL * PPL;

constexpr size_t MiB = 1u << 20;
constexpr size_t WS_CTL = 0, CTL_ZERO_BYTES = 1 * MiB;
constexpr size_t WS_MOD = 4 * MiB;
constexpr size_t WS_B1P = 6 * MiB;
constexpr size_t WS_PAIR = 8 * MiB;
constexpr size_t WS_TOK = 12 * MiB;
constexpr size_t WS_LOG = 22 * MiB;
constexpr size_t WS_WINT = 32 * MiB;
constexpr size_t WS_WOUTT = 50 * MiB;
constexpr size_t WS_WRT = 60 * MiB;
constexpr size_t WS_W1T = 64 * MiB;
constexpr size_t WS_W2T = 576 * MiB;
constexpr size_t WS_X = 832 * MiB;
constexpr size_t WS_HB = 1104 * MiB;
constexpr size_t WS_P = 1240 * MiB;
constexpr size_t WS_Y = 1512 * MiB;
constexpr size_t WS_HP = 1648 * MiB;
constexpr size_t WS_OB = (1648 + 288) * MiB;
constexpr size_t WS_ACT = 2208 * MiB;
constexpr size_t WS_YP = 2768 * MiB;
constexpr size_t WS_HB8 = 3328 * MiB;
constexpr size_t WS_END = 3400 * MiB;
static_assert(WS_MOD + (size_t)NL * 17 * MODW * 4 <= WS_B1P && WS_B1P + (size_t)NL * NE * 2048 * 4 <= WS_PAIR && WS_PAIR + (size_t)T * 32 <= WS_TOK && WS_TOK + (size_t)NE * T * 4 <= WS_LOG && WS_LOG + (size_t)T * 128 <= WS_WINT, "ws map 1");
static_assert(WS_WINT + (size_t)NL * 2048 * 1024 * 2 <= WS_WOUTT && WS_WOUTT + (size_t)NL * 1024 * 1024 * 2 <= WS_WRT && WS_WRT + (size_t)NL * 256 * 1024 * 2 <= WS_W1T && WS_W1T + (size_t)NL * NE * 2048 * 1024 * 2 <= WS_W2T && WS_W2T + (size_t)NL * NE * 1024 * 1024 * 2 <= WS_X, "ws map 2");
static_assert(WS_X + (size_t)T * 4096 <= WS_HB && WS_HB + (size_t)T * 2048 <= WS_P && WS_P + (size_t)T * 4096 <= WS_Y && WS_Y + (size_t)T * 2048 <= WS_HP && WS_HP + (size_t)CAP * 2048 <= WS_ACT && WS_ACT + (size_t)CAP * 2048 <= WS_YP && WS_YP + (size_t)CAP * 2048 <= WS_HB8 && WS_HB8 + (size_t)T * 1024 <= WS_END, "ws map 3");
constexpr int CW_BAR = 4096;
constexpr int CW_CTX = 81920;
constexpr int CW_CQ = 83968;
constexpr int CW_CNT = 65536;
constexpr int RING_BYTES = 131072;
constexpr int ROPE_OFF = RING_BYTES + 2048;
constexpr int T2E_OFF = ROPE_OFF + 8192;
constexpr int MISC_OFF = T2E_OFF + 2048;
constexpr int LDS_BYTES = 149504;
static_assert(MISC_OFF + 1024 == pg8::PG8_BIAS_OFF && pg8::PG8_IDX_OFF + 2048 <= LDS_BYTES, "LDS map");
static_assert(MK_FP8 == 1 && WS_HP + (size_t)CAP * 1024 <= WS_OB && WS_OB + (size_t)T * 2048 <= WS_ACT, "OB lives in the free half of the HP region");

#define GAS __attribute__((address_space(1)))
#define LAS __attribute__((address_space(3)))
typedef unsigned short bf16;
typedef unsigned v4u __attribute__((ext_vector_type(4)));
typedef unsigned v2u __attribute__((ext_vector_type(2)));
typedef float f32x4 __attribute__((ext_vector_type(4)));
typedef float f32x2 __attribute__((ext_vector_type(2)));
typedef GAS unsigned gu32;
#define RLX_AGENT __ATOMIC_RELAXED, __HIP_MEMORY_SCOPE_AGENT
#define LDS_WAIT() asm volatile("s_waitcnt lgkmcnt(0)" ::: "memory")
#define VM_WAIT() asm volatile("s_waitcnt vmcnt(0)" ::: "memory")
__device__ __forceinline__ unsigned f2bf(float f) { unsigned u = __builtin_bit_cast(unsigned, f); return (u + 0x7fffu + ((u >> 16) & 1u)) >> 16; }
__device__ __forceinline__ unsigned pk2(float lo, float hi) { unsigned r; asm("v_cvt_pk_bf16_f32 %0, %1, %2" : "=v"(r) : "v"(lo), "v"(hi)); return r; }
__device__ __forceinline__ float bflo(unsigned w) { return __builtin_bit_cast(float, w << 16); }
__device__ __forceinline__ float bfhi(unsigned w) { return __builtin_bit_cast(float, w & 0xffff0000u); }
__device__ __forceinline__ f32x4 bf4(v2u w) { return (f32x4){bflo(w.x), bfhi(w.x), bflo(w.y), bfhi(w.y)}; }
__device__ __forceinline__ v2u pk4(f32x4 v) { return (v2u){pk2(v.x, v.y), pk2(v.z, v.w)}; }
using pg8::shx; using pg8::wsum; using pg8::dpp_f; using pg8::sum_x16; using pg8::sum_x32; using pg8::get_x16; using pg8::get_x32;
__device__ __forceinline__ float wave_sum(float v) { return wsum(v); }
__device__ __forceinline__ float sum4(f32x4 v) { return (v.x + v.y) + (v.z + v.w); }
__device__ __forceinline__ float sigmoidf_(float z) { return __builtin_amdgcn_rcpf(1.0f + __builtin_amdgcn_exp2f(z * -1.4426950408889634f)); }
template <int I> __device__ __forceinline__ const float* ldin() { const GAS float* p;
    asm volatile("s_load_dwordx2 %0, %1, %2\n\ts_waitcnt lgkmcnt(0)" : "=s"(p) : "s"(__builtin_amdgcn_kernarg_segment_ptr()), "n"(I * 8) : "memory"); return (const float*)p; }
__device__ __forceinline__ float* ldout() { GAS float* p;
    asm volatile("s_load_dwordx2 %0, %1, %2\n\ts_waitcnt lgkmcnt(0)" : "=s"(p) : "s"(__builtin_amdgcn_kernarg_segment_ptr()), "n"(24 * 8) : "memory"); return (float*)p; }
#define XB_TMO      128
#define XB_XCNT(j)  (256  + 64 * (j))
#define XB_XSUB(j)  (1280 + 64 * (j))
#define XB_XGEN(j)  (2304 + 64 * (j))
#define XB_TOP      3328
#define XB_TOPGEN   3392
#define XCD_BAR_WORDS 3456
#define XB_SPIN_CAP (1u << 22)

__device__ __forceinline__ unsigned xb_ld(unsigned* p)              { return __hip_atomic_load(p, __ATOMIC_RELAXED, __HIP_MEMORY_SCOPE_AGENT); }
__device__ __forceinline__ unsigned xb_add(unsigned* p, unsigned v) { return __hip_atomic_fetch_add(p, v, __ATOMIC_RELAXED, __HIP_MEMORY_SCOPE_AGENT); }
__device__ __forceinline__ unsigned xb_xcc_id() { return (unsigned)__builtin_amdgcn_s_getreg((3 << 11) | 20) & 0xFu; }
#define XB_SPIN(cond, bar) do { unsigned _sp = 0; while (cond) { __builtin_amdgcn_s_sleep(1); \
    if ((++_sp & 255u) == 0u) { if (xb_ld(&(bar)[XB_TMO])) break; if (_sp > XB_SPIN_CAP) { atomicAdd(&(bar)[XB_TMO], 1u); break; } } } } while (0)

struct XcdBarrier {
    unsigned* bar; unsigned x;
    volatile LAS unsigned* st;
};

__device__ __forceinline__ XcdBarrier xcd_barrier_post(unsigned* bar, volatile LAS unsigned* st) {
    XcdBarrier b; b.bar = bar; b.x = xb_xcc_id(); b.st = st;
    if (threadIdx.x == 0) (void)xb_add(&bar[XB_XCNT(b.x)], 1u);
    return b;
}
__device__ __forceinline__ void xcd_barrier_complete(unsigned* bar, unsigned x, unsigned& nloc, unsigned& nx) {
    const unsigned G = gridDim.x * gridDim.y * gridDim.z;
    unsigned sum, cnt, mine, sp = 0u;
    for (;;) {
        sum = 0u; cnt = 0u; mine = 0u;
#pragma unroll
        for (unsigned j = 0; j < 16; ++j) { const unsigned c = xb_ld(&bar[XB_XCNT(j)]); sum += c; cnt += (c > 0u) ? 1u : 0u; mine = (j == x) ? c : mine; }
        if (sum == G) break;
        __builtin_amdgcn_s_sleep(1);
        if ((++sp & 255u) == 0u) { if (xb_ld(&bar[XB_TMO])) break; if (sp > XB_SPIN_CAP) { atomicAdd(&bar[XB_TMO], 1u); break; } }
    }
    nloc = mine > 0u ? mine : 1u; nx = cnt > 0u ? cnt : 1u;
}

__device__ __forceinline__ void xcd_barrier(const XcdBarrier& b) {
    asm volatile("s_waitcnt vmcnt(0)" ::: "memory");
    __syncthreads();
    if (threadIdx.x == 0) {
        unsigned* bar = b.bar;
        __builtin_amdgcn_s_waitcnt(0);
        unsigned nloc = b.st[0], nx = b.st[1];
        if (nloc == 0u) { xcd_barrier_complete(bar, b.x, nloc, nx); b.st[0] = nloc; b.st[1] = nx; }
        const unsigned old = xb_add(&bar[XB_XSUB(b.x)], 1u);
        const unsigned gen = old / nloc;
        if (old + 1u == (gen + 1u) * nloc) {
            __builtin_amdgcn_fence(__ATOMIC_RELEASE, "agent");
            asm volatile("s_waitcnt vmcnt(0)" ::: "memory");
            const unsigned og = xb_add(&bar[XB_TOP], 1u);
            const unsigned tg = og / nx;
            if (og + 1u == (tg + 1u) * nx) xb_add(&bar[XB_TOPGEN], 1u);
            else XB_SPIN(xb_ld(&bar[XB_TOPGEN]) == tg, bar);
            __builtin_amdgcn_fence(__ATOMIC_ACQUIRE, "agent");
            xb_add(&bar[XB_XGEN(b.x)], 1u);
            asm volatile("s_waitcnt vmcnt(0)" ::: "memory");
        } else {
            XB_SPIN(xb_ld(&bar[XB_XGEN(b.x)]) == gen, bar);
            __builtin_amdgcn_fence(__ATOMIC_ACQUIRE, "agent");
            asm volatile("s_waitcnt vmcnt(0)" ::: "memory");
        }
    }
    __syncthreads();
}

struct Ctx {
    LAS unsigned char* lds; volatile LAS unsigned* MISC; gu32* ctl;
    int tid, lane, wave, vcu, G, gw, ngw;
    GAS unsigned char* ws;
    __device__ __forceinline__ float* MOD() const { return (float*)(ws + WS_MOD); }
    __device__ __forceinline__ float* B1P() const { return (float*)(ws + WS_B1P); }
    __device__ __forceinline__ float* LOG() const { return (float*)(ws + WS_LOG); }
    __device__ __forceinline__ bf16* X() const { return (bf16*)(ws + WS_X); }
    __device__ __forceinline__ v2u* PAIR() const { return (v2u*)(ws + WS_PAIR); }
    __device__ __forceinline__ int* TOK() const { return (int*)(ws + WS_TOK); }
    __device__ __forceinline__ bf16* WINT() const { return (bf16*)(ws + WS_WINT); }
    __device__ __forceinline__ bf16* WOUTT() const { return (bf16*)(ws + WS_WOUTT); }
    __device__ __forceinline__ bf16* WRT() const { return (bf16*)(ws + WS_WRT); }
    __device__ __forceinline__ bf16* W1T() const { return (bf16*)(ws + WS_W1T); }
    __device__ __forceinline__ bf16* W2T() const { return (bf16*)(ws + WS_W2T); }
    __device__ __forceinline__ bf16* HB() const { return (bf16*)(ws + WS_HB); }
    __device__ __forceinline__ bf16* P() const { return (bf16*)(ws + WS_P); }
    __device__ __forceinline__ bf16* Y() const { return (bf16*)(ws + WS_Y); }
    __device__ __forceinline__ bf16* HP() const { return (bf16*)(ws + WS_HP); }
    __device__ __forceinline__ bf16* ACT() const { return (bf16*)(ws + WS_ACT); }
    __device__ __forceinline__ bf16* YP() const { return (bf16*)(ws + WS_YP); }
    __device__ __forceinline__ bf16* OB() const { return (bf16*)(ws + WS_OB); }
    __device__ __forceinline__ unsigned char* HB8() const { return (unsigned char*)(ws + WS_HB8); }
};
struct Args { const float* in[24]; float* out; unsigned char* ws; int ph_lo, ph_hi; };

__device__ __forceinline__ int w_in_row(int c) { const int r = c & 255; return (c & ~255) + (((r >> 5) & 1) << 7) + ((r >> 6) << 5) + (r & 31); }
__device__ __forceinline__ int w1_row(int n) { const int a = n >> 1; return ((a >> 7) << 8) + ((n & 1) << 7) + (a & 127); }
template <int MODE>
__device__ __forceinline__ void transpose_item(const float* W, int K, int N, bf16* WT, LAS float* scr, int item, int lane) {
    const int nblk = N / 32, kb = item / nblk, nb = item % nblk, k0 = 64 * kb, n0 = 32 * nb;
    { f32x4 ld[8]; const int r8 = lane >> 3, c4 = (lane & 7) * 4;
#pragma unroll
      for (int i = 0; i < 8; ++i) ld[i] = __builtin_nontemporal_load((const f32x4*)(W + (size_t)(k0 + 8 * i + r8) * N + n0 + c4));
#pragma unroll
      for (int i = 0; i < 8; ++i) { LAS float* d = scr + (8 * i + r8) * 33 + c4; d[0] = ld[i].x; d[1] = ld[i].y; d[2] = ld[i].z; d[3] = ld[i].w; } }
    LDS_WAIT(); asm volatile("" ::: "memory");
    const int c = lane & 7;
#pragma unroll
    for (int j = 0; j < 4; ++j) { const int n = (lane >> 3) + 8 * j; const LAS float* s = scr + (8 * c) * 33 + n;
        v4u o; o.x = pk2(s[0 * 33], s[1 * 33]); o.y = pk2(s[2 * 33], s[3 * 33]); o.z = pk2(s[4 * 33], s[5 * 33]); o.w = pk2(s[6 * 33], s[7 * 33]);
        const int orow = MODE == 1 ? w1_row(n0 + n) : MODE == 2 ? w_in_row(n0 + n) : (n0 + n);
        *(GAS v4u*)(WT + (size_t)orow * K + k0 + 8 * c) = o; }
    LDS_WAIT(); asm volatile("" ::: "memory");
}
template <int MODE>
__device__ __forceinline__ void transpose_item8(const float* W, int K, int N, unsigned char* WT, LAS float* scr, int item, int lane) {
    const int nblk = N / 32, kb = item / nblk, nb = item % nblk, k0 = 64 * kb, n0 = 32 * nb;
    { f32x4 ld[8]; const int r8 = lane >> 3, c4 = (lane & 7) * 4;
#pragma unroll
      for (int i = 0; i < 8; ++i) ld[i] = __builtin_nontemporal_load((const f32x4*)(W + (size_t)(k0 + 8 * i + r8) * N + n0 + c4));
#pragma unroll
      for (int i = 0; i < 8; ++i) { LAS float* d = scr + (8 * i + r8) * 33 + c4; d[0] = ld[i].x; d[1] = ld[i].y; d[2] = ld[i].z; d[3] = ld[i].w; } }
    LDS_WAIT(); asm volatile("" ::: "memory");
    const int n = lane >> 1, h = lane & 1; const LAS float* s = scr + (32 * h) * 33 + n;
    unsigned w[8];
#pragma unroll
    for (int q = 0; q < 8; ++q) { int p = __builtin_amdgcn_cvt_pk_fp8_f32(s[(4 * q) * 33] * 32.0f, s[(4 * q + 1) * 33] * 32.0f, 0, false); p = __builtin_amdgcn_cvt_pk_fp8_f32(s[(4 * q + 2) * 33] * 32.0f, s[(4 * q + 3) * 33] * 32.0f, p, true); w[q] = (unsigned)p; }
    const int orow = MODE == 1 ? w1_row(n0 + n) : MODE == 2 ? w_in_row(n0 + n) : (n0 + n);
    GAS v4u* dst = (GAS v4u*)(WT + (size_t)orow * K + k0 + 32 * h);
    dst[0] = (v4u){w[0], w[1], w[2], w[3]}; dst[1] = (v4u){w[4], w[5], w[6], w[7]};
    LDS_WAIT(); asm volatile("" ::: "memory");
}
template <int MODE>
__device__ __forceinline__ void transpose_item8w(const float* W, int K, int N, unsigned char* WT, LAS float* scr, int item, int lane) {
    const int nblk = N / 64, kb = item / nblk, nb = item % nblk, k0 = 64 * kb, n0 = 64 * nb;
    { f32x4 ld[16]; const int r4 = lane >> 4, c4 = (lane & 15) * 4;
#pragma unroll
      for (int i = 0; i < 16; ++i) ld[i] = *(const f32x4*)(W + (size_t)(k0 + 4 * i + r4) * N + n0 + c4);
#pragma unroll
      for (int i = 0; i < 16; ++i) { LAS float* d = scr + (4 * i + r4) * 65 + c4; d[0] = ld[i].x; d[1] = ld[i].y; d[2] = ld[i].z; d[3] = ld[i].w; } }
    LDS_WAIT(); asm volatile("" ::: "memory");
    const LAS float* s = scr + lane;
    const int orow = MODE == 1 ? w1_row(n0 + lane) : (n0 + lane);
    GAS v4u* dst = (GAS v4u*)(WT + (size_t)orow * K + k0);
#pragma unroll
    for (int g4 = 0; g4 < 4; ++g4) { unsigned w[4];
#pragma unroll
        for (int q = 0; q < 4; ++q) { const int kk = 16 * g4 + 4 * q; int p = __builtin_amdgcn_cvt_pk_fp8_f32(s[kk * 65] * 32.0f, s[(kk + 1) * 65] * 32.0f, 0, false); p = __builtin_amdgcn_cvt_pk_fp8_f32(s[(kk + 2) * 65] * 32.0f, s[(kk + 3) * 65] * 32.0f, p, true); w[q] = (unsigned)p; }
        dst[g4] = (v4u){w[0], w[1], w[2], w[3]}; }
    LDS_WAIT(); asm volatile("" ::: "memory");
}
struct WSrc { const float *w_in, *w_out, *w_e1, *w_e2; };
constexpr int CV_IN = 16 * 64, CV_OUT = 16 * 32, CV_E1 = 16 * 64, CV_E2 = 16 * 32, CV_PER_L = CV_IN + CV_OUT + NE * CV_E1 + NE * CV_E2;
constexpr int CV_HEAD = CV_IN + CV_OUT;
__device__ __forceinline__ void convert_item(const Ctx& C, const WSrc& W, int l, int r, LAS float* scr, int lane) {
    if (r < CV_IN) { transpose_item<2>(W.w_in + (size_t)l * 1024 * 2048, 1024, 2048, C.WINT() + (size_t)l * 2048 * 1024, scr, r, lane); return; } r -= CV_IN;
    if (r < CV_OUT) { transpose_item<0>(W.w_out + (size_t)l * 1024 * 1024, 1024, 1024, C.WOUTT() + (size_t)l * 1024 * 1024, scr, r, lane); return; } r -= CV_OUT;
    if (r < NE * CV_E1) { const int e = r / CV_E1; transpose_item8<1>(W.w_e1 + ((size_t)l * NE + e) * 1024 * 2048, 1024, 2048, (unsigned char*)C.W1T() + ((size_t)l * NE + e) * 2048 * 1024, scr, r % CV_E1, lane); return; } r -= NE * CV_E1;
    { const int e = r / CV_E2; transpose_item8<0>(W.w_e2 + ((size_t)l * NE + e) * 1024 * 1024, 1024, 1024, (unsigned char*)C.W2T() + ((size_t)l * NE + e) * 1024 * 1024, scr, r % CV_E2, lane); }
}
constexpr int CV_TAIL = 6;
__device__ __forceinline__ int tail_items(int nwg, int G) { const int rem = nwg % G; return rem ? (G - rem) * NWAVES * CV_TAIL : 0; }
__device__ __forceinline__ void tail_convert(const Ctx& C, int l, int nwg, int first) {
    const int rem = nwg % C.G, c = (int)blockIdx.x; if (rem == 0 || c < rem) return;
    WSrc W; W.w_in = ldin<8>(); W.w_out = ldin<17>(); W.w_e1 = ldin<20>(); W.w_e2 = ldin<22>();
    LAS float* scr = (LAS float*)(C.lds + C.wave * 8448);
    const int stride = (C.G - rem) * NWAVES; int it = first + (c - rem) * NWAVES + C.wave;
#pragma unroll 1
    for (int k = 0; k < CV_TAIL; ++k, it += stride) if (it < CV_PER_L) convert_item(C, W, l, it, scr, C.lane);
}
__device__ __forceinline__ void convert_bias(const Ctx& C, const float* b_e1, int l) {
    for (int i = C.gw * 64 + C.lane; i < NE * 2048; i += C.ngw * 64) { const int n = i & 2047; C.B1P()[(size_t)l * NE * 2048 + (i & ~2047) + w1_row(n)] = b_e1[(size_t)l * NE * 2048 + i]; }
}
__device__ __forceinline__ void phase_prologue(const Ctx& C, const Args& A) {
    __syncthreads();
    {
        LAS float* sS = (LAS float*)C.lds;
        const float* cin = ldin<1>(); const float* cctx = ldin<3>(); const float* wada = ldin<4>(); const float* bada = ldin<5>();
        for (int i = C.tid; i < 17 * 1024; i += NWAVES * 64) { const int j = i >> 10, k = i & 1023; const float v = j < 16 ? cin[j * 1024 + k] : cctx[k]; sS[i] = v * sigmoidf_(v); }
        __syncthreads();
        const int kl = C.tid & 15, cg = C.tid >> 4;
        for (int item = blockIdx.x; item < NL * 64; item += C.G) {
            if (cg >= 24) continue;
            const int l = item / 64, c0 = (item % 64) * 96 + 4 * cg;
            const float* W = wada + (size_t)l * 1024 * MODW + c0;
            f32x4 acc[17];
#pragma unroll
            for (int j = 0; j < 17; ++j) acc[j] = (f32x4){0.f, 0.f, 0.f, 0.f};
#pragma unroll 1
            for (int k0 = kl; k0 < 1024; k0 += 64) { f32x4 w[4];
#pragma unroll
                for (int u = 0; u < 4; ++u) w[u] = __builtin_nontemporal_load((const f32x4*)(W + (size_t)(k0 + 16 * u) * MODW));
#pragma unroll
                for (int u = 0; u < 4; ++u)
#pragma unroll
                    for (int j = 0; j < 17; ++j) acc[j] += sS[j * 1024 + k0 + 16 * u] * w[u]; }
#pragma unroll
            for (int j = 0; j < 17; ++j)
#pragma unroll
                for (int o = 1; o < 16; o <<= 1) { acc[j].x += shx(acc[j].x, o); acc[j].y += shx(acc[j].y, o); acc[j].z += shx(acc[j].z, o); acc[j].w += shx(acc[j].w, o); }
            if (kl == 0) { const f32x4 bv = *(const f32x4*)(bada + (size_t)l * MODW + c0);
#pragma unroll
                for (int j = 0; j < 17; ++j) *(f32x4*)(C.MOD() + ((size_t)l * 17 + j) * MODW + c0) = acc[j] + bv; }
        }
        __syncthreads();
    }
    {
        LAS float* scr = (LAS float*)(C.lds + C.wave * 8448);
        WSrc W; W.w_in = ldin<8>(); W.w_out = ldin<17>(); W.w_e1 = ldin<20>(); W.w_e2 = ldin<22>();
        for (int it = C.gw; it < CV_HEAD; it += C.ngw) convert_item(C, W, 0, it, scr, C.lane);
        convert_bias(C, ldin<21>(), 0);
    }
}

__device__ __forceinline__ void moe_tables(const Ctx& C, int l, bool with_t2e) {
    __syncthreads();
    if (C.tid < NE) C.MISC[40 + C.tid] = __hip_atomic_load(C.ctl + CW_CNT + (l * NE + C.tid) * 64, RLX_AGENT);
    __syncthreads();
    if (C.tid == 0) { unsigned s = 0;
#pragma unroll 1
        for (int e = 0; e < NE; ++e) { C.MISC[e] = s; s += (C.MISC[40 + e] + 255u) >> 8; } C.MISC[NE] = s; }
    __syncthreads();
    if (with_t2e) { LAS unsigned char* t2e = (LAS unsigned char*)(C.lds + T2E_OFF);
        for (int rt = C.tid; rt < MAXRT; rt += NWAVES * 64) { unsigned e = 0;
#pragma unroll 1
            for (int k = 1; k < NE; ++k) e += (C.MISC[k] <= (unsigned)rt) ? 1u : 0u;
            t2e[rt] = (unsigned char)e; }
        __syncthreads(); }
}

__device__ __forceinline__ void row_bt(int r, int& b, int& t, int& j) { b = r / SEG; t = r - b * SEG; j = t < SQ ? b : 16; }
__device__ __forceinline__ void wave_rows(const Ctx& C, int n, int& rbeg, int& rend) { const int rpw = (n + C.ngw - 1) / C.ngw; rbeg = C.gw * rpw; rend = rbeg + rpw < n ? rbeg + rpw : n; }
__device__ __forceinline__ int colq(int q, int lane) { return 512 * (q >> 1) + 8 * lane + 4 * (q & 1); }
__device__ __forceinline__ void bf8_to_f32(v4u w, f32x4& a, f32x4& b) { a = (f32x4){bflo(w.x), bfhi(w.x), bflo(w.y), bfhi(w.y)}; b = (f32x4){bflo(w.z), bfhi(w.z), bflo(w.w), bfhi(w.w)}; }
__device__ __forceinline__ v4u f32_to_bf8(f32x4 a, f32x4 b) { return (v4u){pk2(a.x, a.y), pk2(a.z, a.w), pk2(b.x, b.y), pk2(b.z, b.w)}; }
__device__ __forceinline__ void fp8x8_to_f32(v2u w, f32x4& a, f32x4& b) {
    const unsigned w0 = w.x, w1 = w.y;
    const f32x2 p0 = __builtin_amdgcn_cvt_pk_f32_fp8((int)w0, false), p1 = __builtin_amdgcn_cvt_pk_f32_fp8((int)w0, true), p2 = __builtin_amdgcn_cvt_pk_f32_fp8((int)w1, false), p3 = __builtin_amdgcn_cvt_pk_f32_fp8((int)w1, true);
    a = (f32x4){p0.x, p0.y, p1.x, p1.y}; b = (f32x4){p2.x, p2.y, p3.x, p3.y}; }
__device__ __forceinline__ v2u f32_to_fp8x8(f32x4 a, f32x4 b) {
    int p0 = __builtin_amdgcn_cvt_pk_fp8_f32(a.x, a.y, 0, false); p0 = __builtin_amdgcn_cvt_pk_fp8_f32(a.z, a.w, p0, true);
    int p1 = __builtin_amdgcn_cvt_pk_fp8_f32(b.x, b.y, 0, false); p1 = __builtin_amdgcn_cvt_pk_fp8_f32(b.z, b.w, p1, true);
    return (v2u){(unsigned)p0, (unsigned)p1}; }
__device__ __forceinline__ void modulate2(const f32x4 (&v)[2][4], const f32x4 (&gv)[4], const float* const (&mj)[2], int sh_chunk, f32x4 (&h)[2][4], int lane) {
    f32x4 sh[2][4], sc[2][4]; float ss[2];
#pragma unroll
    for (int u = 0; u < 2; ++u) { ss[u] = 0.f;
#pragma unroll
        for (int q = 0; q < 4; ++q) { const int c = colq(q, lane); sh[u][q] = *(const f32x4*)(mj[u] + sh_chunk * D + c); sc[u][q] = *(const f32x4*)(mj[u] + (sh_chunk + 1) * D + c); ss[u] += sum4(v[u][q] * v[u][q]); } }
    ss[0] = wsum(ss[0]); ss[1] = wsum(ss[1]);
#pragma unroll
    for (int u = 0; u < 2; ++u) { const float rs = __builtin_amdgcn_rsqf(ss[u] * (1.0f / D) + EPS);
#pragma unroll
        for (int q = 0; q < 4; ++q) h[u][q] = (v[u][q] * rs) * gv[q] * (1.0f + sc[u][q]) + sh[u][q]; }
}
__device__ __forceinline__ void pair_load2(const Ctx& C, const int (&r)[2], v2u (&pr)[2][4]) {
#pragma unroll
    for (int u = 0; u < 2; ++u)
#pragma unroll
        for (int k = 0; k < 4; ++k) pr[u][k] = C.PAIR()[(size_t)r[u] * 4 + k];
}
__device__ __forceinline__ void moe_combine2(const Ctx& C, const v2u (&pr)[2][4], f32x4 (&acc)[2][4]) {
    v2u y[2][4][2];
#pragma unroll
    for (int u = 0; u < 2; ++u)
#pragma unroll
        for (int k = 0; k < 4; ++k) { const unsigned px = pr[u][k].x; const unsigned e = px & 31u, pos = px >> 5;
            const unsigned char* yp = (const unsigned char*)C.YP() + ((size_t)C.MISC[e] * 256 + pos) * D + 8 * C.lane;
#pragma unroll
            for (int jj = 0; jj < 2; ++jj) y[u][k][jj] = __builtin_nontemporal_load((const GAS v2u*)(yp + 512 * jj)); }
#pragma unroll
    for (int u = 0; u < 2; ++u) {
#pragma unroll
        for (int q = 0; q < 4; ++q) acc[u][q] = (f32x4){0.f, 0.f, 0.f, 0.f};
#pragma unroll
        for (int k = 0; k < 4; ++k) { const unsigned wb = pr[u][k].y; const float wt = __uint_as_float(wb) * 0.125f;
#pragma unroll
            for (int jj = 0; jj < 2; ++jj) { f32x4 ya, yb; fp8x8_to_f32(y[u][k][jj], ya, yb); acc[u][2 * jj] += wt * ya; acc[u][2 * jj + 1] += wt * yb; } } }
}
__device__ __forceinline__ void ld_x2(const Ctx& C, const bf16* base, const int (&r)[2], f32x4 (&v)[2][4]) {
#pragma unroll
    for (int u = 0; u < 2; ++u)
#pragma unroll
        for (int jj = 0; jj < 2; ++jj) bf8_to_f32(__builtin_nontemporal_load((const GAS v4u*)(base + (size_t)r[u] * D + 512 * jj + 8 * C.lane)), v[u][2 * jj], v[u][2 * jj + 1]);
}

__device__ __forceinline__ void phase_premix(const Ctx& C, const Args& A, int l) {
    if (l > 0) moe_tables(C, l - 1, false);
    const float* modl = C.MOD() + (size_t)l * 17 * MODW; const float* modp = C.MOD() + (size_t)(l > 0 ? l - 1 : 0) * 17 * MODW;
    const float* g = ldin<6>() + (size_t)l * D; const float* xin = ldin<0>(); const float* cxin = ldin<2>();
    f32x4 gv[4];
#pragma unroll
    for (int q = 0; q < 4; ++q) gv[q] = *(const f32x4*)(g + colq(q, C.lane));
    int rbeg, rend; wave_rows(C, T, rbeg, rend);
    v2u pr[2][4]; if (l > 0 && rbeg < rend) { const int rf[2] = {rbeg, rbeg + 1 < rend ? rbeg + 1 : rbeg}; pair_load2(C, rf, pr); }
    int jc = -1; f32x4 gtc[4], shc[4], gsc[4];
#pragma unroll
    for (int q = 0; q < 4; ++q) { gtc[q] = gv[q]; shc[q] = gv[q]; gsc[q] = gv[q]; }
    for (int r0 = rbeg; r0 < rend; r0 += 2) {
        const int r[2] = {r0, r0 + 1 < rend ? r0 + 1 : r0};
        int b[2], t[2], j[2]; row_bt(r[0], b[0], t[0], j[0]); row_bt(r[1], b[1], t[1], j[1]);
        f32x4 v[2][4];
        if (l == 0) {
#pragma unroll
            for (int u = 0; u < 2; ++u) { const float* src = t[u] < SQ ? xin + ((size_t)b[u] * SQ + t[u]) * D : cxin + ((size_t)b[u] * CL + (t[u] - SQ)) * D;
#pragma unroll
                for (int q = 0; q < 4; ++q) v[u][q] = __builtin_nontemporal_load((const f32x4*)(src + colq(q, C.lane))); }
        } else {
            ld_x2(C, C.OB(), r, v);
            v2u prn[2][4]; { const int a = r0 + 2 < rend ? r0 + 2 : r0, b2 = r0 + 3 < rend ? r0 + 3 : a; const int rn[2] = {a, b2}; pair_load2(C, rn, prn); }
            f32x4 acc[2][4]; moe_combine2(C, pr, acc);
#pragma unroll
            for (int u = 0; u < 2; ++u)
#pragma unroll
                for (int k = 0; k < 4; ++k) pr[u][k] = prn[u][k];
            if (j[0] != jc) {
#pragma unroll
                for (int q = 0; q < 4; ++q) gtc[q] = *(const f32x4*)(modp + (size_t)j[0] * MODW + 5 * D + colq(q, C.lane)); }
#pragma unroll
            for (int u = 0; u < 2; ++u) {
                if (j[u] == j[0]) {
#pragma unroll
                    for (int q = 0; q < 4; ++q) v[u][q] += gtc[q] * acc[u][q]; }
                else {
#pragma unroll
                    for (int q = 0; q < 4; ++q) v[u][q] += *(const f32x4*)(modp + (size_t)j[u] * MODW + 5 * D + colq(q, C.lane)) * acc[u][q]; } } }
        if (j[0] != jc) { jc = j[0]; const float* m = modl + (size_t)jc * MODW;
#pragma unroll
            for (int q = 0; q < 4; ++q) { const int c = colq(q, C.lane); shc[q] = *(const f32x4*)(m + c); gsc[q] = gv[q] * (1.0f + *(const f32x4*)(m + D + c)); } }
        f32x4 h[2][4]; float ss[2];
#pragma unroll
        for (int u = 0; u < 2; ++u) { ss[u] = 0.f;
#pragma unroll
            for (int q = 0; q < 4; ++q) ss[u] += sum4(v[u][q] * v[u][q]); }
        ss[0] = wsum(ss[0]); ss[1] = wsum(ss[1]);
#pragma unroll
        for (int u = 0; u < 2; ++u) { const float rs = __builtin_amdgcn_rsqf(ss[u] * (1.0f / D) + EPS);
            if (j[u] == jc) {
#pragma unroll
                for (int q = 0; q < 4; ++q) h[u][q] = (v[u][q] * rs) * gsc[q] + shc[q]; }
            else { const float* m = modl + (size_t)j[u] * MODW;
#pragma unroll
                for (int q = 0; q < 4; ++q) { const int c = colq(q, C.lane); h[u][q] = (v[u][q] * rs) * (gv[q] * (1.0f + *(const f32x4*)(m + D + c))) + *(const f32x4*)(m + c); } } }
#pragma unroll
        for (int u = 0; u < 2; ++u)
#pragma unroll
            for (int jj = 0; jj < 2; ++jj) { const size_t o = (size_t)r[u] * D + 512 * jj + 8 * C.lane;
                __builtin_nontemporal_store(f32_to_bf8(v[u][2 * jj], v[u][2 * jj + 1]), (GAS v4u*)(C.X() + o));
#if MK_FP8_IN == 1
                *(GAS v2u*)((unsigned char*)C.HB() + o) = f32_to_fp8x8(h[u][2 * jj], h[u][2 * jj + 1]); }
#elif MK_FP8_IN == 2
                *(GAS v4u*)(C.HB() + o) = f32_to_bf8(h[u][2 * jj], h[u][2 * jj + 1]); *(GAS v2u*)(C.HB8() + o) = f32_to_fp8x8(h[u][2 * jj], h[u][2 * jj + 1]); }
#else
                *(GAS v4u*)(C.HB() + o) = f32_to_bf8(h[u][2 * jj], h[u][2 * jj + 1]); }
#endif
    }
}
__device__ __forceinline__ void phase_premoe(const Ctx& C, const Args& A, int l) {
    const float* modl = C.MOD() + (size_t)l * 17 * MODW; const float* g = ldin<7>() + (size_t)l * D;
    typedef __bf16 bf16x2_t __attribute__((ext_vector_type(2)));
    volatile LAS unsigned* lhist = C.MISC + 80; volatile LAS unsigned* lbase = C.MISC + 112;
    __syncthreads();
    { const float* wr = ldin<18>() + (size_t)l * D * NE;
      for (int idx = C.tid; idx < 8 * 4 * 2 * 64; idx += NWAVES * 64) { const int ln = idx & 63, jj = (idx >> 6) & 1, ip = (idx >> 7) & 3, e4 = idx >> 9;
          const float* w0 = wr + (size_t)(512 * jj + 8 * ln + 2 * ip) * NE + 4 * e4; const f32x4 a = *(const f32x4*)w0, b = *(const f32x4*)(w0 + NE);
          ((LAS v4u*)C.lds)[idx] = (v4u){pk2(a.x, b.x), pk2(a.y, b.y), pk2(a.z, b.z), pk2(a.w, b.w)}; }
      if (C.tid < NE) lhist[C.tid] = 0u; }
    __syncthreads();
    f32x4 gv[4];
#pragma unroll
    for (int q = 0; q < 4; ++q) gv[q] = *(const f32x4*)(g + colq(q, C.lane));
    const int half = C.lane >> 5, ex = C.lane & 31;
    const float br = ldin<19>()[l * NE + ex];
    const bool lat = l + 1 == NL;
#define RMAP(q) (lat ? ((q) / SQ) * SEG + (q) % SQ : (q))
    int rbeg, rend; wave_rows(C, lat ? NB * SQ : T, rbeg, rend);
    const bool cv = true; int cit = CV_HEAD + tail_items(NROWT * (INW / 256), C.G) + tail_items((l + 1 < NL ? NROWT : NB * SQ / 256) * (D / 256), C.G) + C.gw; LAS float* cscr = (LAS float*)(C.lds + 65536 + C.wave * 8448);
    WSrc W; W.w_in = ldin<8>(); W.w_out = ldin<17>(); W.w_e1 = ldin<20>(); W.w_e2 = ldin<22>();
    v4u ob[2][2];
    if (rbeg < rend) { const int ra = RMAP(rbeg), rb = RMAP(rbeg + 1 < rend ? rbeg + 1 : rbeg);
#pragma unroll
        for (int jj = 0; jj < 2; ++jj) { ob[0][jj] = __builtin_nontemporal_load((const GAS v4u*)(C.OB() + (size_t)ra * D + 512 * jj + 8 * C.lane)); ob[1][jj] = __builtin_nontemporal_load((const GAS v4u*)(C.OB() + (size_t)rb * D + 512 * jj + 8 * C.lane)); } }
    int jc = -1; f32x4 shc[4], gsc[4];
#pragma unroll
    for (int q = 0; q < 4; ++q) { shc[q] = gv[q]; gsc[q] = gv[q]; }
    for (int r0 = rbeg; r0 < rend; r0 += 2) {
        const bool two = r0 + 1 < rend; const int r[2] = {RMAP(r0), RMAP(two ? r0 + 1 : r0)};
        int b[2], t[2], j[2]; row_bt(r[0], b[0], t[0], j[0]); row_bt(r[1], b[1], t[1], j[1]);
        f32x4 v[2][4];
#pragma unroll
        for (int u = 0; u < 2; ++u)
#pragma unroll
            for (int jj = 0; jj < 2; ++jj) bf8_to_f32(ob[u][jj], v[u][2 * jj], v[u][2 * jj + 1]);
        { const int qa = r0 + 2 < rend ? r0 + 2 : r0, qb = r0 + 3 < rend ? r0 + 3 : qa; const int ra = RMAP(qa), rb = RMAP(qb);
#pragma unroll
          for (int jj = 0; jj < 2; ++jj) { ob[0][jj] = __builtin_nontemporal_load((const GAS v4u*)(C.OB() + (size_t)ra * D + 512 * jj + 8 * C.lane)); ob[1][jj] = __builtin_nontemporal_load((const GAS v4u*)(C.OB() + (size_t)rb * D + 512 * jj + 8 * C.lane)); } }
        if (j[0] != jc) { jc = j[0]; const float* m = modl + (size_t)jc * MODW + 3 * D;
#pragma unroll
            for (int q = 0; q < 4; ++q) { const int c = colq(q, C.lane); shc[q] = *(const f32x4*)(m + c); gsc[q] = gv[q] * (1.0f + *(const f32x4*)(m + D + c)); } }
        f32x4 h[2][4]; float ss[2];
#pragma unroll
        for (int u = 0; u < 2; ++u) { ss[u] = 0.f;
#pragma unroll
            for (int q = 0; q < 4; ++q) ss[u] += sum4(v[u][q] * v[u][q]); }
        ss[0] = wsum(ss[0]); ss[1] = wsum(ss[1]);
#pragma unroll
        for (int u = 0; u < 2; ++u) { const float rs = __builtin_amdgcn_rsqf(ss[u] * (1.0f / D) + EPS);
            if (j[u] == jc) {
#pragma unroll
                for (int q = 0; q < 4; ++q) h[u][q] = (v[u][q] * rs) * gsc[q] + shc[q]; }
            else { const float* m = modl + (size_t)j[u] * MODW + 3 * D;
#pragma unroll
                for (int q = 0; q < 4; ++q) { const int c = colq(q, C.lane); h[u][q] = (v[u][q] * rs) * (gv[q] * (1.0f + *(const f32x4*)(m + D + c))) + *(const f32x4*)(m + c); } } }
#pragma unroll
        for (int u = 0; u < 2; ++u)
#pragma unroll
            for (int jj = 0; jj < 2; ++jj) { const size_t o = (size_t)r[u] * D + 512 * jj + 8 * C.lane;
                *(GAS v2u*)(C.HB8() + o) = f32_to_fp8x8(h[u][2 * jj], h[u][2 * jj + 1]); }
        f32x4 pl[2][8];
#pragma unroll
        for (int e4 = 0; e4 < 8; ++e4) { pl[0][e4] = (f32x4){0.f, 0.f, 0.f, 0.f}; pl[1][e4] = pl[0][e4]; }
#pragma unroll
        for (int jj = 0; jj < 2; ++jj)
#pragma unroll
            for (int ip = 0; ip < 4; ++ip) { const int q = 2 * jj + (ip >> 1), c0 = 2 * (ip & 1);
                const bf16x2_t h0 = __builtin_bit_cast(bf16x2_t, pk2(h[0][q][c0], h[0][q][c0 + 1])), h1 = __builtin_bit_cast(bf16x2_t, pk2(h[1][q][c0], h[1][q][c0 + 1]));
#pragma unroll
                for (int e4 = 0; e4 < 8; ++e4) { const v4u w = ((const LAS v4u*)C.lds)[((e4 * 4 + ip) * 2 + jj) * 64 + C.lane];
                    const unsigned wx[4] = {w.x, w.y, w.z, w.w};
#pragma unroll
                    for (int x = 0; x < 4; ++x) { const bf16x2_t wb = __builtin_bit_cast(bf16x2_t, wx[x]);
                        pl[0][e4][x] = __builtin_amdgcn_fdot2_f32_bf16(h0, wb, pl[0][e4][x], false); pl[1][e4][x] = __builtin_amdgcn_fdot2_f32_bf16(h1, wb, pl[1][e4][x], false); } } }
        float s32[32];
#pragma unroll
        for (int e = 0; e < 32; ++e) { const auto r = __builtin_amdgcn_permlane32_swap(__float_as_uint(pl[0][e >> 2][e & 3]), __float_as_uint(pl[1][e >> 2][e & 3]), false, false); s32[e] = __uint_as_float(r[0]) + __uint_as_float(r[1]); }
        float s16[16];
#pragma unroll
        for (int e = 0; e < 16; ++e) { const auto r = __builtin_amdgcn_permlane16_swap(__float_as_uint(s32[e]), __float_as_uint(s32[16 + e]), false, false); s16[e] = __uint_as_float(r[0]) + __uint_as_float(r[1]); }
        float s8[8];
#pragma unroll
        for (int e = 0; e < 8; ++e) { const bool hi = (C.lane & 8) != 0; const float keep = hi ? s16[8 + e] : s16[e], send = hi ? s16[e] : s16[8 + e]; s8[e] = keep + dpp_f<0x128>(send); }
        float s4[4];
#pragma unroll
        for (int e = 0; e < 4; ++e) { const bool hi = (C.lane & 4) != 0; const float keep = hi ? s8[4 + e] : s8[e], send = hi ? s8[e] : s8[4 + e]; s4[e] = keep + dpp_f<0x1B>(dpp_f<0x141>(send)); }
        float s2[2];
#pragma unroll
        for (int e = 0; e < 2; ++e) { const bool hi = (C.lane & 2) != 0; const float keep = hi ? s4[2 + e] : s4[e], send = hi ? s4[e] : s4[2 + e]; s2[e] = keep + dpp_f<0x4E>(send); }
        float lg; { const bool hi = (C.lane & 1) != 0; const float keep = hi ? s2[1] : s2[0], send = hi ? s2[0] : s2[1]; lg = keep + dpp_f<0xB1>(send); }
        const float vv = lg + br; const int vb = __float_as_int(vv);
        float cur = vv; int rank = 4; float sv[4];
#pragma unroll
        for (int k = 0; k < 4; ++k) { float m = cur; m = __builtin_fmaxf(m, dpp_f<0xB1>(m)); m = __builtin_fmaxf(m, dpp_f<0x4E>(m)); m = __builtin_fmaxf(m, dpp_f<0x141>(m)); m = __builtin_fmaxf(m, dpp_f<0x140>(m));
            { const auto rr = __builtin_amdgcn_permlane16_swap(__float_as_uint(m), __float_as_uint(m), false, false); m = __builtin_fmaxf(__uint_as_float(rr[0]), __uint_as_float(rr[1])); }
            sv[k] = m;
            const unsigned long long mk = __ballot(cur == m); const int s0 = (int)__builtin_ctz((unsigned)mk | 0x80000000u), s1 = (int)__builtin_ctz((unsigned)(mk >> 32) | 0x80000000u);
            if (ex == (half ? s1 : s0)) { rank = k; cur = -INFINITY; } }
        const float inv = __builtin_amdgcn_rcpf(1.0f + __expf(sv[1] - sv[0]) + __expf(sv[2] - sv[0]) + __expf(sv[3] - sv[0]));
        if (rank < 4 && (half == 0 || two)) { const int rr = r[half];
            const unsigned lpos = __hip_atomic_fetch_add((LAS unsigned*)(C.lds + MISC_OFF) + 80 + ex, 1u, __ATOMIC_RELAXED, __HIP_MEMORY_SCOPE_WORKGROUP);
            C.PAIR()[(size_t)rr * 4 + rank] = (v2u){(unsigned)ex | (lpos << 5), __float_as_uint(__expf(vv - sv[0]) * inv)}; }
        if (cv) {
#pragma unroll 1
            for (int k = 0; k < 2 && cit < CV_PER_L; ++k, cit += C.ngw) convert_item(C, W, l, cit, cscr, C.lane); }
    }
    if (cv) {
#pragma unroll 1
        for (; cit < CV_PER_L; cit += C.ngw) convert_item(C, W, l, cit, cscr, C.lane);
        if (l + 1 < NL) {
#pragma unroll 1
            for (int it = C.gw; it < CV_HEAD; it += C.ngw) convert_item(C, W, l + 1, it, cscr, C.lane);
            convert_bias(C, ldin<21>(), l + 1); } }
    __syncthreads();
    gu32* cnt = C.ctl + CW_CNT + (size_t)l * NE * 64;
    if (C.tid < NE) { const unsigned n = lhist[C.tid]; lbase[C.tid] = n ? __hip_atomic_fetch_add(cnt + C.tid * 64, n, RLX_AGENT) : 0u; }
    __syncthreads();
    for (int idx = C.lane; idx < (rend - rbeg) * 4; idx += 64) { const int rr = RMAP(rbeg + (idx >> 2)); gu32* px = (gu32*)C.PAIR() + ((size_t)rr * 4 + (idx & 3)) * 2;
        const unsigned x = __hip_atomic_load(px, RLX_AGENT); const unsigned e = x & 31u, pos = lbase[e] + (x >> 5);
        *px = e | (pos << 5); C.TOK()[(size_t)e * T + pos] = rr; }
    __syncthreads();
#undef RMAP
}
__device__ __forceinline__ void phase_final(const Ctx& C, const Args& A) {
    moe_tables(C, NL - 1, false);
    const float* modp = C.MOD() + (size_t)(NL - 1) * 17 * MODW; float* outp = ldout();
    int qbeg, qend; wave_rows(C, NB * SQ, qbeg, qend);
    v2u pr[2][4]; if (qbeg < qend) { const int qa = qbeg, qb = qbeg + 1 < qend ? qbeg + 1 : qbeg; const int rf[2] = {(qa / SQ) * SEG + qa % SQ, (qb / SQ) * SEG + qb % SQ}; pair_load2(C, rf, pr); }
    int bc = -1; f32x4 gtc[4];
#pragma unroll
    for (int q = 0; q < 4; ++q) gtc[q] = (f32x4){0.f, 0.f, 0.f, 0.f};
    for (int q0 = qbeg; q0 < qend; q0 += 2) {
        const int qq[2] = {q0, q0 + 1 < qend ? q0 + 1 : q0}; const int b[2] = {qq[0] / SQ, qq[1] / SQ}; const int r[2] = {b[0] * SEG + (qq[0] - b[0] * SQ), b[1] * SEG + (qq[1] - b[1] * SQ)};
        f32x4 v[2][4]; ld_x2(C, C.OB(), r, v);
        if (b[0] != bc) { bc = b[0];
#pragma unroll
            for (int q = 0; q < 4; ++q) gtc[q] = *(const f32x4*)(modp + (size_t)bc * MODW + 5 * D + colq(q, C.lane)); }
        v2u prn[2][4]; { const int qa = q0 + 2 < qend ? q0 + 2 : q0, qb = q0 + 3 < qend ? q0 + 3 : qa; const int rn[2] = {(qa / SQ) * SEG + qa % SQ, (qb / SQ) * SEG + qb % SQ}; pair_load2(C, rn, prn); }
        f32x4 acc[2][4]; moe_combine2(C, pr, acc);
#pragma unroll
        for (int u = 0; u < 2; ++u)
#pragma unroll
            for (int k = 0; k < 4; ++k) pr[u][k] = prn[u][k];
#pragma unroll
        for (int u = 0; u < 2; ++u) { float* o = outp + (size_t)qq[u] * D;
            if (b[u] == bc) {
#pragma unroll
                for (int q = 0; q < 4; ++q) __builtin_nontemporal_store(v[u][q] + gtc[q] * acc[u][q], (f32x4*)(o + colq(q, C.lane))); }
            else {
#pragma unroll
                for (int q = 0; q < 4; ++q) *(f32x4*)(o + colq(q, C.lane)) = v[u][q] + *(const f32x4*)(modp + (size_t)b[u] * MODW + 5 * D + colq(q, C.lane)) * acc[u][q]; } }
    }
}

__device__ __forceinline__ v4u qk_piece(v4u w, const float (&gain)[8], bool lat, int pos, int i0, bool first, float scale, const LAS f32x2* rope) {
    float f[8] = {bflo(w.x), bfhi(w.x), bflo(w.y), bfhi(w.y), bflo(w.z), bfhi(w.z), bflo(w.w), bfhi(w.w)};
    float ss = 0.f;
#pragma unroll
    for (int i = 0; i < 8; ++i) ss += f[i] * f[i];
    ss += shx(ss, 1); ss += shx(ss, 2); ss += shx(ss, 4);
    const float rs = __builtin_amdgcn_rsqf(ss * (1.0f / 64.0f) + EPS);
    float o[8];
#pragma unroll
    for (int i = 0; i < 8; ++i) f[i] = f[i] * rs * gain[i];
#pragma unroll
    for (int i = 0; i < 8; ++i) { const float pv = shx(f[i], 2); const f32x2 cs = rope[(pos & 63) * 16 + i0 + i];
        const float rot = first ? f[i] * cs.x - pv * cs.y : f[i] * cs.x + pv * cs.y;
        o[i] = (lat ? rot : f[i]) * scale; }
    v4u ow; ow.x = pk2(o[0], o[1]); ow.y = pk2(o[2], o[3]); ow.z = pk2(o[4], o[5]); ow.w = pk2(o[6], o[7]); return ow;
}
__device__ __forceinline__ void phase_qknorm(const Ctx& C, const Args& A, int l) {
    const LAS f32x2* rope = (const LAS f32x2*)(C.lds + ROPE_OFF);
    const float* gq = ldin<9>() + l * 64; const float* gk = ldin<10>() + l * 64;
    const int d0 = 8 * (C.lane & 7);
    const int ax = d0 >> 5, o0 = d0 & 31; const bool first = o0 < 16; const int i0 = o0 & 15;
    float gqv[8], gkv[8];
#pragma unroll
    for (int i = 0; i < 8; ++i) { gqv[i] = gq[d0 + i]; gkv[i] = gk[d0 + i]; }
    int rbeg, rend; wave_rows(C, T, rbeg, rend);
    for (int r0 = rbeg; r0 < rend; r0 += 4) {
        v4u wq[4]; bool ok[4]; int tt[4];
#pragma unroll
        for (int u = 0; u < 4; ++u) { ok[u] = r0 + u < rend; const int r = ok[u] ? r0 + u : r0; tt[u] = r % SEG; wq[u] = *(const GAS v4u*)(C.P() + (size_t)r * INW + 8 * C.lane); }
        const int uk = C.lane >> 4; const bool okk = r0 + uk < rend; const int rk = okk ? r0 + uk : r0; const int tk = rk % SEG;
        bf16* pk = C.P() + (size_t)rk * INW + 512 + 8 * (C.lane & 15);
        const v4u wk = *(const GAS v4u*)pk;
#pragma unroll
        for (int u = 0; u < 4; ++u) { const bool lat = tt[u] < SQ; const int pos = ax == 0 ? (tt[u] >> 6) : (tt[u] & 63);
            const v4u ow = qk_piece(wq[u], gqv, lat, pos, i0, first, attn_body::C2, rope);
            if (ok[u]) *(GAS v4u*)(C.P() + (size_t)(r0 + u) * INW + 8 * C.lane) = ow; }
        { const bool lat = tk < SQ; const int pos = ax == 0 ? (tk >> 6) : (tk & 63);
          const v4u ow = qk_piece(wk, gkv, lat, pos, i0, first, 1.0f, rope);
          if (okk) *(GAS v4u*)pk = ow; }
    }
}

__device__ __forceinline__ void attn_gnorm(const Ctx& C, size_t row0, const float* gg) {
    const f32x4 gA0 = *(const f32x4*)(gg + 8 * C.lane), gA1 = *(const f32x4*)(gg + 8 * C.lane + 4);
    bf16* y0 = C.Y() + (row0 + C.wave * 32) * D + 8 * C.lane;
#pragma unroll 1
    for (int i = 0; i < 32; i += 16) {
        v4u av[16]; float qa[16];
#pragma unroll
        for (int u = 0; u < 16; ++u) av[u] = *(const GAS v4u*)(y0 + (size_t)(i + u) * D);
#pragma unroll
        for (int u = 0; u < 16; ++u) { const f32x4 a0 = bf4((v2u){av[u].x, av[u].y}), a1 = bf4((v2u){av[u].z, av[u].w}); qa[u] = sum4(a0 * a0) + sum4(a1 * a1); }
#pragma unroll
        for (int u = 0; u < 16; ++u) qa[u] = wsum(qa[u]);
#pragma unroll
        for (int u = 0; u < 16; ++u) { const float rsa = __builtin_amdgcn_rsqf(qa[u] * (1.0f / 512.0f) + EPS);
            const f32x4 a0 = bf4((v2u){av[u].x, av[u].y}), a1 = bf4((v2u){av[u].z, av[u].w});
            const v2u o0 = pk4(a0 * rsa * gA0), o1 = pk4(a1 * rsa * gA1);
            *(GAS v4u*)(y0 + (size_t)(i + u) * D) = (v4u){o0.x, o0.y, o1.x, o1.y}; }
    }
}
template <bool FIXR> __device__ __forceinline__ void phase_attn_impl(const Ctx& C, int l) {
    char* shm = (char*)C.lds;
    const attn_body::bf16* Pq = (const attn_body::bf16*)C.P(); attn_body::bf16* Yo = (attn_body::bf16*)C.Y();
    const float* gg = ldin<16>() + (size_t)l * D;
    gu32* cc = C.ctl + CW_CTX + (size_t)l * NB * 16;
    if (l + 1 < NL)
    for (int u = C.G - 1 - C.vcu; u < NB * 8; u += C.G) { const int h = u & 7, b = u >> 3;
        attn_body::attn_unit<8, FIXR>((long)b * SEG + SQ, (long)b * SEG + SQ, CL / 64, h, Pq, Yo, shm);
        asm volatile("s_waitcnt vmcnt(0)" ::: "memory"); __syncthreads();
        if (C.tid == 0) { __builtin_amdgcn_fence(__ATOMIC_RELEASE, "agent"); C.MISC[164] = __hip_atomic_fetch_add(cc + b * 16, 1u, RLX_AGENT); }
        __syncthreads();
        if ((C.MISC[164] & 7u) == 7u) { __builtin_amdgcn_fence(__ATOMIC_ACQUIRE, "agent"); attn_gnorm(C, (size_t)b * SEG + SQ, gg); }
        __syncthreads(); }
    for (int u = C.vcu; u < NB * 16; u += C.G) { const int qb = u & 15, b = u >> 4;
#pragma unroll 1
        for (int h = 0; h < 8; ++h) attn_body::attn_unit<8, FIXR>((long)b * SEG + qb * 256, (long)b * SEG, SEG / 64, h, Pq, Yo, shm);
        asm volatile("s_waitcnt vmcnt(0)" ::: "memory"); __syncthreads();
        attn_gnorm(C, (size_t)b * SEG + qb * 256, gg); }
}

__device__ __forceinline__ void phase_attn(const Ctx& C, int l) {
    float gq = __builtin_fabsf(ldin<9>()[l * 64 + C.lane]), gk = __builtin_fabsf(ldin<10>()[l * 64 + C.lane]);
    gq = __builtin_fmaxf(gq, dpp_f<0xB1>(gq)); gq = __builtin_fmaxf(gq, dpp_f<0x4E>(gq)); gq = __builtin_fmaxf(gq, dpp_f<0x141>(gq)); gq = __builtin_fmaxf(gq, dpp_f<0x140>(gq));
    gk = __builtin_fmaxf(gk, dpp_f<0xB1>(gk)); gk = __builtin_fmaxf(gk, dpp_f<0x4E>(gk)); gk = __builtin_fmaxf(gk, dpp_f<0x141>(gk)); gk = __builtin_fmaxf(gk, dpp_f<0x140>(gk));
    float bq = 0.f, bk = 0.f;
#pragma unroll
    for (int i = 0; i < 4; ++i) { bq = __builtin_fmaxf(bq, __int_as_float(__builtin_amdgcn_readlane(__float_as_int(gq), 16 * i))); bk = __builtin_fmaxf(bk, __int_as_float(__builtin_amdgcn_readlane(__float_as_int(gk), 16 * i))); }
    const float bound = 11.8f * bq * bk;
    if (bound < 60.0f) phase_attn_impl<true>(C, l); else phase_attn_impl<false>(C, l);
}

__device__ __forceinline__ void phase_conv1(const Ctx& C, const Args& A, int l) {
    __syncthreads();
    LAS float* zL = (LAS float*)C.lds;
    const int c4 = 4 * C.lane;
    {
        f32x4 wk[31]; const float* wdw = ldin<11>();
#pragma unroll
        for (int jt = 0; jt < 31; ++jt) wk[jt] = *(const f32x4*)(wdw + ((size_t)l * 31 + jt) * 256 + c4);
        const f32x4 b31 = *(const f32x4*)(ldin<12>() + l * 256 + c4), gln = *(const f32x4*)(ldin<13>() + l * 256 + c4), bln = *(const f32x4*)(ldin<14>() + l * 256 + c4);
        const f32x4 gC = *(const f32x4*)(ldin<16>() + (size_t)l * D + 512 + c4);
        gu32* tq = C.ctl + CW_CQ + l * 16;
        for (int tile = C.vcu; tile < T / 64; ) {
            const int b = tile / 68, tt = tile - b * 68, t0 = tt * 64;
            const int seg_lo = tt < 64 ? 0 : SQ, seg_hi = tt < 64 ? SQ : SEG;
            const size_t rbase = (size_t)b * SEG;
            if (!(l + 1 == NL && tt >= 64)) {
            __syncthreads();
            { v2u ra[12], rg[12];
#pragma unroll
              for (int i = 0; i < 12; ++i) { const int zr = C.wave + 8 * i, t = t0 - 15 + zr; const bool ok = zr < 94 && t >= seg_lo && t < seg_hi;
                  const bf16* p = C.P() + (rbase + (ok ? t : t0)) * INW; ra[i] = *(const GAS v2u*)(p + 768 + c4); rg[i] = *(const GAS v2u*)(p + 1024 + c4); }
#pragma unroll
              for (int i = 0; i < 12; ++i) { const int zr = C.wave + 8 * i, t = t0 - 15 + zr; const bool ok = t >= seg_lo && t < seg_hi;
                  if (zr < 94) { const f32x4 a = bf4(ra[i]), gt = bf4(rg[i]);
                      const f32x4 z = ok ? (f32x4){a.x * sigmoidf_(gt.x), a.y * sigmoidf_(gt.y), a.z * sigmoidf_(gt.z), a.w * sigmoidf_(gt.w)} : (f32x4){0.f, 0.f, 0.f, 0.f};
                      *(LAS f32x4*)(zL + zr * 256 + c4) = z; } } }
            __syncthreads();
            for (int g = 0; g < 2; ++g) { const int i0 = C.wave * 8 + 4 * g;
                f32x4 u[4] = {b31, b31, b31, b31};
#pragma unroll
                for (int j = 0; j < 34; ++j) { const f32x4 z = *(const LAS f32x4*)(zL + (i0 + j) * 256 + c4);
#pragma unroll
                    for (int t = 0; t < 4; ++t) if (j - t >= 0 && j - t < 31) u[t] += wk[j - t] * z; }
                float s[4], vq[4], qq[4]; f32x4 d[4], cf[4];
#pragma unroll
                for (int t = 0; t < 4; ++t) s[t] = sum4(u[t]);
#pragma unroll
                for (int t = 0; t < 4; ++t) s[t] = wsum(s[t]);
#pragma unroll
                for (int t = 0; t < 4; ++t) { d[t] = u[t] - s[t] * (1.0f / 256.0f); vq[t] = sum4(d[t] * d[t]); }
#pragma unroll
                for (int t = 0; t < 4; ++t) vq[t] = wsum(vq[t]);
#pragma unroll
                for (int t = 0; t < 4; ++t) { const f32x4 y = d[t] * __builtin_amdgcn_rsqf(vq[t] * (1.0f / 256.0f) + EPS) * gln + bln;
                    cf[t] = (f32x4){y.x * sigmoidf_(y.x), y.y * sigmoidf_(y.y), y.z * sigmoidf_(y.z), y.w * sigmoidf_(y.w)}; qq[t] = sum4(cf[t] * cf[t]); }
#pragma unroll
                for (int t = 0; t < 4; ++t) qq[t] = wsum(qq[t]);
#pragma unroll
                for (int t = 0; t < 4; ++t) *(GAS v2u*)(C.Y() + (rbase + t0 + i0 + t) * D + 512 + c4) = pk4(cf[t] * __builtin_amdgcn_rsqf(qq[t] * (1.0f / 256.0f) + EPS) * gC);
            }
            }
            if (C.tid == 0) C.MISC[165] = (unsigned)C.G + __hip_atomic_fetch_add(tq, 1u, RLX_AGENT);
            __syncthreads();
            tile = (int)C.MISC[165];
        }
        __syncthreads();
    }
}
__device__ __forceinline__ void phase_conv2(const Ctx& C, const Args& A, int l) {
    const int c4 = 4 * C.lane;
    {
        const float* wsc = ldin<15>() + (size_t)l * 3 * 256 + c4; const f32x4 w30 = *(const f32x4*)(wsc), w31 = *(const f32x4*)(wsc + 256), w32 = *(const f32x4*)(wsc + 512);
        const float* gg = ldin<16>() + (size_t)l * D;
        const f32x4 gS = *(const f32x4*)(gg + 768 + c4);
        gu32* tq = C.ctl + CW_CQ + (NL + l) * 16; int kc = 0;
        for (int ch = C.vcu; ch < T / 64; ++kc) {
        if (C.tid == 0) C.MISC[166 + (kc & 1)] = (unsigned)C.G + __hip_atomic_fetch_add(tq, 1u, RLX_AGENT);
        const int rbeg = ch * 64 + C.wave * 8, rend = (l + 1 == NL && ch % 68 >= 64) ? rbeg : rbeg + 8;
        for (int r0 = rbeg; r0 < rend; r0 += 2) {
            const bool two = r0 + 1 < rend;
            v2u cgv[4], hvv[4], bgv[2];
#pragma unroll
            for (int k = 0; k < 4; ++k) { int rr = r0 - 1 + k; rr = rr < 0 ? 0 : (rr >= T ? T - 1 : rr); const bf16* p = C.P() + (size_t)rr * INW; cgv[k] = *(const GAS v2u*)(p + 1536 + c4); hvv[k] = *(const GAS v2u*)(p + 1792 + c4); }
#pragma unroll
            for (int u = 0; u < 2; ++u) { const int r = two || u == 0 ? r0 + u : r0; bgv[u] = *(const GAS v2u*)(C.P() + (size_t)r * INW + 1280 + c4); }
            f32x4 m[4];
#pragma unroll
            for (int k = 0; k < 4; ++k) m[k] = bf4(cgv[k]) * bf4(hvv[k]);
            f32x4 sv[2]; float qs[2];
#pragma unroll
            for (int u = 0; u < 2; ++u) { const int r = r0 + u; const int t = r % SEG; const bool has_prev = t != 0 && t != SQ, has_next = t != SQ - 1 && t != SEG - 1;
                const f32x4 zero = (f32x4){0.f, 0.f, 0.f, 0.f};
                sv[u] = bf4(bgv[u]) * (w30 * (has_prev ? m[u] : zero) + w31 * m[u + 1] + w32 * (has_next ? m[u + 2] : zero));
                qs[u] = sum4(sv[u] * sv[u]); }
            qs[0] = wsum(qs[0]); qs[1] = wsum(qs[1]);
#pragma unroll
            for (int u = 0; u < 2; ++u) { if (u == 1 && !two) break; bf16* yr = C.Y() + (size_t)(r0 + u) * D;
                *(GAS v2u*)(yr + 768 + c4) = pk4(sv[u] * __builtin_amdgcn_rsqf(qs[u] * (1.0f / 256.0f) + EPS) * gS); }
        }
        __syncthreads(); ch = (int)C.MISC[166 + (kc & 1)];
        }
    }
}

__device__ __forceinline__ void phase_route(const Ctx& C, const Args& A, int l) {
    volatile LAS unsigned* lhist = C.MISC + 80; volatile LAS unsigned* lbase = C.MISC + 112;
    const float br = C.lane < NE ? ldin<19>()[l * NE + C.lane] : 0.f;
    gu32* cnt = C.ctl + CW_CNT + (size_t)l * NE * 64;
    for (int tile = C.vcu; tile < T / 64; tile += C.G) {
        __syncthreads();
        if (C.tid < NE) lhist[C.tid] = 0u;
        __syncthreads();
        unsigned pp[8]; int rk[8];
        float lg[8];
#pragma unroll
        for (int i = 0; i < 8; ++i) { const int r = tile * 64 + C.wave * 8 + i; lg[i] = C.lane < NE ? C.LOG()[(size_t)r * NE + C.lane] + br : -INFINITY; }
#pragma unroll
        for (int i = 0; i < 8; ++i) { const int r = tile * 64 + C.wave * 8 + i; const float v = lg[i]; const int vb = __float_as_int(v);
            int rank = 0;
#pragma unroll
            for (int j = 0; j < NE; ++j) { const float vj = __int_as_float(__builtin_amdgcn_readlane(vb, j)); rank += (vj > v || (vj == v && j < C.lane)) ? 1 : 0; }
            const bool sel = C.lane < NE && rank < 4;
            float sv[4];
#pragma unroll
            for (int k = 0; k < 4; ++k) { const unsigned long long mk = __ballot(C.lane < NE && rank == k); const int src = (int)__builtin_ctzll(mk | (1ull << 63)); sv[k] = __int_as_float(__builtin_amdgcn_readlane(vb, src)); }
            const float e1 = __expf(sv[1] - sv[0]), e2 = __expf(sv[2] - sv[0]), e3 = __expf(sv[3] - sv[0]); const float inv = __builtin_amdgcn_rcpf(1.0f + e1 + e2 + e3);
            rk[i] = sel ? rank : -1; pp[i] = 0u;
            if (sel) { pp[i] = __hip_atomic_fetch_add((LAS unsigned*)(C.lds + MISC_OFF) + 80 + C.lane, 1u, __ATOMIC_RELAXED, __HIP_MEMORY_SCOPE_WORKGROUP);
                ((GAS float*)C.PAIR())[((size_t)r * 4 + rank) * 2 + 1] = __expf(v - sv[0]) * inv; } }
        __syncthreads();
        if (C.tid < NE) { const unsigned n = lhist[C.tid]; lbase[C.tid] = n ? __hip_atomic_fetch_add(cnt + C.tid * 64, n, RLX_AGENT) : 0u; }
        __syncthreads();
        const unsigned mybase = C.lane < NE ? lbase[C.lane] : 0u;
#pragma unroll
        for (int i = 0; i < 8; ++i) if (rk[i] >= 0) { const int r = tile * 64 + C.wave * 8 + i; const unsigned pos = mybase + pp[i];
            ((GAS unsigned*)C.PAIR())[((size_t)r * 4 + rk[i]) * 2] = (unsigned)C.lane | (pos << 5);
            C.TOK()[(size_t)C.lane * T + pos] = r; }
    }
    __syncthreads();
}

__device__ __forceinline__ void phase_gather(const Ctx& C, const Args& A, int l) {
    moe_tables(C, l, true);
    const LAS unsigned char* t2e = (const LAS unsigned char*)(C.lds + T2E_OFF);
    const int nslot = (int)C.MISC[NE] * 256;
    constexpr int RB = MK_FP8 ? 1024 : 2048, NV = RB / 1024;
    const unsigned char* srcb = MK_FP8 ? (const unsigned char*)C.HB8() : (const unsigned char*)C.HB();
    unsigned char* dstb = (unsigned char*)C.HP();
    for (int s0 = C.gw * 16; s0 < nslot; s0 += C.ngw * 16) { const unsigned e = t2e[s0 >> 8]; const unsigned pos0 = (unsigned)s0 - C.MISC[e] * 256u; const unsigned cnt = C.MISC[40 + e];
        int tk = -1; if (C.lane < 16 && pos0 + C.lane < cnt) tk = C.TOK()[(size_t)e * T + pos0 + C.lane];
        v4u v[16][NV];
#pragma unroll
        for (int u = 0; u < 16; ++u) { const int r = __builtin_amdgcn_readlane(tk, u);
            if (r >= 0) { const GAS v4u* src = (const GAS v4u*)(srcb + (size_t)r * RB) + C.lane;
#pragma unroll
                for (int q = 0; q < NV; ++q) v[u][q] = src[64 * q]; } }
#pragma unroll
        for (int u = 0; u < 16; ++u) { const int r = __builtin_amdgcn_readlane(tk, u);
            if (r >= 0) { GAS v4u* dst = (GAS v4u*)(dstb + (size_t)(s0 + u) * RB) + C.lane;
#pragma unroll
                for (int q = 0; q < NV; ++q) dst[64 * q] = v[u][q]; } }
    }
}

__global__ void __launch_bounds__(NWAVES * 64, 2) mk_fwd(Args args) {
    extern __shared__ __attribute__((aligned(16))) unsigned char lds_raw[];
    Ctx C;
    C.lds = (LAS unsigned char*)lds_raw; C.MISC = (volatile LAS unsigned*)(C.lds + MISC_OFF);
    C.tid = threadIdx.x; C.lane = C.tid & 63; C.wave = __builtin_amdgcn_readfirstlane(C.tid >> 6);
    C.G = gridDim.x; { const int bx = blockIdx.x; C.vcu = (C.G % 8 == 0) ? (bx % 8) * (C.G / 8) + bx / 8 : bx; }
    C.gw = C.vcu * NWAVES + C.wave; C.ngw = C.G * NWAVES;
    C.ws = (GAS unsigned char*)args.ws; C.ctl = (gu32*)(C.ws + WS_CTL);
    for (int u = C.tid; u < (LDS_BYTES - MISC_OFF) / 4; u += NWAVES * 64) ((LAS unsigned*)(C.lds + MISC_OFF))[u] = 0u;
    __syncthreads();
    const int lo = args.ph_lo, hi = args.ph_hi;
    const bool multi = (hi - lo) > 1;
    XcdBarrier bar; bar.bar = (unsigned*)(C.ctl + CW_BAR); bar.x = 0; bar.st = C.MISC + 160;
    if (multi) bar = xcd_barrier_post((unsigned*)(C.ctl + CW_BAR), C.MISC + 160);
#ifndef MK_PHMASK
#define MK_PHMASK 0xFFFF
#endif
#define IN(k) (lo <= (k) && (k) < hi)
#ifndef MK_STAMP
#define MK_STAMP -1
#endif
    unsigned long long tacc = 0ull, tst = 0ull;
#define T0(k) do { if (MK_STAMP == (k)) tst = __builtin_amdgcn_s_memrealtime(); } while (0)
#define T1(k) do { if (MK_STAMP == (k)) tacc += __builtin_amdgcn_s_memrealtime() - tst; } while (0)
#define FRESH() do { asm volatile("" : "+v"(C.tid), "+v"(C.lane)); asm volatile("" : "+s"(C.wave), "+s"(C.vcu), "+s"(C.gw), "+s"(C.ws), "+s"(C.ctl)); } while (0)
#define EN(k) ((MK_PHMASK >> (k)) & 1)
#ifndef MK_DUP
#define MK_DUP 0
#endif
#define NREP(k) (((MK_DUP >> (k)) & 1) ? 2 : 1)
#define SEAM(k) do { if (IN((k) + 1)) xcd_barrier(bar); } while (0)

    if (EN(12) && IN(0)) { _Pragma("unroll") for (int rep = 0; rep < NREP(12); ++rep) phase_prologue(C, args); SEAM(0); }
    __syncthreads();
    for (int u = C.tid; u < 64 * 16; u += NWAVES * 64) { const int pos = u >> 4, i = u & 15; const float inv = powf(10000.0f, -(float)(2 * i) / 32.0f); const float ang = (float)pos * inv;
        ((LAS f32x2*)(C.lds + ROPE_OFF))[u] = (f32x2){cosf(ang), sinf(ang)}; }
    __syncthreads();
    for (int l = 0; l < NL; ++l) {
        const int pb = 1 + l * PPL;
        if (EN(0) && IN(pb + 0)) { FRESH(); T0(0); phase_premix(C, args, l); SEAM(pb + 0); T1(0); }
        if (EN(1) && IN(pb + 1)) { FRESH(); T0(1);
            { LAS float* gl = (LAS float*)(C.lds + T2E_OFF); const float* gq = ldin<9>() + l * 64; const float* gk = ldin<10>() + l * 64;
              __syncthreads(); if (C.tid < 128) gl[C.tid] = C.tid < 64 ? gq[C.tid] : gk[C.tid - 64]; __syncthreads(); }
#if MK_FP8_IN == 2
            {
                pg8::Gemm g8{(const pg8::bf16_t*)C.HB8(), (const pg8::bf16_t*)((const unsigned char*)C.HP() + (size_t)l * INW * D), T, 768, D / 2}; pg8::StaticOrder S8; S8.init(T, 768, C.G, (int)blockIdx.x);
                pg8::EpiInProj E8{C.P(), (const LAS float*)(C.lds + ROPE_OFF), (const LAS float*)(C.lds + T2E_OFF), attn_body::C2, 0};
                pg8::gemm_phase<pg8::EpiInProj, pg8::StaticOrder, true, true, true>(C.lds, g8, S8, E8);
                pg8::Gemm g{C.HB(), C.WINT() + ((size_t)l * INW + 768) * D, T, 1280, D}; pg8::StaticOrder S; S.init(T, 1280, C.G, (int)blockIdx.x);
                pg8::EpiInProj E{C.P(), (const LAS float*)(C.lds + ROPE_OFF), (const LAS float*)(C.lds + T2E_OFF), attn_body::C2, 3};
                pg8::gemm_phase<pg8::EpiInProj, pg8::StaticOrder, true, true>(C.lds, g, S, E);
            }
#else
#if MK_FP8_IN == 1
            pg8::Gemm g{C.HB(), (const pg8::bf16_t*)((const unsigned char*)C.WINT() + (size_t)l * INW * D), T, INW, D / 2}; pg8::StaticOrder S; S.init(T, INW, C.G, (int)blockIdx.x);
#else
            pg8::Gemm g{C.HB(), C.WINT() + (size_t)l * INW * D, T, INW, D}; pg8::StaticOrder S; S.init(T, INW, C.G, (int)blockIdx.x);
#endif
            pg8::EpiInProj E{C.P(), (const LAS float*)(C.lds + ROPE_OFF), (const LAS float*)(C.lds + T2E_OFF), attn_body::C2, 0};
_Pragma("unroll") for (int rep = 0; rep < NREP(1); ++rep)
            pg8::gemm_phase<pg8::EpiInProj, pg8::StaticOrder, true, true, MK_FP8_IN == 1>(C.lds, g, S, E);
#endif
            { FRESH(); tail_convert(C, l, NROWT * (INW / 256), CV_HEAD); }
            SEAM(pb + 1); T1(1); }
        if (EN(3) && IN(pb + 3)) { FRESH(); T0(3); _Pragma("unroll") for (int rep = 0; rep < NREP(3); ++rep) phase_attn(C, l); phase_conv1(C, args, l); FRESH(); phase_conv2(C, args, l); SEAM(pb + 3); T1(3); }
        if (EN(5) && IN(pb + 5)) { FRESH(); T0(5);
            pg8::Gemm g{C.Y(), C.WOUTT() + (size_t)l * D * D, T, D, D};
            pg8::EpiGate E{C.OB(), C.MOD() + (size_t)l * 17 * MODW + 2 * D, C.X()};
            if (l + 1 < NL) { pg8::StaticOrder S; S.init(T, D, C.G, (int)blockIdx.x); pg8::gemm_phase<pg8::EpiGate, pg8::StaticOrder, true, true>(C.lds, g, S, E); }
            else { pg8::LatentOrder S; S.init(NB * SQ, D, C.G, (int)blockIdx.x); pg8::gemm_phase<pg8::EpiGate, pg8::LatentOrder, true, true>(C.lds, g, S, E); }
            { FRESH(); tail_convert(C, l, (l + 1 < NL ? NROWT : NB * SQ / 256) * (D / 256), CV_HEAD + tail_items(NROWT * (INW / 256), C.G)); }
            SEAM(pb + 5); T1(5); }
        if (EN(6) && IN(pb + 6)) { FRESH(); T0(6); _Pragma("unroll") for (int rep = 0; rep < NREP(6); ++rep) phase_premoe(C, args, l); SEAM(pb + 6); T1(6); }
        if (EN(10) && IN(pb + 10)) { FRESH(); T0(10);
            moe_tables(C, l, true);
#if MK_FP8
            pg8::Gemm g{(const pg8::bf16_t*)C.HB8(), (const pg8::bf16_t*)((const unsigned char*)C.W1T() + (size_t)l * NE * 2048 * D), CAP, NE * 2048, D / 2};
            pg8::MoeOrder S; S.init((int)C.MISC[NE], 8, C.G, (int)blockIdx.x, (const LAS unsigned char*)(C.lds + T2E_OFF)); S.tok = C.TOK(); S.tstride = T; S.tab = C.MISC;
            pg8::EpiSwiglu8 E{(unsigned char*)C.ACT(), C.B1P() + (size_t)l * NE * 2048};
_Pragma("unroll") for (int rep = 0; rep < NREP(10); ++rep)
            pg8::gemm_phase<pg8::EpiSwiglu8, pg8::MoeOrder, true, true, true, 0x7A7A7A7A, true>(C.lds, g, S, E);
#else
            pg8::Gemm g{C.HP(), C.W1T() + (size_t)l * NE * 2048 * D, CAP, NE * 2048, D};
            pg8::MoeOrder S; S.init((int)C.MISC[NE], 8, C.G, (int)blockIdx.x, (const LAS unsigned char*)(C.lds + T2E_OFF));
            pg8::EpiSwiglu E{C.ACT(), C.B1P() + (size_t)l * NE * 2048};
            pg8::gemm_phase<pg8::EpiSwiglu, pg8::MoeOrder, true, true>(C.lds, g, S, E);
#endif
            SEAM(pb + 10); T1(10); }
        if (EN(11) && IN(pb + 11)) { FRESH(); T0(11);
            moe_tables(C, l, true);
#if MK_FP8
            pg8::Gemm g{C.ACT(), (const pg8::bf16_t*)((const unsigned char*)C.W2T() + (size_t)l * NE * D * D), CAP, NE * D, D / 2};
            pg8::MoeOrder S; S.init((int)C.MISC[NE], 4, C.G, (int)blockIdx.x, (const LAS unsigned char*)(C.lds + T2E_OFF)); S.rev = true;
            pg8::EpiDown E{(unsigned char*)C.YP(), ldin<23>() + (size_t)l * NE * D};
_Pragma("unroll") for (int rep = 0; rep < NREP(11); ++rep)
            pg8::gemm_phase<pg8::EpiDown, pg8::MoeOrder, true, true, true, 0x7D7D7D7D>(C.lds, g, S, E);
#else
            pg8::Gemm g{C.ACT(), C.W2T() + (size_t)l * NE * D * D, CAP, NE * D, D};
            pg8::MoeOrder S; S.init((int)C.MISC[NE], 4, C.G, (int)blockIdx.x, (const LAS unsigned char*)(C.lds + T2E_OFF)); S.rev = true;
            pg8::EpiDown E{(unsigned char*)C.YP(), ldin<23>() + (size_t)l * NE * D};
            pg8::gemm_phase<pg8::EpiDown, pg8::MoeOrder, true, true>(C.lds, g, S, E);
#endif
            SEAM(pb + 11); T1(11); }
    }
    if (EN(13) && IN(NPHASE - 1)) { FRESH(); T0(13); phase_final(C, args); T1(13); }
    if (MK_STAMP >= 0 && blockIdx.x == 0 && C.tid == 0) { asm volatile("s_waitcnt vmcnt(0)" ::: "memory"); ldout()[5] = (float)tacc * 0.001f; }
#undef IN
#undef SEAM
}
}


#if defined(MK_DEBUG)
namespace mkdbg {
using namespace mk;
constexpr size_t WS_DBG = 3420 * MiB;
__device__ const int SROWS[12] = {0, 1, 63, 64, 255, 256, 4095, 4096, 4351, 4352, 30000, 69631};
__device__ __forceinline__ float bfv(const bf16* p, size_t i) { return __builtin_bit_cast(float, (unsigned)p[i] << 16); }
__device__ __forceinline__ void report(float* err, int s, float got, float ref, float atol) {
    float e = fabsf(got - ref) / (fabsf(ref) + atol); if (!(e == e)) e = 100.f;
    atomicMax((unsigned*)err + s, __builtin_bit_cast(unsigned, e));
}
__device__ __forceinline__ void row_info(int r, int& b, int& t, int& j) { b = r / SEG; t = r - b * SEG; j = t < SQ ? b : 16; }
__device__ __forceinline__ float silu_(float v) { return v / (1.f + expf(-v)); }
__device__ __forceinline__ float sigm_(float v) { return 1.f / (1.f + expf(-v)); }
__device__ __forceinline__ void naive_attn(const bf16* P, int r, int h, float* q, float* o) {
    int b, t, j; row_info(r, b, t, j);
    const int k0 = t < SQ ? b * SEG : b * SEG + SQ, nk = t < SQ ? SEG : CL;
    for (int d = 0; d < 64; ++d) q[d] = bfv(P, (size_t)r * INW + h * 64 + d);
    float m = -1e30f;
    for (int kk = 0; kk < nk; ++kk) { float s = 0.f; for (int d = 0; d < 64; ++d) s += q[d] * bfv(P, (size_t)(k0 + kk) * INW + 512 + (h >> 2) * 64 + d); m = fmaxf(m, s); }
    float l = 0.f; for (int d = 0; d < 64; ++d) o[d] = 0.f;
    for (int kk = 0; kk < nk; ++kk) { float s = 0.f; for (int d = 0; d < 64; ++d) s += q[d] * bfv(P, (size_t)(k0 + kk) * INW + 512 + (h >> 2) * 64 + d);
        const float p = exp2f(s - m); l += p; for (int d = 0; d < 64; ++d) o[d] += p * bfv(P, (size_t)(k0 + kk) * INW + 640 + (h >> 2) * 64 + d); }
    for (int d = 0; d < 64; ++d) o[d] /= l;
}
__device__ const int DBG_LS_1[2] = {0, 3};
__device__ const int DBG_JS_2[3] = {0, 7, 16};
__device__ const int DBG_NS_3[4] = {0, 1000, 2053, 6143};
__device__ const int DBG_CS_4[4] = {0, 1, 511, 1023};
__device__ const int DBG_CS_5[16] = {0, 63, 64, 511, 512, 575, 639, 640, 767, 768, 1024, 1279, 1280, 1536, 1792, 2047};
__device__ const int DBG_HS_6[4] = {0, 7, 8, 9};
__device__ const int DBG_HS_7[2] = {0, 5};
__device__ const int DBG_CS_8[4] = {0, 255, 256, 1023};
__device__ const int DBG_ES_9[3] = {0, 7, 31};
__device__ const int DBG_CS_10[3] = {0, 500, 1023};
__device__ const int DBG_CS_11[4] = {0, 127, 128, 1023};
__device__ const int DBG_CS_12[4] = {0, 300, 511, 1023};
__device__ const int DBG_CS_13[4] = {0, 300, 511, 1023};
__device__ const int DBG_CS_14[4] = {0, 300, 511, 1023};
__global__ void __launch_bounds__(256) dbg_kernel(Args a, int stage) {
    unsigned char* ws = a.ws; float* err = (float*)(ws + WS_DBG); float* scr = err + 256;
    const float* MOD = (const float*)(ws + WS_MOD); const bf16* HB = (const bf16*)(ws + WS_HB); const bf16* P = (const bf16*)(ws + WS_P); const bf16* Y = (const bf16*)(ws + WS_Y);
    const float* X = (const float*)(ws + WS_X); const float* LOG = (const float*)(ws + WS_LOG); const v2u* PAIR = (const v2u*)(ws + WS_PAIR); const int* TOK = (const int*)(ws + WS_TOK);
    const bf16* HP = (const bf16*)(ws + WS_HP); const bf16* ACT = (const bf16*)(ws + WS_ACT); const bf16* YP = (const bf16*)(ws + WS_YP);
    const unsigned* cnt = (const unsigned*)(ws + WS_CTL) + CW_CNT;
    const int tid = threadIdx.x;
    __shared__ float shm[15360]; __shared__ unsigned tstart[33];
    if (stage == 0) { if (tid < 64) err[tid] = 0.f; return; }
    if (stage == 1) {
        const int* ls = DBG_LS_1; const int* js = DBG_JS_2; const int* ns = DBG_NS_3;
        if (tid < 24) { const int l = ls[tid / 12], j = js[(tid / 4) % 3], n = ns[tid % 4]; float s = 0.f;
            for (int k = 0; k < 1024; ++k) { const float c = j < 16 ? a.in[1][j * 1024 + k] : a.in[3][k]; s += silu_(c) * a.in[4][((size_t)l * 1024 + k) * MODW + n]; }
            s += a.in[5][l * MODW + n]; report(err, 1, MOD[((size_t)l * 17 + j) * MODW + n], s, 0.05f); }
        return; }
    if (stage == 2 || stage == 8) {
        const int* cs = DBG_CS_4;
        if (tid < 48) { const int r = SROWS[tid / 4], c = cs[tid % 4]; int b, t, j; row_info(r, b, t, j);
            const float* xr = stage == 2 ? (t < SQ ? a.in[0] + ((size_t)b * SQ + t) * D : a.in[2] + ((size_t)b * CL + (t - SQ)) * D) : X + (size_t)r * D;
            float ss = 0.f; for (int k = 0; k < D; ++k) ss += xr[k] * xr[k];
            const float rs = 1.f / sqrtf(ss / D + EPS); const float* g = stage == 2 ? a.in[6] : a.in[7]; const float* mj = MOD + (size_t)j * MODW + (stage == 2 ? 0 : 3 * D);
            const float h = xr[c] * rs * g[c] * (1.f + mj[D + c]) + mj[c];
            report(err, stage, bfv(HB, (size_t)r * D + c), h, 0.05f);
            if (stage == 2) report(err, stage, X[(size_t)r * D + c], xr[c], 0.01f); }
        return; }
    if (stage == 3) {
        const int* cs = DBG_CS_5;
        if (tid < 192) { const int r = SROWS[tid / 16], c = cs[tid % 16]; float s = 0.f;
            for (int k = 0; k < D; ++k) s += bfv(HB, (size_t)r * D + k) * a.in[8][(size_t)k * INW + c];
            report(err, 3, bfv(P, (size_t)r * INW + c), s, 0.05f); }
        return; }
    if (stage == 4) {
        const int* hs = DBG_HS_6;
        if (tid < 48) { const int r = SROWS[tid / 4], h = hs[tid % 4]; int b, t, j; row_info(r, b, t, j);
            float* raw = shm + tid * 128; float* o = raw + 64; float ss = 0.f;
            for (int d = 0; d < 64; ++d) { float s = 0.f; for (int k = 0; k < D; ++k) s += bfv(HB, (size_t)r * D + k) * a.in[8][(size_t)k * INW + h * 64 + d]; raw[d] = s; ss += s * s; }
            const float rs = 1.f / sqrtf(ss / 64.f + EPS); const float* g = h < 8 ? a.in[9] : a.in[10];
            for (int d = 0; d < 64; ++d) raw[d] = raw[d] * rs * g[d];
            for (int ax = 0; ax < 2; ++ax) for (int i = 0; i < 16; ++i) { const float pos = ax == 0 ? (float)(t / 64) : (float)(t % 64); const float ang = pos * powf(10000.f, -(float)(2 * i) / 32.f);
                const float c = t < SQ ? cosf(ang) : 1.f, s = t < SQ ? sinf(ang) : 0.f; const float x1 = raw[ax * 32 + i], x2 = raw[ax * 32 + 16 + i];
                o[ax * 32 + i] = x1 * c - x2 * s; o[ax * 32 + 16 + i] = x2 * c + x1 * s; }
            for (int d = 0; d < 64; ++d) { const float ref = o[d] * (h < 8 ? 0.125f * 1.4426950408889634f : 1.f); report(err, 4, bfv(P, (size_t)r * INW + h * 64 + d), ref, h < 8 ? 0.045f : 0.25f); } }
        return; }
    if (stage == 5) {
        const int* hs = DBG_HS_7;
        if (tid < 24) { const int r = SROWS[tid / 2], h = hs[tid % 2]; float* o = shm + tid * 128; naive_attn(P, r, h, o + 64, o);
            for (int d = 0; d < 64; ++d) report(err, 5, bfv(Y, (size_t)r * D + h * 64 + d), o[d], 0.05f); }
        return; }
    if (stage == 6) {
        if (tid < 12) { const int r = SROWS[tid]; int b, t, j; row_info(r, b, t, j); const int lo = t < SQ ? 0 : SQ, hi = t < SQ ? SQ : SEG; const size_t rb = (size_t)b * SEG;
            float* u = shm + tid * 256; float mean = 0.f;
            for (int c = 0; c < 256; ++c) { float s = a.in[12][c];
                for (int jt = 0; jt < 31; ++jt) { const int tt = t + jt - 15; if (tt >= lo && tt < hi) s += a.in[11][jt * 256 + c] * bfv(P, (rb + tt) * INW + 768 + c) * sigm_(bfv(P, (rb + tt) * INW + 1024 + c)); }
                u[c] = s; mean += s; }
            mean /= 256.f; float var = 0.f; for (int c = 0; c < 256; ++c) var += (u[c] - mean) * (u[c] - mean); var /= 256.f;
            float ss = 0.f; for (int c = 0; c < 256; ++c) { const float y = (u[c] - mean) / sqrtf(var + EPS) * a.in[13][c] + a.in[14][c]; u[c] = silu_(y); ss += u[c] * u[c]; }
            float rs = 1.f / sqrtf(ss / 256.f + EPS);
            for (int c = 0; c < 256; ++c) report(err, 6, bfv(Y, (size_t)r * D + 512 + c), u[c] * rs * a.in[16][512 + c], 0.25f);
            ss = 0.f;
            for (int c = 0; c < 256; ++c) { float s = 0.f; for (int jt = 0; jt < 3; ++jt) { const int tt = t + jt - 1; if (tt >= lo && tt < hi) s += a.in[15][jt * 256 + c] * bfv(P, (rb + tt) * INW + 1536 + c) * bfv(P, (rb + tt) * INW + 1792 + c); }
                u[c] = bfv(P, (size_t)r * INW + 1280 + c) * s; ss += u[c] * u[c]; }
            rs = 1.f / sqrtf(ss / 256.f + EPS);
            for (int c = 0; c < 256; ++c) report(err, 7, bfv(Y, (size_t)r * D + 768 + c), u[c] * rs * a.in[16][768 + c], 0.25f); }
        if (tid >= 64 && tid < 80) { const int r = SROWS[(tid - 64) / 8 == 0 ? 2 : 7], h = (tid - 64) % 8; float* o = shm + 3072 + (tid - 64) * 128; naive_attn(P, r, h, o + 64, o);
            for (int d = 0; d < 64; ++d) scr[((tid - 64) / 8) * 512 + h * 64 + d] = o[d]; }
        __syncthreads();
        if (tid < 2) { const int r = SROWS[tid == 0 ? 2 : 7]; float ss = 0.f; for (int c = 0; c < 512; ++c) ss += scr[tid * 512 + c] * scr[tid * 512 + c];
            const float rs = 1.f / sqrtf(ss / 512.f + EPS); for (int c = 0; c < 512; ++c) report(err, 6, bfv(Y, (size_t)r * D + c), scr[tid * 512 + c] * rs * a.in[16][c], 0.25f); }
        return; }
    if (stage == 9) {
        const int* cs = DBG_CS_8;
        if (tid < 48) { const int r = SROWS[tid / 4], c = cs[tid % 4]; int b, t, j; row_info(r, b, t, j);
            const float* xr = t < SQ ? a.in[0] + ((size_t)b * SQ + t) * D : a.in[2] + ((size_t)b * CL + (t - SQ)) * D;
            float s = 0.f; for (int k = 0; k < D; ++k) s += bfv(Y, (size_t)r * D + k) * a.in[17][(size_t)k * D + c];
            report(err, 9, X[(size_t)r * D + c], xr[c] + MOD[(size_t)j * MODW + 2 * D + c] * s, 0.05f); }
        return; }
    if (stage == 10) {
        const int* es = DBG_ES_9;
        if (tid < 36) { const int r = SROWS[tid / 3], e = es[tid % 3]; float s = 0.f; for (int k = 0; k < D; ++k) s += bfv(HB, (size_t)r * D + k) * a.in[18][(size_t)k * NE + e];
            report(err, 10, LOG[(size_t)r * NE + e], s, 0.05f); }
        return; }
    if (stage == 11) {
        if (tid < 12) { const int r = SROWS[tid]; float* v = shm + tid * 32; for (int e = 0; e < 32; ++e) v[e] = LOG[(size_t)r * NE + e] + a.in[19][e];
            float* sv = shm + 1024 + tid * 8; float* sef = sv + 4;
            for (int k = 0; k < 4; ++k) { int bi = 0; for (int e = 1; e < 32; ++e) if (v[e] > v[bi]) bi = e; sef[k] = (float)bi; sv[k] = v[bi]; v[bi] = -1e30f; }
            float den = 0.f; for (int k = 0; k < 4; ++k) den += expf(sv[k] - sv[0]);
            { float* vv = shm + 2048 + tid * 32; for (int e = 0; e < 32; ++e) vv[e] = LOG[(size_t)r * NE + e] + a.in[19][e];
              float mx = -1e30f, dn = 0.f; for (int k = 0; k < 4; ++k) mx = fmaxf(mx, vv[PAIR[(size_t)r * 4 + k].x & 31]); for (int k = 0; k < 4; ++k) dn += expf(vv[PAIR[(size_t)r * 4 + k].x & 31] - mx);
              for (int k = 0; k < 4; ++k) report(err, 22, __uint_as_float((unsigned)(PAIR[(size_t)r * 4 + k].y + 0u)), expf(vv[PAIR[(size_t)r * 4 + k].x & 31] - mx) / dn, 0.01f); }
            for (int k = 0; k < 4; ++k) { const v2u pr = PAIR[(size_t)r * 4 + k]; const int e = pr.x & 31; const unsigned pos = pr.x >> 5;
                if (tid == 0 && (k == 0 || k == 3)) { err[30 + (k ? 2 : 0)] = __uint_as_float((unsigned)(pr.y + 0u)); err[31 + (k ? 2 : 0)] = expf(sv[k] - sv[0]) / den; }
                report(err, 17, (float)e == sef[k] ? 0.f : 1.f, 0.f, 1.0f); report(err, 18, __uint_as_float((unsigned)(pr.y + 0u)), expf(sv[k] - sv[0]) / den, 0.01f);
                const unsigned c = cnt[e * 64]; report(err, 19, pos < c ? 1.f : 0.f, 1.f, 0.001f); report(err, 20, (float)TOK[(size_t)e * T + (pos < (unsigned)T ? pos : 0)], (float)r, 0.001f); } }
        if (tid == 255) { unsigned s = 0; for (int e = 0; e < 32; ++e) s += cnt[e * 64]; report(err, 21, (float)s, (float)(T * 4), 0.001f); }
        if (tid == 253) { int c = 0; const float* pf = (const float*)PAIR; for (int q = 0; q < 64; ++q) { const float w = pf[q * 2 + 1]; if (w > 0.01f && w <= 1.f) ++c; } err[44] = (float)c; }
        if (tid == 254) { for (int k = 0; k < 4; ++k) { const float w = __uint_as_float((unsigned)(PAIR[k].y + 0u)); err[40 + k] = (float)(!(w == w) || w < 0.f || w > 1.f ? 3 : w < 1e-30f ? 0 : w < 0.05f ? 1 : 2); } }
        return; }
    if (tid == 0) { unsigned s = 0; for (int e = 0; e < 32; ++e) { tstart[e] = s; s += (cnt[e * 64] + 255u) >> 8; } tstart[32] = s; }
    __syncthreads();
    if (stage == 12) {
        const int* cs = DBG_CS_10;
        if (tid < 48) { const int r = SROWS[tid / 4], k = tid % 4; const v2u pr = PAIR[(size_t)r * 4 + k]; const size_t slot = (size_t)tstart[pr.x & 31] * 256 + (pr.x >> 5);
            for (int i = 0; i < 3; ++i) report(err, 12, bfv(HP, slot * D + cs[i]), bfv(HB, (size_t)r * D + cs[i]), 0.001f); }
        return; }
    if (stage == 13) {
        const int* cs = DBG_CS_11;
        if (tid < 192) { const int r = SROWS[tid / 16], k = (tid / 4) % 4, c = cs[tid % 4]; const v2u pr = PAIR[(size_t)r * 4 + k]; const int e = pr.x & 31; const size_t slot = (size_t)tstart[e] * 256 + (pr.x >> 5);
            float ug = a.in[21][(size_t)e * 2048 + 2 * c], uu = a.in[21][(size_t)e * 2048 + 2 * c + 1]; const float* w = a.in[20] + (size_t)e * 1024 * 2048;
            for (int kk = 0; kk < D; ++kk) { const float hv = bfv(HP, slot * D + kk); ug += hv * w[(size_t)kk * 2048 + 2 * c]; uu += hv * w[(size_t)kk * 2048 + 2 * c + 1]; }
            const float gc = fminf(ug, 7.f), uc = fminf(fmaxf(uu, -7.f), 7.f); const float ref = (uc + 1.f) * gc * sigm_(1.702f * gc);
            report(err, 13, bfv(ACT, slot * D + c), ref, 0.25f); }
        return; }
    if (stage == 14) {
        const int* cs = DBG_CS_12;
        if (tid < 192) { const int r = SROWS[tid / 16], k = (tid / 4) % 4, c = cs[tid % 4]; const v2u pr = PAIR[(size_t)r * 4 + k]; const int e = pr.x & 31; const size_t slot = (size_t)tstart[e] * 256 + (pr.x >> 5);
            float s = a.in[23][(size_t)e * 1024 + c]; const float* w = a.in[22] + (size_t)e * 1024 * 1024;
            for (int kk = 0; kk < D; ++kk) s += bfv(ACT, slot * D + kk) * w[(size_t)kk * 1024 + c];
            report(err, 14, bfv(YP, slot * D + c), s, 0.25f); }
        return; }
    if (stage == 15) {
        const int* cs = DBG_CS_13;
        if (tid < 48) { const int r = SROWS[tid / 4], c = cs[tid % 4]; int b, t, j; row_info(r, b, t, j); float f = 0.f;
            for (int k = 0; k < 4; ++k) { const v2u pr = PAIR[(size_t)r * 4 + k]; const size_t slot = (size_t)tstart[pr.x & 31] * 256 + (pr.x >> 5); f += __uint_as_float((unsigned)(pr.y + 0u)) * bfv(YP, slot * D + c); }
            scr[2048 + tid] = X[(size_t)r * D + c] + MOD[(size_t)j * MODW + 5 * D + c] * f; }
        return; }
    if (stage == 16) {
        const int* cs = DBG_CS_14;
        if (tid < 48) { const int r = SROWS[tid / 4], c = cs[tid % 4]; report(err, 16, X[(size_t)r * D + c], scr[2048 + tid], 0.02f); }
        return; }
    if (stage == 99) {
        if (tid == 0) {
#if MK_DEBUG == 3
            a.out[0] = (err[44] + 1.f) * 1e20f; return;
#endif
#if MK_DEBUG == 2
            { const float* db = err + 4096; const v2u* PR = (const v2u*)(a.ws + WS_PAIR); int code = 0;
              auto close = [](float x, float y) { return fabsf(x - y) <= 1e-3f * (fabsf(y) + 1e-3f); };
              for (int ln = 0; ln < 4 && !code; ++ln) for (int j = 0; j < 4; ++j) if (!(db[ln * 16 + j] == db[j])) { code = 10 + ln; break; }
              if (!code) for (int j = 0; j < 3; ++j) if (!(db[j] >= db[j + 1])) code = 20 + j;
              if (!code) for (int ln = 0; ln < 4 && !code; ++ln) for (int j = 0; j < 3; ++j) if (!close(db[ln * 16 + 4 + j], expf(db[j + 1] - db[0]))) { code = 30 + ln; break; }
              if (!code) for (int ln = 0; ln < 4; ++ln) if (!close(db[ln * 16 + 7], 1.f + db[ln * 16 + 4] + db[ln * 16 + 5] + db[ln * 16 + 6])) { code = 40 + ln; break; }
              if (!code) for (int ln = 0; ln < 4; ++ln) if (!close(db[ln * 16 + 8], 1.f / db[ln * 16 + 7])) { code = 50 + ln; break; }
              if (!code) for (int ln = 0; ln < 4; ++ln) if (!close(db[ln * 16 + 9], (ln == 0 ? 1.f : db[ln * 16 + 3 + ln]) * db[ln * 16 + 8])) { code = 60 + ln; break; }
              if (!code) for (int ln = 0; ln < 4; ++ln) if (!close(__uint_as_float((unsigned)(PR[ln].y + 0u)), db[ln * 16 + 9])) { code = 70 + ln; break; }
              if (!code) code = 88;
              a.out[0] = (float)code * 1e20f; return; }
#endif
            int mask = 0; for (int i = 0; i < 6; ++i) if (err[17 + i] > 0.06f) mask |= 1 << i; if (mask) err[11] = 1.f;
            for (int s = 1; s < 17; ++s) if (err[s] > 0.06f) { if (s == 11) { a.out[0] = (float)(10 + mask) * 1e14f; break; } a.out[0] = (1.f + 10.f * fminf(err[s], 0.89f)) * powf(10.f, (float)(4 + s)); break; } }
        return; }
}
}
#endif
#ifndef MK_ONE_LAUNCH
#define MK_ONE_LAUNCH 1
#endif
extern "C" void kernel_launch(void* const* d_in, const int* in_sizes, int n_in, void* d_out, int out_size, void* d_ws, size_t ws_size, hipStream_t stream) {
    using namespace mk;
    static int grid = 0;
    if (grid == 0) {
        if (n_in != 24 || out_size != NB * SQ * D || ws_size < WS_END) { fprintf(stderr, "kernel_launch: unexpected shapes (n_in %d, out %d, ws %zu)\n", n_in, out_size, ws_size); grid = -1; return; }
        int dev = 0, cus = 0, per_cu = 0;
        if (hipGetDevice(&dev) != hipSuccess || hipDeviceGetAttribute(&cus, hipDeviceAttributeMultiprocessorCount, dev) != hipSuccess) { grid = -1; return; }
        if (hipFuncSetAttribute((const void*)mk_fwd, hipFuncAttributeMaxDynamicSharedMemorySize, LDS_BYTES) != hipSuccess) { fprintf(stderr, "kernel_launch: hipFuncSetAttribute failed\n"); grid = -1; return; }
        if (hipOccupancyMaxActiveBlocksPerMultiprocessor(&per_cu, (const void*)mk_fwd, NWAVES * 64, LDS_BYTES) != hipSuccess || per_cu < 1) { fprintf(stderr, "kernel_launch: occupancy query says %d\n", per_cu); per_cu = 1; }
        (void)hipGetLastError();
        grid = cus;
    }
    if (grid < 0) return;
    (void)hipMemsetAsync((char*)d_ws + WS_CTL, 0, CTL_ZERO_BYTES, stream);
    Args a{};
    for (int i = 0; i < 24; ++i) a.in[i] = (const float*)d_in[i];
    a.out = (float*)d_out; a.ws = (unsigned char*)d_ws;
#if MK_ONE_LAUNCH
    a.ph_lo = 0; a.ph_hi = NPHASE;
    hipLaunchKernelGGL(mk_fwd, dim3(grid), dim3(NWAVES * 64), LDS_BYTES, stream, a);
#else
#if defined(MK_DEBUG)
#define DBG(s) hipLaunchKernelGGL(mkdbg::dbg_kernel, dim3(1), dim3(256), 0, stream, a, (s))
    DBG(0);
#else
#define DBG(s) do {} while (0)
#endif
    for (int p = 0; p < NPHASE; ++p) { a.ph_lo = p; a.ph_hi = p + 1; hipLaunchKernelGGL(mk_fwd, dim3(grid), dim3(NWAVES * 64), LDS_BYTES, stream, a);
        if (p == 0) DBG(1); if (p == 1) DBG(2); if (p == 2) DBG(3); if (p == 3) DBG(4); if (p == 4) DBG(5); if (p == 5) DBG(6); if (p == 6) DBG(9); if (p == 7) DBG(8); if (p == 8) DBG(10);
        if (p == 9) DBG(11); if (p == 10) DBG(12); if (p == 11) DBG(13); if (p == 12) { DBG(14); DBG(15); } if (p == 13) DBG(16); }
    DBG(99);
#endif
}
```
